# Optimizing an MI355X kernel written in HIP

```python
import jax, jax.numpy as jnp
from jax import lax
import numpy as np


D_MODEL = 2048
BATCH = 4
SEQ = 2048
DEPTH = 4

GRID_W = 64
CTX_LEN = 256
F32 = jnp.float32

N_BRANCH = 4
RMS_EPS = 1e-6
CONV_DIM = 512
CONV_WIDTH = 31
LN_EPS = 1e-5
SSD_HEADS = 12
SSD_HEAD_DIM = 64
SSD_DIM = SSD_HEADS * SSD_HEAD_DIM
SSD_GROUPS = 4
SSD_STATE = 128
SSD_CONV = 5
SSD_CHUNK = 128
SSD_XBC = SSD_DIM + 2 * SSD_GROUPS * SSD_STATE
SSD_IN = SSD_DIM + SSD_XBC + 2 * SSD_HEADS
FOURIER_GROUPS = 4
FOURIER_GROUP_DIM = 128
FOURIER_DIM = FOURIER_GROUPS * FOURIER_GROUP_DIM
RWKV_HEADS = 8
RWKV_HEAD_DIM = 64
RWKV_DIM = RWKV_HEADS * RWKV_HEAD_DIM
DECAY_LORA = 64
ICL_LORA = 64
GATE_LORA = 128
GN_EPS = 64e-5
RWKV_IN = 3 * RWKV_DIM + 2 * DECAY_LORA + ICL_LORA + GATE_LORA
RWKV_OFFSETS = [RWKV_DIM, 2 * RWKV_DIM, 3 * RWKV_DIM, 3 * RWKV_DIM + DECAY_LORA, 3 * RWKV_DIM + 2 * DECAY_LORA, 3 * RWKV_DIM + 2 * DECAY_LORA + ICL_LORA]
REC_IN = SSD_IN + RWKV_IN
IN_OFFSETS = [SSD_IN, REC_IN, REC_IN + 2 * CONV_DIM, REC_IN + 2 * CONV_DIM + FOURIER_DIM]
IN_DIM = REC_IN + 2 * CONV_DIM + FOURIER_DIM + N_BRANCH * D_MODEL
D_FF = 4 * D_MODEL

kernel_name = 'hybrid_gated_conv_ssd_fourier_rwkv_dit'


def rms_norm(v, g):
    vf = v.astype(F32)
    y = vf * lax.rsqrt(jnp.mean(vf * vf, axis=-1, keepdims=True) + RMS_EPS)
    return (y * g.astype(F32)).astype(v.dtype)


def layer_norm(v, g, b, eps):
    vf = v.astype(F32)
    mu = jnp.mean(vf, axis=-1, keepdims=True)
    var = jnp.mean(jnp.square(vf - mu), axis=-1, keepdims=True)
    return ((vf - mu) * lax.rsqrt(var + eps) * g.astype(F32) + b.astype(F32)).astype(v.dtype)


def _flip(t):
    return jnp.flip(t, axis=1)


def dwconv1d(v, w, bias):
    k, ch = w.shape
    y = lax.conv_general_dilated(v, w.astype(v.dtype)[:, None, :], (1,), [((k - 1) // 2, k // 2)],
                                 dimension_numbers=('NWC', 'WIO', 'NWC'), feature_group_count=ch)
    return y + bias.astype(v.dtype)


def token_shift(v):
    z = jnp.zeros_like(v[:, :1])
    prev = jnp.concatenate([z, v[:, :-1]], axis=1)
    nxt = jnp.concatenate([v[:, 1:], z], axis=1)
    return 0.5 * (prev + nxt) - v


def to_cols(t, rows):
    b, l, ch = t.shape
    return t.reshape(b, rows, GRID_W, ch).transpose(0, 2, 1, 3).reshape(b, l, ch)


def to_rows(t, rows):
    b, l, ch = t.shape
    return t.reshape(b, GRID_W, rows, ch).transpose(0, 2, 1, 3).reshape(b, l, ch)


def segsum(a):
    t = a.shape[-1]
    cs = jnp.cumsum(a, axis=-1)
    diff = cs[..., :, None] - cs[..., None, :]
    return jnp.where(jnp.tril(jnp.ones((t, t), dtype=bool)), diff, -jnp.inf)


def ssd_scan(xs, dt, A, Bm, Cm, h0, need_y):
    b, l, nh, p = xs.shape
    g, n = Bm.shape[2], Bm.shape[3]
    r = nh // g
    c, q = l // SSD_CHUNK, SSD_CHUNK
    xd = (xs * dt[..., None]).reshape(b, c, q, g, r, p)
    a = (dt * A).reshape(b, c, q, g, r)
    a_cs = jnp.cumsum(a, axis=2)
    Bc = Bm.reshape(b, c, q, g, n)
    decay_s = jnp.exp(a_cs[:, :, -1:] - a_cs)
    states = jnp.einsum('bcsgn,bcsgrp->bcgrpn', Bc, xd * decay_s[..., None])
    states = jnp.concatenate([h0.reshape(b, 1, g, r, p, n), states], axis=1)
    chunk_tot = jnp.pad(a_cs[:, :, -1], ((0, 0), (1, 0), (0, 0), (0, 0))).transpose(0, 2, 3, 1)
    decay_c = jnp.exp(segsum(chunk_tot))
    states = jnp.einsum('bgrzc,bcgrpn->bzgrpn', decay_c, states)
    final = states[:, -1].reshape(b, nh, p, n)
    if not need_y:
        return None, final
    Cc = Cm.reshape(b, c, q, g, n)
    L = jnp.exp(segsum(a.transpose(0, 3, 4, 1, 2)))
    CB = jnp.einsum('bclgn,bcsgn->bgcls', Cc, Bc)
    y_diag = jnp.einsum('bgrcls,bcsgrp->bclgrp', CB[:, :, None] * L, xd)
    y_off = jnp.einsum('bclgn,bcgrpn->bclgrp', Cc, states[:, :-1]) * jnp.exp(a_cs)[..., None]
    return (y_diag + y_off).reshape(b, l, nh, p), final


def ssd_branch(u, uc, ctx_out, conv_w, conv_b, A_log, dt_bias, D_skip, norm_g, w_out):
    A = -jnp.exp(A_log.astype(F32))
    dtb = dt_bias.astype(F32)
    Dsk = D_skip.astype(F32)[:, None]

    def prep(v):
        b, l, _ = v.shape
        z, xbc, dt = jnp.split(v, [SSD_DIM, SSD_DIM + SSD_XBC], axis=-1)
        xbc = jax.nn.silu(dwconv1d(xbc, conv_w, conv_b)).astype(F32)
        xs, Bm, Cm = jnp.split(xbc, [SSD_DIM, SSD_DIM + SSD_GROUPS * SSD_STATE], axis=-1)
        xs = xs.reshape(b, l, SSD_HEADS, SSD_HEAD_DIM)
        Bm = Bm.reshape(b, l, SSD_GROUPS, SSD_STATE)
        Cm = Cm.reshape(b, l, SSD_GROUPS, SSD_STATE)
        dt = jax.nn.softplus(dt.astype(F32).reshape(b, l, 2, SSD_HEADS) + dtb)
        return z, xs, Bm, Cm, dt

    def run(v, h0f, h0b, need_y):
        z, xs, Bm, Cm, dt = prep(v)
        yf, sf = ssd_scan(xs, dt[:, :, 0], A[0], Bm, Cm, h0f, need_y)
        yb, sb = ssd_scan(_flip(xs), _flip(dt[:, :, 1]), A[1], _flip(Bm), _flip(Cm), h0b, need_y)
        if not need_y:
            return None, sf, sb
        y = yf + _flip(yb) + Dsk * xs
        y = y.reshape(z.shape).astype(z.dtype) * jax.nn.silu(z)
        return rms_norm(y, norm_g) @ w_out, sf, sb

    h0 = jnp.zeros((u.shape[0], SSD_HEADS, SSD_HEAD_DIM, SSD_STATE), F32)
    yc, sf, sb = run(uc, h0, h0, ctx_out)
    y, _, _ = run(u, sf, sb, True)
    return y, yc


def rwkv7_scan(r, w, k, v, kk, ka, S0, readout):
    def step(S, inp):
        r_t, w_t, k_t, v_t, kk_t, ka_t = inp
        sa = jnp.einsum('bhvk,bhk->bhv', S, -kk_t)
        S = S * w_t[:, :, None, :] + sa[..., None] * ka_t[:, :, None, :] + v_t[..., None] * k_t[:, :, None, :]
        y = jnp.einsum('bhvk,bhk->bhv', S, r_t) if readout else None
        return S, y
    seq = tuple(jnp.moveaxis(t, 1, 0) for t in (r, w, k, v, kk, ka))
    S, ys = lax.scan(step, S0, seq)
    return (jnp.moveaxis(ys, 0, 1) if readout else None), S


def rwkv_branch(u, uc, rows, ctx_out, mu, w0, w2, a0, a2, g2, k_k, k_a, r_k, ln_g, ln_b, w_out):
    def prep(v):
        b, l, _ = v.shape
        v = v + token_shift(v) * mu
        r, k, vv, wf, wb, al, gl = jnp.split(v, RWKV_OFFSETS, axis=-1)
        heads = lambda t: t.astype(F32).reshape(b, l, RWKV_HEADS, RWKV_HEAD_DIM)

        def decay(lo, d):
            wl = -jax.nn.softplus(-(w0[d] + jnp.tanh(lo) @ w2[d])) - 0.5
            return heads(jnp.exp(-jnp.exp(wl.astype(F32))))
        a = jax.nn.sigmoid(a0 + al @ a2)
        kk = heads(k * k_k)
        kk = kk * lax.rsqrt(jnp.sum(kk * kk, axis=-1, keepdims=True) + 1e-12)
        kmod = heads(k * (1 + (a - 1) * k_a))
        g = jax.nn.sigmoid(gl) @ g2
        return heads(r), decay(wf, 0), decay(wb, 1), kmod, heads(vv), kk, kk * heads(a), g

    def run(v, S0f, S0b, need_y):
        b, l, _ = v.shape
        r, wf, wb, k, vv, kk, ka, g = prep(v)
        yf, Sf = rwkv7_scan(r, wf, k, vv, kk, ka, S0f, need_y)
        yb, Sb = rwkv7_scan(*(_flip(t) for t in (r, wb, k, vv, kk, ka)), S0b, need_y)
        if not need_y:
            return None, Sf, Sb
        y = yf + _flip(yb)
        m = jnp.mean(y, axis=-1, keepdims=True)
        var = jnp.mean(jnp.square(y - m), axis=-1, keepdims=True)
        y = ((y - m) * lax.rsqrt(var + GN_EPS)).reshape(b, l, RWKV_DIM) * ln_g + ln_b
        bonus = (jnp.sum(r * k * r_k, axis=-1, keepdims=True) * vv).reshape(b, l, RWKV_DIM)
        return ((y + bonus) * g).astype(v.dtype), Sf, Sb

    S0 = jnp.zeros((u.shape[0], RWKV_HEADS, RWKV_HEAD_DIM, RWKV_HEAD_DIM), F32)
    oc, Sf, Sb = run(uc, S0, S0, ctx_out)
    o, _, _ = run(to_cols(u, rows), Sf, Sb, True)
    y = to_rows(o, rows) @ w_out
    yc = oc @ w_out if ctx_out else None
    return y, yc


def conformer_branch(u, seg, conv_w, conv_b, ln_g, ln_b, w_out):
    b, l, _ = u.shape
    val, gate = jnp.split(u, 2, axis=-1)
    v = (val * jax.nn.sigmoid(gate)).reshape(-1, seg, CONV_DIM)
    v = dwconv1d(v, conv_w, conv_b).reshape(b, l, CONV_DIM)
    v = layer_norm(v, ln_g, ln_b, LN_EPS)
    return jax.nn.silu(v) @ w_out


def fourier_branch(u, w_out):
    b, l, _ = u.shape
    uf = u.astype(F32).reshape(b, l, FOURIER_GROUPS, FOURIER_GROUP_DIM)
    y = jnp.fft.fftn(uf, axes=(1, 3), norm='ortho').real
    return y.reshape(b, l, FOURIER_DIM).astype(u.dtype) @ w_out


def gated_merge(gate_pre, branches, w_o):
    b, l, _ = gate_pre.shape
    gates = jax.nn.sigmoid(gate_pre).reshape(b, l, N_BRANCH, D_MODEL)
    m = gates[:, :, 0] * branches[0]
    for i in range(1, N_BRANCH):
        m = m + gates[:, :, i] * branches[i]
    return m @ w_o


def hybrid_mixer(h, hc, rows, ctx_out, w_in, conv_p, ssd_p, fourier_out, rwkv_p, w_o):
    u = h @ w_in
    uc = hc @ (w_in if ctx_out else w_in[:, :REC_IN])
    u_ssd, u_rwkv, u_conv, u_fft, u_gate = jnp.split(u, IN_OFFSETS, axis=-1)
    uc_ssd, uc_rwkv = uc[..., :SSD_IN], uc[..., SSD_IN:REC_IN]
    p_ssd, pc_ssd = ssd_branch(u_ssd, uc_ssd, ctx_out, *ssd_p)
    p_rwkv, pc_rwkv = rwkv_branch(u_rwkv, uc_rwkv, rows, ctx_out, *rwkv_p)
    p_conv = conformer_branch(u_conv, GRID_W, *conv_p)
    p_fft = fourier_branch(u_fft, fourier_out)
    y = gated_merge(u_gate, (p_conv, p_ssd, p_fft, p_rwkv), w_o)
    if not ctx_out:
        return y, None
    uc_conv, uc_fft, uc_gate = uc[..., IN_OFFSETS[1]:IN_OFFSETS[2]], uc[..., IN_OFFSETS[2]:IN_OFFSETS[3]], uc[..., IN_OFFSETS[3]:]
    pc_conv = conformer_branch(uc_conv, uc_conv.shape[1], *conv_p)
    pc_fft = fourier_branch(uc_fft, fourier_out)
    yc = gated_merge(uc_gate, (pc_conv, pc_ssd, pc_fft, pc_rwkv), w_o)
    return y, yc


def sq_relu_mlp(h, w_up, w_down):
    return jnp.square(jax.nn.relu(h @ w_up)) @ w_down


def setup_inputs(seed: int = 0) -> dict:
    key = jax.random.key(seed)
    ks = iter(jax.random.split(key, 48))
    nrm = lambda shape, scale: jax.random.normal(next(ks), shape, F32) * scale
    L, D = DEPTH, D_MODEL
    x = nrm((BATCH, SEQ, D), 1.0)
    c = nrm((BATCH, D), 1.0)
    ctx = nrm((BATCH, CTX_LEN, D), 1.0)
    c_ctx = nrm((D,), 1.0)
    mod_w = nrm((L, D, 6 * D), 0.5 * D ** -0.5)
    mod_b = nrm((L, 6 * D), 0.02)
    norm_g = 1.0 + nrm((L, 4, D), 0.02)
    w_in = nrm((L, D, IN_DIM), D ** -0.5)
    conv_w = nrm((L, CONV_WIDTH, CONV_DIM), CONV_WIDTH ** -0.5)
    conv_b = nrm((L, CONV_DIM), 0.02)
    conv_ln_g = 1.0 + nrm((L, CONV_DIM), 0.02)
    conv_ln_b = nrm((L, CONV_DIM), 0.02)
    conv_out = nrm((L, CONV_DIM, D), CONV_DIM ** -0.5)
    ssd_conv_w = nrm((L, SSD_CONV, SSD_XBC), SSD_CONV ** -0.5)
    ssd_conv_b = nrm((L, SSD_XBC), 0.02)
    ssd_A_log = jnp.log(jax.random.uniform(next(ks), (L, 2, SSD_HEADS), F32, 1.0, 16.0))
    dt0 = jnp.exp(jax.random.uniform(next(ks), (L, 2, SSD_HEADS), F32, float(np.log(1e-3)), float(np.log(1e-1))))
    ssd_dt_bias = dt0 + jnp.log(-jnp.expm1(-dt0))
    ssd_D = 1.0 + nrm((L, SSD_HEADS), 0.1)
    ssd_norm_g = 1.0 + nrm((L, SSD_DIM), 0.02)
    ssd_out = nrm((L, SSD_DIM, D), SSD_DIM ** -0.5)
    fourier_out = nrm((L, FOURIER_DIM, D), FOURIER_DIM ** -0.5)
    rwkv_mu = jax.random.uniform(next(ks), (L, RWKV_IN), F32, 0.0, 1.0)
    rwkv_w0 = nrm((L, 2, RWKV_DIM), 0.5)
    rwkv_w2 = nrm((L, 2, DECAY_LORA, RWKV_DIM), 0.1 * DECAY_LORA ** -0.5)
    rwkv_a0 = nrm((L, RWKV_DIM), 0.1)
    rwkv_a2 = nrm((L, ICL_LORA, RWKV_DIM), 0.1 * ICL_LORA ** -0.5)
    rwkv_g2 = nrm((L, GATE_LORA, RWKV_DIM), GATE_LORA ** -0.5)
    rwkv_k_k = 0.85 + nrm((L, RWKV_DIM), 0.02)
    rwkv_k_a = 1.0 + nrm((L, RWKV_DIM), 0.02)
    rwkv_r_k = nrm((L, RWKV_HEADS, RWKV_HEAD_DIM), 0.1)
    rwkv_ln_g = 1.0 + nrm((L, RWKV_DIM), 0.02)
    rwkv_ln_b = nrm((L, RWKV_DIM), 0.02)
    rwkv_out = nrm((L, RWKV_DIM, D), RWKV_DIM ** -0.5)
    w_o = nrm((L, D, D), D ** -0.5)
    mlp_up = nrm((L, D, D_FF), D ** -0.5)
    mlp_down = nrm((L, D_FF, D), D_FF ** -0.5)
    return {'x': x, 'c': c, 'ctx': ctx, 'c_ctx': c_ctx, 'mod_w': mod_w, 'mod_b': mod_b,
            'norm_g': norm_g, 'w_in': w_in,
            'conv_w': conv_w, 'conv_b': conv_b, 'conv_ln_g': conv_ln_g, 'conv_ln_b': conv_ln_b, 'conv_out': conv_out,
            'ssd_conv_w': ssd_conv_w, 'ssd_conv_b': ssd_conv_b, 'ssd_A_log': ssd_A_log, 'ssd_dt_bias': ssd_dt_bias,
            'ssd_D': ssd_D, 'ssd_norm_g': ssd_norm_g, 'ssd_out': ssd_out,
            'fourier_out': fourier_out,
            'rwkv_mu': rwkv_mu, 'rwkv_w0': rwkv_w0, 'rwkv_w2': rwkv_w2, 'rwkv_a0': rwkv_a0, 'rwkv_a2': rwkv_a2,
            'rwkv_g2': rwkv_g2, 'rwkv_k_k': rwkv_k_k, 'rwkv_k_a': rwkv_k_a, 'rwkv_r_k': rwkv_r_k,
            'rwkv_ln_g': rwkv_ln_g, 'rwkv_ln_b': rwkv_ln_b, 'rwkv_out': rwkv_out,
            'w_o': w_o, 'mlp_up': mlp_up, 'mlp_down': mlp_down}


def reference(x, c, ctx, c_ctx, mod_w, mod_b, norm_g, w_in,
              conv_w, conv_b, conv_ln_g, conv_ln_b, conv_out,
              ssd_conv_w, ssd_conv_b, ssd_A_log, ssd_dt_bias, ssd_D, ssd_norm_g, ssd_out,
              fourier_out,
              rwkv_mu, rwkv_w0, rwkv_w2, rwkv_a0, rwkv_a2, rwkv_g2, rwkv_k_k, rwkv_k_a, rwkv_r_k,
              rwkv_ln_g, rwkv_ln_b, rwkv_out,
              w_o, mlp_up, mlp_down):
    rows = x.shape[1] // GRID_W
    xc = ctx
    silu_c = jax.nn.silu(c)
    silu_cc = jax.nn.silu(c_ctx)
    for i in range(DEPTH):
        last = i == DEPTH - 1
        mod = silu_c @ mod_w[i] + mod_b[i]
        modc = silu_cc @ mod_w[i] + mod_b[i]
        sh1, sc1, g1, sh2, sc2, g2 = jnp.split(mod[:, None, :], 6, axis=-1)
        csh1, csc1, cg1, csh2, csc2, cg2 = jnp.split(modc, 6, axis=-1)
        conv_p = (conv_w[i], conv_b[i], conv_ln_g[i], conv_ln_b[i], conv_out[i])
        ssd_p = (ssd_conv_w[i], ssd_conv_b[i], ssd_A_log[i], ssd_dt_bias[i], ssd_D[i], ssd_norm_g[i], ssd_out[i])
        rwkv_p = (rwkv_mu[i], rwkv_w0[i], rwkv_w2[i], rwkv_a0[i], rwkv_a2[i], rwkv_g2[i], rwkv_k_k[i],
                  rwkv_k_a[i], rwkv_r_k[i], rwkv_ln_g[i], rwkv_ln_b[i], rwkv_out[i])
        h = rms_norm(x, norm_g[i, 0]) * (1 + sc1) + sh1
        hc = rms_norm(xc, norm_g[i, 0]) * (1 + csc1) + csh1
        y, yc = hybrid_mixer(h, hc, rows, not last, w_in[i], conv_p, ssd_p, fourier_out[i], rwkv_p, w_o[i])
        x = x + g1 * rms_norm(y, norm_g[i, 1])
        h = rms_norm(x, norm_g[i, 2]) * (1 + sc2) + sh2
        x = x + g2 * rms_norm(sq_relu_mlp(h, mlp_up[i], mlp_down[i]), norm_g[i, 3])
        if not last:
            xc = xc + cg1 * rms_norm(yc, norm_g[i, 1])
            hc = rms_norm(xc, norm_g[i, 2]) * (1 + csc2) + csh2
            xc = xc + cg2 * rms_norm(sq_relu_mlp(hc, mlp_up[i], mlp_down[i]), norm_g[i, 3])
    return x
```

```cpp
#include <hip/hip_runtime.h>
#include <cstdio>
#include <cstdint>
namespace pg8 {
#define PG8_LAS __attribute__((address_space(3)))
typedef unsigned short bf16_t;
typedef short bf16x8 __attribute__((ext_vector_type(8)));
typedef float f32x4 __attribute__((ext_vector_type(4)));
typedef unsigned u32x4 __attribute__((ext_vector_type(4)));
constexpr int BM = 256, BK = 64, HALF = 128, HTB = HALF * BK * 2  , STAGE_BYTES = 8 * HTB, NXCD = 8, WGM = 8;

__host__ __device__ __forceinline__ int lds_byte(int r, int c) { const int st = (r >> 4) * 2 + (c >> 5), rr = r & 15, cc = c & 31, ob = rr * 64 + cc * 2; return st * 1024 + (ob ^ (((ob >> 9) & 1) << 5)); }
__host__ __device__ __forceinline__ void stage_rc(int b, int& R, int& C) { const int st = b / 1024, sb = b % 1024, swz = sb ^ (((sb >> 9) & 1) << 5); R = (st >> 1) * 16 + swz / 64; C = (st & 1) * 32 + (swz % 64) / 2; }
__host__ __device__ __forceinline__ int perm32(int rho) { const int n = rho >> 4, i = rho & 15; return 8 * (i >> 2) + 4 * n + (i & 3); }

struct Unit { int pm, pn; };
struct Gemm { const bf16_t* A; const bf16_t* Bt; int M, N, K; };

struct StaticOrder {
    int nM, nN, nwg, G, c;
    __host__ __device__ void init(int M, int N, int G_, int c_) { nM = M / BM; nN = N / BM; nwg = nM * nN; G = G_; c = c_; }
    __host__ __device__ bool next(int i, Unit& u) const {
        const long L = (long)i * G + c; if (L >= nwg) return false;
        int wgid = (int)L; { const int q = nwg / NXCD, r = nwg % NXCD, xcd = wgid % NXCD, off = wgid / NXCD; wgid = (xcd < r ? xcd * (q + 1) : r * (q + 1) + (xcd - r) * q) + off; }
        const int nig = WGM * nN, gid = wgid / nig, fm = gid * WGM, gsz = (nM - fm) < WGM ? (nM - fm) : WGM;
        u.pm = fm + ((wgid % nig) % gsz); u.pn = (wgid % nig) / gsz; return true;
    }
    __device__ __forceinline__ void a_ready(const Unit&) const {}
    __device__ __forceinline__ void done(const Unit&) const {}
};
__device__ __forceinline__ unsigned cvt_pk_bf16(float lo, float hi) { unsigned r; asm volatile("v_cvt_pk_bf16_f32 %0, %1, %2" : "=v"(r) : "v"(lo), "v"(hi)); return r; }
typedef float f32x2 __attribute__((ext_vector_type(2)));
template <class Epi, class Sched, bool ALIGN_EPI = false, bool SP2 = false>
__device__ __forceinline__ void gemm_phase(PG8_LAS unsigned char* lds, const Gemm g, const Sched& S, const Epi& E) {
    int tid_ = threadIdx.x; asm volatile("" : "+v"(tid_)); const int tid = tid_, wid = __builtin_amdgcn_readfirstlane(tid >> 6), lane = tid & 63, wr = wid >> 2, wc = wid & 3, fr = lane & 15, fq = lane >> 4;
    const int K = g.K, nt = K / BK;
    unsigned voffA[2], voffB[2];
#pragma unroll
    for (int i = 0; i < 2; ++i) { int R, C; stage_rc(tid * 16 + i * 8192, R, C); const int Rb = Epi::PERM ? ((R & ~31) + perm32(R & 31)) : R;
        voffA[i] = (unsigned)(R * K + C) * 2u; voffB[i] = (unsigned)(Rb * K + C) * 2u; }
    const size_t kstep = (size_t)(BK * 2);
    const size_t hstep = (size_t)HALF * K * 2;
    const size_t tstep = 2 * hstep;
    const unsigned ldsw = (unsigned)wid * 1024u;
    const int aoff = lds_byte(wr * 64 + fr, fq * 8), boff = lds_byte(wc * 32 + fr, fq * 8);
#define PG8_SA(b, h) (((b) * 2 + (h)) * HTB)
#define PG8_SB(b, h) ((4 + (b) * 2 + (h)) * HTB)
#define PG8_STAGE(bufoff, gbase, voff) do { _Pragma("unroll") for (int _i = 0; _i < 2; ++_i) \
        __builtin_amdgcn_global_load_lds((const unsigned*)((const char*)(gbase) + (voff)[_i]), (PG8_LAS unsigned*)(lds + (bufoff) + ldsw + _i * 8192), 16, 0, 0); } while (0)
#define PG8_LDA(dst, b, h) do { _Pragma("unroll") for (int m = 0; m < 4; ++m) _Pragma("unroll") for (int k = 0; k < 2; ++k) dst[m][k] = *(const PG8_LAS bf16x8*)(lds + PG8_SA(b, h) + aoff + m * 2048 + k * 1024); } while (0)
#define PG8_LDB(dst, b, h) do { _Pragma("unroll") for (int n = 0; n < 2; ++n) _Pragma("unroll") for (int k = 0; k < 2; ++k) dst[n][k] = *(const PG8_LAS bf16x8*)(lds + PG8_SB(b, h) + boff + n * 2048 + k * 1024); } while (0)
#define PG8_MMA(ai, bj, At, Bt) do { __builtin_amdgcn_s_setprio(1); _Pragma("unroll") for (int m = 0; m < 4; ++m) _Pragma("unroll") for (int n = 0; n < 2; ++n) _Pragma("unroll") for (int k = 0; k < 2; ++k) \
        acc[ai][bj][m][n] = __builtin_amdgcn_mfma_f32_16x16x32_bf16(Bt[n][k], At[m][k], acc[ai][bj][m][n], 0, 0, 0); __builtin_amdgcn_s_setprio(0); } while (0)
#define PG8_WAIT_V(n) asm volatile("s_waitcnt vmcnt(" #n ")" ::: "memory")
#define PG8_WAIT_L(n) asm volatile("s_waitcnt lgkmcnt(" #n ")" ::: "memory")
#define PG8_BAR __builtin_amdgcn_s_barrier()
#define PG8_SCHED __builtin_amdgcn_sched_barrier(0)
    Unit cur, nxt; int ui = 0;
    if (!S.next(0, cur)) return;
    f32x4 acc[2][2][4][2];
#pragma unroll
    for (int a = 0; a < 2; ++a)
#pragma unroll
        for (int b = 0; b < 2; ++b)
#pragma unroll
            for (int m = 0; m < 4; ++m)
#pragma unroll
                for (int n = 0; n < 2; ++n) acc[a][b][m][n] = (f32x4){0.f, 0.f, 0.f, 0.f};
    bf16x8 At[4][2], B0[2][2], B1[2][2];
    const char* cA = (const char*)g.A + (size_t)cur.pm * tstep; const char* cB = (const char*)g.Bt + (size_t)cur.pn * tstep;
    S.a_ready(cur);
    if constexpr (SP2) {
        PG8_STAGE(PG8_SB(0, 0), cB, voffB); PG8_STAGE(PG8_SB(0, 1), cB + hstep, voffB); PG8_STAGE(PG8_SA(0, 0), cA, voffA); PG8_STAGE(PG8_SA(0, 1), cA + hstep, voffA);
        if (wr == 1) PG8_BAR;
        PG8_WAIT_V(2); PG8_BAR;
        PG8_STAGE(PG8_SB(1, 0), cB + kstep, voffB); PG8_STAGE(PG8_SA(1, 0), cA + kstep, voffA); PG8_STAGE(PG8_SB(1, 1), cB + hstep + kstep, voffB);
        PG8_WAIT_V(6); PG8_BAR;
    } else {
        PG8_STAGE(PG8_SB(0, 0), cB, voffB); PG8_STAGE(PG8_SA(0, 0), cA, voffA); PG8_STAGE(PG8_SB(0, 1), cB + hstep, voffB); PG8_STAGE(PG8_SA(0, 1), cA + hstep, voffA);
        if (wr == 1) PG8_BAR;
        PG8_WAIT_V(4); PG8_BAR;
        PG8_STAGE(PG8_SB(1, 0), cB + kstep, voffB); PG8_STAGE(PG8_SA(1, 0), cA + kstep, voffA); PG8_STAGE(PG8_SB(1, 1), cB + hstep + kstep, voffB);
        PG8_WAIT_V(6); PG8_BAR;
    }
    for (;;) {
        const bool has_next = S.next(ui + 1, nxt);
        const char* nA = has_next ? (const char*)g.A + (size_t)nxt.pm * tstep : cA; const char* nB = has_next ? (const char*)g.Bt + (size_t)nxt.pn * tstep : cB;
        for (int t = 0; t < nt; t += 2) {
            const bool last = (t == nt - 2);
            const char* a1 = cA + (size_t)(t + 1) * kstep;
            const char* a2 = last ? nA : cA + (size_t)(t + 2) * kstep; const char* b2 = last ? nB : cB + (size_t)(t + 2) * kstep;
            const char* a3 = a2 + kstep; const char* b3 = b2 + kstep;
            if (last && has_next) S.a_ready(nxt);
            if constexpr (SP2) {
            PG8_LDB(B0, 0, 0); PG8_LDB(B1, 0, 1); PG8_SCHED; PG8_LDA(At, 0, 0); PG8_STAGE(PG8_SA(1, 1), a1 + hstep, voffA);
            PG8_WAIT_V(8); PG8_WAIT_L(0); PG8_BAR; PG8_MMA(0, 0, At, B0); PG8_MMA(0, 1, At, B1); PG8_BAR; PG8_SCHED;
            PG8_LDA(At, 0, 1); PG8_STAGE(PG8_SB(0, 0), b2, voffB); PG8_STAGE(PG8_SB(0, 1), b2 + hstep, voffB); PG8_STAGE(PG8_SA(0, 0), a2, voffA);
            PG8_WAIT_V(8); PG8_WAIT_L(0); PG8_BAR; PG8_MMA(1, 0, At, B0); PG8_MMA(1, 1, At, B1); PG8_BAR; PG8_SCHED;
            PG8_LDB(B0, 1, 0); PG8_LDB(B1, 1, 1); PG8_SCHED; PG8_LDA(At, 1, 0); PG8_STAGE(PG8_SA(0, 1), a2 + hstep, voffA);
            PG8_WAIT_V(8); PG8_WAIT_L(0); PG8_BAR; PG8_MMA(0, 0, At, B0); PG8_MMA(0, 1, At, B1); PG8_BAR; PG8_SCHED;
            PG8_LDA(At, 1, 1); PG8_STAGE(PG8_SB(1, 0), b3, voffB); PG8_STAGE(PG8_SB(1, 1), b3 + hstep, voffB); PG8_STAGE(PG8_SA(1, 0), a3, voffA);
            PG8_WAIT_V(8); PG8_WAIT_L(0); PG8_BAR; PG8_MMA(1, 0, At, B0); PG8_MMA(1, 1, At, B1); PG8_BAR; PG8_SCHED;
            } else {
            PG8_LDB(B0, 0, 0); PG8_SCHED; PG8_LDA(At, 0, 0); PG8_STAGE(PG8_SA(1, 1), a1 + hstep, voffA);
            PG8_WAIT_L(8); PG8_BAR; PG8_WAIT_L(0); PG8_MMA(0, 0, At, B0); PG8_BAR; PG8_SCHED;
            PG8_LDB(B1, 0, 1); PG8_STAGE(PG8_SB(0, 0), b2, voffB);
            PG8_BAR; PG8_WAIT_L(0); PG8_MMA(0, 1, At, B1); PG8_BAR;
            PG8_LDA(At, 0, 1); PG8_STAGE(PG8_SA(0, 0), a2, voffA);
            PG8_BAR; PG8_WAIT_L(0); PG8_MMA(1, 0, At, B0); PG8_BAR; PG8_SCHED;
            PG8_STAGE(PG8_SB(0, 1), b2 + hstep, voffB);
            PG8_WAIT_V(6); PG8_BAR; PG8_MMA(1, 1, At, B1); PG8_BAR;
            PG8_LDB(B0, 1, 0); PG8_SCHED; PG8_LDA(At, 1, 0); PG8_STAGE(PG8_SA(0, 1), a2 + hstep, voffA);
            PG8_WAIT_L(8); PG8_BAR; PG8_WAIT_L(0); PG8_MMA(0, 0, At, B0); PG8_BAR; PG8_SCHED;
            PG8_LDB(B1, 1, 1); PG8_STAGE(PG8_SB(1, 0), b3, voffB);
            PG8_BAR; PG8_WAIT_L(0); PG8_MMA(0, 1, At, B1); PG8_BAR;
            PG8_LDA(At, 1, 1); PG8_STAGE(PG8_SA(1, 0), a3, voffA);
            PG8_BAR; PG8_WAIT_L(0); PG8_MMA(1, 0, At, B0); PG8_BAR; PG8_SCHED;
            PG8_STAGE(PG8_SB(1, 1), b3 + hstep, voffB);
            PG8_WAIT_V(6); PG8_BAR; PG8_MMA(1, 1, At, B1); PG8_BAR;
            }
        }
        if constexpr (ALIGN_EPI) { if (wr == 0) PG8_BAR; }
        if constexpr (!Epi::AFTER_DRAIN) { E(acc, cur, wr, wc, fr, fq); S.done(cur); }
        if (!has_next) break;
#pragma unroll
        for (int a = 0; a < 2; ++a)
#pragma unroll
            for (int b = 0; b < 2; ++b)
#pragma unroll
                for (int m = 0; m < 4; ++m)
#pragma unroll
                    for (int n = 0; n < 2; ++n) acc[a][b][m][n] = (f32x4){0.f, 0.f, 0.f, 0.f};
        cur = nxt; cA = nA; cB = nB; ++ui;
        if constexpr (ALIGN_EPI) { if (wr == 1) PG8_BAR; }
    }
    PG8_WAIT_V(0);
    if constexpr (!ALIGN_EPI) { if (wr == 0) PG8_BAR; }
    PG8_BAR;
    if constexpr (Epi::AFTER_DRAIN) { E.fused(acc, cur, wr, wc, fr, fq, lds, wid, lane); S.done(cur); }
#undef PG8_SA
#undef PG8_SB
#undef PG8_STAGE
#undef PG8_LDA
#undef PG8_LDB
#undef PG8_MMA
#undef PG8_WAIT_V
#undef PG8_WAIT_L
#undef PG8_BAR
#undef PG8_SCHED
}
}

namespace pg8 {
__device__ __forceinline__ float sigm(float x) { return __builtin_amdgcn_rcpf(1.f + __expf(-x)); }
__device__ __forceinline__ f32x4 sigm4(f32x4 v) { return (f32x4){sigm(v[0]), sigm(v[1]), sigm(v[2]), sigm(v[3])}; }
__device__ __forceinline__ u32x4 pack8(f32x4 v0, f32x4 v1) { u32x4 w; w.x = cvt_pk_bf16(v0[0], v0[1]); w.y = cvt_pk_bf16(v0[2], v0[3]); w.z = cvt_pk_bf16(v1[0], v1[1]); w.w = cvt_pk_bf16(v1[2], v1[3]); return w; }
__device__ __forceinline__ float bflo(unsigned u) { return __uint_as_float(u << 16); }
__device__ __forceinline__ float bfhi(unsigned u) { return __uint_as_float(u & 0xffff0000u); }

struct EpiInproj {
    static constexpr bool PERM = true, AFTER_DRAIN = false;
    bf16_t* U; float* MISC; int ldu;
    __device__ __forceinline__ void operator()(const f32x4 (&acc)[2][2][4][2], const Unit& u, int wr, int wc, int fr, int fq) const {
        const int row0 = u.pm * BM + wr * 64 + fr, cl = wc * 32 + 8 * fq;
        if (u.pn == 16 || u.pn == 17) {
#pragma unroll
            for (int ai = 0; ai < 2; ++ai)
#pragma unroll
                for (int m = 0; m < 4; ++m) { float* rowp = MISC + (size_t)(row0 + ai * HALF + m * 16) * 512 + (u.pn - 16) * BM + cl;
#pragma unroll
                    for (int bj = 0; bj < 2; ++bj) { *(f32x4*)(rowp + bj * HALF) = acc[ai][bj][m][0]; *(f32x4*)(rowp + bj * HALF + 4) = acc[ai][bj][m][1]; } }
        } else {
            const bool sg = u.pn >= 22;
#pragma unroll
            for (int ai = 0; ai < 2; ++ai)
#pragma unroll
                for (int m = 0; m < 4; ++m) { bf16_t* rowp = U + (size_t)(row0 + ai * HALF + m * 16) * ldu + u.pn * BM + cl;
#pragma unroll
                    for (int bj = 0; bj < 2; ++bj) { f32x4 v0 = acc[ai][bj][m][0], v1 = acc[ai][bj][m][1];
                        if (sg) { v0 = sigm4(v0); v1 = sigm4(v1); }
                        *(u32x4*)(rowp + bj * HALF) = pack8(v0, v1); } }
        }
    }
};
struct EpiBf {
    static constexpr bool PERM = true, AFTER_DRAIN = false;
    int kind; bf16_t* O0; bf16_t* O1;
    __device__ __forceinline__ void operator()(const f32x4 (&acc)[2][2][4][2], const Unit& u, int wr, int wc, int fr, int fq) const {
        bf16_t* base; size_t pitch;
        if (kind == 0) {
            const int half = u.pm >> 1, chb = (u.pm & 1) * 256;
            if (u.pn < 32) { const int b = u.pn >> 3, l0 = (u.pn & 7) * 256; pitch = 4096; base = O0 + ((size_t)(b * 512 + chb) * 2 + half) * 2048 + l0; }
            else { const int b = u.pn - 32; pitch = 512; base = O1 + ((size_t)(b * 512 + chb) * 2 + half) * 256; }
        } else if (kind == 1) { const int b = u.pn >> 1; pitch = 512; base = O0 + (size_t)(b * 2048 + u.pm * 256) * 512 + (u.pn & 1) * 256; }
        else if (kind == 2) { const int b = u.pn >> 1; pitch = 512; base = O0 + (size_t)(8192 + b * 256) * 512 + (u.pn & 1) * 256; }
        else { pitch = 8192; base = O0 + (size_t)(u.pm * 256) * 8192 + u.pn * 256; }
        const int r0 = wr * 64 + fr, cl = wc * 32 + 8 * fq;
#pragma unroll
        for (int ai = 0; ai < 2; ++ai)
#pragma unroll
            for (int m = 0; m < 4; ++m) { bf16_t* rowp = base + (size_t)(r0 + ai * HALF + m * 16) * pitch + cl;
#pragma unroll
                for (int bj = 0; bj < 2; ++bj) { f32x4 v0 = acc[ai][bj][m][0], v1 = acc[ai][bj][m][1];
                    if (kind == 3) { v0 = __builtin_elementwise_max(v0, (f32x4){0.f, 0.f, 0.f, 0.f}); v1 = __builtin_elementwise_max(v1, (f32x4){0.f, 0.f, 0.f, 0.f}); v0 = v0 * v0; v1 = v1 * v1; }
                    *(u32x4*)(rowp + bj * HALF) = pack8(v0, v1); } }
    }
};
struct EpiMerge {
    static constexpr bool PERM = true, AFTER_DRAIN = false;
    const bf16_t* G; int ldg; float* MB; bf16_t* Mo; int job;
    __device__ __forceinline__ void operator()(const f32x4 (&acc)[2][2][4][2], const Unit& u, int wr, int wc, int fr, int fq) const {
        const int row0 = u.pm * BM + wr * 64 + fr, col0 = u.pn * BM + wc * 32 + 8 * fq;
#pragma unroll
        for (int ai = 0; ai < 2; ++ai)
#pragma unroll
            for (int m = 0; m < 4; ++m) { const size_t row = (size_t)(row0 + ai * HALF + m * 16);
#pragma unroll
                for (int bj = 0; bj < 2; ++bj) { const int col = col0 + bj * HALF;
                    const u32x4 g = *(const u32x4*)(G + row * ldg + col);
                    f32x4 v0 = acc[ai][bj][m][0] * (f32x4){bflo(g.x), bfhi(g.x), bflo(g.y), bfhi(g.y)};
                    f32x4 v1 = acc[ai][bj][m][1] * (f32x4){bflo(g.z), bfhi(g.z), bflo(g.w), bfhi(g.w)};
                    float* mp = MB + row * 2048 + col;
                    if (job > 0) { v0 += *(const f32x4*)mp; v1 += *(const f32x4*)(mp + 4); }
                    if (job < 3) { *(f32x4*)mp = v0; *(f32x4*)(mp + 4) = v1; }
                    else *(u32x4*)(Mo + row * 2048 + col) = pack8(v0, v1); } }
    }
};
struct EpiF32 {
    static constexpr bool PERM = false, AFTER_DRAIN = false;
    float* C; int ldc;
    __device__ __forceinline__ void operator()(const f32x4 (&acc)[2][2][4][2], const Unit& u, int wr, int wc, int fr, int fq) const {
        const int row0 = u.pm * BM + wr * 64 + fr, col0 = u.pn * BM + wc * 32 + 4 * fq;
#pragma unroll
        for (int ai = 0; ai < 2; ++ai)
#pragma unroll
            for (int m = 0; m < 4; ++m) { float* rowp = C + (size_t)(row0 + ai * HALF + m * 16) * ldc + col0;
#pragma unroll
                for (int bj = 0; bj < 2; ++bj)
#pragma unroll
                    for (int n = 0; n < 2; ++n) *(f32x4*)(rowp + bj * HALF + n * 16) = acc[ai][bj][m][n]; }
    }
};
}

#define GAS __attribute__((address_space(1)))
#define LAS __attribute__((address_space(3)))
typedef unsigned short bf16;
typedef unsigned v4u __attribute__((ext_vector_type(4)));
typedef unsigned v2u __attribute__((ext_vector_type(2)));
typedef float f32x4 __attribute__((ext_vector_type(4)));
typedef float f32x2 __attribute__((ext_vector_type(2)));
constexpr int NWAVES = 8, NTHR = 512;
constexpr int DM = 2048, NBATCH = 4, LSEQ = 2048, LCTX = 256, DEPTH = 4;
constexpr int TLAT = NBATCH * LSEQ, TCTX = NBATCH * LCTX, TT = TLAT + TCTX;
constexpr int IN_DIM = 14168, DFF = 8192;
constexpr int NU = 13824;
constexpr int UZ = 0, UXBC = 768, URKV = 2560, UMISC = 4096, UCONV = 4608, UGATE = 5632;
constexpr int S_RKV = 2584, S_DT = 2560, S_WF = 4120, S_CONV = 4440, S_FFT = 5464, S_GATE = 5976;
constexpr int RJ = LCTX + LSEQ;
enum { I_X = 0, I_C, I_CTX, I_CCTX, I_MODW, I_MODB, I_NORMG, I_WIN, I_CONVW, I_CONVB, I_CLNG, I_CLNB, I_CONVOUT, I_SCW, I_SCB, I_SALOG, I_SDTB, I_SD, I_SNG, I_SOUT,
       I_FOUT, I_RMU, I_RW0, I_RW2, I_RA0, I_RA2, I_RG2, I_RKK, I_RKA, I_RRK, I_RLNG, I_RLNB, I_ROUT, I_WO, I_UP, I_DOWN, N_IN };
constexpr size_t MiB = 1u << 20;
constexpr size_t OFF_CTL = 0, CTL_BYTES = 1 * MiB;
constexpr size_t OFF_MODV = 1 * MiB;
constexpr size_t OFF_DFTL = 2 * MiB;
constexpr size_t OFF_DFTC = 18 * MiB;
constexpr size_t OFF_W = 20 * MiB, W_LAYER = 139 * MiB;
constexpr size_t WO_IN = 0, WO_FFT = 54 * MiB, WO_CO = 58 * MiB, WO_SO = 60 * MiB, WO_FO = 63 * MiB, WO_RO = 65 * MiB, WO_O = 67 * MiB, WO_UP = 75 * MiB, WO_DN = 107 * MiB;
constexpr size_t OFF_X = 576 * MiB;
constexpr size_t OFF_H = 648 * MiB;
constexpr size_t OFF_U = 684 * MiB;
constexpr size_t OFF_HB = OFF_U;
constexpr size_t OFF_MISC = 927 * MiB;
constexpr size_t OFF_VTL = 945 * MiB;
constexpr size_t OFF_VTC = 961 * MiB;
constexpr size_t OFF_ACONV = 963 * MiB, OFF_ASSD = 972 * MiB, OFF_AFFT = 986 * MiB, OFF_ARWKV = 995 * MiB;
constexpr size_t OFF_XBC = 1004 * MiB;
constexpr size_t OFF_DTA = 1036 * MiB;
constexpr size_t OFF_YSSD = 1038 * MiB;
constexpr size_t OFF_RW = 1092 * MiB, RW_ARR = 18 * MiB;
constexpr size_t OFF_RSC = 1254 * MiB;
constexpr size_t OFF_YRW = 1255 * MiB;
constexpr size_t OFF_MBUF = 1291 * MiB;
constexpr size_t OFF_M = 1363 * MiB;
constexpr size_t OFF_Y = 1399 * MiB;
constexpr size_t WS_END = 1471 * MiB;
constexpr int CW_BAR = 4096;
constexpr int RING_BYTES = 131072, MISC_OFF = RING_BYTES + 320, LDS_BYTES = 147456;

__device__ __forceinline__ float bf2f(unsigned short b) { return __uint_as_float((unsigned)b << 16); }
__device__ __forceinline__ float bflo(unsigned u) { return __uint_as_float(u << 16); }
__device__ __forceinline__ float bfhi(unsigned u) { return __uint_as_float(u & 0xffff0000u); }
__device__ __forceinline__ unsigned f2bf(float f) { unsigned u = __builtin_bit_cast(unsigned, f); return (u + 0x7fffu + ((u >> 16) & 1u)) >> 16; }
__device__ __forceinline__ unsigned pk2(float lo, float hi) { return f2bf(lo) | (f2bf(hi) << 16); }
__device__ __forceinline__ float sigmoidf_(float x) { return 1.f / (1.f + __expf(-x)); }
__device__ __forceinline__ float siluf_(float x) { return x / (1.f + __expf(-x)); }
__device__ __forceinline__ float softplusf_(float x) { return fmaxf(x, 0.f) + log1pf(__expf(-fabsf(x))); }
__device__ __forceinline__ float wave_sum(float v) {
#pragma unroll
    for (int o = 1; o < 64; o <<= 1) v += __shfl_xor(v, o);
    return v;
}
#define LDS_WAIT() asm volatile("s_waitcnt lgkmcnt(0)" ::: "memory")

struct Args { const float* in[N_IN]; float* out; unsigned char* ws; int ph_lo, ph_hi; };
typedef const __attribute__((address_space(4))) Args* KArgs;
__device__ __forceinline__ KArgs kargs() { KArgs p = (KArgs)__builtin_amdgcn_kernarg_segment_ptr(); asm volatile("" : "+s"(p)); return p; }
#define PH_IDS int tid = threadIdx.x; asm volatile("" : "+v"(tid)); const int lane = tid & 63, wave = __builtin_amdgcn_readfirstlane(tid >> 6); (void)lane; (void)wave;

__device__ __forceinline__ int inmap(int n) {
    if (n < 2560) return n;
    if (n < 4096) return S_RKV + (n - 2560);
    if (n < 4608) { const int m = n - 4096; if (m < 24) return S_DT + m; if (m < 64) return -1; if (m < 384) return S_WF + (m - 64); return -1; }
    if (n < 5632) return S_CONV + (n - 4608);
    return S_GATE + (n - 5632);
}
__device__ __forceinline__ int rwkv_tok(int b, int j) { if (j < LCTX) return TLAT + b * LCTX + j; const int s = j - LCTX; return b * LSEQ + (s & 31) * 64 + (s >> 5); }

__device__ __forceinline__ void transpose_item(const float* W, int K, int Nsrc, bf16* WT, int k0, int n0, bool mapped, LAS float* scr, int lane) {
    const int nn = lane & 31; const int sc = mapped ? inmap(n0 + nn) : (n0 + nn);
#pragma unroll 8
    for (int i = 0; i < 32; ++i) { const int kk = 2 * i + (lane >> 5); scr[kk * 33 + nn] = (sc >= 0) ? W[(size_t)(k0 + kk) * Nsrc + sc] : 0.f; }
    LDS_WAIT();
    const int c = lane & 7;
#pragma unroll
    for (int j = 0; j < 4; ++j) { const int n = (lane >> 3) + 8 * j; const LAS float* s = scr + (8 * c) * 33 + n;
        v4u o; o.x = pk2(s[0 * 33], s[1 * 33]); o.y = pk2(s[2 * 33], s[3 * 33]); o.z = pk2(s[4 * 33], s[5 * 33]); o.w = pk2(s[6 * 33], s[7 * 33]);
        *(v4u*)(WT + (size_t)(n0 + n) * K + k0 + 8 * c) = o; }
    LDS_WAIT();
}
constexpr int IT_IN = 32 * (NU / 32), IT_CO = 8 * 64, IT_SO = 12 * 64, IT_FO = 8 * 64, IT_RO = 8 * 64, IT_O = 32 * 64, IT_UP = 32 * 256, IT_DN = 128 * 64;
constexpr int IT_LAYER = IT_IN + IT_CO + IT_SO + IT_FO + IT_RO + IT_O + IT_UP + IT_DN;

__device__ __forceinline__ void p0_prologue(KArgs a, LAS unsigned char* lds, int bid, int G) {
    PH_IDS
    unsigned char* ws = a->ws;
    {
        LAS float* sc = (LAS float*)lds;
        LAS float* part = (LAS float*)(lds + 40960);
        for (int i = tid; i < 5 * DM; i += NTHR) { const float v = (i < 4 * DM) ? a->in[I_C][i] : a->in[I_CCTX][i - 4 * DM]; sc[i] = siluf_(v); }
        __syncthreads();
        float* MODV = (float*)(ws + OFF_MODV);
        for (int it = bid; it < DEPTH * 192; it += G) {
            const int l = it / 192, j = (it % 192) * 64 + lane;
            const float* wp = a->in[I_MODW] + (size_t)l * DM * 12288 + (size_t)(wave * 256) * 12288 + j;
            float acc[5] = {0.f, 0.f, 0.f, 0.f, 0.f};
#pragma unroll 4
            for (int k = 0; k < 256; ++k) { const float w = wp[(size_t)k * 12288];
#pragma unroll
                for (int r = 0; r < 5; ++r) acc[r] += sc[r * DM + wave * 256 + k] * w; }
#pragma unroll
            for (int r = 0; r < 5; ++r) part[(wave * 5 + r) * 64 + lane] = acc[r];
            __syncthreads();
            if (tid < 320) { const int r = tid >> 6, jj = tid & 63; float s = 0.f;
#pragma unroll
                for (int w = 0; w < 8; ++w) s += part[(w * 5 + r) * 64 + jj];
                const int jo = (it % 192) * 64 + jj; MODV[((size_t)l * 5 + r) * 12288 + jo] = s + a->in[I_MODB][l * 12288 + jo]; }
            __syncthreads();
        }
    }
    {
        LAS float* wt = (LAS float*)lds;
        LAS float* ctab = (LAS float*)(lds + 32768);
        LAS float* scr = (LAS float*)(lds + 32768 + 512 + wave * 8448);
        __syncthreads();
        if (tid < 128) ctab[tid] = cospif((float)tid * (1.f / 64.f));
        for (int it = bid; it < DEPTH * 32 * 4; it += G) {
            const int l = it / 128, kb = (it % 128) / 4, g = it % 4, k0 = kb * 64;
            __syncthreads();
            for (int i = tid; i < 64 * 32; i += NTHR) { const int kk = i >> 5, c4 = i & 31;
                *(LAS f32x4*)(wt + kk * 128 + c4 * 4) = *(const f32x4*)(a->in[I_WIN] + ((size_t)l * DM + k0 + kk) * IN_DIM + S_FFT + g * 128 + c4 * 4); }
            __syncthreads();
            const int half = wave >> 2, cp = (wave & 3) * 32 + (lane & 31), n0 = half * 512 + g * 128 + (wave & 3) * 32;
#pragma unroll 1
            for (int i = 0; i < 32; ++i) { const int kk = 2 * i + (lane >> 5); float s = 0.f;
#pragma unroll 8
                for (int c = 0; c < 128; ++c) s += wt[kk * 128 + c] * ctab[(c * cp - 32 * half) & 127];
                scr[kk * 33 + (lane & 31)] = s; }
            LDS_WAIT();
            bf16* WT = (bf16*)(ws + OFF_W + (size_t)l * W_LAYER + WO_FFT);
            const int c = lane & 7;
#pragma unroll
            for (int j = 0; j < 4; ++j) { const int n = (lane >> 3) + 8 * j; const LAS float* s = scr + (8 * c) * 33 + n;
                v4u o; o.x = pk2(s[0 * 33], s[1 * 33]); o.y = pk2(s[2 * 33], s[3 * 33]); o.z = pk2(s[4 * 33], s[5 * 33]); o.w = pk2(s[6 * 33], s[7 * 33]);
                *(v4u*)(WT + (size_t)(n0 + n) * DM + k0 + 8 * c) = o; }
            LDS_WAIT();
        }
        __syncthreads();
    }
    const int gw = bid * NWAVES + wave, NGW = G * NWAVES;
    {
        LAS float* scr = (LAS float*)(lds + wave * 8448);
        for (int it = gw; it < DEPTH * IT_LAYER; it += NGW) {
            const int l = it / IT_LAYER; int r = it % IT_LAYER; unsigned char* wl = ws + OFF_W + (size_t)l * W_LAYER;
            if (r < IT_IN) { const int kb = r / (NU / 32), nb = r % (NU / 32); transpose_item(a->in[I_WIN] + (size_t)l * DM * IN_DIM, DM, IN_DIM, (bf16*)(wl + WO_IN), kb * 64, nb * 32, true, scr, lane); continue; } r -= IT_IN;
            if (r < IT_CO) { transpose_item(a->in[I_CONVOUT] + (size_t)l * 512 * DM, 512, DM, (bf16*)(wl + WO_CO), (r / 64) * 64, (r % 64) * 32, false, scr, lane); continue; } r -= IT_CO;
            if (r < IT_SO) { transpose_item(a->in[I_SOUT] + (size_t)l * 768 * DM, 768, DM, (bf16*)(wl + WO_SO), (r / 64) * 64, (r % 64) * 32, false, scr, lane); continue; } r -= IT_SO;
            if (r < IT_FO) { transpose_item(a->in[I_FOUT] + (size_t)l * 512 * DM, 512, DM, (bf16*)(wl + WO_FO), (r / 64) * 64, (r % 64) * 32, false, scr, lane); continue; } r -= IT_FO;
            if (r < IT_RO) { transpose_item(a->in[I_ROUT] + (size_t)l * 512 * DM, 512, DM, (bf16*)(wl + WO_RO), (r / 64) * 64, (r % 64) * 32, false, scr, lane); continue; } r -= IT_RO;
            if (r < IT_O) { transpose_item(a->in[I_WO] + (size_t)l * DM * DM, DM, DM, (bf16*)(wl + WO_O), (r / 64) * 64, (r % 64) * 32, false, scr, lane); continue; } r -= IT_O;
            if (r < IT_UP) { transpose_item(a->in[I_UP] + (size_t)l * DM * DFF, DM, DFF, (bf16*)(wl + WO_UP), (r / 256) * 64, (r % 256) * 32, false, scr, lane); continue; } r -= IT_UP;
            transpose_item(a->in[I_DOWN] + (size_t)l * DFF * DM, DFF, DM, (bf16*)(wl + WO_DN), (r / 64) * 64, (r % 64) * 32, false, scr, lane);
        }
    }
    {
        const int gt = bid * NTHR + tid, NGT = G * NTHR;
        bf16* FL = (bf16*)(ws + OFF_DFTL); bf16* FC = (bf16*)(ws + OFF_DFTC);
        for (int i = gt; i < 2048 * 512; i += NGT) { const int lp = i >> 9, k8 = (i & 511) * 8; unsigned o[4];
#pragma unroll
            for (int e = 0; e < 4; ++e) { float v[2];
#pragma unroll
                for (int q = 0; q < 2; ++q) { const int k = k8 + 2 * e + q; const int m = (lp * (k & 2047)) & 2047; float sn, cs; sincospif((float)m * (1.f / 1024.f), &sn, &cs); v[q] = (k < 2048 ? cs : -sn) * (1.f / 512.f); }
                o[e] = pk2(v[0], v[1]); }
            *(v4u*)(FL + (size_t)lp * 4096 + k8) = (v4u){o[0], o[1], o[2], o[3]}; }
        for (int i = gt; i < 256 * 64; i += NGT) { const int lp = i >> 6, k8 = (i & 63) * 8; unsigned o[4];
#pragma unroll
            for (int e = 0; e < 4; ++e) { float v[2];
#pragma unroll
                for (int q = 0; q < 2; ++q) { const int k = k8 + 2 * e + q; const int m = (lp * (k & 255)) & 255; float sn, cs; sincospif((float)m * (1.f / 128.f), &sn, &cs); v[q] = (k < 256 ? cs : -sn) * 0.005524271728f; }
                o[e] = pk2(v[0], v[1]); }
            *(v4u*)(FC + (size_t)lp * 512 + k8) = (v4u){o[0], o[1], o[2], o[3]}; }
        f32x4* X4 = (f32x4*)(ws + OFF_X); const f32x4* x4 = (const f32x4*)a->in[I_X]; const f32x4* c4 = (const f32x4*)a->in[I_CTX];
        for (int i = gt; i < TT * (DM / 4); i += NGT) X4[i] = (i < TLAT * (DM / 4)) ? x4[i] : c4[i - TLAT * (DM / 4)];
    }
}

__device__ __forceinline__ void norm_phase(KArgs a, int mode, const float* gY, const float* gH, const float* modY  , const float* modH  ,
                                           int bid, int G) {
    PH_IDS
    unsigned char* ws = a->ws; const int gw = bid * NWAVES + wave, NGW = G * NWAVES;
    float* X = (float*)(ws + OFF_X); const float* Y = (const float*)(ws + OFF_Y); bf16* H = (bf16*)(ws + OFF_H);
    for (int row = gw; row < TT; row += NGW) {
        if (mode == 2 && row >= TLAT) continue;
        const int mr = row < TLAT ? (row >> 11) : 4;
        f32x4 x[8];
        const f32x4* xr = (const f32x4*)(X + (size_t)row * DM) + lane;
#pragma unroll
        for (int j = 0; j < 8; ++j) x[j] = xr[64 * j];
        if (mode != 0) {
            const f32x4* yr = (const f32x4*)(Y + (size_t)row * DM) + lane; f32x4 y[8]; float ss = 0.f;
#pragma unroll
            for (int j = 0; j < 8; ++j) { y[j] = yr[64 * j]; ss += (y[j].x * y[j].x + y[j].y * y[j].y) + (y[j].z * y[j].z + y[j].w * y[j].w); }
            const float r = rsqrtf(wave_sum(ss) * (1.f / DM) + 1e-6f);
            const f32x4* gp = (const f32x4*)gY + lane; const f32x4* gt = (const f32x4*)(modY + (size_t)mr * 12288) + lane;
#pragma unroll
            for (int j = 0; j < 8; ++j) x[j] += gt[64 * j] * (y[j] * r * gp[64 * j]);
            if (mode == 1) { f32x4* xw = (f32x4*)(X + (size_t)row * DM) + lane;
#pragma unroll
                for (int j = 0; j < 8; ++j) xw[64 * j] = x[j]; }
            else { f32x4* ow = (f32x4*)(a->out + (size_t)row * DM) + lane;
#pragma unroll
                for (int j = 0; j < 8; ++j) ow[64 * j] = x[j]; }
        }
        if (mode != 2) {
            float ss = 0.f;
#pragma unroll
            for (int j = 0; j < 8; ++j) ss += (x[j].x * x[j].x + x[j].y * x[j].y) + (x[j].z * x[j].z + x[j].w * x[j].w);
            const float r = rsqrtf(wave_sum(ss) * (1.f / DM) + 1e-6f);
            const f32x4* gp = (const f32x4*)gH + lane; const f32x4* sh = (const f32x4*)(modH + (size_t)mr * 12288) + lane; const f32x4* sc = sh + 512;
            v2u* hw = (v2u*)(H + (size_t)row * DM) + lane;
#pragma unroll
            for (int j = 0; j < 8; ++j) { const f32x4 h = (x[j] * r * gp[64 * j]) * (sc[64 * j] + 1.f) + sh[64 * j]; hw[64 * j] = (v2u){pk2(h.x, h.y), pk2(h.z, h.w)}; }
        }
    }
}
#define XB_TMO      128
#define XB_XCNT(j)  (256  + 64 * (j))
#define XB_XSUB(j)  (1280 + 64 * (j))
#define XB_XGEN(j)  (2304 + 64 * (j))
#define XB_TOP      3328
#define XB_TOPGEN   3392
#define XCD_BAR_WORDS 3456
#define XB_SPIN_CAP (1u << 18)

__device__ __forceinline__ unsigned xb_ld(unsigned* p)              { return __hip_atomic_load(p, __ATOMIC_RELAXED, __HIP_MEMORY_SCOPE_AGENT); }
__device__ __forceinline__ unsigned xb_add(unsigned* p, unsigned v) { return __hip_atomic_fetch_add(p, v, __ATOMIC_RELAXED, __HIP_MEMORY_SCOPE_AGENT); }
__device__ __forceinline__ unsigned xb_xcc_id() { return (unsigned)__builtin_amdgcn_s_getreg((3 << 11) | 20) & 0xFu; }
#define XB_SPIN(cond, bar) do { unsigned _sp = 0; while (cond) { __builtin_amdgcn_s_sleep(1); \
    if ((++_sp & 255u) == 0u) { if (xb_ld(&(bar)[XB_TMO])) break; if (_sp > XB_SPIN_CAP) { atomicAdd(&(bar)[XB_TMO], 1u); break; } } } } while (0)

struct XcdBarrier {
    unsigned* bar; unsigned x;
    volatile LAS unsigned* st;
};

__device__ __forceinline__ XcdBarrier xcd_barrier_post(unsigned* bar, volatile LAS unsigned* st) {
    XcdBarrier b; b.bar = bar; b.x = xb_xcc_id(); b.st = st;
    if (threadIdx.x == 0) (void)xb_add(&bar[XB_XCNT(b.x)], 1u);
    return b;
}
__device__ __forceinline__ void xcd_barrier_complete(unsigned* bar, unsigned x, unsigned& nloc, unsigned& nx) {
    const unsigned G = gridDim.x * gridDim.y * gridDim.z;
    unsigned sum, cnt, mine, sp = 0u;
    for (;;) {
        sum = 0u; cnt = 0u; mine = 0u;
#pragma unroll
        for (unsigned j = 0; j < 16; ++j) { const unsigned c = xb_ld(&bar[XB_XCNT(j)]); sum += c; cnt += (c > 0u) ? 1u : 0u; mine = (j == x) ? c : mine; }
        if (sum == G) break;
        __builtin_amdgcn_s_sleep(1);
        if ((++sp & 255u) == 0u) { if (xb_ld(&bar[XB_TMO])) break; if (sp > XB_SPIN_CAP) { atomicAdd(&bar[XB_TMO], 1u); break; } }
    }
    nloc = mine > 0u ? mine : 1u; nx = cnt > 0u ? cnt : 1u;
}

__device__ __forceinline__ void xcd_barrier(const XcdBarrier& b) {
    asm volatile("s_waitcnt vmcnt(0)" ::: "memory");
    __syncthreads();
    if (threadIdx.x == 0) {
        unsigned* bar = b.bar;
        __builtin_amdgcn_s_waitcnt(0);
        unsigned nloc = b.st[0], nx = b.st[1];
        if (nloc == 0u) { xcd_barrier_complete(bar, b.x, nloc, nx); b.st[0] = nloc; b.st[1] = nx; }
        const unsigned old = xb_add(&bar[XB_XSUB(b.x)], 1u);
        const unsigned gen = old / nloc;
        if (old + 1u == (gen + 1u) * nloc) {
            __builtin_amdgcn_fence(__ATOMIC_RELEASE, "agent");
            asm volatile("s_waitcnt vmcnt(0)" ::: "memory");
            const unsigned og = xb_add(&bar[XB_TOP], 1u);
            const unsigned tg = og / nx;
            if (og + 1u == (tg + 1u) * nx) xb_add(&bar[XB_TOPGEN], 1u);
            else XB_SPIN(xb_ld(&bar[XB_TOPGEN]) == tg, bar);
            __builtin_amdgcn_fence(__ATOMIC_ACQUIRE, "agent");
            xb_add(&bar[XB_XGEN(b.x)], 1u);
            asm volatile("s_waitcnt vmcnt(0)" ::: "memory");
        } else {
            XB_SPIN(xb_ld(&bar[XB_XGEN(b.x)]) == gen, bar);
            __builtin_amdgcn_fence(__ATOMIC_ACQUIRE, "agent");
            asm volatile("s_waitcnt vmcnt(0)" ::: "memory");
        }
    }
    __syncthreads();
}

__device__ __forceinline__ void rwkv_prep_item(KArgs a, int l, int item, LAS unsigned char* lds, int tid, int lane) {
    unsigned char* ws = a->ws;
    const bf16* U = (const bf16*)(ws + OFF_U); const float* MISC = (const float*)(ws + OFF_MISC);
    const int b = item / 288, j0 = (item % 288) * 8; const bool isctx = j0 < LCTX;
    LAS unsigned* rawrkv = (LAS unsigned*)lds;
    LAS float* rawm = (LAS float*)(lds + 30720);
    LAS float* RP = (LAS float*)(lds + 43520);
    LAS float* KP = RP + 4096; LAS float* VP = KP + 4096;
    LAS float* LA = VP + 4096;
    for (int idx = tid; idx < 10 * 192; idx += NTHR) { const int rr = idx / 192, c8 = idx % 192, jj = j0 - 1 + rr;
        const bool valid = isctx ? (jj >= 0 && jj < LCTX) : (jj >= LCTX && jj < RJ);
        v4u v = (v4u){0u, 0u, 0u, 0u}; if (valid) v = *(const v4u*)(U + (size_t)rwkv_tok(b, jj) * NU + URKV + c8 * 8);
        *(LAS v4u*)(rawrkv + rr * 768 + c8 * 4) = v; }
    for (int idx = tid; idx < 10 * 80; idx += NTHR) { const int rr = idx / 80, c4 = idx % 80, jj = j0 - 1 + rr;
        const bool valid = isctx ? (jj >= 0 && jj < LCTX) : (jj >= LCTX && jj < RJ);
        f32x4 v = (f32x4){0.f, 0.f, 0.f, 0.f}; if (valid) v = *(const f32x4*)(MISC + (size_t)rwkv_tok(b, jj) * 512 + 64 + c4 * 4);
        *(LAS f32x4*)(rawm + rr * 320 + c4 * 4) = v; }
    __syncthreads();
    const float* mu = a->in[I_RMU] + l * 1856;
    for (int idx = tid; idx < 8 * 768; idx += NTHR) { const int i = idx / 768, cp = idx % 768;
        const unsigned p = rawrkv[i * 768 + cp], c = rawrkv[(i + 1) * 768 + cp], n = rawrkv[(i + 2) * 768 + cp];
        float x0 = bflo(c), x1 = bfhi(c);
        x0 = x0 + (0.5f * (bflo(p) + bflo(n)) - x0) * mu[2 * cp]; x1 = x1 + (0.5f * (bfhi(p) + bfhi(n)) - x1) * mu[2 * cp + 1];
        const int ch = 2 * cp, reg = ch >> 9; LAS float* dst = (reg == 0 ? RP : (reg == 1 ? KP : VP)) + i * 512 + (ch & 511);
        *(LAS f32x2*)dst = (f32x2){x0, x1}; }
    for (int idx = tid; idx < 8 * 320; idx += NTHR) { const int i = idx / 320, m = idx % 320;
        float x = rawm[(i + 1) * 320 + m]; const float p = rawm[i * 320 + m], n = rawm[(i + 2) * 320 + m];
        x = x + (0.5f * (p + n) - x) * mu[1536 + m];
        if (m < 128) x = tanhf(x); else if (m >= 192) x = sigmoidf_(x);
        LA[i * 320 + m] = x; }
    __syncthreads();
    const int c = tid, h = tid >> 6;
    float af[8], ab[8], aa[8], ag[8];
#pragma unroll
    for (int i = 0; i < 8; ++i) { af[i] = 0.f; ab[i] = 0.f; aa[i] = 0.f; ag[i] = 0.f; }
    {
        const float* w2f = a->in[I_RW2] + (size_t)((l * 2 + 0) * 64) * 512 + c; const float* w2b = a->in[I_RW2] + (size_t)((l * 2 + 1) * 64) * 512 + c;
        const float* a2p = a->in[I_RA2] + (size_t)(l * 64) * 512 + c; const float* g2p = a->in[I_RG2] + (size_t)(l * 128) * 512 + c;
#pragma unroll 2
        for (int j = 0; j < 64; j += 4) {
            const float f0 = w2f[(j + 0) * 512], f1 = w2f[(j + 1) * 512], f2 = w2f[(j + 2) * 512], f3 = w2f[(j + 3) * 512];
            const float b0 = w2b[(j + 0) * 512], b1 = w2b[(j + 1) * 512], b2 = w2b[(j + 2) * 512], b3 = w2b[(j + 3) * 512];
            const float a0 = a2p[(j + 0) * 512], a1 = a2p[(j + 1) * 512], a2_ = a2p[(j + 2) * 512], a3 = a2p[(j + 3) * 512];
#pragma unroll
            for (int i = 0; i < 8; ++i) { const f32x4 xf = *(const LAS f32x4*)(LA + i * 320 + j), xb = *(const LAS f32x4*)(LA + i * 320 + 64 + j), xa = *(const LAS f32x4*)(LA + i * 320 + 128 + j);
                af[i] += xf.x * f0 + xf.y * f1 + xf.z * f2 + xf.w * f3; ab[i] += xb.x * b0 + xb.y * b1 + xb.z * b2 + xb.w * b3; aa[i] += xa.x * a0 + xa.y * a1 + xa.z * a2_ + xa.w * a3; } }
#pragma unroll 2
        for (int j = 0; j < 128; j += 4) {
            const float g0 = g2p[(j + 0) * 512], g1 = g2p[(j + 1) * 512], g2_ = g2p[(j + 2) * 512], g3 = g2p[(j + 3) * 512];
#pragma unroll
            for (int i = 0; i < 8; ++i) { const f32x4 xg = *(const LAS f32x4*)(LA + i * 320 + 192 + j); ag[i] += xg.x * g0 + xg.y * g1 + xg.z * g2_ + xg.w * g3; } }
    }
    const float w0f = a->in[I_RW0][(l * 2 + 0) * 512 + c], w0b = a->in[I_RW0][(l * 2 + 1) * 512 + c], a0c = a->in[I_RA0][l * 512 + c];
    const float kkc = a->in[I_RKK][l * 512 + c], kac = a->in[I_RKA][l * 512 + c], rkc = a->in[I_RRK][l * 512 + c];
    float* RW = (float*)(ws + OFF_RW); constexpr size_t AS = RW_ARR / 4; float* RSC = (float*)(ws + OFF_RSC);
#pragma unroll
    for (int i = 0; i < 8; ++i) {
        const size_t R = (size_t)b * RJ + j0 + i;
        const float r = RP[i * 512 + c], k = KP[i * 512 + c], v = VP[i * 512 + c];
        const float wf = __expf(-__expf(-softplusf_(-(w0f + af[i])) - 0.5f)), wb = __expf(-__expf(-softplusf_(-(w0b + ab[i])) - 0.5f));
        const float av = sigmoidf_(a0c + aa[i]);
        const float kkv = k * kkc; const float kk = kkv * rsqrtf(wave_sum(kkv * kkv) + 1e-12f);
        const float kmod = k * (1.f + (av - 1.f) * kac), ka = kk * av;
        const float c1 = wave_sum(ka * r), c2 = wave_sum(kmod * r), bon = wave_sum(r * kmod * rkc);
        float* o = RW + R * 512 + c;
        o[0 * AS] = wf; o[1 * AS] = wf * r; o[2 * AS] = wb; o[3 * AS] = wb * r; o[4 * AS] = kmod; o[5 * AS] = -kk; o[6 * AS] = ka; o[7 * AS] = v; o[8 * AS] = ag[i];
        if (lane == 0) { RSC[R * 8 + h] = c1; RSC[(size_t)TT * 8 + R * 8 + h] = c2; RSC[(size_t)2 * TT * 8 + R * 8 + h] = bon; }
    }
    __syncthreads();
}
__device__ __forceinline__ void ssd_prep_item(KArgs a, int l, int item, int tid) {
    unsigned char* ws = a->ws; const bf16* U = (const bf16*)(ws + OFF_U); const float* MISC = (const float*)(ws + OFF_MISC);
    bf16* XBC = (bf16*)(ws + OFF_XBC); float* DTA = (float*)(ws + OFF_DTA);
    const int t0 = item * 16;
    const int seq_lo = t0 < TLAT ? (t0 & ~(LSEQ - 1)) : TLAT + ((t0 - TLAT) & ~(LCTX - 1)), seq_hi = seq_lo + (t0 < TLAT ? LSEQ : LCTX);
    for (int cp = tid; cp < 896; cp += NTHR) {
        float w0[5], w1[5];
#pragma unroll
        for (int j = 0; j < 5; ++j) { const f32x2 w = *(const f32x2*)(a->in[I_SCW] + (size_t)(l * 5 + j) * 1792 + 2 * cp); w0[j] = w.x; w1[j] = w.y; }
        const f32x2 bb = *(const f32x2*)(a->in[I_SCB] + l * 1792 + 2 * cp);
        float i0[20], i1[20];
#pragma unroll
        for (int r = 0; r < 20; ++r) { const int row = t0 - 2 + r; unsigned u = 0u; if (row >= seq_lo && row < seq_hi) u = *(const unsigned*)(U + (size_t)row * NU + UXBC + 2 * cp); i0[r] = bflo(u); i1[r] = bfhi(u); }
#pragma unroll
        for (int o = 0; o < 16; ++o) { float s0 = bb.x, s1 = bb.y;
#pragma unroll
            for (int j = 0; j < 5; ++j) { s0 += w0[j] * i0[o + j]; s1 += w1[j] * i1[o + j]; }
            *(unsigned*)(XBC + (size_t)(t0 + o) * 1792 + 2 * cp) = pk2(siluf_(s0), siluf_(s1)); }
    }
    if (tid < 16 * 24) { const int o = tid / 24, q = tid % 24;
        const float dt = softplusf_(MISC[(size_t)(t0 + o) * 512 + q] + a->in[I_SDTB][l * 24 + q]); const float A = -__expf(a->in[I_SALOG][l * 24 + q]);
        DTA[(size_t)(t0 + o) * 48 + q] = dt; DTA[(size_t)(t0 + o) * 48 + 24 + q] = dt * A; }
}
__device__ __forceinline__ void conv_item(KArgs a, int l, int item, LAS unsigned char* lds, int tid, int lane, int wave) {
    unsigned char* ws = a->ws; const bf16* U = (const bf16*)(ws + OFF_U); bf16* AC = (bf16*)(ws + OFF_ACONV);
    int t0, seg_lo, seg_hi;
    if (item < 256) { t0 = item * 32; seg_lo = t0 & ~63; seg_hi = seg_lo + 64; }
    else { const int ci = item - 256; t0 = TLAT + ci * 32; seg_lo = TLAT + (ci >> 3) * LCTX; seg_hi = seg_lo + LCTX; }
    LAS bf16* inimg = (LAS bf16*)lds;
    LAS float* outimg = (LAS float*)(lds + 63488);
    for (int idx = tid; idx < 62 * 64; idx += NTHR) { const int rr = idx >> 6, c8 = idx & 63, row = t0 - 15 + rr;
        v4u o = (v4u){0u, 0u, 0u, 0u};
        if (row >= seg_lo && row < seg_hi) { const v4u va = *(const v4u*)(U + (size_t)row * NU + UCONV + c8 * 8), vg = *(const v4u*)(U + (size_t)row * NU + UCONV + 512 + c8 * 8);
            o.x = pk2(bflo(va.x) * sigmoidf_(bflo(vg.x)), bfhi(va.x) * sigmoidf_(bfhi(vg.x))); o.y = pk2(bflo(va.y) * sigmoidf_(bflo(vg.y)), bfhi(va.y) * sigmoidf_(bfhi(vg.y)));
            o.z = pk2(bflo(va.z) * sigmoidf_(bflo(vg.z)), bfhi(va.z) * sigmoidf_(bfhi(vg.z))); o.w = pk2(bflo(va.w) * sigmoidf_(bflo(vg.w)), bfhi(va.w) * sigmoidf_(bfhi(vg.w))); }
        *(LAS v4u*)(inimg + rr * 512 + c8 * 8) = o; }
    __syncthreads();
    {
        const int c = tid; float w[31];
#pragma unroll
        for (int j = 0; j < 31; ++j) w[j] = a->in[I_CONVW][(size_t)(l * 31 + j) * 512 + c];
        const float bias = a->in[I_CONVB][l * 512 + c];
#pragma unroll 2
        for (int o = 0; o < 32; ++o) { float s = bias;
#pragma unroll
            for (int j = 0; j < 31; ++j) s += w[j] * bf2f(inimg[(o + j) * 512 + c]);
            outimg[o * 512 + c] = s; }
    }
    __syncthreads();
    {
        const f32x4 g0 = *(const f32x4*)(a->in[I_CLNG] + l * 512 + 8 * lane), g1 = *(const f32x4*)(a->in[I_CLNG] + l * 512 + 8 * lane + 4);
        const f32x4 b0 = *(const f32x4*)(a->in[I_CLNB] + l * 512 + 8 * lane), b1 = *(const f32x4*)(a->in[I_CLNB] + l * 512 + 8 * lane + 4);
#pragma unroll
        for (int q = 0; q < 4; ++q) { const int o = wave * 4 + q;
            f32x4 x0 = *(const LAS f32x4*)(outimg + o * 512 + 8 * lane), x1 = *(const LAS f32x4*)(outimg + o * 512 + 8 * lane + 4);
            const float mean = wave_sum((x0.x + x0.y + x0.z + x0.w) + (x1.x + x1.y + x1.z + x1.w)) * (1.f / 512.f);
            x0 = x0 - mean; x1 = x1 - mean;
            const float var = wave_sum((x0.x * x0.x + x0.y * x0.y + x0.z * x0.z + x0.w * x0.w) + (x1.x * x1.x + x1.y * x1.y + x1.z * x1.z + x1.w * x1.w)) * (1.f / 512.f);
            const float rs = rsqrtf(var + 1e-5f);
            x0 = x0 * rs * g0 + b0; x1 = x1 * rs * g1 + b1;
            v4u ov; ov.x = pk2(siluf_(x0.x), siluf_(x0.y)); ov.y = pk2(siluf_(x0.z), siluf_(x0.w)); ov.z = pk2(siluf_(x1.x), siluf_(x1.y)); ov.w = pk2(siluf_(x1.z), siluf_(x1.w));
            *(v4u*)(AC + (size_t)(t0 + o) * 512 + 8 * lane) = ov; }
    }
    __syncthreads();
}

__device__ __forceinline__ int ssd_tok(int b, int dir, int pos) {
    if (pos < LCTX) return TLAT + b * LCTX + (dir ? (LCTX - 1 - pos) : pos);
    const int q = pos - LCTX; return b * LSEQ + (dir ? (LSEQ - 1 - q) : q);
}
__device__ __forceinline__ void ssd_scan_simple(KArgs a, int idx, int tid) {
    unsigned char* ws = a->ws; const bf16* XBC = (const bf16*)(ws + OFF_XBC); const float* DTA = (const float*)(ws + OFF_DTA);
    const int b = idx / 24, dir = (idx % 24) / 12, h = idx % 12, g = h / 3, p = tid >> 3, n0 = (tid & 7) * 16, q = dir * 12 + h;
    float* Yo = (float*)(ws + OFF_YSSD) + (size_t)dir * TT * 768;
    float hs[16];
#pragma unroll
    for (int i = 0; i < 16; ++i) hs[i] = 0.f;
    for (int pos = 0; pos < RJ; ++pos) {
        const int tok = ssd_tok(b, dir, pos);
        const float dt = DTA[(size_t)tok * 48 + q], dec = __expf(DTA[(size_t)tok * 48 + 24 + q]);
        const bf16* row = XBC + (size_t)tok * 1792;
        const float xd = bf2f(row[h * 64 + p]) * dt;
        const v4u B0 = *(const v4u*)(row + 768 + g * 128 + n0), B1 = *(const v4u*)(row + 768 + g * 128 + n0 + 8);
        const v4u C0 = *(const v4u*)(row + 1280 + g * 128 + n0), C1 = *(const v4u*)(row + 1280 + g * 128 + n0 + 8);
        const float Bv[16] = {bflo(B0.x), bfhi(B0.x), bflo(B0.y), bfhi(B0.y), bflo(B0.z), bfhi(B0.z), bflo(B0.w), bfhi(B0.w), bflo(B1.x), bfhi(B1.x), bflo(B1.y), bfhi(B1.y), bflo(B1.z), bfhi(B1.z), bflo(B1.w), bfhi(B1.w)};
        const float Cv[16] = {bflo(C0.x), bfhi(C0.x), bflo(C0.y), bfhi(C0.y), bflo(C0.z), bfhi(C0.z), bflo(C0.w), bfhi(C0.w), bflo(C1.x), bfhi(C1.x), bflo(C1.y), bfhi(C1.y), bflo(C1.z), bfhi(C1.z), bflo(C1.w), bfhi(C1.w)};
        float yp = 0.f;
#pragma unroll
        for (int i = 0; i < 16; ++i) { hs[i] = hs[i] * dec + xd * Bv[i]; yp += hs[i] * Cv[i]; }
        yp += __shfl_xor(yp, 1); yp += __shfl_xor(yp, 2); yp += __shfl_xor(yp, 4);
        if ((tid & 7) == 0) Yo[(size_t)tok * 768 + h * 64 + p] = yp;
    }
}
__device__ __forceinline__ void rwkv_scan_simple(KArgs a, int idx, int tid) {
    unsigned char* ws = a->ws; const float* RW = (const float*)(ws + OFF_RW); constexpr size_t AS = RW_ARR / 4; const float* RSC = (const float*)(ws + OFF_RSC);
    const int b = idx / 16, dir = (idx % 16) / 8, h = idx % 8, v = tid >> 3, k0 = (tid & 7) * 8;
    float* Yo = (float*)(ws + OFF_YRW) + (size_t)dir * TT * 512;
    const float* Wd = RW + (dir ? 2 : 0) * AS; const float* WRd = RW + (dir ? 3 : 1) * AS;
    float S[8];
#pragma unroll
    for (int i = 0; i < 8; ++i) S[i] = 0.f;
    for (int pos = 0; pos < RJ; ++pos) {
        const int j = dir ? (pos < LCTX ? (LCTX - 1 - pos) : (RJ + LCTX - 1 - pos)) : pos;
        const size_t R = (size_t)b * RJ + j; const size_t o = R * 512 + h * 64 + k0;
        const f32x4 w0 = *(const f32x4*)(Wd + o), w1 = *(const f32x4*)(Wd + o + 4), r0 = *(const f32x4*)(WRd + o), r1 = *(const f32x4*)(WRd + o + 4);
        const f32x4 kA = *(const f32x4*)(RW + 4 * AS + o), kB = *(const f32x4*)(RW + 4 * AS + o + 4), nA = *(const f32x4*)(RW + 5 * AS + o), nB = *(const f32x4*)(RW + 5 * AS + o + 4);
        const f32x4 aA = *(const f32x4*)(RW + 6 * AS + o), aB = *(const f32x4*)(RW + 6 * AS + o + 4);
        const float vv = RW[7 * AS + R * 512 + h * 64 + v], c1 = RSC[R * 8 + h], c2 = RSC[(size_t)TT * 8 + R * 8 + h];
        const float w[8] = {w0.x, w0.y, w0.z, w0.w, w1.x, w1.y, w1.z, w1.w}, wr[8] = {r0.x, r0.y, r0.z, r0.w, r1.x, r1.y, r1.z, r1.w};
        const float kk_[8] = {kA.x, kA.y, kA.z, kA.w, kB.x, kB.y, kB.z, kB.w}, kn[8] = {nA.x, nA.y, nA.z, nA.w, nB.x, nB.y, nB.z, nB.w}, ka[8] = {aA.x, aA.y, aA.z, aA.w, aB.x, aB.y, aB.z, aB.w};
        float sa = 0.f, pp = 0.f;
#pragma unroll
        for (int i = 0; i < 8; ++i) { sa += S[i] * kn[i]; pp += S[i] * wr[i]; }
        sa += __shfl_xor(sa, 1); pp += __shfl_xor(pp, 1); sa += __shfl_xor(sa, 2); pp += __shfl_xor(pp, 2); sa += __shfl_xor(sa, 4); pp += __shfl_xor(pp, 4);
#pragma unroll
        for (int i = 0; i < 8; ++i) S[i] = S[i] * w[i] + sa * ka[i] + vv * kk_[i];
        if ((tid & 7) == 0) Yo[R * 512 + h * 64 + v] = pp + sa * c1 + vv * c2;
    }
}

__device__ __forceinline__ void post_phase(KArgs a, int l, int bid, int G) {
    PH_IDS
    unsigned char* ws = a->ws; const int gw = bid * NWAVES + wave, NGW = G * NWAVES;
    const bf16* U = (const bf16*)(ws + OFF_U); const bf16* XBC = (const bf16*)(ws + OFF_XBC);
    const float* Y0 = (const float*)(ws + OFF_YSSD); const float* Y1 = Y0 + (size_t)TT * 768; bf16* AS_ = (bf16*)(ws + OFF_ASSD);
    for (int row = gw; row < TT; row += NGW) {
        f32x4 y[3]; float ss = 0.f;
#pragma unroll
        for (int j = 0; j < 3; ++j) { const int col = 4 * lane + 256 * j; const float dsk = a->in[I_SD][l * 12 + (col >> 6)];
            const f32x4 yf = *(const f32x4*)(Y0 + (size_t)row * 768 + col), yb = *(const f32x4*)(Y1 + (size_t)row * 768 + col);
            const v2u xs = *(const v2u*)(XBC + (size_t)row * 1792 + col), z = *(const v2u*)(U + (size_t)row * NU + UZ + col);
            f32x4 v = yf + yb + dsk * (f32x4){bflo(xs.x), bfhi(xs.x), bflo(xs.y), bfhi(xs.y)};
            v = v * (f32x4){siluf_(bflo(z.x)), siluf_(bfhi(z.x)), siluf_(bflo(z.y)), siluf_(bfhi(z.y))};
            y[j] = v; ss += (v.x * v.x + v.y * v.y) + (v.z * v.z + v.w * v.w); }
        const float r = rsqrtf(wave_sum(ss) * (1.f / 768.f) + 1e-6f);
#pragma unroll
        for (int j = 0; j < 3; ++j) { const int col = 4 * lane + 256 * j; const f32x4 g = *(const f32x4*)(a->in[I_SNG] + l * 768 + col); const f32x4 o = y[j] * r * g;
            *(v2u*)(AS_ + (size_t)row * 768 + col) = (v2u){pk2(o.x, o.y), pk2(o.z, o.w)}; }
    }
    const float* RW = (const float*)(ws + OFF_RW); constexpr size_t AS = RW_ARR / 4; const float* RSC = (const float*)(ws + OFF_RSC);
    const float* R0 = (const float*)(ws + OFF_YRW); const float* R1 = R0 + (size_t)TT * 512; bf16* AR = (bf16*)(ws + OFF_ARWKV);
    for (int row = gw; row < TT; row += NGW) {
        size_t R;
        if (row < TLAT) { const int b = row >> 11, t = row & 2047, rr = t >> 6, cc = t & 63; R = (size_t)b * RJ + LCTX + cc * 32 + rr; }
        else { const int b = (row - TLAT) >> 8, jj = (row - TLAT) & 255; R = (size_t)b * RJ + jj; }
        const int c0 = 8 * lane, h = lane >> 3;
        f32x4 ya = *(const f32x4*)(R0 + R * 512 + c0) + *(const f32x4*)(R1 + R * 512 + c0), yb = *(const f32x4*)(R0 + R * 512 + c0 + 4) + *(const f32x4*)(R1 + R * 512 + c0 + 4);
        float s = (ya.x + ya.y + ya.z + ya.w) + (yb.x + yb.y + yb.z + yb.w);
        s += __shfl_xor(s, 1); s += __shfl_xor(s, 2); s += __shfl_xor(s, 4);
        const float mean = s * (1.f / 64.f); ya = ya - mean; yb = yb - mean;
        float q = (ya.x * ya.x + ya.y * ya.y + ya.z * ya.z + ya.w * ya.w) + (yb.x * yb.x + yb.y * yb.y + yb.z * yb.z + yb.w * yb.w);
        q += __shfl_xor(q, 1); q += __shfl_xor(q, 2); q += __shfl_xor(q, 4);
        const float rs = rsqrtf(q * (1.f / 64.f) + 64e-5f);
        const f32x4 lg0 = *(const f32x4*)(a->in[I_RLNG] + l * 512 + c0), lg1 = *(const f32x4*)(a->in[I_RLNG] + l * 512 + c0 + 4), lb0 = *(const f32x4*)(a->in[I_RLNB] + l * 512 + c0), lb1 = *(const f32x4*)(a->in[I_RLNB] + l * 512 + c0 + 4);
        const float bon = RSC[(size_t)2 * TT * 8 + R * 8 + h];
        const f32x4 v0 = *(const f32x4*)(RW + 7 * AS + R * 512 + c0), v1 = *(const f32x4*)(RW + 7 * AS + R * 512 + c0 + 4), g0 = *(const f32x4*)(RW + 8 * AS + R * 512 + c0), g1 = *(const f32x4*)(RW + 8 * AS + R * 512 + c0 + 4);
        const f32x4 o0 = (ya * rs * lg0 + lb0 + bon * v0) * g0, o1 = (yb * rs * lg1 + lb1 + bon * v1) * g1;
        *(v4u*)(AR + (size_t)row * 512 + c0) = (v4u){pk2(o0.x, o0.y), pk2(o0.z, o0.w), pk2(o1.x, o1.y), pk2(o1.z, o1.w)};
    }
}

constexpr int NPH = 2 + 10 * DEPTH;
#ifndef MK_ONE_LAUNCH
#define MK_ONE_LAUNCH 1
#endif

__global__ void __launch_bounds__(NTHR, 2) fwd(Args a_unused) {
    extern __shared__ __attribute__((aligned(16))) unsigned char lds_raw[];
    LAS unsigned char* lds = (LAS unsigned char*)lds_raw;
    const int bid = blockIdx.x, G = gridDim.x;
    volatile LAS unsigned* MISCW = (volatile LAS unsigned*)(lds + MISC_OFF);
    if (threadIdx.x < 32) MISCW[threadIdx.x] = 0u;
    __syncthreads();
    const int ph_lo = kargs()->ph_lo, ph_hi = kargs()->ph_hi;
    const bool multi = (ph_hi - ph_lo) > 1;
    XcdBarrier bar; bar.bar = (unsigned*)(kargs()->ws + OFF_CTL) + CW_BAR; bar.x = 0; bar.st = nullptr;
    if (multi) bar = xcd_barrier_post((unsigned*)(kargs()->ws + OFF_CTL) + CW_BAR, MISCW + 8);
#define IN(k) (ph_lo <= (k) && (k) < ph_hi)
#define SEAM(k) do { if (IN(k) && IN((k) + 1)) xcd_barrier(bar); } while (0)

    if (IN(0)) p0_prologue(kargs(), lds, bid, G);
    SEAM(0);
    if (IN(1)) { KArgs a = kargs(); norm_phase(a, 0, nullptr, a->in[I_NORMG] + 0, nullptr, (const float*)(a->ws + OFF_MODV), bid, G); }
    SEAM(1);

    for (int l = 0; l < DEPTH; ++l) {
        const int pb = 2 + 10 * l;
#define PH_LOCALS KArgs a = kargs(); unsigned char* ws = a->ws; unsigned char* wl = ws + OFF_W + (size_t)l * W_LAYER; bf16* Hb = (bf16*)(ws + OFF_H); (void)wl; (void)Hb; \
        const float* ng = a->in[I_NORMG] + (size_t)l * 4 * DM; const float* mv = (const float*)(ws + OFF_MODV) + (size_t)l * 5 * 12288; (void)ng; (void)mv;
        if (IN(pb + 0)) { PH_LOCALS
            __syncthreads();
            { pg8::Gemm g{Hb, (const bf16*)(wl + WO_IN), TT, NU, DM}; pg8::StaticOrder S; S.init(TT, NU, G, bid);
              pg8::EpiInproj E{(bf16*)(ws + OFF_U), (float*)(ws + OFF_MISC), NU};
              pg8::gemm_phase<pg8::EpiInproj, pg8::StaticOrder, true, true>(lds, g, S, E); }
            { pg8::Gemm g{(const bf16*)(wl + WO_FFT), Hb, 1024, TT, DM}; pg8::StaticOrder S; S.init(1024, TT, G, bid);
              pg8::EpiBf E{0, (bf16*)(ws + OFF_VTL), (bf16*)(ws + OFF_VTC)};
              pg8::gemm_phase<pg8::EpiBf, pg8::StaticOrder, true, true>(lds, g, S, E); }
        }
        SEAM(pb + 0);
        if (IN(pb + 1)) { PH_LOCALS PH_IDS
            __syncthreads();
            for (int it = bid; it < NBATCH * 288; it += G) rwkv_prep_item(a, l, it, lds, tid, lane);
            for (int it = (bid + 128) % G; it < TT / 16; it += G) ssd_prep_item(a, l, it, tid);
            __syncthreads();
            for (int it = (bid + 192) % G; it < 288; it += G) conv_item(a, l, it, lds, tid, lane, wave);
        }
        SEAM(pb + 1);
        if (IN(pb + 2)) { PH_LOCALS PH_IDS
            __syncthreads();
            if (bid < 64) rwkv_scan_simple(a, bid, tid);
            else if (bid < 160) ssd_scan_simple(a, bid - 64, tid);
            else {
                { pg8::Gemm g{(const bf16*)(ws + OFF_DFTL), (const bf16*)(ws + OFF_VTL), 2048, 2048, 4096}; pg8::StaticOrder S; S.init(2048, 2048, G - 160, bid - 160);
                  pg8::EpiBf E{1, (bf16*)(ws + OFF_AFFT), nullptr};
                  pg8::gemm_phase<pg8::EpiBf, pg8::StaticOrder, true, true>(lds, g, S, E); }
                { pg8::Gemm g{(const bf16*)(ws + OFF_DFTC), (const bf16*)(ws + OFF_VTC), 256, 2048, 512}; pg8::StaticOrder S; S.init(256, 2048, G - 160, bid - 160);
                  pg8::EpiBf E{2, (bf16*)(ws + OFF_AFFT), nullptr};
                  pg8::gemm_phase<pg8::EpiBf, pg8::StaticOrder, true, true>(lds, g, S, E); }
            }
        }
        SEAM(pb + 2);
        if (IN(pb + 3)) post_phase(kargs(), l, bid, G);
        SEAM(pb + 3);
        if (IN(pb + 4)) { PH_LOCALS
            __syncthreads();
            const bf16* Gt = (const bf16*)(ws + OFF_U) + UGATE; float* MB = (float*)(ws + OFF_MBUF); bf16* Mo = (bf16*)(ws + OFF_M);
            pg8::StaticOrder S; S.init(TT, DM, G, bid);
            { pg8::Gemm g{(const bf16*)(ws + OFF_ACONV), (const bf16*)(wl + WO_CO), TT, DM, 512}; pg8::EpiMerge E{Gt + 0 * DM, NU, MB, Mo, 0}; pg8::gemm_phase<pg8::EpiMerge, pg8::StaticOrder, true, true>(lds, g, S, E); }
            { pg8::Gemm g{(const bf16*)(ws + OFF_ASSD), (const bf16*)(wl + WO_SO), TT, DM, 768}; pg8::EpiMerge E{Gt + 1 * DM, NU, MB, Mo, 1}; pg8::gemm_phase<pg8::EpiMerge, pg8::StaticOrder, true, true>(lds, g, S, E); }
            { pg8::Gemm g{(const bf16*)(ws + OFF_AFFT), (const bf16*)(wl + WO_FO), TT, DM, 512}; pg8::EpiMerge E{Gt + 2 * DM, NU, MB, Mo, 2}; pg8::gemm_phase<pg8::EpiMerge, pg8::StaticOrder, true, true>(lds, g, S, E); }
            { pg8::Gemm g{(const bf16*)(ws + OFF_ARWKV), (const bf16*)(wl + WO_RO), TT, DM, 512}; pg8::EpiMerge E{Gt + 3 * DM, NU, MB, Mo, 3}; pg8::gemm_phase<pg8::EpiMerge, pg8::StaticOrder, true, true>(lds, g, S, E); }
        }
        SEAM(pb + 4);
        if (IN(pb + 5)) { PH_LOCALS
            __syncthreads();
            pg8::Gemm g{(const bf16*)(ws + OFF_M), (const bf16*)(wl + WO_O), TT, DM, DM}; pg8::StaticOrder S; S.init(TT, DM, G, bid);
            pg8::EpiF32 E{(float*)(ws + OFF_Y), DM};
            pg8::gemm_phase<pg8::EpiF32, pg8::StaticOrder, true, true>(lds, g, S, E);
        }
        SEAM(pb + 5);
        if (IN(pb + 6)) { PH_LOCALS norm_phase(a, 1, ng + 1 * DM, ng + 2 * DM, mv + 2 * DM, mv + 3 * DM, bid, G); }
        SEAM(pb + 6);
        if (IN(pb + 7)) { PH_LOCALS
            __syncthreads();
            pg8::Gemm g{Hb, (const bf16*)(wl + WO_UP), TT, DFF, DM}; pg8::StaticOrder S; S.init(TT, DFF, G, bid);
            pg8::EpiBf E{3, (bf16*)(ws + OFF_HB), nullptr};
            pg8::gemm_phase<pg8::EpiBf, pg8::StaticOrder, true, true>(lds, g, S, E);
        }
        SEAM(pb + 7);
        if (IN(pb + 8)) { PH_LOCALS
            __syncthreads();
            pg8::Gemm g{(const bf16*)(ws + OFF_HB), (const bf16*)(wl + WO_DN), TT, DM, DFF}; pg8::StaticOrder S; S.init(TT, DM, G, bid);
            pg8::EpiF32 E{(float*)(ws + OFF_Y), DM};
            pg8::gemm_phase<pg8::EpiF32, pg8::StaticOrder, true, true>(lds, g, S, E);
        }
        SEAM(pb + 8);
        if (IN(pb + 9)) { PH_LOCALS
            if (l < DEPTH - 1) norm_phase(a, 1, ng + 3 * DM, ng + 4 * DM  , mv + 5 * DM, mv + 5 * 12288  , bid, G);
            else norm_phase(a, 2, ng + 3 * DM, nullptr, mv + 5 * DM, nullptr, bid, G);
        }
        SEAM(pb + 9);
    }
#undef IN
#undef SEAM
}

extern "C" void kernel_launch(void* const* d_in, const int* in_sizes, int n_in, void* d_out, int out_size, void* d_ws, size_t ws_size, hipStream_t stream) {
    static int grid = 0;
    if (grid == 0) {
        if (n_in != N_IN || out_size != TLAT * DM || ws_size < WS_END) { fprintf(stderr, "kernel_launch: unexpected shapes (n_in %d out %d ws %zu); nothing launched\n", n_in, out_size, ws_size); grid = -1; return; }
        int dev = 0, cus = 0;
        if (hipGetDevice(&dev) != hipSuccess || hipDeviceGetAttribute(&cus, hipDeviceAttributeMultiprocessorCount, dev) != hipSuccess) { grid = -1; return; }
        if (hipFuncSetAttribute((const void*)fwd, hipFuncAttributeMaxDynamicSharedMemorySize, LDS_BYTES) != hipSuccess) { fprintf(stderr, "kernel_launch: hipFuncSetAttribute failed\n"); grid = -1; return; }
        int per_cu = 0;
        if (hipOccupancyMaxActiveBlocksPerMultiprocessor(&per_cu, (const void*)fwd, NTHR, LDS_BYTES) != hipSuccess || per_cu < 1) fprintf(stderr, "kernel_launch: occupancy query says %d\n", per_cu);
        (void)hipGetLastError();
        grid = cus;
        if (grid < 192) { fprintf(stderr, "kernel_launch: %d CUs: this kernel's scan phase needs > 160 workgroups\n", grid); grid = -1; return; }
    }
    if (grid < 0) return;
    if (hipMemsetAsync((char*)d_ws + OFF_CTL, 0, CTL_BYTES, stream) != hipSuccess) return;
    Args a{};
    for (int i = 0; i < N_IN; ++i) a.in[i] = (const float*)d_in[i];
    a.out = (float*)d_out; a.ws = (unsigned char*)d_ws;
#if MK_ONE_LAUNCH
    a.ph_lo = 0; a.ph_hi = NPH;
    hipLaunchKernelGGL(fwd, dim3(grid), dim3(NTHR), LDS_BYTES, stream, a);
#else
    for (int p = 0; p < NPH; ++p) { a.ph_lo = p; a.ph_hi = p + 1; hipLaunchKernelGGL(fwd, dim3(grid), dim3(NTHR), LDS_BYTES, stream, a); }
#endif
}
```

```cpp
#include <hip/hip_runtime.h>
#include <cstdio>
#include <cstdint>
namespace pg8 {
#define PG8_LAS __attribute__((address_space(3)))
typedef unsigned short bf16_t;
typedef short bf16x8 __attribute__((ext_vector_type(8)));
typedef float f32x4 __attribute__((ext_vector_type(4)));
typedef unsigned u32x4 __attribute__((ext_vector_type(4)));
constexpr int BM = 256, BK = 64, HALF = 128, HTB = HALF * BK * 2  , STAGE_BYTES = 8 * HTB, NXCD = 8, WGM = 8;

__host__ __device__ __forceinline__ int lds_byte(int r, int c) { const int st = (r >> 4) * 2 + (c >> 5), rr = r & 15, cc = c & 31, ob = rr * 64 + cc * 2; return st * 1024 + (ob ^ (((ob >> 9) & 1) << 5)); }
__host__ __device__ __forceinline__ void stage_rc(int b, int& R, int& C) { const int st = b / 1024, sb = b % 1024, swz = sb ^ (((sb >> 9) & 1) << 5); R = (st >> 1) * 16 + swz / 64; C = (st & 1) * 32 + (swz % 64) / 2; }
__host__ __device__ __forceinline__ int perm32(int rho) { const int n = rho >> 4, i = rho & 15; return 8 * (i >> 2) + 4 * n + (i & 3); }

struct Unit { int pm, pn; };
struct Gemm { const bf16_t* A; const bf16_t* Bt; int M, N, K; };

struct StaticOrder {
    int nM, nN, nwg, G, c;
    __host__ __device__ void init(int M, int N, int G_, int c_) { nM = M / BM; nN = N / BM; nwg = nM * nN; G = G_; c = c_; }
    __host__ __device__ bool next(int i, Unit& u) const {
        const long L = (long)i * G + c; if (L >= nwg) return false;
        int wgid = (int)L; { const int q = nwg / NXCD, r = nwg % NXCD, xcd = wgid % NXCD, off = wgid / NXCD; wgid = (xcd < r ? xcd * (q + 1) : r * (q + 1) + (xcd - r) * q) + off; }
        const int nig = WGM * nN, gid = wgid / nig, fm = gid * WGM, gsz = (nM - fm) < WGM ? (nM - fm) : WGM;
        u.pm = fm + ((wgid % nig) % gsz); u.pn = (wgid % nig) / gsz; return true;
    }
    __device__ __forceinline__ void a_ready(const Unit&) const {}
    __device__ __forceinline__ void done(const Unit&) const {}
};
__device__ __forceinline__ unsigned cvt_pk_bf16(float lo, float hi) { unsigned r; asm volatile("v_cvt_pk_bf16_f32 %0, %1, %2" : "=v"(r) : "v"(lo), "v"(hi)); return r; }
typedef float f32x2 __attribute__((ext_vector_type(2)));
template <class Epi, class Sched, bool ALIGN_EPI = false, bool SP2 = false>
__device__ __forceinline__ void gemm_phase(PG8_LAS unsigned char* lds, const Gemm g, const Sched& S, const Epi& E) {
    int tid_ = threadIdx.x; asm volatile("" : "+v"(tid_)); const int tid = tid_, wid = __builtin_amdgcn_readfirstlane(tid >> 6), lane = tid & 63, wr = wid >> 2, wc = wid & 3, fr = lane & 15, fq = lane >> 4;
    const int K = g.K, nt = K / BK;
    unsigned voffA[2], voffB[2];
#pragma unroll
    for (int i = 0; i < 2; ++i) { int R, C; stage_rc(tid * 16 + i * 8192, R, C); const int Rb = Epi::PERM ? ((R & ~31) + perm32(R & 31)) : R;
        voffA[i] = (unsigned)(R * K + C) * 2u; voffB[i] = (unsigned)(Rb * K + C) * 2u; }
    const size_t kstep = (size_t)(BK * 2);
    const size_t hstep = (size_t)HALF * K * 2;
    const size_t tstep = 2 * hstep;
    const unsigned ldsw = (unsigned)wid * 1024u;
    const int aoff = lds_byte(wr * 64 + fr, fq * 8), boff = lds_byte(wc * 32 + fr, fq * 8);
#define PG8_SA(b, h) (((b) * 2 + (h)) * HTB)
#define PG8_SB(b, h) ((4 + (b) * 2 + (h)) * HTB)
#define PG8_STAGE(bufoff, gbase, voff) do { _Pragma("unroll") for (int _i = 0; _i < 2; ++_i) \
        __builtin_amdgcn_global_load_lds((const unsigned*)((const char*)(gbase) + (voff)[_i]), (PG8_LAS unsigned*)(lds + (bufoff) + ldsw + _i * 8192), 16, 0, 0); } while (0)
#define PG8_LDA(dst, b, h) do { _Pragma("unroll") for (int m = 0; m < 4; ++m) _Pragma("unroll") for (int k = 0; k < 2; ++k) dst[m][k] = *(const PG8_LAS bf16x8*)(lds + PG8_SA(b, h) + aoff + m * 2048 + k * 1024); } while (0)
#define PG8_LDB(dst, b, h) do { _Pragma("unroll") for (int n = 0; n < 2; ++n) _Pragma("unroll") for (int k = 0; k < 2; ++k) dst[n][k] = *(const PG8_LAS bf16x8*)(lds + PG8_SB(b, h) + boff + n * 2048 + k * 1024); } while (0)
#define PG8_MMA(ai, bj, At, Bt) do { __builtin_amdgcn_s_setprio(1); _Pragma("unroll") for (int m = 0; m < 4; ++m) _Pragma("unroll") for (int n = 0; n < 2; ++n) _Pragma("unroll") for (int k = 0; k < 2; ++k) \
        acc[ai][bj][m][n] = __builtin_amdgcn_mfma_f32_16x16x32_bf16(Bt[n][k], At[m][k], acc[ai][bj][m][n], 0, 0, 0); __builtin_amdgcn_s_setprio(0); } while (0)
#define PG8_WAIT_V(n) asm volatile("s_waitcnt vmcnt(" #n ")" ::: "memory")
#define PG8_WAIT_L(n) asm volatile("s_waitcnt lgkmcnt(" #n ")" ::: "memory")
#define PG8_BAR __builtin_amdgcn_s_barrier()
#define PG8_SCHED __builtin_amdgcn_sched_barrier(0)
    Unit cur, nxt; int ui = 0;
    if (!S.next(0, cur)) return;
    f32x4 acc[2][2][4][2];
#pragma unroll
    for (int a = 0; a < 2; ++a)
#pragma unroll
        for (int b = 0; b < 2; ++b)
#pragma unroll
            for (int m = 0; m < 4; ++m)
#pragma unroll
                for (int n = 0; n < 2; ++n) acc[a][b][m][n] = (f32x4){0.f, 0.f, 0.f, 0.f};
    bf16x8 At[4][2], B0[2][2], B1[2][2];
    const char* cA = (const char*)g.A + (size_t)cur.pm * tstep; const char* cB = (const char*)g.Bt + (size_t)cur.pn * tstep;
    S.a_ready(cur);
    if constexpr (SP2) {
        PG8_STAGE(PG8_SB(0, 0), cB, voffB); PG8_STAGE(PG8_SB(0, 1), cB + hstep, voffB); PG8_STAGE(PG8_SA(0, 0), cA, voffA); PG8_STAGE(PG8_SA(0, 1), cA + hstep, voffA);
        if (wr == 1) PG8_BAR;
        PG8_WAIT_V(2); PG8_BAR;
        PG8_STAGE(PG8_SB(1, 0), cB + kstep, voffB); PG8_STAGE(PG8_SA(1, 0), cA + kstep, voffA); PG8_STAGE(PG8_SB(1, 1), cB + hstep + kstep, voffB);
        PG8_WAIT_V(6); PG8_BAR;
    } else {
        PG8_STAGE(PG8_SB(0, 0), cB, voffB); PG8_STAGE(PG8_SA(0, 0), cA, voffA); PG8_STAGE(PG8_SB(0, 1), cB + hstep, voffB); PG8_STAGE(PG8_SA(0, 1), cA + hstep, voffA);
        if (wr == 1) PG8_BAR;
        PG8_WAIT_V(4); PG8_BAR;
        PG8_STAGE(PG8_SB(1, 0), cB + kstep, voffB); PG8_STAGE(PG8_SA(1, 0), cA + kstep, voffA); PG8_STAGE(PG8_SB(1, 1), cB + hstep + kstep, voffB);
        PG8_WAIT_V(6); PG8_BAR;
    }
    for (;;) {
        const bool has_next = S.next(ui + 1, nxt);
        const char* nA = has_next ? (const char*)g.A + (size_t)nxt.pm * tstep : cA; const char* nB = has_next ? (const char*)g.Bt + (size_t)nxt.pn * tstep : cB;
        for (int t = 0; t < nt; t += 2) {
            const bool last = (t == nt - 2);
            const char* a1 = cA + (size_t)(t + 1) * kstep;
            const char* a2 = last ? nA : cA + (size_t)(t + 2) * kstep; const char* b2 = last ? nB : cB + (size_t)(t + 2) * kstep;
            const char* a3 = a2 + kstep; const char* b3 = b2 + kstep;
            if (last && has_next) S.a_ready(nxt);
            if constexpr (SP2) {
            PG8_LDB(B0, 0, 0); PG8_LDB(B1, 0, 1); PG8_SCHED; PG8_LDA(At, 0, 0); PG8_STAGE(PG8_SA(1, 1), a1 + hstep, voffA);
            PG8_WAIT_V(8); PG8_WAIT_L(0); PG8_BAR; PG8_MMA(0, 0, At, B0); PG8_MMA(0, 1, At, B1); PG8_BAR; PG8_SCHED;
            PG8_LDA(At, 0, 1); PG8_STAGE(PG8_SB(0, 0), b2, voffB); PG8_STAGE(PG8_SB(0, 1), b2 + hstep, voffB); PG8_STAGE(PG8_SA(0, 0), a2, voffA);
            PG8_WAIT_V(8); PG8_WAIT_L(0); PG8_BAR; PG8_MMA(1, 0, At, B0); PG8_MMA(1, 1, At, B1); PG8_BAR; PG8_SCHED;
            PG8_LDB(B0, 1, 0); PG8_LDB(B1, 1, 1); PG8_SCHED; PG8_LDA(At, 1, 0); PG8_STAGE(PG8_SA(0, 1), a2 + hstep, voffA);
            PG8_WAIT_V(8); PG8_WAIT_L(0); PG8_BAR; PG8_MMA(0, 0, At, B0); PG8_MMA(0, 1, At, B1); PG8_BAR; PG8_SCHED;
            PG8_LDA(At, 1, 1); PG8_STAGE(PG8_SB(1, 0), b3, voffB); PG8_STAGE(PG8_SB(1, 1), b3 + hstep, voffB); PG8_STAGE(PG8_SA(1, 0), a3, voffA);
            PG8_WAIT_V(8); PG8_WAIT_L(0); PG8_BAR; PG8_MMA(1, 0, At, B0); PG8_MMA(1, 1, At, B1); PG8_BAR; PG8_SCHED;
            } else {
            PG8_LDB(B0, 0, 0); PG8_SCHED; PG8_LDA(At, 0, 0); PG8_STAGE(PG8_SA(1, 1), a1 + hstep, voffA);
            PG8_WAIT_L(8); PG8_BAR; PG8_WAIT_L(0); PG8_MMA(0, 0, At, B0); PG8_BAR; PG8_SCHED;
            PG8_LDB(B1, 0, 1); PG8_STAGE(PG8_SB(0, 0), b2, voffB);
            PG8_BAR; PG8_WAIT_L(0); PG8_MMA(0, 1, At, B1); PG8_BAR;
            PG8_LDA(At, 0, 1); PG8_STAGE(PG8_SA(0, 0), a2, voffA);
            PG8_BAR; PG8_WAIT_L(0); PG8_MMA(1, 0, At, B0); PG8_BAR; PG8_SCHED;
            PG8_STAGE(PG8_SB(0, 1), b2 + hstep, voffB);
            PG8_WAIT_V(6); PG8_BAR; PG8_MMA(1, 1, At, B1); PG8_BAR;
            PG8_LDB(B0, 1, 0); PG8_SCHED; PG8_LDA(At, 1, 0); PG8_STAGE(PG8_SA(0, 1), a2 + hstep, voffA);
            PG8_WAIT_L(8); PG8_BAR; PG8_WAIT_L(0); PG8_MMA(0, 0, At, B0); PG8_BAR; PG8_SCHED;
            PG8_LDB(B1, 1, 1); PG8_STAGE(PG8_SB(1, 0), b3, voffB);
            PG8_BAR; PG8_WAIT_L(0); PG8_MMA(0, 1, At, B1); PG8_BAR;
            PG8_LDA(At, 1, 1); PG8_STAGE(PG8_SA(1, 0), a3, voffA);
            PG8_BAR; PG8_WAIT_L(0); PG8_MMA(1, 0, At, B0); PG8_BAR; PG8_SCHED;
            PG8_STAGE(PG8_SB(1, 1), b3 + hstep, voffB);
            PG8_WAIT_V(6); PG8_BAR; PG8_MMA(1, 1, At, B1); PG8_BAR;
            }
        }
        if constexpr (ALIGN_EPI) { if (wr == 0) PG8_BAR; }
        if constexpr (!Epi::AFTER_DRAIN) { E(acc, cur, wr, wc, fr, fq); S.done(cur); }
        if (!has_next) break;
#pragma unroll
        for (int a = 0; a < 2; ++a)
#pragma unroll
            for (int b = 0; b < 2; ++b)
#pragma unroll
                for (int m = 0; m < 4; ++m)
#pragma unroll
                    for (int n = 0; n < 2; ++n) acc[a][b][m][n] = (f32x4){0.f, 0.f, 0.f, 0.f};
        cur = nxt; cA = nA; cB = nB; ++ui;
        if constexpr (ALIGN_EPI) { if (wr == 1) PG8_BAR; }
    }
    PG8_WAIT_V(0);
    if constexpr (!ALIGN_EPI) { if (wr == 0) PG8_BAR; }
    PG8_BAR;
    if constexpr (Epi::AFTER_DRAIN) { E.fused(acc, cur, wr, wc, fr, fq, lds, wid, lane); S.done(cur); }
#undef PG8_SA
#undef PG8_SB
#undef PG8_STAGE
#undef PG8_LDA
#undef PG8_LDB
#undef PG8_MMA
#undef PG8_WAIT_V
#undef PG8_WAIT_L
#undef PG8_BAR
#undef PG8_SCHED
}
}

namespace pg8 {
__device__ __forceinline__ float sigm(float x) { return __builtin_amdgcn_rcpf(1.f + __expf(-x)); }
__device__ __forceinline__ f32x4 sigm4(f32x4 v) { return (f32x4){sigm(v[0]), sigm(v[1]), sigm(v[2]), sigm(v[3])}; }
__device__ __forceinline__ u32x4 pack8(f32x4 v0, f32x4 v1) { u32x4 w; w.x = cvt_pk_bf16(v0[0], v0[1]); w.y = cvt_pk_bf16(v0[2], v0[3]); w.z = cvt_pk_bf16(v1[0], v1[1]); w.w = cvt_pk_bf16(v1[2], v1[3]); return w; }
__device__ __forceinline__ float bflo(unsigned u) { return __uint_as_float(u << 16); }
__device__ __forceinline__ float bfhi(unsigned u) { return __uint_as_float(u & 0xffff0000u); }

struct EpiInproj {
    static constexpr bool PERM = true, AFTER_DRAIN = false;
    bf16_t* U; float* MISC; int ldu;
    __device__ __forceinline__ void operator()(const f32x4 (&acc)[2][2][4][2], const Unit& u, int wr, int wc, int fr, int fq) const {
        const int row0 = u.pm * BM + wr * 64 + fr, cl = wc * 32 + 8 * fq;
        if (u.pn == 16 || u.pn == 17) {
#pragma unroll
            for (int ai = 0; ai < 2; ++ai)
#pragma unroll
                for (int m = 0; m < 4; ++m) { float* rowp = MISC + (size_t)(row0 + ai * HALF + m * 16) * 512 + (u.pn - 16) * BM + cl;
#pragma unroll
                    for (int bj = 0; bj < 2; ++bj) { *(f32x4*)(rowp + bj * HALF) = acc[ai][bj][m][0]; *(f32x4*)(rowp + bj * HALF + 4) = acc[ai][bj][m][1]; } }
        } else {
            const bool sg = u.pn >= 22;
#pragma unroll
            for (int ai = 0; ai < 2; ++ai)
#pragma unroll
                for (int m = 0; m < 4; ++m) { bf16_t* rowp = U + (size_t)(row0 + ai * HALF + m * 16) * ldu + u.pn * BM + cl;
#pragma unroll
                    for (int bj = 0; bj < 2; ++bj) { f32x4 v0 = acc[ai][bj][m][0], v1 = acc[ai][bj][m][1];
                        if (sg) { v0 = sigm4(v0); v1 = sigm4(v1); }
                        *(u32x4*)(rowp + bj * HALF) = pack8(v0, v1); } }
        }
    }
};
struct EpiBf {
    static constexpr bool PERM = true, AFTER_DRAIN = false;
    int kind; bf16_t* O0; bf16_t* O1;
    __device__ __forceinline__ void operator()(const f32x4 (&acc)[2][2][4][2], const Unit& u, int wr, int wc, int fr, int fq) const {
        bf16_t* base; size_t pitch;
        if (kind == 0) {
            const int half = u.pm >> 1, chb = (u.pm & 1) * 256;
            if (u.pn < 32) { const int b = u.pn >> 3, l0 = (u.pn & 7) * 256; pitch = 4096; base = O0 + ((size_t)(b * 512 + chb) * 2 + half) * 2048 + l0; }
            else { const int b = u.pn - 32; pitch = 512; base = O1 + ((size_t)(b * 512 + chb) * 2 + half) * 256; }
        } else if (kind == 1) { const int b = u.pn >> 1; pitch = 512; base = O0 + (size_t)(b * 2048 + u.pm * 256) * 512 + (u.pn & 1) * 256; }
        else if (kind == 2) { const int b = u.pn >> 1; pitch = 512; base = O0 + (size_t)(8192 + b * 256) * 512 + (u.pn & 1) * 256; }
        else { pitch = 8192; base = O0 + (size_t)(u.pm * 256) * 8192 + u.pn * 256; }
        const int r0 = wr * 64 + fr, cl = wc * 32 + 8 * fq;
#pragma unroll
        for (int ai = 0; ai < 2; ++ai)
#pragma unroll
            for (int m = 0; m < 4; ++m) { bf16_t* rowp = base + (size_t)(r0 + ai * HALF + m * 16) * pitch + cl;
#pragma unroll
                for (int bj = 0; bj < 2; ++bj) { f32x4 v0 = acc[ai][bj][m][0], v1 = acc[ai][bj][m][1];
                    if (kind == 3) { v0 = __builtin_elementwise_max(v0, (f32x4){0.f, 0.f, 0.f, 0.f}); v1 = __builtin_elementwise_max(v1, (f32x4){0.f, 0.f, 0.f, 0.f}); v0 = v0 * v0; v1 = v1 * v1; }
                    *(u32x4*)(rowp + bj * HALF) = pack8(v0, v1); } }
    }
};
struct EpiMerge {
    static constexpr bool PERM = true, AFTER_DRAIN = false;
    const bf16_t* G; int ldg; float* MB; bf16_t* Mo; int job;
    __device__ __forceinline__ void operator()(const f32x4 (&acc)[2][2][4][2], const Unit& u, int wr, int wc, int fr, int fq) const {
        const int row0 = u.pm * BM + wr * 64 + fr, col0 = u.pn * BM + wc * 32 + 8 * fq;
#pragma unroll
        for (int ai = 0; ai < 2; ++ai)
#pragma unroll
            for (int m = 0; m < 4; ++m) { const size_t row = (size_t)(row0 + ai * HALF + m * 16);
#pragma unroll
                for (int bj = 0; bj < 2; ++bj) { const int col = col0 + bj * HALF;
                    const u32x4 g = *(const u32x4*)(G + row * ldg + col);
                    f32x4 v0 = acc[ai][bj][m][0] * (f32x4){bflo(g.x), bfhi(g.x), bflo(g.y), bfhi(g.y)};
                    f32x4 v1 = acc[ai][bj][m][1] * (f32x4){bflo(g.z), bfhi(g.z), bflo(g.w), bfhi(g.w)};
                    float* mp = MB + row * 2048 + col;
                    if (job > 0) { v0 += *(const f32x4*)mp; v1 += *(const f32x4*)(mp + 4); }
                    if (job < 3) { *(f32x4*)mp = v0; *(f32x4*)(mp + 4) = v1; }
                    else *(u32x4*)(Mo + row * 2048 + col) = pack8(v0, v1); } }
    }
};
struct EpiF32 {
    static constexpr bool PERM = false, AFTER_DRAIN = false;
    float* C; int ldc;
    __device__ __forceinline__ void operator()(const f32x4 (&acc)[2][2][4][2], const Unit& u, int wr, int wc, int fr, int fq) const {
        const int row0 = u.pm * BM + wr * 64 + fr, col0 = u.pn * BM + wc * 32 + 4 * fq;
#pragma unroll
        for (int ai = 0; ai < 2; ++ai)
#pragma unroll
            for (int m = 0; m < 4; ++m) { float* rowp = C + (size_t)(row0 + ai * HALF + m * 16) * ldc + col0;
#pragma unroll
                for (int bj = 0; bj < 2; ++bj)
#pragma unroll
                    for (int n = 0; n < 2; ++n) *(f32x4*)(rowp + bj * HALF + n * 16) = acc[ai][bj][m][n]; }
    }
};
}

#define GAS __attribute__((address_space(1)))
#define LAS __attribute__((address_space(3)))
typedef unsigned short bf16;
typedef unsigned v4u __attribute__((ext_vector_type(4)));
typedef unsigned v2u __attribute__((ext_vector_type(2)));
typedef float f32x4 __attribute__((ext_vector_type(4)));
typedef float f32x2 __attribute__((ext_vector_type(2)));
constexpr int NWAVES = 8, NTHR = 512;
constexpr int DM = 2048, NBATCH = 4, LSEQ = 2048, LCTX = 256, DEPTH = 4;
constexpr int TLAT = NBATCH * LSEQ, TCTX = NBATCH * LCTX, TT = TLAT + TCTX;
constexpr int IN_DIM = 14168, DFF = 8192;
constexpr int NU = 13824;
constexpr int UZ = 0, UXBC = 768, URKV = 2560, UMISC = 4096, UCONV = 4608, UGATE = 5632;
constexpr int S_RKV = 2584, S_DT = 2560, S_WF = 4120, S_CONV = 4440, S_FFT = 5464, S_GATE = 5976;
constexpr int RJ = LCTX + LSEQ;
enum { I_X = 0, I_C, I_CTX, I_CCTX, I_MODW, I_MODB, I_NORMG, I_WIN, I_CONVW, I_CONVB, I_CLNG, I_CLNB, I_CONVOUT, I_SCW, I_SCB, I_SALOG, I_SDTB, I_SD, I_SNG, I_SOUT,
       I_FOUT, I_RMU, I_RW0, I_RW2, I_RA0, I_RA2, I_RG2, I_RKK, I_RKA, I_RRK, I_RLNG, I_RLNB, I_ROUT, I_WO, I_UP, I_DOWN, N_IN };
constexpr size_t MiB = 1u << 20;
constexpr size_t OFF_CTL = 0, CTL_BYTES = 1 * MiB;
constexpr size_t OFF_MODV = 1 * MiB;
constexpr size_t OFF_DFTL = 2 * MiB;
constexpr size_t OFF_DFTC = 18 * MiB;
constexpr size_t OFF_W = 20 * MiB, W_LAYER = 139 * MiB;
constexpr size_t WO_IN = 0, WO_FFT = 54 * MiB, WO_CO = 58 * MiB, WO_SO = 60 * MiB, WO_FO = 63 * MiB, WO_RO = 65 * MiB, WO_O = 67 * MiB, WO_UP = 75 * MiB, WO_DN = 107 * MiB;
constexpr size_t OFF_X = 576 * MiB;
constexpr size_t OFF_H = 648 * MiB;
constexpr size_t OFF_U = 684 * MiB;
constexpr size_t OFF_HB = OFF_U;
constexpr size_t OFF_MISC = 927 * MiB;
constexpr size_t OFF_VTL = 945 * MiB;
constexpr size_t OFF_VTC = 961 * MiB;
constexpr size_t OFF_ACONV = 963 * MiB, OFF_ASSD = 972 * MiB, OFF_AFFT = 986 * MiB, OFF_ARWKV = 995 * MiB;
constexpr size_t OFF_XBC = 1004 * MiB;
constexpr size_t OFF_DTA = 1036 * MiB;
constexpr size_t OFF_YSSD = 1038 * MiB;
constexpr size_t OFF_RW = 1092 * MiB, RW_ARR = 18 * MiB;
constexpr size_t OFF_RSC = 1254 * MiB;
constexpr size_t OFF_YRW = 1255 * MiB;
constexpr size_t OFF_MBUF = 1291 * MiB;
constexpr size_t OFF_M = 1363 * MiB;
constexpr size_t OFF_Y = 1399 * MiB;
constexpr size_t WS_END = 1471 * MiB;
constexpr int CW_BAR = 4096;
constexpr int RING_BYTES = 131072, MISC_OFF = RING_BYTES + 320, LDS_BYTES = 147456;

__device__ __forceinline__ float bf2f(unsigned short b) { return __uint_as_float((unsigned)b << 16); }
__device__ __forceinline__ float bflo(unsigned u) { return __uint_as_float(u << 16); }
__device__ __forceinline__ float bfhi(unsigned u) { return __uint_as_float(u & 0xffff0000u); }
__device__ __forceinline__ unsigned f2bf(float f) { unsigned u = __builtin_bit_cast(unsigned, f); return (u + 0x7fffu + ((u >> 16) & 1u)) >> 16; }
__device__ __forceinline__ unsigned pk2(float lo, float hi) { return f2bf(lo) | (f2bf(hi) << 16); }
__device__ __forceinline__ float sigmoidf_(float x) { return 1.f / (1.f + __expf(-x)); }
__device__ __forceinline__ float siluf_(float x) { return x / (1.f + __expf(-x)); }
__device__ __forceinline__ float softplusf_(float x) { return fmaxf(x, 0.f) + log1pf(__expf(-fabsf(x))); }
__device__ __forceinline__ float wave_sum(float v) {
#pragma unroll
    for (int o = 1; o < 64; o <<= 1) v += __shfl_xor(v, o);
    return v;
}
#define LDS_WAIT() asm volatile("s_waitcnt lgkmcnt(0)" ::: "memory")

struct Args { const float* in[N_IN]; float* out; unsigned char* ws; int ph_lo, ph_hi; };
typedef const __attribute__((address_space(4))) Args* KArgs;
__device__ __forceinline__ KArgs kargs() { KArgs p = (KArgs)__builtin_amdgcn_kernarg_segment_ptr(); asm volatile("" : "+s"(p)); return p; }
#define PH_IDS int tid = threadIdx.x; asm volatile("" : "+v"(tid)); const int lane = tid & 63, wave = __builtin_amdgcn_readfirstlane(tid >> 6); (void)lane; (void)wave;

__device__ __forceinline__ int inmap(int n) {
    if (n < 2560) return n;
    if (n < 4096) return S_RKV + (n - 2560);
    if (n < 4608) { const int m = n - 4096; if (m < 24) return S_DT + m; if (m < 64) return -1; if (m < 384) return S_WF + (m - 64); return -1; }
    if (n < 5632) return S_CONV + (n - 4608);
    return S_GATE + (n - 5632);
}
__device__ __forceinline__ int rwkv_tok(int b, int j) { if (j < LCTX) return TLAT + b * LCTX + j; const int s = j - LCTX; return b * LSEQ + (s & 31) * 64 + (s >> 5); }

__device__ __forceinline__ void transpose_item(const float* W, int K, int Nsrc, bf16* WT, int k0, int n0, bool mapped, LAS float* scr, int lane) {
    const int nn = lane & 31; const int sc = mapped ? inmap(n0 + nn) : (n0 + nn);
#pragma unroll 8
    for (int i = 0; i < 32; ++i) { const int kk = 2 * i + (lane >> 5); scr[kk * 33 + nn] = (sc >= 0) ? W[(size_t)(k0 + kk) * Nsrc + sc] : 0.f; }
    LDS_WAIT();
    const int c = lane & 7;
#pragma unroll
    for (int j = 0; j < 4; ++j) { const int n = (lane >> 3) + 8 * j; const LAS float* s = scr + (8 * c) * 33 + n;
        v4u o; o.x = pk2(s[0 * 33], s[1 * 33]); o.y = pk2(s[2 * 33], s[3 * 33]); o.z = pk2(s[4 * 33], s[5 * 33]); o.w = pk2(s[6 * 33], s[7 * 33]);
        *(v4u*)(WT + (size_t)(n0 + n) * K + k0 + 8 * c) = o; }
    LDS_WAIT();
}
constexpr int IT_IN = 32 * (NU / 32), IT_CO = 8 * 64, IT_SO = 12 * 64, IT_FO = 8 * 64, IT_RO = 8 * 64, IT_O = 32 * 64, IT_UP = 32 * 256, IT_DN = 128 * 64;
constexpr int IT_LAYER = IT_IN + IT_CO + IT_SO + IT_FO + IT_RO + IT_O + IT_UP + IT_DN;

__device__ __forceinline__ void p0_prologue(KArgs a, LAS unsigned char* lds, int bid, int G) {
    PH_IDS
    unsigned char* ws = a->ws;
    {
        LAS float* sc = (LAS float*)lds;
        LAS float* part = (LAS float*)(lds + 40960);
        for (int i = tid; i < 5 * DM; i += NTHR) { const float v = (i < 4 * DM) ? a->in[I_C][i] : a->in[I_CCTX][i - 4 * DM]; sc[i] = siluf_(v); }
        __syncthreads();
        float* MODV = (float*)(ws + OFF_MODV);
        for (int it = bid; it < DEPTH * 192; it += G) {
            const int l = it / 192, j = (it % 192) * 64 + lane;
            const float* wp = a->in[I_MODW] + (size_t)l * DM * 12288 + (size_t)(wave * 256) * 12288 + j;
            float acc[5] = {0.f, 0.f, 0.f, 0.f, 0.f};
#pragma unroll 4
            for (int k = 0; k < 256; ++k) { const float w = wp[(size_t)k * 12288];
#pragma unroll
                for (int r = 0; r < 5; ++r) acc[r] += sc[r * DM + wave * 256 + k] * w; }
#pragma unroll
            for (int r = 0; r < 5; ++r) part[(wave * 5 + r) * 64 + lane] = acc[r];
            __syncthreads();
            if (tid < 320) { const int r = tid >> 6, jj = tid & 63; float s = 0.f;
#pragma unroll
                for (int w = 0; w < 8; ++w) s += part[(w * 5 + r) * 64 + jj];
                const int jo = (it % 192) * 64 + jj; MODV[((size_t)l * 5 + r) * 12288 + jo] = s + a->in[I_MODB][l * 12288 + jo]; }
            __syncthreads();
        }
    }
    {
        LAS float* wt = (LAS float*)lds;
        LAS float* ctab = (LAS float*)(lds + 32768);
        LAS float* scr = (LAS float*)(lds + 32768 + 512 + wave * 8448);
        __syncthreads();
        if (tid < 128) ctab[tid] = cospif((float)tid * (1.f / 64.f));
        for (int it = bid; it < DEPTH * 32 * 4; it += G) {
            const int l = it / 128, kb = (it % 128) / 4, g = it % 4, k0 = kb * 64;
            __syncthreads();
            for (int i = tid; i < 64 * 32; i += NTHR) { const int kk = i >> 5, c4 = i & 31;
                *(LAS f32x4*)(wt + kk * 128 + c4 * 4) = *(const f32x4*)(a->in[I_WIN] + ((size_t)l * DM + k0 + kk) * IN_DIM + S_FFT + g * 128 + c4 * 4); }
            __syncthreads();
            const int half = wave >> 2, cp = (wave & 3) * 32 + (lane & 31), n0 = half * 512 + g * 128 + (wave & 3) * 32;
#pragma unroll 1
            for (int i = 0; i < 32; ++i) { const int kk = 2 * i + (lane >> 5); float s = 0.f;
#pragma unroll 8
                for (int c = 0; c < 128; ++c) s += wt[kk * 128 + c] * ctab[(c * cp - 32 * half) & 127];
                scr[kk * 33 + (lane & 31)] = s; }
            LDS_WAIT();
            bf16* WT = (bf16*)(ws + OFF_W + (size_t)l * W_LAYER + WO_FFT);
            const int c = lane & 7;
#pragma unroll
            for (int j = 0; j < 4; ++j) { const int n = (lane >> 3) + 8 * j; const LAS float* s = scr + (8 * c) * 33 + n;
                v4u o; o.x = pk2(s[0 * 33], s[1 * 33]); o.y = pk2(s[2 * 33], s[3 * 33]); o.z = pk2(s[4 * 33], s[5 * 33]); o.w = pk2(s[6 * 33], s[7 * 33]);
                *(v4u*)(WT + (size_t)(n0 + n) * DM + k0 + 8 * c) = o; }
            LDS_WAIT();
        }
        __syncthreads();
    }
    const int gw = bid * NWAVES + wave, NGW = G * NWAVES;
    {
        LAS float* scr = (LAS float*)(lds + wave * 8448);
        for (int it = gw; it < DEPTH * IT_LAYER; it += NGW) {
            const int l = it / IT_LAYER; int r = it % IT_LAYER; unsigned char* wl = ws + OFF_W + (size_t)l * W_LAYER;
            if (r < IT_IN) { const int kb = r / (NU / 32), nb = r % (NU / 32); transpose_item(a->in[I_WIN] + (size_t)l * DM * IN_DIM, DM, IN_DIM, (bf16*)(wl + WO_IN), kb * 64, nb * 32, true, scr, lane); continue; } r -= IT_IN;
            if (r < IT_CO) { transpose_item(a->in[I_CONVOUT] + (size_t)l * 512 * DM, 512, DM, (bf16*)(wl + WO_CO), (r / 64) * 64, (r % 64) * 32, false, scr, lane); continue; } r -= IT_CO;
            if (r < IT_SO) { transpose_item(a->in[I_SOUT] + (size_t)l * 768 * DM, 768, DM, (bf16*)(wl + WO_SO), (r / 64) * 64, (r % 64) * 32, false, scr, lane); continue; } r -= IT_SO;
            if (r < IT_FO) { transpose_item(a->in[I_FOUT] + (size_t)l * 512 * DM, 512, DM, (bf16*)(wl + WO_FO), (r / 64) * 64, (r % 64) * 32, false, scr, lane); continue; } r -= IT_FO;
            if (r < IT_RO) { transpose_item(a->in[I_ROUT] + (size_t)l * 512 * DM, 512, DM, (bf16*)(wl + WO_RO), (r / 64) * 64, (r % 64) * 32, false, scr, lane); continue; } r -= IT_RO;
            if (r < IT_O) { transpose_item(a->in[I_WO] + (size_t)l * DM * DM, DM, DM, (bf16*)(wl + WO_O), (r / 64) * 64, (r % 64) * 32, false, scr, lane); continue; } r -= IT_O;
            if (r < IT_UP) { transpose_item(a->in[I_UP] + (size_t)l * DM * DFF, DM, DFF, (bf16*)(wl + WO_UP), (r / 256) * 64, (r % 256) * 32, false, scr, lane); continue; } r -= IT_UP;
            transpose_item(a->in[I_DOWN] + (size_t)l * DFF * DM, DFF, DM, (bf16*)(wl + WO_DN), (r / 64) * 64, (r % 64) * 32, false, scr, lane);
        }
    }
    {
        const int gt = bid * NTHR + tid, NGT = G * NTHR;
        bf16* FL = (bf16*)(ws + OFF_DFTL); bf16* FC = (bf16*)(ws + OFF_DFTC);
        for (int i = gt; i < 2048 * 512; i += NGT) { const int lp = i >> 9, k8 = (i & 511) * 8; unsigned o[4];
#pragma unroll
            for (int e = 0; e < 4; ++e) { float v[2];
#pragma unroll
                for (int q = 0; q < 2; ++q) { const int k = k8 + 2 * e + q; const int m = (lp * (k & 2047)) & 2047; float sn, cs; sincospif((float)m * (1.f / 1024.f), &sn, &cs); v[q] = (k < 2048 ? cs : -sn) * (1.f / 512.f); }
                o[e] = pk2(v[0], v[1]); }
            *(v4u*)(FL + (size_t)lp * 4096 + k8) = (v4u){o[0], o[1], o[2], o[3]}; }
        for (int i = gt; i < 256 * 64; i += NGT) { const int lp = i >> 6, k8 = (i & 63) * 8; unsigned o[4];
#pragma unroll
            for (int e = 0; e < 4; ++e) { float v[2];
#pragma unroll
                for (int q = 0; q < 2; ++q) { const int k = k8 + 2 * e + q; const int m = (lp * (k & 255)) & 255; float sn, cs; sincospif((float)m * (1.f / 128.f), &sn, &cs); v[q] = (k < 256 ? cs : -sn) * 0.005524271728f; }
                o[e] = pk2(v[0], v[1]); }
            *(v4u*)(FC + (size_t)lp * 512 + k8) = (v4u){o[0], o[1], o[2], o[3]}; }
        f32x4* X4 = (f32x4*)(ws + OFF_X); const f32x4* x4 = (const f32x4*)a->in[I_X]; const f32x4* c4 = (const f32x4*)a->in[I_CTX];
        for (int i = gt; i < TT * (DM / 4); i += NGT) X4[i] = (i < TLAT * (DM / 4)) ? x4[i] : c4[i - TLAT * (DM / 4)];
    }
}

__device__ __forceinline__ void norm_phase(KArgs a, int mode, const float* gY, const float* gH, const float* modY  , const float* modH  ,
                                           int bid, int G) {
    PH_IDS
    unsigned char* ws = a->ws; const int gw = bid * NWAVES + wave, NGW = G * NWAVES;
    float* X = (float*)(ws + OFF_X); const float* Y = (const float*)(ws + OFF_Y); bf16* H = (bf16*)(ws + OFF_H);
    for (int row = gw; row < TT; row += NGW) {
        if (mode == 2 && row >= TLAT) continue;
        const int mr = row < TLAT ? (row >> 11) : 4;
        f32x4 x[8];
        const f32x4* xr = (const f32x4*)(X + (size_t)row * DM) + lane;
#pragma unroll
        for (int j = 0; j < 8; ++j) x[j] = xr[64 * j];
        if (mode != 0) {
            const f32x4* yr = (const f32x4*)(Y + (size_t)row * DM) + lane; f32x4 y[8]; float ss = 0.f;
#pragma unroll
            for (int j = 0; j < 8; ++j) { y[j] = yr[64 * j]; ss += (y[j].x * y[j].x + y[j].y * y[j].y) + (y[j].z * y[j].z + y[j].w * y[j].w); }
            const float r = rsqrtf(wave_sum(ss) * (1.f / DM) + 1e-6f);
            const f32x4* gp = (const f32x4*)gY + lane; const f32x4* gt = (const f32x4*)(modY + (size_t)mr * 12288) + lane;
#pragma unroll
            for (int j = 0; j < 8; ++j) x[j] += gt[64 * j] * (y[j] * r * gp[64 * j]);
            if (mode == 1) { f32x4* xw = (f32x4*)(X + (size_t)row * DM) + lane;
#pragma unroll
                for (int j = 0; j < 8; ++j) xw[64 * j] = x[j]; }
            else { f32x4* ow = (f32x4*)(a->out + (size_t)row * DM) + lane;
#pragma unroll
                for (int j = 0; j < 8; ++j) ow[64 * j] = x[j]; }
        }
        if (mode != 2) {
            float ss = 0.f;
#pragma unroll
            for (int j = 0; j < 8; ++j) ss += (x[j].x * x[j].x + x[j].y * x[j].y) + (x[j].z * x[j].z + x[j].w * x[j].w);
            const float r = rsqrtf(wave_sum(ss) * (1.f / DM) + 1e-6f);
            const f32x4* gp = (const f32x4*)gH + lane; const f32x4* sh = (const f32x4*)(modH + (size_t)mr * 12288) + lane; const f32x4* sc = sh + 512;
            v2u* hw = (v2u*)(H + (size_t)row * DM) + lane;
#pragma unroll
            for (int j = 0; j < 8; ++j) { const f32x4 h = (x[j] * r * gp[64 * j]) * (sc[64 * j] + 1.f) + sh[64 * j]; hw[64 * j] = (v2u){pk2(h.x, h.y), pk2(h.z, h.w)}; }
        }
    }
}
#define XB_TMO      128
#define XB_XCNT(j)  (256  + 64 * (j))
#define XB_XSUB(j)  (1280 + 64 * (j))
#define XB_XGEN(j)  (2304 + 64 * (j))
#define XB_TOP      3328
#define XB_TOPGEN   3392
#define XCD_BAR_WORDS 3456
#define XB_SPIN_CAP (1u << 18)

__device__ __forceinline__ unsigned xb_ld(unsigned* p)              { return __hip_atomic_load(p, __ATOMIC_RELAXED, __HIP_MEMORY_SCOPE_AGENT); }
__device__ __forceinline__ unsigned xb_add(unsigned* p, unsigned v) { return __hip_atomic_fetch_add(p, v, __ATOMIC_RELAXED, __HIP_MEMORY_SCOPE_AGENT); }
__device__ __forceinline__ unsigned xb_xcc_id() { return (unsigned)__builtin_amdgcn_s_getreg((3 << 11) | 20) & 0xFu; }
#define XB_SPIN(cond, bar) do { unsigned _sp = 0; while (cond) { __builtin_amdgcn_s_sleep(1); \
    if ((++_sp & 255u) == 0u) { if (xb_ld(&(bar)[XB_TMO])) break; if (_sp > XB_SPIN_CAP) { atomicAdd(&(bar)[XB_TMO], 1u); break; } } } } while (0)

struct XcdBarrier {
    unsigned* bar; unsigned x;
    volatile LAS unsigned* st;
};

__device__ __forceinline__ XcdBarrier xcd_barrier_post(unsigned* bar, volatile LAS unsigned* st) {
    XcdBarrier b; b.bar = bar; b.x = xb_xcc_id(); b.st = st;
    if (threadIdx.x == 0) (void)xb_add(&bar[XB_XCNT(b.x)], 1u);
    return b;
}
__device__ __forceinline__ void xcd_barrier_complete(unsigned* bar, unsigned x, unsigned& nloc, unsigned& nx) {
    const unsigned G = gridDim.x * gridDim.y * gridDim.z;
    unsigned sum, cnt, mine, sp = 0u;
    for (;;) {
        sum = 0u; cnt = 0u; mine = 0u;
#pragma unroll
        for (unsigned j = 0; j < 16; ++j) { const unsigned c = xb_ld(&bar[XB_XCNT(j)]); sum += c; cnt += (c > 0u) ? 1u : 0u; mine = (j == x) ? c : mine; }
        if (sum == G) break;
        __builtin_amdgcn_s_sleep(1);
        if ((++sp & 255u) == 0u) { if (xb_ld(&bar[XB_TMO])) break; if (sp > XB_SPIN_CAP) { atomicAdd(&bar[XB_TMO], 1u); break; } }
    }
    nloc = mine > 0u ? mine : 1u; nx = cnt > 0u ? cnt : 1u;
}

__device__ __forceinline__ void xcd_barrier(const XcdBarrier& b) {
    asm volatile("s_waitcnt vmcnt(0)" ::: "memory");
    __syncthreads();
    if (threadIdx.x == 0) {
        unsigned* bar = b.bar;
        __builtin_amdgcn_s_waitcnt(0);
        unsigned nloc = b.st[0], nx = b.st[1];
        if (nloc == 0u) { xcd_barrier_complete(bar, b.x, nloc, nx); b.st[0] = nloc; b.st[1] = nx; }
        const unsigned old = xb_add(&bar[XB_XSUB(b.x)], 1u);
        const unsigned gen = old / nloc;
        if (old + 1u == (gen + 1u) * nloc) {
            __builtin_amdgcn_fence(__ATOMIC_RELEASE, "agent");
            asm volatile("s_waitcnt vmcnt(0)" ::: "memory");
            const unsigned og = xb_add(&bar[XB_TOP], 1u);
            const unsigned tg = og / nx;
            if (og + 1u == (tg + 1u) * nx) xb_add(&bar[XB_TOPGEN], 1u);
            else XB_SPIN(xb_ld(&bar[XB_TOPGEN]) == tg, bar);
            __builtin_amdgcn_fence(__ATOMIC_ACQUIRE, "agent");
            xb_add(&bar[XB_XGEN(b.x)], 1u);
            asm volatile("s_waitcnt vmcnt(0)" ::: "memory");
        } else {
            XB_SPIN(xb_ld(&bar[XB_XGEN(b.x)]) == gen, bar);
            __builtin_amdgcn_fence(__ATOMIC_ACQUIRE, "agent");
            asm volatile("s_waitcnt vmcnt(0)" ::: "memory");
        }
    }
    __syncthreads();
}

__device__ __forceinline__ void rwkv_prep_item(KArgs a, int l, int item, LAS unsigned char* lds, int tid, int lane) {
    unsigned char* ws = a->ws;
    const bf16* U = (const bf16*)(ws + OFF_U); const float* MISC = (const float*)(ws + OFF_MISC);
    const int b = item / 288, j0 = (item % 288) * 8; const bool isctx = j0 < LCTX;
    LAS unsigned* rawrkv = (LAS unsigned*)lds;
    LAS float* rawm = (LAS float*)(lds + 30720);
    LAS float* RP = (LAS float*)(lds + 43520);
    LAS float* KP = RP + 4096; LAS float* VP = KP + 4096;
    LAS float* LA = VP + 4096;
    for (int idx = tid; idx < 10 * 192; idx += NTHR) { const int rr = idx / 192, c8 = idx % 192, jj = j0 - 1 + rr;
        const bool valid = isctx ? (jj >= 0 && jj < LCTX) : (jj >= LCTX && jj < RJ);
        v4u v = (v4u){0u, 0u, 0u, 0u}; if (valid) v = *(const v4u*)(U + (size_t)rwkv_tok(b, jj) * NU + URKV + c8 * 8);
        *(LAS v4u*)(rawrkv + rr * 768 + c8 * 4) = v; }
    for (int idx = tid; idx < 10 * 80; idx += NTHR) { const int rr = idx / 80, c4 = idx % 80, jj = j0 - 1 + rr;
        const bool valid = isctx ? (jj >= 0 && jj < LCTX) : (jj >= LCTX && jj < RJ);
        f32x4 v = (f32x4){0.f, 0.f, 0.f, 0.f}; if (valid) v = *(const f32x4*)(MISC + (size_t)rwkv_tok(b, jj) * 512 + 64 + c4 * 4);
        *(LAS f32x4*)(rawm + rr * 320 + c4 * 4) = v; }
    __syncthreads();
    const float* mu = a->in[I_RMU] + l * 1856;
    for (int idx = tid; idx < 8 * 768; idx += NTHR) { const int i = idx / 768, cp = idx % 768;
        const unsigned p = rawrkv[i * 768 + cp], c = rawrkv[(i + 1) * 768 + cp], n = rawrkv[(i + 2) * 768 + cp];
        float x0 = bflo(c), x1 = bfhi(c);
        x0 = x0 + (0.5f * (bflo(p) + bflo(n)) - x0) * mu[2 * cp]; x1 = x1 + (0.5f * (bfhi(p) + bfhi(n)) - x1) * mu[2 * cp + 1];
        const int ch = 2 * cp, reg = ch >> 9; LAS float* dst = (reg == 0 ? RP : (reg == 1 ? KP : VP)) + i * 512 + (ch & 511);
        *(LAS f32x2*)dst = (f32x2){x0, x1}; }
    for (int idx = tid; idx < 8 * 320; idx += NTHR) { const int i = idx / 320, m = idx % 320;
        float x = rawm[(i + 1) * 320 + m]; const float p = rawm[i * 320 + m], n = rawm[(i + 2) * 320 + m];
        x = x + (0.5f * (p + n) - x) * mu[1536 + m];
        if (m < 128) x = tanhf(x); else if (m >= 192) x = sigmoidf_(x);
        LA[i * 320 + m] = x; }
    __syncthreads();
    const int c = tid, h = tid >> 6;
    float af[8], ab[8], aa[8], ag[8];
#pragma unroll
    for (int i = 0; i < 8; ++i) { af[i] = 0.f; ab[i] = 0.f; aa[i] = 0.f; ag[i] = 0.f; }
    {
        const float* w2f = a->in[I_RW2] + (size_t)((l * 2 + 0) * 64) * 512 + c; const float* w2b = a->in[I_RW2] + (size_t)((l * 2 + 1) * 64) * 512 + c;
        const float* a2p = a->in[I_RA2] + (size_t)(l * 64) * 512 + c; const float* g2p = a->in[I_RG2] + (size_t)(l * 128) * 512 + c;
#pragma unroll 2
        for (int j = 0; j < 64; j += 4) {
            const float f0 = w2f[(j + 0) * 512], f1 = w2f[(j + 1) * 512], f2 = w2f[(j + 2) * 512], f3 = w2f[(j + 3) * 512];
            const float b0 = w2b[(j + 0) * 512], b1 = w2b[(j + 1) * 512], b2 = w2b[(j + 2) * 512], b3 = w2b[(j + 3) * 512];
            const float a0 = a2p[(j + 0) * 512], a1 = a2p[(j + 1) * 512], a2_ = a2p[(j + 2) * 512], a3 = a2p[(j + 3) * 512];
#pragma unroll
            for (int i = 0; i < 8; ++i) { const f32x4 xf = *(const LAS f32x4*)(LA + i * 320 + j), xb = *(const LAS f32x4*)(LA + i * 320 + 64 + j), xa = *(const LAS f32x4*)(LA + i * 320 + 128 + j);
                af[i] += xf.x * f0 + xf.y * f1 + xf.z * f2 + xf.w * f3; ab[i] += xb.x * b0 + xb.y * b1 + xb.z * b2 + xb.w * b3; aa[i] += xa.x * a0 + xa.y * a1 + xa.z * a2_ + xa.w * a3; } }
#pragma unroll 2
        for (int j = 0; j < 128; j += 4) {
            const float g0 = g2p[(j + 0) * 512], g1 = g2p[(j + 1) * 512], g2_ = g2p[(j + 2) * 512], g3 = g2p[(j + 3) * 512];
#pragma unroll
            for (int i = 0; i < 8; ++i) { const f32x4 xg = *(const LAS f32x4*)(LA + i * 320 + 192 + j); ag[i] += xg.x * g0 + xg.y * g1 + xg.z * g2_ + xg.w * g3; } }
    }
    const float w0f = a->in[I_RW0][(l * 2 + 0) * 512 + c], w0b = a->in[I_RW0][(l * 2 + 1) * 512 + c], a0c = a->in[I_RA0][l * 512 + c];
    const float kkc = a->in[I_RKK][l * 512 + c], kac = a->in[I_RKA][l * 512 + c], rkc = a->in[I_RRK][l * 512 + c];
    float* RW = (float*)(ws + OFF_RW); constexpr size_t AS = RW_ARR / 4; float* RSC = (float*)(ws + OFF_RSC);
#pragma unroll
    for (int i = 0; i < 8; ++i) {
        const size_t R = (size_t)b * RJ + j0 + i;
        const float r = RP[i * 512 + c], k = KP[i * 512 + c], v = VP[i * 512 + c];
        const float wf = __expf(-__expf(-softplusf_(-(w0f + af[i])) - 0.5f)), wb = __expf(-__expf(-softplusf_(-(w0b + ab[i])) - 0.5f));
        const float av = sigmoidf_(a0c + aa[i]);
        const float kkv = k * kkc; const float kk = kkv * rsqrtf(wave_sum(kkv * kkv) + 1e-12f);
        const float kmod = k * (1.f + (av - 1.f) * kac), ka = kk * av;
        const float c1 = wave_sum(ka * r), c2 = wave_sum(kmod * r), bon = wave_sum(r * kmod * rkc);
        float* o = RW + R * 512 + c;
        o[0 * AS] = wf; o[1 * AS] = wf * r; o[2 * AS] = wb; o[3 * AS] = wb * r; o[4 * AS] = kmod; o[5 * AS] = -kk; o[6 * AS] = ka; o[7 * AS] = v; o[8 * AS] = ag[i];
        if (lane == 0) { RSC[R * 8 + h] = c1; RSC[(size_t)TT * 8 + R * 8 + h] = c2; RSC[(size_t)2 * TT * 8 + R * 8 + h] = bon; }
    }
    __syncthreads();
}
__device__ __forceinline__ void ssd_prep_item(KArgs a, int l, int item, int tid) {
    unsigned char* ws = a->ws; const bf16* U = (const bf16*)(ws + OFF_U); const float* MISC = (const float*)(ws + OFF_MISC);
    bf16* XBC = (bf16*)(ws + OFF_XBC); float* DTA = (float*)(ws + OFF_DTA);
    const int t0 = item * 16;
    const int seq_lo = t0 < TLAT ? (t0 & ~(LSEQ - 1)) : TLAT + ((t0 - TLAT) & ~(LCTX - 1)), seq_hi = seq_lo + (t0 < TLAT ? LSEQ : LCTX);
    for (int cp = tid; cp < 896; cp += NTHR) {
        float w0[5], w1[5];
#pragma unroll
        for (int j = 0; j < 5; ++j) { const f32x2 w = *(const f32x2*)(a->in[I_SCW] + (size_t)(l * 5 + j) * 1792 + 2 * cp); w0[j] = w.x; w1[j] = w.y; }
        const f32x2 bb = *(const f32x2*)(a->in[I_SCB] + l * 1792 + 2 * cp);
        float i0[20], i1[20];
#pragma unroll
        for (int r = 0; r < 20; ++r) { const int row = t0 - 2 + r; unsigned u = 0u; if (row >= seq_lo && row < seq_hi) u = *(const unsigned*)(U + (size_t)row * NU + UXBC + 2 * cp); i0[r] = bflo(u); i1[r] = bfhi(u); }
#pragma unroll
        for (int o = 0; o < 16; ++o) { float s0 = bb.x, s1 = bb.y;
#pragma unroll
            for (int j = 0; j < 5; ++j) { s0 += w0[j] * i0[o + j]; s1 += w1[j] * i1[o + j]; }
            *(unsigned*)(XBC + (size_t)(t0 + o) * 1792 + 2 * cp) = pk2(siluf_(s0), siluf_(s1)); }
    }
    if (tid < 16 * 24) { const int o = tid / 24, q = tid % 24;
        const float dt = softplusf_(MISC[(size_t)(t0 + o) * 512 + q] + a->in[I_SDTB][l * 24 + q]); const float A = -__expf(a->in[I_SALOG][l * 24 + q]);
        DTA[(size_t)(t0 + o) * 48 + q] = dt; DTA[(size_t)(t0 + o) * 48 + 24 + q] = dt * A; }
}
__device__ __forceinline__ void conv_item(KArgs a, int l, int item, LAS unsigned char* lds, int tid, int lane, int wave) {
    unsigned char* ws = a->ws; const bf16* U = (const bf16*)(ws + OFF_U); bf16* AC = (bf16*)(ws + OFF_ACONV);
    int t0, seg_lo, seg_hi;
    if (item < 256) { t0 = item * 32; seg_lo = t0 & ~63; seg_hi = seg_lo + 64; }
    else { const int ci = item - 256; t0 = TLAT + ci * 32; seg_lo = TLAT + (ci >> 3) * LCTX; seg_hi = seg_lo + LCTX; }
    LAS bf16* inimg = (LAS bf16*)lds;
    LAS float* outimg = (LAS float*)(lds + 63488);
    for (int idx = tid; idx < 62 * 64; idx += NTHR) { const int rr = idx >> 6, c8 = idx & 63, row = t0 - 15 + rr;
        v4u o = (v4u){0u, 0u, 0u, 0u};
        if (row >= seg_lo && row < seg_hi) { const v4u va = *(const v4u*)(U + (size_t)row * NU + UCONV + c8 * 8), vg = *(const v4u*)(U + (size_t)row * NU + UCONV + 512 + c8 * 8);
            o.x = pk2(bflo(va.x) * sigmoidf_(bflo(vg.x)), bfhi(va.x) * sigmoidf_(bfhi(vg.x))); o.y = pk2(bflo(va.y) * sigmoidf_(bflo(vg.y)), bfhi(va.y) * sigmoidf_(bfhi(vg.y)));
            o.z = pk2(bflo(va.z) * sigmoidf_(bflo(vg.z)), bfhi(va.z) * sigmoidf_(bfhi(vg.z))); o.w = pk2(bflo(va.w) * sigmoidf_(bflo(vg.w)), bfhi(va.w) * sigmoidf_(bfhi(vg.w))); }
        *(LAS v4u*)(inimg + rr * 512 + c8 * 8) = o; }
    __syncthreads();
    {
        const int c = tid; float w[31];
#pragma unroll
        for (int j = 0; j < 31; ++j) w[j] = a->in[I_CONVW][(size_t)(l * 31 + j) * 512 + c];
        const float bias = a->in[I_CONVB][l * 512 + c];
#pragma unroll 2
        for (int o = 0; o < 32; ++o) { float s = bias;
#pragma unroll
            for (int j = 0; j < 31; ++j) s += w[j] * bf2f(inimg[(o + j) * 512 + c]);
            outimg[o * 512 + c] = s; }
    }
    __syncthreads();
    {
        const f32x4 g0 = *(const f32x4*)(a->in[I_CLNG] + l * 512 + 8 * lane), g1 = *(const f32x4*)(a->in[I_CLNG] + l * 512 + 8 * lane + 4);
        const f32x4 b0 = *(const f32x4*)(a->in[I_CLNB] + l * 512 + 8 * lane), b1 = *(const f32x4*)(a->in[I_CLNB] + l * 512 + 8 * lane + 4);
#pragma unroll
        for (int q = 0; q < 4; ++q) { const int o = wave * 4 + q;
            f32x4 x0 = *(const LAS f32x4*)(outimg + o * 512 + 8 * lane), x1 = *(const LAS f32x4*)(outimg + o * 512 + 8 * lane + 4);
            const float mean = wave_sum((x0.x + x0.y + x0.z + x0.w) + (x1.x + x1.y + x1.z + x1.w)) * (1.f / 512.f);
            x0 = x0 - mean; x1 = x1 - mean;
            const float var = wave_sum((x0.x * x0.x + x0.y * x0.y + x0.z * x0.z + x0.w * x0.w) + (x1.x * x1.x + x1.y * x1.y + x1.z * x1.z + x1.w * x1.w)) * (1.f / 512.f);
            const float rs = rsqrtf(var + 1e-5f);
            x0 = x0 * rs * g0 + b0; x1 = x1 * rs * g1 + b1;
            v4u ov; ov.x = pk2(siluf_(x0.x), siluf_(x0.y)); ov.y = pk2(siluf_(x0.z), siluf_(x0.w)); ov.z = pk2(siluf_(x1.x), siluf_(x1.y)); ov.w = pk2(siluf_(x1.z), siluf_(x1.w));
            *(v4u*)(AC + (size_t)(t0 + o) * 512 + 8 * lane) = ov; }
    }
    __syncthreads();
}

__device__ __forceinline__ int ssd_tok(int b, int dir, int pos) {
    if (pos < LCTX) return TLAT + b * LCTX + (dir ? (LCTX - 1 - pos) : pos);
    const int q = pos - LCTX; return b * LSEQ + (dir ? (LSEQ - 1 - q) : q);
}
__device__ __forceinline__ void ssd_scan_simple(KArgs a, int idx, int tid) {
    unsigned char* ws = a->ws; const bf16* XBC = (const bf16*)(ws + OFF_XBC); const float* DTA = (const float*)(ws + OFF_DTA);
    const int b = idx / 24, dir = (idx % 24) / 12, h = idx % 12, g = h / 3, p = tid >> 3, n0 = (tid & 7) * 16, q = dir * 12 + h;
    float* Yo = (float*)(ws + OFF_YSSD) + (size_t)dir * TT * 768;
    float hs[16];
#pragma unroll
    for (int i = 0; i < 16; ++i) hs[i] = 0.f;
    for (int pos = 0; pos < RJ; ++pos) {
        const int tok = ssd_tok(b, dir, pos);
        const float dt = DTA[(size_t)tok * 48 + q], dec = __expf(DTA[(size_t)tok * 48 + 24 + q]);
        const bf16* row = XBC + (size_t)tok * 1792;
        const float xd = bf2f(row[h * 64 + p]) * dt;
        const v4u B0 = *(const v4u*)(row + 768 + g * 128 + n0), B1 = *(const v4u*)(row + 768 + g * 128 + n0 + 8);
        const v4u C0 = *(const v4u*)(row + 1280 + g * 128 + n0), C1 = *(const v4u*)(row + 1280 + g * 128 + n0 + 8);
        const float Bv[16] = {bflo(B0.x), bfhi(B0.x), bflo(B0.y), bfhi(B0.y), bflo(B0.z), bfhi(B0.z), bflo(B0.w), bfhi(B0.w), bflo(B1.x), bfhi(B1.x), bflo(B1.y), bfhi(B1.y), bflo(B1.z), bfhi(B1.z), bflo(B1.w), bfhi(B1.w)};
        const float Cv[16] = {bflo(C0.x), bfhi(C0.x), bflo(C0.y), bfhi(C0.y), bflo(C0.z), bfhi(C0.z), bflo(C0.w), bfhi(C0.w), bflo(C1.x), bfhi(C1.x), bflo(C1.y), bfhi(C1.y), bflo(C1.z), bfhi(C1.z), bflo(C1.w), bfhi(C1.w)};
        float yp = 0.f;
#pragma unroll
        for (int i = 0; i < 16; ++i) { hs[i] = hs[i] * dec + xd * Bv[i]; yp += hs[i] * Cv[i]; }
        yp += __shfl_xor(yp, 1); yp += __shfl_xor(yp, 2); yp += __shfl_xor(yp, 4);
        if ((tid & 7) == 0) Yo[(size_t)tok * 768 + h * 64 + p] = yp;
    }
}
__device__ __forceinline__ void rwkv_scan_simple(KArgs a, int idx, int tid) {
    unsigned char* ws = a->ws; const float* RW = (const float*)(ws + OFF_RW); constexpr size_t AS = RW_ARR / 4; const float* RSC = (const float*)(ws + OFF_RSC);
    const int b = idx / 16, dir = (idx % 16) / 8, h = idx % 8, v = tid >> 3, k0 = (tid & 7) * 8;
    float* Yo = (float*)(ws + OFF_YRW) + (size_t)dir * TT * 512;
    const float* Wd = RW + (dir ? 2 : 0) * AS; const float* WRd = RW + (dir ? 3 : 1) * AS;
    float S[8];
#pragma unroll
    for (int i = 0; i < 8; ++i) S[i] = 0.f;
    for (int pos = 0; pos < RJ; ++pos) {
        const int j = dir ? (pos < LCTX ? (LCTX - 1 - pos) : (RJ + LCTX - 1 - pos)) : pos;
        const size_t R = (size_t)b * RJ + j; const size_t o = R * 512 + h * 64 + k0;
        const f32x4 w0 = *(const f32x4*)(Wd + o), w1 = *(const f32x4*)(Wd + o + 4), r0 = *(const f32x4*)(WRd + o), r1 = *(const f32x4*)(WRd + o + 4);
        const f32x4 kA = *(const f32x4*)(RW + 4 * AS + o), kB = *(const f32x4*)(RW + 4 * AS + o + 4), nA = *(const f32x4*)(RW + 5 * AS + o), nB = *(const f32x4*)(RW + 5 * AS + o + 4);
        const f32x4 aA = *(const f32x4*)(RW + 6 * AS + o), aB = *(const f32x4*)(RW + 6 * AS + o + 4);
        const float vv = RW[7 * AS + R * 512 + h * 64 + v], c1 = RSC[R * 8 + h], c2 = RSC[(size_t)TT * 8 + R * 8 + h];
        const float w[8] = {w0.x, w0.y, w0.z, w0.w, w1.x, w1.y, w1.z, w1.w}, wr[8] = {r0.x, r0.y, r0.z, r0.w, r1.x, r1.y, r1.z, r1.w};
        const float kk_[8] = {kA.x, kA.y, kA.z, kA.w, kB.x, kB.y, kB.z, kB.w}, kn[8] = {nA.x, nA.y, nA.z, nA.w, nB.x, nB.y, nB.z, nB.w}, ka[8] = {aA.x, aA.y, aA.z, aA.w, aB.x, aB.y, aB.z, aB.w};
        float sa = 0.f, pp = 0.f;
#pragma unroll
        for (int i = 0; i < 8; ++i) { sa += S[i] * kn[i]; pp += S[i] * wr[i]; }
        sa += __shfl_xor(sa, 1); pp += __shfl_xor(pp, 1); sa += __shfl_xor(sa, 2); pp += __shfl_xor(pp, 2); sa += __shfl_xor(sa, 4); pp += __shfl_xor(pp, 4);
#pragma unroll
        for (int i = 0; i < 8; ++i) S[i] = S[i] * w[i] + sa * ka[i] + vv * kk_[i];
        if ((tid & 7) == 0) Yo[R * 512 + h * 64 + v] = pp + sa * c1 + vv * c2;
    }
}

__device__ __forceinline__ void post_phase(KArgs a, int l, int bid, int G) {
    PH_IDS
    unsigned char* ws = a->ws; const int gw = bid * NWAVES + wave, NGW = G * NWAVES;
    const bf16* U = (const bf16*)(ws + OFF_U); const bf16* XBC = (const bf16*)(ws + OFF_XBC);
    const float* Y0 = (const float*)(ws + OFF_YSSD); const float* Y1 = Y0 + (size_t)TT * 768; bf16* AS_ = (bf16*)(ws + OFF_ASSD);
    for (int row = gw; row < TT; row += NGW) {
        f32x4 y[3]; float ss = 0.f;
#pragma unroll
        for (int j = 0; j < 3; ++j) { const int col = 4 * lane + 256 * j; const float dsk = a->in[I_SD][l * 12 + (col >> 6)];
            const f32x4 yf = *(const f32x4*)(Y0 + (size_t)row * 768 + col), yb = *(const f32x4*)(Y1 + (size_t)row * 768 + col);
            const v2u xs = *(const v2u*)(XBC + (size_t)row * 1792 + col), z = *(const v2u*)(U + (size_t)row * NU + UZ + col);
            f32x4 v = yf + yb + dsk * (f32x4){bflo(xs.x), bfhi(xs.x), bflo(xs.y), bfhi(xs.y)};
            v = v * (f32x4){siluf_(bflo(z.x)), siluf_(bfhi(z.x)), siluf_(bflo(z.y)), siluf_(bfhi(z.y))};
            y[j] = v; ss += (v.x * v.x + v.y * v.y) + (v.z * v.z + v.w * v.w); }
        const float r = rsqrtf(wave_sum(ss) * (1.f / 768.f) + 1e-6f);
#pragma unroll
        for (int j = 0; j < 3; ++j) { const int col = 4 * lane + 256 * j; const f32x4 g = *(const f32x4*)(a->in[I_SNG] + l * 768 + col); const f32x4 o = y[j] * r * g;
            *(v2u*)(AS_ + (size_t)row * 768 + col) = (v2u){pk2(o.x, o.y), pk2(o.z, o.w)}; }
    }
    const float* RW = (const float*)(ws + OFF_RW); constexpr size_t AS = RW_ARR / 4; const float* RSC = (const float*)(ws + OFF_RSC);
    const float* R0 = (const float*)(ws + OFF_YRW); const float* R1 = R0 + (size_t)TT * 512; bf16* AR = (bf16*)(ws + OFF_ARWKV);
    for (int row = gw; row < TT; row += NGW) {
        size_t R;
        if (row < TLAT) { const int b = row >> 11, t = row & 2047, rr = t >> 6, cc = t & 63; R = (size_t)b * RJ + LCTX + cc * 32 + rr; }
        else { const int b = (row - TLAT) >> 8, jj = (row - TLAT) & 255; R = (size_t)b * RJ + jj; }
        const int c0 = 8 * lane, h = lane >> 3;
        f32x4 ya = *(const f32x4*)(R0 + R * 512 + c0) + *(const f32x4*)(R1 + R * 512 + c0), yb = *(const f32x4*)(R0 + R * 512 + c0 + 4) + *(const f32x4*)(R1 + R * 512 + c0 + 4);
        float s = (ya.x + ya.y + ya.z + ya.w) + (yb.x + yb.y + yb.z + yb.w);
        s += __shfl_xor(s, 1); s += __shfl_xor(s, 2); s += __shfl_xor(s, 4);
        const float mean = s * (1.f / 64.f); ya = ya - mean; yb = yb - mean;
        float q = (ya.x * ya.x + ya.y * ya.y + ya.z * ya.z + ya.w * ya.w) + (yb.x * yb.x + yb.y * yb.y + yb.z * yb.z + yb.w * yb.w);
        q += __shfl_xor(q, 1); q += __shfl_xor(q, 2); q += __shfl_xor(q, 4);
        const float rs = rsqrtf(q * (1.f / 64.f) + 64e-5f);
        const f32x4 lg0 = *(const f32x4*)(a->in[I_RLNG] + l * 512 + c0), lg1 = *(const f32x4*)(a->in[I_RLNG] + l * 512 + c0 + 4), lb0 = *(const f32x4*)(a->in[I_RLNB] + l * 512 + c0), lb1 = *(const f32x4*)(a->in[I_RLNB] + l * 512 + c0 + 4);
        const float bon = RSC[(size_t)2 * TT * 8 + R * 8 + h];
        const f32x4 v0 = *(const f32x4*)(RW + 7 * AS + R * 512 + c0), v1 = *(const f32x4*)(RW + 7 * AS + R * 512 + c0 + 4), g0 = *(const f32x4*)(RW + 8 * AS + R * 512 + c0), g1 = *(const f32x4*)(RW + 8 * AS + R * 512 + c0 + 4);
        const f32x4 o0 = (ya * rs * lg0 + lb0 + bon * v0) * g0, o1 = (yb * rs * lg1 + lb1 + bon * v1) * g1;
        *(v4u*)(AR + (size_t)row * 512 + c0) = (v4u){pk2(o0.x, o0.y), pk2(o0.z, o0.w), pk2(o1.x, o1.y), pk2(o1.z, o1.w)};
    }
}

template <int CTRL> __device__ __forceinline__ float dpp_add(float x) { return x + __int_as_float(__builtin_amdgcn_update_dpp(0, __float_as_int(x), CTRL, 0xf, 0xf, true)); }
__device__ __forceinline__ size_t rwkv_row(int b, int dir, int pos) { const int j = dir ? (pos < LCTX ? (LCTX - 1 - pos) : (RJ + LCTX - 1 - pos)) : pos; return (size_t)b * RJ + j; }
constexpr int RWS_BUF = 45568, RWS_V = 40960, RWS_C = 45056, RWS_CH = 32;
__device__ __forceinline__ void rwkv_scan_fast(KArgs a, int idx, LAS unsigned char* lds, int tid, int lane, int wave) {
    unsigned char* ws = a->ws; const float* RW = (const float*)(ws + OFF_RW); constexpr size_t AS = RW_ARR / 4; const float* RSC = (const float*)(ws + OFF_RSC);
    const int combo = idx >> 1, half = idx & 1, b = combo >> 4, dir = (combo >> 3) & 1, h = combo & 7, v0 = half * 32;
    float* Yo = (float*)(ws + OFF_YRW) + (size_t)dir * TT * 512;
    const float* arr0 = RW + (dir ? 2 : 0) * AS; const float* arr1 = RW + (dir ? 3 : 1) * AS;
    const int ls = tid >> 4, lc4 = tid & 15;
    f32x4 pre[5]; f32x4 prev = (f32x4){0.f, 0.f, 0.f, 0.f}; float prec = 0.f;
    auto issue = [&](int chunk) {
        const size_t R = rwkv_row(b, dir, chunk * RWS_CH + ls); const size_t o = R * 512 + h * 64 + lc4 * 4;
        pre[0] = *(const f32x4*)(arr0 + o); pre[1] = *(const f32x4*)(arr1 + o); pre[2] = *(const f32x4*)(RW + 4 * AS + o); pre[3] = *(const f32x4*)(RW + 5 * AS + o); pre[4] = *(const f32x4*)(RW + 6 * AS + o);
        if (tid < 256) { const size_t R2 = rwkv_row(b, dir, chunk * RWS_CH + (tid >> 3)); prev = *(const f32x4*)(RW + 7 * AS + R2 * 512 + h * 64 + v0 + (tid & 7) * 4); }
        else if (tid < 320) { const int t2 = tid - 256; const size_t R2 = rwkv_row(b, dir, chunk * RWS_CH + (t2 >> 1)); prec = RSC[(size_t)(t2 & 1) * TT * 8 + R2 * 8 + h]; }
    };
    auto commit = [&](int buf) {
        LAS unsigned char* B = lds + buf * RWS_BUF;
#pragma unroll
        for (int i = 0; i < 5; ++i) *(LAS f32x4*)(B + i * 8192 + ls * 256 + lc4 * 16) = pre[i];
        if (tid < 256) *(LAS f32x4*)(B + RWS_V + (tid >> 3) * 128 + (tid & 7) * 16) = prev;
        else if (tid < 320) *(LAS float*)(B + RWS_C + (tid - 256) * 4) = prec;
    };
    f32x4 S0 = (f32x4){0.f, 0.f, 0.f, 0.f}, S1 = S0;
    const int rl = wave * 8 + (lane >> 3), q = lane & 7;
    issue(0); commit(0); __syncthreads();
    constexpr int NCH = RJ / RWS_CH;
    for (int ch = 0; ch < NCH; ++ch) {
        if (ch + 1 < NCH) issue(ch + 1);
        if (wave < 4) {
            const LAS unsigned char* B = lds + (ch & 1) * RWS_BUF;
#pragma unroll 4
            for (int s = 0; s < RWS_CH; ++s) {
                const LAS unsigned char* p = B + s * 256 + q * 32;
                const f32x4 w0 = *(const LAS f32x4*)(p), w1 = *(const LAS f32x4*)(p + 16), r0 = *(const LAS f32x4*)(p + 8192), r1 = *(const LAS f32x4*)(p + 8192 + 16);
                const f32x4 k0 = *(const LAS f32x4*)(p + 16384), k1 = *(const LAS f32x4*)(p + 16384 + 16), n0 = *(const LAS f32x4*)(p + 24576), n1 = *(const LAS f32x4*)(p + 24576 + 16);
                const f32x4 a0 = *(const LAS f32x4*)(p + 32768), a1 = *(const LAS f32x4*)(p + 32768 + 16);
                const float vv = *(const LAS float*)(B + RWS_V + s * 128 + rl * 4); const f32x2 cc = *(const LAS f32x2*)(B + RWS_C + s * 8);
                const f32x4 t0 = S0 * n0 + S1 * n1, t1 = S0 * r0 + S1 * r1;
                float sa = (t0.x + t0.y) + (t0.z + t0.w), pp = (t1.x + t1.y) + (t1.z + t1.w);
                sa = dpp_add<0xB1>(sa); pp = dpp_add<0xB1>(pp); sa = dpp_add<0x4E>(sa); pp = dpp_add<0x4E>(pp); sa = dpp_add<0x141>(sa); pp = dpp_add<0x141>(pp);
                S0 = S0 * w0 + (sa * a0 + vv * k0); S1 = S1 * w1 + (sa * a1 + vv * k1);
                if (q == 0) { const size_t R = rwkv_row(b, dir, ch * RWS_CH + s); Yo[R * 512 + h * 64 + v0 + rl] = pp + sa * cc.x + vv * cc.y; }
            }
        }
        if (ch + 1 < NCH) commit((ch + 1) & 1);
        __syncthreads();
    }
}

typedef short bf16x8 __attribute__((ext_vector_type(8)));
constexpr int SS_CM = 0, SS_BM = 17408, SS_BST = 34816, SS_XT = 53248, SS_MX = 62464, SS_HB = 71680, SS_CS = 89088, SS_DT = 89344;
__device__ __forceinline__ float bfe(const v4u& v, int i) { const unsigned u = (i < 2) ? v.x : (i < 4) ? v.y : (i < 6) ? v.z : v.w; return (i & 1) ? bfhi(u) : bflo(u); }
__device__ __forceinline__ unsigned short bfraw(const v4u& v, int i) { const unsigned u = (i < 2) ? v.x : (i < 4) ? v.y : (i < 6) ? v.z : v.w; return (unsigned short)((i & 1) ? (u >> 16) : (u & 0xffffu)); }
__device__ __forceinline__ void ssd_scan_fast(KArgs a, int idx, LAS unsigned char* lds, int tid, int lane, int wave) {
    unsigned char* ws = a->ws; const bf16* XBC = (const bf16*)(ws + OFF_XBC); const float* DTA = (const float*)(ws + OFF_DTA);
    const int b = idx / 24, dir = (idx % 24) / 12, h = idx % 12, g = h / 3, q = dir * 12 + h;
    float* Yo = (float*)(ws + OFF_YSSD) + (size_t)dir * TT * 768;
    LAS bf16* Cm = (LAS bf16*)(lds + SS_CM); LAS bf16* Bm = (LAS bf16*)(lds + SS_BM); LAS bf16* BsT = (LAS bf16*)(lds + SS_BST); LAS bf16* XT = (LAS bf16*)(lds + SS_XT);
    LAS bf16* Mx = (LAS bf16*)(lds + SS_MX); LAS bf16* Hb = (LAS bf16*)(lds + SS_HB); LAS float* CS = (LAS float*)(lds + SS_CS); LAS float* DTV = (LAS float*)(lds + SS_DT);
    const int fr = lane & 15, fq = lane >> 4, ss = tid & 63, sc = tid >> 6, tl = wave >> 1, wh = wave & 1;
    { unsigned z = 0u; asm volatile("" : "+v"(z)); for (int i = tid; i < 17408 / 16; i += NTHR) *(LAS v4u*)(lds + SS_HB + i * 16) = (v4u){z, z, z, z}; }
    f32x4 hacc[4];
#pragma unroll
    for (int j = 0; j < 4; ++j) hacc[j] = (f32x4){0.f, 0.f, 0.f, 0.f};
    v4u pc0, pc1, pb0, pb1, px; float pdt = 0.f, pa = 0.f;
    auto issue = [&](int ch) {
        const int tok = ssd_tok(b, dir, ch * 64 + ss); const bf16* row = XBC + (size_t)tok * 1792;
        pc0 = *(const v4u*)(row + 1280 + g * 128 + sc * 8); pc1 = *(const v4u*)(row + 1280 + g * 128 + (sc + 8) * 8);
        pb0 = *(const v4u*)(row + 768 + g * 128 + sc * 8); pb1 = *(const v4u*)(row + 768 + g * 128 + (sc + 8) * 8);
        px = *(const v4u*)(row + h * 64 + sc * 8);
        if (tid < 64) { pdt = DTA[(size_t)tok * 48 + q]; pa = DTA[(size_t)tok * 48 + 24 + q]; }
    };
    issue(0);
    for (int ch = 0; ch < RJ / 64; ++ch) {
        *(LAS v4u*)(Cm + ss * 136 + sc * 8) = pc0; *(LAS v4u*)(Cm + ss * 136 + (sc + 8) * 8) = pc1;
        *(LAS v4u*)(Bm + ss * 136 + sc * 8) = pb0; *(LAS v4u*)(Bm + ss * 136 + (sc + 8) * 8) = pb1;
#pragma unroll
        for (int i = 0; i < 8; ++i) XT[(sc * 8 + i) * 72 + ss] = bfraw(px, i);
        if (tid < 64) { float x = pa;
#pragma unroll
            for (int o = 1; o < 64; o <<= 1) { const float t = __shfl_up(x, o); if (lane >= o) x += t; }
            CS[tid] = x; DTV[tid] = pdt; }
        __syncthreads();
        const float cl = CS[63];
        { const float scl = DTV[ss] * __expf(cl - CS[ss]);
#pragma unroll
            for (int i = 0; i < 8; ++i) { BsT[(sc * 8 + i) * 72 + ss] = (bf16)f2bf(bfe(pb0, i) * scl); BsT[((sc + 8) * 8 + i) * 72 + ss] = (bf16)f2bf(bfe(pb1, i) * scl); } }
        if (ch + 1 < RJ / 64) issue(ch + 1);
#pragma unroll
        for (int j = 0; j < 2; ++j) { const int tc = wh * 2 + j; f32x4 acc = (f32x4){0.f, 0.f, 0.f, 0.f};
            if (tc <= tl) {
#pragma unroll
                for (int ks = 0; ks < 4; ++ks) { const bf16x8 af = *(const LAS bf16x8*)(Cm + (16 * tl + fr) * 136 + ks * 32 + fq * 8), bf = *(const LAS bf16x8*)(Bm + (16 * tc + fr) * 136 + ks * 32 + fq * 8);
                    acc = __builtin_amdgcn_mfma_f32_16x16x32_bf16(af, bf, acc, 0, 0, 0); } }
            const int s = 16 * tc + fr; const float css = CS[s], dts = DTV[s];
#pragma unroll
            for (int i = 0; i < 4; ++i) { const int l = 16 * tl + 4 * fq + i; const float v = (s <= l) ? acc[i] * __expf(CS[l] - css) * dts : 0.f; Mx[l * 72 + s] = (bf16)f2bf(v); } }
        __syncthreads();
#pragma unroll
        for (int j = 0; j < 2; ++j) { const int tp = wh * 2 + j; f32x4 acc = (f32x4){0.f, 0.f, 0.f, 0.f};
#pragma unroll
            for (int ks = 0; ks < 4; ++ks) { const bf16x8 af = *(const LAS bf16x8*)(Cm + (16 * tl + fr) * 136 + ks * 32 + fq * 8), bf = *(const LAS bf16x8*)(Hb + (16 * tp + fr) * 136 + ks * 32 + fq * 8);
                acc = __builtin_amdgcn_mfma_f32_16x16x32_bf16(af, bf, acc, 0, 0, 0); }
#pragma unroll
            for (int i = 0; i < 4; ++i) acc[i] *= __expf(CS[16 * tl + 4 * fq + i]);
#pragma unroll
            for (int ks = 0; ks < 2; ++ks) { const bf16x8 af = *(const LAS bf16x8*)(Mx + (16 * tl + fr) * 72 + ks * 32 + fq * 8), bf = *(const LAS bf16x8*)(XT + (16 * tp + fr) * 72 + ks * 32 + fq * 8);
                acc = __builtin_amdgcn_mfma_f32_16x16x32_bf16(af, bf, acc, 0, 0, 0); }
#pragma unroll
            for (int i = 0; i < 4; ++i) { const int tok = ssd_tok(b, dir, ch * 64 + 16 * tl + 4 * fq + i); Yo[(size_t)tok * 768 + h * 64 + 16 * tp + fr] = acc[i]; } }
        { const float ecl = __expf(cl);
#pragma unroll
            for (int j = 0; j < 4; ++j) { const int tn = wh * 4 + j; hacc[j] = hacc[j] * ecl;
#pragma unroll
                for (int ks = 0; ks < 2; ++ks) { const bf16x8 af = *(const LAS bf16x8*)(XT + (16 * tl + fr) * 72 + ks * 32 + fq * 8), bf = *(const LAS bf16x8*)(BsT + (16 * tn + fr) * 72 + ks * 32 + fq * 8);
                    hacc[j] = __builtin_amdgcn_mfma_f32_16x16x32_bf16(af, bf, hacc[j], 0, 0, 0); } } }
        __syncthreads();
#pragma unroll
        for (int j = 0; j < 4; ++j) { const int tn = wh * 4 + j;
#pragma unroll
            for (int i = 0; i < 4; ++i) Hb[(16 * tl + 4 * fq + i) * 136 + 16 * tn + fr] = (bf16)f2bf(hacc[j][i]); }
    }
}

constexpr int NPH = 2 + 10 * DEPTH;
#ifndef MK_ONE_LAUNCH
#define MK_ONE_LAUNCH 1
#endif

__global__ void __launch_bounds__(NTHR, 2) fwd(Args a_unused) {
    extern __shared__ __attribute__((aligned(16))) unsigned char lds_raw[];
    LAS unsigned char* lds = (LAS unsigned char*)lds_raw;
    const int bid0 = blockIdx.x, G0 = gridDim.x;
#define PH_BG int bid = bid0, G = G0; asm volatile("" : "+s"(bid), "+s"(G));
    volatile LAS unsigned* MISCW = (volatile LAS unsigned*)(lds + MISC_OFF);
    if (threadIdx.x < 32) MISCW[threadIdx.x] = 0u;
    __syncthreads();
    const int ph_lo = kargs()->ph_lo, ph_hi = kargs()->ph_hi;
    const bool multi = (ph_hi - ph_lo) > 1;
    XcdBarrier bar; bar.bar = (unsigned*)(kargs()->ws + OFF_CTL) + CW_BAR; bar.x = 0; bar.st = nullptr;
    if (multi) bar = xcd_barrier_post((unsigned*)(kargs()->ws + OFF_CTL) + CW_BAR, MISCW + 8);
#define IN(k) (ph_lo <= (k) && (k) < ph_hi)
#define SEAM(k) do { if (IN(k) && IN((k) + 1)) xcd_barrier(bar); } while (0)

    if (IN(0)) { PH_BG p0_prologue(kargs(), lds, bid, G); }
    SEAM(0);
    if (IN(1)) { PH_BG KArgs a = kargs(); norm_phase(a, 0, nullptr, a->in[I_NORMG] + 0, nullptr, (const float*)(a->ws + OFF_MODV), bid, G); }
    SEAM(1);

    for (int l = 0; l < DEPTH; ++l) {
        const int pb = 2 + 10 * l;
#define PH_LOCALS PH_BG KArgs a = kargs(); unsigned char* ws = a->ws; unsigned char* wl = ws + OFF_W + (size_t)l * W_LAYER; bf16* Hb = (bf16*)(ws + OFF_H); (void)wl; (void)Hb; \
        const float* ng = a->in[I_NORMG] + (size_t)l * 4 * DM; const float* mv = (const float*)(ws + OFF_MODV) + (size_t)l * 5 * 12288; (void)ng; (void)mv;
        if (IN(pb + 0)) { PH_LOCALS
            __syncthreads();
            { pg8::Gemm g{Hb, (const bf16*)(wl + WO_IN), TT, NU, DM}; pg8::StaticOrder S; S.init(TT, NU, G, bid);
              pg8::EpiInproj E{(bf16*)(ws + OFF_U), (float*)(ws + OFF_MISC), NU};
              pg8::gemm_phase<pg8::EpiInproj, pg8::StaticOrder, true, true>(lds, g, S, E); }
            { pg8::Gemm g{(const bf16*)(wl + WO_FFT), Hb, 1024, TT, DM}; pg8::StaticOrder S; S.init(1024, TT, G, bid);
              pg8::EpiBf E{0, (bf16*)(ws + OFF_VTL), (bf16*)(ws + OFF_VTC)};
              pg8::gemm_phase<pg8::EpiBf, pg8::StaticOrder, true, true>(lds, g, S, E); }
        }
        SEAM(pb + 0);
        if (IN(pb + 1)) { PH_LOCALS PH_IDS
            __syncthreads();
            for (int it = bid; it < NBATCH * 288; it += G) rwkv_prep_item(a, l, it, lds, tid, lane);
            for (int it = (bid + 128) % G; it < TT / 16; it += G) ssd_prep_item(a, l, it, tid);
            __syncthreads();
            for (int it = (bid + 192) % G; it < 288; it += G) conv_item(a, l, it, lds, tid, lane, wave);
        }
        SEAM(pb + 1);
        if (IN(pb + 2)) { PH_LOCALS PH_IDS
            __syncthreads();
            if (bid < 128) rwkv_scan_fast(a, bid, lds, tid, lane, wave);
            else if (bid < 224) ssd_scan_fast(a, bid - 128, lds, tid, lane, wave);
            else {
                { pg8::Gemm g{(const bf16*)(ws + OFF_DFTL), (const bf16*)(ws + OFF_VTL), 2048, 2048, 4096}; pg8::StaticOrder S; S.init(2048, 2048, G - 224, bid - 224);
                  pg8::EpiBf E{1, (bf16*)(ws + OFF_AFFT), nullptr};
                  pg8::gemm_phase<pg8::EpiBf, pg8::StaticOrder, true, true>(lds, g, S, E); }
                { pg8::Gemm g{(const bf16*)(ws + OFF_DFTC), (const bf16*)(ws + OFF_VTC), 256, 2048, 512}; pg8::StaticOrder S; S.init(256, 2048, G - 224, bid - 224);
                  pg8::EpiBf E{2, (bf16*)(ws + OFF_AFFT), nullptr};
                  pg8::gemm_phase<pg8::EpiBf, pg8::StaticOrder, true, true>(lds, g, S, E); }
            }
        }
        SEAM(pb + 2);
        if (IN(pb + 3)) { PH_BG post_phase(kargs(), l, bid, G); }
        SEAM(pb + 3);
        if (IN(pb + 4)) { PH_LOCALS
            __syncthreads();
            const bf16* Gt = (const bf16*)(ws + OFF_U) + UGATE; float* MB = (float*)(ws + OFF_MBUF); bf16* Mo = (bf16*)(ws + OFF_M);
            pg8::StaticOrder S; S.init(TT, DM, G, bid);
            { pg8::Gemm g{(const bf16*)(ws + OFF_ACONV), (const bf16*)(wl + WO_CO), TT, DM, 512}; pg8::EpiMerge E{Gt + 0 * DM, NU, MB, Mo, 0}; pg8::gemm_phase<pg8::EpiMerge, pg8::StaticOrder, true, true>(lds, g, S, E); }
            { pg8::Gemm g{(const bf16*)(ws + OFF_ASSD), (const bf16*)(wl + WO_SO), TT, DM, 768}; pg8::EpiMerge E{Gt + 1 * DM, NU, MB, Mo, 1}; pg8::gemm_phase<pg8::EpiMerge, pg8::StaticOrder, true, true>(lds, g, S, E); }
            { pg8::Gemm g{(const bf16*)(ws + OFF_AFFT), (const bf16*)(wl + WO_FO), TT, DM, 512}; pg8::EpiMerge E{Gt + 2 * DM, NU, MB, Mo, 2}; pg8::gemm_phase<pg8::EpiMerge, pg8::StaticOrder, true, true>(lds, g, S, E); }
            { pg8::Gemm g{(const bf16*)(ws + OFF_ARWKV), (const bf16*)(wl + WO_RO), TT, DM, 512}; pg8::EpiMerge E{Gt + 3 * DM, NU, MB, Mo, 3}; pg8::gemm_phase<pg8::EpiMerge, pg8::StaticOrder, true, true>(lds, g, S, E); }
        }
        SEAM(pb + 4);
        if (IN(pb + 5)) { PH_LOCALS
            __syncthreads();
            pg8::Gemm g{(const bf16*)(ws + OFF_M), (const bf16*)(wl + WO_O), TT, DM, DM}; pg8::StaticOrder S; S.init(TT, DM, G, bid);
            pg8::EpiF32 E{(float*)(ws + OFF_Y), DM};
            pg8::gemm_phase<pg8::EpiF32, pg8::StaticOrder, true, true>(lds, g, S, E);
        }
        SEAM(pb + 5);
        if (IN(pb + 6)) { PH_LOCALS norm_phase(a, 1, ng + 1 * DM, ng + 2 * DM, mv + 2 * DM, mv + 3 * DM, bid, G); }
        SEAM(pb + 6);
        if (IN(pb + 7)) { PH_LOCALS
            __syncthreads();
            pg8::Gemm g{Hb, (const bf16*)(wl + WO_UP), TT, DFF, DM}; pg8::StaticOrder S; S.init(TT, DFF, G, bid);
            pg8::EpiBf E{3, (bf16*)(ws + OFF_HB), nullptr};
            pg8::gemm_phase<pg8::EpiBf, pg8::StaticOrder, true, true>(lds, g, S, E);
        }
        SEAM(pb + 7);
        if (IN(pb + 8)) { PH_LOCALS
            __syncthreads();
            pg8::Gemm g{(const bf16*)(ws + OFF_HB), (const bf16*)(wl + WO_DN), TT, DM, DFF}; pg8::StaticOrder S; S.init(TT, DM, G, bid);
            pg8::EpiF32 E{(float*)(ws + OFF_Y), DM};
            pg8::gemm_phase<pg8::EpiF32, pg8::StaticOrder, true, true>(lds, g, S, E);
        }
        SEAM(pb + 8);
        if (IN(pb + 9)) { PH_LOCALS
            if (l < DEPTH - 1) norm_phase(a, 1, ng + 3 * DM, ng + 4 * DM  , mv + 5 * DM, mv + 5 * 12288  , bid, G);
            else norm_phase(a, 2, ng + 3 * DM, nullptr, mv + 5 * DM, nullptr, bid, G);
        }
        SEAM(pb + 9);
    }
#undef IN
#undef SEAM
}

extern "C" void kernel_launch(void* const* d_in, const int* in_sizes, int n_in, void* d_out, int out_size, void* d_ws, size_t ws_size, hipStream_t stream) {
    static int grid = 0;
    if (grid == 0) {
        if (n_in != N_IN || out_size != TLAT * DM || ws_size < WS_END) { fprintf(stderr, "kernel_launch: unexpected shapes (n_in %d out %d ws %zu); nothing launched\n", n_in, out_size, ws_size); grid = -1; return; }
        int dev = 0, cus = 0;
        if (hipGetDevice(&dev) != hipSuccess || hipDeviceGetAttribute(&cus, hipDeviceAttributeMultiprocessorCount, dev) != hipSuccess) { grid = -1; return; }
        if (hipFuncSetAttribute((const void*)fwd, hipFuncAttributeMaxDynamicSharedMemorySize, LDS_BYTES) != hipSuccess) { fprintf(stderr, "kernel_launch: hipFuncSetAttribute failed\n"); grid = -1; return; }
        int per_cu = 0;
        if (hipOccupancyMaxActiveBlocksPerMultiprocessor(&per_cu, (const void*)fwd, NTHR, LDS_BYTES) != hipSuccess || per_cu < 1) fprintf(stderr, "kernel_launch: occupancy query says %d\n", per_cu);
        (void)hipGetLastError();
        grid = cus;
        if (grid < 232) { fprintf(stderr, "kernel_launch: %d CUs: this kernel's scan phase needs > 160 workgroups\n", grid); grid = -1; return; }
    }
    if (grid < 0) return;
    if (hipMemsetAsync((char*)d_ws + OFF_CTL, 0, CTL_BYTES, stream) != hipSuccess) return;
    Args a{};
    for (int i = 0; i < N_IN; ++i) a.in[i] = (const float*)d_in[i];
    a.out = (float*)d_out; a.ws = (unsigned char*)d_ws;
#if MK_ONE_LAUNCH
    a.ph_lo = 0; a.ph_hi = NPH;
    hipLaunchKernelGGL(fwd, dim3(grid), dim3(NTHR), LDS_BYTES, stream, a);
#else
    for (int p = 0; p < NPH; ++p) { a.ph_lo = p; a.ph_hi = p + 1; hipLaunchKernelGGL(fwd, dim3(grid), dim3(NTHR), LDS_BYTES, stream, a); }
#endif
}
```

```cpp
#include <hip/hip_runtime.h>
#include <cstdio>
#include <cstdint>
namespace pg8 {
#define PG8_LAS __attribute__((address_space(3)))
typedef unsigned short bf16_t;
typedef short bf16x8 __attribute__((ext_vector_type(8)));
typedef float f32x4 __attribute__((ext_vector_type(4)));
typedef unsigned u32x4 __attribute__((ext_vector_type(4)));
constexpr int BM = 256, BK = 64, HALF = 128, HTB = HALF * BK * 2  , STAGE_BYTES = 8 * HTB, NXCD = 8, WGM = 8;

__host__ __device__ __forceinline__ int lds_byte(int r, int c) { const int st = (r >> 4) * 2 + (c >> 5), rr = r & 15, cc = c & 31, ob = rr * 64 + cc * 2; return st * 1024 + (ob ^ (((ob >> 9) & 1) << 5)); }
__host__ __device__ __forceinline__ void stage_rc(int b, int& R, int& C) { const int st = b / 1024, sb = b % 1024, swz = sb ^ (((sb >> 9) & 1) << 5); R = (st >> 1) * 16 + swz / 64; C = (st & 1) * 32 + (swz % 64) / 2; }
__host__ __device__ __forceinline__ int perm32(int rho) { const int n = rho >> 4, i = rho & 15; return 8 * (i >> 2) + 4 * n + (i & 3); }

struct Unit { int pm, pn; };
struct Gemm { const bf16_t* A; const bf16_t* Bt; int M, N, K; };

struct StaticOrder {
    int nM, nN, nwg, G, c;
    __host__ __device__ void init(int M, int N, int G_, int c_) { nM = M / BM; nN = N / BM; nwg = nM * nN; G = G_; c = c_; }
    __host__ __device__ bool next(int i, Unit& u) const {
        const long L = (long)i * G + c; if (L >= nwg) return false;
        int wgid = (int)L; { const int q = nwg / NXCD, r = nwg % NXCD, xcd = wgid % NXCD, off = wgid / NXCD; wgid = (xcd < r ? xcd * (q + 1) : r * (q + 1) + (xcd - r) * q) + off; }
        const int nig = WGM * nN, gid = wgid / nig, fm = gid * WGM, gsz = (nM - fm) < WGM ? (nM - fm) : WGM;
        u.pm = fm + ((wgid % nig) % gsz); u.pn = (wgid % nig) / gsz; return true;
    }
    __device__ __forceinline__ void a_ready(const Unit&) const {}
    __device__ __forceinline__ void done(const Unit&) const {}
};
__device__ __forceinline__ unsigned cvt_pk_bf16(float lo, float hi) { unsigned r; asm volatile("v_cvt_pk_bf16_f32 %0, %1, %2" : "=v"(r) : "v"(lo), "v"(hi)); return r; }
typedef float f32x2 __attribute__((ext_vector_type(2)));
template <class Epi, class Sched, bool ALIGN_EPI = false, bool SP2 = false>
__device__ __forceinline__ void gemm_phase(PG8_LAS unsigned char* lds, const Gemm g, const Sched& S, const Epi& E) {
    int tid_ = threadIdx.x; asm volatile("" : "+v"(tid_)); const int tid = tid_, wid = __builtin_amdgcn_readfirstlane(tid >> 6), lane = tid & 63, wr = wid >> 2, wc = wid & 3, fr = lane & 15, fq = lane >> 4;
    const int K = g.K, nt = K / BK;
    unsigned voffA[2], voffB[2];
#pragma unroll
    for (int i = 0; i < 2; ++i) { int R, C; stage_rc(tid * 16 + i * 8192, R, C); const int Rb = Epi::PERM ? ((R & ~31) + perm32(R & 31)) : R;
        voffA[i] = (unsigned)(R * K + C) * 2u; voffB[i] = (unsigned)(Rb * K + C) * 2u; }
    const size_t kstep = (size_t)(BK * 2);
    const size_t hstep = (size_t)HALF * K * 2;
    const size_t tstep = 2 * hstep;
    const unsigned ldsw = (unsigned)wid * 1024u;
    const int aoff = lds_byte(wr * 64 + fr, fq * 8), boff = lds_byte(wc * 32 + fr, fq * 8);
#define PG8_SA(b, h) (((b) * 2 + (h)) * HTB)
#define PG8_SB(b, h) ((4 + (b) * 2 + (h)) * HTB)
#define PG8_STAGE(bufoff, gbase, voff) do { _Pragma("unroll") for (int _i = 0; _i < 2; ++_i) \
        __builtin_amdgcn_global_load_lds((const unsigned*)((const char*)(gbase) + (voff)[_i]), (PG8_LAS unsigned*)(lds + (bufoff) + ldsw + _i * 8192), 16, 0, 0); } while (0)
#define PG8_LDA(dst, b, h) do { _Pragma("unroll") for (int m = 0; m < 4; ++m) _Pragma("unroll") for (int k = 0; k < 2; ++k) dst[m][k] = *(const PG8_LAS bf16x8*)(lds + PG8_SA(b, h) + aoff + m * 2048 + k * 1024); } while (0)
#define PG8_LDB(dst, b, h) do { _Pragma("unroll") for (int n = 0; n < 2; ++n) _Pragma("unroll") for (int k = 0; k < 2; ++k) dst[n][k] = *(const PG8_LAS bf16x8*)(lds + PG8_SB(b, h) + boff + n * 2048 + k * 1024); } while (0)
#define PG8_MMA(ai, bj, At, Bt) do { __builtin_amdgcn_s_setprio(1); _Pragma("unroll") for (int m = 0; m < 4; ++m) _Pragma("unroll") for (int n = 0; n < 2; ++n) _Pragma("unroll") for (int k = 0; k < 2; ++k) \
        acc[ai][bj][m][n] = __builtin_amdgcn_mfma_f32_16x16x32_bf16(Bt[n][k], At[m][k], acc[ai][bj][m][n], 0, 0, 0); __builtin_amdgcn_s_setprio(0); } while (0)
#define PG8_WAIT_V(n) asm volatile("s_waitcnt vmcnt(" #n ")" ::: "memory")
#define PG8_WAIT_L(n) asm volatile("s_waitcnt lgkmcnt(" #n ")" ::: "memory")
#define PG8_BAR __builtin_amdgcn_s_barrier()
#define PG8_SCHED __builtin_amdgcn_sched_barrier(0)
    Unit cur, nxt; int ui = 0;
    if (!S.next(0, cur)) return;
    f32x4 acc[2][2][4][2];
#pragma unroll
    for (int a = 0; a < 2; ++a)
#pragma unroll
        for (int b = 0; b < 2; ++b)
#pragma unroll
            for (int m = 0; m < 4; ++m)
#pragma unroll
                for (int n = 0; n < 2; ++n) acc[a][b][m][n] = (f32x4){0.f, 0.f, 0.f, 0.f};
    bf16x8 At[4][2], B0[2][2], B1[2][2];
    const char* cA = (const char*)g.A + (size_t)cur.pm * tstep; const char* cB = (const char*)g.Bt + (size_t)cur.pn * tstep;
    S.a_ready(cur);
    if constexpr (SP2) {
        PG8_STAGE(PG8_SB(0, 0), cB, voffB); PG8_STAGE(PG8_SB(0, 1), cB + hstep, voffB); PG8_STAGE(PG8_SA(0, 0), cA, voffA); PG8_STAGE(PG8_SA(0, 1), cA + hstep, voffA);
        if (wr == 1) PG8_BAR;
        PG8_WAIT_V(2); PG8_BAR;
        PG8_STAGE(PG8_SB(1, 0), cB + kstep, voffB); PG8_STAGE(PG8_SA(1, 0), cA + kstep, voffA); PG8_STAGE(PG8_SB(1, 1), cB + hstep + kstep, voffB);
        PG8_WAIT_V(6); PG8_BAR;
    } else {
        PG8_STAGE(PG8_SB(0, 0), cB, voffB); PG8_STAGE(PG8_SA(0, 0), cA, voffA); PG8_STAGE(PG8_SB(0, 1), cB + hstep, voffB); PG8_STAGE(PG8_SA(0, 1), cA + hstep, voffA);
        if (wr == 1) PG8_BAR;
        PG8_WAIT_V(4); PG8_BAR;
        PG8_STAGE(PG8_SB(1, 0), cB + kstep, voffB); PG8_STAGE(PG8_SA(1, 0), cA + kstep, voffA); PG8_STAGE(PG8_SB(1, 1), cB + hstep + kstep, voffB);
        PG8_WAIT_V(6); PG8_BAR;
    }
    for (;;) {
        const bool has_next = S.next(ui + 1, nxt);
        const char* nA = has_next ? (const char*)g.A + (size_t)nxt.pm * tstep : cA; const char* nB = has_next ? (const char*)g.Bt + (size_t)nxt.pn * tstep : cB;
        for (int t = 0; t < nt; t += 2) {
            const bool last = (t == nt - 2);
            const char* a1 = cA + (size_t)(t + 1) * kstep;
            const char* a2 = last ? nA : cA + (size_t)(t + 2) * kstep; const char* b2 = last ? nB : cB + (size_t)(t + 2) * kstep;
            const char* a3 = a2 + kstep; const char* b3 = b2 + kstep;
            if (last && has_next) S.a_ready(nxt);
            if constexpr (SP2) {
            PG8_LDB(B0, 0, 0); PG8_LDB(B1, 0, 1); PG8_SCHED; PG8_LDA(At, 0, 0); PG8_STAGE(PG8_SA(1, 1), a1 + hstep, voffA);
            PG8_WAIT_V(8); PG8_WAIT_L(0); PG8_BAR; PG8_MMA(0, 0, At, B0); PG8_MMA(0, 1, At, B1); PG8_BAR; PG8_SCHED;
            PG8_LDA(At, 0, 1); PG8_STAGE(PG8_SB(0, 0), b2, voffB); PG8_STAGE(PG8_SB(0, 1), b2 + hstep, voffB); PG8_STAGE(PG8_SA(0, 0), a2, voffA);
            PG8_WAIT_V(8); PG8_WAIT_L(0); PG8_BAR; PG8_MMA(1, 0, At, B0); PG8_MMA(1, 1, At, B1); PG8_BAR; PG8_SCHED;
            PG8_LDB(B0, 1, 0); PG8_LDB(B1, 1, 1); PG8_SCHED; PG8_LDA(At, 1, 0); PG8_STAGE(PG8_SA(0, 1), a2 + hstep, voffA);
            PG8_WAIT_V(8); PG8_WAIT_L(0); PG8_BAR; PG8_MMA(0, 0, At, B0); PG8_MMA(0, 1, At, B1); PG8_BAR; PG8_SCHED;
            PG8_LDA(At, 1, 1); PG8_STAGE(PG8_SB(1, 0), b3, voffB); PG8_STAGE(PG8_SB(1, 1), b3 + hstep, voffB); PG8_STAGE(PG8_SA(1, 0), a3, voffA);
            PG8_WAIT_V(8); PG8_WAIT_L(0); PG8_BAR; PG8_MMA(1, 0, At, B0); PG8_MMA(1, 1, At, B1); PG8_BAR; PG8_SCHED;
            } else {
            PG8_LDB(B0, 0, 0); PG8_SCHED; PG8_LDA(At, 0, 0); PG8_STAGE(PG8_SA(1, 1), a1 + hstep, voffA);
            PG8_WAIT_L(8); PG8_BAR; PG8_WAIT_L(0); PG8_MMA(0, 0, At, B0); PG8_BAR; PG8_SCHED;
            PG8_LDB(B1, 0, 1); PG8_STAGE(PG8_SB(0, 0), b2, voffB);
            PG8_BAR; PG8_WAIT_L(0); PG8_MMA(0, 1, At, B1); PG8_BAR;
            PG8_LDA(At, 0, 1); PG8_STAGE(PG8_SA(0, 0), a2, voffA);
            PG8_BAR; PG8_WAIT_L(0); PG8_MMA(1, 0, At, B0); PG8_BAR; PG8_SCHED;
            PG8_STAGE(PG8_SB(0, 1), b2 + hstep, voffB);
            PG8_WAIT_V(6); PG8_BAR; PG8_MMA(1, 1, At, B1); PG8_BAR;
            PG8_LDB(B0, 1, 0); PG8_SCHED; PG8_LDA(At, 1, 0); PG8_STAGE(PG8_SA(0, 1), a2 + hstep, voffA);
            PG8_WAIT_L(8); PG8_BAR; PG8_WAIT_L(0); PG8_MMA(0, 0, At, B0); PG8_BAR; PG8_SCHED;
            PG8_LDB(B1, 1, 1); PG8_STAGE(PG8_SB(1, 0), b3, voffB);
            PG8_BAR; PG8_WAIT_L(0); PG8_MMA(0, 1, At, B1); PG8_BAR;
            PG8_LDA(At, 1, 1); PG8_STAGE(PG8_SA(1, 0), a3, voffA);
            PG8_BAR; PG8_WAIT_L(0); PG8_MMA(1, 0, At, B0); PG8_BAR; PG8_SCHED;
            PG8_STAGE(PG8_SB(1, 1), b3 + hstep, voffB);
            PG8_WAIT_V(6); PG8_BAR; PG8_MMA(1, 1, At, B1); PG8_BAR;
            }
        }
        if constexpr (ALIGN_EPI) { if (wr == 0) PG8_BAR; }
        if constexpr (!Epi::AFTER_DRAIN) { E(acc, cur, wr, wc, fr, fq); S.done(cur); }
        if (!has_next) break;
#pragma unroll
        for (int a = 0; a < 2; ++a)
#pragma unroll
            for (int b = 0; b < 2; ++b)
#pragma unroll
                for (int m = 0; m < 4; ++m)
#pragma unroll
                    for (int n = 0; n < 2; ++n) acc[a][b][m][n] = (f32x4){0.f, 0.f, 0.f, 0.f};
        cur = nxt; cA = nA; cB = nB; ++ui;
        if constexpr (ALIGN_EPI) { if (wr == 1) PG8_BAR; }
    }
    PG8_WAIT_V(0);
    if constexpr (!ALIGN_EPI) { if (wr == 0) PG8_BAR; }
    PG8_BAR;
    if constexpr (Epi::AFTER_DRAIN) { E.fused(acc, cur, wr, wc, fr, fq, lds, wid, lane); S.done(cur); }
#undef PG8_SA
#undef PG8_SB
#undef PG8_STAGE
#undef PG8_LDA
#undef PG8_LDB
#undef PG8_MMA
#undef PG8_WAIT_V
#undef PG8_WAIT_L
#undef PG8_BAR
#undef PG8_SCHED
}
}

namespace pg8 {
__device__ __forceinline__ float sigm(float x) { return __builtin_amdgcn_rcpf(1.f + __expf(-x)); }
__device__ __forceinline__ f32x4 sigm4(f32x4 v) { return (f32x4){sigm(v[0]), sigm(v[1]), sigm(v[2]), sigm(v[3])}; }
__device__ __forceinline__ u32x4 pack8(f32x4 v0, f32x4 v1) { u32x4 w; w.x = cvt_pk_bf16(v0[0], v0[1]); w.y = cvt_pk_bf16(v0[2], v0[3]); w.z = cvt_pk_bf16(v1[0], v1[1]); w.w = cvt_pk_bf16(v1[2], v1[3]); return w; }
__device__ __forceinline__ float bflo(unsigned u) { return __uint_as_float(u << 16); }
__device__ __forceinline__ float bfhi(unsigned u) { return __uint_as_float(u & 0xffff0000u); }

struct EpiInproj {
    static constexpr bool PERM = true, AFTER_DRAIN = false;
    bf16_t* U; float* MISC; int ldu;
    __device__ __forceinline__ void operator()(const f32x4 (&acc)[2][2][4][2], const Unit& u, int wr, int wc, int fr, int fq) const {
        const int row0 = u.pm * BM + wr * 64 + fr, cl = wc * 32 + 8 * fq;
        if (u.pn == 16 || u.pn == 17) {
#pragma unroll
            for (int ai = 0; ai < 2; ++ai)
#pragma unroll
                for (int m = 0; m < 4; ++m) { float* rowp = MISC + (size_t)(row0 + ai * HALF + m * 16) * 512 + (u.pn - 16) * BM + cl;
#pragma unroll
                    for (int bj = 0; bj < 2; ++bj) { *(f32x4*)(rowp + bj * HALF) = acc[ai][bj][m][0]; *(f32x4*)(rowp + bj * HALF + 4) = acc[ai][bj][m][1]; } }
        } else {
            const bool sg = u.pn >= 22;
#pragma unroll
            for (int ai = 0; ai < 2; ++ai)
#pragma unroll
                for (int m = 0; m < 4; ++m) { bf16_t* rowp = U + (size_t)(row0 + ai * HALF + m * 16) * ldu + u.pn * BM + cl;
#pragma unroll
                    for (int bj = 0; bj < 2; ++bj) { f32x4 v0 = acc[ai][bj][m][0], v1 = acc[ai][bj][m][1];
                        if (sg) { v0 = sigm4(v0); v1 = sigm4(v1); }
                        *(u32x4*)(rowp + bj * HALF) = pack8(v0, v1); } }
        }
    }
};
struct EpiBf {
    static constexpr bool PERM = true, AFTER_DRAIN = false;
    int kind; bf16_t* O0; bf16_t* O1;
    __device__ __forceinline__ void operator()(const f32x4 (&acc)[2][2][4][2], const Unit& u, int wr, int wc, int fr, int fq) const {
        bf16_t* base; size_t pitch;
        if (kind == 0) {
            const int half = u.pm >> 1, chb = (u.pm & 1) * 256;
            if (u.pn < 32) { const int b = u.pn >> 3, l0 = (u.pn & 7) * 256; pitch = 4096; base = O0 + ((size_t)(b * 512 + chb) * 2 + half) * 2048 + l0; }
            else { const int b = u.pn - 32; pitch = 512; base = O1 + ((size_t)(b * 512 + chb) * 2 + half) * 256; }
        } else if (kind == 1) { const int b = u.pn >> 1; pitch = 512; base = O0 + (size_t)(b * 2048 + u.pm * 256) * 512 + (u.pn & 1) * 256; }
        else if (kind == 2) { const int b = u.pn >> 1; pitch = 512; base = O0 + (size_t)(8192 + b * 256) * 512 + (u.pn & 1) * 256; }
        else { pitch = 8192; base = O0 + (size_t)(u.pm * 256) * 8192 + u.pn * 256; }
        const int r0 = wr * 64 + fr, cl = wc * 32 + 8 * fq;
#pragma unroll
        for (int ai = 0; ai < 2; ++ai)
#pragma unroll
            for (int m = 0; m < 4; ++m) { bf16_t* rowp = base + (size_t)(r0 + ai * HALF + m * 16) * pitch + cl;
#pragma unroll
                for (int bj = 0; bj < 2; ++bj) { f32x4 v0 = acc[ai][bj][m][0], v1 = acc[ai][bj][m][1];
                    if (kind == 3) { v0 = __builtin_elementwise_max(v0, (f32x4){0.f, 0.f, 0.f, 0.f}); v1 = __builtin_elementwise_max(v1, (f32x4){0.f, 0.f, 0.f, 0.f}); v0 = v0 * v0; v1 = v1 * v1; }
                    *(u32x4*)(rowp + bj * HALF) = pack8(v0, v1); } }
    }
};
struct EpiMerge {
    static constexpr bool PERM = true, AFTER_DRAIN = false;
    const bf16_t* G; int ldg; float* MB; bf16_t* Mo; int job;
    __device__ __forceinline__ void operator()(const f32x4 (&acc)[2][2][4][2], const Unit& u, int wr, int wc, int fr, int fq) const {
        const int row0 = u.pm * BM + wr * 64 + fr, col0 = u.pn * BM + wc * 32 + 8 * fq;
#pragma unroll
        for (int ai = 0; ai < 2; ++ai)
#pragma unroll
            for (int m = 0; m < 4; ++m) { const size_t row = (size_t)(row0 + ai * HALF + m * 16);
#pragma unroll
                for (int bj = 0; bj < 2; ++bj) { const int col = col0 + bj * HALF;
                    const u32x4 g = *(const u32x4*)(G + row * ldg + col);
                    f32x4 v0 = acc[ai][bj][m][0] * (f32x4){bflo(g.x), bfhi(g.x), bflo(g.y), bfhi(g.y)};
                    f32x4 v1 = acc[ai][bj][m][1] * (f32x4){bflo(g.z), bfhi(g.z), bflo(g.w), bfhi(g.w)};
                    float* mp = MB + row * 2048 + col;
                    if (job > 0) { v0 += *(const f32x4*)mp; v1 += *(const f32x4*)(mp + 4); }
                    if (job < 3) { *(f32x4*)mp = v0; *(f32x4*)(mp + 4) = v1; }
                    else *(u32x4*)(Mo + row * 2048 + col) = pack8(v0, v1); } }
    }
};
struct EpiF32 {
    static constexpr bool PERM = false, AFTER_DRAIN = false;
    float* C; int ldc;
    __device__ __forceinline__ void operator()(const f32x4 (&acc)[2][2][4][2], const Unit& u, int wr, int wc, int fr, int fq) const {
        const int row0 = u.pm * BM + wr * 64 + fr, col0 = u.pn * BM + wc * 32 + 4 * fq;
#pragma unroll
        for (int ai = 0; ai < 2; ++ai)
#pragma unroll
            for (int m = 0; m < 4; ++m) { float* rowp = C + (size_t)(row0 + ai * HALF + m * 16) * ldc + col0;
#pragma unroll
                for (int bj = 0; bj < 2; ++bj)
#pragma unroll
                    for (int n = 0; n < 2; ++n) *(f32x4*)(rowp + bj * HALF + n * 16) = acc[ai][bj][m][n]; }
    }
};
}

#define GAS __attribute__((address_space(1)))
#define LAS __attribute__((address_space(3)))
typedef unsigned short bf16;
typedef unsigned v4u __attribute__((ext_vector_type(4)));
typedef unsigned v2u __attribute__((ext_vector_type(2)));
typedef float f32x4 __attribute__((ext_vector_type(4)));
typedef float f32x2 __attribute__((ext_vector_type(2)));
constexpr int NWAVES = 8, NTHR = 512;
constexpr int DM = 2048, NBATCH = 4, LSEQ = 2048, LCTX = 256, DEPTH = 4;
constexpr int TLAT = NBATCH * LSEQ, TCTX = NBATCH * LCTX, TT = TLAT + TCTX;
constexpr int IN_DIM = 14168, DFF = 8192;
constexpr int NU = 13824;
constexpr int UZ = 0, UXBC = 768, URKV = 2560, UMISC = 4096, UCONV = 4608, UGATE = 5632;
constexpr int S_RKV = 2584, S_DT = 2560, S_WF = 4120, S_CONV = 4440, S_FFT = 5464, S_GATE = 5976;
constexpr int RJ = LCTX + LSEQ;
enum { I_X = 0, I_C, I_CTX, I_CCTX, I_MODW, I_MODB, I_NORMG, I_WIN, I_CONVW, I_CONVB, I_CLNG, I_CLNB, I_CONVOUT, I_SCW, I_SCB, I_SALOG, I_SDTB, I_SD, I_SNG, I_SOUT,
       I_FOUT, I_RMU, I_RW0, I_RW2, I_RA0, I_RA2, I_RG2, I_RKK, I_RKA, I_RRK, I_RLNG, I_RLNB, I_ROUT, I_WO, I_UP, I_DOWN, N_IN };
constexpr size_t MiB = 1u << 20;
constexpr size_t OFF_CTL = 0, CTL_BYTES = 1 * MiB;
constexpr size_t OFF_MODV = 1 * MiB;
constexpr size_t OFF_DFTL = 2 * MiB;
constexpr size_t OFF_DFTC = 18 * MiB;
constexpr size_t OFF_W = 20 * MiB, W_LAYER = 139 * MiB;
constexpr size_t WO_IN = 0, WO_FFT = 54 * MiB, WO_CO = 58 * MiB, WO_SO = 60 * MiB, WO_FO = 63 * MiB, WO_RO = 65 * MiB, WO_O = 67 * MiB, WO_UP = 75 * MiB, WO_DN = 107 * MiB;
constexpr size_t OFF_X = 576 * MiB;
constexpr size_t OFF_H = 648 * MiB;
constexpr size_t OFF_U = 684 * MiB;
constexpr size_t OFF_HB = OFF_U;
constexpr size_t OFF_MISC = 927 * MiB;
constexpr size_t OFF_VTL = 945 * MiB;
constexpr size_t OFF_VTC = 961 * MiB;
constexpr size_t OFF_ACONV = 963 * MiB, OFF_ASSD = 972 * MiB, OFF_AFFT = 986 * MiB, OFF_ARWKV = 995 * MiB;
constexpr size_t OFF_XBC = 1004 * MiB;
constexpr size_t OFF_DTA = 1036 * MiB;
constexpr size_t OFF_YSSD = 1038 * MiB;
constexpr size_t OFF_RW = 1092 * MiB, RW_ARR = 18 * MiB;
constexpr size_t OFF_RSC = 1254 * MiB;
constexpr size_t OFF_YRW = 1255 * MiB;
constexpr size_t OFF_MBUF = 1291 * MiB;
constexpr size_t OFF_M = 1363 * MiB;
constexpr size_t OFF_Y = 1399 * MiB;
constexpr size_t OFF_WLT = 1471 * MiB;
constexpr size_t WS_END = 1473 * MiB;
constexpr int CW_Q = 8192;
constexpr int CW_BAR = 4096;
constexpr int RING_BYTES = 131072, MISC_OFF = RING_BYTES + 320, LDS_BYTES = 147456;

__device__ __forceinline__ float bf2f(unsigned short b) { return __uint_as_float((unsigned)b << 16); }
__device__ __forceinline__ float bflo(unsigned u) { return __uint_as_float(u << 16); }
__device__ __forceinline__ float bfhi(unsigned u) { return __uint_as_float(u & 0xffff0000u); }
__device__ __forceinline__ unsigned f2bf(float f) { unsigned u = __builtin_bit_cast(unsigned, f); return (u + 0x7fffu + ((u >> 16) & 1u)) >> 16; }
__device__ __forceinline__ unsigned pk2(float lo, float hi) { return f2bf(lo) | (f2bf(hi) << 16); }
__device__ __forceinline__ float sigmoidf_(float x) { return 1.f / (1.f + __expf(-x)); }
__device__ __forceinline__ float siluf_(float x) { return x / (1.f + __expf(-x)); }
__device__ __forceinline__ float softplusf_(float x) { return fmaxf(x, 0.f) + log1pf(__expf(-fabsf(x))); }
__device__ __forceinline__ float wave_sum(float v) {
#pragma unroll
    for (int o = 1; o < 64; o <<= 1) v += __shfl_xor(v, o);
    return v;
}
#define LDS_WAIT() asm volatile("s_waitcnt lgkmcnt(0)" ::: "memory")

struct Args { const float* in[N_IN]; float* out; unsigned char* ws; int ph_lo, ph_hi; };
typedef const __attribute__((address_space(4))) Args* KArgs;
__device__ __forceinline__ KArgs kargs() { KArgs p = (KArgs)__builtin_amdgcn_kernarg_segment_ptr(); asm volatile("" : "+s"(p)); return p; }
#define PH_IDS int tid = threadIdx.x; asm volatile("" : "+v"(tid)); const int lane = tid & 63, wave = __builtin_amdgcn_readfirstlane(tid >> 6); (void)lane; (void)wave;

__device__ __forceinline__ int inmap(int n) {
    if (n < 2560) return n;
    if (n < 4096) return S_RKV + (n - 2560);
    if (n < 4608) { const int m = n - 4096; if (m < 24) return S_DT + m; if (m < 64) return -1; if (m < 384) return S_WF + (m - 64); return -1; }
    if (n < 5632) return S_CONV + (n - 4608);
    return S_GATE + (n - 5632);
}
__device__ __forceinline__ int rwkv_tok(int b, int j) { if (j < LCTX) return TLAT + b * LCTX + j; const int s = j - LCTX; return b * LSEQ + (s & 31) * 64 + (s >> 5); }

__device__ __forceinline__ void transpose_item(const float* W, int K, int Nsrc, bf16* WT, int k0, int n0, bool mapped, LAS float* scr, int lane) {
    const int nn = lane & 31; const int sc = mapped ? inmap(n0 + nn) : (n0 + nn);
#pragma unroll 8
    for (int i = 0; i < 32; ++i) { const int kk = 2 * i + (lane >> 5); scr[kk * 33 + nn] = (sc >= 0) ? W[(size_t)(k0 + kk) * Nsrc + sc] : 0.f; }
    LDS_WAIT();
    const int c = lane & 7;
#pragma unroll
    for (int j = 0; j < 4; ++j) { const int n = (lane >> 3) + 8 * j; const LAS float* s = scr + (8 * c) * 33 + n;
        v4u o; o.x = pk2(s[0 * 33], s[1 * 33]); o.y = pk2(s[2 * 33], s[3 * 33]); o.z = pk2(s[4 * 33], s[5 * 33]); o.w = pk2(s[6 * 33], s[7 * 33]);
        *(v4u*)(WT + (size_t)(n0 + n) * K + k0 + 8 * c) = o; }
    LDS_WAIT();
}
constexpr int IT_IN = 32 * (NU / 32), IT_CO = 8 * 64, IT_SO = 12 * 64, IT_FO = 8 * 64, IT_RO = 8 * 64, IT_O = 32 * 64, IT_UP = 32 * 256, IT_DN = 128 * 64;
constexpr int IT_LAYER = IT_IN + IT_CO + IT_SO + IT_FO + IT_RO + IT_O + IT_UP + IT_DN;

__device__ __forceinline__ void p0_prologue(KArgs a, LAS unsigned char* lds, int bid, int G) {
    PH_IDS
    unsigned char* ws = a->ws;
    {
        LAS float* sc = (LAS float*)lds;
        LAS float* part = (LAS float*)(lds + 40960);
        for (int i = tid; i < 5 * DM; i += NTHR) { const float v = (i < 4 * DM) ? a->in[I_C][i] : a->in[I_CCTX][i - 4 * DM]; sc[i] = siluf_(v); }
        __syncthreads();
        float* MODV = (float*)(ws + OFF_MODV);
        for (int it = bid; it < DEPTH * 192; it += G) {
            const int l = it / 192, j = (it % 192) * 64 + lane;
            const float* wp = a->in[I_MODW] + (size_t)l * DM * 12288 + (size_t)(wave * 256) * 12288 + j;
            float acc[5] = {0.f, 0.f, 0.f, 0.f, 0.f};
#pragma unroll 4
            for (int k = 0; k < 256; ++k) { const float w = wp[(size_t)k * 12288];
#pragma unroll
                for (int r = 0; r < 5; ++r) acc[r] += sc[r * DM + wave * 256 + k] * w; }
#pragma unroll
            for (int r = 0; r < 5; ++r) part[(wave * 5 + r) * 64 + lane] = acc[r];
            __syncthreads();
            if (tid < 320) { const int r = tid >> 6, jj = tid & 63; float s = 0.f;
#pragma unroll
                for (int w = 0; w < 8; ++w) s += part[(w * 5 + r) * 64 + jj];
                const int jo = (it % 192) * 64 + jj; MODV[((size_t)l * 5 + r) * 12288 + jo] = s + a->in[I_MODB][l * 12288 + jo]; }
            __syncthreads();
        }
    }
    {
        LAS float* wt = (LAS float*)lds;
        LAS float* ctab = (LAS float*)(lds + 32768);
        LAS float* scr = (LAS float*)(lds + 32768 + 512 + wave * 8448);
        __syncthreads();
        if (tid < 128) ctab[tid] = cospif((float)tid * (1.f / 64.f));
        for (int it = bid; it < DEPTH * 32 * 4; it += G) {
            const int l = it / 128, kb = (it % 128) / 4, g = it % 4, k0 = kb * 64;
            __syncthreads();
            for (int i = tid; i < 64 * 32; i += NTHR) { const int kk = i >> 5, c4 = i & 31;
                *(LAS f32x4*)(wt + kk * 128 + c4 * 4) = *(const f32x4*)(a->in[I_WIN] + ((size_t)l * DM + k0 + kk) * IN_DIM + S_FFT + g * 128 + c4 * 4); }
            __syncthreads();
            const int half = wave >> 2, cp = (wave & 3) * 32 + (lane & 31), n0 = half * 512 + g * 128 + (wave & 3) * 32;
#pragma unroll 1
            for (int i = 0; i < 32; ++i) { const int kk = 2 * i + (lane >> 5); float s = 0.f;
#pragma unroll 8
                for (int c = 0; c < 128; ++c) s += wt[kk * 128 + c] * ctab[(c * cp - 32 * half) & 127];
                scr[kk * 33 + (lane & 31)] = s; }
            LDS_WAIT();
            bf16* WT = (bf16*)(ws + OFF_W + (size_t)l * W_LAYER + WO_FFT);
            const int c = lane & 7;
#pragma unroll
            for (int j = 0; j < 4; ++j) { const int n = (lane >> 3) + 8 * j; const LAS float* s = scr + (8 * c) * 33 + n;
                v4u o; o.x = pk2(s[0 * 33], s[1 * 33]); o.y = pk2(s[2 * 33], s[3 * 33]); o.z = pk2(s[4 * 33], s[5 * 33]); o.w = pk2(s[6 * 33], s[7 * 33]);
                *(v4u*)(WT + (size_t)(n0 + n) * DM + k0 + 8 * c) = o; }
            LDS_WAIT();
        }
        __syncthreads();
    }
    const int gw = bid * NWAVES + wave, NGW = G * NWAVES;
    {
        LAS float* scr = (LAS float*)(lds + wave * 8448);
        for (int it = gw; it < DEPTH * IT_LAYER; it += NGW) {
            const int l = it / IT_LAYER; int r = it % IT_LAYER; unsigned char* wl = ws + OFF_W + (size_t)l * W_LAYER;
            if (r < IT_IN) { const int kb = r / (NU / 32), nb = r % (NU / 32); transpose_item(a->in[I_WIN] + (size_t)l * DM * IN_DIM, DM, IN_DIM, (bf16*)(wl + WO_IN), kb * 64, nb * 32, true, scr, lane); continue; } r -= IT_IN;
            if (r < IT_CO) { transpose_item(a->in[I_CONVOUT] + (size_t)l * 512 * DM, 512, DM, (bf16*)(wl + WO_CO), (r / 64) * 64, (r % 64) * 32, false, scr, lane); continue; } r -= IT_CO;
            if (r < IT_SO) { transpose_item(a->in[I_SOUT] + (size_t)l * 768 * DM, 768, DM, (bf16*)(wl + WO_SO), (r / 64) * 64, (r % 64) * 32, false, scr, lane); continue; } r -= IT_SO;
            if (r < IT_FO) { transpose_item(a->in[I_FOUT] + (size_t)l * 512 * DM, 512, DM, (bf16*)(wl + WO_FO), (r / 64) * 64, (r % 64) * 32, false, scr, lane); continue; } r -= IT_FO;
            if (r < IT_RO) { transpose_item(a->in[I_ROUT] + (size_t)l * 512 * DM, 512, DM, (bf16*)(wl + WO_RO), (r / 64) * 64, (r % 64) * 32, false, scr, lane); continue; } r -= IT_RO;
            if (r < IT_O) { transpose_item(a->in[I_WO] + (size_t)l * DM * DM, DM, DM, (bf16*)(wl + WO_O), (r / 64) * 64, (r % 64) * 32, false, scr, lane); continue; } r -= IT_O;
            if (r < IT_UP) { transpose_item(a->in[I_UP] + (size_t)l * DM * DFF, DM, DFF, (bf16*)(wl + WO_UP), (r / 256) * 64, (r % 256) * 32, false, scr, lane); continue; } r -= IT_UP;
            transpose_item(a->in[I_DOWN] + (size_t)l * DFF * DM, DFF, DM, (bf16*)(wl + WO_DN), (r / 64) * 64, (r % 64) * 32, false, scr, lane);
        }
    }
    {
        const int gt = bid * NTHR + tid, NGT = G * NTHR;
        bf16* FL = (bf16*)(ws + OFF_DFTL); bf16* FC = (bf16*)(ws + OFF_DFTC);
        { bf16* WLT = (bf16*)(ws + OFF_WLT);
          for (int i = gt; i < DEPTH * 512 * 320; i += NGT) { const int l = i / (512 * 320), c = (i / 320) % 512, j = i % 320; float v;
              if (j < 64) v = a->in[I_RW2][((size_t)(l * 2 + 0) * 64 + j) * 512 + c]; else if (j < 128) v = a->in[I_RW2][((size_t)(l * 2 + 1) * 64 + (j - 64)) * 512 + c];
              else if (j < 192) v = a->in[I_RA2][((size_t)l * 64 + (j - 128)) * 512 + c]; else v = a->in[I_RG2][((size_t)l * 128 + (j - 192)) * 512 + c];
              WLT[i] = (bf16)f2bf(v); } }
        for (int i = gt; i < 2048 * 512; i += NGT) { const int lp = i >> 9, k8 = (i & 511) * 8; unsigned o[4];
#pragma unroll
            for (int e = 0; e < 4; ++e) { float v[2];
#pragma unroll
                for (int q = 0; q < 2; ++q) { const int k = k8 + 2 * e + q; const int m = (lp * (k & 2047)) & 2047; float sn, cs; sincospif((float)m * (1.f / 1024.f), &sn, &cs); v[q] = (k < 2048 ? cs : -sn) * (1.f / 512.f); }
                o[e] = pk2(v[0], v[1]); }
            *(v4u*)(FL + (size_t)lp * 4096 + k8) = (v4u){o[0], o[1], o[2], o[3]}; }
        for (int i = gt; i < 256 * 64; i += NGT) { const int lp = i >> 6, k8 = (i & 63) * 8; unsigned o[4];
#pragma unroll
            for (int e = 0; e < 4; ++e) { float v[2];
#pragma unroll
                for (int q = 0; q < 2; ++q) { const int k = k8 + 2 * e + q; const int m = (lp * (k & 255)) & 255; float sn, cs; sincospif((float)m * (1.f / 128.f), &sn, &cs); v[q] = (k < 256 ? cs : -sn) * 0.005524271728f; }
                o[e] = pk2(v[0], v[1]); }
            *(v4u*)(FC + (size_t)lp * 512 + k8) = (v4u){o[0], o[1], o[2], o[3]}; }
        f32x4* X4 = (f32x4*)(ws + OFF_X); const f32x4* x4 = (const f32x4*)a->in[I_X]; const f32x4* c4 = (const f32x4*)a->in[I_CTX];
        for (int i = gt; i < TT * (DM / 4); i += NGT) X4[i] = (i < TLAT * (DM / 4)) ? x4[i] : c4[i - TLAT * (DM / 4)];
    }
}

__device__ __forceinline__ void norm_phase(KArgs a, int mode, const float* gY, const float* gH, const float* modY  , const float* modH  ,
                                           int bid, int G) {
    PH_IDS
    unsigned char* ws = a->ws; const int gw = bid * NWAVES + wave, NGW = G * NWAVES;
    float* X = (float*)(ws + OFF_X); const float* Y = (const float*)(ws + OFF_Y); bf16* H = (bf16*)(ws + OFF_H);
    for (int row = gw; row < TT; row += NGW) {
        if (mode == 2 && row >= TLAT) continue;
        const int mr = row < TLAT ? (row >> 11) : 4;
        f32x4 x[8];
        const f32x4* xr = (const f32x4*)(X + (size_t)row * DM) + lane;
#pragma unroll
        for (int j = 0; j < 8; ++j) x[j] = xr[64 * j];
        if (mode != 0) {
            const f32x4* yr = (const f32x4*)(Y + (size_t)row * DM) + lane; f32x4 y[8]; float ss = 0.f;
#pragma unroll
            for (int j = 0; j < 8; ++j) { y[j] = yr[64 * j]; ss += (y[j].x * y[j].x + y[j].y * y[j].y) + (y[j].z * y[j].z + y[j].w * y[j].w); }
            const float r = rsqrtf(wave_sum(ss) * (1.f / DM) + 1e-6f);
            const f32x4* gp = (const f32x4*)gY + lane; const f32x4* gt = (const f32x4*)(modY + (size_t)mr * 12288) + lane;
#pragma unroll
            for (int j = 0; j < 8; ++j) x[j] += gt[64 * j] * (y[j] * r * gp[64 * j]);
            if (mode == 1) { f32x4* xw = (f32x4*)(X + (size_t)row * DM) + lane;
#pragma unroll
                for (int j = 0; j < 8; ++j) xw[64 * j] = x[j]; }
            else { f32x4* ow = (f32x4*)(a->out + (size_t)row * DM) + lane;
#pragma unroll
                for (int j = 0; j < 8; ++j) ow[64 * j] = x[j]; }
        }
        if (mode != 2) {
            float ss = 0.f;
#pragma unroll
            for (int j = 0; j < 8; ++j) ss += (x[j].x * x[j].x + x[j].y * x[j].y) + (x[j].z * x[j].z + x[j].w * x[j].w);
            const float r = rsqrtf(wave_sum(ss) * (1.f / DM) + 1e-6f);
            const f32x4* gp = (const f32x4*)gH + lane; const f32x4* sh = (const f32x4*)(modH + (size_t)mr * 12288) + lane; const f32x4* sc = sh + 512;
            v2u* hw = (v2u*)(H + (size_t)row * DM) + lane;
#pragma unroll
            for (int j = 0; j < 8; ++j) { const f32x4 h = (x[j] * r * gp[64 * j]) * (sc[64 * j] + 1.f) + sh[64 * j]; hw[64 * j] = (v2u){pk2(h.x, h.y), pk2(h.z, h.w)}; }
        }
    }
}
#define XB_TMO      128
#define XB_XCNT(j)  (256  + 64 * (j))
#define XB_XSUB(j)  (1280 + 64 * (j))
#define XB_XGEN(j)  (2304 + 64 * (j))
#define XB_TOP      3328
#define XB_TOPGEN   3392
#define XCD_BAR_WORDS 3456
#define XB_SPIN_CAP (1u << 18)

__device__ __forceinline__ unsigned xb_ld(unsigned* p)              { return __hip_atomic_load(p, __ATOMIC_RELAXED, __HIP_MEMORY_SCOPE_AGENT); }
__device__ __forceinline__ unsigned xb_add(unsigned* p, unsigned v) { return __hip_atomic_fetch_add(p, v, __ATOMIC_RELAXED, __HIP_MEMORY_SCOPE_AGENT); }
__device__ __forceinline__ unsigned xb_xcc_id() { return (unsigned)__builtin_amdgcn_s_getreg((3 << 11) | 20) & 0xFu; }
#define XB_SPIN(cond, bar) do { unsigned _sp = 0; while (cond) { __builtin_amdgcn_s_sleep(1); \
    if ((++_sp & 255u) == 0u) { if (xb_ld(&(bar)[XB_TMO])) break; if (_sp > XB_SPIN_CAP) { atomicAdd(&(bar)[XB_TMO], 1u); break; } } } } while (0)

struct XcdBarrier {
    unsigned* bar; unsigned x;
    volatile LAS unsigned* st;
};

__device__ __forceinline__ XcdBarrier xcd_barrier_post(unsigned* bar, volatile LAS unsigned* st) {
    XcdBarrier b; b.bar = bar; b.x = xb_xcc_id(); b.st = st;
    if (threadIdx.x == 0) (void)xb_add(&bar[XB_XCNT(b.x)], 1u);
    return b;
}
__device__ __forceinline__ void xcd_barrier_complete(unsigned* bar, unsigned x, unsigned& nloc, unsigned& nx) {
    const unsigned G = gridDim.x * gridDim.y * gridDim.z;
    unsigned sum, cnt, mine, sp = 0u;
    for (;;) {
        sum = 0u; cnt = 0u; mine = 0u;
#pragma unroll
        for (unsigned j = 0; j < 16; ++j) { const unsigned c = xb_ld(&bar[XB_XCNT(j)]); sum += c; cnt += (c > 0u) ? 1u : 0u; mine = (j == x) ? c : mine; }
        if (sum == G) break;
        __builtin_amdgcn_s_sleep(1);
        if ((++sp & 255u) == 0u) { if (xb_ld(&bar[XB_TMO])) break; if (sp > XB_SPIN_CAP) { atomicAdd(&bar[XB_TMO], 1u); break; } }
    }
    nloc = mine > 0u ? mine : 1u; nx = cnt > 0u ? cnt : 1u;
}

__device__ __forceinline__ void xcd_barrier(const XcdBarrier& b) {
    asm volatile("s_waitcnt vmcnt(0)" ::: "memory");
    __syncthreads();
    if (threadIdx.x == 0) {
        unsigned* bar = b.bar;
        __builtin_amdgcn_s_waitcnt(0);
        unsigned nloc = b.st[0], nx = b.st[1];
        if (nloc == 0u) { xcd_barrier_complete(bar, b.x, nloc, nx); b.st[0] = nloc; b.st[1] = nx; }
        const unsigned old = xb_add(&bar[XB_XSUB(b.x)], 1u);
        const unsigned gen = old / nloc;
        if (old + 1u == (gen + 1u) * nloc) {
            __builtin_amdgcn_fence(__ATOMIC_RELEASE, "agent");
            asm volatile("s_waitcnt vmcnt(0)" ::: "memory");
            const unsigned og = xb_add(&bar[XB_TOP], 1u);
            const unsigned tg = og / nx;
            if (og + 1u == (tg + 1u) * nx) xb_add(&bar[XB_TOPGEN], 1u);
            else XB_SPIN(xb_ld(&bar[XB_TOPGEN]) == tg, bar);
            __builtin_amdgcn_fence(__ATOMIC_ACQUIRE, "agent");
            xb_add(&bar[XB_XGEN(b.x)], 1u);
            asm volatile("s_waitcnt vmcnt(0)" ::: "memory");
        } else {
            XB_SPIN(xb_ld(&bar[XB_XGEN(b.x)]) == gen, bar);
            __builtin_amdgcn_fence(__ATOMIC_ACQUIRE, "agent");
            asm volatile("s_waitcnt vmcnt(0)" ::: "memory");
        }
    }
    __syncthreads();
}

template <int CTRL> __device__ __forceinline__ float dpp_add(float x) { return x + __int_as_float(__builtin_amdgcn_update_dpp(0, __float_as_int(x), CTRL, 0xf, 0xf, true)); }
__device__ __forceinline__ float row16_sum(float x) { x = dpp_add<0xB1>(x); x = dpp_add<0x4E>(x); x = dpp_add<0x141>(x); x = dpp_add<0x140>(x); return x; }
typedef short bf16x8 __attribute__((ext_vector_type(8)));
constexpr int RP_PITCH = 516, ACT_PITCH = 328;
__device__ __forceinline__ void rwkv_prep_item(KArgs a, int l, int item, LAS unsigned char* lds, int tid, int lane, int wave) {
    unsigned char* ws = a->ws;
    const bf16* U = (const bf16*)(ws + OFF_U); const float* MISC = (const float*)(ws + OFF_MISC);
    const int b = item / 144, j0 = (item % 144) * 16; const bool isctx = j0 < LCTX;
    LAS float* RP = (LAS float*)lds;
    LAS float* KP = RP + 16 * RP_PITCH; LAS float* VP = KP + 16 * RP_PITCH;
    LAS bf16* ACT = (LAS bf16*)(lds + 3 * 16 * RP_PITCH * 4);
    const float* mu = a->in[I_RMU] + l * 1856;
    for (int idx = tid; idx < 16 * 192; idx += NTHR) { const int i = idx / 192, c8 = idx % 192, jj = j0 + i;
        const bool hp = isctx ? (jj - 1 >= 0) : (jj - 1 >= LCTX), hn = isctx ? (jj + 1 < LCTX) : (jj + 1 < RJ);
        const v4u c = *(const v4u*)(U + (size_t)rwkv_tok(b, jj) * NU + URKV + c8 * 8);
        v4u p = (v4u){0u, 0u, 0u, 0u}, n = p;
        if (hp) p = *(const v4u*)(U + (size_t)rwkv_tok(b, jj - 1) * NU + URKV + c8 * 8);
        if (hn) n = *(const v4u*)(U + (size_t)rwkv_tok(b, jj + 1) * NU + URKV + c8 * 8);
        const f32x4 m0 = *(const f32x4*)(mu + c8 * 8), m1 = *(const f32x4*)(mu + c8 * 8 + 4);
        f32x4 x0 = (f32x4){bflo(c.x), bfhi(c.x), bflo(c.y), bfhi(c.y)}, x1 = (f32x4){bflo(c.z), bfhi(c.z), bflo(c.w), bfhi(c.w)};
        const f32x4 s0 = (f32x4){bflo(p.x) + bflo(n.x), bfhi(p.x) + bfhi(n.x), bflo(p.y) + bflo(n.y), bfhi(p.y) + bfhi(n.y)}, s1 = (f32x4){bflo(p.z) + bflo(n.z), bfhi(p.z) + bfhi(n.z), bflo(p.w) + bflo(n.w), bfhi(p.w) + bfhi(n.w)};
        x0 = x0 + (0.5f * s0 - x0) * m0; x1 = x1 + (0.5f * s1 - x1) * m1;
        const int ch = c8 * 8, reg = ch >> 9; LAS float* dst = (reg == 0 ? RP : (reg == 1 ? KP : VP)) + i * RP_PITCH + (ch & 511);
        *(LAS f32x4*)dst = x0; *(LAS f32x4*)(dst + 4) = x1; }
    for (int idx = tid; idx < 16 * 80; idx += NTHR) { const int i = idx / 80, c4 = idx % 80, jj = j0 + i;
        const bool hp = isctx ? (jj - 1 >= 0) : (jj - 1 >= LCTX), hn = isctx ? (jj + 1 < LCTX) : (jj + 1 < RJ);
        f32x4 x = *(const f32x4*)(MISC + (size_t)rwkv_tok(b, jj) * 512 + 64 + c4 * 4); f32x4 p = (f32x4){0.f, 0.f, 0.f, 0.f}, n = p;
        if (hp) p = *(const f32x4*)(MISC + (size_t)rwkv_tok(b, jj - 1) * 512 + 64 + c4 * 4);
        if (hn) n = *(const f32x4*)(MISC + (size_t)rwkv_tok(b, jj + 1) * 512 + 64 + c4 * 4);
        x = x + (0.5f * (p + n) - x) * *(const f32x4*)(mu + 1536 + c4 * 4);
        const int m = c4 * 4;
        if (m < 128) x = (f32x4){tanhf(x.x), tanhf(x.y), tanhf(x.z), tanhf(x.w)}; else if (m >= 192) x = (f32x4){sigmoidf_(x.x), sigmoidf_(x.y), sigmoidf_(x.z), sigmoidf_(x.w)};
        *(LAS v2u*)(ACT + i * ACT_PITCH + m) = (v2u){pk2(x.x, x.y), pk2(x.z, x.w)}; }
    __syncthreads();
    const int fr = lane & 15, fq = lane >> 4, h = wave;
    f32x4 acc[4][4];
#pragma unroll
    for (int o = 0; o < 4; ++o)
#pragma unroll
        for (int nt = 0; nt < 4; ++nt) acc[o][nt] = (f32x4){0.f, 0.f, 0.f, 0.f};
    {
        const bf16* WLT = (const bf16*)(ws + OFF_WLT) + (size_t)l * 512 * 320 + (size_t)(64 * wave + fr) * 320 + fq * 8;
#pragma unroll
        for (int ks = 0; ks < 10; ++ks) { const int o = ks < 2 ? 0 : (ks < 4 ? 1 : (ks < 6 ? 2 : 3));
            const bf16x8 af = *(const LAS bf16x8*)(ACT + fr * ACT_PITCH + ks * 32 + fq * 8);
#pragma unroll
            for (int nt = 0; nt < 4; ++nt) { const bf16x8 bf = *(const bf16x8*)(WLT + (size_t)nt * 16 * 320 + ks * 32);
                acc[o][nt] = __builtin_amdgcn_mfma_f32_16x16x32_bf16(af, bf, acc[o][nt], 0, 0, 0); } }
    }
    float* RW = (float*)(ws + OFF_RW); constexpr size_t AS = RW_ARR / 4; float* RSC = (float*)(ws + OFF_RSC);
    float w0f[4], w0b[4], a0c[4], kkc[4], kac[4], rkc[4];
#pragma unroll
    for (int nt = 0; nt < 4; ++nt) { const int c = 64 * wave + 16 * nt + fr; w0f[nt] = a->in[I_RW0][(l * 2 + 0) * 512 + c]; w0b[nt] = a->in[I_RW0][(l * 2 + 1) * 512 + c]; a0c[nt] = a->in[I_RA0][l * 512 + c];
        kkc[nt] = a->in[I_RKK][l * 512 + c]; kac[nt] = a->in[I_RKA][l * 512 + c]; rkc[nt] = a->in[I_RRK][l * 512 + c]; }
#pragma unroll
    for (int i = 0; i < 4; ++i) { const int tok = 4 * fq + i; const size_t R = (size_t)b * RJ + j0 + tok;
        float r[4], k[4], v[4], av[4], kkv[4]; float ss = 0.f;
#pragma unroll
        for (int nt = 0; nt < 4; ++nt) { const int c = 64 * wave + 16 * nt + fr; r[nt] = RP[tok * RP_PITCH + c]; k[nt] = KP[tok * RP_PITCH + c]; v[nt] = VP[tok * RP_PITCH + c];
            av[nt] = sigmoidf_(a0c[nt] + acc[2][nt][i]); kkv[nt] = k[nt] * kkc[nt]; ss += kkv[nt] * kkv[nt]; }
        const float rn = rsqrtf(row16_sum(ss) + 1e-12f);
        float c1 = 0.f, c2 = 0.f, bon = 0.f;
#pragma unroll
        for (int nt = 0; nt < 4; ++nt) { const int c = 64 * wave + 16 * nt + fr;
            const float wf = __expf(-__expf(-softplusf_(-(w0f[nt] + acc[0][nt][i])) - 0.5f)), wb = __expf(-__expf(-softplusf_(-(w0b[nt] + acc[1][nt][i])) - 0.5f));
            const float kk = kkv[nt] * rn, kmod = k[nt] * (1.f + (av[nt] - 1.f) * kac[nt]), ka = kk * av[nt];
            c1 += ka * r[nt]; c2 += kmod * r[nt]; bon += r[nt] * kmod * rkc[nt];
            float* o = RW + R * 512 + c;
            o[0 * AS] = wf; o[1 * AS] = wf * r[nt]; o[2 * AS] = wb; o[3 * AS] = wb * r[nt]; o[4 * AS] = kmod; o[5 * AS] = -kk; o[6 * AS] = ka; o[7 * AS] = v[nt]; o[8 * AS] = acc[3][nt][i]; }
        c1 = row16_sum(c1); c2 = row16_sum(c2); bon = row16_sum(bon);
        if (fr == 0) { RSC[R * 8 + h] = c1; RSC[(size_t)TT * 8 + R * 8 + h] = c2; RSC[(size_t)2 * TT * 8 + R * 8 + h] = bon; }
    }
    __syncthreads();
}
__device__ __forceinline__ void ssd_prep_item(KArgs a, int l, int item, int tid) {
    unsigned char* ws = a->ws; const bf16* U = (const bf16*)(ws + OFF_U); const float* MISC = (const float*)(ws + OFF_MISC);
    bf16* XBC = (bf16*)(ws + OFF_XBC); float* DTA = (float*)(ws + OFF_DTA);
    const int t0 = item * 16;
    const int seq_lo = t0 < TLAT ? (t0 & ~(LSEQ - 1)) : TLAT + ((t0 - TLAT) & ~(LCTX - 1)), seq_hi = seq_lo + (t0 < TLAT ? LSEQ : LCTX);
    for (int cp = tid; cp < 896; cp += NTHR) {
        float w0[5], w1[5];
#pragma unroll
        for (int j = 0; j < 5; ++j) { const f32x2 w = *(const f32x2*)(a->in[I_SCW] + (size_t)(l * 5 + j) * 1792 + 2 * cp); w0[j] = w.x; w1[j] = w.y; }
        const f32x2 bb = *(const f32x2*)(a->in[I_SCB] + l * 1792 + 2 * cp);
        float i0[20], i1[20];
#pragma unroll
        for (int r = 0; r < 20; ++r) { const int row = t0 - 2 + r; unsigned u = 0u; if (row >= seq_lo && row < seq_hi) u = *(const unsigned*)(U + (size_t)row * NU + UXBC + 2 * cp); i0[r] = bflo(u); i1[r] = bfhi(u); }
#pragma unroll
        for (int o = 0; o < 16; ++o) { float s0 = bb.x, s1 = bb.y;
#pragma unroll
            for (int j = 0; j < 5; ++j) { s0 += w0[j] * i0[o + j]; s1 += w1[j] * i1[o + j]; }
            *(unsigned*)(XBC + (size_t)(t0 + o) * 1792 + 2 * cp) = pk2(siluf_(s0), siluf_(s1)); }
    }
    if (tid < 16 * 24) { const int o = tid / 24, q = tid % 24;
        const float dt = softplusf_(MISC[(size_t)(t0 + o) * 512 + q] + a->in[I_SDTB][l * 24 + q]); const float A = -__expf(a->in[I_SALOG][l * 24 + q]);
        DTA[(size_t)(t0 + o) * 48 + q] = dt; DTA[(size_t)(t0 + o) * 48 + 24 + q] = dt * A; }
}
__device__ __forceinline__ void conv_item(KArgs a, int l, int item, LAS unsigned char* lds, int tid, int lane, int wave) {
    unsigned char* ws = a->ws; const bf16* U = (const bf16*)(ws + OFF_U); bf16* AC = (bf16*)(ws + OFF_ACONV);
    int t0, seg_lo, seg_hi;
    if (item < 256) { t0 = item * 32; seg_lo = t0 & ~63; seg_hi = seg_lo + 64; }
    else { const int ci = item - 256; t0 = TLAT + ci * 32; seg_lo = TLAT + (ci >> 3) * LCTX; seg_hi = seg_lo + LCTX; }
    LAS bf16* inimg = (LAS bf16*)lds;
    LAS float* outimg = (LAS float*)(lds + 63488);
    for (int idx = tid; idx < 62 * 64; idx += NTHR) { const int rr = idx >> 6, c8 = idx & 63, row = t0 - 15 + rr;
        v4u o = (v4u){0u, 0u, 0u, 0u};
        if (row >= seg_lo && row < seg_hi) { const v4u va = *(const v4u*)(U + (size_t)row * NU + UCONV + c8 * 8), vg = *(const v4u*)(U + (size_t)row * NU + UCONV + 512 + c8 * 8);
            o.x = pk2(bflo(va.x) * sigmoidf_(bflo(vg.x)), bfhi(va.x) * sigmoidf_(bfhi(vg.x))); o.y = pk2(bflo(va.y) * sigmoidf_(bflo(vg.y)), bfhi(va.y) * sigmoidf_(bfhi(vg.y)));
            o.z = pk2(bflo(va.z) * sigmoidf_(bflo(vg.z)), bfhi(va.z) * sigmoidf_(bfhi(vg.z))); o.w = pk2(bflo(va.w) * sigmoidf_(bflo(vg.w)), bfhi(va.w) * sigmoidf_(bfhi(vg.w))); }
        *(LAS v4u*)(inimg + rr * 512 + c8 * 8) = o; }
    __syncthreads();
    {
        const int c = tid; float w[31];
#pragma unroll
        for (int j = 0; j < 31; ++j) w[j] = a->in[I_CONVW][(size_t)(l * 31 + j) * 512 + c];
        const float bias = a->in[I_CONVB][l * 512 + c];
#pragma unroll 2
        for (int o = 0; o < 32; ++o) { float s = bias;
#pragma unroll
            for (int j = 0; j < 31; ++j) s += w[j] * bf2f(inimg[(o + j) * 512 + c]);
            outimg[o * 512 + c] = s; }
    }
    __syncthreads();
    {
        const f32x4 g0 = *(const f32x4*)(a->in[I_CLNG] + l * 512 + 8 * lane), g1 = *(const f32x4*)(a->in[I_CLNG] + l * 512 + 8 * lane + 4);
        const f32x4 b0 = *(const f32x4*)(a->in[I_CLNB] + l * 512 + 8 * lane), b1 = *(const f32x4*)(a->in[I_CLNB] + l * 512 + 8 * lane + 4);
#pragma unroll
        for (int q = 0; q < 4; ++q) { const int o = wave * 4 + q;
            f32x4 x0 = *(const LAS f32x4*)(outimg + o * 512 + 8 * lane), x1 = *(const LAS f32x4*)(outimg + o * 512 + 8 * lane + 4);
            const float mean = wave_sum((x0.x + x0.y + x0.z + x0.w) + (x1.x + x1.y + x1.z + x1.w)) * (1.f / 512.f);
            x0 = x0 - mean; x1 = x1 - mean;
            const float var = wave_sum((x0.x * x0.x + x0.y * x0.y + x0.z * x0.z + x0.w * x0.w) + (x1.x * x1.x + x1.y * x1.y + x1.z * x1.z + x1.w * x1.w)) * (1.f / 512.f);
            const float rs = rsqrtf(var + 1e-5f);
            x0 = x0 * rs * g0 + b0; x1 = x1 * rs * g1 + b1;
            v4u ov; ov.x = pk2(siluf_(x0.x), siluf_(x0.y)); ov.y = pk2(siluf_(x0.z), siluf_(x0.w)); ov.z = pk2(siluf_(x1.x), siluf_(x1.y)); ov.w = pk2(siluf_(x1.z), siluf_(x1.w));
            *(v4u*)(AC + (size_t)(t0 + o) * 512 + 8 * lane) = ov; }
    }
    __syncthreads();
}

__device__ __forceinline__ int ssd_tok(int b, int dir, int pos) {
    if (pos < LCTX) return TLAT + b * LCTX + (dir ? (LCTX - 1 - pos) : pos);
    const int q = pos - LCTX; return b * LSEQ + (dir ? (LSEQ - 1 - q) : q);
}
__device__ __forceinline__ void ssd_scan_simple(KArgs a, int idx, int tid) {
    unsigned char* ws = a->ws; const bf16* XBC = (const bf16*)(ws + OFF_XBC); const float* DTA = (const float*)(ws + OFF_DTA);
    const int b = idx / 24, dir = (idx % 24) / 12, h = idx % 12, g = h / 3, p = tid >> 3, n0 = (tid & 7) * 16, q = dir * 12 + h;
    float* Yo = (float*)(ws + OFF_YSSD) + (size_t)dir * TT * 768;
    float hs[16];
#pragma unroll
    for (int i = 0; i < 16; ++i) hs[i] = 0.f;
    for (int pos = 0; pos < RJ; ++pos) {
        const int tok = ssd_tok(b, dir, pos);
        const float dt = DTA[(size_t)tok * 48 + q], dec = __expf(DTA[(size_t)tok * 48 + 24 + q]);
        const bf16* row = XBC + (size_t)tok * 1792;
        const float xd = bf2f(row[h * 64 + p]) * dt;
        const v4u B0 = *(const v4u*)(row + 768 + g * 128 + n0), B1 = *(const v4u*)(row + 768 + g * 128 + n0 + 8);
        const v4u C0 = *(const v4u*)(row + 1280 + g * 128 + n0), C1 = *(const v4u*)(row + 1280 + g * 128 + n0 + 8);
        const float Bv[16] = {bflo(B0.x), bfhi(B0.x), bflo(B0.y), bfhi(B0.y), bflo(B0.z), bfhi(B0.z), bflo(B0.w), bfhi(B0.w), bflo(B1.x), bfhi(B1.x), bflo(B1.y), bfhi(B1.y), bflo(B1.z), bfhi(B1.z), bflo(B1.w), bfhi(B1.w)};
        const float Cv[16] = {bflo(C0.x), bfhi(C0.x), bflo(C0.y), bfhi(C0.y), bflo(C0.z), bfhi(C0.z), bflo(C0.w), bfhi(C0.w), bflo(C1.x), bfhi(C1.x), bflo(C1.y), bfhi(C1.y), bflo(C1.z), bfhi(C1.z), bflo(C1.w), bfhi(C1.w)};
        float yp = 0.f;
#pragma unroll
        for (int i = 0; i < 16; ++i) { hs[i] = hs[i] * dec + xd * Bv[i]; yp += hs[i] * Cv[i]; }
        yp += __shfl_xor(yp, 1); yp += __shfl_xor(yp, 2); yp += __shfl_xor(yp, 4);
        if ((tid & 7) == 0) Yo[(size_t)tok * 768 + h * 64 + p] = yp;
    }
}
__device__ __forceinline__ void rwkv_scan_simple(KArgs a, int idx, int tid) {
    unsigned char* ws = a->ws; const float* RW = (const float*)(ws + OFF_RW); constexpr size_t AS = RW_ARR / 4; const float* RSC = (const float*)(ws + OFF_RSC);
    const int b = idx / 16, dir = (idx % 16) / 8, h = idx % 8, v = tid >> 3, k0 = (tid & 7) * 8;
    float* Yo = (float*)(ws + OFF_YRW) + (size_t)dir * TT * 512;
    const float* Wd = RW + (dir ? 2 : 0) * AS; const float* WRd = RW + (dir ? 3 : 1) * AS;
    float S[8];
#pragma unroll
    for (int i = 0; i < 8; ++i) S[i] = 0.f;
    for (int pos = 0; pos < RJ; ++pos) {
        const int j = dir ? (pos < LCTX ? (LCTX - 1 - pos) : (RJ + LCTX - 1 - pos)) : pos;
        const size_t R = (size_t)b * RJ + j; const size_t o = R * 512 + h * 64 + k0;
        const f32x4 w0 = *(const f32x4*)(Wd + o), w1 = *(const f32x4*)(Wd + o + 4), r0 = *(const f32x4*)(WRd + o), r1 = *(const f32x4*)(WRd + o + 4);
        const f32x4 kA = *(const f32x4*)(RW + 4 * AS + o), kB = *(const f32x4*)(RW + 4 * AS + o + 4), nA = *(const f32x4*)(RW + 5 * AS + o), nB = *(const f32x4*)(RW + 5 * AS + o + 4);
        const f32x4 aA = *(const f32x4*)(RW + 6 * AS + o), aB = *(const f32x4*)(RW + 6 * AS + o + 4);
        const float vv = RW[7 * AS + R * 512 + h * 64 + v], c1 = RSC[R * 8 + h], c2 = RSC[(size_t)TT * 8 + R * 8 + h];
        const float w[8] = {w0.x, w0.y, w0.z, w0.w, w1.x, w1.y, w1.z, w1.w}, wr[8] = {r0.x, r0.y, r0.z, r0.w, r1.x, r1.y, r1.z, r1.w};
        const float kk_[8] = {kA.x, kA.y, kA.z, kA.w, kB.x, kB.y, kB.z, kB.w}, kn[8] = {nA.x, nA.y, nA.z, nA.w, nB.x, nB.y, nB.z, nB.w}, ka[8] = {aA.x, aA.y, aA.z, aA.w, aB.x, aB.y, aB.z, aB.w};
        float sa = 0.f, pp = 0.f;
#pragma unroll
        for (int i = 0; i < 8; ++i) { sa += S[i] * kn[i]; pp += S[i] * wr[i]; }
        sa += __shfl_xor(sa, 1); pp += __shfl_xor(pp, 1); sa += __shfl_xor(sa, 2); pp += __shfl_xor(pp, 2); sa += __shfl_xor(sa, 4); pp += __shfl_xor(pp, 4);
#pragma unroll
        for (int i = 0; i < 8; ++i) S[i] = S[i] * w[i] + sa * ka[i] + vv * kk_[i];
        if ((tid & 7) == 0) Yo[R * 512 + h * 64 + v] = pp + sa * c1 + vv * c2;
    }
}

__device__ __forceinline__ void post_phase(KArgs a, int l, int bid, int G) {
    PH_IDS
    unsigned char* ws = a->ws; const int gw = bid * NWAVES + wave, NGW = G * NWAVES;
    const bf16* U = (const bf16*)(ws + OFF_U); const bf16* XBC = (const bf16*)(ws + OFF_XBC);
    const float* Y0 = (const float*)(ws + OFF_YSSD); const float* Y1 = Y0 + (size_t)TT * 768; bf16* AS_ = (bf16*)(ws + OFF_ASSD);
    for (int row = gw; row < TT; row += NGW) {
        f32x4 y[3]; float ss = 0.f;
#pragma unroll
        for (int j = 0; j < 3; ++j) { const int col = 4 * lane + 256 * j; const float dsk = a->in[I_SD][l * 12 + (col >> 6)];
            const f32x4 yf = *(const f32x4*)(Y0 + (size_t)row * 768 + col), yb = *(const f32x4*)(Y1 + (size_t)row * 768 + col);
            const v2u xs = *(const v2u*)(XBC + (size_t)row * 1792 + col), z = *(const v2u*)(U + (size_t)row * NU + UZ + col);
            f32x4 v = yf + yb + dsk * (f32x4){bflo(xs.x), bfhi(xs.x), bflo(xs.y), bfhi(xs.y)};
            v = v * (f32x4){siluf_(bflo(z.x)), siluf_(bfhi(z.x)), siluf_(bflo(z.y)), siluf_(bfhi(z.y))};
            y[j] = v; ss += (v.x * v.x + v.y * v.y) + (v.z * v.z + v.w * v.w); }
        const float r = rsqrtf(wave_sum(ss) * (1.f / 768.f) + 1e-6f);
#pragma unroll
        for (int j = 0; j < 3; ++j) { const int col = 4 * lane + 256 * j; const f32x4 g = *(const f32x4*)(a->in[I_SNG] + l * 768 + col); const f32x4 o = y[j] * r * g;
            *(v2u*)(AS_ + (size_t)row * 768 + col) = (v2u){pk2(o.x, o.y), pk2(o.z, o.w)}; }
    }
    const float* RW = (const float*)(ws + OFF_RW); constexpr size_t AS = RW_ARR / 4; const float* RSC = (const float*)(ws + OFF_RSC);
    const float* R0 = (const float*)(ws + OFF_YRW); const float* R1 = R0 + (size_t)TT * 512; bf16* AR = (bf16*)(ws + OFF_ARWKV);
    for (int row = gw; row < TT; row += NGW) {
        size_t R;
        if (row < TLAT) { const int b = row >> 11, t = row & 2047, rr = t >> 6, cc = t & 63; R = (size_t)b * RJ + LCTX + cc * 32 + rr; }
        else { const int b = (row - TLAT) >> 8, jj = (row - TLAT) & 255; R = (size_t)b * RJ + jj; }
        const int c0 = 8 * lane, h = lane >> 3;
        f32x4 ya = *(const f32x4*)(R0 + R * 512 + c0) + *(const f32x4*)(R1 + R * 512 + c0), yb = *(const f32x4*)(R0 + R * 512 + c0 + 4) + *(const f32x4*)(R1 + R * 512 + c0 + 4);
        float s = (ya.x + ya.y + ya.z + ya.w) + (yb.x + yb.y + yb.z + yb.w);
        s += __shfl_xor(s, 1); s += __shfl_xor(s, 2); s += __shfl_xor(s, 4);
        const float mean = s * (1.f / 64.f); ya = ya - mean; yb = yb - mean;
        float q = (ya.x * ya.x + ya.y * ya.y + ya.z * ya.z + ya.w * ya.w) + (yb.x * yb.x + yb.y * yb.y + yb.z * yb.z + yb.w * yb.w);
        q += __shfl_xor(q, 1); q += __shfl_xor(q, 2); q += __shfl_xor(q, 4);
        const float rs = rsqrtf(q * (1.f / 64.f) + 64e-5f);
        const f32x4 lg0 = *(const f32x4*)(a->in[I_RLNG] + l * 512 + c0), lg1 = *(const f32x4*)(a->in[I_RLNG] + l * 512 + c0 + 4), lb0 = *(const f32x4*)(a->in[I_RLNB] + l * 512 + c0), lb1 = *(const f32x4*)(a->in[I_RLNB] + l * 512 + c0 + 4);
        const float bon = RSC[(size_t)2 * TT * 8 + R * 8 + h];
        const f32x4 v0 = *(const f32x4*)(RW + 7 * AS + R * 512 + c0), v1 = *(const f32x4*)(RW + 7 * AS + R * 512 + c0 + 4), g0 = *(const f32x4*)(RW + 8 * AS + R * 512 + c0), g1 = *(const f32x4*)(RW + 8 * AS + R * 512 + c0 + 4);
        const f32x4 o0 = (ya * rs * lg0 + lb0 + bon * v0) * g0, o1 = (yb * rs * lg1 + lb1 + bon * v1) * g1;
        *(v4u*)(AR + (size_t)row * 512 + c0) = (v4u){pk2(o0.x, o0.y), pk2(o0.z, o0.w), pk2(o1.x, o1.y), pk2(o1.z, o1.w)};
    }
}

__device__ __forceinline__ size_t rwkv_row(int b, int dir, int pos) { const int j = dir ? (pos < LCTX ? (LCTX - 1 - pos) : (RJ + LCTX - 1 - pos)) : pos; return (size_t)b * RJ + j; }
constexpr int RWS_BUF = 45568, RWS_V = 40960, RWS_C = 45056, RWS_CH = 32;
__device__ __forceinline__ void rwkv_scan_fast(KArgs a, int idx, LAS unsigned char* lds, int tid, int lane, int wave) {
    unsigned char* ws = a->ws; const float* RW = (const float*)(ws + OFF_RW); constexpr size_t AS = RW_ARR / 4; const float* RSC = (const float*)(ws + OFF_RSC);
    const int combo = idx >> 1, half = idx & 1, b = combo >> 4, dir = (combo >> 3) & 1, h = combo & 7, v0 = half * 32;
    float* Yo = (float*)(ws + OFF_YRW) + (size_t)dir * TT * 512;
    const float* arr0 = RW + (dir ? 2 : 0) * AS; const float* arr1 = RW + (dir ? 3 : 1) * AS;
    const int ls = tid >> 4, lc4 = tid & 15;
    f32x4 pre[5]; f32x4 prev = (f32x4){0.f, 0.f, 0.f, 0.f}; float prec = 0.f;
    auto issue = [&](int chunk) {
        const size_t R = rwkv_row(b, dir, chunk * RWS_CH + ls); const size_t o = R * 512 + h * 64 + lc4 * 4;
        pre[0] = *(const f32x4*)(arr0 + o); pre[1] = *(const f32x4*)(arr1 + o); pre[2] = *(const f32x4*)(RW + 4 * AS + o); pre[3] = *(const f32x4*)(RW + 5 * AS + o); pre[4] = *(const f32x4*)(RW + 6 * AS + o);
        if (tid < 256) { const size_t R2 = rwkv_row(b, dir, chunk * RWS_CH + (tid >> 3)); prev = *(const f32x4*)(RW + 7 * AS + R2 * 512 + h * 64 + v0 + (tid & 7) * 4); }
        else if (tid < 320) { const int t2 = tid - 256; const size_t R2 = rwkv_row(b, dir, chunk * RWS_CH + (t2 >> 1)); prec = RSC[(size_t)(t2 & 1) * TT * 8 + R2 * 8 + h]; }
    };
    auto commit = [&](int buf) {
        LAS unsigned char* B = lds + buf * RWS_BUF;
#pragma unroll
        for (int i = 0; i < 5; ++i) *(LAS f32x4*)(B + i * 8192 + ls * 256 + lc4 * 16) = pre[i];
        if (tid < 256) *(LAS f32x4*)(B + RWS_V + (tid >> 3) * 128 + (tid & 7) * 16) = prev;
        else if (tid < 320) *(LAS float*)(B + RWS_C + (tid - 256) * 4) = prec;
    };
    f32x4 S0 = (f32x4){0.f, 0.f, 0.f, 0.f}, S1 = S0;
    const int rl = (wave & 3) * 8 + (lane >> 3), q = lane & 7;
    LAS float* ybuf = (LAS float*)(lds + 2 * RWS_BUF);
    issue(0); commit(0); __syncthreads();
    constexpr int NCH = RJ / RWS_CH;
    struct RwOp { f32x4 w0, w1, r0, r1, k0, k1, n0, n1, a0, a1; float vv; f32x2 cc; };
    for (int ch = 0; ch < NCH; ++ch) {
        if (ch + 1 < NCH) issue(ch + 1);
        if (wave < 4) {
            const LAS unsigned char* B = lds + (ch & 1) * RWS_BUF; const LAS unsigned char* p0 = B + q * 32; const LAS unsigned char* pv = B + RWS_V + rl * 4;
            LAS float* yb = ((q == 0) ? (ybuf + (ch & 1) * 1024) : (ybuf + 2048)) + rl;
            auto ldop = [&](int s) { RwOp o; const LAS unsigned char* p = p0 + s * 256;
                o.w0 = *(const LAS f32x4*)(p); o.w1 = *(const LAS f32x4*)(p + 16); o.r0 = *(const LAS f32x4*)(p + 8192); o.r1 = *(const LAS f32x4*)(p + 8192 + 16);
                o.k0 = *(const LAS f32x4*)(p + 16384); o.k1 = *(const LAS f32x4*)(p + 16384 + 16); o.n0 = *(const LAS f32x4*)(p + 24576); o.n1 = *(const LAS f32x4*)(p + 24576 + 16);
                o.a0 = *(const LAS f32x4*)(p + 32768); o.a1 = *(const LAS f32x4*)(p + 32768 + 16);
                o.vv = *(const LAS float*)(pv + s * 128); o.cc = *(const LAS f32x2*)(B + RWS_C + s * 8); return o; };
            RwOp cur = ldop(0);
#pragma unroll
            for (int s = 0; s < RWS_CH; ++s) {
                RwOp nxt = cur; if (s + 1 < RWS_CH) nxt = ldop(s + 1);
                const f32x4 t0 = S0 * cur.n0 + S1 * cur.n1, t1 = S0 * cur.r0 + S1 * cur.r1;
                float sa = (t0.x + t0.y) + (t0.z + t0.w), pp = (t1.x + t1.y) + (t1.z + t1.w);
                sa = dpp_add<0xB1>(sa); pp = dpp_add<0xB1>(pp); sa = dpp_add<0x4E>(sa); pp = dpp_add<0x4E>(pp); sa = dpp_add<0x141>(sa); pp = dpp_add<0x141>(pp);
                S0 = S0 * cur.w0 + (sa * cur.a0 + cur.vv * cur.k0); S1 = S1 * cur.w1 + (sa * cur.a1 + cur.vv * cur.k1);
                const float y = pp + sa * cur.cc.x + cur.vv * cur.cc.y;
                yb[s * 32] = y;
                cur = nxt;
            }
        } else if (ch > 0) {
            const int t2 = tid - 256, s = t2 >> 3, r4 = t2 & 7; const size_t R = rwkv_row(b, dir, (ch - 1) * RWS_CH + s);
            *(f32x4*)(Yo + R * 512 + h * 64 + v0 + r4 * 4) = *(const LAS f32x4*)(ybuf + ((ch - 1) & 1) * 1024 + s * 32 + r4 * 4);
        }
        if (ch + 1 < NCH) commit((ch + 1) & 1);
        __syncthreads();
    }
    if (wave >= 4) { const int t2 = tid - 256, s = t2 >> 3, r4 = t2 & 7; const size_t R = rwkv_row(b, dir, (NCH - 1) * RWS_CH + s);
        *(f32x4*)(Yo + R * 512 + h * 64 + v0 + r4 * 4) = *(const LAS f32x4*)(ybuf + ((NCH - 1) & 1) * 1024 + s * 32 + r4 * 4); }
    __syncthreads();
}

constexpr int SS_CM = 0, SS_BM = 17408, SS_BST = 34816, SS_XT = 53248, SS_MX = 62464, SS_HB = 71680, SS_CS = 89088, SS_DT = 89344;
__device__ __forceinline__ float bfe(const v4u& v, int i) { const unsigned u = (i < 2) ? v.x : (i < 4) ? v.y : (i < 6) ? v.z : v.w; return (i & 1) ? bfhi(u) : bflo(u); }
__device__ __forceinline__ unsigned short bfraw(const v4u& v, int i) { const unsigned u = (i < 2) ? v.x : (i < 4) ? v.y : (i < 6) ? v.z : v.w; return (unsigned short)((i & 1) ? (u >> 16) : (u & 0xffffu)); }
__device__ __forceinline__ void ssd_scan_fast(KArgs a, int idx, LAS unsigned char* lds, int tid, int lane, int wave) {
    unsigned char* ws = a->ws; const bf16* XBC = (const bf16*)(ws + OFF_XBC); const float* DTA = (const float*)(ws + OFF_DTA);
    const int b = idx / 24, dir = (idx % 24) / 12, h = idx % 12, g = h / 3, q = dir * 12 + h;
    float* Yo = (float*)(ws + OFF_YSSD) + (size_t)dir * TT * 768;
    LAS bf16* Cm = (LAS bf16*)(lds + SS_CM); LAS bf16* Bm = (LAS bf16*)(lds + SS_BM); LAS bf16* BsT = (LAS bf16*)(lds + SS_BST); LAS bf16* XT = (LAS bf16*)(lds + SS_XT);
    LAS bf16* Mx = (LAS bf16*)(lds + SS_MX); LAS bf16* Hb = (LAS bf16*)(lds + SS_HB); LAS float* CS = (LAS float*)(lds + SS_CS); LAS float* DTV = (LAS float*)(lds + SS_DT);
    const int fr = lane & 15, fq = lane >> 4, ss = tid & 63, sc = tid >> 6, tl = wave >> 1, wh = wave & 1;
    { unsigned z = 0u; asm volatile("" : "+v"(z)); for (int i = tid; i < 17408 / 16; i += NTHR) *(LAS v4u*)(lds + SS_HB + i * 16) = (v4u){z, z, z, z}; }
    f32x4 hacc[4];
#pragma unroll
    for (int j = 0; j < 4; ++j) hacc[j] = (f32x4){0.f, 0.f, 0.f, 0.f};
    v4u pc0, pc1, pb0, pb1, px; float pdt = 0.f, pa = 0.f;
    auto issue = [&](int ch) {
        const int tok = ssd_tok(b, dir, ch * 64 + ss); const bf16* row = XBC + (size_t)tok * 1792;
        pc0 = *(const v4u*)(row + 1280 + g * 128 + sc * 8); pc1 = *(const v4u*)(row + 1280 + g * 128 + (sc + 8) * 8);
        pb0 = *(const v4u*)(row + 768 + g * 128 + sc * 8); pb1 = *(const v4u*)(row + 768 + g * 128 + (sc + 8) * 8);
        px = *(const v4u*)(row + h * 64 + sc * 8);
        if (tid < 64) { pdt = DTA[(size_t)tok * 48 + q]; pa = DTA[(size_t)tok * 48 + 24 + q]; }
    };
    issue(0);
    for (int ch = 0; ch < RJ / 64; ++ch) {
        *(LAS v4u*)(Cm + ss * 136 + sc * 8) = pc0; *(LAS v4u*)(Cm + ss * 136 + (sc + 8) * 8) = pc1;
        *(LAS v4u*)(Bm + ss * 136 + sc * 8) = pb0; *(LAS v4u*)(Bm + ss * 136 + (sc + 8) * 8) = pb1;
#pragma unroll
        for (int i = 0; i < 8; ++i) XT[(sc * 8 + i) * 72 + ss] = bfraw(px, i);
        if (tid < 64) { float x = pa;
#pragma unroll
            for (int o = 1; o < 64; o <<= 1) { const float t = __shfl_up(x, o); if (lane >= o) x += t; }
            CS[tid] = x; DTV[tid] = pdt; }
        __syncthreads();
        const float cl = CS[63];
        { const float scl = DTV[ss] * __expf(cl - CS[ss]);
#pragma unroll
            for (int i = 0; i < 8; ++i) { BsT[(sc * 8 + i) * 72 + ss] = (bf16)f2bf(bfe(pb0, i) * scl); BsT[((sc + 8) * 8 + i) * 72 + ss] = (bf16)f2bf(bfe(pb1, i) * scl); } }
        if (ch + 1 < RJ / 64) issue(ch + 1);
#pragma unroll
        for (int j = 0; j < 2; ++j) { const int tc = wh * 2 + j; f32x4 acc = (f32x4){0.f, 0.f, 0.f, 0.f};
            if (tc <= tl) {
#pragma unroll
                for (int ks = 0; ks < 4; ++ks) { const bf16x8 af = *(const LAS bf16x8*)(Cm + (16 * tl + fr) * 136 + ks * 32 + fq * 8), bf = *(const LAS bf16x8*)(Bm + (16 * tc + fr) * 136 + ks * 32 + fq * 8);
                    acc = __builtin_amdgcn_mfma_f32_16x16x32_bf16(af, bf, acc, 0, 0, 0); } }
            const int s = 16 * tc + fr; const float css = CS[s], dts = DTV[s];
#pragma unroll
            for (int i = 0; i < 4; ++i) { const int l = 16 * tl + 4 * fq + i; const float v = (s <= l) ? acc[i] * __expf(CS[l] - css) * dts : 0.f; Mx[l * 72 + s] = (bf16)f2bf(v); } }
        __syncthreads();
#pragma unroll
        for (int j = 0; j < 2; ++j) { const int tp = wh * 2 + j; f32x4 acc = (f32x4){0.f, 0.f, 0.f, 0.f};
#pragma unroll
            for (int ks = 0; ks < 4; ++ks) { const bf16x8 af = *(const LAS bf16x8*)(Cm + (16 * tl + fr) * 136 + ks * 32 + fq * 8), bf = *(const LAS bf16x8*)(Hb + (16 * tp + fr) * 136 + ks * 32 + fq * 8);
                acc = __builtin_amdgcn_mfma_f32_16x16x32_bf16(af, bf, acc, 0, 0, 0); }
#pragma unroll
            for (int i = 0; i < 4; ++i) acc[i] *= __expf(CS[16 * tl + 4 * fq + i]);
#pragma unroll
            for (int ks = 0; ks < 2; ++ks) { const bf16x8 af = *(const LAS bf16x8*)(Mx + (16 * tl + fr) * 72 + ks * 32 + fq * 8), bf = *(const LAS bf16x8*)(XT + (16 * tp + fr) * 72 + ks * 32 + fq * 8);
                acc = __builtin_amdgcn_mfma_f32_16x16x32_bf16(af, bf, acc, 0, 0, 0); }
#pragma unroll
            for (int i = 0; i < 4; ++i) { const int tok = ssd_tok(b, dir, ch * 64 + 16 * tl + 4 * fq + i); Yo[(size_t)tok * 768 + h * 64 + 16 * tp + fr] = acc[i]; } }
        { const float ecl = __expf(cl);
#pragma unroll
            for (int j = 0; j < 4; ++j) { const int tn = wh * 4 + j; hacc[j] = hacc[j] * ecl;
#pragma unroll
                for (int ks = 0; ks < 2; ++ks) { const bf16x8 af = *(const LAS bf16x8*)(XT + (16 * tl + fr) * 72 + ks * 32 + fq * 8), bf = *(const LAS bf16x8*)(BsT + (16 * tn + fr) * 72 + ks * 32 + fq * 8);
                    hacc[j] = __builtin_amdgcn_mfma_f32_16x16x32_bf16(af, bf, hacc[j], 0, 0, 0); } } }
        __syncthreads();
#pragma unroll
        for (int j = 0; j < 4; ++j) { const int tn = wh * 4 + j;
#pragma unroll
            for (int i = 0; i < 4; ++i) Hb[(16 * tl + 4 * fq + i) * 136 + 16 * tn + fr] = (bf16)f2bf(hacc[j][i]); }
    }
}

constexpr int NPH = 2 + 10 * DEPTH;
#ifndef PROBE_MASK
#define PROBE_MASK 0
#endif
#ifndef PROBE_P0
#define PROBE_P0 0
#endif
#ifndef PROBE_SUB
#define PROBE_SUB 0
#endif
#ifndef PROBE_REPS
#define PROBE_REPS 3
#endif
#define REPS(k) (((PROBE_MASK >> (k)) & 1) ? PROBE_REPS : 1)
#ifndef MK_ONE_LAUNCH
#define MK_ONE_LAUNCH 1
#endif

__global__ void __launch_bounds__(NTHR, 2) fwd(Args a_unused) {
    extern __shared__ __attribute__((aligned(16))) unsigned char lds_raw[];
    LAS unsigned char* lds = (LAS unsigned char*)lds_raw;
    const int bid0 = blockIdx.x, G0 = gridDim.x;
#define PH_BG int bid = bid0, G = G0; asm volatile("" : "+s"(bid), "+s"(G));
    volatile LAS unsigned* MISCW = (volatile LAS unsigned*)(lds + MISC_OFF);
    if (threadIdx.x < 32) MISCW[threadIdx.x] = 0u;
    __syncthreads();
    const int ph_lo = kargs()->ph_lo, ph_hi = kargs()->ph_hi;
    const bool multi = (ph_hi - ph_lo) > 1;
    XcdBarrier bar; bar.bar = (unsigned*)(kargs()->ws + OFF_CTL) + CW_BAR; bar.x = 0; bar.st = nullptr;
    if (multi) bar = xcd_barrier_post((unsigned*)(kargs()->ws + OFF_CTL) + CW_BAR, MISCW + 8);
#define IN(k) (ph_lo <= (k) && (k) < ph_hi)
#define SEAM(k) do { if (IN(k) && IN((k) + 1)) xcd_barrier(bar); } while (0)

    for (int rep = 0; rep < (PROBE_P0 ? PROBE_REPS : 1); ++rep) {
    if (IN(0)) { PH_BG p0_prologue(kargs(), lds, bid, G); }
    if (rep + 1 < (PROBE_P0 ? PROBE_REPS : 1)) xcd_barrier(bar); }
    SEAM(0);
    if (IN(1)) { PH_BG KArgs a = kargs(); norm_phase(a, 0, nullptr, a->in[I_NORMG] + 0, nullptr, (const float*)(a->ws + OFF_MODV), bid, G); }
    SEAM(1);

    for (int l = 0; l < DEPTH; ++l) {
        const int pb = 2 + 10 * l;
#define PH_LOCALS PH_BG KArgs a = kargs(); unsigned char* ws = a->ws; unsigned char* wl = ws + OFF_W + (size_t)l * W_LAYER; bf16* Hb = (bf16*)(ws + OFF_H); (void)wl; (void)Hb; \
        const float* ng = a->in[I_NORMG] + (size_t)l * 4 * DM; const float* mv = (const float*)(ws + OFF_MODV) + (size_t)l * 5 * 12288; (void)ng; (void)mv;
        for (int rep = 0; rep < REPS(0); ++rep) {
        if (IN(pb + 0)) { PH_LOCALS
            __syncthreads();
            { pg8::Gemm g{Hb, (const bf16*)(wl + WO_IN), TT, NU, DM}; pg8::StaticOrder S; S.init(TT, NU, G, bid);
              pg8::EpiInproj E{(bf16*)(ws + OFF_U), (float*)(ws + OFF_MISC), NU};
              pg8::gemm_phase<pg8::EpiInproj, pg8::StaticOrder, true, true>(lds, g, S, E); }
            { pg8::Gemm g{(const bf16*)(wl + WO_FFT), Hb, 1024, TT, DM}; pg8::StaticOrder S; S.init(1024, TT, G, bid);
              pg8::EpiBf E{0, (bf16*)(ws + OFF_VTL), (bf16*)(ws + OFF_VTC)};
              pg8::gemm_phase<pg8::EpiBf, pg8::StaticOrder, true, true>(lds, g, S, E); }
        }
        if (rep + 1 < REPS(0)) xcd_barrier(bar); }
        SEAM(pb + 0);
        for (int rep = 0; rep < REPS(1); ++rep) {
        if (IN(pb + 1)) { PH_LOCALS PH_IDS
            __syncthreads();
            if (bid < 64) { pg8::Gemm g{(const bf16*)(ws + OFF_DFTL), (const bf16*)(ws + OFF_VTL), 2048, 2048, 4096}; pg8::StaticOrder S; S.init(2048, 2048, 64, bid);
                  pg8::EpiBf E{1, (bf16*)(ws + OFF_AFFT), nullptr};
                  pg8::gemm_phase<pg8::EpiBf, pg8::StaticOrder, true, true>(lds, g, S, E); }
            else if (bid < 72) { pg8::Gemm g{(const bf16*)(ws + OFF_DFTC), (const bf16*)(ws + OFF_VTC), 256, 2048, 512}; pg8::StaticOrder S; S.init(256, 2048, 8, bid - 64);
                  pg8::EpiBf E{2, (bf16*)(ws + OFF_AFFT), nullptr};
                  pg8::gemm_phase<pg8::EpiBf, pg8::StaticOrder, true, true>(lds, g, S, E); }
            __syncthreads();
            {
                unsigned* qctr = (unsigned*)(ws + OFF_CTL) + CW_Q + (l * 4 + rep) * 64;
                volatile LAS unsigned* qslot = (volatile LAS unsigned*)(lds + MISC_OFF) + 16;
                for (;;) {
                    if (tid == 0) qslot[0] = __hip_atomic_fetch_add(qctr, 1u, __ATOMIC_RELAXED, __HIP_MEMORY_SCOPE_AGENT);
                    __syncthreads();
                    const int it = (int)qslot[0];
                    __syncthreads();
                    if (it >= 576 + 288 + 576) break;
                    if (it < 576) rwkv_prep_item(a, l, it, lds, tid, lane, wave);
                    else if (it < 576 + 288) conv_item(a, l, it - 576, lds, tid, lane, wave);
                    else ssd_prep_item(a, l, it - 576 - 288, tid);
                }
            }
        }
        if (rep + 1 < REPS(1)) xcd_barrier(bar); }
        SEAM(pb + 1);
        for (int rep = 0; rep < REPS(2); ++rep) {
        if (IN(pb + 2)) { PH_LOCALS PH_IDS
            __syncthreads();
            if (bid < 128) { if (rep == 0 || PROBE_SUB == 0) rwkv_scan_fast(a, bid, lds, tid, lane, wave); }
            else if (bid < 224) { if (rep == 0 || PROBE_SUB == 1) ssd_scan_fast(a, bid - 128, lds, tid, lane, wave); }
        }
        if (rep + 1 < REPS(2)) xcd_barrier(bar); }
        SEAM(pb + 2);
        for (int rep = 0; rep < REPS(3); ++rep) {
        if (IN(pb + 3)) { PH_BG post_phase(kargs(), l, bid, G); }
        if (rep + 1 < REPS(3)) xcd_barrier(bar); }
        SEAM(pb + 3);
        for (int rep = 0; rep < REPS(4); ++rep) {
        if (IN(pb + 4)) { PH_LOCALS
            __syncthreads();
            const bf16* Gt = (const bf16*)(ws + OFF_U) + UGATE; float* MB = (float*)(ws + OFF_MBUF); bf16* Mo = (bf16*)(ws + OFF_M);
            pg8::StaticOrder S; S.init(TT, DM, G, bid);
            { pg8::Gemm g{(const bf16*)(ws + OFF_ACONV), (const bf16*)(wl + WO_CO), TT, DM, 512}; pg8::EpiMerge E{Gt + 0 * DM, NU, MB, Mo, 0}; pg8::gemm_phase<pg8::EpiMerge, pg8::StaticOrder, true, true>(lds, g, S, E); }
            { pg8::Gemm g{(const bf16*)(ws + OFF_ASSD), (const bf16*)(wl + WO_SO), TT, DM, 768}; pg8::EpiMerge E{Gt + 1 * DM, NU, MB, Mo, 1}; pg8::gemm_phase<pg8::EpiMerge, pg8::StaticOrder, true, true>(lds, g, S, E); }
            { pg8::Gemm g{(const bf16*)(ws + OFF_AFFT), (const bf16*)(wl + WO_FO), TT, DM, 512}; pg8::EpiMerge E{Gt + 2 * DM, NU, MB, Mo, 2}; pg8::gemm_phase<pg8::EpiMerge, pg8::StaticOrder, true, true>(lds, g, S, E); }
            { pg8::Gemm g{(const bf16*)(ws + OFF_ARWKV), (const bf16*)(wl + WO_RO), TT, DM, 512}; pg8::EpiMerge E{Gt + 3 * DM, NU, MB, Mo, 3}; pg8::gemm_phase<pg8::EpiMerge, pg8::StaticOrder, true, true>(lds, g, S, E); }
        }
        if (rep + 1 < REPS(4)) xcd_barrier(bar); }
        SEAM(pb + 4);
        for (int rep = 0; rep < REPS(5); ++rep) {
        if (IN(pb + 5)) { PH_LOCALS
            __syncthreads();
            pg8::Gemm g{(const bf16*)(ws + OFF_M), (const bf16*)(wl + WO_O), TT, DM, DM}; pg8::StaticOrder S; S.init(TT, DM, G, bid);
            pg8::EpiF32 E{(float*)(ws + OFF_Y), DM};
            pg8::gemm_phase<pg8::EpiF32, pg8::StaticOrder, true, true>(lds, g, S, E);
        }
        if (rep + 1 < REPS(5)) xcd_barrier(bar); }
        SEAM(pb + 5);
        for (int rep = 0; rep < REPS(6); ++rep) {
        if (IN(pb + 6)) { PH_LOCALS norm_phase(a, 1, ng + 1 * DM, ng + 2 * DM, mv + 2 * DM, mv + 3 * DM, bid, G); }
        if (rep + 1 < REPS(6)) xcd_barrier(bar); }
        SEAM(pb + 6);
        for (int rep = 0; rep < REPS(7); ++rep) {
        if (IN(pb + 7)) { PH_LOCALS
            __syncthreads();
            pg8::Gemm g{Hb, (const bf16*)(wl + WO_UP), TT, DFF, DM}; pg8::StaticOrder S; S.init(TT, DFF, G, bid);
            pg8::EpiBf E{3, (bf16*)(ws + OFF_HB), nullptr};
            pg8::gemm_phase<pg8::EpiBf, pg8::StaticOrder, true, true>(lds, g, S, E);
        }
        if (rep + 1 < REPS(7)) xcd_barrier(bar); }
        SEAM(pb + 7);
        for (int rep = 0; rep < REPS(8); ++rep) {
        if (IN(pb + 8)) { PH_LOCALS
            __syncthreads();
            pg8::Gemm g{(const bf16*)(ws + OFF_HB), (const bf16*)(wl + WO_DN), TT, DM, DFF}; pg8::StaticOrder S; S.init(TT, DM, G, bid);
            pg8::EpiF32 E{(float*)(ws + OFF_Y), DM};
            pg8::gemm_phase<pg8::EpiF32, pg8::StaticOrder, true, true>(lds, g, S, E);
        }
        if (rep + 1 < REPS(8)) xcd_barrier(bar); }
        SEAM(pb + 8);
        for (int rep = 0; rep < REPS(9); ++rep) {
        if (IN(pb + 9)) { PH_LOCALS
            if (l < DEPTH - 1) norm_phase(a, 1, ng + 3 * DM, ng + 4 * DM  , mv + 5 * DM, mv + 5 * 12288  , bid, G);
            else norm_phase(a, 2, ng + 3 * DM, nullptr, mv + 5 * DM, nullptr, bid, G);
        }
        if (rep + 1 < REPS(9)) xcd_barrier(bar); }
        SEAM(pb + 9);
    }
#undef IN
#undef SEAM
}

extern "C" void kernel_launch(void* const* d_in, const int* in_sizes, int n_in, void* d_out, int out_size, void* d_ws, size_t ws_size, hipStream_t stream) {
    static int grid = 0;
    if (grid == 0) {
        if (n_in != N_IN || out_size != TLAT * DM || ws_size < WS_END) { fprintf(stderr, "kernel_launch: unexpected shapes (n_in %d out %d ws %zu); nothing launched\n", n_in, out_size, ws_size); grid = -1; return; }
        int dev = 0, cus = 0;
        if (hipGetDevice(&dev) != hipSuccess || hipDeviceGetAttribute(&cus, hipDeviceAttributeMultiprocessorCount, dev) != hipSuccess) { grid = -1; return; }
        if (hipFuncSetAttribute((const void*)fwd, hipFuncAttributeMaxDynamicSharedMemorySize, LDS_BYTES) != hipSuccess) { fprintf(stderr, "kernel_launch: hipFuncSetAttribute failed\n"); grid = -1; return; }
        int per_cu = 0;
        if (hipOccupancyMaxActiveBlocksPerMultiprocessor(&per_cu, (const void*)fwd, NTHR, LDS_BYTES) != hipSuccess || per_cu < 1) fprintf(stderr, "kernel_launch: occupancy query says %d\n", per_cu);
        (void)hipGetLastError();
        grid = cus;
        if (grid < 232) { fprintf(stderr, "kernel_launch: %d CUs: this kernel's scan phase needs > 160 workgroups\n", grid); grid = -1; return; }
    }
    if (grid < 0) return;
    if (hipMemsetAsync((char*)d_ws + OFF_CTL, 0, CTL_BYTES, stream) != hipSuccess) return;
    Args a{};
    for (int i = 0; i < N_IN; ++i) a.in[i] = (const float*)d_in[i];
    a.out = (float*)d_out; a.ws = (unsigned char*)d_ws;
#if MK_ONE_LAUNCH
    a.ph_lo = 0; a.ph_hi = NPH;
    hipLaunchKernelGGL(fwd, dim3(grid), dim3(NTHR), LDS_BYTES, stream, a);
#else
    for (int p = 0; p < NPH; ++p) { a.ph_lo = p; a.ph_hi = p + 1; hipLaunchKernelGGL(fwd, dim3(grid), dim3(NTHR), LDS_BYTES, stream, a); }
#endif
}
```

```cpp
#include <hip/hip_runtime.h>
#include <cstdio>
#include <cstdint>
namespace pg8 {
#define PG8_LAS __attribute__((address_space(3)))
typedef unsigned short bf16_t;
typedef short bf16x8 __attribute__((ext_vector_type(8)));
typedef float f32x4 __attribute__((ext_vector_type(4)));
typedef unsigned u32x4 __attribute__((ext_vector_type(4)));
constexpr int BM = 256, BK = 64, HALF = 128, HTB = HALF * BK * 2  , STAGE_BYTES = 8 * HTB, NXCD = 8, WGM = 8;

__host__ __device__ __forceinline__ int lds_byte(int r, int c) { const int st = (r >> 4) * 2 + (c >> 5), rr = r & 15, cc = c & 31, ob = rr * 64 + cc * 2; return st * 1024 + (ob ^ (((ob >> 9) & 1) << 5)); }
__host__ __device__ __forceinline__ void stage_rc(int b, int& R, int& C) { const int st = b / 1024, sb = b % 1024, swz = sb ^ (((sb >> 9) & 1) << 5); R = (st >> 1) * 16 + swz / 64; C = (st & 1) * 32 + (swz % 64) / 2; }
__host__ __device__ __forceinline__ int perm32(int rho) { const int n = rho >> 4, i = rho & 15; return 8 * (i >> 2) + 4 * n + (i & 3); }

struct Unit { int pm, pn, kind; };
struct Gemm { const bf16_t* A; const bf16_t* Bt; int M, N, K; };

struct StaticOrder {
    int nM, nN, nwg, G, c;
    __host__ __device__ void init(int M, int N, int G_, int c_) { nM = M / BM; nN = N / BM; nwg = nM * nN; G = G_; c = c_; }
    __host__ __device__ bool next(int i, Unit& u) const {
        const long L = (long)i * G + c; if (L >= nwg) return false;
        int wgid = (int)L; { const int q = nwg / NXCD, r = nwg % NXCD, xcd = wgid % NXCD, off = wgid / NXCD; wgid = (xcd < r ? xcd * (q + 1) : r * (q + 1) + (xcd - r) * q) + off; }
        const int nig = WGM * nN, gid = wgid / nig, fm = gid * WGM, gsz = (nM - fm) < WGM ? (nM - fm) : WGM;
        u.pm = fm + ((wgid % nig) % gsz); u.pn = (wgid % nig) / gsz; return true;
    }
    __device__ __forceinline__ void a_ready(const Unit&) const {}
    __device__ __forceinline__ void done(const Unit&) const {}
};
__device__ __forceinline__ unsigned cvt_pk_bf16(float lo, float hi) { unsigned r; asm volatile("v_cvt_pk_bf16_f32 %0, %1, %2" : "=v"(r) : "v"(lo), "v"(hi)); return r; }
typedef float f32x2 __attribute__((ext_vector_type(2)));
template <class Epi, class Sched, bool ALIGN_EPI = false, bool SP2 = false>
__device__ __forceinline__ void gemm_phase(PG8_LAS unsigned char* lds, const int ldk  , const Sched& S, const Epi& E, const int wave_id) {
    unsigned z_ = 0u; asm volatile("" : "+v"(z_)); const int lane_ = (int)__builtin_amdgcn_mbcnt_hi(~0u, __builtin_amdgcn_mbcnt_lo(~0u, z_)); int wid_ = wave_id; asm volatile("" : "+s"(wid_)); const int wid = wid_, lane = lane_, tid = wid * 64 + lane, wr = wid >> 2, wc = wid & 3, fr = lane & 15, fq = lane >> 4;
    const int K = ldk; int nt;
    unsigned voffA[2], voffB[2];
#pragma unroll
    for (int i = 0; i < 2; ++i) { int R, C; stage_rc(tid * 16 + i * 8192, R, C); const int Rb = Epi::PERM ? ((R & ~31) + perm32(R & 31)) : R;
        voffA[i] = (unsigned)(R * K + C) * 2u; voffB[i] = (unsigned)(Rb * K + C) * 2u; }
    const size_t kstep = (size_t)(BK * 2);
    const size_t hstep = (size_t)HALF * K * 2;
    const unsigned ldsw = (unsigned)wid * 1024u;
    const int aoff = lds_byte(wr * 64 + fr, fq * 8), boff = lds_byte(wc * 32 + fr, fq * 8);
#define PG8_SA(b, h) (((b) * 2 + (h)) * HTB)
#define PG8_SB(b, h) ((4 + (b) * 2 + (h)) * HTB)
#define PG8_STAGE(bufoff, gbase, voff) do { _Pragma("unroll") for (int _i = 0; _i < 2; ++_i) \
        __builtin_amdgcn_global_load_lds((const unsigned*)((const char*)(gbase) + (voff)[_i]), (PG8_LAS unsigned*)(lds + (bufoff) + ldsw + _i * 8192), 16, 0, 0); } while (0)
#define PG8_LDA(dst, b, h) do { _Pragma("unroll") for (int m = 0; m < 4; ++m) _Pragma("unroll") for (int k = 0; k < 2; ++k) dst[m][k] = *(const PG8_LAS bf16x8*)(lds + PG8_SA(b, h) + aoff + m * 2048 + k * 1024); } while (0)
#define PG8_LDB(dst, b, h) do { _Pragma("unroll") for (int n = 0; n < 2; ++n) _Pragma("unroll") for (int k = 0; k < 2; ++k) dst[n][k] = *(const PG8_LAS bf16x8*)(lds + PG8_SB(b, h) + boff + n * 2048 + k * 1024); } while (0)
#define PG8_MMA(ai, bj, At, Bt) do { __builtin_amdgcn_s_setprio(1); _Pragma("unroll") for (int m = 0; m < 4; ++m) _Pragma("unroll") for (int n = 0; n < 2; ++n) _Pragma("unroll") for (int k = 0; k < 2; ++k) \
        acc[ai][bj][m][n] = __builtin_amdgcn_mfma_f32_16x16x32_bf16(Bt[n][k], At[m][k], acc[ai][bj][m][n], 0, 0, 0); __builtin_amdgcn_s_setprio(0); } while (0)
#define PG8_WAIT_V(n) asm volatile("s_waitcnt vmcnt(" #n ")" ::: "memory")
#define PG8_WAIT_L(n) asm volatile("s_waitcnt lgkmcnt(" #n ")" ::: "memory")
#define PG8_BAR __builtin_amdgcn_s_barrier()
#define PG8_SCHED __builtin_amdgcn_sched_barrier(0)
    Unit cur, nxt; int ui = 0;
    if (!S.next(0, cur)) return;
    f32x4 acc[2][2][4][2];
#pragma unroll
    for (int a = 0; a < 2; ++a)
#pragma unroll
        for (int b = 0; b < 2; ++b)
#pragma unroll
            for (int m = 0; m < 4; ++m)
#pragma unroll
                for (int n = 0; n < 2; ++n) acc[a][b][m][n] = (f32x4){0.f, 0.f, 0.f, 0.f};
    bf16x8 At[4][2], B0[2][2], B1[2][2];
    const char* cA = S.abase(cur); const char* cB = S.bbase(cur); nt = S.nt(cur);
    S.a_ready(cur);
    if constexpr (SP2) {
        PG8_STAGE(PG8_SB(0, 0), cB, voffB); PG8_STAGE(PG8_SB(0, 1), cB + hstep, voffB); PG8_STAGE(PG8_SA(0, 0), cA, voffA); PG8_STAGE(PG8_SA(0, 1), cA + hstep, voffA);
        if (wr == 1) PG8_BAR;
        PG8_WAIT_V(2); PG8_BAR;
        PG8_STAGE(PG8_SB(1, 0), cB + kstep, voffB); PG8_STAGE(PG8_SA(1, 0), cA + kstep, voffA); PG8_STAGE(PG8_SB(1, 1), cB + hstep + kstep, voffB);
        PG8_WAIT_V(6); PG8_BAR;
    } else {
        PG8_STAGE(PG8_SB(0, 0), cB, voffB); PG8_STAGE(PG8_SA(0, 0), cA, voffA); PG8_STAGE(PG8_SB(0, 1), cB + hstep, voffB); PG8_STAGE(PG8_SA(0, 1), cA + hstep, voffA);
        if (wr == 1) PG8_BAR;
        PG8_WAIT_V(4); PG8_BAR;
        PG8_STAGE(PG8_SB(1, 0), cB + kstep, voffB); PG8_STAGE(PG8_SA(1, 0), cA + kstep, voffA); PG8_STAGE(PG8_SB(1, 1), cB + hstep + kstep, voffB);
        PG8_WAIT_V(6); PG8_BAR;
    }
    for (;;) {
        const bool has_next = S.next(ui + 1, nxt);
        const char* nA = has_next ? S.abase(nxt) : cA; const char* nB = has_next ? S.bbase(nxt) : cB;
        for (int t = 0; t < nt; t += 2) {
            const bool last = (t == nt - 2);
            const char* a1 = cA + (size_t)(t + 1) * kstep;
            const char* a2 = last ? nA : cA + (size_t)(t + 2) * kstep; const char* b2 = last ? nB : cB + (size_t)(t + 2) * kstep;
            const char* a3 = a2 + kstep; const char* b3 = b2 + kstep;
            if (last && has_next) S.a_ready(nxt);
            if constexpr (Epi::HOOK) E.khook(acc, cur, t, wr, wc, fr, fq);
            if constexpr (SP2) {
            PG8_LDB(B0, 0, 0); PG8_LDB(B1, 0, 1); PG8_SCHED; PG8_LDA(At, 0, 0); PG8_STAGE(PG8_SA(1, 1), a1 + hstep, voffA);
            PG8_WAIT_V(8); PG8_WAIT_L(0); PG8_BAR; PG8_MMA(0, 0, At, B0); PG8_MMA(0, 1, At, B1); PG8_BAR; PG8_SCHED;
            PG8_LDA(At, 0, 1); PG8_STAGE(PG8_SB(0, 0), b2, voffB); PG8_STAGE(PG8_SB(0, 1), b2 + hstep, voffB); PG8_STAGE(PG8_SA(0, 0), a2, voffA);
            PG8_WAIT_V(8); PG8_WAIT_L(0); PG8_BAR; PG8_MMA(1, 0, At, B0); PG8_MMA(1, 1, At, B1); PG8_BAR; PG8_SCHED;
            PG8_LDB(B0, 1, 0); PG8_LDB(B1, 1, 1); PG8_SCHED; PG8_LDA(At, 1, 0); PG8_STAGE(PG8_SA(0, 1), a2 + hstep, voffA);
            PG8_WAIT_V(8); PG8_WAIT_L(0); PG8_BAR; PG8_MMA(0, 0, At, B0); PG8_MMA(0, 1, At, B1); PG8_BAR; PG8_SCHED;
            PG8_LDA(At, 1, 1); PG8_STAGE(PG8_SB(1, 0), b3, voffB); PG8_STAGE(PG8_SB(1, 1), b3 + hstep, voffB); PG8_STAGE(PG8_SA(1, 0), a3, voffA);
            PG8_WAIT_V(8); PG8_WAIT_L(0); PG8_BAR; PG8_MMA(1, 0, At, B0); PG8_MMA(1, 1, At, B1); PG8_BAR; PG8_SCHED;
            } else {
            PG8_LDB(B0, 0, 0); PG8_SCHED; PG8_LDA(At, 0, 0); PG8_STAGE(PG8_SA(1, 1), a1 + hstep, voffA);
            PG8_WAIT_L(8); PG8_BAR; PG8_WAIT_L(0); PG8_MMA(0, 0, At, B0); PG8_BAR; PG8_SCHED;
            PG8_LDB(B1, 0, 1); PG8_STAGE(PG8_SB(0, 0), b2, voffB);
            PG8_BAR; PG8_WAIT_L(0); PG8_MMA(0, 1, At, B1); PG8_BAR;
            PG8_LDA(At, 0, 1); PG8_STAGE(PG8_SA(0, 0), a2, voffA);
            PG8_BAR; PG8_WAIT_L(0); PG8_MMA(1, 0, At, B0); PG8_BAR; PG8_SCHED;
            PG8_STAGE(PG8_SB(0, 1), b2 + hstep, voffB);
            PG8_WAIT_V(6); PG8_BAR; PG8_MMA(1, 1, At, B1); PG8_BAR;
            PG8_LDB(B0, 1, 0); PG8_SCHED; PG8_LDA(At, 1, 0); PG8_STAGE(PG8_SA(0, 1), a2 + hstep, voffA);
            PG8_WAIT_L(8); PG8_BAR; PG8_WAIT_L(0); PG8_MMA(0, 0, At, B0); PG8_BAR; PG8_SCHED;
            PG8_LDB(B1, 1, 1); PG8_STAGE(PG8_SB(1, 0), b3, voffB);
            PG8_BAR; PG8_WAIT_L(0); PG8_MMA(0, 1, At, B1); PG8_BAR;
            PG8_LDA(At, 1, 1); PG8_STAGE(PG8_SA(1, 0), a3, voffA);
            PG8_BAR; PG8_WAIT_L(0); PG8_MMA(1, 0, At, B0); PG8_BAR; PG8_SCHED;
            PG8_STAGE(PG8_SB(1, 1), b3 + hstep, voffB);
            PG8_WAIT_V(6); PG8_BAR; PG8_MMA(1, 1, At, B1); PG8_BAR;
            }
        }
        if constexpr (ALIGN_EPI) { if (wr == 0) PG8_BAR; }
        if constexpr (!Epi::AFTER_DRAIN) { E(acc, cur, wr, wc, fr, fq); S.done(cur); }
        if (!has_next) break;
#pragma unroll
        for (int a = 0; a < 2; ++a)
#pragma unroll
            for (int b = 0; b < 2; ++b)
#pragma unroll
                for (int m = 0; m < 4; ++m)
#pragma unroll
                    for (int n = 0; n < 2; ++n) acc[a][b][m][n] = (f32x4){0.f, 0.f, 0.f, 0.f};
        cur = nxt; cA = nA; cB = nB; ++ui; nt = S.nt(cur);
        if constexpr (ALIGN_EPI) { if (wr == 1) PG8_BAR; }
    }
    PG8_WAIT_V(0);
    if constexpr (!ALIGN_EPI) { if (wr == 0) PG8_BAR; }
    PG8_BAR;
    if constexpr (Epi::AFTER_DRAIN) { E.fused(acc, cur, wr, wc, fr, fq, lds, wid, lane); S.done(cur); }
#undef PG8_SA
#undef PG8_SB
#undef PG8_STAGE
#undef PG8_LDA
#undef PG8_LDB
#undef PG8_MMA
#undef PG8_WAIT_V
#undef PG8_WAIT_L
#undef PG8_BAR
#undef PG8_SCHED
}
}

namespace pg8 {
__device__ __forceinline__ float sigm(float x) { return __builtin_amdgcn_rcpf(1.f + __expf(-x)); }
__device__ __forceinline__ f32x4 sigm4(f32x4 v) { return (f32x4){sigm(v[0]), sigm(v[1]), sigm(v[2]), sigm(v[3])}; }
__device__ __forceinline__ u32x4 pack8(f32x4 v0, f32x4 v1) { u32x4 w; w.x = cvt_pk_bf16(v0[0], v0[1]); w.y = cvt_pk_bf16(v0[2], v0[3]); w.z = cvt_pk_bf16(v1[0], v1[1]); w.w = cvt_pk_bf16(v1[2], v1[3]); return w; }
__device__ __forceinline__ float bflo(unsigned u) { return __uint_as_float(u << 16); }
__device__ __forceinline__ float bfhi(unsigned u) { return __uint_as_float(u & 0xffff0000u); }


struct TileMap {
    int nM, nN, nwg;
    __device__ __forceinline__ void init(int nM_, int nN_) { nM = nM_; nN = nN_; nwg = nM_ * nN_; }
    __device__ __forceinline__ void map(int L, int& pm, int& pn) const {
        int wgid = L; { const int q = nwg / NXCD, r = nwg % NXCD, xcd = wgid % NXCD, off = wgid / NXCD; wgid = (xcd < r ? xcd * (q + 1) : r * (q + 1) + (xcd - r) * q) + off; }
        const int nig = WGM * nN, gid = wgid / nig, fm = gid * WGM, gsz = (nM - fm) < WGM ? (nM - fm) : WGM;
        pm = fm + ((wgid % nig) % gsz); pn = (wgid % nig) / gsz;
    }
};
struct Sched2 {
    const char *A0, *B0, *A1, *B1; size_t tstep; int ntk; TileMap t0, t1; int G, c;
    __device__ __forceinline__ bool next(int i, Unit& u) const { const int L = i * G + c;
        if (L < t0.nwg) { t0.map(L, u.pm, u.pn); u.kind = 0; return true; }
        if (L - t0.nwg < t1.nwg) { t1.map(L - t0.nwg, u.pm, u.pn); u.kind = 1; return true; }
        return false; }
    __device__ __forceinline__ const char* abase(const Unit& u) const { return (u.kind ? A1 : A0) + (size_t)u.pm * tstep; }
    __device__ __forceinline__ const char* bbase(const Unit& u) const { return (u.kind ? B1 : B0) + (size_t)u.pn * tstep; }
    __device__ __forceinline__ int nt(const Unit&) const { return ntk; }
    __device__ __forceinline__ void a_ready(const Unit&) const {}
    __device__ __forceinline__ void done(const Unit&) const {}
};
struct SchedSplit {
    const char *A, *B; size_t tstep; int ntk; TileMap tm; int nctx, G, c;
    __device__ __forceinline__ bool next(int i, Unit& u) const { const int L = i * G + c;
        if (L < 256) { tm.map(L, u.pm, u.pn); u.kind = 0; return true; }
        const int e = L - 256; if (e < nctx) { const int tile = e & 31; u.pm = 32 + (tile >> 3); u.pn = tile & 7; u.kind = 1 + (e >> 5); return true; }
        return false; }
    __device__ __forceinline__ const char* abase(const Unit& u) const { return A + (size_t)u.pm * tstep + (u.kind ? (size_t)(u.kind - 1) * (ntk / 8) * 128 : 0); }
    __device__ __forceinline__ const char* bbase(const Unit& u) const { return B + (size_t)u.pn * tstep + (u.kind ? (size_t)(u.kind - 1) * (ntk / 8) * 128 : 0); }
    __device__ __forceinline__ int nt(const Unit& u) const { return u.kind ? ntk / 8 : ntk; }
    __device__ __forceinline__ void a_ready(const Unit&) const {}
    __device__ __forceinline__ void done(const Unit&) const {}
};
struct EpiInproj {
    static constexpr bool PERM = true, AFTER_DRAIN = false, HOOK = false;
    bf16_t* U; float* MISC; int ldu;
    __device__ __forceinline__ void operator()(const f32x4 (&acc)[2][2][4][2], const Unit& u, int wr, int wc, int fr, int fq) const {
        const int row0 = u.pm * BM + wr * 64 + fr, cl = wc * 32 + 8 * fq;
        if (u.pn == 16 || u.pn == 17) {
#pragma unroll
            for (int ai = 0; ai < 2; ++ai)
#pragma unroll
                for (int m = 0; m < 4; ++m) { float* rowp = MISC + (size_t)(row0 + ai * HALF + m * 16) * 512 + (u.pn - 16) * BM + cl;
#pragma unroll
                    for (int bj = 0; bj < 2; ++bj) { *(f32x4*)(rowp + bj * HALF) = acc[ai][bj][m][0]; *(f32x4*)(rowp + bj * HALF + 4) = acc[ai][bj][m][1]; } }
        } else {
            const bool sg = u.pn >= 22;
#pragma unroll
            for (int ai = 0; ai < 2; ++ai)
#pragma unroll
                for (int m = 0; m < 4; ++m) { bf16_t* rowp = U + (size_t)(row0 + ai * HALF + m * 16) * ldu + u.pn * BM + cl;
#pragma unroll
                    for (int bj = 0; bj < 2; ++bj) { f32x4 v0 = acc[ai][bj][m][0], v1 = acc[ai][bj][m][1];
                        if (sg) { v0 = sigm4(v0); v1 = sigm4(v1); }
                        *(u32x4*)(rowp + bj * HALF) = pack8(v0, v1); } }
        }
    }
};
struct EpiBf {
    static constexpr bool PERM = true, AFTER_DRAIN = false, HOOK = false;
    int kind; bf16_t* O0; bf16_t* O1;
    __device__ __forceinline__ void operator()(const f32x4 (&acc)[2][2][4][2], const Unit& u, int wr, int wc, int fr, int fq) const {
        bf16_t* base; size_t pitch;
        if (kind == 0) {
            const int half = u.pm >> 1, chb = (u.pm & 1) * 256;
            if (u.pn < 32) { const int b = u.pn >> 3, l0 = (u.pn & 7) * 256; pitch = 4096; base = O0 + ((size_t)(b * 512 + chb) * 2 + half) * 2048 + l0; }
            else { const int b = u.pn - 32; pitch = 512; base = O1 + ((size_t)(b * 512 + chb) * 2 + half) * 256; }
        } else if (kind == 1) { const int b = u.pn >> 1; pitch = 2304; base = O0 + (size_t)(b * 2048 + u.pm * 256) * 2304 + 1280 + (u.pn & 1) * 256; }
        else if (kind == 2) { const int b = u.pn >> 1; pitch = 2304; base = O0 + (size_t)(8192 + b * 256) * 2304 + 1280 + (u.pn & 1) * 256; }
        else { pitch = 8192; base = O0 + (size_t)(u.pm * 256) * 8192 + u.pn * 256; }
        const int r0 = wr * 64 + fr, cl = wc * 32 + 8 * fq;
#pragma unroll
        for (int ai = 0; ai < 2; ++ai)
#pragma unroll
            for (int m = 0; m < 4; ++m) { bf16_t* rowp = base + (size_t)(r0 + ai * HALF + m * 16) * pitch + cl;
#pragma unroll
                for (int bj = 0; bj < 2; ++bj) { f32x4 v0 = acc[ai][bj][m][0], v1 = acc[ai][bj][m][1];
                    if (kind == 3) { v0 = __builtin_elementwise_max(v0, (f32x4){0.f, 0.f, 0.f, 0.f}); v1 = __builtin_elementwise_max(v1, (f32x4){0.f, 0.f, 0.f, 0.f}); v0 = v0 * v0; v1 = v1 * v1; }
                    *(u32x4*)(rowp + bj * HALF) = pack8(v0, v1); } }
    }
};
struct EpiChain {
    static constexpr bool PERM = true, AFTER_DRAIN = false, HOOK = true;
    const bf16_t* G; int ldg; bf16_t* Mo;
    __device__ __forceinline__ void khook(f32x4 (&acc)[2][2][4][2], const Unit& u, int t, int wr, int wc, int fr, int fq) const {
        if (t != 8 && t != 20 && t != 28) return;
        const int i = (t == 8) ? 0 : (t == 20 ? 1 : 2);
        int row0 = u.pm * BM + wr * 64 + fr; const int col0 = u.pn * BM + wc * 32 + 8 * fq + i * 2048;
        asm volatile("" : "+v"(row0));
#pragma unroll
        for (int ai = 0; ai < 2; ++ai)
#pragma unroll
            for (int m = 0; m < 4; ++m) { const bf16_t* gp = G + (size_t)(row0 + ai * HALF + m * 16) * ldg + col0;
#pragma unroll
                for (int bj = 0; bj < 2; ++bj) { const u32x4 g = *(const u32x4*)(gp + bj * HALF), h = *(const u32x4*)(gp + bj * HALF + 2048);
                    const unsigned gw[4] = {g.x, g.y, g.z, g.w}, hw[4] = {h.x, h.y, h.z, h.w};
#pragma unroll
                    for (int e2 = 0; e2 < 4; ++e2) { const float r0 = fmaxf(bflo(gw[e2]), 1e-6f) * __builtin_amdgcn_rcpf(fmaxf(bflo(hw[e2]), 1e-6f)), r1 = fmaxf(bfhi(gw[e2]), 1e-6f) * __builtin_amdgcn_rcpf(fmaxf(bfhi(hw[e2]), 1e-6f));
                        acc[ai][bj][m][e2 >> 1][(e2 & 1) * 2] *= r0; acc[ai][bj][m][e2 >> 1][(e2 & 1) * 2 + 1] *= r1; } }
                asm volatile("" ::: "memory"); }
    }
    __device__ __forceinline__ void operator()(const f32x4 (&acc)[2][2][4][2], const Unit& u, int wr, int wc, int fr, int fq) const {
        const int row0 = u.pm * BM + wr * 64 + fr, col0 = u.pn * BM + wc * 32 + 8 * fq;
#pragma unroll
        for (int ai = 0; ai < 2; ++ai)
#pragma unroll
            for (int m = 0; m < 4; ++m) { const size_t row = (size_t)(row0 + ai * HALF + m * 16);
#pragma unroll
                for (int bj = 0; bj < 2; ++bj) { const int col = col0 + bj * HALF;
                    const u32x4 g = *(const u32x4*)(G + row * ldg + col + 3 * 2048);
                    const f32x4 v0 = acc[ai][bj][m][0] * (f32x4){fmaxf(bflo(g.x), 1e-6f), fmaxf(bfhi(g.x), 1e-6f), fmaxf(bflo(g.y), 1e-6f), fmaxf(bfhi(g.y), 1e-6f)};
                    const f32x4 v1 = acc[ai][bj][m][1] * (f32x4){fmaxf(bflo(g.z), 1e-6f), fmaxf(bfhi(g.z), 1e-6f), fmaxf(bflo(g.w), 1e-6f), fmaxf(bfhi(g.w), 1e-6f)};
                    *(u32x4*)(Mo + row * 2048 + col) = pack8(v0, v1); } }
    }
};
struct EpiF32 {
    static constexpr bool PERM = false, AFTER_DRAIN = false, HOOK = false;
    float* C; float* YC;
    __device__ __forceinline__ void operator()(const f32x4 (&acc)[2][2][4][2], const Unit& u, int wr, int wc, int fr, int fq) const {
        const int row0 = u.pm * BM + wr * 64 + fr, col0 = u.pn * BM + wc * 32 + 4 * fq;
        float* base = u.kind ? (YC + (size_t)(u.kind - 1) * 1024 * 2048 + (size_t)(row0 - 8192) * 2048) : (C + (size_t)row0 * 2048);
#pragma unroll
        for (int ai = 0; ai < 2; ++ai)
#pragma unroll
            for (int m = 0; m < 4; ++m) { float* rowp = base + (size_t)(ai * HALF + m * 16) * 2048 + col0;
#pragma unroll
                for (int bj = 0; bj < 2; ++bj)
#pragma unroll
                    for (int n = 0; n < 2; ++n) *(f32x4*)(rowp + bj * HALF + n * 16) = acc[ai][bj][m][n]; }
    }
};
struct EpiIn2 {
    static constexpr bool PERM = true, AFTER_DRAIN = false, HOOK = false;
    EpiInproj e0; EpiBf e1;
    __device__ __forceinline__ void operator()(const f32x4 (&acc)[2][2][4][2], const Unit& u, int wr, int wc, int fr, int fq) const { if (u.kind == 0) e0(acc, u, wr, wc, fr, fq); else e1(acc, u, wr, wc, fr, fq); }
};
}

#define GAS __attribute__((address_space(1)))
#define LAS __attribute__((address_space(3)))
typedef unsigned short bf16;
typedef unsigned v4u __attribute__((ext_vector_type(4)));
typedef unsigned v2u __attribute__((ext_vector_type(2)));
typedef float f32x4 __attribute__((ext_vector_type(4)));
typedef float f32x2 __attribute__((ext_vector_type(2)));
constexpr int NWAVES = 8, NTHR = 512;
constexpr int DM = 2048, NBATCH = 4, LSEQ = 2048, LCTX = 256, DEPTH = 4;
constexpr int TLAT = NBATCH * LSEQ, TCTX = NBATCH * LCTX, TT = TLAT + TCTX;
constexpr int IN_DIM = 14168, DFF = 8192;
constexpr int NU = 13824;
constexpr int UZ = 0, UXBC = 768, URKV = 2560, UMISC = 4096, UCONV = 4608, UGATE = 5632;
constexpr int S_RKV = 2584, S_DT = 2560, S_WF = 4120, S_CONV = 4440, S_FFT = 5464, S_GATE = 5976;
constexpr int RJ = LCTX + LSEQ;
enum { I_X = 0, I_C, I_CTX, I_CCTX, I_MODW, I_MODB, I_NORMG, I_WIN, I_CONVW, I_CONVB, I_CLNG, I_CLNB, I_CONVOUT, I_SCW, I_SCB, I_SALOG, I_SDTB, I_SD, I_SNG, I_SOUT,
       I_FOUT, I_RMU, I_RW0, I_RW2, I_RA0, I_RA2, I_RG2, I_RKK, I_RKA, I_RRK, I_RLNG, I_RLNB, I_ROUT, I_WO, I_UP, I_DOWN, N_IN };
constexpr size_t MiB = 1u << 20;
constexpr size_t OFF_CTL = 0, CTL_BYTES = 1 * MiB;
constexpr size_t OFF_MODV = 1 * MiB;
constexpr size_t OFF_DFTL = 2 * MiB;
constexpr size_t OFF_DFTC = 18 * MiB;
constexpr size_t OFF_W = 20 * MiB, W_LAYER = 139 * MiB;
constexpr size_t WO_IN = 0, WO_FFT = 54 * MiB, WO_CAT = 58 * MiB  , WO_O = 67 * MiB, WO_UP = 75 * MiB, WO_DN = 107 * MiB;
constexpr size_t OFF_X = 576 * MiB;
constexpr size_t OFF_H = 648 * MiB;
constexpr size_t OFF_U = 684 * MiB;
constexpr size_t OFF_HB = OFF_U;
constexpr size_t OFF_MISC = 927 * MiB;
constexpr size_t OFF_VTL = 945 * MiB;
constexpr size_t OFF_VTC = 961 * MiB;
constexpr size_t OFF_ACAT = 963 * MiB;
constexpr int AC_CONV = 0, AC_SSD = 512, AC_FFT = 1280, AC_RWKV = 1792, ACW = 2304;
constexpr size_t OFF_XBC = 1004 * MiB;
constexpr size_t OFF_DTA = 1036 * MiB;
constexpr size_t OFF_YSSD = 1038 * MiB;
constexpr size_t OFF_RW = 1092 * MiB, RW_ARR = 18 * MiB;
constexpr size_t OFF_RSC = 1254 * MiB;
constexpr size_t OFF_YRW = 1255 * MiB;
constexpr size_t OFF_MBUF = 1291 * MiB;
constexpr size_t OFF_M = 1363 * MiB;
constexpr size_t OFF_Y = 1399 * MiB;
constexpr size_t OFF_WLT = 1471 * MiB;
constexpr size_t OFF_YC = 1473 * MiB;
constexpr size_t WS_END = 1537 * MiB;
constexpr int CW_Q = 8192;
constexpr int CW_BAR = 4096;
constexpr int RING_BYTES = 131072, MISC_OFF = RING_BYTES + 320, LDS_BYTES = 147456;

__device__ __forceinline__ float bf2f(unsigned short b) { return __uint_as_float((unsigned)b << 16); }
__device__ __forceinline__ float bflo(unsigned u) { return __uint_as_float(u << 16); }
__device__ __forceinline__ float bfhi(unsigned u) { return __uint_as_float(u & 0xffff0000u); }
__device__ __forceinline__ unsigned f2bf(float f) { unsigned u = __builtin_bit_cast(unsigned, f); return (u + 0x7fffu + ((u >> 16) & 1u)) >> 16; }
__device__ __forceinline__ unsigned pk2(float lo, float hi) { return f2bf(lo) | (f2bf(hi) << 16); }
__device__ __forceinline__ float sigmoidf_(float x) { return 1.f / (1.f + __expf(-x)); }
__device__ __forceinline__ float siluf_(float x) { return x / (1.f + __expf(-x)); }
__device__ __forceinline__ float softplusf_(float x) { return fmaxf(x, 0.f) + log1pf(__expf(-fabsf(x))); }
template <int CTRL> __device__ __forceinline__ float dpp_add(float x) { return x + __int_as_float(__builtin_amdgcn_update_dpp(0, __float_as_int(x), CTRL, 0xf, 0xf, true)); }
__device__ __forceinline__ float sum8(float x) { x = dpp_add<0xB1>(x); x = dpp_add<0x4E>(x); x = dpp_add<0x141>(x); return x; }
__device__ __forceinline__ float row16_sum(float x) { x = sum8(x); x = dpp_add<0x140>(x); return x; }
__device__ __forceinline__ float wave_sum(float v) {
    const float r = row16_sum(v);
    return (__int_as_float(__builtin_amdgcn_readlane(__float_as_int(r), 0)) + __int_as_float(__builtin_amdgcn_readlane(__float_as_int(r), 16))) +
           (__int_as_float(__builtin_amdgcn_readlane(__float_as_int(r), 32)) + __int_as_float(__builtin_amdgcn_readlane(__float_as_int(r), 48)));
}
#define LDS_WAIT() asm volatile("s_waitcnt lgkmcnt(0)" ::: "memory")

struct Args { const float* in[N_IN]; float* out; unsigned char* ws; int ph_lo, ph_hi; };
typedef const __attribute__((address_space(4))) Args* KArgs;
__device__ __forceinline__ KArgs kargs() { KArgs p = (KArgs)__builtin_amdgcn_kernarg_segment_ptr(); asm volatile("" : "+s"(p)); return p; }
#define PH_IDS unsigned z_ = 0u; asm volatile("" : "+v"(z_)); const int lane_ = (int)__builtin_amdgcn_mbcnt_hi(~0u, __builtin_amdgcn_mbcnt_lo(~0u, z_)); int wv_ = wave0; asm volatile("" : "+s"(wv_)); const int lane = lane_, wave = wv_, tid = wv_ * 64 + lane_; (void)lane; (void)wave; (void)tid;

__device__ __forceinline__ int inmap(int n) {
    if (n < 2560) return n;
    if (n < 4096) return S_RKV + (n - 2560);
    if (n < 4608) { const int m = n - 4096; if (m < 24) return S_DT + m; if (m < 64) return -1; if (m < 384) return S_WF + (m - 64); return -1; }
    if (n < 5632) return S_CONV + (n - 4608);
    return S_GATE + (n - 5632);
}
__device__ __forceinline__ int rwkv_tok(int b, int j) { if (j < LCTX) return TLAT + b * LCTX + j; const int s = j - LCTX; return b * LSEQ + (s & 31) * 64 + (s >> 5); }

__device__ __forceinline__ void transpose_item(const float* W, int ldw, int Nsrc, bf16* WT, int k0, int n0, bool mapped, LAS float* scr, int lane, int koff = 0) {
    const int nn = lane & 31; const int sc = mapped ? inmap(n0 + nn) : (n0 + nn);
#pragma unroll 8
    for (int i = 0; i < 32; ++i) { const int kk = 2 * i + (lane >> 5); scr[kk * 33 + nn] = (sc >= 0) ? W[(size_t)(k0 + kk) * Nsrc + sc] : 0.f; }
    LDS_WAIT();
    const int c = lane & 7;
#pragma unroll
    for (int j = 0; j < 4; ++j) { const int n = (lane >> 3) + 8 * j; const LAS float* s = scr + (8 * c) * 33 + n;
        v4u o; o.x = pk2(s[0 * 33], s[1 * 33]); o.y = pk2(s[2 * 33], s[3 * 33]); o.z = pk2(s[4 * 33], s[5 * 33]); o.w = pk2(s[6 * 33], s[7 * 33]);
        *(v4u*)(WT + (size_t)(n0 + n) * ldw + koff + k0 + 8 * c) = o; }
    LDS_WAIT();
}
constexpr int IT_IN = 32 * (NU / 32), IT_CO = 8 * 64, IT_SO = 12 * 64, IT_FO = 8 * 64, IT_RO = 8 * 64, IT_O = 32 * 64, IT_UP = 32 * 256, IT_DN = 128 * 64;
constexpr int IT_LAYER = IT_IN + IT_CO + IT_SO + IT_FO + IT_RO + IT_O + IT_UP + IT_DN;

__device__ __forceinline__ void p0_prologue(KArgs a, LAS unsigned char* lds, int bid, int G, const int wave0) {
    PH_IDS
    unsigned char* ws = a->ws;
    {
        LAS float* sc = (LAS float*)lds;
        LAS float* part = (LAS float*)(lds + 40960);
        for (int i = tid; i < 5 * DM; i += NTHR) { const float v = (i < 4 * DM) ? a->in[I_C][i] : a->in[I_CCTX][i - 4 * DM]; sc[i] = siluf_(v); }
        __syncthreads();
        float* MODV = (float*)(ws + OFF_MODV);
        for (int it = bid; it < DEPTH * 192; it += G) {
            const int l = it / 192, j = (it % 192) * 64 + lane;
            const float* wp = a->in[I_MODW] + (size_t)l * DM * 12288 + (size_t)(wave * 256) * 12288 + j;
            float acc[5] = {0.f, 0.f, 0.f, 0.f, 0.f};
#pragma unroll 4
            for (int k = 0; k < 256; ++k) { const float w = wp[(size_t)k * 12288];
#pragma unroll
                for (int r = 0; r < 5; ++r) acc[r] += sc[r * DM + wave * 256 + k] * w; }
#pragma unroll
            for (int r = 0; r < 5; ++r) part[(wave * 5 + r) * 64 + lane] = acc[r];
            __syncthreads();
            if (tid < 320) { const int r = tid >> 6, jj = tid & 63; float s = 0.f;
#pragma unroll
                for (int w = 0; w < 8; ++w) s += part[(w * 5 + r) * 64 + jj];
                const int jo = (it % 192) * 64 + jj; MODV[((size_t)l * 5 + r) * 12288 + jo] = s + a->in[I_MODB][l * 12288 + jo]; }
            __syncthreads();
        }
    }
    {
        LAS float* wt = (LAS float*)lds;
        LAS float* ctab = (LAS float*)(lds + 32768);
        LAS float* scr = (LAS float*)(lds + 32768 + 512 + wave * 8448);
        __syncthreads();
        if (tid < 128) ctab[tid] = cospif((float)tid * (1.f / 64.f));
        for (int it = bid; it < DEPTH * 32 * 4; it += G) {
            const int l = it / 128, kb = (it % 128) / 4, g = it % 4, k0 = kb * 64;
            __syncthreads();
            for (int i = tid; i < 64 * 32; i += NTHR) { const int kk = i >> 5, c4 = i & 31;
                *(LAS f32x4*)(wt + kk * 128 + c4 * 4) = *(const f32x4*)(a->in[I_WIN] + ((size_t)l * DM + k0 + kk) * IN_DIM + S_FFT + g * 128 + c4 * 4); }
            __syncthreads();
            const int half = wave >> 2, cp = (wave & 3) * 32 + (lane & 31), n0 = half * 512 + g * 128 + (wave & 3) * 32;
#pragma unroll 1
            for (int i = 0; i < 32; ++i) { const int kk = 2 * i + (lane >> 5); float s = 0.f;
#pragma unroll 8
                for (int c = 0; c < 128; ++c) s += wt[kk * 128 + c] * ctab[(c * cp - 32 * half) & 127];
                scr[kk * 33 + (lane & 31)] = s; }
            LDS_WAIT();
            bf16* WT = (bf16*)(ws + OFF_W + (size_t)l * W_LAYER + WO_FFT);
            const int c = lane & 7;
#pragma unroll
            for (int j = 0; j < 4; ++j) { const int n = (lane >> 3) + 8 * j; const LAS float* s = scr + (8 * c) * 33 + n;
                v4u o; o.x = pk2(s[0 * 33], s[1 * 33]); o.y = pk2(s[2 * 33], s[3 * 33]); o.z = pk2(s[4 * 33], s[5 * 33]); o.w = pk2(s[6 * 33], s[7 * 33]);
                *(v4u*)(WT + (size_t)(n0 + n) * DM + k0 + 8 * c) = o; }
            LDS_WAIT();
        }
        __syncthreads();
    }
    const int gw = bid * NWAVES + wave, NGW = G * NWAVES;
    {
        LAS float* scr = (LAS float*)(lds + wave * 8448);
        for (int it = gw; it < DEPTH * IT_LAYER; it += NGW) {
            const int l = it / IT_LAYER; int r = it % IT_LAYER; unsigned char* wl = ws + OFF_W + (size_t)l * W_LAYER;
            if (r < IT_IN) { const int kb = r / (NU / 32), nb = r % (NU / 32); transpose_item(a->in[I_WIN] + (size_t)l * DM * IN_DIM, DM, IN_DIM, (bf16*)(wl + WO_IN), kb * 64, nb * 32, true, scr, lane); continue; } r -= IT_IN;
            if (r < IT_CO) { transpose_item(a->in[I_CONVOUT] + (size_t)l * 512 * DM, ACW, DM, (bf16*)(wl + WO_CAT), (r / 64) * 64, (r % 64) * 32, false, scr, lane, AC_CONV); continue; } r -= IT_CO;
            if (r < IT_SO) { transpose_item(a->in[I_SOUT] + (size_t)l * 768 * DM, ACW, DM, (bf16*)(wl + WO_CAT), (r / 64) * 64, (r % 64) * 32, false, scr, lane, AC_SSD); continue; } r -= IT_SO;
            if (r < IT_FO) { transpose_item(a->in[I_FOUT] + (size_t)l * 512 * DM, ACW, DM, (bf16*)(wl + WO_CAT), (r / 64) * 64, (r % 64) * 32, false, scr, lane, AC_FFT); continue; } r -= IT_FO;
            if (r < IT_RO) { transpose_item(a->in[I_ROUT] + (size_t)l * 512 * DM, ACW, DM, (bf16*)(wl + WO_CAT), (r / 64) * 64, (r % 64) * 32, false, scr, lane, AC_RWKV); continue; } r -= IT_RO;
            if (r < IT_O) { transpose_item(a->in[I_WO] + (size_t)l * DM * DM, DM, DM, (bf16*)(wl + WO_O), (r / 64) * 64, (r % 64) * 32, false, scr, lane); continue; } r -= IT_O;
            if (r < IT_UP) { transpose_item(a->in[I_UP] + (size_t)l * DM * DFF, DM, DFF, (bf16*)(wl + WO_UP), (r / 256) * 64, (r % 256) * 32, false, scr, lane); continue; } r -= IT_UP;
            transpose_item(a->in[I_DOWN] + (size_t)l * DFF * DM, DFF, DM, (bf16*)(wl + WO_DN), (r / 64) * 64, (r % 64) * 32, false, scr, lane);
        }
    }
    {
        const int gt = bid * NTHR + tid, NGT = G * NTHR;
        bf16* FL = (bf16*)(ws + OFF_DFTL); bf16* FC = (bf16*)(ws + OFF_DFTC);
        { bf16* WLT = (bf16*)(ws + OFF_WLT);
          for (int i = gt; i < DEPTH * 512 * 320; i += NGT) { const int l = i / (512 * 320), c = (i / 320) % 512, j = i % 320; float v;
              if (j < 64) v = a->in[I_RW2][((size_t)(l * 2 + 0) * 64 + j) * 512 + c]; else if (j < 128) v = a->in[I_RW2][((size_t)(l * 2 + 1) * 64 + (j - 64)) * 512 + c];
              else if (j < 192) v = a->in[I_RA2][((size_t)l * 64 + (j - 128)) * 512 + c]; else v = a->in[I_RG2][((size_t)l * 128 + (j - 192)) * 512 + c];
              WLT[i] = (bf16)f2bf(v); } }
        for (int i = gt; i < 2048 * 512; i += NGT) { const int lp = i >> 9, k8 = (i & 511) * 8; unsigned o[4];
#pragma unroll
            for (int e = 0; e < 4; ++e) { float v[2];
#pragma unroll
                for (int q = 0; q < 2; ++q) { const int k = k8 + 2 * e + q; const int m = (lp * (k & 2047)) & 2047; float sn, cs; sincospif((float)m * (1.f / 1024.f), &sn, &cs); v[q] = (k < 2048 ? cs : -sn) * (1.f / 512.f); }
                o[e] = pk2(v[0], v[1]); }
            *(v4u*)(FL + (size_t)lp * 4096 + k8) = (v4u){o[0], o[1], o[2], o[3]}; }
        for (int i = gt; i < 256 * 64; i += NGT) { const int lp = i >> 6, k8 = (i & 63) * 8; unsigned o[4];
#pragma unroll
            for (int e = 0; e < 4; ++e) { float v[2];
#pragma unroll
                for (int q = 0; q < 2; ++q) { const int k = k8 + 2 * e + q; const int m = (lp * (k & 255)) & 255; float sn, cs; sincospif((float)m * (1.f / 128.f), &sn, &cs); v[q] = (k < 256 ? cs : -sn) * 0.005524271728f; }
                o[e] = pk2(v[0], v[1]); }
            *(v4u*)(FC + (size_t)lp * 512 + k8) = (v4u){o[0], o[1], o[2], o[3]}; }
        f32x4* X4 = (f32x4*)(ws + OFF_X); const f32x4* x4 = (const f32x4*)a->in[I_X]; const f32x4* c4 = (const f32x4*)a->in[I_CTX];
        for (int i = gt; i < TT * (DM / 4); i += NGT) X4[i] = (i < TLAT * (DM / 4)) ? x4[i] : c4[i - TLAT * (DM / 4)];
    }
}

__device__ __forceinline__ void norm_phase(KArgs a, int mode, const float* gY, const float* gH, const float* modY  , const float* modH  ,
                                           int bid, int G, const int wave0, int nrows, bool split = false  ) {
    PH_IDS
    unsigned char* ws = a->ws; const int gw = bid * NWAVES + wave, NGW = G * NWAVES;
    float* X = (float*)(ws + OFF_X); const float* Y = (const float*)(ws + OFF_Y); bf16* H = (bf16*)(ws + OFF_H);
    for (int row = gw; row < nrows; row += NGW) {
        const int mr = row < TLAT ? (row >> 11) : 4;
        f32x4 x[8];
        const f32x4* xr = (const f32x4*)(X + (size_t)row * DM) + lane;
#pragma unroll
        for (int j = 0; j < 8; ++j) x[j] = xr[64 * j];
        if (mode != 0) {
            const f32x4* yr = (const f32x4*)(Y + (size_t)row * DM) + lane; f32x4 y[8]; float ss = 0.f;
            if (split && row >= TLAT) { const f32x4* yc = (const f32x4*)((const float*)(ws + OFF_YC) + (size_t)(row - TLAT) * DM) + lane;
#pragma unroll
                for (int j = 0; j < 8; ++j) { f32x4 t = yc[64 * j];
#pragma unroll
                    for (int sl = 1; sl < 8; ++sl) t += yc[(size_t)sl * 1024 * 512 + 64 * j];
                    y[j] = t; } }
            else {
#pragma unroll
                for (int j = 0; j < 8; ++j) y[j] = yr[64 * j]; }
#pragma unroll
            for (int j = 0; j < 8; ++j) { ss += (y[j].x * y[j].x + y[j].y * y[j].y) + (y[j].z * y[j].z + y[j].w * y[j].w); }
            const float r = rsqrtf(wave_sum(ss) * (1.f / DM) + 1e-6f);
            const f32x4* gp = (const f32x4*)gY + lane; const f32x4* gt = (const f32x4*)(modY + (size_t)mr * 12288) + lane;
#pragma unroll
            for (int j = 0; j < 8; ++j) x[j] += gt[64 * j] * (y[j] * r * gp[64 * j]);
            if (mode == 1) { f32x4* xw = (f32x4*)(X + (size_t)row * DM) + lane;
#pragma unroll
                for (int j = 0; j < 8; ++j) xw[64 * j] = x[j]; }
            else { f32x4* ow = (f32x4*)(a->out + (size_t)row * DM) + lane;
#pragma unroll
                for (int j = 0; j < 8; ++j) ow[64 * j] = x[j]; }
        }
        if (mode != 2) {
            float ss = 0.f;
#pragma unroll
            for (int j = 0; j < 8; ++j) ss += (x[j].x * x[j].x + x[j].y * x[j].y) + (x[j].z * x[j].z + x[j].w * x[j].w);
            const float r = rsqrtf(wave_sum(ss) * (1.f / DM) + 1e-6f);
            const f32x4* gp = (const f32x4*)gH + lane; const f32x4* sh = (const f32x4*)(modH + (size_t)mr * 12288) + lane; const f32x4* sc = sh + 512;
            v2u* hw = (v2u*)(H + (size_t)row * DM) + lane;
#pragma unroll
            for (int j = 0; j < 8; ++j) { const f32x4 h = (x[j] * r * gp[64 * j]) * (sc[64 * j] + 1.f) + sh[64 * j]; hw[64 * j] = (v2u){pk2(h.x, h.y), pk2(h.z, h.w)}; }
        }
    }
}
#define XB_TMO      128
#define XB_XCNT(j)  (256  + 64 * (j))
#define XB_XSUB(j)  (1280 + 64 * (j))
#define XB_XGEN(j)  (2304 + 64 * (j))
#define XB_TOP      3328
#define XB_TOPGEN   3392
#define XCD_BAR_WORDS 3456
#define XB_SPIN_CAP (1u << 18)

__device__ __forceinline__ unsigned xb_ld(unsigned* p)              { return __hip_atomic_load(p, __ATOMIC_RELAXED, __HIP_MEMORY_SCOPE_AGENT); }
__device__ __forceinline__ unsigned xb_add(unsigned* p, unsigned v) { return __hip_atomic_fetch_add(p, v, __ATOMIC_RELAXED, __HIP_MEMORY_SCOPE_AGENT); }
__device__ __forceinline__ unsigned xb_xcc_id() { return (unsigned)__builtin_amdgcn_s_getreg((3 << 11) | 20) & 0xFu; }
#define XB_SPIN(cond, bar) do { unsigned _sp = 0; while (cond) { __builtin_amdgcn_s_sleep(1); \
    if ((++_sp & 255u) == 0u) { if (xb_ld(&(bar)[XB_TMO])) break; if (_sp > XB_SPIN_CAP) { atomicAdd(&(bar)[XB_TMO], 1u); break; } } } } while (0)

struct XcdBarrier {
    unsigned* bar; unsigned x; int wv;
    volatile LAS unsigned* st;
};

__device__ __forceinline__ bool xb_t0(int wv) { unsigned z_ = 0u; asm volatile("" : "+v"(z_)); return wv == 0 && __builtin_amdgcn_mbcnt_hi(~0u, __builtin_amdgcn_mbcnt_lo(~0u, z_)) == 0u; }
__device__ __forceinline__ XcdBarrier xcd_barrier_post(unsigned* bar, volatile LAS unsigned* st, int wv) {
    XcdBarrier b; b.bar = bar; b.x = xb_xcc_id(); b.st = st; b.wv = wv;
    if (xb_t0(wv)) (void)xb_add(&bar[XB_XCNT(b.x)], 1u);
    return b;
}
__device__ __forceinline__ void xcd_barrier_complete(unsigned* bar, unsigned x, unsigned& nloc, unsigned& nx) {
    const unsigned G = gridDim.x * gridDim.y * gridDim.z;
    unsigned sum, cnt, mine, sp = 0u;
    for (;;) {
        sum = 0u; cnt = 0u; mine = 0u;
#pragma unroll
        for (unsigned j = 0; j < 16; ++j) { const unsigned c = xb_ld(&bar[XB_XCNT(j)]); sum += c; cnt += (c > 0u) ? 1u : 0u; mine = (j == x) ? c : mine; }
        if (sum == G) break;
        __builtin_amdgcn_s_sleep(1);
        if ((++sp & 255u) == 0u) { if (xb_ld(&bar[XB_TMO])) break; if (sp > XB_SPIN_CAP) { atomicAdd(&bar[XB_TMO], 1u); break; } }
    }
    nloc = mine > 0u ? mine : 1u; nx = cnt > 0u ? cnt : 1u;
}

__device__ __forceinline__ void xcd_barrier(const XcdBarrier& b) {
    asm volatile("s_waitcnt vmcnt(0)" ::: "memory");
    __syncthreads();
    if (xb_t0(b.wv)) {
        unsigned* bar = b.bar;
        __builtin_amdgcn_s_waitcnt(0);
        unsigned nloc = b.st[0], nx = b.st[1];
        if (nloc == 0u) { xcd_barrier_complete(bar, b.x, nloc, nx); b.st[0] = nloc; b.st[1] = nx; }
        const unsigned old = xb_add(&bar[XB_XSUB(b.x)], 1u);
        const unsigned gen = old / nloc;
        if (old + 1u == (gen + 1u) * nloc) {
            __builtin_amdgcn_fence(__ATOMIC_RELEASE, "agent");
            asm volatile("s_waitcnt vmcnt(0)" ::: "memory");
            const unsigned og = xb_add(&bar[XB_TOP], 1u);
            const unsigned tg = og / nx;
            if (og + 1u == (tg + 1u) * nx) xb_add(&bar[XB_TOPGEN], 1u);
            else XB_SPIN(xb_ld(&bar[XB_TOPGEN]) == tg, bar);
            __builtin_amdgcn_fence(__ATOMIC_ACQUIRE, "agent");
            xb_add(&bar[XB_XGEN(b.x)], 1u);
            asm volatile("s_waitcnt vmcnt(0)" ::: "memory");
        } else {
            XB_SPIN(xb_ld(&bar[XB_XGEN(b.x)]) == gen, bar);
            __builtin_amdgcn_fence(__ATOMIC_ACQUIRE, "agent");
            asm volatile("s_waitcnt vmcnt(0)" ::: "memory");
        }
    }
    __syncthreads();
}

typedef short bf16x8 __attribute__((ext_vector_type(8)));
constexpr int RP_PITCH = 516, ACT_PITCH = 328;
__device__ __forceinline__ void rwkv_prep_item(KArgs a, int l, int item, LAS unsigned char* lds, int tid, int lane, int wave) {
    unsigned char* ws = a->ws;
    const bf16* U = (const bf16*)(ws + OFF_U); const float* MISC = (const float*)(ws + OFF_MISC);
    const int b = item / 144, j0 = (item % 144) * 16; const bool isctx = j0 < LCTX;
    LAS float* RP = (LAS float*)lds;
    LAS float* KP = RP + 16 * RP_PITCH; LAS float* VP = KP + 16 * RP_PITCH;
    LAS bf16* ACT = (LAS bf16*)(lds + 3 * 16 * RP_PITCH * 4);
    const float* mu = a->in[I_RMU] + l * 1856;
    for (int idx = tid; idx < 16 * 192; idx += NTHR) { const int i = idx / 192, c8 = idx % 192, jj = j0 + i;
        const bool hp = isctx ? (jj - 1 >= 0) : (jj - 1 >= LCTX), hn = isctx ? (jj + 1 < LCTX) : (jj + 1 < RJ);
        const v4u c = *(const v4u*)(U + (size_t)rwkv_tok(b, jj) * NU + URKV + c8 * 8);
        v4u p = (v4u){0u, 0u, 0u, 0u}, n = p;
        if (hp) p = *(const v4u*)(U + (size_t)rwkv_tok(b, jj - 1) * NU + URKV + c8 * 8);
        if (hn) n = *(const v4u*)(U + (size_t)rwkv_tok(b, jj + 1) * NU + URKV + c8 * 8);
        const f32x4 m0 = *(const f32x4*)(mu + c8 * 8), m1 = *(const f32x4*)(mu + c8 * 8 + 4);
        f32x4 x0 = (f32x4){bflo(c.x), bfhi(c.x), bflo(c.y), bfhi(c.y)}, x1 = (f32x4){bflo(c.z), bfhi(c.z), bflo(c.w), bfhi(c.w)};
        const f32x4 s0 = (f32x4){bflo(p.x) + bflo(n.x), bfhi(p.x) + bfhi(n.x), bflo(p.y) + bflo(n.y), bfhi(p.y) + bfhi(n.y)}, s1 = (f32x4){bflo(p.z) + bflo(n.z), bfhi(p.z) + bfhi(n.z), bflo(p.w) + bflo(n.w), bfhi(p.w) + bfhi(n.w)};
        x0 = x0 + (0.5f * s0 - x0) * m0; x1 = x1 + (0.5f * s1 - x1) * m1;
        const int ch = c8 * 8, reg = ch >> 9; LAS float* dst = (reg == 0 ? RP : (reg == 1 ? KP : VP)) + i * RP_PITCH + (ch & 511);
        *(LAS f32x4*)dst = x0; *(LAS f32x4*)(dst + 4) = x1; }
    for (int idx = tid; idx < 16 * 80; idx += NTHR) { const int i = idx / 80, c4 = idx % 80, jj = j0 + i;
        const bool hp = isctx ? (jj - 1 >= 0) : (jj - 1 >= LCTX), hn = isctx ? (jj + 1 < LCTX) : (jj + 1 < RJ);
        f32x4 x = *(const f32x4*)(MISC + (size_t)rwkv_tok(b, jj) * 512 + 64 + c4 * 4); f32x4 p = (f32x4){0.f, 0.f, 0.f, 0.f}, n = p;
        if (hp) p = *(const f32x4*)(MISC + (size_t)rwkv_tok(b, jj - 1) * 512 + 64 + c4 * 4);
        if (hn) n = *(const f32x4*)(MISC + (size_t)rwkv_tok(b, jj + 1) * 512 + 64 + c4 * 4);
        x = x + (0.5f * (p + n) - x) * *(const f32x4*)(mu + 1536 + c4 * 4);
        const int m = c4 * 4;
        if (m < 128) x = (f32x4){tanhf(x.x), tanhf(x.y), tanhf(x.z), tanhf(x.w)}; else if (m >= 192) x = (f32x4){sigmoidf_(x.x), sigmoidf_(x.y), sigmoidf_(x.z), sigmoidf_(x.w)};
        *(LAS v2u*)(ACT + i * ACT_PITCH + m) = (v2u){pk2(x.x, x.y), pk2(x.z, x.w)}; }
    __syncthreads();
    const int fr = lane & 15, fq = lane >> 4, h = wave;
    f32x4 acc[4][4];
#pragma unroll
    for (int o = 0; o < 4; ++o)
#pragma unroll
        for (int nt = 0; nt < 4; ++nt) acc[o][nt] = (f32x4){0.f, 0.f, 0.f, 0.f};
    {
        const bf16* WLT = (const bf16*)(ws + OFF_WLT) + (size_t)l * 512 * 320 + (size_t)(64 * wave + fr) * 320 + fq * 8;
#pragma unroll
        for (int ks = 0; ks < 10; ++ks) { const int o = ks < 2 ? 0 : (ks < 4 ? 1 : (ks < 6 ? 2 : 3));
            const bf16x8 af = *(const LAS bf16x8*)(ACT + fr * ACT_PITCH + ks * 32 + fq * 8);
#pragma unroll
            for (int nt = 0; nt < 4; ++nt) { const bf16x8 bf = *(const bf16x8*)(WLT + (size_t)nt * 16 * 320 + ks * 32);
                acc[o][nt] = __builtin_amdgcn_mfma_f32_16x16x32_bf16(af, bf, acc[o][nt], 0, 0, 0); } }
    }
    float* RW = (float*)(ws + OFF_RW); constexpr size_t AS = RW_ARR / 4; float* RSC = (float*)(ws + OFF_RSC);
    float w0f[4], w0b[4], a0c[4], kkc[4], kac[4], rkc[4];
#pragma unroll
    for (int nt = 0; nt < 4; ++nt) { const int c = 64 * wave + 16 * nt + fr; w0f[nt] = a->in[I_RW0][(l * 2 + 0) * 512 + c]; w0b[nt] = a->in[I_RW0][(l * 2 + 1) * 512 + c]; a0c[nt] = a->in[I_RA0][l * 512 + c];
        kkc[nt] = a->in[I_RKK][l * 512 + c]; kac[nt] = a->in[I_RKA][l * 512 + c]; rkc[nt] = a->in[I_RRK][l * 512 + c]; }
#pragma unroll
    for (int i = 0; i < 4; ++i) { const int tok = 4 * fq + i; const size_t R = (size_t)b * RJ + j0 + tok;
        float r[4], k[4], v[4], av[4], kkv[4]; float ss = 0.f;
#pragma unroll
        for (int nt = 0; nt < 4; ++nt) { const int c = 64 * wave + 16 * nt + fr; r[nt] = RP[tok * RP_PITCH + c]; k[nt] = KP[tok * RP_PITCH + c]; v[nt] = VP[tok * RP_PITCH + c];
            av[nt] = sigmoidf_(a0c[nt] + acc[2][nt][i]); kkv[nt] = k[nt] * kkc[nt]; ss += kkv[nt] * kkv[nt]; }
        const float rn = rsqrtf(row16_sum(ss) + 1e-12f);
        float c1 = 0.f, c2 = 0.f, bon = 0.f;
#pragma unroll
        for (int nt = 0; nt < 4; ++nt) { const int c = 64 * wave + 16 * nt + fr;
            const float wf = __expf(-__expf(-softplusf_(-(w0f[nt] + acc[0][nt][i])) - 0.5f)), wb = __expf(-__expf(-softplusf_(-(w0b[nt] + acc[1][nt][i])) - 0.5f));
            const float kk = kkv[nt] * rn, kmod = k[nt] * (1.f + (av[nt] - 1.f) * kac[nt]), ka = kk * av[nt];
            c1 += ka * r[nt]; c2 += kmod * r[nt]; bon += r[nt] * kmod * rkc[nt];
            float* o = RW + R * 512 + c;
            o[0 * AS] = wf; o[1 * AS] = wf * r[nt]; o[2 * AS] = wb; o[3 * AS] = wb * r[nt]; o[4 * AS] = kmod; o[5 * AS] = -kk; o[6 * AS] = ka; o[7 * AS] = v[nt]; o[8 * AS] = acc[3][nt][i]; }
        c1 = row16_sum(c1); c2 = row16_sum(c2); bon = row16_sum(bon);
        if (fr == 0) { RSC[R * 8 + h] = c1; RSC[(size_t)TT * 8 + R * 8 + h] = c2; RSC[(size_t)2 * TT * 8 + R * 8 + h] = bon; }
    }
    __syncthreads();
}
__device__ __forceinline__ void ssd_prep_item(KArgs a, int l, int item, int tid) {
    unsigned char* ws = a->ws; const bf16* U = (const bf16*)(ws + OFF_U); const float* MISC = (const float*)(ws + OFF_MISC);
    bf16* XBC = (bf16*)(ws + OFF_XBC); float* DTA = (float*)(ws + OFF_DTA);
    const int t0 = item * 16;
    const int seq_lo = t0 < TLAT ? (t0 & ~(LSEQ - 1)) : TLAT + ((t0 - TLAT) & ~(LCTX - 1)), seq_hi = seq_lo + (t0 < TLAT ? LSEQ : LCTX);
    for (int cp = tid; cp < 896; cp += NTHR) {
        float w0[5], w1[5];
#pragma unroll
        for (int j = 0; j < 5; ++j) { const f32x2 w = *(const f32x2*)(a->in[I_SCW] + (size_t)(l * 5 + j) * 1792 + 2 * cp); w0[j] = w.x; w1[j] = w.y; }
        const f32x2 bb = *(const f32x2*)(a->in[I_SCB] + l * 1792 + 2 * cp);
        float i0[20], i1[20];
#pragma unroll
        for (int r = 0; r < 20; ++r) { const int row = t0 - 2 + r; unsigned u = 0u; if (row >= seq_lo && row < seq_hi) u = *(const unsigned*)(U + (size_t)row * NU + UXBC + 2 * cp); i0[r] = bflo(u); i1[r] = bfhi(u); }
#pragma unroll
        for (int o = 0; o < 16; ++o) { float s0 = bb.x, s1 = bb.y;
#pragma unroll
            for (int j = 0; j < 5; ++j) { s0 += w0[j] * i0[o + j]; s1 += w1[j] * i1[o + j]; }
            *(unsigned*)(XBC + (size_t)(t0 + o) * 1792 + 2 * cp) = pk2(siluf_(s0), siluf_(s1)); }
    }
    if (tid < 16 * 24) { const int o = tid / 24, q = tid % 24;
        const float dt = softplusf_(MISC[(size_t)(t0 + o) * 512 + q] + a->in[I_SDTB][l * 24 + q]); const float A = -__expf(a->in[I_SALOG][l * 24 + q]);
        DTA[(size_t)(t0 + o) * 48 + q] = dt; DTA[(size_t)(t0 + o) * 48 + 24 + q] = dt * A; }
}
__device__ __forceinline__ void conv_item(KArgs a, int l, int item, LAS unsigned char* lds, int tid, int lane, int wave) {
    unsigned char* ws = a->ws; const bf16* U = (const bf16*)(ws + OFF_U); bf16* AC = (bf16*)(ws + OFF_ACAT) + AC_CONV;
    int t0, seg_lo, seg_hi;
    if (item < 256) { t0 = item * 32; seg_lo = t0 & ~63; seg_hi = seg_lo + 64; }
    else { const int ci = item - 256; t0 = TLAT + ci * 32; seg_lo = TLAT + (ci >> 3) * LCTX; seg_hi = seg_lo + LCTX; }
    LAS bf16* inimg = (LAS bf16*)lds;
    LAS float* outimg = (LAS float*)(lds + 63488);
    for (int idx = tid; idx < 62 * 64; idx += NTHR) { const int rr = idx >> 6, c8 = idx & 63, row = t0 - 15 + rr;
        v4u o = (v4u){0u, 0u, 0u, 0u};
        if (row >= seg_lo && row < seg_hi) { const v4u va = *(const v4u*)(U + (size_t)row * NU + UCONV + c8 * 8), vg = *(const v4u*)(U + (size_t)row * NU + UCONV + 512 + c8 * 8);
            o.x = pk2(bflo(va.x) * sigmoidf_(bflo(vg.x)), bfhi(va.x) * sigmoidf_(bfhi(vg.x))); o.y = pk2(bflo(va.y) * sigmoidf_(bflo(vg.y)), bfhi(va.y) * sigmoidf_(bfhi(vg.y)));
            o.z = pk2(bflo(va.z) * sigmoidf_(bflo(vg.z)), bfhi(va.z) * sigmoidf_(bfhi(vg.z))); o.w = pk2(bflo(va.w) * sigmoidf_(bflo(vg.w)), bfhi(va.w) * sigmoidf_(bfhi(vg.w))); }
        *(LAS v4u*)(inimg + rr * 512 + c8 * 8) = o; }
    __syncthreads();
    {
        const int c = tid; float w[31];
#pragma unroll
        for (int j = 0; j < 31; ++j) w[j] = a->in[I_CONVW][(size_t)(l * 31 + j) * 512 + c];
        const float bias = a->in[I_CONVB][l * 512 + c];
#pragma unroll 2
        for (int o = 0; o < 32; ++o) { float s = bias;
#pragma unroll
            for (int j = 0; j < 31; ++j) s += w[j] * bf2f(inimg[(o + j) * 512 + c]);
            outimg[o * 512 + c] = s; }
    }
    __syncthreads();
    {
        const f32x4 g0 = *(const f32x4*)(a->in[I_CLNG] + l * 512 + 8 * lane), g1 = *(const f32x4*)(a->in[I_CLNG] + l * 512 + 8 * lane + 4);
        const f32x4 b0 = *(const f32x4*)(a->in[I_CLNB] + l * 512 + 8 * lane), b1 = *(const f32x4*)(a->in[I_CLNB] + l * 512 + 8 * lane + 4);
#pragma unroll
        for (int q = 0; q < 4; ++q) { const int o = wave * 4 + q;
            f32x4 x0 = *(const LAS f32x4*)(outimg + o * 512 + 8 * lane), x1 = *(const LAS f32x4*)(outimg + o * 512 + 8 * lane + 4);
            const float mean = wave_sum((x0.x + x0.y + x0.z + x0.w) + (x1.x + x1.y + x1.z + x1.w)) * (1.f / 512.f);
            x0 = x0 - mean; x1 = x1 - mean;
            const float var = wave_sum((x0.x * x0.x + x0.y * x0.y + x0.z * x0.z + x0.w * x0.w) + (x1.x * x1.x + x1.y * x1.y + x1.z * x1.z + x1.w * x1.w)) * (1.f / 512.f);
            const float rs = rsqrtf(var + 1e-5f);
            x0 = x0 * rs * g0 + b0; x1 = x1 * rs * g1 + b1;
            v4u ov; ov.x = pk2(siluf_(x0.x), siluf_(x0.y)); ov.y = pk2(siluf_(x0.z), siluf_(x0.w)); ov.z = pk2(siluf_(x1.x), siluf_(x1.y)); ov.w = pk2(siluf_(x1.z), siluf_(x1.w));
            *(v4u*)(AC + (size_t)(t0 + o) * ACW + 8 * lane) = ov; }
    }
    __syncthreads();
}

__device__ __forceinline__ int ssd_tok(int b, int dir, int pos) {
    if (pos < LCTX) return TLAT + b * LCTX + (dir ? (LCTX - 1 - pos) : pos);
    const int q = pos - LCTX; return b * LSEQ + (dir ? (LSEQ - 1 - q) : q);
}
__device__ __forceinline__ void post_phase(KArgs a, int l, int bid, int G, const int wave0) {
    PH_IDS
    unsigned char* ws = a->ws; const int gw = bid * NWAVES + wave, NGW = G * NWAVES;
    const bf16* U = (const bf16*)(ws + OFF_U); const bf16* XBC = (const bf16*)(ws + OFF_XBC);
    const float* Y0 = (const float*)(ws + OFF_YSSD); const float* Y1 = Y0 + (size_t)TT * 768; bf16* AS_ = (bf16*)(ws + OFF_ACAT) + AC_SSD;
    for (int row = gw; row < TT; row += NGW) {
        f32x4 y[3]; float ss = 0.f;
#pragma unroll
        for (int j = 0; j < 3; ++j) { const int col = 4 * lane + 256 * j; const float dsk = a->in[I_SD][l * 12 + (col >> 6)];
            const f32x4 yf = *(const f32x4*)(Y0 + (size_t)row * 768 + col), yb = *(const f32x4*)(Y1 + (size_t)row * 768 + col);
            const v2u xs = *(const v2u*)(XBC + (size_t)row * 1792 + col), z = *(const v2u*)(U + (size_t)row * NU + UZ + col);
            f32x4 v = yf + yb + dsk * (f32x4){bflo(xs.x), bfhi(xs.x), bflo(xs.y), bfhi(xs.y)};
            v = v * (f32x4){siluf_(bflo(z.x)), siluf_(bfhi(z.x)), siluf_(bflo(z.y)), siluf_(bfhi(z.y))};
            y[j] = v; ss += (v.x * v.x + v.y * v.y) + (v.z * v.z + v.w * v.w); }
        const float r = rsqrtf(wave_sum(ss) * (1.f / 768.f) + 1e-6f);
#pragma unroll
        for (int j = 0; j < 3; ++j) { const int col = 4 * lane + 256 * j; const f32x4 g = *(const f32x4*)(a->in[I_SNG] + l * 768 + col); const f32x4 o = y[j] * r * g;
            *(v2u*)(AS_ + (size_t)row * ACW + col) = (v2u){pk2(o.x, o.y), pk2(o.z, o.w)}; }
    }
    const float* RW = (const float*)(ws + OFF_RW); constexpr size_t AS = RW_ARR / 4; const float* RSC = (const float*)(ws + OFF_RSC);
    const float* R0 = (const float*)(ws + OFF_YRW); const float* R1 = R0 + (size_t)TT * 512; bf16* AR = (bf16*)(ws + OFF_ACAT) + AC_RWKV;
    for (int row = gw; row < TT; row += NGW) {
        size_t R;
        if (row < TLAT) { const int b = row >> 11, t = row & 2047, rr = t >> 6, cc = t & 63; R = (size_t)b * RJ + LCTX + cc * 32 + rr; }
        else { const int b = (row - TLAT) >> 8, jj = (row - TLAT) & 255; R = (size_t)b * RJ + jj; }
        const int c0 = 8 * lane, h = lane >> 3;
        f32x4 ya = *(const f32x4*)(R0 + R * 512 + c0) + *(const f32x4*)(R1 + R * 512 + c0), yb = *(const f32x4*)(R0 + R * 512 + c0 + 4) + *(const f32x4*)(R1 + R * 512 + c0 + 4);
        float s = (ya.x + ya.y + ya.z + ya.w) + (yb.x + yb.y + yb.z + yb.w);
        s = sum8(s);
        const float mean = s * (1.f / 64.f); ya = ya - mean; yb = yb - mean;
        float q = (ya.x * ya.x + ya.y * ya.y + ya.z * ya.z + ya.w * ya.w) + (yb.x * yb.x + yb.y * yb.y + yb.z * yb.z + yb.w * yb.w);
        q = sum8(q);
        const float rs = rsqrtf(q * (1.f / 64.f) + 64e-5f);
        const f32x4 lg0 = *(const f32x4*)(a->in[I_RLNG] + l * 512 + c0), lg1 = *(const f32x4*)(a->in[I_RLNG] + l * 512 + c0 + 4), lb0 = *(const f32x4*)(a->in[I_RLNB] + l * 512 + c0), lb1 = *(const f32x4*)(a->in[I_RLNB] + l * 512 + c0 + 4);
        const float bon = RSC[(size_t)2 * TT * 8 + R * 8 + h];
        const f32x4 v0 = *(const f32x4*)(RW + 7 * AS + R * 512 + c0), v1 = *(const f32x4*)(RW + 7 * AS + R * 512 + c0 + 4), g0 = *(const f32x4*)(RW + 8 * AS + R * 512 + c0), g1 = *(const f32x4*)(RW + 8 * AS + R * 512 + c0 + 4);
        const f32x4 o0 = (ya * rs * lg0 + lb0 + bon * v0) * g0, o1 = (yb * rs * lg1 + lb1 + bon * v1) * g1;
        *(v4u*)(AR + (size_t)row * ACW + c0) = (v4u){pk2(o0.x, o0.y), pk2(o0.z, o0.w), pk2(o1.x, o1.y), pk2(o1.z, o1.w)};
    }
}

__device__ __forceinline__ size_t rwkv_row(int b, int dir, int pos) { const int j = dir ? (pos < LCTX ? (LCTX - 1 - pos) : (RJ + LCTX - 1 - pos)) : pos; return (size_t)b * RJ + j; }
constexpr int RWS_BUF = 45568, RWS_V = 40960, RWS_C = 45056, RWS_CH = 32;
__device__ __forceinline__ void rwkv_scan_fast(KArgs a, int idx, LAS unsigned char* lds, int tid, int lane, int wave) {
    unsigned char* ws = a->ws; const float* RW = (const float*)(ws + OFF_RW); constexpr size_t AS = RW_ARR / 4; const float* RSC = (const float*)(ws + OFF_RSC);
    const int combo = idx >> 1, half = idx & 1, b = combo >> 4, dir = (combo >> 3) & 1, h = combo & 7, v0 = half * 32;
    float* Yo = (float*)(ws + OFF_YRW) + (size_t)dir * TT * 512;
    const float* arr0 = RW + (dir ? 2 : 0) * AS; const float* arr1 = RW + (dir ? 3 : 1) * AS;
    const int ls = tid >> 4, lc4 = tid & 15;
    f32x4 pre[5]; f32x4 prev = (f32x4){0.f, 0.f, 0.f, 0.f}; float prec = 0.f;
    auto issue = [&](int chunk) {
        const size_t R = rwkv_row(b, dir, chunk * RWS_CH + ls); const size_t o = R * 512 + h * 64 + lc4 * 4;
        pre[0] = *(const f32x4*)(arr0 + o); pre[1] = *(const f32x4*)(arr1 + o); pre[2] = *(const f32x4*)(RW + 4 * AS + o); pre[3] = *(const f32x4*)(RW + 5 * AS + o); pre[4] = *(const f32x4*)(RW + 6 * AS + o);
        if (tid < 256) { const size_t R2 = rwkv_row(b, dir, chunk * RWS_CH + (tid >> 3)); prev = *(const f32x4*)(RW + 7 * AS + R2 * 512 + h * 64 + v0 + (tid & 7) * 4); }
        else if (tid < 320) { const int t2 = tid - 256; const size_t R2 = rwkv_row(b, dir, chunk * RWS_CH + (t2 >> 1)); prec = RSC[(size_t)(t2 & 1) * TT * 8 + R2 * 8 + h]; }
    };
    auto commit = [&](int buf) {
        LAS unsigned char* B = lds + buf * RWS_BUF;
#pragma unroll
        for (int i = 0; i < 5; ++i) *(LAS f32x4*)(B + i * 8192 + ls * 256 + lc4 * 16) = pre[i];
        if (tid < 256) *(LAS f32x4*)(B + RWS_V + (tid >> 3) * 128 + (tid & 7) * 16) = prev;
        else if (tid < 320) *(LAS float*)(B + RWS_C + (tid - 256) * 4) = prec;
    };
    f32x4 S0 = (f32x4){0.f, 0.f, 0.f, 0.f}, S1 = S0;
    const int rl = (wave & 3) * 8 + (lane >> 3), q = lane & 7;
    LAS float* ybuf = (LAS float*)(lds + 2 * RWS_BUF);
    issue(0); commit(0); __syncthreads();
    constexpr int NCH = RJ / RWS_CH;
    struct RwOp { f32x4 w0, w1, r0, r1, k0, k1, n0, n1, a0, a1; float vv; f32x2 cc; };
    for (int ch = 0; ch < NCH; ++ch) {
        if (ch + 1 < NCH) issue(ch + 1);
        if (wave < 4) {
            const LAS unsigned char* B = lds + (ch & 1) * RWS_BUF; const LAS unsigned char* p0 = B + q * 32; const LAS unsigned char* pv = B + RWS_V + rl * 4;
            LAS float* yb = ((q == 0) ? (ybuf + (ch & 1) * 1024) : (ybuf + 2048)) + rl;
            auto ldop = [&](int s) { RwOp o; const LAS unsigned char* p = p0 + s * 256;
                o.w0 = *(const LAS f32x4*)(p); o.w1 = *(const LAS f32x4*)(p + 16); o.r0 = *(const LAS f32x4*)(p + 8192); o.r1 = *(const LAS f32x4*)(p + 8192 + 16);
                o.k0 = *(const LAS f32x4*)(p + 16384); o.k1 = *(const LAS f32x4*)(p + 16384 + 16); o.n0 = *(const LAS f32x4*)(p + 24576); o.n1 = *(const LAS f32x4*)(p + 24576 + 16);
                o.a0 = *(const LAS f32x4*)(p + 32768); o.a1 = *(const LAS f32x4*)(p + 32768 + 16);
                o.vv = *(const LAS float*)(pv + s * 128); o.cc = *(const LAS f32x2*)(B + RWS_C + s * 8); return o; };
            RwOp cur = ldop(0);
#pragma unroll
            for (int s = 0; s < RWS_CH; ++s) {
                RwOp nxt = cur; if (s + 1 < RWS_CH) nxt = ldop(s + 1);
                const f32x4 t0 = S0 * cur.n0 + S1 * cur.n1, t1 = S0 * cur.r0 + S1 * cur.r1;
                float sa = (t0.x + t0.y) + (t0.z + t0.w), pp = (t1.x + t1.y) + (t1.z + t1.w);
                sa = dpp_add<0xB1>(sa); pp = dpp_add<0xB1>(pp); sa = dpp_add<0x4E>(sa); pp = dpp_add<0x4E>(pp); sa = dpp_add<0x141>(sa); pp = dpp_add<0x141>(pp);
                S0 = S0 * cur.w0 + (sa * cur.a0 + cur.vv * cur.k0); S1 = S1 * cur.w1 + (sa * cur.a1 + cur.vv * cur.k1);
                const float y = pp + sa * cur.cc.x + cur.vv * cur.cc.y;
                yb[s * 32] = y;
                cur = nxt;
            }
        } else if (ch > 0) {
            const int t2 = tid - 256, s = t2 >> 3, r4 = t2 & 7; const size_t R = rwkv_row(b, dir, (ch - 1) * RWS_CH + s);
            *(f32x4*)(Yo + R * 512 + h * 64 + v0 + r4 * 4) = *(const LAS f32x4*)(ybuf + ((ch - 1) & 1) * 1024 + s * 32 + r4 * 4);
        }
        if (ch + 1 < NCH) commit((ch + 1) & 1);
        __syncthreads();
    }
    if (wave >= 4) { const int t2 = tid - 256, s = t2 >> 3, r4 = t2 & 7; const size_t R = rwkv_row(b, dir, (NCH - 1) * RWS_CH + s);
        *(f32x4*)(Yo + R * 512 + h * 64 + v0 + r4 * 4) = *(const LAS f32x4*)(ybuf + ((NCH - 1) & 1) * 1024 + s * 32 + r4 * 4); }
    __syncthreads();
}

constexpr int SS_CM = 0, SS_BM = 17408, SS_BST = 34816, SS_XT = 53248, SS_MX = 62464, SS_HB = 71680, SS_CS = 89088, SS_DT = 89344;
__device__ __forceinline__ float bfe(const v4u& v, int i) { const unsigned u = (i < 2) ? v.x : (i < 4) ? v.y : (i < 6) ? v.z : v.w; return (i & 1) ? bfhi(u) : bflo(u); }
__device__ __forceinline__ unsigned short bfraw(const v4u& v, int i) { const unsigned u = (i < 2) ? v.x : (i < 4) ? v.y : (i < 6) ? v.z : v.w; return (unsigned short)((i & 1) ? (u >> 16) : (u & 0xffffu)); }
__device__ __forceinline__ void ssd_scan_fast(KArgs a, int idx, LAS unsigned char* lds, int tid, int lane, int wave) {
    unsigned char* ws = a->ws; const bf16* XBC = (const bf16*)(ws + OFF_XBC); const float* DTA = (const float*)(ws + OFF_DTA);
    const int b = idx / 24, dir = (idx % 24) / 12, h = idx % 12, g = h / 3, q = dir * 12 + h;
    float* Yo = (float*)(ws + OFF_YSSD) + (size_t)dir * TT * 768;
    LAS bf16* Cm = (LAS bf16*)(lds + SS_CM); LAS bf16* Bm = (LAS bf16*)(lds + SS_BM); LAS bf16* BsT = (LAS bf16*)(lds + SS_BST); LAS bf16* XT = (LAS bf16*)(lds + SS_XT);
    LAS bf16* Mx = (LAS bf16*)(lds + SS_MX); LAS bf16* Hb = (LAS bf16*)(lds + SS_HB); LAS float* CS = (LAS float*)(lds + SS_CS); LAS float* DTV = (LAS float*)(lds + SS_DT);
    const int fr = lane & 15, fq = lane >> 4, ss = tid & 63, sc = tid >> 6, tl = wave >> 1, wh = wave & 1;
    { unsigned z = 0u; asm volatile("" : "+v"(z)); for (int i = tid; i < 17408 / 16; i += NTHR) *(LAS v4u*)(lds + SS_HB + i * 16) = (v4u){z, z, z, z}; }
    f32x4 hacc[4];
#pragma unroll
    for (int j = 0; j < 4; ++j) hacc[j] = (f32x4){0.f, 0.f, 0.f, 0.f};
    v4u pc0, pc1, pb0, pb1, px; float pdt = 0.f, pa = 0.f;
    auto issue = [&](int ch) {
        const int tok = ssd_tok(b, dir, ch * 64 + ss); const bf16* row = XBC + (size_t)tok * 1792;
        pc0 = *(const v4u*)(row + 1280 + g * 128 + sc * 8); pc1 = *(const v4u*)(row + 1280 + g * 128 + (sc + 8) * 8);
        pb0 = *(const v4u*)(row + 768 + g * 128 + sc * 8); pb1 = *(const v4u*)(row + 768 + g * 128 + (sc + 8) * 8);
        px = *(const v4u*)(row + h * 64 + sc * 8);
        if (tid < 64) { pdt = DTA[(size_t)tok * 48 + q]; pa = DTA[(size_t)tok * 48 + 24 + q]; }
    };
    issue(0);
    for (int ch = 0; ch < RJ / 64; ++ch) {
        *(LAS v4u*)(Cm + ss * 136 + sc * 8) = pc0; *(LAS v4u*)(Cm + ss * 136 + (sc + 8) * 8) = pc1;
        *(LAS v4u*)(Bm + ss * 136 + sc * 8) = pb0; *(LAS v4u*)(Bm + ss * 136 + (sc + 8) * 8) = pb1;
#pragma unroll
        for (int i = 0; i < 8; ++i) XT[(sc * 8 + i) * 72 + ss] = bfraw(px, i);
        if (tid < 64) { float x = pa;
#pragma unroll
            for (int o = 1; o < 64; o <<= 1) { const float t = __int_as_float(__builtin_amdgcn_ds_bpermute((lane - o) << 2, __float_as_int(x))); if (lane >= o) x += t; }
            CS[tid] = x; DTV[tid] = pdt; }
        __syncthreads();
        const float cl = CS[63];
        { const float scl = DTV[ss] * __expf(cl - CS[ss]);
#pragma unroll
            for (int i = 0; i < 8; ++i) { BsT[(sc * 8 + i) * 72 + ss] = (bf16)f2bf(bfe(pb0, i) * scl); BsT[((sc + 8) * 8 + i) * 72 + ss] = (bf16)f2bf(bfe(pb1, i) * scl); } }
        if (ch + 1 < RJ / 64) issue(ch + 1);
#pragma unroll
        for (int j = 0; j < 2; ++j) { const int tc = wh * 2 + j; f32x4 acc = (f32x4){0.f, 0.f, 0.f, 0.f};
            if (tc <= tl) {
#pragma unroll
                for (int ks = 0; ks < 4; ++ks) { const bf16x8 af = *(const LAS bf16x8*)(Cm + (16 * tl + fr) * 136 + ks * 32 + fq * 8), bf = *(const LAS bf16x8*)(Bm + (16 * tc + fr) * 136 + ks * 32 + fq * 8);
                    acc = __builtin_amdgcn_mfma_f32_16x16x32_bf16(af, bf, acc, 0, 0, 0); } }
            const int s = 16 * tc + fr; const float css = CS[s], dts = DTV[s];
#pragma unroll
            for (int i = 0; i < 4; ++i) { const int l = 16 * tl + 4 * fq + i; const float v = (s <= l) ? acc[i] * __expf(CS[l] - css) * dts : 0.f; Mx[l * 72 + s] = (bf16)f2bf(v); } }
        __syncthreads();
#pragma unroll
        for (int j = 0; j < 2; ++j) { const int tp = wh * 2 + j; f32x4 acc = (f32x4){0.f, 0.f, 0.f, 0.f};
#pragma unroll
            for (int ks = 0; ks < 4; ++ks) { const bf16x8 af = *(const LAS bf16x8*)(Cm + (16 * tl + fr) * 136 + ks * 32 + fq * 8), bf = *(const LAS bf16x8*)(Hb + (16 * tp + fr) * 136 + ks * 32 + fq * 8);
                acc = __builtin_amdgcn_mfma_f32_16x16x32_bf16(af, bf, acc, 0, 0, 0); }
#pragma unroll
            for (int i = 0; i < 4; ++i) acc[i] *= __expf(CS[16 * tl + 4 * fq + i]);
#pragma unroll
            for (int ks = 0; ks < 2; ++ks) { const bf16x8 af = *(const LAS bf16x8*)(Mx + (16 * tl + fr) * 72 + ks * 32 + fq * 8), bf = *(const LAS bf16x8*)(XT + (16 * tp + fr) * 72 + ks * 32 + fq * 8);
                acc = __builtin_amdgcn_mfma_f32_16x16x32_bf16(af, bf, acc, 0, 0, 0); }
#pragma unroll
            for (int i = 0; i < 4; ++i) { const int tok = ssd_tok(b, dir, ch * 64 + 16 * tl + 4 * fq + i); Yo[(size_t)tok * 768 + h * 64 + 16 * tp + fr] = acc[i]; } }
        { const float ecl = __expf(cl);
#pragma unroll
            for (int j = 0; j < 4; ++j) { const int tn = wh * 4 + j; hacc[j] = hacc[j] * ecl;
#pragma unroll
                for (int ks = 0; ks < 2; ++ks) { const bf16x8 af = *(const LAS bf16x8*)(XT + (16 * tl + fr) * 72 + ks * 32 + fq * 8), bf = *(const LAS bf16x8*)(BsT + (16 * tn + fr) * 72 + ks * 32 + fq * 8);
                    hacc[j] = __builtin_amdgcn_mfma_f32_16x16x32_bf16(af, bf, hacc[j], 0, 0, 0); } } }
        __syncthreads();
#pragma unroll
        for (int j = 0; j < 4; ++j) { const int tn = wh * 4 + j;
#pragma unroll
            for (int i = 0; i < 4; ++i) Hb[(16 * tl + 4 * fq + i) * 136 + 16 * tn + fr] = (bf16)f2bf(hacc[j][i]); }
    }
}

constexpr int NPH = 2 + 10 * DEPTH;
#ifndef PROBE_MASK
#define PROBE_MASK 0
#endif
#ifndef PROBE_P0
#define PROBE_P0 0
#endif
#ifndef PROBE_SUB
#define PROBE_SUB 0
#endif
#ifndef PROBE_REPS
#define PROBE_REPS 3
#endif
#define REPS(k) (((PROBE_MASK >> (k)) & 1) ? PROBE_REPS : 1)
#ifndef MK_ONE_LAUNCH
#define MK_ONE_LAUNCH 1
#endif

__global__ void __launch_bounds__(NTHR, 2) fwd(Args a_unused) {
    extern __shared__ __attribute__((aligned(16))) unsigned char lds_raw[];
    LAS unsigned char* lds = (LAS unsigned char*)lds_raw;
    const int bid0 = blockIdx.x, G0 = gridDim.x, wave0 = __builtin_amdgcn_readfirstlane(threadIdx.x >> 6);
#define PH_BG int bid = bid0, G = G0; asm volatile("" : "+s"(bid), "+s"(G));
    volatile LAS unsigned* MISCW = (volatile LAS unsigned*)(lds + MISC_OFF);
    if (threadIdx.x < 32) MISCW[threadIdx.x] = 0u;
    __syncthreads();
    const int ph_lo = kargs()->ph_lo, ph_hi = kargs()->ph_hi;
    const bool multi = (ph_hi - ph_lo) > 1;
    XcdBarrier bar; bar.bar = (unsigned*)(kargs()->ws + OFF_CTL) + CW_BAR; bar.x = 0; bar.st = nullptr; bar.wv = wave0;
    if (multi) bar = xcd_barrier_post((unsigned*)(kargs()->ws + OFF_CTL) + CW_BAR, MISCW + 8, wave0);
#define IN(k) (ph_lo <= (k) && (k) < ph_hi)
#define SEAM(k) do { if (IN(k) && IN((k) + 1)) xcd_barrier(bar); } while (0)

    for (int rep = 0; rep < (PROBE_P0 ? PROBE_REPS : 1); ++rep) {
    if (IN(0)) { PH_BG p0_prologue(kargs(), lds, bid, G, wave0); }
    if (rep + 1 < (PROBE_P0 ? PROBE_REPS : 1)) xcd_barrier(bar); }
    SEAM(0);
    if (IN(1)) { PH_BG KArgs a = kargs(); norm_phase(a, 0, nullptr, a->in[I_NORMG] + 0, nullptr, (const float*)(a->ws + OFF_MODV), bid, G, wave0, TT); }
    SEAM(1);

    for (int l = 0; l < DEPTH; ++l) {
        const int pb = 2 + 10 * l;
#define PH_LOCALS PH_BG KArgs a = kargs(); unsigned char* ws = a->ws; unsigned char* wl = ws + OFF_W + (size_t)l * W_LAYER; bf16* Hb = (bf16*)(ws + OFF_H); (void)wl; (void)Hb; \
        const float* ng = a->in[I_NORMG] + (size_t)l * 4 * DM; const float* mv = (const float*)(ws + OFF_MODV) + (size_t)l * 5 * 12288; (void)ng; (void)mv;
        const bool lastl = (l == DEPTH - 1);
        for (int rep = 0; rep < REPS(0); ++rep) {
        if (IN(pb + 0)) { PH_LOCALS
            __syncthreads();
            pg8::Sched2 S; S.A0 = (const char*)Hb; S.B0 = (const char*)(wl + WO_IN); S.A1 = (const char*)(wl + WO_FFT); S.B1 = (const char*)Hb; S.tstep = (size_t)256 * DM * 2; S.ntk = DM / 64;
            S.t0.init(TT / 256, NU / 256); S.t1.init(4, TT / 256); S.G = G; S.c = bid;
            pg8::EpiIn2 E{pg8::EpiInproj{(bf16*)(ws + OFF_U), (float*)(ws + OFF_MISC), NU}, pg8::EpiBf{0, (bf16*)(ws + OFF_VTL), (bf16*)(ws + OFF_VTC)}};
            pg8::gemm_phase<pg8::EpiIn2, pg8::Sched2, true, true>(lds, DM, S, E, wave0);
        }
        if (rep + 1 < REPS(0)) xcd_barrier(bar); }
        SEAM(pb + 0);
        for (int rep = 0; rep < REPS(1); ++rep) {
        if (IN(pb + 1)) { PH_LOCALS PH_IDS
            __syncthreads();
            if (bid < 64) { pg8::Sched2 S; S.A0 = (const char*)(ws + OFF_DFTL); S.B0 = (const char*)(ws + OFF_VTL); S.A1 = S.A0; S.B1 = S.B0; S.tstep = (size_t)256 * 4096 * 2; S.ntk = 64; S.t0.init(8, 8); S.t1.init(0, 0); S.G = 64; S.c = bid;
                  pg8::EpiBf E{1, (bf16*)(ws + OFF_ACAT), nullptr};
                  pg8::gemm_phase<pg8::EpiBf, pg8::Sched2, true, true>(lds, 4096, S, E, wave0); }
            else if (bid < 72) { pg8::Sched2 S; S.A0 = (const char*)(ws + OFF_DFTC); S.B0 = (const char*)(ws + OFF_VTC); S.A1 = S.A0; S.B1 = S.B0; S.tstep = (size_t)256 * 512 * 2; S.ntk = 8; S.t0.init(1, 8); S.t1.init(0, 0); S.G = 8; S.c = bid - 64;
                  pg8::EpiBf E{2, (bf16*)(ws + OFF_ACAT), nullptr};
                  pg8::gemm_phase<pg8::EpiBf, pg8::Sched2, true, true>(lds, 512, S, E, wave0); }
            __syncthreads();
            {
                unsigned* qctr = (unsigned*)(ws + OFF_CTL) + CW_Q + (l * 4 + rep) * 64;
                volatile LAS unsigned* qslot = (volatile LAS unsigned*)(lds + MISC_OFF) + 16;
                for (;;) {
                    if (tid == 0) qslot[0] = __hip_atomic_fetch_add(qctr, 1u, __ATOMIC_RELAXED, __HIP_MEMORY_SCOPE_AGENT);
                    __syncthreads();
                    const int it = (int)qslot[0];
                    __syncthreads();
                    if (it >= 576 + 288 + 576) break;
                    int ln_i = lane; asm volatile("" : "+v"(ln_i)); const int tid_i = wave * 64 + ln_i;
                    if (it < 576) rwkv_prep_item(a, l, it, lds, tid_i, ln_i, wave);
                    else if (it < 576 + 288) conv_item(a, l, it - 576, lds, tid_i, ln_i, wave);
                    else ssd_prep_item(a, l, it - 576 - 288, tid_i);
                }
            }
        }
        if (rep + 1 < REPS(1)) xcd_barrier(bar); }
        SEAM(pb + 1);
        for (int rep = 0; rep < REPS(2); ++rep) {
        if (IN(pb + 2)) { PH_LOCALS PH_IDS
            __syncthreads();
            if (bid < 128) { if (rep == 0 || PROBE_SUB == 0) rwkv_scan_fast(a, bid, lds, tid, lane, wave); }
            else if (bid < 224) { if (rep == 0 || PROBE_SUB == 1) ssd_scan_fast(a, bid - 128, lds, tid, lane, wave); }
        }
        if (rep + 1 < REPS(2)) xcd_barrier(bar); }
        SEAM(pb + 2);
        for (int rep = 0; rep < REPS(3); ++rep) {
        if (IN(pb + 3)) { PH_BG post_phase(kargs(), l, bid, G, wave0); }
        if (rep + 1 < REPS(3)) xcd_barrier(bar); }
        SEAM(pb + 3);
        for (int rep = 0; rep < REPS(4); ++rep) {
        if (IN(pb + 4)) { PH_LOCALS
            __syncthreads();
            pg8::Sched2 S; S.A0 = (const char*)(ws + OFF_ACAT); S.B0 = (const char*)(wl + WO_CAT); S.A1 = S.A0; S.B1 = S.B0; S.tstep = (size_t)256 * ACW * 2; S.ntk = ACW / 64;
            S.t0.init(lastl ? TLAT / 256 : TT / 256, DM / 256); S.t1.init(0, 0); S.G = G; S.c = bid;
            pg8::EpiChain E{(const bf16*)(ws + OFF_U) + UGATE, NU, (bf16*)(ws + OFF_M)};
            pg8::gemm_phase<pg8::EpiChain, pg8::Sched2, true, true>(lds, ACW, S, E, wave0);
        }
        if (rep + 1 < REPS(4)) xcd_barrier(bar); }
        SEAM(pb + 4);
        for (int rep = 0; rep < REPS(5); ++rep) {
        if (IN(pb + 5)) { PH_LOCALS
            __syncthreads();
            pg8::SchedSplit S; S.A = (const char*)(ws + OFF_M); S.B = (const char*)(wl + WO_O); S.tstep = (size_t)256 * DM * 2; S.ntk = DM / 64; S.tm.init(32, 8); S.nctx = lastl ? 0 : 256; S.G = G; S.c = bid;
            pg8::EpiF32 E{(float*)(ws + OFF_Y), (float*)(ws + OFF_YC)};
            pg8::gemm_phase<pg8::EpiF32, pg8::SchedSplit, true, true>(lds, DM, S, E, wave0);
        }
        if (rep + 1 < REPS(5)) xcd_barrier(bar); }
        SEAM(pb + 5);
        if (IN(pb + 6)) { PH_LOCALS norm_phase(a, 1, ng + 1 * DM, ng + 2 * DM, mv + 2 * DM, mv + 3 * DM, bid, G, wave0, lastl ? TLAT : TT, !lastl); }
        SEAM(pb + 6);
        for (int rep = 0; rep < REPS(7); ++rep) {
        if (IN(pb + 7)) { PH_LOCALS
            __syncthreads();
            pg8::Sched2 S; S.A0 = (const char*)Hb; S.B0 = (const char*)(wl + WO_UP); S.A1 = S.A0; S.B1 = S.B0; S.tstep = (size_t)256 * DM * 2; S.ntk = DM / 64;
            S.t0.init(lastl ? TLAT / 256 : TT / 256, DFF / 256); S.t1.init(0, 0); S.G = G; S.c = bid;
            pg8::EpiBf E{3, (bf16*)(ws + OFF_HB), nullptr};
            pg8::gemm_phase<pg8::EpiBf, pg8::Sched2, true, true>(lds, DM, S, E, wave0);
        }
        if (rep + 1 < REPS(7)) xcd_barrier(bar); }
        SEAM(pb + 7);
        for (int rep = 0; rep < REPS(8); ++rep) {
        if (IN(pb + 8)) { PH_LOCALS
            __syncthreads();
            pg8::SchedSplit S; S.A = (const char*)(ws + OFF_HB); S.B = (const char*)(wl + WO_DN); S.tstep = (size_t)256 * DFF * 2; S.ntk = DFF / 64; S.tm.init(32, 8); S.nctx = lastl ? 0 : 256; S.G = G; S.c = bid;
            pg8::EpiF32 E{(float*)(ws + OFF_Y), (float*)(ws + OFF_YC)};
            pg8::gemm_phase<pg8::EpiF32, pg8::SchedSplit, true, true>(lds, DFF, S, E, wave0);
        }
        if (rep + 1 < REPS(8)) xcd_barrier(bar); }
        SEAM(pb + 8);
        if (IN(pb + 9)) { PH_LOCALS
            if (!lastl) norm_phase(a, 1, ng + 3 * DM, ng + 4 * DM  , mv + 5 * DM, mv + 5 * 12288  , bid, G, wave0, TT, true);
            else norm_phase(a, 2, ng + 3 * DM, nullptr, mv + 5 * DM, nullptr, bid, G, wave0, TLAT);
        }
        SEAM(pb + 9);
    }
#undef IN
#undef SEAM
}

extern "C" void kernel_launch(void* const* d_in, const int* in_sizes, int n_in, void* d_out, int out_size, void* d_ws, size_t ws_size, hipStream_t stream) {
    static int grid = 0;
    if (grid == 0) {
        if (n_in != N_IN || out_size != TLAT * DM || ws_size < WS_END) { fprintf(stderr, "kernel_launch: unexpected shapes (n_in %d out %d ws %zu); nothing launched\n", n_in, out_size, ws_size); grid = -1; return; }
        int dev = 0, cus = 0;
        if (hipGetDevice(&dev) != hipSuccess || hipDeviceGetAttribute(&cus, hipDeviceAttributeMultiprocessorCount, dev) != hipSuccess) { grid = -1; return; }
        if (hipFuncSetAttribute((const void*)fwd, hipFuncAttributeMaxDynamicSharedMemorySize, LDS_BYTES) != hipSuccess) { fprintf(stderr, "kernel_launch: hipFuncSetAttribute failed\n"); grid = -1; return; }
        int per_cu = 0;
        if (hipOccupancyMaxActiveBlocksPerMultiprocessor(&per_cu, (const void*)fwd, NTHR, LDS_BYTES) != hipSuccess || per_cu < 1) fprintf(stderr, "kernel_launch: occupancy query says %d\n", per_cu);
        (void)hipGetLastError();
        grid = cus;
        if (grid < 232) { fprintf(stderr, "kernel_launch: %d CUs: this kernel's scan phase needs > 160 workgroups\n", grid); grid = -1; return; }
    }
    if (grid < 0) return;
    if (hipMemsetAsync((char*)d_ws + OFF_CTL, 0, CTL_BYTES, stream) != hipSuccess) return;
    Args a{};
    for (int i = 0; i < N_IN; ++i) a.in[i] = (const float*)d_in[i];
    a.out = (float*)d_out; a.ws = (unsigned char*)d_ws;
#if MK_ONE_LAUNCH
    a.ph_lo = 0; a.ph_hi = NPH;
    hipLaunchKernelGGL(fwd, dim3(grid), dim3(NTHR), LDS_BYTES, stream, a);
#else
    for (int p = 0; p < NPH; ++p) { a.ph_lo = p; a.ph_hi = p + 1; hipLaunchKernelGGL(fwd, dim3(grid), dim3(NTHR), LDS_BYTES, stream, a); }
#endif
}
```

```cpp
#include <hip/hip_runtime.h>
#include <cstdio>
#include <cstdint>
namespace pg8 {
#define PG8_LAS __attribute__((address_space(3)))
typedef unsigned short bf16_t;
typedef short bf16x8 __attribute__((ext_vector_type(8)));
typedef float f32x4 __attribute__((ext_vector_type(4)));
typedef unsigned u32x4 __attribute__((ext_vector_type(4)));
constexpr int BM = 256, BK = 64, HALF = 128, HTB = HALF * BK * 2  , STAGE_BYTES = 8 * HTB, NXCD = 8, WGM = 8;

__host__ __device__ __forceinline__ int lds_byte(int r, int c) { const int st = (r >> 4) * 2 + (c >> 5), rr = r & 15, cc = c & 31, ob = rr * 64 + cc * 2; return st * 1024 + (ob ^ (((ob >> 9) & 1) << 5)); }
__host__ __device__ __forceinline__ void stage_rc(int b, int& R, int& C) { const int st = b / 1024, sb = b % 1024, swz = sb ^ (((sb >> 9) & 1) << 5); R = (st >> 1) * 16 + swz / 64; C = (st & 1) * 32 + (swz % 64) / 2; }
__host__ __device__ __forceinline__ int perm32(int rho) { const int n = rho >> 4, i = rho & 15; return 8 * (i >> 2) + 4 * n + (i & 3); }

struct Unit { int pm, pn, kind; };
struct Gemm { const bf16_t* A; const bf16_t* Bt; int M, N, K; };

struct StaticOrder {
    int nM, nN, nwg, G, c;
    __host__ __device__ void init(int M, int N, int G_, int c_) { nM = M / BM; nN = N / BM; nwg = nM * nN; G = G_; c = c_; }
    __host__ __device__ bool next(int i, Unit& u) const {
        const long L = (long)i * G + c; if (L >= nwg) return false;
        int wgid = (int)L; { const int q = nwg / NXCD, r = nwg % NXCD, xcd = wgid % NXCD, off = wgid / NXCD; wgid = (xcd < r ? xcd * (q + 1) : r * (q + 1) + (xcd - r) * q) + off; }
        const int nig = WGM * nN, gid = wgid / nig, fm = gid * WGM, gsz = (nM - fm) < WGM ? (nM - fm) : WGM;
        u.pm = fm + ((wgid % nig) % gsz); u.pn = (wgid % nig) / gsz; return true;
    }
    __device__ __forceinline__ void a_ready(const Unit&) const {}
    __device__ __forceinline__ void done(const Unit&) const {}
};
__device__ __forceinline__ unsigned cvt_pk_bf16(float lo, float hi) { unsigned r; asm volatile("v_cvt_pk_bf16_f32 %0, %1, %2" : "=v"(r) : "v"(lo), "v"(hi)); return r; }
typedef float f32x2 __attribute__((ext_vector_type(2)));
template <class Epi, class Sched, bool ALIGN_EPI = false, bool SP2 = false>
__device__ __forceinline__ void gemm_phase(PG8_LAS unsigned char* lds, const int ldk  , const Sched& S, const Epi& E, const int wave_id) {
    unsigned z_ = 0u; asm volatile("" : "+v"(z_)); const int lane_ = (int)__builtin_amdgcn_mbcnt_hi(~0u, __builtin_amdgcn_mbcnt_lo(~0u, z_)); int wid_ = wave_id; asm volatile("" : "+s"(wid_)); const int wid = wid_, lane = lane_, tid = wid * 64 + lane, wr = wid >> 2, wc = wid & 3, fr = lane & 15, fq = lane >> 4;
    const int K = ldk; int nt;
    unsigned voffA[2], voffB[2];
#pragma unroll
    for (int i = 0; i < 2; ++i) { int R, C; stage_rc(tid * 16 + i * 8192, R, C); const int Rb = Epi::PERM ? ((R & ~31) + perm32(R & 31)) : R;
        voffA[i] = (unsigned)(R * K + C) * 2u; voffB[i] = (unsigned)(Rb * K + C) * 2u; }
    const size_t kstep = (size_t)(BK * 2);
    const size_t hstep = (size_t)HALF * K * 2;
    const unsigned ldsw = (unsigned)wid * 1024u;
    const int aoff = lds_byte(wr * 64 + fr, fq * 8), boff = lds_byte(wc * 32 + fr, fq * 8);
#define PG8_SA(b, h) (((b) * 2 + (h)) * HTB)
#define PG8_SB(b, h) ((4 + (b) * 2 + (h)) * HTB)
#define PG8_STAGE(bufoff, gbase, voff) do { _Pragma("unroll") for (int _i = 0; _i < 2; ++_i) \
        __builtin_amdgcn_global_load_lds((const unsigned*)((const char*)(gbase) + (voff)[_i]), (PG8_LAS unsigned*)(lds + (bufoff) + ldsw + _i * 8192), 16, 0, 0); } while (0)
#define PG8_LDA(dst, b, h) do { _Pragma("unroll") for (int m = 0; m < 4; ++m) _Pragma("unroll") for (int k = 0; k < 2; ++k) dst[m][k] = *(const PG8_LAS bf16x8*)(lds + PG8_SA(b, h) + aoff + m * 2048 + k * 1024); } while (0)
#define PG8_LDB(dst, b, h) do { _Pragma("unroll") for (int n = 0; n < 2; ++n) _Pragma("unroll") for (int k = 0; k < 2; ++k) dst[n][k] = *(const PG8_LAS bf16x8*)(lds + PG8_SB(b, h) + boff + n * 2048 + k * 1024); } while (0)
#define PG8_MMA(ai, bj, At, Bt) do { __builtin_amdgcn_s_setprio(1); _Pragma("unroll") for (int m = 0; m < 4; ++m) _Pragma("unroll") for (int n = 0; n < 2; ++n) _Pragma("unroll") for (int k = 0; k < 2; ++k) \
        acc[ai][bj][m][n] = __builtin_amdgcn_mfma_f32_16x16x32_bf16(Bt[n][k], At[m][k], acc[ai][bj][m][n], 0, 0, 0); __builtin_amdgcn_s_setprio(0); } while (0)
#define PG8_WAIT_V(n) asm volatile("s_waitcnt vmcnt(" #n ")" ::: "memory")
#define PG8_WAIT_L(n) asm volatile("s_waitcnt lgkmcnt(" #n ")" ::: "memory")
#define PG8_BAR __builtin_amdgcn_s_barrier()
#define PG8_SCHED __builtin_amdgcn_sched_barrier(0)
    Unit cur, nxt; int ui = 0;
    if (!S.next(0, cur)) return;
    f32x4 acc[2][2][4][2];
#pragma unroll
    for (int a = 0; a < 2; ++a)
#pragma unroll
        for (int b = 0; b < 2; ++b)
#pragma unroll
            for (int m = 0; m < 4; ++m)
#pragma unroll
                for (int n = 0; n < 2; ++n) acc[a][b][m][n] = (f32x4){0.f, 0.f, 0.f, 0.f};
    bf16x8 At[4][2], B0[2][2], B1[2][2];
    const char* cA = S.abase(cur); const char* cB = S.bbase(cur); nt = S.nt(cur);
    S.a_ready(cur);
    if constexpr (SP2) {
        PG8_STAGE(PG8_SB(0, 0), cB, voffB); PG8_STAGE(PG8_SB(0, 1), cB + hstep, voffB); PG8_STAGE(PG8_SA(0, 0), cA, voffA); PG8_STAGE(PG8_SA(0, 1), cA + hstep, voffA);
        if (wr == 1) PG8_BAR;
        PG8_WAIT_V(2); PG8_BAR;
        PG8_STAGE(PG8_SB(1, 0), cB + kstep, voffB); PG8_STAGE(PG8_SA(1, 0), cA + kstep, voffA); PG8_STAGE(PG8_SB(1, 1), cB + hstep + kstep, voffB);
        PG8_WAIT_V(6); PG8_BAR;
    } else {
        PG8_STAGE(PG8_SB(0, 0), cB, voffB); PG8_STAGE(PG8_SA(0, 0), cA, voffA); PG8_STAGE(PG8_SB(0, 1), cB + hstep, voffB); PG8_STAGE(PG8_SA(0, 1), cA + hstep, voffA);
        if (wr == 1) PG8_BAR;
        PG8_WAIT_V(4); PG8_BAR;
        PG8_STAGE(PG8_SB(1, 0), cB + kstep, voffB); PG8_STAGE(PG8_SA(1, 0), cA + kstep, voffA); PG8_STAGE(PG8_SB(1, 1), cB + hstep + kstep, voffB);
        PG8_WAIT_V(6); PG8_BAR;
    }
    for (;;) {
        const bool has_next = S.next(ui + 1, nxt);
        const char* nA = has_next ? S.abase(nxt) : cA; const char* nB = has_next ? S.bbase(nxt) : cB;
        for (int t = 0; t < nt; t += 2) {
            const bool last = (t == nt - 2);
            const char* a1 = cA + (size_t)(t + 1) * kstep;
            const char* a2 = last ? nA : cA + (size_t)(t + 2) * kstep; const char* b2 = last ? nB : cB + (size_t)(t + 2) * kstep;
            const char* a3 = a2 + kstep; const char* b3 = b2 + kstep;
            if (last && has_next) S.a_ready(nxt);
            if constexpr (Epi::HOOK) E.khook(acc, cur, t, wr, wc, fr, fq);
            if constexpr (SP2) {
            PG8_LDB(B0, 0, 0); PG8_LDB(B1, 0, 1); PG8_SCHED; PG8_LDA(At, 0, 0); PG8_STAGE(PG8_SA(1, 1), a1 + hstep, voffA);
            PG8_WAIT_V(8); PG8_WAIT_L(0); PG8_BAR; PG8_MMA(0, 0, At, B0); PG8_MMA(0, 1, At, B1); PG8_BAR; PG8_SCHED;
            PG8_LDA(At, 0, 1); PG8_STAGE(PG8_SB(0, 0), b2, voffB); PG8_STAGE(PG8_SB(0, 1), b2 + hstep, voffB); PG8_STAGE(PG8_SA(0, 0), a2, voffA);
            PG8_WAIT_V(8); PG8_WAIT_L(0); PG8_BAR; PG8_MMA(1, 0, At, B0); PG8_MMA(1, 1, At, B1); PG8_BAR; PG8_SCHED;
            PG8_LDB(B0, 1, 0); PG8_LDB(B1, 1, 1); PG8_SCHED; PG8_LDA(At, 1, 0); PG8_STAGE(PG8_SA(0, 1), a2 + hstep, voffA);
            PG8_WAIT_V(8); PG8_WAIT_L(0); PG8_BAR; PG8_MMA(0, 0, At, B0); PG8_MMA(0, 1, At, B1); PG8_BAR; PG8_SCHED;
            PG8_LDA(At, 1, 1); PG8_STAGE(PG8_SB(1, 0), b3, voffB); PG8_STAGE(PG8_SB(1, 1), b3 + hstep, voffB); PG8_STAGE(PG8_SA(1, 0), a3, voffA);
            PG8_WAIT_V(8); PG8_WAIT_L(0); PG8_BAR; PG8_MMA(1, 0, At, B0); PG8_MMA(1, 1, At, B1); PG8_BAR; PG8_SCHED;
            } else {
            PG8_LDB(B0, 0, 0); PG8_SCHED; PG8_LDA(At, 0, 0); PG8_STAGE(PG8_SA(1, 1), a1 + hstep, voffA);
            PG8_WAIT_L(8); PG8_BAR; PG8_WAIT_L(0); PG8_MMA(0, 0, At, B0); PG8_BAR; PG8_SCHED;
            PG8_LDB(B1, 0, 1); PG8_STAGE(PG8_SB(0, 0), b2, voffB);
            PG8_BAR; PG8_WAIT_L(0); PG8_MMA(0, 1, At, B1); PG8_BAR;
            PG8_LDA(At, 0, 1); PG8_STAGE(PG8_SA(0, 0), a2, voffA);
            PG8_BAR; PG8_WAIT_L(0); PG8_MMA(1, 0, At, B0); PG8_BAR; PG8_SCHED;
            PG8_STAGE(PG8_SB(0, 1), b2 + hstep, voffB);
            PG8_WAIT_V(6); PG8_BAR; PG8_MMA(1, 1, At, B1); PG8_BAR;
            PG8_LDB(B0, 1, 0); PG8_SCHED; PG8_LDA(At, 1, 0); PG8_STAGE(PG8_SA(0, 1), a2 + hstep, voffA);
            PG8_WAIT_L(8); PG8_BAR; PG8_WAIT_L(0); PG8_MMA(0, 0, At, B0); PG8_BAR; PG8_SCHED;
            PG8_LDB(B1, 1, 1); PG8_STAGE(PG8_SB(1, 0), b3, voffB);
            PG8_BAR; PG8_WAIT_L(0); PG8_MMA(0, 1, At, B1); PG8_BAR;
            PG8_LDA(At, 1, 1); PG8_STAGE(PG8_SA(1, 0), a3, voffA);
            PG8_BAR; PG8_WAIT_L(0); PG8_MMA(1, 0, At, B0); PG8_BAR; PG8_SCHED;
            PG8_STAGE(PG8_SB(1, 1), b3 + hstep, voffB);
            PG8_WAIT_V(6); PG8_BAR; PG8_MMA(1, 1, At, B1); PG8_BAR;
            }
        }
        if constexpr (ALIGN_EPI) { if (wr == 0) PG8_BAR; }
        if constexpr (!Epi::AFTER_DRAIN) { E(acc, cur, wr, wc, fr, fq); S.done(cur); }
        if (!has_next) break;
#pragma unroll
        for (int a = 0; a < 2; ++a)
#pragma unroll
            for (int b = 0; b < 2; ++b)
#pragma unroll
                for (int m = 0; m < 4; ++m)
#pragma unroll
                    for (int n = 0; n < 2; ++n) acc[a][b][m][n] = (f32x4){0.f, 0.f, 0.f, 0.f};
        cur = nxt; cA = nA; cB = nB; ++ui; nt = S.nt(cur);
        if constexpr (ALIGN_EPI) { if (wr == 1) PG8_BAR; }
    }
    PG8_WAIT_V(0);
    if constexpr (!ALIGN_EPI) { if (wr == 0) PG8_BAR; }
    PG8_BAR;
    if constexpr (Epi::AFTER_DRAIN) { E.fused(acc, cur, wr, wc, fr, fq, lds, wid, lane); S.done(cur); }
#undef PG8_SA
#undef PG8_SB
#undef PG8_STAGE
#undef PG8_LDA
#undef PG8_LDB
#undef PG8_MMA
#undef PG8_WAIT_V
#undef PG8_WAIT_L
#undef PG8_BAR
#undef PG8_SCHED
}
}

namespace pg8 {
__device__ __forceinline__ float sigm(float x) { return __builtin_amdgcn_rcpf(1.f + __expf(-x)); }
__device__ __forceinline__ f32x4 sigm4(f32x4 v) { return (f32x4){sigm(v[0]), sigm(v[1]), sigm(v[2]), sigm(v[3])}; }
__device__ __forceinline__ u32x4 pack8(f32x4 v0, f32x4 v1) { u32x4 w; w.x = cvt_pk_bf16(v0[0], v0[1]); w.y = cvt_pk_bf16(v0[2], v0[3]); w.z = cvt_pk_bf16(v1[0], v1[1]); w.w = cvt_pk_bf16(v1[2], v1[3]); return w; }
__device__ __forceinline__ float bflo(unsigned u) { return __uint_as_float(u << 16); }
__device__ __forceinline__ float bfhi(unsigned u) { return __uint_as_float(u & 0xffff0000u); }


struct TileMap {
    int nM, nN, nwg;
    __device__ __forceinline__ void init(int nM_, int nN_) { nM = nM_; nN = nN_; nwg = nM_ * nN_; }
    __device__ __forceinline__ void map(int L, int& pm, int& pn) const {
        int wgid = L; { const int q = nwg / NXCD, r = nwg % NXCD, xcd = wgid % NXCD, off = wgid / NXCD; wgid = (xcd < r ? xcd * (q + 1) : r * (q + 1) + (xcd - r) * q) + off; }
        const int nig = WGM * nN, gid = wgid / nig, fm = gid * WGM, gsz = (nM - fm) < WGM ? (nM - fm) : WGM;
        pm = fm + ((wgid % nig) % gsz); pn = (wgid % nig) / gsz;
    }
};
struct Sched2 {
    const char *A0, *B0, *A1, *B1; size_t tstep; int ntk; TileMap t0, t1; int G, c;
    int pn_off0 = 0, first = 0, limit = 0x7fffffff;
    __device__ __forceinline__ bool next(int i, Unit& u) const { const int L = first + i * G + c;
        if (L >= limit) return false;
        if (L < t0.nwg) { t0.map(L, u.pm, u.pn); u.pn += pn_off0; u.kind = 0; return true; }
        if (L - t0.nwg < t1.nwg) { t1.map(L - t0.nwg, u.pm, u.pn); u.kind = 1; return true; }
        return false; }
    __device__ __forceinline__ const char* abase(const Unit& u) const { return (u.kind ? A1 : A0) + (size_t)u.pm * tstep; }
    __device__ __forceinline__ const char* bbase(const Unit& u) const { return (u.kind ? B1 : B0) + (size_t)u.pn * tstep; }
    __device__ __forceinline__ int nt(const Unit&) const { return ntk; }
    __device__ __forceinline__ void a_ready(const Unit&) const {}
    __device__ __forceinline__ void done(const Unit&) const {}
};
struct SchedSplit {
    const char *A, *B; size_t tstep; int ntk; TileMap tm; int nctx, G, c;
    __device__ __forceinline__ bool next(int i, Unit& u) const { const int L = i * G + c;
        if (L < 256) { tm.map(L, u.pm, u.pn); u.kind = 0; return true; }
        const int e = L - 256; if (e < nctx) { const int tile = e & 31; u.pm = 32 + (tile >> 3); u.pn = tile & 7; u.kind = 1 + (e >> 5); return true; }
        return false; }
    __device__ __forceinline__ const char* abase(const Unit& u) const { return A + (size_t)u.pm * tstep + (u.kind ? (size_t)(u.kind - 1) * (ntk / 8) * 128 : 0); }
    __device__ __forceinline__ const char* bbase(const Unit& u) const { return B + (size_t)u.pn * tstep + (u.kind ? (size_t)(u.kind - 1) * (ntk / 8) * 128 : 0); }
    __device__ __forceinline__ int nt(const Unit& u) const { return u.kind ? ntk / 8 : ntk; }
    __device__ __forceinline__ void a_ready(const Unit&) const {}
    __device__ __forceinline__ void done(const Unit&) const {}
};
struct EpiInproj {
    static constexpr bool PERM = true, AFTER_DRAIN = false, HOOK = false;
    bf16_t* U; float* MISC; int ldu;
    __device__ __forceinline__ void operator()(const f32x4 (&acc)[2][2][4][2], const Unit& u, int wr, int wc, int fr, int fq) const {
        const int row0 = u.pm * BM + wr * 64 + fr, cl = wc * 32 + 8 * fq;
        if (u.pn == 16 || u.pn == 17) {
#pragma unroll
            for (int ai = 0; ai < 2; ++ai)
#pragma unroll
                for (int m = 0; m < 4; ++m) { float* rowp = MISC + (size_t)(row0 + ai * HALF + m * 16) * 512 + (u.pn - 16) * BM + cl;
#pragma unroll
                    for (int bj = 0; bj < 2; ++bj) { *(f32x4*)(rowp + bj * HALF) = acc[ai][bj][m][0]; *(f32x4*)(rowp + bj * HALF + 4) = acc[ai][bj][m][1]; } }
        } else {
            const bool sg = u.pn >= 22;
#pragma unroll
            for (int ai = 0; ai < 2; ++ai)
#pragma unroll
                for (int m = 0; m < 4; ++m) { bf16_t* rowp = U + (size_t)(row0 + ai * HALF + m * 16) * ldu + u.pn * BM + cl;
#pragma unroll
                    for (int bj = 0; bj < 2; ++bj) { f32x4 v0 = acc[ai][bj][m][0], v1 = acc[ai][bj][m][1];
                        if (sg) { v0 = sigm4(v0); v1 = sigm4(v1); }
                        *(u32x4*)(rowp + bj * HALF) = pack8(v0, v1); } }
        }
    }
};
struct EpiBf {
    static constexpr bool PERM = true, AFTER_DRAIN = false, HOOK = false;
    int kind; bf16_t* O0; bf16_t* O1;
    __device__ __forceinline__ void operator()(const f32x4 (&acc)[2][2][4][2], const Unit& u, int wr, int wc, int fr, int fq) const {
        bf16_t* base; size_t pitch;
        if (kind == 0) {
            const int half = u.pm >> 1, chb = (u.pm & 1) * 256;
            if (u.pn < 32) { const int b = u.pn >> 3, l0 = (u.pn & 7) * 256; pitch = 4096; base = O0 + ((size_t)(b * 512 + chb) * 2 + half) * 2048 + l0; }
            else { const int b = u.pn - 32; pitch = 512; base = O1 + ((size_t)(b * 512 + chb) * 2 + half) * 256; }
        } else if (kind == 1) { const int b = u.pn >> 1; pitch = 2304; base = O0 + (size_t)(b * 2048 + u.pm * 256) * 2304 + 1280 + (u.pn & 1) * 256; }
        else if (kind == 2) { const int b = u.pn >> 1; pitch = 2304; base = O0 + (size_t)(8192 + b * 256) * 2304 + 1280 + (u.pn & 1) * 256; }
        else { pitch = 8192; base = O0 + (size_t)(u.pm * 256) * 8192 + u.pn * 256; }
        const int r0 = wr * 64 + fr, cl = wc * 32 + 8 * fq;
#pragma unroll
        for (int ai = 0; ai < 2; ++ai)
#pragma unroll
            for (int m = 0; m < 4; ++m) { bf16_t* rowp = base + (size_t)(r0 + ai * HALF + m * 16) * pitch + cl;
#pragma unroll
                for (int bj = 0; bj < 2; ++bj) { f32x4 v0 = acc[ai][bj][m][0], v1 = acc[ai][bj][m][1];
                    if (kind == 3) { v0 = __builtin_elementwise_max(v0, (f32x4){0.f, 0.f, 0.f, 0.f}); v1 = __builtin_elementwise_max(v1, (f32x4){0.f, 0.f, 0.f, 0.f}); v0 = v0 * v0; v1 = v1 * v1; }
                    *(u32x4*)(rowp + bj * HALF) = pack8(v0, v1); } }
    }
};
struct EpiChain {
    static constexpr bool PERM = true, AFTER_DRAIN = false, HOOK = true;
    const bf16_t* G; int ldg; bf16_t* Mo;
    __device__ __forceinline__ void khook(f32x4 (&acc)[2][2][4][2], const Unit& u, int t, int wr, int wc, int fr, int fq) const {
        if (t != 8 && t != 20 && t != 28) return;
        const int i = (t == 8) ? 0 : (t == 20 ? 1 : 2);
        int row0 = u.pm * BM + wr * 64 + fr; const int col0 = u.pn * BM + wc * 32 + 8 * fq + i * 2048;
        asm volatile("" : "+v"(row0));
#pragma unroll
        for (int ai = 0; ai < 2; ++ai)
#pragma unroll
            for (int m = 0; m < 4; ++m) { const bf16_t* gp = G + (size_t)(row0 + ai * HALF + m * 16) * ldg + col0;
#pragma unroll
                for (int bj = 0; bj < 2; ++bj) { const u32x4 g = *(const u32x4*)(gp + bj * HALF), h = *(const u32x4*)(gp + bj * HALF + 2048);
                    const unsigned gw[4] = {g.x, g.y, g.z, g.w}, hw[4] = {h.x, h.y, h.z, h.w};
#pragma unroll
                    for (int e2 = 0; e2 < 4; ++e2) { const float r0 = fmaxf(bflo(gw[e2]), 1e-6f) * __builtin_amdgcn_rcpf(fmaxf(bflo(hw[e2]), 1e-6f)), r1 = fmaxf(bfhi(gw[e2]), 1e-6f) * __builtin_amdgcn_rcpf(fmaxf(bfhi(hw[e2]), 1e-6f));
                        acc[ai][bj][m][e2 >> 1][(e2 & 1) * 2] *= r0; acc[ai][bj][m][e2 >> 1][(e2 & 1) * 2 + 1] *= r1; } }
                asm volatile("" ::: "memory"); }
    }
    __device__ __forceinline__ void operator()(const f32x4 (&acc)[2][2][4][2], const Unit& u, int wr, int wc, int fr, int fq) const {
        const int row0 = u.pm * BM + wr * 64 + fr, col0 = u.pn * BM + wc * 32 + 8 * fq;
#pragma unroll
        for (int ai = 0; ai < 2; ++ai)
#pragma unroll
            for (int m = 0; m < 4; ++m) { const size_t row = (size_t)(row0 + ai * HALF + m * 16);
#pragma unroll
                for (int bj = 0; bj < 2; ++bj) { const int col = col0 + bj * HALF;
                    const u32x4 g = *(const u32x4*)(G + row * ldg + col + 3 * 2048);
                    const f32x4 v0 = acc[ai][bj][m][0] * (f32x4){fmaxf(bflo(g.x), 1e-6f), fmaxf(bfhi(g.x), 1e-6f), fmaxf(bflo(g.y), 1e-6f), fmaxf(bfhi(g.y), 1e-6f)};
                    const f32x4 v1 = acc[ai][bj][m][1] * (f32x4){fmaxf(bflo(g.z), 1e-6f), fmaxf(bfhi(g.z), 1e-6f), fmaxf(bflo(g.w), 1e-6f), fmaxf(bfhi(g.w), 1e-6f)};
                    *(u32x4*)(Mo + row * 2048 + col) = pack8(v0, v1); } }
    }
};
struct EpiF32 {
    static constexpr bool PERM = false, AFTER_DRAIN = false, HOOK = false;
    float* C; float* YC;
    __device__ __forceinline__ void operator()(const f32x4 (&acc)[2][2][4][2], const Unit& u, int wr, int wc, int fr, int fq) const {
        const int row0 = u.pm * BM + wr * 64 + fr, col0 = u.pn * BM + wc * 32 + 4 * fq;
        float* base = u.kind ? (YC + (size_t)(u.kind - 1) * 1024 * 2048 + (size_t)(row0 - 8192) * 2048) : (C + (size_t)row0 * 2048);
#pragma unroll
        for (int ai = 0; ai < 2; ++ai)
#pragma unroll
            for (int m = 0; m < 4; ++m) { float* rowp = base + (size_t)(ai * HALF + m * 16) * 2048 + col0;
#pragma unroll
                for (int bj = 0; bj < 2; ++bj)
#pragma unroll
                    for (int n = 0; n < 2; ++n) *(f32x4*)(rowp + bj * HALF + n * 16) = acc[ai][bj][m][n]; }
    }
};
struct EpiIn2 {
    static constexpr bool PERM = true, AFTER_DRAIN = false, HOOK = false;
    EpiInproj e0; EpiBf e1;
    __device__ __forceinline__ void operator()(const f32x4 (&acc)[2][2][4][2], const Unit& u, int wr, int wc, int fr, int fq) const { if (u.kind == 0) e0(acc, u, wr, wc, fr, fq); else e1(acc, u, wr, wc, fr, fq); }
};
}

#define GAS __attribute__((address_space(1)))
#define LAS __attribute__((address_space(3)))
typedef unsigned short bf16;
typedef unsigned v4u __attribute__((ext_vector_type(4)));
typedef unsigned v2u __attribute__((ext_vector_type(2)));
typedef float f32x4 __attribute__((ext_vector_type(4)));
typedef float f32x2 __attribute__((ext_vector_type(2)));
constexpr int NWAVES = 8, NTHR = 512;
constexpr int DM = 2048, NBATCH = 4, LSEQ = 2048, LCTX = 256, DEPTH = 4;
constexpr int TLAT = NBATCH * LSEQ, TCTX = NBATCH * LCTX, TT = TLAT + TCTX;
constexpr int IN_DIM = 14168, DFF = 8192;
constexpr int NU = 13824;
constexpr int UZ = 0, UXBC = 768, URKV = 2560, UMISC = 4096, UCONV = 4608, UGATE = 5632;
constexpr int S_RKV = 2584, S_DT = 2560, S_WF = 4120, S_CONV = 4440, S_FFT = 5464, S_GATE = 5976;
constexpr int RJ = LCTX + LSEQ;
enum { I_X = 0, I_C, I_CTX, I_CCTX, I_MODW, I_MODB, I_NORMG, I_WIN, I_CONVW, I_CONVB, I_CLNG, I_CLNB, I_CONVOUT, I_SCW, I_SCB, I_SALOG, I_SDTB, I_SD, I_SNG, I_SOUT,
       I_FOUT, I_RMU, I_RW0, I_RW2, I_RA0, I_RA2, I_RG2, I_RKK, I_RKA, I_RRK, I_RLNG, I_RLNB, I_ROUT, I_WO, I_UP, I_DOWN, N_IN };
constexpr size_t MiB = 1u << 20;
constexpr size_t OFF_CTL = 0, CTL_BYTES = 1 * MiB;
constexpr size_t OFF_MODV = 1 * MiB;
constexpr size_t OFF_DFTL = 2 * MiB;
constexpr size_t OFF_DFTC = 18 * MiB;
constexpr size_t OFF_W = 20 * MiB, W_LAYER = 139 * MiB;
constexpr size_t WO_IN = 0, WO_FFT = 54 * MiB, WO_CAT = 58 * MiB  , WO_O = 67 * MiB, WO_UP = 75 * MiB, WO_DN = 107 * MiB;
constexpr size_t OFF_X = 576 * MiB;
constexpr size_t OFF_H = 648 * MiB;
constexpr size_t OFF_U = 684 * MiB;
constexpr size_t OFF_HB = OFF_U;
constexpr size_t OFF_MISC = 927 * MiB;
constexpr size_t OFF_VTL = 945 * MiB;
constexpr size_t OFF_VTC = 961 * MiB;
constexpr size_t OFF_ACAT = 963 * MiB;
constexpr int AC_CONV = 0, AC_SSD = 512, AC_FFT = 1280, AC_RWKV = 1792, ACW = 2304;
constexpr size_t OFF_XBC = 1004 * MiB;
constexpr size_t OFF_DTA = 1036 * MiB;
constexpr size_t OFF_YSSD = 1038 * MiB;
constexpr size_t OFF_RW = 1092 * MiB, RW_ARR = 18 * MiB;
constexpr size_t OFF_RSC = 1254 * MiB;
constexpr size_t OFF_YRW = 1255 * MiB;
constexpr size_t OFF_MBUF = 1291 * MiB;
constexpr size_t OFF_M = 1363 * MiB;
constexpr size_t OFF_Y = 1399 * MiB;
constexpr size_t OFF_WLT = 1471 * MiB;
constexpr size_t OFF_YC = 1473 * MiB;
constexpr size_t WS_END = 1537 * MiB;
constexpr int CW_Q = 8192;
constexpr int CW_BAR = 4096;
constexpr int RING_BYTES = 131072, MISC_OFF = RING_BYTES + 320, LDS_BYTES = 147456;

__device__ __forceinline__ float bf2f(unsigned short b) { return __uint_as_float((unsigned)b << 16); }
__device__ __forceinline__ float bflo(unsigned u) { return __uint_as_float(u << 16); }
__device__ __forceinline__ float bfhi(unsigned u) { return __uint_as_float(u & 0xffff0000u); }
__device__ __forceinline__ unsigned f2bf(float f) { unsigned u = __builtin_bit_cast(unsigned, f); return (u + 0x7fffu + ((u >> 16) & 1u)) >> 16; }
__device__ __forceinline__ unsigned pk2(float lo, float hi) { return f2bf(lo) | (f2bf(hi) << 16); }
__device__ __forceinline__ float sigmoidf_(float x) { return 1.f / (1.f + __expf(-x)); }
__device__ __forceinline__ float siluf_(float x) { return x / (1.f + __expf(-x)); }
__device__ __forceinline__ float softplusf_(float x) { return fmaxf(x, 0.f) + log1pf(__expf(-fabsf(x))); }
template <int CTRL> __device__ __forceinline__ float dpp_add(float x) { return x + __int_as_float(__builtin_amdgcn_update_dpp(0, __float_as_int(x), CTRL, 0xf, 0xf, true)); }
__device__ __forceinline__ float sum8(float x) { x = dpp_add<0xB1>(x); x = dpp_add<0x4E>(x); x = dpp_add<0x141>(x); return x; }
__device__ __forceinline__ float row16_sum(float x) { x = sum8(x); x = dpp_add<0x140>(x); return x; }
__device__ __forceinline__ float wave_sum(float v) {
    const float r = row16_sum(v);
    return (__int_as_float(__builtin_amdgcn_readlane(__float_as_int(r), 0)) + __int_as_float(__builtin_amdgcn_readlane(__float_as_int(r), 16))) +
           (__int_as_float(__builtin_amdgcn_readlane(__float_as_int(r), 32)) + __int_as_float(__builtin_amdgcn_readlane(__float_as_int(r), 48)));
}
#define LDS_WAIT() asm volatile("s_waitcnt lgkmcnt(0)" ::: "memory")

struct Args { const float* in[N_IN]; float* out; unsigned char* ws; int ph_lo, ph_hi; };
typedef const __attribute__((address_space(4))) Args* KArgs;
__device__ __forceinline__ KArgs kargs() { KArgs p = (KArgs)__builtin_amdgcn_kernarg_segment_ptr(); asm volatile("" : "+s"(p)); return p; }
#define PH_IDS unsigned z_ = 0u; asm volatile("" : "+v"(z_)); const int lane_ = (int)__builtin_amdgcn_mbcnt_hi(~0u, __builtin_amdgcn_mbcnt_lo(~0u, z_)); int wv_ = wave0; asm volatile("" : "+s"(wv_)); const int lane = lane_, wave = wv_, tid = wv_ * 64 + lane_; (void)lane; (void)wave; (void)tid;

__device__ __forceinline__ int inmap(int n) {
    if (n < 2560) return n;
    if (n < 4096) return S_RKV + (n - 2560);
    if (n < 4608) { const int m = n - 4096; if (m < 24) return S_DT + m; if (m < 64) return -1; if (m < 384) return S_WF + (m - 64); return -1; }
    if (n < 5632) return S_CONV + (n - 4608);
    return S_GATE + (n - 5632);
}
__device__ __forceinline__ int rwkv_tok(int b, int j) { if (j < LCTX) return TLAT + b * LCTX + j; const int s = j - LCTX; return b * LSEQ + (s & 31) * 64 + (s >> 5); }

__device__ __forceinline__ void transpose_item(const float* W, int ldw, int Nsrc, bf16* WT, int k0, int n0, bool mapped, LAS float* scr, int lane, int koff = 0) {
    const int nn = lane & 31; const int sc = mapped ? inmap(n0 + nn) : (n0 + nn);
    float v[32];
#pragma unroll
    for (int i = 0; i < 32; ++i) { const int kk = 2 * i + (lane >> 5); v[i] = (sc >= 0) ? W[(size_t)(k0 + kk) * Nsrc + sc] : 0.f; }
#pragma unroll
    for (int i = 0; i < 32; ++i) { const int kk = 2 * i + (lane >> 5); scr[kk * 33 + nn] = v[i]; }
    LDS_WAIT();
    const int c = lane & 7;
#pragma unroll
    for (int j = 0; j < 4; ++j) { const int n = (lane >> 3) + 8 * j; const LAS float* s = scr + (8 * c) * 33 + n;
        v4u o; o.x = pk2(s[0 * 33], s[1 * 33]); o.y = pk2(s[2 * 33], s[3 * 33]); o.z = pk2(s[4 * 33], s[5 * 33]); o.w = pk2(s[6 * 33], s[7 * 33]);
        *(v4u*)(WT + (size_t)(n0 + n) * ldw + koff + k0 + 8 * c) = o; }
    LDS_WAIT();
}
constexpr int IT_IN = 32 * (NU / 32), IT_CO = 8 * 64, IT_SO = 12 * 64, IT_FO = 8 * 64, IT_RO = 8 * 64, IT_O = 32 * 64, IT_UP = 32 * 256, IT_DN = 128 * 64;
constexpr int IT_LAYER = IT_IN + IT_CO + IT_SO + IT_FO + IT_RO + IT_O + IT_UP + IT_DN;

__device__ __forceinline__ void p0_prologue(KArgs a, LAS unsigned char* lds, int bid, int G, const int wave0) {
    PH_IDS
    unsigned char* ws = a->ws;
    {
        LAS float* sc = (LAS float*)lds;
        LAS float* part = (LAS float*)(lds + 40960);
        for (int i = tid; i < 5 * DM; i += NTHR) { const float v = (i < 4 * DM) ? a->in[I_C][i] : a->in[I_CCTX][i - 4 * DM]; sc[i] = siluf_(v); }
        __syncthreads();
        float* MODV = (float*)(ws + OFF_MODV);
        for (int it = bid; it < DEPTH * 192; it += G) {
            const int l = it / 192, j = (it % 192) * 64 + lane;
            const float* wp = a->in[I_MODW] + (size_t)l * DM * 12288 + (size_t)(wave * 256) * 12288 + j;
            float acc[5] = {0.f, 0.f, 0.f, 0.f, 0.f};
#pragma unroll 1
            for (int k0 = 0; k0 < 256; k0 += 32) { float w[32];
#pragma unroll
                for (int k = 0; k < 32; ++k) w[k] = wp[(size_t)(k0 + k) * 12288];
#pragma unroll
                for (int k = 0; k < 32; ++k)
#pragma unroll
                    for (int r = 0; r < 5; ++r) acc[r] += sc[r * DM + wave * 256 + k0 + k] * w[k]; }
#pragma unroll
            for (int r = 0; r < 5; ++r) part[(wave * 5 + r) * 64 + lane] = acc[r];
            __syncthreads();
            if (tid < 320) { const int r = tid >> 6, jj = tid & 63; float s = 0.f;
#pragma unroll
                for (int w = 0; w < 8; ++w) s += part[(w * 5 + r) * 64 + jj];
                const int jo = (it % 192) * 64 + jj; MODV[((size_t)l * 5 + r) * 12288 + jo] = s + a->in[I_MODB][l * 12288 + jo]; }
            __syncthreads();
        }
    }
    {
        LAS float* wt = (LAS float*)lds;
        LAS float* ctab = (LAS float*)(lds + 32768);
        LAS float* scr = (LAS float*)(lds + 32768 + 512 + wave * 8448);
        __syncthreads();
        if (tid < 128) ctab[tid] = cospif((float)tid * (1.f / 64.f));
        for (int it = bid; it < DEPTH * 32 * 4; it += G) {
            const int l = it / 128, kb = (it % 128) / 4, g = it % 4, k0 = kb * 64;
            __syncthreads();
            for (int i = tid; i < 64 * 32; i += NTHR) { const int kk = i >> 5, c4 = i & 31;
                *(LAS f32x4*)(wt + kk * 128 + c4 * 4) = *(const f32x4*)(a->in[I_WIN] + ((size_t)l * DM + k0 + kk) * IN_DIM + S_FFT + g * 128 + c4 * 4); }
            __syncthreads();
            const int half = wave >> 2, cp = (wave & 3) * 32 + (lane & 31), n0 = half * 512 + g * 128 + (wave & 3) * 32;
#pragma unroll 1
            for (int i = 0; i < 32; ++i) { const int kk = 2 * i + (lane >> 5); float s = 0.f;
#pragma unroll 8
                for (int c = 0; c < 128; ++c) s += wt[kk * 128 + c] * ctab[(c * cp - 32 * half) & 127];
                scr[kk * 33 + (lane & 31)] = s; }
            LDS_WAIT();
            bf16* WT = (bf16*)(ws + OFF_W + (size_t)l * W_LAYER + WO_FFT);
            const int c = lane & 7;
#pragma unroll
            for (int j = 0; j < 4; ++j) { const int n = (lane >> 3) + 8 * j; const LAS float* s = scr + (8 * c) * 33 + n;
                v4u o; o.x = pk2(s[0 * 33], s[1 * 33]); o.y = pk2(s[2 * 33], s[3 * 33]); o.z = pk2(s[4 * 33], s[5 * 33]); o.w = pk2(s[6 * 33], s[7 * 33]);
                *(v4u*)(WT + (size_t)(n0 + n) * DM + k0 + 8 * c) = o; }
            LDS_WAIT();
        }
        __syncthreads();
    }
    const int gw = bid * NWAVES + wave, NGW = G * NWAVES;
    {
        LAS float* scr = (LAS float*)(lds + wave * 8448);
        for (int it = gw; it < DEPTH * IT_LAYER; it += NGW) {
            const int l = it / IT_LAYER; int r = it % IT_LAYER; unsigned char* wl = ws + OFF_W + (size_t)l * W_LAYER;
            if (r < IT_IN) { const int kb = r / (NU / 32), nb = r % (NU / 32); transpose_item(a->in[I_WIN] + (size_t)l * DM * IN_DIM, DM, IN_DIM, (bf16*)(wl + WO_IN), kb * 64, nb * 32, true, scr, lane); continue; } r -= IT_IN;
            if (r < IT_CO) { transpose_item(a->in[I_CONVOUT] + (size_t)l * 512 * DM, ACW, DM, (bf16*)(wl + WO_CAT), (r / 64) * 64, (r % 64) * 32, false, scr, lane, AC_CONV); continue; } r -= IT_CO;
            if (r < IT_SO) { transpose_item(a->in[I_SOUT] + (size_t)l * 768 * DM, ACW, DM, (bf16*)(wl + WO_CAT), (r / 64) * 64, (r % 64) * 32, false, scr, lane, AC_SSD); continue; } r -= IT_SO;
            if (r < IT_FO) { transpose_item(a->in[I_FOUT] + (size_t)l * 512 * DM, ACW, DM, (bf16*)(wl + WO_CAT), (r / 64) * 64, (r % 64) * 32, false, scr, lane, AC_FFT); continue; } r -= IT_FO;
            if (r < IT_RO) { transpose_item(a->in[I_ROUT] + (size_t)l * 512 * DM, ACW, DM, (bf16*)(wl + WO_CAT), (r / 64) * 64, (r % 64) * 32, false, scr, lane, AC_RWKV); continue; } r -= IT_RO;
            if (r < IT_O) { transpose_item(a->in[I_WO] + (size_t)l * DM * DM, DM, DM, (bf16*)(wl + WO_O), (r / 64) * 64, (r % 64) * 32, false, scr, lane); continue; } r -= IT_O;
            if (r < IT_UP) { transpose_item(a->in[I_UP] + (size_t)l * DM * DFF, DM, DFF, (bf16*)(wl + WO_UP), (r / 256) * 64, (r % 256) * 32, false, scr, lane); continue; } r -= IT_UP;
            transpose_item(a->in[I_DOWN] + (size_t)l * DFF * DM, DFF, DM, (bf16*)(wl + WO_DN), (r / 64) * 64, (r % 64) * 32, false, scr, lane);
        }
    }
    {
        const int gt = bid * NTHR + tid, NGT = G * NTHR;
        bf16* FL = (bf16*)(ws + OFF_DFTL); bf16* FC = (bf16*)(ws + OFF_DFTC);
        { bf16* WLT = (bf16*)(ws + OFF_WLT);
          for (int i = gt; i < DEPTH * 512 * 320; i += NGT) { const int l = i / (512 * 320), c = (i / 320) % 512, j = i % 320; float v;
              if (j < 64) v = a->in[I_RW2][((size_t)(l * 2 + 0) * 64 + j) * 512 + c]; else if (j < 128) v = a->in[I_RW2][((size_t)(l * 2 + 1) * 64 + (j - 64)) * 512 + c];
              else if (j < 192) v = a->in[I_RA2][((size_t)l * 64 + (j - 128)) * 512 + c]; else v = a->in[I_RG2][((size_t)l * 128 + (j - 192)) * 512 + c];
              WLT[i] = (bf16)f2bf(v); } }
        for (int i = gt; i < 2048 * 512; i += NGT) { const int lp = i >> 9, k8 = (i & 511) * 8; unsigned o[4];
#pragma unroll
            for (int e = 0; e < 4; ++e) { float v[2];
#pragma unroll
                for (int q = 0; q < 2; ++q) { const int k = k8 + 2 * e + q; const int m = (lp * (k & 2047)) & 2047; float sn, cs; sincospif((float)m * (1.f / 1024.f), &sn, &cs); v[q] = (k < 2048 ? cs : -sn) * (1.f / 512.f); }
                o[e] = pk2(v[0], v[1]); }
            *(v4u*)(FL + (size_t)lp * 4096 + k8) = (v4u){o[0], o[1], o[2], o[3]}; }
        for (int i = gt; i < 256 * 64; i += NGT) { const int lp = i >> 6, k8 = (i & 63) * 8; unsigned o[4];
#pragma unroll
            for (int e = 0; e < 4; ++e) { float v[2];
#pragma unroll
                for (int q = 0; q < 2; ++q) { const int k = k8 + 2 * e + q; const int m = (lp * (k & 255)) & 255; float sn, cs; sincospif((float)m * (1.f / 128.f), &sn, &cs); v[q] = (k < 256 ? cs : -sn) * 0.005524271728f; }
                o[e] = pk2(v[0], v[1]); }
            *(v4u*)(FC + (size_t)lp * 512 + k8) = (v4u){o[0], o[1], o[2], o[3]}; }
        f32x4* X4 = (f32x4*)(ws + OFF_X); const f32x4* x4 = (const f32x4*)a->in[I_X]; const f32x4* c4 = (const f32x4*)a->in[I_CTX];
        for (int i = gt; i < TT * (DM / 4); i += NGT) X4[i] = (i < TLAT * (DM / 4)) ? x4[i] : c4[i - TLAT * (DM / 4)];
    }
}

__device__ __forceinline__ void norm_phase(KArgs a, int mode, const float* gY, const float* gH, const float* modY  , const float* modH  ,
                                           int bid, int G, const int wave0, int nrows, bool split = false  ) {
    PH_IDS
    unsigned char* ws = a->ws; const int gw = bid * NWAVES + wave, NGW = G * NWAVES;
    float* X = (float*)(ws + OFF_X); const float* Y = (const float*)(ws + OFF_Y); bf16* H = (bf16*)(ws + OFF_H);
    for (int row = gw; row < nrows; row += NGW) {
        const int mr = row < TLAT ? (row >> 11) : 4;
        f32x4 x[8];
        const f32x4* xr = (const f32x4*)(X + (size_t)row * DM) + lane;
#pragma unroll
        for (int j = 0; j < 8; ++j) x[j] = xr[64 * j];
        if (mode != 0) {
            const f32x4* yr = (const f32x4*)(Y + (size_t)row * DM) + lane; f32x4 y[8]; float ss = 0.f;
            if (split && row >= TLAT) { const f32x4* yc = (const f32x4*)((const float*)(ws + OFF_YC) + (size_t)(row - TLAT) * DM) + lane;
#pragma unroll
                for (int j = 0; j < 8; ++j) { f32x4 t = yc[64 * j];
#pragma unroll
                    for (int sl = 1; sl < 8; ++sl) t += yc[(size_t)sl * 1024 * 512 + 64 * j];
                    y[j] = t; } }
            else {
#pragma unroll
                for (int j = 0; j < 8; ++j) y[j] = yr[64 * j]; }
#pragma unroll
            for (int j = 0; j < 8; ++j) { ss += (y[j].x * y[j].x + y[j].y * y[j].y) + (y[j].z * y[j].z + y[j].w * y[j].w); }
            const float r = rsqrtf(wave_sum(ss) * (1.f / DM) + 1e-6f);
            const f32x4* gp = (const f32x4*)gY + lane; const f32x4* gt = (const f32x4*)(modY + (size_t)mr * 12288) + lane;
#pragma unroll
            for (int j = 0; j < 8; ++j) x[j] += gt[64 * j] * (y[j] * r * gp[64 * j]);
            if (mode == 1) { f32x4* xw = (f32x4*)(X + (size_t)row * DM) + lane;
#pragma unroll
                for (int j = 0; j < 8; ++j) xw[64 * j] = x[j]; }
            else { f32x4* ow = (f32x4*)(a->out + (size_t)row * DM) + lane;
#pragma unroll
                for (int j = 0; j < 8; ++j) ow[64 * j] = x[j]; }
        }
        if (mode != 2) {
            float ss = 0.f;
#pragma unroll
            for (int j = 0; j < 8; ++j) ss += (x[j].x * x[j].x + x[j].y * x[j].y) + (x[j].z * x[j].z + x[j].w * x[j].w);
            const float r = rsqrtf(wave_sum(ss) * (1.f / DM) + 1e-6f);
            const f32x4* gp = (const f32x4*)gH + lane; const f32x4* sh = (const f32x4*)(modH + (size_t)mr * 12288) + lane; const f32x4* sc = sh + 512;
            v2u* hw = (v2u*)(H + (size_t)row * DM) + lane;
#pragma unroll
            for (int j = 0; j < 8; ++j) { const f32x4 h = (x[j] * r * gp[64 * j]) * (sc[64 * j] + 1.f) + sh[64 * j]; hw[64 * j] = (v2u){pk2(h.x, h.y), pk2(h.z, h.w)}; }
        }
    }
}
#define XB_TMO      128
#define XB_XCNT(j)  (256  + 64 * (j))
#define XB_XSUB(j)  (1280 + 64 * (j))
#define XB_XGEN(j)  (2304 + 64 * (j))
#define XB_TOP      3328
#define XB_TOPGEN   3392
#define XCD_BAR_WORDS 3456
#define XB_SPIN_CAP (1u << 18)

__device__ __forceinline__ unsigned xb_ld(unsigned* p)              { return __hip_atomic_load(p, __ATOMIC_RELAXED, __HIP_MEMORY_SCOPE_AGENT); }
__device__ __forceinline__ unsigned xb_add(unsigned* p, unsigned v) { return __hip_atomic_fetch_add(p, v, __ATOMIC_RELAXED, __HIP_MEMORY_SCOPE_AGENT); }
__device__ __forceinline__ unsigned xb_xcc_id() { return (unsigned)__builtin_amdgcn_s_getreg((3 << 11) | 20) & 0xFu; }
#define XB_SPIN(cond, bar) do { unsigned _sp = 0; while (cond) { __builtin_amdgcn_s_sleep(1); \
    if ((++_sp & 255u) == 0u) { if (xb_ld(&(bar)[XB_TMO])) break; if (_sp > XB_SPIN_CAP) { atomicAdd(&(bar)[XB_TMO], 1u); break; } } } } while (0)

struct XcdBarrier {
    unsigned* bar; unsigned x; int wv;
    volatile LAS unsigned* st;
};

__device__ __forceinline__ bool xb_t0(int wv) { unsigned z_ = 0u; asm volatile("" : "+v"(z_)); return wv == 0 && __builtin_amdgcn_mbcnt_hi(~0u, __builtin_amdgcn_mbcnt_lo(~0u, z_)) == 0u; }
__device__ __forceinline__ XcdBarrier xcd_barrier_post(unsigned* bar, volatile LAS unsigned* st, int wv) {
    XcdBarrier b; b.bar = bar; b.x = xb_xcc_id(); b.st = st; b.wv = wv;
    if (xb_t0(wv)) (void)xb_add(&bar[XB_XCNT(b.x)], 1u);
    return b;
}
__device__ __forceinline__ void xcd_barrier_complete(unsigned* bar, unsigned x, unsigned& nloc, unsigned& nx) {
    const unsigned G = gridDim.x * gridDim.y * gridDim.z;
    unsigned sum, cnt, mine, sp = 0u;
    for (;;) {
        sum = 0u; cnt = 0u; mine = 0u;
#pragma unroll
        for (unsigned j = 0; j < 16; ++j) { const unsigned c = xb_ld(&bar[XB_XCNT(j)]); sum += c; cnt += (c > 0u) ? 1u : 0u; mine = (j == x) ? c : mine; }
        if (sum == G) break;
        __builtin_amdgcn_s_sleep(1);
        if ((++sp & 255u) == 0u) { if (xb_ld(&bar[XB_TMO])) break; if (sp > XB_SPIN_CAP) { atomicAdd(&bar[XB_TMO], 1u); break; } }
    }
    nloc = mine > 0u ? mine : 1u; nx = cnt > 0u ? cnt : 1u;
}

__device__ __forceinline__ void xcd_barrier(const XcdBarrier& b) {
    asm volatile("s_waitcnt vmcnt(0)" ::: "memory");
    __syncthreads();
    if (xb_t0(b.wv)) {
        unsigned* bar = b.bar;
        __builtin_amdgcn_s_waitcnt(0);
        unsigned nloc = b.st[0], nx = b.st[1];
        if (nloc == 0u) { xcd_barrier_complete(bar, b.x, nloc, nx); b.st[0] = nloc; b.st[1] = nx; }
        const unsigned old = xb_add(&bar[XB_XSUB(b.x)], 1u);
        const unsigned gen = old / nloc;
        if (old + 1u == (gen + 1u) * nloc) {
            __builtin_amdgcn_fence(__ATOMIC_RELEASE, "agent");
            asm volatile("s_waitcnt vmcnt(0)" ::: "memory");
            const unsigned og = xb_add(&bar[XB_TOP], 1u);
            const unsigned tg = og / nx;
            if (og + 1u == (tg + 1u) * nx) xb_add(&bar[XB_TOPGEN], 1u);
            else XB_SPIN(xb_ld(&bar[XB_TOPGEN]) == tg, bar);
            __builtin_amdgcn_fence(__ATOMIC_ACQUIRE, "agent");
            xb_add(&bar[XB_XGEN(b.x)], 1u);
            asm volatile("s_waitcnt vmcnt(0)" ::: "memory");
        } else {
            XB_SPIN(xb_ld(&bar[XB_XGEN(b.x)]) == gen, bar);
            __builtin_amdgcn_fence(__ATOMIC_ACQUIRE, "agent");
            asm volatile("s_waitcnt vmcnt(0)" ::: "memory");
        }
    }
    __syncthreads();
}

typedef short bf16x8 __attribute__((ext_vector_type(8)));
constexpr int RP_PITCH = 516, ACT_PITCH = 328;
__device__ __forceinline__ void rwkv_prep_item(KArgs a, int l, int item, LAS unsigned char* lds, int tid, int lane, int wave) {
    unsigned char* ws = a->ws;
    const bf16* U = (const bf16*)(ws + OFF_U); const float* MISC = (const float*)(ws + OFF_MISC);
    const int b = item / 144, j0 = (item % 144) * 16; const bool isctx = j0 < LCTX;
    LAS float* RP = (LAS float*)lds;
    LAS float* KP = RP + 16 * RP_PITCH; LAS float* VP = KP + 16 * RP_PITCH;
    LAS bf16* ACT = (LAS bf16*)(lds + 3 * 16 * RP_PITCH * 4);
    const float* mu = a->in[I_RMU] + l * 1856;
    for (int idx = tid; idx < 16 * 192; idx += NTHR) { const int i = idx / 192, c8 = idx % 192, jj = j0 + i;
        const bool hp = isctx ? (jj - 1 >= 0) : (jj - 1 >= LCTX), hn = isctx ? (jj + 1 < LCTX) : (jj + 1 < RJ);
        const v4u c = *(const v4u*)(U + (size_t)rwkv_tok(b, jj) * NU + URKV + c8 * 8);
        v4u p = (v4u){0u, 0u, 0u, 0u}, n = p;
        if (hp) p = *(const v4u*)(U + (size_t)rwkv_tok(b, jj - 1) * NU + URKV + c8 * 8);
        if (hn) n = *(const v4u*)(U + (size_t)rwkv_tok(b, jj + 1) * NU + URKV + c8 * 8);
        const f32x4 m0 = *(const f32x4*)(mu + c8 * 8), m1 = *(const f32x4*)(mu + c8 * 8 + 4);
        f32x4 x0 = (f32x4){bflo(c.x), bfhi(c.x), bflo(c.y), bfhi(c.y)}, x1 = (f32x4){bflo(c.z), bfhi(c.z), bflo(c.w), bfhi(c.w)};
        const f32x4 s0 = (f32x4){bflo(p.x) + bflo(n.x), bfhi(p.x) + bfhi(n.x), bflo(p.y) + bflo(n.y), bfhi(p.y) + bfhi(n.y)}, s1 = (f32x4){bflo(p.z) + bflo(n.z), bfhi(p.z) + bfhi(n.z), bflo(p.w) + bflo(n.w), bfhi(p.w) + bfhi(n.w)};
        x0 = x0 + (0.5f * s0 - x0) * m0; x1 = x1 + (0.5f * s1 - x1) * m1;
        const int ch = c8 * 8, reg = ch >> 9; LAS float* dst = (reg == 0 ? RP : (reg == 1 ? KP : VP)) + i * RP_PITCH + (ch & 511);
        *(LAS f32x4*)dst = x0; *(LAS f32x4*)(dst + 4) = x1; }
    for (int idx = tid; idx < 16 * 80; idx += NTHR) { const int i = idx / 80, c4 = idx % 80, jj = j0 + i;
        const bool hp = isctx ? (jj - 1 >= 0) : (jj - 1 >= LCTX), hn = isctx ? (jj + 1 < LCTX) : (jj + 1 < RJ);
        f32x4 x = *(const f32x4*)(MISC + (size_t)rwkv_tok(b, jj) * 512 + 64 + c4 * 4); f32x4 p = (f32x4){0.f, 0.f, 0.f, 0.f}, n = p;
        if (hp) p = *(const f32x4*)(MISC + (size_t)rwkv_tok(b, jj - 1) * 512 + 64 + c4 * 4);
        if (hn) n = *(const f32x4*)(MISC + (size_t)rwkv_tok(b, jj + 1) * 512 + 64 + c4 * 4);
        x = x + (0.5f * (p + n) - x) * *(const f32x4*)(mu + 1536 + c4 * 4);
        const int m = c4 * 4;
        if (m < 128) x = (f32x4){tanhf(x.x), tanhf(x.y), tanhf(x.z), tanhf(x.w)}; else if (m >= 192) x = (f32x4){sigmoidf_(x.x), sigmoidf_(x.y), sigmoidf_(x.z), sigmoidf_(x.w)};
        *(LAS v2u*)(ACT + i * ACT_PITCH + m) = (v2u){pk2(x.x, x.y), pk2(x.z, x.w)}; }
    __syncthreads();
    const int fr = lane & 15, fq = lane >> 4, h = wave;
    f32x4 acc[4][4];
#pragma unroll
    for (int o = 0; o < 4; ++o)
#pragma unroll
        for (int nt = 0; nt < 4; ++nt) acc[o][nt] = (f32x4){0.f, 0.f, 0.f, 0.f};
    {
        const bf16* WLT = (const bf16*)(ws + OFF_WLT) + (size_t)l * 512 * 320 + (size_t)(64 * wave + fr) * 320 + fq * 8;
#pragma unroll
        for (int ks = 0; ks < 10; ++ks) { const int o = ks < 2 ? 0 : (ks < 4 ? 1 : (ks < 6 ? 2 : 3));
            const bf16x8 af = *(const LAS bf16x8*)(ACT + fr * ACT_PITCH + ks * 32 + fq * 8);
#pragma unroll
            for (int nt = 0; nt < 4; ++nt) { const bf16x8 bf = *(const bf16x8*)(WLT + (size_t)nt * 16 * 320 + ks * 32);
                acc[o][nt] = __builtin_amdgcn_mfma_f32_16x16x32_bf16(af, bf, acc[o][nt], 0, 0, 0); } }
    }
    float* RW = (float*)(ws + OFF_RW); constexpr size_t AS = RW_ARR / 4; float* RSC = (float*)(ws + OFF_RSC);
    float w0f[4], w0b[4], a0c[4], kkc[4], kac[4], rkc[4];
#pragma unroll
    for (int nt = 0; nt < 4; ++nt) { const int c = 64 * wave + 16 * nt + fr; w0f[nt] = a->in[I_RW0][(l * 2 + 0) * 512 + c]; w0b[nt] = a->in[I_RW0][(l * 2 + 1) * 512 + c]; a0c[nt] = a->in[I_RA0][l * 512 + c];
        kkc[nt] = a->in[I_RKK][l * 512 + c]; kac[nt] = a->in[I_RKA][l * 512 + c]; rkc[nt] = a->in[I_RRK][l * 512 + c]; }
#pragma unroll
    for (int i = 0; i < 4; ++i) { const int tok = 4 * fq + i; const size_t R = (size_t)b * RJ + j0 + tok;
        float r[4], k[4], v[4], av[4], kkv[4]; float ss = 0.f;
#pragma unroll
        for (int nt = 0; nt < 4; ++nt) { const int c = 64 * wave + 16 * nt + fr; r[nt] = RP[tok * RP_PITCH + c]; k[nt] = KP[tok * RP_PITCH + c]; v[nt] = VP[tok * RP_PITCH + c];
            av[nt] = sigmoidf_(a0c[nt] + acc[2][nt][i]); kkv[nt] = k[nt] * kkc[nt]; ss += kkv[nt] * kkv[nt]; }
        const float rn = rsqrtf(row16_sum(ss) + 1e-12f);
        float c1 = 0.f, c2 = 0.f, bon = 0.f;
#pragma unroll
        for (int nt = 0; nt < 4; ++nt) { const int c = 64 * wave + 16 * nt + fr;
            const float wf = __expf(-__expf(-softplusf_(-(w0f[nt] + acc[0][nt][i])) - 0.5f)), wb = __expf(-__expf(-softplusf_(-(w0b[nt] + acc[1][nt][i])) - 0.5f));
            const float kk = kkv[nt] * rn, kmod = k[nt] * (1.f + (av[nt] - 1.f) * kac[nt]), ka = kk * av[nt];
            c1 += ka * r[nt]; c2 += kmod * r[nt]; bon += r[nt] * kmod * rkc[nt];
            float* o = RW + R * 512 + c;
            o[0 * AS] = wf; o[1 * AS] = wf * r[nt]; o[2 * AS] = wb; o[3 * AS] = wb * r[nt]; o[4 * AS] = kmod; o[5 * AS] = -kk; o[6 * AS] = ka; o[7 * AS] = v[nt]; o[8 * AS] = acc[3][nt][i]; }
        c1 = row16_sum(c1); c2 = row16_sum(c2); bon = row16_sum(bon);
        if (fr == 0) { RSC[R * 8 + h] = c1; RSC[(size_t)TT * 8 + R * 8 + h] = c2; RSC[(size_t)2 * TT * 8 + R * 8 + h] = bon; }
    }
    __syncthreads();
}
__device__ __forceinline__ void ssd_prep_item(KArgs a, int l, int item, int tid) {
    unsigned char* ws = a->ws; const bf16* U = (const bf16*)(ws + OFF_U); const float* MISC = (const float*)(ws + OFF_MISC);
    bf16* XBC = (bf16*)(ws + OFF_XBC); float* DTA = (float*)(ws + OFF_DTA);
    const int t0 = item * 16;
    const int seq_lo = t0 < TLAT ? (t0 & ~(LSEQ - 1)) : TLAT + ((t0 - TLAT) & ~(LCTX - 1)), seq_hi = seq_lo + (t0 < TLAT ? LSEQ : LCTX);
    for (int cp = tid; cp < 896; cp += NTHR) {
        float w0[5], w1[5];
#pragma unroll
        for (int j = 0; j < 5; ++j) { const f32x2 w = *(const f32x2*)(a->in[I_SCW] + (size_t)(l * 5 + j) * 1792 + 2 * cp); w0[j] = w.x; w1[j] = w.y; }
        const f32x2 bb = *(const f32x2*)(a->in[I_SCB] + l * 1792 + 2 * cp);
        float i0[20], i1[20];
#pragma unroll
        for (int r = 0; r < 20; ++r) { const int row = t0 - 2 + r; unsigned u = 0u; if (row >= seq_lo && row < seq_hi) u = *(const unsigned*)(U + (size_t)row * NU + UXBC + 2 * cp); i0[r] = bflo(u); i1[r] = bfhi(u); }
#pragma unroll
        for (int o = 0; o < 16; ++o) { float s0 = bb.x, s1 = bb.y;
#pragma unroll
            for (int j = 0; j < 5; ++j) { s0 += w0[j] * i0[o + j]; s1 += w1[j] * i1[o + j]; }
            *(unsigned*)(XBC + (size_t)(t0 + o) * 1792 + 2 * cp) = pk2(siluf_(s0), siluf_(s1)); }
    }
    if (tid < 16 * 24) { const int o = tid / 24, q = tid % 24;
        const float dt = softplusf_(MISC[(size_t)(t0 + o) * 512 + q] + a->in[I_SDTB][l * 24 + q]); const float A = -__expf(a->in[I_SALOG][l * 24 + q]);
        DTA[(size_t)(t0 + o) * 48 + q] = dt; DTA[(size_t)(t0 + o) * 48 + 24 + q] = dt * A; }
}
__device__ __forceinline__ void conv_item(KArgs a, int l, int item, LAS unsigned char* lds, int tid, int lane, int wave) {
    unsigned char* ws = a->ws; const bf16* U = (const bf16*)(ws + OFF_U); bf16* AC = (bf16*)(ws + OFF_ACAT) + AC_CONV;
    int t0, seg_lo, seg_hi;
    if (item < 256) { t0 = item * 32; seg_lo = t0 & ~63; seg_hi = seg_lo + 64; }
    else { const int ci = item - 256; t0 = TLAT + ci * 32; seg_lo = TLAT + (ci >> 3) * LCTX; seg_hi = seg_lo + LCTX; }
    LAS bf16* inimg = (LAS bf16*)lds;
    LAS float* outimg = (LAS float*)(lds + 63488);
    for (int idx = tid; idx < 62 * 64; idx += NTHR) { const int rr = idx >> 6, c8 = idx & 63, row = t0 - 15 + rr;
        v4u o = (v4u){0u, 0u, 0u, 0u};
        if (row >= seg_lo && row < seg_hi) { const v4u va = *(const v4u*)(U + (size_t)row * NU + UCONV + c8 * 8), vg = *(const v4u*)(U + (size_t)row * NU + UCONV + 512 + c8 * 8);
            o.x = pk2(bflo(va.x) * sigmoidf_(bflo(vg.x)), bfhi(va.x) * sigmoidf_(bfhi(vg.x))); o.y = pk2(bflo(va.y) * sigmoidf_(bflo(vg.y)), bfhi(va.y) * sigmoidf_(bfhi(vg.y)));
            o.z = pk2(bflo(va.z) * sigmoidf_(bflo(vg.z)), bfhi(va.z) * sigmoidf_(bfhi(vg.z))); o.w = pk2(bflo(va.w) * sigmoidf_(bflo(vg.w)), bfhi(va.w) * sigmoidf_(bfhi(vg.w))); }
        *(LAS v4u*)(inimg + rr * 512 + c8 * 8) = o; }
    __syncthreads();
    {
        const int c = tid; float w[31];
#pragma unroll
        for (int j = 0; j < 31; ++j) w[j] = a->in[I_CONVW][(size_t)(l * 31 + j) * 512 + c];
        const float bias = a->in[I_CONVB][l * 512 + c];
#pragma unroll 2
        for (int o = 0; o < 32; ++o) { float s = bias;
#pragma unroll
            for (int j = 0; j < 31; ++j) s += w[j] * bf2f(inimg[(o + j) * 512 + c]);
            outimg[o * 512 + c] = s; }
    }
    __syncthreads();
    {
        const f32x4 g0 = *(const f32x4*)(a->in[I_CLNG] + l * 512 + 8 * lane), g1 = *(const f32x4*)(a->in[I_CLNG] + l * 512 + 8 * lane + 4);
        const f32x4 b0 = *(const f32x4*)(a->in[I_CLNB] + l * 512 + 8 * lane), b1 = *(const f32x4*)(a->in[I_CLNB] + l * 512 + 8 * lane + 4);
#pragma unroll
        for (int q = 0; q < 4; ++q) { const int o = wave * 4 + q;
            f32x4 x0 = *(const LAS f32x4*)(outimg + o * 512 + 8 * lane), x1 = *(const LAS f32x4*)(outimg + o * 512 + 8 * lane + 4);
            const float mean = wave_sum((x0.x + x0.y + x0.z + x0.w) + (x1.x + x1.y + x1.z + x1.w)) * (1.f / 512.f);
            x0 = x0 - mean; x1 = x1 - mean;
            const float var = wave_sum((x0.x * x0.x + x0.y * x0.y + x0.z * x0.z + x0.w * x0.w) + (x1.x * x1.x + x1.y * x1.y + x1.z * x1.z + x1.w * x1.w)) * (1.f / 512.f);
            const float rs = rsqrtf(var + 1e-5f);
            x0 = x0 * rs * g0 + b0; x1 = x1 * rs * g1 + b1;
            v4u ov; ov.x = pk2(siluf_(x0.x), siluf_(x0.y)); ov.y = pk2(siluf_(x0.z), siluf_(x0.w)); ov.z = pk2(siluf_(x1.x), siluf_(x1.y)); ov.w = pk2(siluf_(x1.z), siluf_(x1.w));
            *(v4u*)(AC + (size_t)(t0 + o) * ACW + 8 * lane) = ov; }
    }
    __syncthreads();
}

__device__ __forceinline__ int ssd_tok(int b, int dir, int pos) {
    if (pos < LCTX) return TLAT + b * LCTX + (dir ? (LCTX - 1 - pos) : pos);
    const int q = pos - LCTX; return b * LSEQ + (dir ? (LSEQ - 1 - q) : q);
}
__device__ __forceinline__ void post_phase(KArgs a, int l, int bid, int G, const int wave0) {
    PH_IDS
    unsigned char* ws = a->ws; const int gw = bid * NWAVES + wave, NGW = G * NWAVES;
    const bf16* U = (const bf16*)(ws + OFF_U); const bf16* XBC = (const bf16*)(ws + OFF_XBC);
    const float* Y0 = (const float*)(ws + OFF_YSSD); const float* Y1 = Y0 + (size_t)TT * 768; bf16* AS_ = (bf16*)(ws + OFF_ACAT) + AC_SSD;
    for (int row = gw; row < TT; row += NGW) {
        f32x4 y[3]; float ss = 0.f;
#pragma unroll
        for (int j = 0; j < 3; ++j) { const int col = 4 * lane + 256 * j; const float dsk = a->in[I_SD][l * 12 + (col >> 6)];
            const f32x4 yf = *(const f32x4*)(Y0 + (size_t)row * 768 + col), yb = *(const f32x4*)(Y1 + (size_t)row * 768 + col);
            const v2u xs = *(const v2u*)(XBC + (size_t)row * 1792 + col), z = *(const v2u*)(U + (size_t)row * NU + UZ + col);
            f32x4 v = yf + yb + dsk * (f32x4){bflo(xs.x), bfhi(xs.x), bflo(xs.y), bfhi(xs.y)};
            v = v * (f32x4){siluf_(bflo(z.x)), siluf_(bfhi(z.x)), siluf_(bflo(z.y)), siluf_(bfhi(z.y))};
            y[j] = v; ss += (v.x * v.x + v.y * v.y) + (v.z * v.z + v.w * v.w); }
        const float r = rsqrtf(wave_sum(ss) * (1.f / 768.f) + 1e-6f);
#pragma unroll
        for (int j = 0; j < 3; ++j) { const int col = 4 * lane + 256 * j; const f32x4 g = *(const f32x4*)(a->in[I_SNG] + l * 768 + col); const f32x4 o = y[j] * r * g;
            *(v2u*)(AS_ + (size_t)row * ACW + col) = (v2u){pk2(o.x, o.y), pk2(o.z, o.w)}; }
    }
    const float* RW = (const float*)(ws + OFF_RW); constexpr size_t AS = RW_ARR / 4; const float* RSC = (const float*)(ws + OFF_RSC);
    const float* R0 = (const float*)(ws + OFF_YRW); const float* R1 = R0 + (size_t)TT * 512; bf16* AR = (bf16*)(ws + OFF_ACAT) + AC_RWKV;
    for (int row = gw; row < TT; row += NGW) {
        size_t R;
        if (row < TLAT) { const int b = row >> 11, t = row & 2047, rr = t >> 6, cc = t & 63; R = (size_t)b * RJ + LCTX + cc * 32 + rr; }
        else { const int b = (row - TLAT) >> 8, jj = (row - TLAT) & 255; R = (size_t)b * RJ + jj; }
        const int c0 = 8 * lane, h = lane >> 3;
        f32x4 ya = *(const f32x4*)(R0 + R * 512 + c0) + *(const f32x4*)(R1 + R * 512 + c0), yb = *(const f32x4*)(R0 + R * 512 + c0 + 4) + *(const f32x4*)(R1 + R * 512 + c0 + 4);
        float s = (ya.x + ya.y + ya.z + ya.w) + (yb.x + yb.y + yb.z + yb.w);
        s = sum8(s);
        const float mean = s * (1.f / 64.f); ya = ya - mean; yb = yb - mean;
        float q = (ya.x * ya.x + ya.y * ya.y + ya.z * ya.z + ya.w * ya.w) + (yb.x * yb.x + yb.y * yb.y + yb.z * yb.z + yb.w * yb.w);
        q = sum8(q);
        const float rs = rsqrtf(q * (1.f / 64.f) + 64e-5f);
        const f32x4 lg0 = *(const f32x4*)(a->in[I_RLNG] + l * 512 + c0), lg1 = *(const f32x4*)(a->in[I_RLNG] + l * 512 + c0 + 4), lb0 = *(const f32x4*)(a->in[I_RLNB] + l * 512 + c0), lb1 = *(const f32x4*)(a->in[I_RLNB] + l * 512 + c0 + 4);
        const float bon = RSC[(size_t)2 * TT * 8 + R * 8 + h];
        const f32x4 v0 = *(const f32x4*)(RW + 7 * AS + R * 512 + c0), v1 = *(const f32x4*)(RW + 7 * AS + R * 512 + c0 + 4), g0 = *(const f32x4*)(RW + 8 * AS + R * 512 + c0), g1 = *(const f32x4*)(RW + 8 * AS + R * 512 + c0 + 4);
        const f32x4 o0 = (ya * rs * lg0 + lb0 + bon * v0) * g0, o1 = (yb * rs * lg1 + lb1 + bon * v1) * g1;
        *(v4u*)(AR + (size_t)row * ACW + c0) = (v4u){pk2(o0.x, o0.y), pk2(o0.z, o0.w), pk2(o1.x, o1.y), pk2(o1.z, o1.w)};
    }
}

__device__ __forceinline__ size_t rwkv_row(int b, int dir, int pos) { const int j = dir ? (pos < LCTX ? (LCTX - 1 - pos) : (RJ + LCTX - 1 - pos)) : pos; return (size_t)b * RJ + j; }
constexpr int RWS_BUF = 45568, RWS_V = 40960, RWS_C = 45056, RWS_CH = 32;
__device__ __forceinline__ void rwkv_scan_fast(KArgs a, int idx, LAS unsigned char* lds, int tid, int lane, int wave) {
    unsigned char* ws = a->ws; const float* RW = (const float*)(ws + OFF_RW); constexpr size_t AS = RW_ARR / 4; const float* RSC = (const float*)(ws + OFF_RSC);
    const int combo = idx >> 1, half = idx & 1, b = combo >> 4, dir = (combo >> 3) & 1, h = combo & 7, v0 = half * 32;
    float* Yo = (float*)(ws + OFF_YRW) + (size_t)dir * TT * 512;
    const float* arr0 = RW + (dir ? 2 : 0) * AS; const float* arr1 = RW + (dir ? 3 : 1) * AS;
    const int ls = tid >> 4, lc4 = tid & 15;
    f32x4 pre[5]; f32x4 prev = (f32x4){0.f, 0.f, 0.f, 0.f}; float prec = 0.f;
    auto issue = [&](int chunk) {
        const size_t R = rwkv_row(b, dir, chunk * RWS_CH + ls); const size_t o = R * 512 + h * 64 + lc4 * 4;
        pre[0] = *(const f32x4*)(arr0 + o); pre[1] = *(const f32x4*)(arr1 + o); pre[2] = *(const f32x4*)(RW + 4 * AS + o); pre[3] = *(const f32x4*)(RW + 5 * AS + o); pre[4] = *(const f32x4*)(RW + 6 * AS + o);
        if (tid < 256) { const size_t R2 = rwkv_row(b, dir, chunk * RWS_CH + (tid >> 3)); prev = *(const f32x4*)(RW + 7 * AS + R2 * 512 + h * 64 + v0 + (tid & 7) * 4); }
        else if (tid < 320) { const int t2 = tid - 256; const size_t R2 = rwkv_row(b, dir, chunk * RWS_CH + (t2 >> 1)); prec = RSC[(size_t)(t2 & 1) * TT * 8 + R2 * 8 + h]; }
    };
    auto commit = [&](int buf) {
        LAS unsigned char* B = lds + buf * RWS_BUF;
#pragma unroll
        for (int i = 0; i < 5; ++i) *(LAS f32x4*)(B + i * 8192 + ls * 256 + lc4 * 16) = pre[i];
        if (tid < 256) *(LAS f32x4*)(B + RWS_V + (tid >> 3) * 128 + (tid & 7) * 16) = prev;
        else if (tid < 320) *(LAS float*)(B + RWS_C + (tid - 256) * 4) = prec;
    };
    f32x4 S0 = (f32x4){0.f, 0.f, 0.f, 0.f}, S1 = S0;
    const int rl = (wave & 3) * 8 + (lane >> 3), q = lane & 7;
    LAS float* ybuf = (LAS float*)(lds + 2 * RWS_BUF);
    issue(0); commit(0); __syncthreads();
    constexpr int NCH = RJ / RWS_CH;
    struct RwOp { f32x4 w0, w1, r0, r1, k0, k1, n0, n1, a0, a1; float vv; f32x2 cc; };
    for (int ch = 0; ch < NCH; ++ch) {
        if (ch + 1 < NCH) issue(ch + 1);
        if (wave < 4) {
            const LAS unsigned char* B = lds + (ch & 1) * RWS_BUF; const LAS unsigned char* p0 = B + q * 32; const LAS unsigned char* pv = B + RWS_V + rl * 4;
            LAS float* yb = ((q == 0) ? (ybuf + (ch & 1) * 1024) : (ybuf + 2048)) + rl;
            auto ldop = [&](int s) { RwOp o; const LAS unsigned char* p = p0 + s * 256;
                o.w0 = *(const LAS f32x4*)(p); o.w1 = *(const LAS f32x4*)(p + 16); o.r0 = *(const LAS f32x4*)(p + 8192); o.r1 = *(const LAS f32x4*)(p + 8192 + 16);
                o.k0 = *(const LAS f32x4*)(p + 16384); o.k1 = *(const LAS f32x4*)(p + 16384 + 16); o.n0 = *(const LAS f32x4*)(p + 24576); o.n1 = *(const LAS f32x4*)(p + 24576 + 16);
                o.a0 = *(const LAS f32x4*)(p + 32768); o.a1 = *(const LAS f32x4*)(p + 32768 + 16);
                o.vv = *(const LAS float*)(pv + s * 128); o.cc = *(const LAS f32x2*)(B + RWS_C + s * 8); return o; };
            RwOp cur = ldop(0);
#pragma unroll
            for (int s = 0; s < RWS_CH; ++s) {
                RwOp nxt = cur; if (s + 1 < RWS_CH) nxt = ldop(s + 1);
                const f32x4 t0 = S0 * cur.n0 + S1 * cur.n1, t1 = S0 * cur.r0 + S1 * cur.r1;
                float sa = (t0.x + t0.y) + (t0.z + t0.w), pp = (t1.x + t1.y) + (t1.z + t1.w);
                sa = dpp_add<0xB1>(sa); pp = dpp_add<0xB1>(pp); sa = dpp_add<0x4E>(sa); pp = dpp_add<0x4E>(pp); sa = dpp_add<0x141>(sa); pp = dpp_add<0x141>(pp);
                S0 = S0 * cur.w0 + (sa * cur.a0 + cur.vv * cur.k0); S1 = S1 * cur.w1 + (sa * cur.a1 + cur.vv * cur.k1);
                const float y = pp + sa * cur.cc.x + cur.vv * cur.cc.y;
                yb[s * 32] = y;
                cur = nxt;
            }
        } else if (ch > 0) {
            const int t2 = tid - 256, s = t2 >> 3, r4 = t2 & 7; const size_t R = rwkv_row(b, dir, (ch - 1) * RWS_CH + s);
            *(f32x4*)(Yo + R * 512 + h * 64 + v0 + r4 * 4) = *(const LAS f32x4*)(ybuf + ((ch - 1) & 1) * 1024 + s * 32 + r4 * 4);
        }
        if (ch + 1 < NCH) commit((ch + 1) & 1);
        __syncthreads();
    }
    if (wave >= 4) { const int t2 = tid - 256, s = t2 >> 3, r4 = t2 & 7; const size_t R = rwkv_row(b, dir, (NCH - 1) * RWS_CH + s);
        *(f32x4*)(Yo + R * 512 + h * 64 + v0 + r4 * 4) = *(const LAS f32x4*)(ybuf + ((NCH - 1) & 1) * 1024 + s * 32 + r4 * 4); }
    __syncthreads();
}

constexpr int SS_CM = 0, SS_BM = 17408, SS_BST = 34816, SS_XT = 53248, SS_MX = 62464, SS_HB = 71680, SS_CS = 89088, SS_DT = 89344;
__device__ __forceinline__ float bfe(const v4u& v, int i) { const unsigned u = (i < 2) ? v.x : (i < 4) ? v.y : (i < 6) ? v.z : v.w; return (i & 1) ? bfhi(u) : bflo(u); }
__device__ __forceinline__ unsigned short bfraw(const v4u& v, int i) { const unsigned u = (i < 2) ? v.x : (i < 4) ? v.y : (i < 6) ? v.z : v.w; return (unsigned short)((i & 1) ? (u >> 16) : (u & 0xffffu)); }
__device__ __forceinline__ void ssd_scan_fast(KArgs a, int idx, LAS unsigned char* lds, int tid, int lane, int wave) {
    unsigned char* ws = a->ws; const bf16* XBC = (const bf16*)(ws + OFF_XBC); const float* DTA = (const float*)(ws + OFF_DTA);
    const int b = idx / 24, dir = (idx % 24) / 12, h = idx % 12, g = h / 3, q = dir * 12 + h;
    float* Yo = (float*)(ws + OFF_YSSD) + (size_t)dir * TT * 768;
    LAS bf16* Cm = (LAS bf16*)(lds + SS_CM); LAS bf16* Bm = (LAS bf16*)(lds + SS_BM); LAS bf16* BsT = (LAS bf16*)(lds + SS_BST); LAS bf16* XT = (LAS bf16*)(lds + SS_XT);
    LAS bf16* Mx = (LAS bf16*)(lds + SS_MX); LAS bf16* Hb = (LAS bf16*)(lds + SS_HB); LAS float* CS = (LAS float*)(lds + SS_CS); LAS float* DTV = (LAS float*)(lds + SS_DT);
    const int fr = lane & 15, fq = lane >> 4, ss = tid & 63, sc = tid >> 6, tl = wave >> 1, wh = wave & 1;
    { unsigned z = 0u; asm volatile("" : "+v"(z)); for (int i = tid; i < 17408 / 16; i += NTHR) *(LAS v4u*)(lds + SS_HB + i * 16) = (v4u){z, z, z, z}; }
    f32x4 hacc[4];
#pragma unroll
    for (int j = 0; j < 4; ++j) hacc[j] = (f32x4){0.f, 0.f, 0.f, 0.f};
    v4u pc0, pc1, pb0, pb1, px; float pdt = 0.f, pa = 0.f;
    auto issue = [&](int ch) {
        const int tok = ssd_tok(b, dir, ch * 64 + ss); const bf16* row = XBC + (size_t)tok * 1792;
        pc0 = *(const v4u*)(row + 1280 + g * 128 + sc * 8); pc1 = *(const v4u*)(row + 1280 + g * 128 + (sc + 8) * 8);
        pb0 = *(const v4u*)(row + 768 + g * 128 + sc * 8); pb1 = *(const v4u*)(row + 768 + g * 128 + (sc + 8) * 8);
        px = *(const v4u*)(row + h * 64 + sc * 8);
        if (tid < 64) { pdt = DTA[(size_t)tok * 48 + q]; pa = DTA[(size_t)tok * 48 + 24 + q]; }
    };
    issue(0);
    for (int ch = 0; ch < RJ / 64; ++ch) {
        *(LAS v4u*)(Cm + ss * 136 + sc * 8) = pc0; *(LAS v4u*)(Cm + ss * 136 + (sc + 8) * 8) = pc1;
        *(LAS v4u*)(Bm + ss * 136 + sc * 8) = pb0; *(LAS v4u*)(Bm + ss * 136 + (sc + 8) * 8) = pb1;
#pragma unroll
        for (int i = 0; i < 8; ++i) XT[(sc * 8 + i) * 72 + ss] = bfraw(px, i);
        if (tid < 64) { float x = pa;
#pragma unroll
            for (int o = 1; o < 64; o <<= 1) { const float t = __int_as_float(__builtin_amdgcn_ds_bpermute((lane - o) << 2, __float_as_int(x))); if (lane >= o) x += t; }
            CS[tid] = x; DTV[tid] = pdt; }
        __syncthreads();
        const float cl = CS[63];
        { const float scl = DTV[ss] * __expf(cl - CS[ss]);
#pragma unroll
            for (int i = 0; i < 8; ++i) { BsT[(sc * 8 + i) * 72 + ss] = (bf16)f2bf(bfe(pb0, i) * scl); BsT[((sc + 8) * 8 + i) * 72 + ss] = (bf16)f2bf(bfe(pb1, i) * scl); } }
        if (ch + 1 < RJ / 64) issue(ch + 1);
#pragma unroll
        for (int j = 0; j < 2; ++j) { const int tc = wh * 2 + j; f32x4 acc = (f32x4){0.f, 0.f, 0.f, 0.f};
            if (tc <= tl) {
#pragma unroll
                for (int ks = 0; ks < 4; ++ks) { const bf16x8 af = *(const LAS bf16x8*)(Cm + (16 * tl + fr) * 136 + ks * 32 + fq * 8), bf = *(const LAS bf16x8*)(Bm + (16 * tc + fr) * 136 + ks * 32 + fq * 8);
                    acc = __builtin_amdgcn_mfma_f32_16x16x32_bf16(af, bf, acc, 0, 0, 0); } }
            const int s = 16 * tc + fr; const float css = CS[s], dts = DTV[s];
#pragma unroll
            for (int i = 0; i < 4; ++i) { const int l = 16 * tl + 4 * fq + i; const float v = (s <= l) ? acc[i] * __expf(CS[l] - css) * dts : 0.f; Mx[l * 72 + s] = (bf16)f2bf(v); } }
        __syncthreads();
#pragma unroll
        for (int j = 0; j < 2; ++j) { const int tp = wh * 2 + j; f32x4 acc = (f32x4){0.f, 0.f, 0.f, 0.f};
#pragma unroll
            for (int ks = 0; ks < 4; ++ks) { const bf16x8 af = *(const LAS bf16x8*)(Cm + (16 * tl + fr) * 136 + ks * 32 + fq * 8), bf = *(const LAS bf16x8*)(Hb + (16 * tp + fr) * 136 + ks * 32 + fq * 8);
                acc = __builtin_amdgcn_mfma_f32_16x16x32_bf16(af, bf, acc, 0, 0, 0); }
#pragma unroll
            for (int i = 0; i < 4; ++i) acc[i] *= __expf(CS[16 * tl + 4 * fq + i]);
#pragma unroll
            for (int ks = 0; ks < 2; ++ks) { const bf16x8 af = *(const LAS bf16x8*)(Mx + (16 * tl + fr) * 72 + ks * 32 + fq * 8), bf = *(const LAS bf16x8*)(XT + (16 * tp + fr) * 72 + ks * 32 + fq * 8);
                acc = __builtin_amdgcn_mfma_f32_16x16x32_bf16(af, bf, acc, 0, 0, 0); }
#pragma unroll
            for (int i = 0; i < 4; ++i) { const int tok = ssd_tok(b, dir, ch * 64 + 16 * tl + 4 * fq + i); Yo[(size_t)tok * 768 + h * 64 + 16 * tp + fr] = acc[i]; } }
        { const float ecl = __expf(cl);
#pragma unroll
            for (int j = 0; j < 4; ++j) { const int tn = wh * 4 + j; hacc[j] = hacc[j] * ecl;
#pragma unroll
                for (int ks = 0; ks < 2; ++ks) { const bf16x8 af = *(const LAS bf16x8*)(XT + (16 * tl + fr) * 72 + ks * 32 + fq * 8), bf = *(const LAS bf16x8*)(BsT + (16 * tn + fr) * 72 + ks * 32 + fq * 8);
                    hacc[j] = __builtin_amdgcn_mfma_f32_16x16x32_bf16(af, bf, hacc[j], 0, 0, 0); } } }
        __syncthreads();
#pragma unroll
        for (int j = 0; j < 4; ++j) { const int tn = wh * 4 + j;
#pragma unroll
            for (int i = 0; i < 4; ++i) Hb[(16 * tl + 4 * fq + i) * 136 + 16 * tn + fr] = (bf16)f2bf(hacc[j][i]); }
    }
}

constexpr int NPH = 2 + 10 * DEPTH;
#ifndef PROBE_MASK
#define PROBE_MASK 0
#endif
#ifndef PROBE_P0
#define PROBE_P0 0
#endif
#ifndef PROBE_SUB
#define PROBE_SUB 0
#endif
#ifndef PROBE_REPS
#define PROBE_REPS 3
#endif
#define REPS(k) (((PROBE_MASK >> (k)) & 1) ? PROBE_REPS : 1)
constexpr int GATE_LATE = 9;
#ifndef MK_ONE_LAUNCH
#define MK_ONE_LAUNCH 1
#endif

__global__ void __launch_bounds__(NTHR, 2) fwd(Args a_unused) {
    extern __shared__ __attribute__((aligned(16))) unsigned char lds_raw[];
    LAS unsigned char* lds = (LAS unsigned char*)lds_raw;
    const int bid0 = blockIdx.x, G0 = gridDim.x, wave0 = __builtin_amdgcn_readfirstlane(threadIdx.x >> 6);
#define PH_BG int bid = bid0, G = G0; asm volatile("" : "+s"(bid), "+s"(G));
    volatile LAS unsigned* MISCW = (volatile LAS unsigned*)(lds + MISC_OFF);
    if (threadIdx.x < 32) MISCW[threadIdx.x] = 0u;
    __syncthreads();
    const int ph_lo = kargs()->ph_lo, ph_hi = kargs()->ph_hi;
    const bool multi = (ph_hi - ph_lo) > 1;
    XcdBarrier bar; bar.bar = (unsigned*)(kargs()->ws + OFF_CTL) + CW_BAR; bar.x = 0; bar.st = nullptr; bar.wv = wave0;
    if (multi) bar = xcd_barrier_post((unsigned*)(kargs()->ws + OFF_CTL) + CW_BAR, MISCW + 8, wave0);
#define IN(k) (ph_lo <= (k) && (k) < ph_hi)
#define SEAM(k) do { if (IN(k) && IN((k) + 1)) xcd_barrier(bar); } while (0)

    for (int rep = 0; rep < (PROBE_P0 ? PROBE_REPS : 1); ++rep) {
    if (IN(0)) { PH_BG p0_prologue(kargs(), lds, bid, G, wave0); }
    if (rep + 1 < (PROBE_P0 ? PROBE_REPS : 1)) xcd_barrier(bar); }
    SEAM(0);
    if (IN(1)) { PH_BG KArgs a = kargs(); norm_phase(a, 0, nullptr, a->in[I_NORMG] + 0, nullptr, (const float*)(a->ws + OFF_MODV), bid, G, wave0, TT); }
    SEAM(1);

    for (int l = 0; l < DEPTH; ++l) {
        const int pb = 2 + 10 * l;
#define PH_LOCALS PH_BG KArgs a = kargs(); unsigned char* ws = a->ws; unsigned char* wl = ws + OFF_W + (size_t)l * W_LAYER; bf16* Hb = (bf16*)(ws + OFF_H); (void)wl; (void)Hb; \
        const float* ng = a->in[I_NORMG] + (size_t)l * 4 * DM; const float* mv = (const float*)(ws + OFF_MODV) + (size_t)l * 5 * 12288; (void)ng; (void)mv;
        const bool lastl = (l == DEPTH - 1);
        for (int rep = 0; rep < REPS(0); ++rep) {
        if (IN(pb + 0)) { PH_LOCALS
            __syncthreads();
            pg8::Sched2 S; S.A0 = (const char*)Hb; S.B0 = (const char*)(wl + WO_IN); S.A1 = (const char*)(wl + WO_FFT); S.B1 = (const char*)Hb; S.tstep = (size_t)256 * DM * 2; S.ntk = DM / 64;
            S.t0.init(TT / 256, NU / 256 - GATE_LATE); S.t1.init(4, TT / 256); S.G = G; S.c = bid;
            pg8::EpiIn2 E{pg8::EpiInproj{(bf16*)(ws + OFF_U), (float*)(ws + OFF_MISC), NU}, pg8::EpiBf{0, (bf16*)(ws + OFF_VTL), (bf16*)(ws + OFF_VTC)}};
            pg8::gemm_phase<pg8::EpiIn2, pg8::Sched2, true, true>(lds, DM, S, E, wave0);
        }
        if (rep + 1 < REPS(0)) xcd_barrier(bar); }
        SEAM(pb + 0);
        for (int rep = 0; rep < REPS(1); ++rep) {
        if (IN(pb + 1)) { PH_LOCALS PH_IDS
            __syncthreads();
            if (bid < 64) { pg8::Sched2 S; S.A0 = (const char*)(ws + OFF_DFTL); S.B0 = (const char*)(ws + OFF_VTL); S.A1 = S.A0; S.B1 = S.B0; S.tstep = (size_t)256 * 4096 * 2; S.ntk = 64; S.t0.init(8, 8); S.t1.init(0, 0); S.G = 64; S.c = bid;
                  pg8::EpiBf E{1, (bf16*)(ws + OFF_ACAT), nullptr};
                  pg8::gemm_phase<pg8::EpiBf, pg8::Sched2, true, true>(lds, 4096, S, E, wave0); }
            else if (bid < 72) { pg8::Sched2 S; S.A0 = (const char*)(ws + OFF_DFTC); S.B0 = (const char*)(ws + OFF_VTC); S.A1 = S.A0; S.B1 = S.B0; S.tstep = (size_t)256 * 512 * 2; S.ntk = 8; S.t0.init(1, 8); S.t1.init(0, 0); S.G = 8; S.c = bid - 64;
                  pg8::EpiBf E{2, (bf16*)(ws + OFF_ACAT), nullptr};
                  pg8::gemm_phase<pg8::EpiBf, pg8::Sched2, true, true>(lds, 512, S, E, wave0); }
            __syncthreads();
            {
                unsigned* qctr = (unsigned*)(ws + OFF_CTL) + CW_Q + (l * 4 + rep) * 64;
                volatile LAS unsigned* qslot = (volatile LAS unsigned*)(lds + MISC_OFF) + 16;
                for (;;) {
                    if (tid == 0) qslot[0] = __hip_atomic_fetch_add(qctr, 1u, __ATOMIC_RELAXED, __HIP_MEMORY_SCOPE_AGENT);
                    __syncthreads();
                    const int it = (int)qslot[0];
                    __syncthreads();
                    if (it >= 576 + 288 + 576) break;
                    int ln_i = lane; asm volatile("" : "+v"(ln_i)); const int tid_i = wave * 64 + ln_i;
                    if (it < 576) rwkv_prep_item(a, l, it, lds, tid_i, ln_i, wave);
                    else if (it < 576 + 288) conv_item(a, l, it - 576, lds, tid_i, ln_i, wave);
                    else ssd_prep_item(a, l, it - 576 - 288, tid_i);
                }
            }
        }
        if (rep + 1 < REPS(1)) xcd_barrier(bar); }
        SEAM(pb + 1);
        for (int rep = 0; rep < REPS(2); ++rep) {
        if (IN(pb + 2)) { PH_LOCALS PH_IDS
            __syncthreads();
            if (bid < 128) { if (rep == 0 || PROBE_SUB == 0) rwkv_scan_fast(a, bid, lds, tid, lane, wave); }
            else {
                if (bid < 224) { if (rep == 0 || PROBE_SUB == 1) ssd_scan_fast(a, bid - 128, lds, tid, lane, wave); }
                __syncthreads();
                pg8::Sched2 S; S.A0 = (const char*)Hb; S.B0 = (const char*)(wl + WO_IN); S.A1 = S.A0; S.B1 = S.B0; S.tstep = (size_t)256 * DM * 2; S.ntk = DM / 64;
                S.t0.init(TT / 256, GATE_LATE); S.t1.init(0, 0); S.pn_off0 = NU / 256 - GATE_LATE;
                if (bid >= 224) { S.G = 32; S.c = bid - 224; S.first = 0; S.limit = 192; } else { S.G = 96; S.c = bid - 128; S.first = 192; S.limit = 36 * GATE_LATE; }
                pg8::EpiIn2 E{pg8::EpiInproj{(bf16*)(ws + OFF_U), (float*)(ws + OFF_MISC), NU}, pg8::EpiBf{0, (bf16*)(ws + OFF_VTL), (bf16*)(ws + OFF_VTC)}};
                pg8::gemm_phase<pg8::EpiIn2, pg8::Sched2, true, true>(lds, DM, S, E, wave0);
            }
        }
        if (rep + 1 < REPS(2)) xcd_barrier(bar); }
        SEAM(pb + 2);
        for (int rep = 0; rep < REPS(3); ++rep) {
        if (IN(pb + 3)) { PH_BG post_phase(kargs(), l, bid, G, wave0); }
        if (rep + 1 < REPS(3)) xcd_barrier(bar); }
        SEAM(pb + 3);
        for (int rep = 0; rep < REPS(4); ++rep) {
        if (IN(pb + 4)) { PH_LOCALS
            __syncthreads();
            pg8::Sched2 S; S.A0 = (const char*)(ws + OFF_ACAT); S.B0 = (const char*)(wl + WO_CAT); S.A1 = S.A0; S.B1 = S.B0; S.tstep = (size_t)256 * ACW * 2; S.ntk = ACW / 64;
            S.t0.init(lastl ? TLAT / 256 : TT / 256, DM / 256); S.t1.init(0, 0); S.G = G; S.c = bid;
            pg8::EpiChain E{(const bf16*)(ws + OFF_U) + UGATE, NU, (bf16*)(ws + OFF_M)};
            pg8::gemm_phase<pg8::EpiChain, pg8::Sched2, true, true>(lds, ACW, S, E, wave0);
        }
        if (rep + 1 < REPS(4)) xcd_barrier(bar); }
        SEAM(pb + 4);
        for (int rep = 0; rep < REPS(5); ++rep) {
        if (IN(pb + 5)) { PH_LOCALS
            __syncthreads();
            pg8::SchedSplit S; S.A = (const char*)(ws + OFF_M); S.B = (const char*)(wl + WO_O); S.tstep = (size_t)256 * DM * 2; S.ntk = DM / 64; S.tm.init(32, 8); S.nctx = lastl ? 0 : 256; S.G = G; S.c = bid;
            pg8::EpiF32 E{(float*)(ws + OFF_Y), (float*)(ws + OFF_YC)};
            pg8::gemm_phase<pg8::EpiF32, pg8::SchedSplit, true, true>(lds, DM, S, E, wave0);
        }
        if (rep + 1 < REPS(5)) xcd_barrier(bar); }
        SEAM(pb + 5);
        if (IN(pb + 6)) { PH_LOCALS norm_phase(a, 1, ng + 1 * DM, ng + 2 * DM, mv + 2 * DM, mv + 3 * DM, bid, G, wave0, lastl ? TLAT : TT, !lastl); }
        SEAM(pb + 6);
        for (int rep = 0; rep < REPS(7); ++rep) {
        if (IN(pb + 7)) { PH_LOCALS
            __syncthreads();
            pg8::Sched2 S; S.A0 = (const char*)Hb; S.B0 = (const char*)(wl + WO_UP); S.A1 = S.A0; S.B1 = S.B0; S.tstep = (size_t)256 * DM * 2; S.ntk = DM / 64;
            S.t0.init(lastl ? TLAT / 256 : TT / 256, DFF / 256); S.t1.init(0, 0); S.G = G; S.c = bid;
            pg8::EpiBf E{3, (bf16*)(ws + OFF_HB), nullptr};
            pg8::gemm_phase<pg8::EpiBf, pg8::Sched2, true, true>(lds, DM, S, E, wave0);
        }
        if (rep + 1 < REPS(7)) xcd_barrier(bar); }
        SEAM(pb + 7);
        for (int rep = 0; rep < REPS(8); ++rep) {
        if (IN(pb + 8)) { PH_LOCALS
            __syncthreads();
            pg8::SchedSplit S; S.A = (const char*)(ws + OFF_HB); S.B = (const char*)(wl + WO_DN); S.tstep = (size_t)256 * DFF * 2; S.ntk = DFF / 64; S.tm.init(32, 8); S.nctx = lastl ? 0 : 256; S.G = G; S.c = bid;
            pg8::EpiF32 E{(float*)(ws + OFF_Y), (float*)(ws + OFF_YC)};
            pg8::gemm_phase<pg8::EpiF32, pg8::SchedSplit, true, true>(lds, DFF, S, E, wave0);
        }
        if (rep + 1 < REPS(8)) xcd_barrier(bar); }
        SEAM(pb + 8);
        if (IN(pb + 9)) { PH_LOCALS
            if (!lastl) norm_phase(a, 1, ng + 3 * DM, ng + 4 * DM  , mv + 5 * DM, mv + 5 * 12288  , bid, G, wave0, TT, true);
            else norm_phase(a, 2, ng + 3 * DM, nullptr, mv + 5 * DM, nullptr, bid, G, wave0, TLAT);
        }
        SEAM(pb + 9);
    }
#undef IN
#undef SEAM
}

extern "C" void kernel_launch(void* const* d_in, const int* in_sizes, int n_in, void* d_out, int out_size, void* d_ws, size_t ws_size, hipStream_t stream) {
    static int grid = 0;
    if (grid == 0) {
        if (n_in != N_IN || out_size != TLAT * DM || ws_size < WS_END) { fprintf(stderr, "kernel_launch: unexpected shapes (n_in %d out %d ws %zu); nothing launched\n", n_in, out_size, ws_size); grid = -1; return; }
        int dev = 0, cus = 0;
        if (hipGetDevice(&dev) != hipSuccess || hipDeviceGetAttribute(&cus, hipDeviceAttributeMultiprocessorCount, dev) != hipSuccess) { grid = -1; return; }
        if (hipFuncSetAttribute((const void*)fwd, hipFuncAttributeMaxDynamicSharedMemorySize, LDS_BYTES) != hipSuccess) { fprintf(stderr, "kernel_launch: hipFuncSetAttribute failed\n"); grid = -1; return; }
        int per_cu = 0;
        if (hipOccupancyMaxActiveBlocksPerMultiprocessor(&per_cu, (const void*)fwd, NTHR, LDS_BYTES) != hipSuccess || per_cu < 1) fprintf(stderr, "kernel_launch: occupancy query says %d\n", per_cu);
        (void)hipGetLastError();
        grid = cus;
        if (grid < 232) { fprintf(stderr, "kernel_launch: %d CUs: this kernel's scan phase needs > 160 workgroups\n", grid); grid = -1; return; }
    }
    if (grid < 0) return;
    if (hipMemsetAsync((char*)d_ws + OFF_CTL, 0, CTL_BYTES, stream) != hipSuccess) return;
    Args a{};
    for (int i = 0; i < N_IN; ++i) a.in[i] = (const float*)d_in[i];
    a.out = (float*)d_out; a.ws = (unsigned char*)d_ws;
#if MK_ONE_LAUNCH
    a.ph_lo = 0; a.ph_hi = NPH;
    hipLaunchKernelGGL(fwd, dim3(grid), dim3(NTHR), LDS_BYTES, stream, a);
#else
    for (int p = 0; p < NPH; ++p) { a.ph_lo = p; a.ph_hi = p + 1; hipLaunchKernelGGL(fwd, dim3(grid), dim3(NTHR), LDS_BYTES, stream, a); }
#endif
}
```

```cpp
#include <hip/hip_runtime.h>
#include <cstdio>
#include <cstdint>
namespace pg8 {
#define PG8_LAS __attribute__((address_space(3)))
typedef unsigned short bf16_t;
typedef short bf16x8 __attribute__((ext_vector_type(8)));
typedef float f32x4 __attribute__((ext_vector_type(4)));
typedef unsigned u32x4 __attribute__((ext_vector_type(4)));
constexpr int BM = 256, BK = 64, HALF = 128, HTB = HALF * BK * 2  , STAGE_BYTES = 8 * HTB, NXCD = 8, WGM = 8;

__host__ __device__ __forceinline__ int lds_byte(int r, int c) { const int st = (r >> 4) * 2 + (c >> 5), rr = r & 15, cc = c & 31, ob = rr * 64 + cc * 2; return st * 1024 + (ob ^ (((ob >> 9) & 1) << 5)); }
__host__ __device__ __forceinline__ void stage_rc(int b, int& R, int& C) { const int st = b / 1024, sb = b % 1024, swz = sb ^ (((sb >> 9) & 1) << 5); R = (st >> 1) * 16 + swz / 64; C = (st & 1) * 32 + (swz % 64) / 2; }
__host__ __device__ __forceinline__ int perm32(int rho) { const int n = rho >> 4, i = rho & 15; return 8 * (i >> 2) + 4 * n + (i & 3); }

struct Unit { int pm, pn, kind; };
struct Gemm { const bf16_t* A; const bf16_t* Bt; int M, N, K; };

struct StaticOrder {
    int nM, nN, nwg, G, c;
    __host__ __device__ void init(int M, int N, int G_, int c_) { nM = M / BM; nN = N / BM; nwg = nM * nN; G = G_; c = c_; }
    __host__ __device__ bool next(int i, Unit& u) const {
        const long L = (long)i * G + c; if (L >= nwg) return false;
        int wgid = (int)L; { const int q = nwg / NXCD, r = nwg % NXCD, xcd = wgid % NXCD, off = wgid / NXCD; wgid = (xcd < r ? xcd * (q + 1) : r * (q + 1) + (xcd - r) * q) + off; }
        const int nig = WGM * nN, gid = wgid / nig, fm = gid * WGM, gsz = (nM - fm) < WGM ? (nM - fm) : WGM;
        u.pm = fm + ((wgid % nig) % gsz); u.pn = (wgid % nig) / gsz; return true;
    }
    __device__ __forceinline__ void a_ready(const Unit&) const {}
    __device__ __forceinline__ void done(const Unit&) const {}
};
__device__ __forceinline__ unsigned cvt_pk_bf16(float lo, float hi) { unsigned r; asm volatile("v_cvt_pk_bf16_f32 %0, %1, %2" : "=v"(r) : "v"(lo), "v"(hi)); return r; }
typedef float f32x2 __attribute__((ext_vector_type(2)));
template <class Epi, class Sched, bool ALIGN_EPI = false, bool SP2 = false>
__device__ __forceinline__ void gemm_phase(PG8_LAS unsigned char* lds, const int ldk  , const Sched& S, const Epi& E, const int wave_id) {
    unsigned z_ = 0u; asm volatile("" : "+v"(z_)); const int lane_ = (int)__builtin_amdgcn_mbcnt_hi(~0u, __builtin_amdgcn_mbcnt_lo(~0u, z_)); int wid_ = wave_id; asm volatile("" : "+s"(wid_)); const int wid = wid_, lane = lane_, tid = wid * 64 + lane, wr = wid >> 2, wc = wid & 3, fr = lane & 15, fq = lane >> 4;
    const int K = ldk; int nt;
    unsigned voffA[2], voffB[2];
#pragma unroll
    for (int i = 0; i < 2; ++i) { int R, C; stage_rc(tid * 16 + i * 8192, R, C); const int Rb = Epi::PERM ? ((R & ~31) + perm32(R & 31)) : R;
        voffA[i] = (unsigned)(R * K + C) * 2u; voffB[i] = (unsigned)(Rb * K + C) * 2u; }
    const size_t kstep = (size_t)(BK * 2);
    const size_t hstep = (size_t)HALF * K * 2;
    const unsigned ldsw = (unsigned)wid * 1024u;
    const int aoff = lds_byte(wr * 64 + fr, fq * 8), boff = lds_byte(wc * 32 + fr, fq * 8);
#define PG8_SA(b, h) (((b) * 2 + (h)) * HTB)
#define PG8_SB(b, h) ((4 + (b) * 2 + (h)) * HTB)
#define PG8_STAGE(bufoff, gbase, voff) do { _Pragma("unroll") for (int _i = 0; _i < 2; ++_i) \
        __builtin_amdgcn_global_load_lds((const unsigned*)((const char*)(gbase) + (voff)[_i]), (PG8_LAS unsigned*)(lds + (bufoff) + ldsw + _i * 8192), 16, 0, 0); } while (0)
#define PG8_LDA(dst, b, h) do { _Pragma("unroll") for (int m = 0; m < 4; ++m) _Pragma("unroll") for (int k = 0; k < 2; ++k) dst[m][k] = *(const PG8_LAS bf16x8*)(lds + PG8_SA(b, h) + aoff + m * 2048 + k * 1024); } while (0)
#define PG8_LDB(dst, b, h) do { _Pragma("unroll") for (int n = 0; n < 2; ++n) _Pragma("unroll") for (int k = 0; k < 2; ++k) dst[n][k] = *(const PG8_LAS bf16x8*)(lds + PG8_SB(b, h) + boff + n * 2048 + k * 1024); } while (0)
#define PG8_MMA(ai, bj, At, Bt) do { __builtin_amdgcn_s_setprio(1); _Pragma("unroll") for (int m = 0; m < 4; ++m) _Pragma("unroll") for (int n = 0; n < 2; ++n) _Pragma("unroll") for (int k = 0; k < 2; ++k) \
        acc[ai][bj][m][n] = __builtin_amdgcn_mfma_f32_16x16x32_bf16(Bt[n][k], At[m][k], acc[ai][bj][m][n], 0, 0, 0); __builtin_amdgcn_s_setprio(0); } while (0)
#define PG8_WAIT_V(n) asm volatile("s_waitcnt vmcnt(" #n ")" ::: "memory")
#define PG8_WAIT_L(n) asm volatile("s_waitcnt lgkmcnt(" #n ")" ::: "memory")
#define PG8_BAR __builtin_amdgcn_s_barrier()
#define PG8_SCHED __builtin_amdgcn_sched_barrier(0)
    Unit cur, nxt; int ui = 0;
    if (!S.next(0, cur)) return;
    f32x4 acc[2][2][4][2];
#pragma unroll
    for (int a = 0; a < 2; ++a)
#pragma unroll
        for (int b = 0; b < 2; ++b)
#pragma unroll
            for (int m = 0; m < 4; ++m)
#pragma unroll
                for (int n = 0; n < 2; ++n) acc[a][b][m][n] = (f32x4){0.f, 0.f, 0.f, 0.f};
    bf16x8 At[4][2], B0[2][2], B1[2][2];
    const char* cA = S.abase(cur); const char* cB = S.bbase(cur); nt = S.nt(cur);
    S.a_ready(cur);
    if constexpr (SP2) {
        PG8_STAGE(PG8_SB(0, 0), cB, voffB); PG8_STAGE(PG8_SB(0, 1), cB + hstep, voffB); PG8_STAGE(PG8_SA(0, 0), cA, voffA); PG8_STAGE(PG8_SA(0, 1), cA + hstep, voffA);
        if (wr == 1) PG8_BAR;
        PG8_WAIT_V(2); PG8_BAR;
        PG8_STAGE(PG8_SB(1, 0), cB + kstep, voffB); PG8_STAGE(PG8_SA(1, 0), cA + kstep, voffA); PG8_STAGE(PG8_SB(1, 1), cB + hstep + kstep, voffB);
        PG8_WAIT_V(6); PG8_BAR;
    } else {
        PG8_STAGE(PG8_SB(0, 0), cB, voffB); PG8_STAGE(PG8_SA(0, 0), cA, voffA); PG8_STAGE(PG8_SB(0, 1), cB + hstep, voffB); PG8_STAGE(PG8_SA(0, 1), cA + hstep, voffA);
        if (wr == 1) PG8_BAR;
        PG8_WAIT_V(4); PG8_BAR;
        PG8_STAGE(PG8_SB(1, 0), cB + kstep, voffB); PG8_STAGE(PG8_SA(1, 0), cA + kstep, voffA); PG8_STAGE(PG8_SB(1, 1), cB + hstep + kstep, voffB);
        PG8_WAIT_V(6); PG8_BAR;
    }
    for (;;) {
        const bool has_next = S.next(ui + 1, nxt);
        const char* nA = has_next ? S.abase(nxt) : cA; const char* nB = has_next ? S.bbase(nxt) : cB;
        for (int t = 0; t < nt; t += 2) {
            const bool last = (t == nt - 2);
            const char* a1 = cA + (size_t)(t + 1) * kstep;
            const char* a2 = last ? nA : cA + (size_t)(t + 2) * kstep; const char* b2 = last ? nB : cB + (size_t)(t + 2) * kstep;
            const char* a3 = a2 + kstep; const char* b3 = b2 + kstep;
            if (last && has_next) S.a_ready(nxt);
            if constexpr (Epi::HOOK) E.khook(acc, cur, t, wr, wc, fr, fq);
            if constexpr (SP2) {
            PG8_LDB(B0, 0, 0); PG8_LDB(B1, 0, 1); PG8_SCHED; PG8_LDA(At, 0, 0); PG8_STAGE(PG8_SA(1, 1), a1 + hstep, voffA);
            PG8_WAIT_V(8); PG8_WAIT_L(0); PG8_BAR; PG8_MMA(0, 0, At, B0); PG8_MMA(0, 1, At, B1); PG8_BAR; PG8_SCHED;
            PG8_LDA(At, 0, 1); PG8_STAGE(PG8_SB(0, 0), b2, voffB); PG8_STAGE(PG8_SB(0, 1), b2 + hstep, voffB); PG8_STAGE(PG8_SA(0, 0), a2, voffA);
            PG8_WAIT_V(8); PG8_WAIT_L(0); PG8_BAR; PG8_MMA(1, 0, At, B0); PG8_MMA(1, 1, At, B1); PG8_BAR; PG8_SCHED;
            PG8_LDB(B0, 1, 0); PG8_LDB(B1, 1, 1); PG8_SCHED; PG8_LDA(At, 1, 0); PG8_STAGE(PG8_SA(0, 1), a2 + hstep, voffA);
            PG8_WAIT_V(8); PG8_WAIT_L(0); PG8_BAR; PG8_MMA(0, 0, At, B0); PG8_MMA(0, 1, At, B1); PG8_BAR; PG8_SCHED;
            PG8_LDA(At, 1, 1); PG8_STAGE(PG8_SB(1, 0), b3, voffB); PG8_STAGE(PG8_SB(1, 1), b3 + hstep, voffB); PG8_STAGE(PG8_SA(1, 0), a3, voffA);
            PG8_WAIT_V(8); PG8_WAIT_L(0); PG8_BAR; PG8_MMA(1, 0, At, B0); PG8_MMA(1, 1, At, B1); PG8_BAR; PG8_SCHED;
            } else {
            PG8_LDB(B0, 0, 0); PG8_SCHED; PG8_LDA(At, 0, 0); PG8_STAGE(PG8_SA(1, 1), a1 + hstep, voffA);
            PG8_WAIT_L(8); PG8_BAR; PG8_WAIT_L(0); PG8_MMA(0, 0, At, B0); PG8_BAR; PG8_SCHED;
            PG8_LDB(B1, 0, 1); PG8_STAGE(PG8_SB(0, 0), b2, voffB);
            PG8_BAR; PG8_WAIT_L(0); PG8_MMA(0, 1, At, B1); PG8_BAR;
            PG8_LDA(At, 0, 1); PG8_STAGE(PG8_SA(0, 0), a2, voffA);
            PG8_BAR; PG8_WAIT_L(0); PG8_MMA(1, 0, At, B0); PG8_BAR; PG8_SCHED;
            PG8_STAGE(PG8_SB(0, 1), b2 + hstep, voffB);
            PG8_WAIT_V(6); PG8_BAR; PG8_MMA(1, 1, At, B1); PG8_BAR;
            PG8_LDB(B0, 1, 0); PG8_SCHED; PG8_LDA(At, 1, 0); PG8_STAGE(PG8_SA(0, 1), a2 + hstep, voffA);
            PG8_WAIT_L(8); PG8_BAR; PG8_WAIT_L(0); PG8_MMA(0, 0, At, B0); PG8_BAR; PG8_SCHED;
            PG8_LDB(B1, 1, 1); PG8_STAGE(PG8_SB(1, 0), b3, voffB);
            PG8_BAR; PG8_WAIT_L(0); PG8_MMA(0, 1, At, B1); PG8_BAR;
            PG8_LDA(At, 1, 1); PG8_STAGE(PG8_SA(1, 0), a3, voffA);
            PG8_BAR; PG8_WAIT_L(0); PG8_MMA(1, 0, At, B0); PG8_BAR; PG8_SCHED;
            PG8_STAGE(PG8_SB(1, 1), b3 + hstep, voffB);
            PG8_WAIT_V(6); PG8_BAR; PG8_MMA(1, 1, At, B1); PG8_BAR;
            }
        }
        if constexpr (ALIGN_EPI) { if (wr == 0) PG8_BAR; }
        if constexpr (!Epi::AFTER_DRAIN) { E(acc, cur, wr, wc, fr, fq); S.done(cur); }
        if (!has_next) break;
#pragma unroll
        for (int a = 0; a < 2; ++a)
#pragma unroll
            for (int b = 0; b < 2; ++b)
#pragma unroll
                for (int m = 0; m < 4; ++m)
#pragma unroll
                    for (int n = 0; n < 2; ++n) acc[a][b][m][n] = (f32x4){0.f, 0.f, 0.f, 0.f};
        cur = nxt; cA = nA; cB = nB; ++ui; nt = S.nt(cur);
        if constexpr (ALIGN_EPI) { if (wr == 1) PG8_BAR; }
    }
    PG8_WAIT_V(0);
    if constexpr (!ALIGN_EPI) { if (wr == 0) PG8_BAR; }
    PG8_BAR;
    if constexpr (Epi::AFTER_DRAIN) { E.fused(acc, cur, wr, wc, fr, fq, lds, wid, lane); S.done(cur); }
#undef PG8_SA
#undef PG8_SB
#undef PG8_STAGE
#undef PG8_LDA
#undef PG8_LDB
#undef PG8_MMA
#undef PG8_WAIT_V
#undef PG8_WAIT_L
#undef PG8_BAR
#undef PG8_SCHED
}
}

namespace pg8 {
__device__ __forceinline__ float sigm(float x) { return __builtin_amdgcn_rcpf(1.f + __expf(-x)); }
__device__ __forceinline__ f32x4 sigm4(f32x4 v) { return (f32x4){sigm(v[0]), sigm(v[1]), sigm(v[2]), sigm(v[3])}; }
__device__ __forceinline__ u32x4 pack8(f32x4 v0, f32x4 v1) { u32x4 w; w.x = cvt_pk_bf16(v0[0], v0[1]); w.y = cvt_pk_bf16(v0[2], v0[3]); w.z = cvt_pk_bf16(v1[0], v1[1]); w.w = cvt_pk_bf16(v1[2], v1[3]); return w; }
__device__ __forceinline__ float bflo(unsigned u) { return __uint_as_float(u << 16); }
__device__ __forceinline__ float bfhi(unsigned u) { return __uint_as_float(u & 0xffff0000u); }


struct TileMap {
    int nM, nN, nwg;
    __device__ __forceinline__ void init(int nM_, int nN_) { nM = nM_; nN = nN_; nwg = nM_ * nN_; }
    __device__ __forceinline__ void map(int L, int& pm, int& pn) const {
        int wgid = L; { const int q = nwg / NXCD, r = nwg % NXCD, xcd = wgid % NXCD, off = wgid / NXCD; wgid = (xcd < r ? xcd * (q + 1) : r * (q + 1) + (xcd - r) * q) + off; }
        const int nig = WGM * nN, gid = wgid / nig, fm = gid * WGM, gsz = (nM - fm) < WGM ? (nM - fm) : WGM;
        pm = fm + ((wgid % nig) % gsz); pn = (wgid % nig) / gsz;
    }
};
struct Sched2 {
    const char *A0, *B0, *A1, *B1; size_t tstep; int ntk; TileMap t0, t1; int G, c;
    int pn_off0 = 0, first = 0, limit = 0x7fffffff;
    __device__ __forceinline__ bool next(int i, Unit& u) const { const int L = first + i * G + c;
        if (L >= limit) return false;
        if (L < t0.nwg) { t0.map(L, u.pm, u.pn); u.pn += pn_off0; u.kind = 0; return true; }
        if (L - t0.nwg < t1.nwg) { t1.map(L - t0.nwg, u.pm, u.pn); u.kind = 1; return true; }
        return false; }
    __device__ __forceinline__ const char* abase(const Unit& u) const { return (u.kind ? A1 : A0) + (size_t)u.pm * tstep; }
    __device__ __forceinline__ const char* bbase(const Unit& u) const { return (u.kind ? B1 : B0) + (size_t)u.pn * tstep; }
    __device__ __forceinline__ int nt(const Unit&) const { return ntk; }
    __device__ __forceinline__ void a_ready(const Unit&) const {}
    __device__ __forceinline__ void done(const Unit&) const {}
};
struct SchedSplit {
    const char *A, *B; size_t tstep; int ntk; TileMap tm; int nctx, G, c;
    __device__ __forceinline__ bool next(int i, Unit& u) const { const int L = i * G + c;
        if (L < 256) { tm.map(L, u.pm, u.pn); u.kind = 0; return true; }
        const int e = L - 256; if (e < nctx) { const int tile = e & 31; u.pm = 32 + (tile >> 3); u.pn = tile & 7; u.kind = 1 + (e >> 5); return true; }
        return false; }
    __device__ __forceinline__ const char* abase(const Unit& u) const { return A + (size_t)u.pm * tstep + (u.kind ? (size_t)(u.kind - 1) * (ntk / 8) * 128 : 0); }
    __device__ __forceinline__ const char* bbase(const Unit& u) const { return B + (size_t)u.pn * tstep + (u.kind ? (size_t)(u.kind - 1) * (ntk / 8) * 128 : 0); }
    __device__ __forceinline__ int nt(const Unit& u) const { return u.kind ? ntk / 8 : ntk; }
    __device__ __forceinline__ void a_ready(const Unit&) const {}
    __device__ __forceinline__ void done(const Unit&) const {}
};
struct EpiInproj {
    static constexpr bool PERM = true, AFTER_DRAIN = false, HOOK = false;
    bf16_t* U; float* MISC; int ldu;
    __device__ __forceinline__ void operator()(const f32x4 (&acc)[2][2][4][2], const Unit& u, int wr, int wc, int fr, int fq) const {
        const int row0 = u.pm * BM + wr * 64 + fr, cl = wc * 32 + 8 * fq;
        if (u.pn == 16 || u.pn == 17) {
#pragma unroll
            for (int ai = 0; ai < 2; ++ai)
#pragma unroll
                for (int m = 0; m < 4; ++m) { float* rowp = MISC + (size_t)(row0 + ai * HALF + m * 16) * 512 + (u.pn - 16) * BM + cl;
#pragma unroll
                    for (int bj = 0; bj < 2; ++bj) { *(f32x4*)(rowp + bj * HALF) = acc[ai][bj][m][0]; *(f32x4*)(rowp + bj * HALF + 4) = acc[ai][bj][m][1]; } }
        } else {
            const bool sg = u.pn >= 22;
#pragma unroll
            for (int ai = 0; ai < 2; ++ai)
#pragma unroll
                for (int m = 0; m < 4; ++m) { bf16_t* rowp = U + (size_t)(row0 + ai * HALF + m * 16) * ldu + u.pn * BM + cl;
#pragma unroll
                    for (int bj = 0; bj < 2; ++bj) { f32x4 v0 = acc[ai][bj][m][0], v1 = acc[ai][bj][m][1];
                        if (sg) { v0 = sigm4(v0); v1 = sigm4(v1); }
                        *(u32x4*)(rowp + bj * HALF) = pack8(v0, v1); } }
        }
    }
};
struct EpiBf {
    static constexpr bool PERM = true, AFTER_DRAIN = false, HOOK = false;
    int kind; bf16_t* O0; bf16_t* O1;
    __device__ __forceinline__ void operator()(const f32x4 (&acc)[2][2][4][2], const Unit& u, int wr, int wc, int fr, int fq) const {
        bf16_t* base; size_t pitch;
        if (kind == 0) {
            const int half = u.pm >> 1, chb = (u.pm & 1) * 256;
            if (u.pn < 32) { const int b = u.pn >> 3, l0 = (u.pn & 7) * 256; pitch = 4096; base = O0 + ((size_t)(b * 512 + chb) * 2 + half) * 2048 + l0; }
            else { const int b = u.pn - 32; pitch = 512; base = O1 + ((size_t)(b * 512 + chb) * 2 + half) * 256; }
        } else if (kind == 1) { const int b = u.pn >> 1; pitch = 2304; base = O0 + (size_t)(b * 2048 + u.pm * 256) * 2304 + 1280 + (u.pn & 1) * 256; }
        else if (kind == 2) { const int b = u.pn >> 1; pitch = 2304; base = O0 + (size_t)(8192 + b * 256) * 2304 + 1280 + (u.pn & 1) * 256; }
        else { pitch = 8192; base = O0 + (size_t)(u.pm * 256) * 8192 + u.pn * 256; }
        const int r0 = wr * 64 + fr, cl = wc * 32 + 8 * fq;
#pragma unroll
        for (int ai = 0; ai < 2; ++ai)
#pragma unroll
            for (int m = 0; m < 4; ++m) { bf16_t* rowp = base + (size_t)(r0 + ai * HALF + m * 16) * pitch + cl;
#pragma unroll
                for (int bj = 0; bj < 2; ++bj) { f32x4 v0 = acc[ai][bj][m][0], v1 = acc[ai][bj][m][1];
                    if (kind == 3) { v0 = __builtin_elementwise_max(v0, (f32x4){0.f, 0.f, 0.f, 0.f}); v1 = __builtin_elementwise_max(v1, (f32x4){0.f, 0.f, 0.f, 0.f}); v0 = v0 * v0; v1 = v1 * v1; }
                    *(u32x4*)(rowp + bj * HALF) = pack8(v0, v1); } }
    }
};
struct EpiChain {
    static constexpr bool PERM = true, AFTER_DRAIN = false, HOOK = true;
    const bf16_t* G; int ldg; bf16_t* Mo;
    __device__ __forceinline__ void khook(f32x4 (&acc)[2][2][4][2], const Unit& u, int t, int wr, int wc, int fr, int fq) const {
        if (t != 8 && t != 20 && t != 28) return;
        const int i = (t == 8) ? 0 : (t == 20 ? 1 : 2);
        int row0 = u.pm * BM + wr * 64 + fr; const int col0 = u.pn * BM + wc * 32 + 8 * fq + i * 2048;
        asm volatile("" : "+v"(row0));
#pragma unroll
        for (int ai = 0; ai < 2; ++ai)
#pragma unroll
            for (int m = 0; m < 4; ++m) { const bf16_t* gp = G + (size_t)(row0 + ai * HALF + m * 16) * ldg + col0;
#pragma unroll
                for (int bj = 0; bj < 2; ++bj) { const u32x4 g = *(const u32x4*)(gp + bj * HALF), h = *(const u32x4*)(gp + bj * HALF + 2048);
                    const unsigned gw[4] = {g.x, g.y, g.z, g.w}, hw[4] = {h.x, h.y, h.z, h.w};
#pragma unroll
                    for (int e2 = 0; e2 < 4; ++e2) { const float r0 = fmaxf(bflo(gw[e2]), 1e-6f) * __builtin_amdgcn_rcpf(fmaxf(bflo(hw[e2]), 1e-6f)), r1 = fmaxf(bfhi(gw[e2]), 1e-6f) * __builtin_amdgcn_rcpf(fmaxf(bfhi(hw[e2]), 1e-6f));
                        acc[ai][bj][m][e2 >> 1][(e2 & 1) * 2] *= r0; acc[ai][bj][m][e2 >> 1][(e2 & 1) * 2 + 1] *= r1; } }
                asm volatile("" ::: "memory"); }
    }
    __device__ __forceinline__ void operator()(const f32x4 (&acc)[2][2][4][2], const Unit& u, int wr, int wc, int fr, int fq) const {
        const int row0 = u.pm * BM + wr * 64 + fr, col0 = u.pn * BM + wc * 32 + 8 * fq;
#pragma unroll
        for (int ai = 0; ai < 2; ++ai)
#pragma unroll
            for (int m = 0; m < 4; ++m) { const size_t row = (size_t)(row0 + ai * HALF + m * 16);
#pragma unroll
                for (int bj = 0; bj < 2; ++bj) { const int col = col0 + bj * HALF;
                    const u32x4 g = *(const u32x4*)(G + row * ldg + col + 3 * 2048);
                    const f32x4 v0 = acc[ai][bj][m][0] * (f32x4){fmaxf(bflo(g.x), 1e-6f), fmaxf(bfhi(g.x), 1e-6f), fmaxf(bflo(g.y), 1e-6f), fmaxf(bfhi(g.y), 1e-6f)};
                    const f32x4 v1 = acc[ai][bj][m][1] * (f32x4){fmaxf(bflo(g.z), 1e-6f), fmaxf(bfhi(g.z), 1e-6f), fmaxf(bflo(g.w), 1e-6f), fmaxf(bfhi(g.w), 1e-6f)};
                    *(u32x4*)(Mo + row * 2048 + col) = pack8(v0, v1); } }
    }
};
struct EpiF32 {
    static constexpr bool PERM = false, AFTER_DRAIN = false, HOOK = false;
    float* C; float* YC;
    __device__ __forceinline__ void operator()(const f32x4 (&acc)[2][2][4][2], const Unit& u, int wr, int wc, int fr, int fq) const {
        const int row0 = u.pm * BM + wr * 64 + fr, col0 = u.pn * BM + wc * 32 + 4 * fq;
        float* base = u.kind ? (YC + (size_t)(u.kind - 1) * 1024 * 2048 + (size_t)(row0 - 8192) * 2048) : (C + (size_t)row0 * 2048);
#pragma unroll
        for (int ai = 0; ai < 2; ++ai)
#pragma unroll
            for (int m = 0; m < 4; ++m) { float* rowp = base + (size_t)(ai * HALF + m * 16) * 2048 + col0;
#pragma unroll
                for (int bj = 0; bj < 2; ++bj)
#pragma unroll
                    for (int n = 0; n < 2; ++n) *(f32x4*)(rowp + bj * HALF + n * 16) = acc[ai][bj][m][n]; }
    }
};
struct EpiIn2 {
    static constexpr bool PERM = true, AFTER_DRAIN = false, HOOK = false;
    EpiInproj e0; EpiBf e1;
    __device__ __forceinline__ void operator()(const f32x4 (&acc)[2][2][4][2], const Unit& u, int wr, int wc, int fr, int fq) const { if (u.kind == 0) e0(acc, u, wr, wc, fr, fq); else e1(acc, u, wr, wc, fr, fq); }
};
}

#define GAS __attribute__((address_space(1)))
#define LAS __attribute__((address_space(3)))
typedef unsigned short bf16;
typedef unsigned v4u __attribute__((ext_vector_type(4)));
typedef unsigned v2u __attribute__((ext_vector_type(2)));
typedef float f32x4 __attribute__((ext_vector_type(4)));
typedef float f32x2 __attribute__((ext_vector_type(2)));
constexpr int NWAVES = 8, NTHR = 512;
constexpr int DM = 2048, NBATCH = 4, LSEQ = 2048, LCTX = 256, DEPTH = 4;
constexpr int TLAT = NBATCH * LSEQ, TCTX = NBATCH * LCTX, TT = TLAT + TCTX;
constexpr int IN_DIM = 14168, DFF = 8192;
constexpr int NU = 13824;
constexpr int UZ = 0, UXBC = 768, URKV = 2560, UMISC = 4096, UCONV = 4608, UGATE = 5632;
constexpr int S_RKV = 2584, S_DT = 2560, S_WF = 4120, S_CONV = 4440, S_FFT = 5464, S_GATE = 5976;
constexpr int RJ = LCTX + LSEQ;
enum { I_X = 0, I_C, I_CTX, I_CCTX, I_MODW, I_MODB, I_NORMG, I_WIN, I_CONVW, I_CONVB, I_CLNG, I_CLNB, I_CONVOUT, I_SCW, I_SCB, I_SALOG, I_SDTB, I_SD, I_SNG, I_SOUT,
       I_FOUT, I_RMU, I_RW0, I_RW2, I_RA0, I_RA2, I_RG2, I_RKK, I_RKA, I_RRK, I_RLNG, I_RLNB, I_ROUT, I_WO, I_UP, I_DOWN, N_IN };
constexpr size_t MiB = 1u << 20;
constexpr size_t OFF_CTL = 0, CTL_BYTES = 1 * MiB;
constexpr size_t OFF_MODV = 1 * MiB;
constexpr size_t OFF_DFTL = 2 * MiB;
constexpr size_t OFF_DFTC = 18 * MiB;
constexpr size_t OFF_W = 20 * MiB, W_LAYER = 139 * MiB;
constexpr size_t WO_IN = 0, WO_FFT = 54 * MiB, WO_CAT = 58 * MiB  , WO_O = 67 * MiB, WO_UP = 75 * MiB, WO_DN = 107 * MiB;
constexpr size_t OFF_X = 576 * MiB;
constexpr size_t OFF_H = 648 * MiB;
constexpr size_t OFF_U = 684 * MiB;
constexpr size_t OFF_HB = OFF_U;
constexpr size_t OFF_MISC = 927 * MiB;
constexpr size_t OFF_VTL = 945 * MiB;
constexpr size_t OFF_VTC = 961 * MiB;
constexpr size_t OFF_ACAT = 963 * MiB;
constexpr int AC_CONV = 0, AC_SSD = 512, AC_FFT = 1280, AC_RWKV = 1792, ACW = 2304;
constexpr size_t OFF_XBC = 1004 * MiB;
constexpr size_t OFF_DTA = 1036 * MiB;
constexpr size_t OFF_YSSD = 1038 * MiB;
constexpr size_t OFF_RW = 1092 * MiB, RW_ARR = 18 * MiB;
constexpr size_t OFF_RSC = 1254 * MiB;
constexpr size_t OFF_YRW = 1255 * MiB;
constexpr size_t OFF_MBUF = 1291 * MiB;
constexpr size_t OFF_M = 1363 * MiB;
constexpr size_t OFF_Y = 1399 * MiB;
constexpr size_t OFF_WLT = 1471 * MiB;
constexpr size_t OFF_YC = 1473 * MiB;
constexpr size_t WS_END = 1537 * MiB;
constexpr int CW_Q = 8192;
constexpr int CW_BAR = 4096;
constexpr int RING_BYTES = 131072, MISC_OFF = RING_BYTES + 320, LDS_BYTES = 147456;

__device__ __forceinline__ float bf2f(unsigned short b) { return __uint_as_float((unsigned)b << 16); }
__device__ __forceinline__ float bflo(unsigned u) { return __uint_as_float(u << 16); }
__device__ __forceinline__ float bfhi(unsigned u) { return __uint_as_float(u & 0xffff0000u); }
__device__ __forceinline__ unsigned f2bf(float f) { unsigned u = __builtin_bit_cast(unsigned, f); return (u + 0x7fffu + ((u >> 16) & 1u)) >> 16; }
__device__ __forceinline__ unsigned pk2(float lo, float hi) { return f2bf(lo) | (f2bf(hi) << 16); }
__device__ __forceinline__ float sigmoidf_(float x) { return 1.f / (1.f + __expf(-x)); }
__device__ __forceinline__ float siluf_(float x) { return x / (1.f + __expf(-x)); }
__device__ __forceinline__ float softplusf_(float x) { return fmaxf(x, 0.f) + log1pf(__expf(-fabsf(x))); }
template <int CTRL> __device__ __forceinline__ float dpp_add(float x) { return x + __int_as_float(__builtin_amdgcn_update_dpp(0, __float_as_int(x), CTRL, 0xf, 0xf, true)); }
__device__ __forceinline__ float sum8(float x) { x = dpp_add<0xB1>(x); x = dpp_add<0x4E>(x); x = dpp_add<0x141>(x); return x; }
__device__ __forceinline__ float row16_sum(float x) { x = sum8(x); x = dpp_add<0x140>(x); return x; }
__device__ __forceinline__ float wave_sum(float v) {
    const float r = row16_sum(v);
    return (__int_as_float(__builtin_amdgcn_readlane(__float_as_int(r), 0)) + __int_as_float(__builtin_amdgcn_readlane(__float_as_int(r), 16))) +
           (__int_as_float(__builtin_amdgcn_readlane(__float_as_int(r), 32)) + __int_as_float(__builtin_amdgcn_readlane(__float_as_int(r), 48)));
}
#define LDS_WAIT() asm volatile("s_waitcnt lgkmcnt(0)" ::: "memory")

struct Args { const float* in[N_IN]; float* out; unsigned char* ws; int ph_lo, ph_hi; };
typedef const __attribute__((address_space(4))) Args* KArgs;
__device__ __forceinline__ KArgs kargs() { KArgs p = (KArgs)__builtin_amdgcn_kernarg_segment_ptr(); asm volatile("" : "+s"(p)); return p; }
#define PH_IDS unsigned z_ = 0u; asm volatile("" : "+v"(z_)); const int lane_ = (int)__builtin_amdgcn_mbcnt_hi(~0u, __builtin_amdgcn_mbcnt_lo(~0u, z_)); int wv_ = wave0; asm volatile("" : "+s"(wv_)); const int lane = lane_, wave = wv_, tid = wv_ * 64 + lane_; (void)lane; (void)wave; (void)tid;

__device__ __forceinline__ int inmap(int n) {
    if (n < 2560) return n;
    if (n < 4096) return S_RKV + (n - 2560);
    if (n < 4608) { const int m = n - 4096; if (m < 24) return S_DT + m; if (m < 64) return -1; if (m < 384) return S_WF + (m - 64); return -1; }
    if (n < 5632) return S_CONV + (n - 4608);
    return S_GATE + (n - 5632);
}
__device__ __forceinline__ int rwkv_tok(int b, int j) { if (j < LCTX) return TLAT + b * LCTX + j; const int s = j - LCTX; return b * LSEQ + (s & 31) * 64 + (s >> 5); }

__device__ __forceinline__ void transpose_item(const float* W, int ldw, int Nsrc, bf16* WT, int k0, int n0, bool mapped, LAS float* scr, int lane, int koff = 0) {
    const int nn = lane & 31; const int sc = mapped ? inmap(n0 + nn) : (n0 + nn);
    float v[32];
#pragma unroll
    for (int i = 0; i < 32; ++i) { const int kk = 2 * i + (lane >> 5); v[i] = (sc >= 0) ? W[(size_t)(k0 + kk) * Nsrc + sc] : 0.f; }
#pragma unroll
    for (int i = 0; i < 32; ++i) { const int kk = 2 * i + (lane >> 5); scr[kk * 33 + nn] = v[i]; }
    LDS_WAIT();
    const int c = lane & 7;
#pragma unroll
    for (int j = 0; j < 4; ++j) { const int n = (lane >> 3) + 8 * j; const LAS float* s = scr + (8 * c) * 33 + n;
        v4u o; o.x = pk2(s[0 * 33], s[1 * 33]); o.y = pk2(s[2 * 33], s[3 * 33]); o.z = pk2(s[4 * 33], s[5 * 33]); o.w = pk2(s[6 * 33], s[7 * 33]);
        *(v4u*)(WT + (size_t)(n0 + n) * ldw + koff + k0 + 8 * c) = o; }
    LDS_WAIT();
}
constexpr int IT_IN = 32 * (NU / 32), IT_CO = 8 * 64, IT_SO = 12 * 64, IT_FO = 8 * 64, IT_RO = 8 * 64, IT_O = 32 * 64, IT_UP = 32 * 256, IT_DN = 128 * 64;
constexpr int IT_LAYER = IT_IN + IT_CO + IT_SO + IT_FO + IT_RO + IT_O + IT_UP + IT_DN;

__device__ __forceinline__ void p0_prologue(KArgs a, LAS unsigned char* lds, int bid, int G, const int wave0) {
    PH_IDS
    unsigned char* ws = a->ws;
    {
        LAS float* sc = (LAS float*)lds;
        LAS float* part = (LAS float*)(lds + 40960);
        for (int i = tid; i < 5 * DM; i += NTHR) { const float v = (i < 4 * DM) ? a->in[I_C][i] : a->in[I_CCTX][i - 4 * DM]; sc[i] = siluf_(v); }
        __syncthreads();
        float* MODV = (float*)(ws + OFF_MODV);
        for (int it = bid; it < DEPTH * 192; it += G) {
            const int l = it / 192, j = (it % 192) * 64 + lane;
            const float* wp = a->in[I_MODW] + (size_t)l * DM * 12288 + (size_t)(wave * 256) * 12288 + j;
            float acc[5] = {0.f, 0.f, 0.f, 0.f, 0.f};
#pragma unroll 1
            for (int k0 = 0; k0 < 256; k0 += 32) { float w[32];
#pragma unroll
                for (int k = 0; k < 32; ++k) w[k] = wp[(size_t)(k0 + k) * 12288];
#pragma unroll
                for (int k = 0; k < 32; ++k)
#pragma unroll
                    for (int r = 0; r < 5; ++r) acc[r] += sc[r * DM + wave * 256 + k0 + k] * w[k]; }
#pragma unroll
            for (int r = 0; r < 5; ++r) part[(wave * 5 + r) * 64 + lane] = acc[r];
            __syncthreads();
            if (tid < 320) { const int r = tid >> 6, jj = tid & 63; float s = 0.f;
#pragma unroll
                for (int w = 0; w < 8; ++w) s += part[(w * 5 + r) * 64 + jj];
                const int jo = (it % 192) * 64 + jj; MODV[((size_t)l * 5 + r) * 12288 + jo] = s + a->in[I_MODB][l * 12288 + jo]; }
            __syncthreads();
        }
    }
    {
        LAS float* wt = (LAS float*)lds;
        LAS float* ctab = (LAS float*)(lds + 32768);
        LAS float* scr = (LAS float*)(lds + 32768 + 512 + wave * 8448);
        __syncthreads();
        if (tid < 128) ctab[tid] = cospif((float)tid * (1.f / 64.f));
        for (int it = bid; it < DEPTH * 32 * 4; it += G) {
            const int l = it / 128, kb = (it % 128) / 4, g = it % 4, k0 = kb * 64;
            __syncthreads();
            for (int i = tid; i < 64 * 32; i += NTHR) { const int kk = i >> 5, c4 = i & 31;
                *(LAS f32x4*)(wt + kk * 128 + c4 * 4) = *(const f32x4*)(a->in[I_WIN] + ((size_t)l * DM + k0 + kk) * IN_DIM + S_FFT + g * 128 + c4 * 4); }
            __syncthreads();
            const int half = wave >> 2, cp = (wave & 3) * 32 + (lane & 31), n0 = half * 512 + g * 128 + (wave & 3) * 32;
#pragma unroll 1
            for (int i = 0; i < 32; ++i) { const int kk = 2 * i + (lane >> 5); float s = 0.f;
#pragma unroll 8
                for (int c = 0; c < 128; ++c) s += wt[kk * 128 + c] * ctab[(c * cp - 32 * half) & 127];
                scr[kk * 33 + (lane & 31)] = s; }
            LDS_WAIT();
            bf16* WT = (bf16*)(ws + OFF_W + (size_t)l * W_LAYER + WO_FFT);
            const int c = lane & 7;
#pragma unroll
            for (int j = 0; j < 4; ++j) { const int n = (lane >> 3) + 8 * j; const LAS float* s = scr + (8 * c) * 33 + n;
                v4u o; o.x = pk2(s[0 * 33], s[1 * 33]); o.y = pk2(s[2 * 33], s[3 * 33]); o.z = pk2(s[4 * 33], s[5 * 33]); o.w = pk2(s[6 * 33], s[7 * 33]);
                *(v4u*)(WT + (size_t)(n0 + n) * DM + k0 + 8 * c) = o; }
            LDS_WAIT();
        }
        __syncthreads();
    }
    const int gw = bid * NWAVES + wave, NGW = G * NWAVES;
    {
        LAS float* scr = (LAS float*)(lds + wave * 8448);
        for (int it = gw; it < DEPTH * IT_LAYER; it += NGW) {
            const int l = it / IT_LAYER; int r = it % IT_LAYER; unsigned char* wl = ws + OFF_W + (size_t)l * W_LAYER;
            if (r < IT_IN) { const int kb = r / (NU / 32), nb = r % (NU / 32); transpose_item(a->in[I_WIN] + (size_t)l * DM * IN_DIM, DM, IN_DIM, (bf16*)(wl + WO_IN), kb * 64, nb * 32, true, scr, lane); continue; } r -= IT_IN;
            if (r < IT_CO) { transpose_item(a->in[I_CONVOUT] + (size_t)l * 512 * DM, ACW, DM, (bf16*)(wl + WO_CAT), (r / 64) * 64, (r % 64) * 32, false, scr, lane, AC_CONV); continue; } r -= IT_CO;
            if (r < IT_SO) { transpose_item(a->in[I_SOUT] + (size_t)l * 768 * DM, ACW, DM, (bf16*)(wl + WO_CAT), (r / 64) * 64, (r % 64) * 32, false, scr, lane, AC_SSD); continue; } r -= IT_SO;
            if (r < IT_FO) { transpose_item(a->in[I_FOUT] + (size_t)l * 512 * DM, ACW, DM, (bf16*)(wl + WO_CAT), (r / 64) * 64, (r % 64) * 32, false, scr, lane, AC_FFT); continue; } r -= IT_FO;
            if (r < IT_RO) { transpose_item(a->in[I_ROUT] + (size_t)l * 512 * DM, ACW, DM, (bf16*)(wl + WO_CAT), (r / 64) * 64, (r % 64) * 32, false, scr, lane, AC_RWKV); continue; } r -= IT_RO;
            if (r < IT_O) { transpose_item(a->in[I_WO] + (size_t)l * DM * DM, DM, DM, (bf16*)(wl + WO_O), (r / 64) * 64, (r % 64) * 32, false, scr, lane); continue; } r -= IT_O;
            if (r < IT_UP) { transpose_item(a->in[I_UP] + (size_t)l * DM * DFF, DM, DFF, (bf16*)(wl + WO_UP), (r / 256) * 64, (r % 256) * 32, false, scr, lane); continue; } r -= IT_UP;
            transpose_item(a->in[I_DOWN] + (size_t)l * DFF * DM, DFF, DM, (bf16*)(wl + WO_DN), (r / 64) * 64, (r % 64) * 32, false, scr, lane);
        }
    }
    {
        const int gt = bid * NTHR + tid, NGT = G * NTHR;
        bf16* FL = (bf16*)(ws + OFF_DFTL); bf16* FC = (bf16*)(ws + OFF_DFTC);
        { bf16* WLT = (bf16*)(ws + OFF_WLT);
          for (int i = gt; i < DEPTH * 512 * 320; i += NGT) { const int l = i / (512 * 320), c = (i / 320) % 512, j = i % 320; float v;
              if (j < 64) v = a->in[I_RW2][((size_t)(l * 2 + 0) * 64 + j) * 512 + c]; else if (j < 128) v = a->in[I_RW2][((size_t)(l * 2 + 1) * 64 + (j - 64)) * 512 + c];
              else if (j < 192) v = a->in[I_RA2][((size_t)l * 64 + (j - 128)) * 512 + c]; else v = a->in[I_RG2][((size_t)l * 128 + (j - 192)) * 512 + c];
              WLT[i] = (bf16)f2bf(v); } }
        for (int i = gt; i < 2048 * 512; i += NGT) { const int lp = i >> 9, k8 = (i & 511) * 8; unsigned o[4];
#pragma unroll
            for (int e = 0; e < 4; ++e) { float v[2];
#pragma unroll
                for (int q = 0; q < 2; ++q) { const int k = k8 + 2 * e + q; const int m = (lp * (k & 2047)) & 2047; float sn, cs; sincospif((float)m * (1.f / 1024.f), &sn, &cs); v[q] = (k < 2048 ? cs : -sn) * (1.f / 512.f); }
                o[e] = pk2(v[0], v[1]); }
            *(v4u*)(FL + (size_t)lp * 4096 + k8) = (v4u){o[0], o[1], o[2], o[3]}; }
        for (int i = gt; i < 256 * 64; i += NGT) { const int lp = i >> 6, k8 = (i & 63) * 8; unsigned o[4];
#pragma unroll
            for (int e = 0; e < 4; ++e) { float v[2];
#pragma unroll
                for (int q = 0; q < 2; ++q) { const int k = k8 + 2 * e + q; const int m = (lp * (k & 255)) & 255; float sn, cs; sincospif((float)m * (1.f / 128.f), &sn, &cs); v[q] = (k < 256 ? cs : -sn) * 0.005524271728f; }
                o[e] = pk2(v[0], v[1]); }
            *(v4u*)(FC + (size_t)lp * 512 + k8) = (v4u){o[0], o[1], o[2], o[3]}; }
        f32x4* X4 = (f32x4*)(ws + OFF_X); const f32x4* x4 = (const f32x4*)a->in[I_X]; const f32x4* c4 = (const f32x4*)a->in[I_CTX];
        for (int i = gt; i < TT * (DM / 4); i += NGT) X4[i] = (i < TLAT * (DM / 4)) ? x4[i] : c4[i - TLAT * (DM / 4)];
    }
}

__device__ __forceinline__ void norm_phase(KArgs a, int mode, const float* gY, const float* gH, const float* modY  , const float* modH  ,
                                           int bid, int G, const int wave0, int nrows, bool split = false  ) {
    PH_IDS
    unsigned char* ws = a->ws; const int gw = bid * NWAVES + wave, NGW = G * NWAVES;
    float* X = (float*)(ws + OFF_X); const float* Y = (const float*)(ws + OFF_Y); bf16* H = (bf16*)(ws + OFF_H);
    for (int row = gw; row < nrows; row += NGW) {
        const int mr = row < TLAT ? (row >> 11) : 4;
        f32x4 x[8];
        const f32x4* xr = (const f32x4*)(X + (size_t)row * DM) + lane;
#pragma unroll
        for (int j = 0; j < 8; ++j) x[j] = xr[64 * j];
        if (mode != 0) {
            const f32x4* yr = (const f32x4*)(Y + (size_t)row * DM) + lane; f32x4 y[8]; float ss = 0.f;
            if (split && row >= TLAT) { const f32x4* yc = (const f32x4*)((const float*)(ws + OFF_YC) + (size_t)(row - TLAT) * DM) + lane;
#pragma unroll
                for (int j = 0; j < 8; ++j) { f32x4 t = yc[64 * j];
#pragma unroll
                    for (int sl = 1; sl < 8; ++sl) t += yc[(size_t)sl * 1024 * 512 + 64 * j];
                    y[j] = t; } }
            else {
#pragma unroll
                for (int j = 0; j < 8; ++j) y[j] = yr[64 * j]; }
#pragma unroll
            for (int j = 0; j < 8; ++j) { ss += (y[j].x * y[j].x + y[j].y * y[j].y) + (y[j].z * y[j].z + y[j].w * y[j].w); }
            const float r = rsqrtf(wave_sum(ss) * (1.f / DM) + 1e-6f);
            const f32x4* gp = (const f32x4*)gY + lane; const f32x4* gt = (const f32x4*)(modY + (size_t)mr * 12288) + lane;
#pragma unroll
            for (int j = 0; j < 8; ++j) x[j] += gt[64 * j] * (y[j] * r * gp[64 * j]);
            if (mode == 1) { f32x4* xw = (f32x4*)(X + (size_t)row * DM) + lane;
#pragma unroll
                for (int j = 0; j < 8; ++j) xw[64 * j] = x[j]; }
            else { f32x4* ow = (f32x4*)(a->out + (size_t)row * DM) + lane;
#pragma unroll
                for (int j = 0; j < 8; ++j) ow[64 * j] = x[j]; }
        }
        if (mode != 2) {
            float ss = 0.f;
#pragma unroll
            for (int j = 0; j < 8; ++j) ss += (x[j].x * x[j].x + x[j].y * x[j].y) + (x[j].z * x[j].z + x[j].w * x[j].w);
            const float r = rsqrtf(wave_sum(ss) * (1.f / DM) + 1e-6f);
            const f32x4* gp = (const f32x4*)gH + lane; const f32x4* sh = (const f32x4*)(modH + (size_t)mr * 12288) + lane; const f32x4* sc = sh + 512;
            v2u* hw = (v2u*)(H + (size_t)row * DM) + lane;
#pragma unroll
            for (int j = 0; j < 8; ++j) { const f32x4 h = (x[j] * r * gp[64 * j]) * (sc[64 * j] + 1.f) + sh[64 * j]; hw[64 * j] = (v2u){pk2(h.x, h.y), pk2(h.z, h.w)}; }
        }
    }
}
#define XB_TMO      128
#define XB_XCNT(j)  (256  + 64 * (j))
#define XB_XSUB(j)  (1280 + 64 * (j))
#define XB_XGEN(j)  (2304 + 64 * (j))
#define XB_TOP      3328
#define XB_TOPGEN   3392
#define XCD_BAR_WORDS 3456
#define XB_SPIN_CAP (1u << 18)

__device__ __forceinline__ unsigned xb_ld(unsigned* p)              { return __hip_atomic_load(p, __ATOMIC_RELAXED, __HIP_MEMORY_SCOPE_AGENT); }
__device__ __forceinline__ unsigned xb_add(unsigned* p, unsigned v) { return __hip_atomic_fetch_add(p, v, __ATOMIC_RELAXED, __HIP_MEMORY_SCOPE_AGENT); }
__device__ __forceinline__ unsigned xb_xcc_id() { return (unsigned)__builtin_amdgcn_s_getreg((3 << 11) | 20) & 0xFu; }
#define XB_SPIN(cond, bar) do { unsigned _sp = 0; while (cond) { __builtin_amdgcn_s_sleep(1); \
    if ((++_sp & 255u) == 0u) { if (xb_ld(&(bar)[XB_TMO])) break; if (_sp > XB_SPIN_CAP) { atomicAdd(&(bar)[XB_TMO], 1u); break; } } } } while (0)

struct XcdBarrier {
    unsigned* bar; unsigned x; int wv;
    volatile LAS unsigned* st;
};

__device__ __forceinline__ bool xb_t0(int wv) { unsigned z_ = 0u; asm volatile("" : "+v"(z_)); return wv == 0 && __builtin_amdgcn_mbcnt_hi(~0u, __builtin_amdgcn_mbcnt_lo(~0u, z_)) == 0u; }
__device__ __forceinline__ XcdBarrier xcd_barrier_post(unsigned* bar, volatile LAS unsigned* st, int wv) {
    XcdBarrier b; b.bar = bar; b.x = xb_xcc_id(); b.st = st; b.wv = wv;
    if (xb_t0(wv)) (void)xb_add(&bar[XB_XCNT(b.x)], 1u);
    return b;
}
__device__ __forceinline__ void xcd_barrier_complete(unsigned* bar, unsigned x, unsigned& nloc, unsigned& nx) {
    const unsigned G = gridDim.x * gridDim.y * gridDim.z;
    unsigned sum, cnt, mine, sp = 0u;
    for (;;) {
        sum = 0u; cnt = 0u; mine = 0u;
#pragma unroll
        for (unsigned j = 0; j < 16; ++j) { const unsigned c = xb_ld(&bar[XB_XCNT(j)]); sum += c; cnt += (c > 0u) ? 1u : 0u; mine = (j == x) ? c : mine; }
        if (sum == G) break;
        __builtin_amdgcn_s_sleep(1);
        if ((++sp & 255u) == 0u) { if (xb_ld(&bar[XB_TMO])) break; if (sp > XB_SPIN_CAP) { atomicAdd(&bar[XB_TMO], 1u); break; } }
    }
    nloc = mine > 0u ? mine : 1u; nx = cnt > 0u ? cnt : 1u;
}

__device__ __forceinline__ void xcd_barrier(const XcdBarrier& b) {
    asm volatile("s_waitcnt vmcnt(0)" ::: "memory");
    __syncthreads();
    if (xb_t0(b.wv)) {
        unsigned* bar = b.bar;
        __builtin_amdgcn_s_waitcnt(0);
        unsigned nloc = b.st[0], nx = b.st[1];
        if (nloc == 0u) { xcd_barrier_complete(bar, b.x, nloc, nx); b.st[0] = nloc; b.st[1] = nx; }
        const unsigned old = xb_add(&bar[XB_XSUB(b.x)], 1u);
        const unsigned gen = old / nloc;
        if (old + 1u == (gen + 1u) * nloc) {
            __builtin_amdgcn_fence(__ATOMIC_RELEASE, "agent");
            asm volatile("s_waitcnt vmcnt(0)" ::: "memory");
            const unsigned og = xb_add(&bar[XB_TOP], 1u);
            const unsigned tg = og / nx;
            if (og + 1u == (tg + 1u) * nx) xb_add(&bar[XB_TOPGEN], 1u);
            else XB_SPIN(xb_ld(&bar[XB_TOPGEN]) == tg, bar);
            __builtin_amdgcn_fence(__ATOMIC_ACQUIRE, "agent");
            xb_add(&bar[XB_XGEN(b.x)], 1u);
            asm volatile("s_waitcnt vmcnt(0)" ::: "memory");
        } else {
            XB_SPIN(xb_ld(&bar[XB_XGEN(b.x)]) == gen, bar);
            __builtin_amdgcn_fence(__ATOMIC_ACQUIRE, "agent");
            asm volatile("s_waitcnt vmcnt(0)" ::: "memory");
        }
    }
    __syncthreads();
}

typedef short bf16x8 __attribute__((ext_vector_type(8)));
constexpr int RP_PITCH = 516, ACT_PITCH = 328;
__device__ __forceinline__ void rwkv_prep_item(KArgs a, int l, int item, LAS unsigned char* lds, int tid, int lane, int wave) {
    unsigned char* ws = a->ws;
    const bf16* U = (const bf16*)(ws + OFF_U); const float* MISC = (const float*)(ws + OFF_MISC);
    const int b = item / 144, j0 = (item % 144) * 16; const bool isctx = j0 < LCTX;
    LAS float* RP = (LAS float*)lds;
    LAS float* KP = RP + 16 * RP_PITCH; LAS float* VP = KP + 16 * RP_PITCH;
    LAS bf16* ACT = (LAS bf16*)(lds + 3 * 16 * RP_PITCH * 4);
    const float* mu = a->in[I_RMU] + l * 1856;
    for (int idx = tid; idx < 16 * 192; idx += NTHR) { const int i = idx / 192, c8 = idx % 192, jj = j0 + i;
        const bool hp = isctx ? (jj - 1 >= 0) : (jj - 1 >= LCTX), hn = isctx ? (jj + 1 < LCTX) : (jj + 1 < RJ);
        const v4u c = *(const v4u*)(U + (size_t)rwkv_tok(b, jj) * NU + URKV + c8 * 8);
        v4u p = (v4u){0u, 0u, 0u, 0u}, n = p;
        if (hp) p = *(const v4u*)(U + (size_t)rwkv_tok(b, jj - 1) * NU + URKV + c8 * 8);
        if (hn) n = *(const v4u*)(U + (size_t)rwkv_tok(b, jj + 1) * NU + URKV + c8 * 8);
        const f32x4 m0 = *(const f32x4*)(mu + c8 * 8), m1 = *(const f32x4*)(mu + c8 * 8 + 4);
        f32x4 x0 = (f32x4){bflo(c.x), bfhi(c.x), bflo(c.y), bfhi(c.y)}, x1 = (f32x4){bflo(c.z), bfhi(c.z), bflo(c.w), bfhi(c.w)};
        const f32x4 s0 = (f32x4){bflo(p.x) + bflo(n.x), bfhi(p.x) + bfhi(n.x), bflo(p.y) + bflo(n.y), bfhi(p.y) + bfhi(n.y)}, s1 = (f32x4){bflo(p.z) + bflo(n.z), bfhi(p.z) + bfhi(n.z), bflo(p.w) + bflo(n.w), bfhi(p.w) + bfhi(n.w)};
        x0 = x0 + (0.5f * s0 - x0) * m0; x1 = x1 + (0.5f * s1 - x1) * m1;
        const int ch = c8 * 8, reg = ch >> 9; LAS float* dst = (reg == 0 ? RP : (reg == 1 ? KP : VP)) + i * RP_PITCH + (ch & 511);
        *(LAS f32x4*)dst = x0; *(LAS f32x4*)(dst + 4) = x1; }
    for (int idx = tid; idx < 16 * 80; idx += NTHR) { const int i = idx / 80, c4 = idx % 80, jj = j0 + i;
        const bool hp = isctx ? (jj - 1 >= 0) : (jj - 1 >= LCTX), hn = isctx ? (jj + 1 < LCTX) : (jj + 1 < RJ);
        f32x4 x = *(const f32x4*)(MISC + (size_t)rwkv_tok(b, jj) * 512 + 64 + c4 * 4); f32x4 p = (f32x4){0.f, 0.f, 0.f, 0.f}, n = p;
        if (hp) p = *(const f32x4*)(MISC + (size_t)rwkv_tok(b, jj - 1) * 512 + 64 + c4 * 4);
        if (hn) n = *(const f32x4*)(MISC + (size_t)rwkv_tok(b, jj + 1) * 512 + 64 + c4 * 4);
        x = x + (0.5f * (p + n) - x) * *(const f32x4*)(mu + 1536 + c4 * 4);
        const int m = c4 * 4;
        if (m < 128) x = (f32x4){tanhf(x.x), tanhf(x.y), tanhf(x.z), tanhf(x.w)}; else if (m >= 192) x = (f32x4){sigmoidf_(x.x), sigmoidf_(x.y), sigmoidf_(x.z), sigmoidf_(x.w)};
        *(LAS v2u*)(ACT + i * ACT_PITCH + m) = (v2u){pk2(x.x, x.y), pk2(x.z, x.w)}; }
    __syncthreads();
    const int fr = lane & 15, fq = lane >> 4, h = wave;
    f32x4 acc[4][4];
#pragma unroll
    for (int o = 0; o < 4; ++o)
#pragma unroll
        for (int nt = 0; nt < 4; ++nt) acc[o][nt] = (f32x4){0.f, 0.f, 0.f, 0.f};
    {
        const bf16* WLT = (const bf16*)(ws + OFF_WLT) + (size_t)l * 512 * 320 + (size_t)(64 * wave + fr) * 320 + fq * 8;
#pragma unroll
        for (int ks = 0; ks < 10; ++ks) { const int o = ks < 2 ? 0 : (ks < 4 ? 1 : (ks < 6 ? 2 : 3));
            const bf16x8 af = *(const LAS bf16x8*)(ACT + fr * ACT_PITCH + ks * 32 + fq * 8);
#pragma unroll
            for (int nt = 0; nt < 4; ++nt) { const bf16x8 bf = *(const bf16x8*)(WLT + (size_t)nt * 16 * 320 + ks * 32);
                acc[o][nt] = __builtin_amdgcn_mfma_f32_16x16x32_bf16(af, bf, acc[o][nt], 0, 0, 0); } }
    }
    float* RW = (float*)(ws + OFF_RW); constexpr size_t AS = RW_ARR / 4; float* RSC = (float*)(ws + OFF_RSC);
    float w0f[4], w0b[4], a0c[4], kkc[4], kac[4], rkc[4];
#pragma unroll
    for (int nt = 0; nt < 4; ++nt) { const int c = 64 * wave + 16 * nt + fr; w0f[nt] = a->in[I_RW0][(l * 2 + 0) * 512 + c]; w0b[nt] = a->in[I_RW0][(l * 2 + 1) * 512 + c]; a0c[nt] = a->in[I_RA0][l * 512 + c];
        kkc[nt] = a->in[I_RKK][l * 512 + c]; kac[nt] = a->in[I_RKA][l * 512 + c]; rkc[nt] = a->in[I_RRK][l * 512 + c]; }
#pragma unroll
    for (int i = 0; i < 4; ++i) { const int tok = 4 * fq + i; const size_t R = (size_t)b * RJ + j0 + tok;
        float r[4], k[4], v[4], av[4], kkv[4]; float ss = 0.f;
#pragma unroll
        for (int nt = 0; nt < 4; ++nt) { const int c = 64 * wave + 16 * nt + fr; r[nt] = RP[tok * RP_PITCH + c]; k[nt] = KP[tok * RP_PITCH + c]; v[nt] = VP[tok * RP_PITCH + c];
            av[nt] = sigmoidf_(a0c[nt] + acc[2][nt][i]); kkv[nt] = k[nt] * kkc[nt]; ss += kkv[nt] * kkv[nt]; }
        const float rn = rsqrtf(row16_sum(ss) + 1e-12f);
        float c1 = 0.f, c2 = 0.f, bon = 0.f;
#pragma unroll
        for (int nt = 0; nt < 4; ++nt) { const int c = 64 * wave + 16 * nt + fr;
            const float wf = __expf(-__expf(-softplusf_(-(w0f[nt] + acc[0][nt][i])) - 0.5f)), wb = __expf(-__expf(-softplusf_(-(w0b[nt] + acc[1][nt][i])) - 0.5f));
            const float kk = kkv[nt] * rn, kmod = k[nt] * (1.f + (av[nt] - 1.f) * kac[nt]), ka = kk * av[nt];
            c1 += ka * r[nt]; c2 += kmod * r[nt]; bon += r[nt] * kmod * rkc[nt];
            float* o = RW + R * 512 + c;
            o[0 * AS] = wf; o[1 * AS] = wf * r[nt]; o[2 * AS] = wb; o[3 * AS] = wb * r[nt]; o[4 * AS] = kmod; o[5 * AS] = -kk; o[6 * AS] = ka; o[7 * AS] = v[nt]; o[8 * AS] = acc[3][nt][i]; }
        c1 = row16_sum(c1); c2 = row16_sum(c2); bon = row16_sum(bon);
        if (fr == 0) { RSC[R * 8 + h] = c1; RSC[(size_t)TT * 8 + R * 8 + h] = c2; RSC[(size_t)2 * TT * 8 + R * 8 + h] = bon; }
    }
    __syncthreads();
}
__device__ __forceinline__ void ssd_prep_item(KArgs a, int l, int item, int tid) {
    unsigned char* ws = a->ws; const bf16* U = (const bf16*)(ws + OFF_U); const float* MISC = (const float*)(ws + OFF_MISC);
    bf16* XBC = (bf16*)(ws + OFF_XBC); float* DTA = (float*)(ws + OFF_DTA);
    const int t0 = item * 16;
    const int seq_lo = t0 < TLAT ? (t0 & ~(LSEQ - 1)) : TLAT + ((t0 - TLAT) & ~(LCTX - 1)), seq_hi = seq_lo + (t0 < TLAT ? LSEQ : LCTX);
    for (int cp = tid; cp < 896; cp += NTHR) {
        float w0[5], w1[5];
#pragma unroll
        for (int j = 0; j < 5; ++j) { const f32x2 w = *(const f32x2*)(a->in[I_SCW] + (size_t)(l * 5 + j) * 1792 + 2 * cp); w0[j] = w.x; w1[j] = w.y; }
        const f32x2 bb = *(const f32x2*)(a->in[I_SCB] + l * 1792 + 2 * cp);
        float i0[20], i1[20];
#pragma unroll
        for (int r = 0; r < 20; ++r) { const int row = t0 - 2 + r; unsigned u = 0u; if (row >= seq_lo && row < seq_hi) u = *(const unsigned*)(U + (size_t)row * NU + UXBC + 2 * cp); i0[r] = bflo(u); i1[r] = bfhi(u); }
#pragma unroll
        for (int o = 0; o < 16; ++o) { float s0 = bb.x, s1 = bb.y;
#pragma unroll
            for (int j = 0; j < 5; ++j) { s0 += w0[j] * i0[o + j]; s1 += w1[j] * i1[o + j]; }
            *(unsigned*)(XBC + (size_t)(t0 + o) * 1792 + 2 * cp) = pk2(siluf_(s0), siluf_(s1)); }
    }
    if (tid < 16 * 24) { const int o = tid / 24, q = tid % 24;
        const float dt = softplusf_(MISC[(size_t)(t0 + o) * 512 + q] + a->in[I_SDTB][l * 24 + q]); const float A = -__expf(a->in[I_SALOG][l * 24 + q]);
        DTA[(size_t)(t0 + o) * 48 + q] = dt; DTA[(size_t)(t0 + o) * 48 + 24 + q] = dt * A; }
}
__device__ __forceinline__ void conv_item(KArgs a, int l, int item, LAS unsigned char* lds, int tid, int lane, int wave) {
    unsigned char* ws = a->ws; const bf16* U = (const bf16*)(ws + OFF_U); bf16* AC = (bf16*)(ws + OFF_ACAT) + AC_CONV;
    int t0, seg_lo, seg_hi;
    if (item < 256) { t0 = item * 32; seg_lo = t0 & ~63; seg_hi = seg_lo + 64; }
    else { const int ci = item - 256; t0 = TLAT + ci * 32; seg_lo = TLAT + (ci >> 3) * LCTX; seg_hi = seg_lo + LCTX; }
    LAS bf16* inimg = (LAS bf16*)lds;
    LAS float* outimg = (LAS float*)(lds + 63488);
    for (int idx = tid; idx < 62 * 64; idx += NTHR) { const int rr = idx >> 6, c8 = idx & 63, row = t0 - 15 + rr;
        v4u o = (v4u){0u, 0u, 0u, 0u};
        if (row >= seg_lo && row < seg_hi) { const v4u va = *(const v4u*)(U + (size_t)row * NU + UCONV + c8 * 8), vg = *(const v4u*)(U + (size_t)row * NU + UCONV + 512 + c8 * 8);
            o.x = pk2(bflo(va.x) * sigmoidf_(bflo(vg.x)), bfhi(va.x) * sigmoidf_(bfhi(vg.x))); o.y = pk2(bflo(va.y) * sigmoidf_(bflo(vg.y)), bfhi(va.y) * sigmoidf_(bfhi(vg.y)));
            o.z = pk2(bflo(va.z) * sigmoidf_(bflo(vg.z)), bfhi(va.z) * sigmoidf_(bfhi(vg.z))); o.w = pk2(bflo(va.w) * sigmoidf_(bflo(vg.w)), bfhi(va.w) * sigmoidf_(bfhi(vg.w))); }
        *(LAS v4u*)(inimg + rr * 512 + c8 * 8) = o; }
    __syncthreads();
    {
        const int c = tid; float w[31];
#pragma unroll
        for (int j = 0; j < 31; ++j) w[j] = a->in[I_CONVW][(size_t)(l * 31 + j) * 512 + c];
        const float bias = a->in[I_CONVB][l * 512 + c];
#pragma unroll 2
        for (int o = 0; o < 32; ++o) { float s = bias;
#pragma unroll
            for (int j = 0; j < 31; ++j) s += w[j] * bf2f(inimg[(o + j) * 512 + c]);
            outimg[o * 512 + c] = s; }
    }
    __syncthreads();
    {
        const f32x4 g0 = *(const f32x4*)(a->in[I_CLNG] + l * 512 + 8 * lane), g1 = *(const f32x4*)(a->in[I_CLNG] + l * 512 + 8 * lane + 4);
        const f32x4 b0 = *(const f32x4*)(a->in[I_CLNB] + l * 512 + 8 * lane), b1 = *(const f32x4*)(a->in[I_CLNB] + l * 512 + 8 * lane + 4);
#pragma unroll
        for (int q = 0; q < 4; ++q) { const int o = wave * 4 + q;
            f32x4 x0 = *(const LAS f32x4*)(outimg + o * 512 + 8 * lane), x1 = *(const LAS f32x4*)(outimg + o * 512 + 8 * lane + 4);
            const float mean = wave_sum((x0.x + x0.y + x0.z + x0.w) + (x1.x + x1.y + x1.z + x1.w)) * (1.f / 512.f);
            x0 = x0 - mean; x1 = x1 - mean;
            const float var = wave_sum((x0.x * x0.x + x0.y * x0.y + x0.z * x0.z + x0.w * x0.w) + (x1.x * x1.x + x1.y * x1.y + x1.z * x1.z + x1.w * x1.w)) * (1.f / 512.f);
            const float rs = rsqrtf(var + 1e-5f);
            x0 = x0 * rs * g0 + b0; x1 = x1 * rs * g1 + b1;
            v4u ov; ov.x = pk2(siluf_(x0.x), siluf_(x0.y)); ov.y = pk2(siluf_(x0.z), siluf_(x0.w)); ov.z = pk2(siluf_(x1.x), siluf_(x1.y)); ov.w = pk2(siluf_(x1.z), siluf_(x1.w));
            *(v4u*)(AC + (size_t)(t0 + o) * ACW + 8 * lane) = ov; }
    }
    __syncthreads();
}

__device__ __forceinline__ int ssd_tok(int b, int dir, int pos) {
    if (pos < LCTX) return TLAT + b * LCTX + (dir ? (LCTX - 1 - pos) : pos);
    const int q = pos - LCTX; return b * LSEQ + (dir ? (LSEQ - 1 - q) : q);
}
__device__ __forceinline__ void post_phase(KArgs a, int l, int bid, int G, const int wave0) {
    PH_IDS
    unsigned char* ws = a->ws; const int gw = bid * NWAVES + wave, NGW = G * NWAVES;
    const bf16* U = (const bf16*)(ws + OFF_U); const bf16* XBC = (const bf16*)(ws + OFF_XBC);
    const float* Y0 = (const float*)(ws + OFF_YSSD); const float* Y1 = Y0 + (size_t)TT * 768; bf16* AS_ = (bf16*)(ws + OFF_ACAT) + AC_SSD;
    for (int row = gw; row < TT; row += NGW) {
        f32x4 y[3]; float ss = 0.f;
#pragma unroll
        for (int j = 0; j < 3; ++j) { const int col = 4 * lane + 256 * j; const float dsk = a->in[I_SD][l * 12 + (col >> 6)];
            const f32x4 yf = *(const f32x4*)(Y0 + (size_t)row * 768 + col), yb = *(const f32x4*)(Y1 + (size_t)row * 768 + col);
            const v2u xs = *(const v2u*)(XBC + (size_t)row * 1792 + col), z = *(const v2u*)(U + (size_t)row * NU + UZ + col);
            f32x4 v = yf + yb + dsk * (f32x4){bflo(xs.x), bfhi(xs.x), bflo(xs.y), bfhi(xs.y)};
            v = v * (f32x4){siluf_(bflo(z.x)), siluf_(bfhi(z.x)), siluf_(bflo(z.y)), siluf_(bfhi(z.y))};
            y[j] = v; ss += (v.x * v.x + v.y * v.y) + (v.z * v.z + v.w * v.w); }
        const float r = rsqrtf(wave_sum(ss) * (1.f / 768.f) + 1e-6f);
#pragma unroll
        for (int j = 0; j < 3; ++j) { const int col = 4 * lane + 256 * j; const f32x4 g = *(const f32x4*)(a->in[I_SNG] + l * 768 + col); const f32x4 o = y[j] * r * g;
            *(v2u*)(AS_ + (size_t)row * ACW + col) = (v2u){pk2(o.x, o.y), pk2(o.z, o.w)}; }
    }
    const float* RW = (const float*)(ws + OFF_RW); constexpr size_t AS = RW_ARR / 4; const float* RSC = (const float*)(ws + OFF_RSC);
    const float* R0 = (const float*)(ws + OFF_YRW); const float* R1 = R0 + (size_t)TT * 512; bf16* AR = (bf16*)(ws + OFF_ACAT) + AC_RWKV;
    for (int row = gw; row < TT; row += NGW) {
        size_t R;
        if (row < TLAT) { const int b = row >> 11, t = row & 2047, rr = t >> 6, cc = t & 63; R = (size_t)b * RJ + LCTX + cc * 32 + rr; }
        else { const int b = (row - TLAT) >> 8, jj = (row - TLAT) & 255; R = (size_t)b * RJ + jj; }
        const int c0 = 8 * lane, h = lane >> 3;
        f32x4 ya = *(const f32x4*)(R0 + R * 512 + c0) + *(const f32x4*)(R1 + R * 512 + c0), yb = *(const f32x4*)(R0 + R * 512 + c0 + 4) + *(const f32x4*)(R1 + R * 512 + c0 + 4);
        float s = (ya.x + ya.y + ya.z + ya.w) + (yb.x + yb.y + yb.z + yb.w);
        s = sum8(s);
        const float mean = s * (1.f / 64.f); ya = ya - mean; yb = yb - mean;
        float q = (ya.x * ya.x + ya.y * ya.y + ya.z * ya.z + ya.w * ya.w) + (yb.x * yb.x + yb.y * yb.y + yb.z * yb.z + yb.w * yb.w);
        q = sum8(q);
        const float rs = rsqrtf(q * (1.f / 64.f) + 64e-5f);
        const f32x4 lg0 = *(const f32x4*)(a->in[I_RLNG] + l * 512 + c0), lg1 = *(const f32x4*)(a->in[I_RLNG] + l * 512 + c0 + 4), lb0 = *(const f32x4*)(a->in[I_RLNB] + l * 512 + c0), lb1 = *(const f32x4*)(a->in[I_RLNB] + l * 512 + c0 + 4);
        const float bon = RSC[(size_t)2 * TT * 8 + R * 8 + h];
        const f32x4 v0 = *(const f32x4*)(RW + 7 * AS + R * 512 + c0), v1 = *(const f32x4*)(RW + 7 * AS + R * 512 + c0 + 4), g0 = *(const f32x4*)(RW + 8 * AS + R * 512 + c0), g1 = *(const f32x4*)(RW + 8 * AS + R * 512 + c0 + 4);
        const f32x4 o0 = (ya * rs * lg0 + lb0 + bon * v0) * g0, o1 = (yb * rs * lg1 + lb1 + bon * v1) * g1;
        *(v4u*)(AR + (size_t)row * ACW + c0) = (v4u){pk2(o0.x, o0.y), pk2(o0.z, o0.w), pk2(o1.x, o1.y), pk2(o1.z, o1.w)};
    }
}

__device__ __forceinline__ size_t rwkv_row(int b, int dir, int pos) { const int j = dir ? (pos < LCTX ? (LCTX - 1 - pos) : (RJ + LCTX - 1 - pos)) : pos; return (size_t)b * RJ + j; }
constexpr int RWS_BUF = 45568, RWS_V = 40960, RWS_C = 45056, RWS_CH = 32;
__device__ __forceinline__ void rwkv_scan_fast(KArgs a, int idx, LAS unsigned char* lds, int tid, int lane, int wave) {
    unsigned char* ws = a->ws; const float* RW = (const float*)(ws + OFF_RW); constexpr size_t AS = RW_ARR / 4; const float* RSC = (const float*)(ws + OFF_RSC);
    const int combo = idx >> 1, half = idx & 1, b = combo >> 4, dir = (combo >> 3) & 1, h = combo & 7, v0 = half * 32;
    float* Yo = (float*)(ws + OFF_YRW) + (size_t)dir * TT * 512;
    const float* arr0 = RW + (dir ? 2 : 0) * AS; const float* arr1 = RW + (dir ? 3 : 1) * AS;
    const int ls = tid >> 4, lc4 = tid & 15;
    f32x4 pre[5]; f32x4 prev = (f32x4){0.f, 0.f, 0.f, 0.f}; float prec = 0.f;
    auto issue = [&](int chunk) {
        const size_t R = rwkv_row(b, dir, chunk * RWS_CH + ls); const size_t o = R * 512 + h * 64 + lc4 * 4;
        pre[0] = *(const f32x4*)(arr0 + o); pre[1] = *(const f32x4*)(arr1 + o); pre[2] = *(const f32x4*)(RW + 4 * AS + o); pre[3] = *(const f32x4*)(RW + 5 * AS + o); pre[4] = *(const f32x4*)(RW + 6 * AS + o);
        if (tid < 256) { const size_t R2 = rwkv_row(b, dir, chunk * RWS_CH + (tid >> 3)); prev = *(const f32x4*)(RW + 7 * AS + R2 * 512 + h * 64 + v0 + (tid & 7) * 4); }
        else if (tid < 320) { const int t2 = tid - 256; const size_t R2 = rwkv_row(b, dir, chunk * RWS_CH + (t2 >> 1)); prec = RSC[(size_t)(t2 & 1) * TT * 8 + R2 * 8 + h]; }
    };
    auto commit = [&](int buf) {
        LAS unsigned char* B = lds + buf * RWS_BUF;
#pragma unroll
        for (int i = 0; i < 5; ++i) *(LAS f32x4*)(B + i * 8192 + ls * 256 + lc4 * 16) = pre[i];
        if (tid < 256) *(LAS f32x4*)(B + RWS_V + (tid >> 3) * 128 + (tid & 7) * 16) = prev;
        else if (tid < 320) *(LAS float*)(B + RWS_C + (tid - 256) * 4) = prec;
    };
    f32x4 S0 = (f32x4){0.f, 0.f, 0.f, 0.f}, S1 = S0;
    const int rl = (wave & 3) * 8 + (lane >> 3), q = lane & 7;
    LAS float* ybuf = (LAS float*)(lds + 2 * RWS_BUF);
    issue(0); commit(0); __syncthreads();
    constexpr int NCH = RJ / RWS_CH;
    struct RwOp { f32x4 w0, w1, r0, r1, k0, k1, n0, n1, a0, a1; float vv; f32x2 cc; };
    for (int ch = 0; ch < NCH; ++ch) {
        if (ch + 1 < NCH) issue(ch + 1);
        if (wave < 4) {
            const LAS unsigned char* B = lds + (ch & 1) * RWS_BUF; const LAS unsigned char* p0 = B + q * 32; const LAS unsigned char* pv = B + RWS_V + rl * 4;
            LAS float* yb = ((q == 0) ? (ybuf + (ch & 1) * 1024) : (ybuf + 2048)) + rl;
            auto ldop = [&](int s) { RwOp o; const LAS unsigned char* p = p0 + s * 256;
                o.w0 = *(const LAS f32x4*)(p); o.w1 = *(const LAS f32x4*)(p + 16); o.r0 = *(const LAS f32x4*)(p + 8192); o.r1 = *(const LAS f32x4*)(p + 8192 + 16);
                o.k0 = *(const LAS f32x4*)(p + 16384); o.k1 = *(const LAS f32x4*)(p + 16384 + 16); o.n0 = *(const LAS f32x4*)(p + 24576); o.n1 = *(const LAS f32x4*)(p + 24576 + 16);
                o.a0 = *(const LAS f32x4*)(p + 32768); o.a1 = *(const LAS f32x4*)(p + 32768 + 16);
                o.vv = *(const LAS float*)(pv + s * 128); o.cc = *(const LAS f32x2*)(B + RWS_C + s * 8); return o; };
            RwOp cur = ldop(0), nx1 = ldop(1);
#pragma unroll
            for (int s = 0; s < RWS_CH; ++s) {
                RwOp nx2 = nx1; if (s + 2 < RWS_CH) nx2 = ldop(s + 2);
                asm volatile("" ::: "memory");
                const f32x4 t0 = S0 * cur.n0 + S1 * cur.n1, t1 = S0 * cur.r0 + S1 * cur.r1;
                float sa = (t0.x + t0.y) + (t0.z + t0.w), pp = (t1.x + t1.y) + (t1.z + t1.w);
                sa = dpp_add<0xB1>(sa); pp = dpp_add<0xB1>(pp); sa = dpp_add<0x4E>(sa); pp = dpp_add<0x4E>(pp); sa = dpp_add<0x141>(sa); pp = dpp_add<0x141>(pp);
                S0 = S0 * cur.w0 + (sa * cur.a0 + cur.vv * cur.k0); S1 = S1 * cur.w1 + (sa * cur.a1 + cur.vv * cur.k1);
                const float y = pp + sa * cur.cc.x + cur.vv * cur.cc.y;
                yb[s * 32] = y;
                cur = nx1; nx1 = nx2;
            }
        } else if (ch > 0) {
            const int t2 = tid - 256, s = t2 >> 3, r4 = t2 & 7; const size_t R = rwkv_row(b, dir, (ch - 1) * RWS_CH + s);
            *(f32x4*)(Yo + R * 512 + h * 64 + v0 + r4 * 4) = *(const LAS f32x4*)(ybuf + ((ch - 1) & 1) * 1024 + s * 32 + r4 * 4);
        }
        if (ch + 1 < NCH) commit((ch + 1) & 1);
        __syncthreads();
    }
    if (wave >= 4) { const int t2 = tid - 256, s = t2 >> 3, r4 = t2 & 7; const size_t R = rwkv_row(b, dir, (NCH - 1) * RWS_CH + s);
        *(f32x4*)(Yo + R * 512 + h * 64 + v0 + r4 * 4) = *(const LAS f32x4*)(ybuf + ((NCH - 1) & 1) * 1024 + s * 32 + r4 * 4); }
    __syncthreads();
}

constexpr int SS_CM = 0, SS_BM = 17408, SS_BST = 34816, SS_XT = 53248, SS_MX = 62464, SS_HB = 71680, SS_CS = 89088, SS_DT = 89344;
__device__ __forceinline__ float bfe(const v4u& v, int i) { const unsigned u = (i < 2) ? v.x : (i < 4) ? v.y : (i < 6) ? v.z : v.w; return (i & 1) ? bfhi(u) : bflo(u); }
__device__ __forceinline__ unsigned short bfraw(const v4u& v, int i) { const unsigned u = (i < 2) ? v.x : (i < 4) ? v.y : (i < 6) ? v.z : v.w; return (unsigned short)((i & 1) ? (u >> 16) : (u & 0xffffu)); }
__device__ __forceinline__ void ssd_scan_fast(KArgs a, int idx, LAS unsigned char* lds, int tid, int lane, int wave) {
    unsigned char* ws = a->ws; const bf16* XBC = (const bf16*)(ws + OFF_XBC); const float* DTA = (const float*)(ws + OFF_DTA);
    const int b = idx / 24, dir = (idx % 24) / 12, h = idx % 12, g = h / 3, q = dir * 12 + h;
    float* Yo = (float*)(ws + OFF_YSSD) + (size_t)dir * TT * 768;
    LAS bf16* Cm = (LAS bf16*)(lds + SS_CM); LAS bf16* Bm = (LAS bf16*)(lds + SS_BM); LAS bf16* BsT = (LAS bf16*)(lds + SS_BST); LAS bf16* XT = (LAS bf16*)(lds + SS_XT);
    LAS bf16* Mx = (LAS bf16*)(lds + SS_MX); LAS bf16* Hb = (LAS bf16*)(lds + SS_HB); LAS float* CS = (LAS float*)(lds + SS_CS); LAS float* DTV = (LAS float*)(lds + SS_DT);
    const int fr = lane & 15, fq = lane >> 4, ss = tid & 63, sc = tid >> 6, tl = wave >> 1, wh = wave & 1;
    { unsigned z = 0u; asm volatile("" : "+v"(z)); for (int i = tid; i < 17408 / 16; i += NTHR) *(LAS v4u*)(lds + SS_HB + i * 16) = (v4u){z, z, z, z}; }
    f32x4 hacc[4];
#pragma unroll
    for (int j = 0; j < 4; ++j) hacc[j] = (f32x4){0.f, 0.f, 0.f, 0.f};
    v4u pc0, pc1, pb0, pb1, px; float pdt = 0.f, pa = 0.f;
    auto issue = [&](int ch) {
        const int tok = ssd_tok(b, dir, ch * 64 + ss); const bf16* row = XBC + (size_t)tok * 1792;
        pc0 = *(const v4u*)(row + 1280 + g * 128 + sc * 8); pc1 = *(const v4u*)(row + 1280 + g * 128 + (sc + 8) * 8);
        pb0 = *(const v4u*)(row + 768 + g * 128 + sc * 8); pb1 = *(const v4u*)(row + 768 + g * 128 + (sc + 8) * 8);
        px = *(const v4u*)(row + h * 64 + sc * 8);
        if (tid < 64) { pdt = DTA[(size_t)tok * 48 + q]; pa = DTA[(size_t)tok * 48 + 24 + q]; }
    };
    issue(0);
    for (int ch = 0; ch < RJ / 64; ++ch) {
        *(LAS v4u*)(Cm + ss * 136 + sc * 8) = pc0; *(LAS v4u*)(Cm + ss * 136 + (sc + 8) * 8) = pc1;
        *(LAS v4u*)(Bm + ss * 136 + sc * 8) = pb0; *(LAS v4u*)(Bm + ss * 136 + (sc + 8) * 8) = pb1;
#pragma unroll
        for (int i = 0; i < 8; ++i) XT[(sc * 8 + i) * 72 + ss] = bfraw(px, i);
        if (tid < 64) { float x = pa;
            x += __int_as_float(__builtin_amdgcn_update_dpp(0, __float_as_int(x), 0x111, 0xf, 0xf, false)); x += __int_as_float(__builtin_amdgcn_update_dpp(0, __float_as_int(x), 0x112, 0xf, 0xf, false));
            x += __int_as_float(__builtin_amdgcn_update_dpp(0, __float_as_int(x), 0x114, 0xf, 0xf, false)); x += __int_as_float(__builtin_amdgcn_update_dpp(0, __float_as_int(x), 0x118, 0xf, 0xf, false));
            x += __int_as_float(__builtin_amdgcn_update_dpp(0, __float_as_int(x), 0x142, 0xa, 0xf, false)); x += __int_as_float(__builtin_amdgcn_update_dpp(0, __float_as_int(x), 0x143, 0xc, 0xf, false));
            CS[tid] = x; DTV[tid] = pdt; }
        __syncthreads();
        const float cl = CS[63];
        { const float scl = DTV[ss] * __expf(cl - CS[ss]);
#pragma unroll
            for (int i = 0; i < 8; ++i) { BsT[(sc * 8 + i) * 72 + ss] = (bf16)f2bf(bfe(pb0, i) * scl); BsT[((sc + 8) * 8 + i) * 72 + ss] = (bf16)f2bf(bfe(pb1, i) * scl); } }
        if (ch + 1 < RJ / 64) issue(ch + 1);
#pragma unroll
        for (int j = 0; j < 2; ++j) { const int tc = wh * 2 + j; f32x4 acc = (f32x4){0.f, 0.f, 0.f, 0.f};
            if (tc <= tl) {
#pragma unroll
                for (int ks = 0; ks < 4; ++ks) { const bf16x8 af = *(const LAS bf16x8*)(Cm + (16 * tl + fr) * 136 + ks * 32 + fq * 8), bf = *(const LAS bf16x8*)(Bm + (16 * tc + fr) * 136 + ks * 32 + fq * 8);
                    acc = __builtin_amdgcn_mfma_f32_16x16x32_bf16(af, bf, acc, 0, 0, 0); } }
            const int s = 16 * tc + fr; const float css = CS[s], dts = DTV[s];
#pragma unroll
            for (int i = 0; i < 4; ++i) { const int l = 16 * tl + 4 * fq + i; const float v = (s <= l) ? acc[i] * __expf(CS[l] - css) * dts : 0.f; Mx[l * 72 + s] = (bf16)f2bf(v); } }
        __syncthreads();
#pragma unroll
        for (int j = 0; j < 2; ++j) { const int tp = wh * 2 + j; f32x4 acc = (f32x4){0.f, 0.f, 0.f, 0.f};
#pragma unroll
            for (int ks = 0; ks < 4; ++ks) { const bf16x8 af = *(const LAS bf16x8*)(Cm + (16 * tl + fr) * 136 + ks * 32 + fq * 8), bf = *(const LAS bf16x8*)(Hb + (16 * tp + fr) * 136 + ks * 32 + fq * 8);
                acc = __builtin_amdgcn_mfma_f32_16x16x32_bf16(af, bf, acc, 0, 0, 0); }
#pragma unroll
            for (int i = 0; i < 4; ++i) acc[i] *= __expf(CS[16 * tl + 4 * fq + i]);
#pragma unroll
            for (int ks = 0; ks < 2; ++ks) { const bf16x8 af = *(const LAS bf16x8*)(Mx + (16 * tl + fr) * 72 + ks * 32 + fq * 8), bf = *(const LAS bf16x8*)(XT + (16 * tp + fr) * 72 + ks * 32 + fq * 8);
                acc = __builtin_amdgcn_mfma_f32_16x16x32_bf16(af, bf, acc, 0, 0, 0); }
#pragma unroll
            for (int i = 0; i < 4; ++i) { const int tok = ssd_tok(b, dir, ch * 64 + 16 * tl + 4 * fq + i); Yo[(size_t)tok * 768 + h * 64 + 16 * tp + fr] = acc[i]; } }
        { const float ecl = __expf(cl);
#pragma unroll
            for (int j = 0; j < 4; ++j) { const int tn = wh * 4 + j; hacc[j] = hacc[j] * ecl;
#pragma unroll
                for (int ks = 0; ks < 2; ++ks) { const bf16x8 af = *(const LAS bf16x8*)(XT + (16 * tl + fr) * 72 + ks * 32 + fq * 8), bf = *(const LAS bf16x8*)(BsT + (16 * tn + fr) * 72 + ks * 32 + fq * 8);
                    hacc[j] = __builtin_amdgcn_mfma_f32_16x16x32_bf16(af, bf, hacc[j], 0, 0, 0); } } }
        __syncthreads();
#pragma unroll
        for (int j = 0; j < 4; ++j) { const int tn = wh * 4 + j;
#pragma unroll
            for (int i = 0; i < 4; ++i) Hb[(16 * tl + 4 * fq + i) * 136 + 16 * tn + fr] = (bf16)f2bf(hacc[j][i]); }
    }
}

constexpr int NPH = 2 + 10 * DEPTH;
#ifndef PROBE_MASK
#define PROBE_MASK 0
#endif
#ifndef PROBE_P0
#define PROBE_P0 0
#endif
#ifndef PROBE_SUB
#define PROBE_SUB 0
#endif
#ifndef PROBE_REPS
#define PROBE_REPS 3
#endif
#define REPS(k) (((PROBE_MASK >> (k)) & 1) ? PROBE_REPS : 1)
constexpr int GATE_LATE = 17;
constexpr int GATE_X = 256;
#ifndef MK_ONE_LAUNCH
#define MK_ONE_LAUNCH 1
#endif

__global__ void __launch_bounds__(NTHR, 2) fwd(Args a_unused) {
    extern __shared__ __attribute__((aligned(16))) unsigned char lds_raw[];
    LAS unsigned char* lds = (LAS unsigned char*)lds_raw;
    const int bid0 = blockIdx.x, G0 = gridDim.x, wave0 = __builtin_amdgcn_readfirstlane(threadIdx.x >> 6);
#define PH_BG int bid = bid0, G = G0; asm volatile("" : "+s"(bid), "+s"(G));
    volatile LAS unsigned* MISCW = (volatile LAS unsigned*)(lds + MISC_OFF);
    if (threadIdx.x < 32) MISCW[threadIdx.x] = 0u;
    __syncthreads();
    const int ph_lo = kargs()->ph_lo, ph_hi = kargs()->ph_hi;
    const bool multi = (ph_hi - ph_lo) > 1;
    XcdBarrier bar; bar.bar = (unsigned*)(kargs()->ws + OFF_CTL) + CW_BAR; bar.x = 0; bar.st = nullptr; bar.wv = wave0;
    if (multi) bar = xcd_barrier_post((unsigned*)(kargs()->ws + OFF_CTL) + CW_BAR, MISCW + 8, wave0);
#define IN(k) (ph_lo <= (k) && (k) < ph_hi)
#define SEAM(k) do { if (IN(k) && IN((k) + 1)) xcd_barrier(bar); } while (0)

    for (int rep = 0; rep < (PROBE_P0 ? PROBE_REPS : 1); ++rep) {
    if (IN(0)) { PH_BG p0_prologue(kargs(), lds, bid, G, wave0); }
    if (rep + 1 < (PROBE_P0 ? PROBE_REPS : 1)) xcd_barrier(bar); }
    SEAM(0);
    if (IN(1)) { PH_BG KArgs a = kargs(); norm_phase(a, 0, nullptr, a->in[I_NORMG] + 0, nullptr, (const float*)(a->ws + OFF_MODV), bid, G, wave0, TT); }
    SEAM(1);

    for (int l = 0; l < DEPTH; ++l) {
        const int pb = 2 + 10 * l;
#define PH_LOCALS PH_BG KArgs a = kargs(); unsigned char* ws = a->ws; unsigned char* wl = ws + OFF_W + (size_t)l * W_LAYER; bf16* Hb = (bf16*)(ws + OFF_H); (void)wl; (void)Hb; \
        const float* ng = a->in[I_NORMG] + (size_t)l * 4 * DM; const float* mv = (const float*)(ws + OFF_MODV) + (size_t)l * 5 * 12288; (void)ng; (void)mv;
        const bool lastl = (l == DEPTH - 1);
        for (int rep = 0; rep < REPS(0); ++rep) {
        if (IN(pb + 0)) { PH_LOCALS
            __syncthreads();
            pg8::Sched2 S; S.A0 = (const char*)Hb; S.B0 = (const char*)(wl + WO_IN); S.A1 = (const char*)(wl + WO_FFT); S.B1 = (const char*)Hb; S.tstep = (size_t)256 * DM * 2; S.ntk = DM / 64;
            S.t0.init(TT / 256, NU / 256 - GATE_LATE); S.t1.init(4, TT / 256); S.G = G; S.c = bid;
            pg8::EpiIn2 E{pg8::EpiInproj{(bf16*)(ws + OFF_U), (float*)(ws + OFF_MISC), NU}, pg8::EpiBf{0, (bf16*)(ws + OFF_VTL), (bf16*)(ws + OFF_VTC)}};
            pg8::gemm_phase<pg8::EpiIn2, pg8::Sched2, true, true>(lds, DM, S, E, wave0);
        }
        if (rep + 1 < REPS(0)) xcd_barrier(bar); }
        SEAM(pb + 0);
        for (int rep = 0; rep < REPS(1); ++rep) {
        if (IN(pb + 1)) { PH_LOCALS PH_IDS
            __syncthreads();
            if (bid < 64) { pg8::Sched2 S; S.A0 = (const char*)(ws + OFF_DFTL); S.B0 = (const char*)(ws + OFF_VTL); S.A1 = S.A0; S.B1 = S.B0; S.tstep = (size_t)256 * 4096 * 2; S.ntk = 64; S.t0.init(8, 8); S.t1.init(0, 0); S.G = 64; S.c = bid;
                  pg8::EpiBf E{1, (bf16*)(ws + OFF_ACAT), nullptr};
                  pg8::gemm_phase<pg8::EpiBf, pg8::Sched2, true, true>(lds, 4096, S, E, wave0); }
            else if (bid < 72) { pg8::Sched2 S; S.A0 = (const char*)(ws + OFF_DFTC); S.B0 = (const char*)(ws + OFF_VTC); S.A1 = S.A0; S.B1 = S.B0; S.tstep = (size_t)256 * 512 * 2; S.ntk = 8; S.t0.init(1, 8); S.t1.init(0, 0); S.G = 8; S.c = bid - 64;
                  pg8::EpiBf E{2, (bf16*)(ws + OFF_ACAT), nullptr};
                  pg8::gemm_phase<pg8::EpiBf, pg8::Sched2, true, true>(lds, 512, S, E, wave0); }
            __syncthreads();
            {
                unsigned* qctr = (unsigned*)(ws + OFF_CTL) + CW_Q + (l * 4 + rep) * 64;
                volatile LAS unsigned* qslot = (volatile LAS unsigned*)(lds + MISC_OFF) + 16;
                for (;;) {
                    if (tid == 0) qslot[0] = __hip_atomic_fetch_add(qctr, 1u, __ATOMIC_RELAXED, __HIP_MEMORY_SCOPE_AGENT);
                    __syncthreads();
                    const int it = (int)qslot[0];
                    __syncthreads();
                    if (it >= 576 + 288 + 576) break;
                    int ln_i = lane; asm volatile("" : "+v"(ln_i)); const int tid_i = wave * 64 + ln_i;
                    if (it < 576) rwkv_prep_item(a, l, it, lds, tid_i, ln_i, wave);
                    else if (it < 576 + 288) conv_item(a, l, it - 576, lds, tid_i, ln_i, wave);
                    else ssd_prep_item(a, l, it - 576 - 288, tid_i);
                }
            }
        }
        if (rep + 1 < REPS(1)) xcd_barrier(bar); }
        SEAM(pb + 1);
        for (int rep = 0; rep < REPS(2); ++rep) {
        if (IN(pb + 2)) { PH_LOCALS PH_IDS
            __syncthreads();
            if (bid < 128) { if (rep == 0 || PROBE_SUB == 0) rwkv_scan_fast(a, bid, lds, tid, lane, wave); }
            else {
                if (bid < 224) { if (rep == 0 || PROBE_SUB == 1) ssd_scan_fast(a, bid - 128, lds, tid, lane, wave); }
                __syncthreads();
                if (rep == 0 || PROBE_SUB == 2) {
                pg8::Sched2 S; S.A0 = (const char*)Hb; S.B0 = (const char*)(wl + WO_IN); S.A1 = S.A0; S.B1 = S.B0; S.tstep = (size_t)256 * DM * 2; S.ntk = DM / 64;
                S.t0.init(TT / 256, GATE_LATE); S.t1.init(0, 0); S.pn_off0 = NU / 256 - GATE_LATE;
                if (bid >= 224) { S.G = 32; S.c = bid - 224; S.first = 0; S.limit = GATE_X; } else { S.G = 96; S.c = bid - 128; S.first = GATE_X; S.limit = 36 * GATE_LATE; }
                pg8::EpiIn2 E{pg8::EpiInproj{(bf16*)(ws + OFF_U), (float*)(ws + OFF_MISC), NU}, pg8::EpiBf{0, (bf16*)(ws + OFF_VTL), (bf16*)(ws + OFF_VTC)}};
                pg8::gemm_phase<pg8::EpiIn2, pg8::Sched2, true, true>(lds, DM, S, E, wave0); }
            }
        }
        if (rep + 1 < REPS(2)) xcd_barrier(bar); }
        SEAM(pb + 2);
        for (int rep = 0; rep < REPS(3); ++rep) {
        if (IN(pb + 3)) { PH_BG post_phase(kargs(), l, bid, G, wave0); }
        if (rep + 1 < REPS(3)) xcd_barrier(bar); }
        SEAM(pb + 3);
        for (int rep = 0; rep < REPS(4); ++rep) {
        if (IN(pb + 4)) { PH_LOCALS
            __syncthreads();
            pg8::Sched2 S; S.A0 = (const char*)(ws + OFF_ACAT); S.B0 = (const char*)(wl + WO_CAT); S.A1 = S.A0; S.B1 = S.B0; S.tstep = (size_t)256 * ACW * 2; S.ntk = ACW / 64;
            S.t0.init(lastl ? TLAT / 256 : TT / 256, DM / 256); S.t1.init(0, 0); S.G = G; S.c = bid;
            pg8::EpiChain E{(const bf16*)(ws + OFF_U) + UGATE, NU, (bf16*)(ws + OFF_M)};
            pg8::gemm_phase<pg8::EpiChain, pg8::Sched2, true, true>(lds, ACW, S, E, wave0);
        }
        if (rep + 1 < REPS(4)) xcd_barrier(bar); }
        SEAM(pb + 4);
        for (int rep = 0; rep < REPS(5); ++rep) {
        if (IN(pb + 5)) { PH_LOCALS
            __syncthreads();
            pg8::SchedSplit S; S.A = (const char*)(ws + OFF_M); S.B = (const char*)(wl + WO_O); S.tstep = (size_t)256 * DM * 2; S.ntk = DM / 64; S.tm.init(32, 8); S.nctx = lastl ? 0 : 256; S.G = G; S.c = bid;
            pg8::EpiF32 E{(float*)(ws + OFF_Y), (float*)(ws + OFF_YC)};
            pg8::gemm_phase<pg8::EpiF32, pg8::SchedSplit, true, true>(lds, DM, S, E, wave0);
        }
        if (rep + 1 < REPS(5)) xcd_barrier(bar); }
        SEAM(pb + 5);
        if (IN(pb + 6)) { PH_LOCALS norm_phase(a, 1, ng + 1 * DM, ng + 2 * DM, mv + 2 * DM, mv + 3 * DM, bid, G, wave0, lastl ? TLAT : TT, !lastl); }
        SEAM(pb + 6);
        for (int rep = 0; rep < REPS(7); ++rep) {
        if (IN(pb + 7)) { PH_LOCALS
            __syncthreads();
            pg8::Sched2 S; S.A0 = (const char*)Hb; S.B0 = (const char*)(wl + WO_UP); S.A1 = S.A0; S.B1 = S.B0; S.tstep = (size_t)256 * DM * 2; S.ntk = DM / 64;
            S.t0.init(lastl ? TLAT / 256 : TT / 256, DFF / 256); S.t1.init(0, 0); S.G = G; S.c = bid;
            pg8::EpiBf E{3, (bf16*)(ws + OFF_HB), nullptr};
            pg8::gemm_phase<pg8::EpiBf, pg8::Sched2, true, true>(lds, DM, S, E, wave0);
        }
        if (rep + 1 < REPS(7)) xcd_barrier(bar); }
        SEAM(pb + 7);
        for (int rep = 0; rep < REPS(8); ++rep) {
        if (IN(pb + 8)) { PH_LOCALS
            __syncthreads();
            pg8::SchedSplit S; S.A = (const char*)(ws + OFF_HB); S.B = (const char*)(wl + WO_DN); S.tstep = (size_t)256 * DFF * 2; S.ntk = DFF / 64; S.tm.init(32, 8); S.nctx = lastl ? 0 : 256; S.G = G; S.c = bid;
            pg8::EpiF32 E{(float*)(ws + OFF_Y), (float*)(ws + OFF_YC)};
            pg8::gemm_phase<pg8::EpiF32, pg8::SchedSplit, true, true>(lds, DFF, S, E, wave0);
        }
        if (rep + 1 < REPS(8)) xcd_barrier(bar); }
        SEAM(pb + 8);
        if (IN(pb + 9)) { PH_LOCALS
            if (!lastl) norm_phase(a, 1, ng + 3 * DM, ng + 4 * DM  , mv + 5 * DM, mv + 5 * 12288  , bid, G, wave0, TT, true);
            else norm_phase(a, 2, ng + 3 * DM, nullptr, mv + 5 * DM, nullptr, bid, G, wave0, TLAT);
        }
        SEAM(pb + 9);
    }
#undef IN
#undef SEAM
}

extern "C" void kernel_launch(void* const* d_in, const int* in_sizes, int n_in, void* d_out, int out_size, void* d_ws, size_t ws_size, hipStream_t stream) {
    static int grid = 0;
    if (grid == 0) {
        if (n_in != N_IN || out_size != TLAT * DM || ws_size < WS_END) { fprintf(stderr, "kernel_launch: unexpected shapes (n_in %d out %d ws %zu); nothing launched\n", n_in, out_size, ws_size); grid = -1; return; }
        int dev = 0, cus = 0;
        if (hipGetDevice(&dev) != hipSuccess || hipDeviceGetAttribute(&cus, hipDeviceAttributeMultiprocessorCount, dev) != hipSuccess) { grid = -1; return; }
        if (hipFuncSetAttribute((const void*)fwd, hipFuncAttributeMaxDynamicSharedMemorySize, LDS_BYTES) != hipSuccess) { fprintf(stderr, "kernel_launch: hipFuncSetAttribute failed\n"); grid = -1; return; }
        int per_cu = 0;
        if (hipOccupancyMaxActiveBlocksPerMultiprocessor(&per_cu, (const void*)fwd, NTHR, LDS_BYTES) != hipSuccess || per_cu < 1) fprintf(stderr, "kernel_launch: occupancy query says %d\n", per_cu);
        (void)hipGetLastError();
        grid = cus;
        if (grid < 232) { fprintf(stderr, "kernel_launch: %d CUs: this kernel's scan phase needs > 160 workgroups\n", grid); grid = -1; return; }
    }
    if (grid < 0) return;
    if (hipMemsetAsync((char*)d_ws + OFF_CTL, 0, CTL_BYTES, stream) != hipSuccess) return;
    Args a{};
    for (int i = 0; i < N_IN; ++i) a.in[i] = (const float*)d_in[i];
    a.out = (float*)d_out; a.ws = (unsigned char*)d_ws;
#if MK_ONE_LAUNCH
    a.ph_lo = 0; a.ph_hi = NPH;
    hipLaunchKernelGGL(fwd, dim3(grid), dim3(NTHR), LDS_BYTES, stream, a);
#else
    for (int p = 0; p < NPH; ++p) { a.ph_lo = p; a.ph_hi = p + 1; hipLaunchKernelGGL(fwd, dim3(grid), dim3(NTHR), LDS_BYTES, stream, a); }
#endif
}
```

```cpp
#include <hip/hip_runtime.h>
#include <cstdio>
#include <cstdint>
namespace pg8 {
#define PG8_LAS __attribute__((address_space(3)))
typedef unsigned short bf16_t;
typedef short bf16x8 __attribute__((ext_vector_type(8)));
typedef float f32x4 __attribute__((ext_vector_type(4)));
typedef unsigned u32x4 __attribute__((ext_vector_type(4)));
constexpr int BM = 256, BK = 64, HALF = 128, HTB = HALF * BK * 2  , STAGE_BYTES = 8 * HTB, NXCD = 8, WGM = 8;

__host__ __device__ __forceinline__ int lds_byte(int r, int c) { const int st = (r >> 4) * 2 + (c >> 5), rr = r & 15, cc = c & 31, ob = rr * 64 + cc * 2; return st * 1024 + (ob ^ (((ob >> 9) & 1) << 5)); }
__host__ __device__ __forceinline__ void stage_rc(int b, int& R, int& C) { const int st = b / 1024, sb = b % 1024, swz = sb ^ (((sb >> 9) & 1) << 5); R = (st >> 1) * 16 + swz / 64; C = (st & 1) * 32 + (swz % 64) / 2; }
__host__ __device__ __forceinline__ int perm32(int rho) { const int n = rho >> 4, i = rho & 15; return 8 * (i >> 2) + 4 * n + (i & 3); }

struct Unit { int pm, pn, kind; };
struct Gemm { const bf16_t* A; const bf16_t* Bt; int M, N, K; };

struct StaticOrder {
    int nM, nN, nwg, G, c;
    __host__ __device__ void init(int M, int N, int G_, int c_) { nM = M / BM; nN = N / BM; nwg = nM * nN; G = G_; c = c_; }
    __host__ __device__ bool next(int i, Unit& u) const {
        const long L = (long)i * G + c; if (L >= nwg) return false;
        int wgid = (int)L; { const int q = nwg / NXCD, r = nwg % NXCD, xcd = wgid % NXCD, off = wgid / NXCD; wgid = (xcd < r ? xcd * (q + 1) : r * (q + 1) + (xcd - r) * q) + off; }
        const int nig = WGM * nN, gid = wgid / nig, fm = gid * WGM, gsz = (nM - fm) < WGM ? (nM - fm) : WGM;
        u.pm = fm + ((wgid % nig) % gsz); u.pn = (wgid % nig) / gsz; return true;
    }
    __device__ __forceinline__ void a_ready(const Unit&) const {}
    __device__ __forceinline__ void done(const Unit&) const {}
};
__device__ __forceinline__ unsigned cvt_pk_bf16(float lo, float hi) { unsigned r; asm volatile("v_cvt_pk_bf16_f32 %0, %1, %2" : "=v"(r) : "v"(lo), "v"(hi)); return r; }
typedef float f32x2 __attribute__((ext_vector_type(2)));
template <class Epi, class Sched, bool ALIGN_EPI = false, bool SP2 = false>
__device__ __forceinline__ void gemm_phase(PG8_LAS unsigned char* lds, const int ldk  , const Sched& S, const Epi& E, const int wave_id) {
    unsigned z_ = 0u; asm volatile("" : "+v"(z_)); const int lane_ = (int)__builtin_amdgcn_mbcnt_hi(~0u, __builtin_amdgcn_mbcnt_lo(~0u, z_)); int wid_ = wave_id; asm volatile("" : "+s"(wid_)); const int wid = wid_, lane = lane_, tid = wid * 64 + lane, wr = wid >> 2, wc = wid & 3, fr = lane & 15, fq = lane >> 4;
    const int K = ldk; int nt;
    unsigned voffA[2], voffB[2];
#pragma unroll
    for (int i = 0; i < 2; ++i) { int R, C; stage_rc(tid * 16 + i * 8192, R, C); const int Rb = Epi::PERM ? ((R & ~31) + perm32(R & 31)) : R;
        voffA[i] = (unsigned)(R * K + C) * 2u; voffB[i] = (unsigned)(Rb * K + C) * 2u; }
    const size_t kstep = (size_t)(BK * 2);
    const size_t hstep = (size_t)HALF * K * 2;
    const unsigned ldsw = (unsigned)wid * 1024u;
    const int aoff = lds_byte(wr * 64 + fr, fq * 8), boff = lds_byte(wc * 32 + fr, fq * 8);
#define PG8_SA(b, h) (((b) * 2 + (h)) * HTB)
#define PG8_SB(b, h) ((4 + (b) * 2 + (h)) * HTB)
#define PG8_STAGE(bufoff, gbase, voff) do { _Pragma("unroll") for (int _i = 0; _i < 2; ++_i) \
        __builtin_amdgcn_global_load_lds((const unsigned*)((const char*)(gbase) + (voff)[_i]), (PG8_LAS unsigned*)(lds + (bufoff) + ldsw + _i * 8192), 16, 0, 0); } while (0)
#define PG8_LDA(dst, b, h) do { _Pragma("unroll") for (int m = 0; m < 4; ++m) _Pragma("unroll") for (int k = 0; k < 2; ++k) dst[m][k] = *(const PG8_LAS bf16x8*)(lds + PG8_SA(b, h) + aoff + m * 2048 + k * 1024); } while (0)
#define PG8_LDB(dst, b, h) do { _Pragma("unroll") for (int n = 0; n < 2; ++n) _Pragma("unroll") for (int k = 0; k < 2; ++k) dst[n][k] = *(const PG8_LAS bf16x8*)(lds + PG8_SB(b, h) + boff + n * 2048 + k * 1024); } while (0)
#define PG8_MMA(ai, bj, At, Bt) do { __builtin_amdgcn_s_setprio(1); _Pragma("unroll") for (int m = 0; m < 4; ++m) _Pragma("unroll") for (int n = 0; n < 2; ++n) _Pragma("unroll") for (int k = 0; k < 2; ++k) \
        acc[ai][bj][m][n] = __builtin_amdgcn_mfma_f32_16x16x32_bf16(Bt[n][k], At[m][k], acc[ai][bj][m][n], 0, 0, 0); __builtin_amdgcn_s_setprio(0); } while (0)
#define PG8_WAIT_V(n) asm volatile("s_waitcnt vmcnt(" #n ")" ::: "memory")
#define PG8_WAIT_L(n) asm volatile("s_waitcnt lgkmcnt(" #n ")" ::: "memory")
#define PG8_BAR __builtin_amdgcn_s_barrier()
#define PG8_SCHED __builtin_amdgcn_sched_barrier(0)
    Unit cur, nxt; int ui = 0;
    if (!S.next(0, cur)) return;
    f32x4 acc[2][2][4][2];
#pragma unroll
    for (int a = 0; a < 2; ++a)
#pragma unroll
        for (int b = 0; b < 2; ++b)
#pragma unroll
            for (int m = 0; m < 4; ++m)
#pragma unroll
                for (int n = 0; n < 2; ++n) acc[a][b][m][n] = (f32x4){0.f, 0.f, 0.f, 0.f};
    bf16x8 At[4][2], B0[2][2], B1[2][2];
    const char* cA = S.abase(cur); const char* cB = S.bbase(cur); nt = S.nt(cur);
    S.a_ready(cur);
    if constexpr (SP2) {
        PG8_STAGE(PG8_SB(0, 0), cB, voffB); PG8_STAGE(PG8_SB(0, 1), cB + hstep, voffB); PG8_STAGE(PG8_SA(0, 0), cA, voffA); PG8_STAGE(PG8_SA(0, 1), cA + hstep, voffA);
        if (wr == 1) PG8_BAR;
        PG8_WAIT_V(2); PG8_BAR;
        PG8_STAGE(PG8_SB(1, 0), cB + kstep, voffB); PG8_STAGE(PG8_SA(1, 0), cA + kstep, voffA); PG8_STAGE(PG8_SB(1, 1), cB + hstep + kstep, voffB);
        PG8_WAIT_V(6); PG8_BAR;
    } else {
        PG8_STAGE(PG8_SB(0, 0), cB, voffB); PG8_STAGE(PG8_SA(0, 0), cA, voffA); PG8_STAGE(PG8_SB(0, 1), cB + hstep, voffB); PG8_STAGE(PG8_SA(0, 1), cA + hstep, voffA);
        if (wr == 1) PG8_BAR;
        PG8_WAIT_V(4); PG8_BAR;
        PG8_STAGE(PG8_SB(1, 0), cB + kstep, voffB); PG8_STAGE(PG8_SA(1, 0), cA + kstep, voffA); PG8_STAGE(PG8_SB(1, 1), cB + hstep + kstep, voffB);
        PG8_WAIT_V(6); PG8_BAR;
    }
    for (;;) {
        const bool has_next = S.next(ui + 1, nxt);
        const char* nA = has_next ? S.abase(nxt) : cA; const char* nB = has_next ? S.bbase(nxt) : cB;
        for (int t = 0; t < nt; t += 2) {
            const bool last = (t == nt - 2);
            const char* a1 = cA + (size_t)(t + 1) * kstep;
            const char* a2 = last ? nA : cA + (size_t)(t + 2) * kstep; const char* b2 = last ? nB : cB + (size_t)(t + 2) * kstep;
            const char* a3 = a2 + kstep; const char* b3 = b2 + kstep;
            if (last && has_next) S.a_ready(nxt);
            if constexpr (Epi::HOOK) E.khook(acc, cur, t, wr, wc, fr, fq);
            if constexpr (SP2) {
            PG8_LDB(B0, 0, 0); PG8_LDB(B1, 0, 1); PG8_SCHED; PG8_LDA(At, 0, 0); PG8_STAGE(PG8_SA(1, 1), a1 + hstep, voffA);
            PG8_WAIT_V(8); PG8_WAIT_L(0); PG8_BAR; PG8_MMA(0, 0, At, B0); PG8_MMA(0, 1, At, B1); PG8_BAR; PG8_SCHED;
            PG8_LDA(At, 0, 1); PG8_STAGE(PG8_SB(0, 0), b2, voffB); PG8_STAGE(PG8_SB(0, 1), b2 + hstep, voffB); PG8_STAGE(PG8_SA(0, 0), a2, voffA);
            PG8_WAIT_V(8); PG8_WAIT_L(0); PG8_BAR; PG8_MMA(1, 0, At, B0); PG8_MMA(1, 1, At, B1); PG8_BAR; PG8_SCHED;
            PG8_LDB(B0, 1, 0); PG8_LDB(B1, 1, 1); PG8_SCHED; PG8_LDA(At, 1, 0); PG8_STAGE(PG8_SA(0, 1), a2 + hstep, voffA);
            PG8_WAIT_V(8); PG8_WAIT_L(0); PG8_BAR; PG8_MMA(0, 0, At, B0); PG8_MMA(0, 1, At, B1); PG8_BAR; PG8_SCHED;
            PG8_LDA(At, 1, 1); PG8_STAGE(PG8_SB(1, 0), b3, voffB); PG8_STAGE(PG8_SB(1, 1), b3 + hstep, voffB); PG8_STAGE(PG8_SA(1, 0), a3, voffA);
            PG8_WAIT_V(8); PG8_WAIT_L(0); PG8_BAR; PG8_MMA(1, 0, At, B0); PG8_MMA(1, 1, At, B1); PG8_BAR; PG8_SCHED;
            } else {
            PG8_LDB(B0, 0, 0); PG8_SCHED; PG8_LDA(At, 0, 0); PG8_STAGE(PG8_SA(1, 1), a1 + hstep, voffA);
            PG8_WAIT_L(8); PG8_BAR; PG8_WAIT_L(0); PG8_MMA(0, 0, At, B0); PG8_BAR; PG8_SCHED;
            PG8_LDB(B1, 0, 1); PG8_STAGE(PG8_SB(0, 0), b2, voffB);
            PG8_BAR; PG8_WAIT_L(0); PG8_MMA(0, 1, At, B1); PG8_BAR;
            PG8_LDA(At, 0, 1); PG8_STAGE(PG8_SA(0, 0), a2, voffA);
            PG8_BAR; PG8_WAIT_L(0); PG8_MMA(1, 0, At, B0); PG8_BAR; PG8_SCHED;
            PG8_STAGE(PG8_SB(0, 1), b2 + hstep, voffB);
            PG8_WAIT_V(6); PG8_BAR; PG8_MMA(1, 1, At, B1); PG8_BAR;
            PG8_LDB(B0, 1, 0); PG8_SCHED; PG8_LDA(At, 1, 0); PG8_STAGE(PG8_SA(0, 1), a2 + hstep, voffA);
            PG8_WAIT_L(8); PG8_BAR; PG8_WAIT_L(0); PG8_MMA(0, 0, At, B0); PG8_BAR; PG8_SCHED;
            PG8_LDB(B1, 1, 1); PG8_STAGE(PG8_SB(1, 0), b3, voffB);
            PG8_BAR; PG8_WAIT_L(0); PG8_MMA(0, 1, At, B1); PG8_BAR;
            PG8_LDA(At, 1, 1); PG8_STAGE(PG8_SA(1, 0), a3, voffA);
            PG8_BAR; PG8_WAIT_L(0); PG8_MMA(1, 0, At, B0); PG8_BAR; PG8_SCHED;
            PG8_STAGE(PG8_SB(1, 1), b3 + hstep, voffB);
            PG8_WAIT_V(6); PG8_BAR; PG8_MMA(1, 1, At, B1); PG8_BAR;
            }
        }
        if constexpr (ALIGN_EPI) { if (wr == 0) PG8_BAR; }
        if constexpr (!Epi::AFTER_DRAIN) { E(acc, cur, wr, wc, fr, fq); S.done(cur); }
        if (!has_next) break;
#pragma unroll
        for (int a = 0; a < 2; ++a)
#pragma unroll
            for (int b = 0; b < 2; ++b)
#pragma unroll
                for (int m = 0; m < 4; ++m)
#pragma unroll
                    for (int n = 0; n < 2; ++n) acc[a][b][m][n] = (f32x4){0.f, 0.f, 0.f, 0.f};
        cur = nxt; cA = nA; cB = nB; ++ui; nt = S.nt(cur);
        if constexpr (ALIGN_EPI) { if (wr == 1) PG8_BAR; }
    }
    PG8_WAIT_V(0);
    if constexpr (!ALIGN_EPI) { if (wr == 0) PG8_BAR; }
    PG8_BAR;
    if constexpr (Epi::AFTER_DRAIN) { E.fused(acc, cur, wr, wc, fr, fq, lds, wid, lane); S.done(cur); }
#undef PG8_SA
#undef PG8_SB
#undef PG8_STAGE
#undef PG8_LDA
#undef PG8_LDB
#undef PG8_MMA
#undef PG8_WAIT_V
#undef PG8_WAIT_L
#undef PG8_BAR
#undef PG8_SCHED
}
}

namespace pg8 {
__device__ __forceinline__ float sigm(float x) { return __builtin_amdgcn_rcpf(1.f + __expf(-x)); }
__device__ __forceinline__ f32x4 sigm4(f32x4 v) { return (f32x4){sigm(v[0]), sigm(v[1]), sigm(v[2]), sigm(v[3])}; }
__device__ __forceinline__ u32x4 pack8(f32x4 v0, f32x4 v1) { u32x4 w; w.x = cvt_pk_bf16(v0[0], v0[1]); w.y = cvt_pk_bf16(v0[2], v0[3]); w.z = cvt_pk_bf16(v1[0], v1[1]); w.w = cvt_pk_bf16(v1[2], v1[3]); return w; }
__device__ __forceinline__ float bflo(unsigned u) { return __uint_as_float(u << 16); }
__device__ __forceinline__ float bfhi(unsigned u) { return __uint_as_float(u & 0xffff0000u); }


struct TileMap {
    int nM, nN, nwg;
    __device__ __forceinline__ void init(int nM_, int nN_) { nM = nM_; nN = nN_; nwg = nM_ * nN_; }
    __device__ __forceinline__ void map(int L, int& pm, int& pn) const {
        int wgid = L; { const int q = nwg / NXCD, r = nwg % NXCD, xcd = wgid % NXCD, off = wgid / NXCD; wgid = (xcd < r ? xcd * (q + 1) : r * (q + 1) + (xcd - r) * q) + off; }
        const int nig = WGM * nN, gid = wgid / nig, fm = gid * WGM, gsz = (nM - fm) < WGM ? (nM - fm) : WGM;
        pm = fm + ((wgid % nig) % gsz); pn = (wgid % nig) / gsz;
    }
};
struct Sched2 {
    const char *A0, *B0, *A1, *B1; size_t tstep; int ntk; TileMap t0, t1; int G, c;
    int pn_off0 = 0, first = 0, limit = 0x7fffffff;
    __device__ __forceinline__ bool next(int i, Unit& u) const { const int L = first + i * G + c;
        if (L >= limit) return false;
        if (L < t0.nwg) { t0.map(L, u.pm, u.pn); u.pn += pn_off0; u.kind = 0; return true; }
        if (L - t0.nwg < t1.nwg) { t1.map(L - t0.nwg, u.pm, u.pn); u.kind = 1; return true; }
        return false; }
    __device__ __forceinline__ const char* abase(const Unit& u) const { return (u.kind ? A1 : A0) + (size_t)u.pm * tstep; }
    __device__ __forceinline__ const char* bbase(const Unit& u) const { return (u.kind ? B1 : B0) + (size_t)u.pn * tstep; }
    __device__ __forceinline__ int nt(const Unit&) const { return ntk; }
    __device__ __forceinline__ void a_ready(const Unit&) const {}
    __device__ __forceinline__ void done(const Unit&) const {}
};
struct SchedSplit {
    const char *A, *B; size_t tstep; int ntk; TileMap tm; int nctx, G, c;
    __device__ __forceinline__ bool next(int i, Unit& u) const { const int L = i * G + c;
        if (L < 256) { tm.map(L, u.pm, u.pn); u.kind = 0; return true; }
        const int e = L - 256; if (e < nctx) { const int tile = e & 31; u.pm = 32 + (tile >> 3); u.pn = tile & 7; u.kind = 1 + (e >> 5); return true; }
        return false; }
    __device__ __forceinline__ const char* abase(const Unit& u) const { return A + (size_t)u.pm * tstep + (u.kind ? (size_t)(u.kind - 1) * (ntk / 8) * 128 : 0); }
    __device__ __forceinline__ const char* bbase(const Unit& u) const { return B + (size_t)u.pn * tstep + (u.kind ? (size_t)(u.kind - 1) * (ntk / 8) * 128 : 0); }
    __device__ __forceinline__ int nt(const Unit& u) const { return u.kind ? ntk / 8 : ntk; }
    __device__ __forceinline__ void a_ready(const Unit&) const {}
    __device__ __forceinline__ void done(const Unit&) const {}
};
struct EpiInproj {
    static constexpr bool PERM = true, AFTER_DRAIN = false, HOOK = false;
    bf16_t* U; float* MISC; int ldu;
    __device__ __forceinline__ void operator()(const f32x4 (&acc)[2][2][4][2], const Unit& u, int wr, int wc, int fr, int fq) const {
        const int row0 = u.pm * BM + wr * 64 + fr, cl = wc * 32 + 8 * fq;
        if (u.pn == 16 || u.pn == 17) {
#pragma unroll
            for (int ai = 0; ai < 2; ++ai)
#pragma unroll
                for (int m = 0; m < 4; ++m) { float* rowp = MISC + (size_t)(row0 + ai * HALF + m * 16) * 512 + (u.pn - 16) * BM + cl;
#pragma unroll
                    for (int bj = 0; bj < 2; ++bj) { *(f32x4*)(rowp + bj * HALF) = acc[ai][bj][m][0]; *(f32x4*)(rowp + bj * HALF + 4) = acc[ai][bj][m][1]; } }
        } else {
            const bool sg = u.pn >= 22;
#pragma unroll
            for (int ai = 0; ai < 2; ++ai)
#pragma unroll
                for (int m = 0; m < 4; ++m) { bf16_t* rowp = U + (size_t)(row0 + ai * HALF + m * 16) * ldu + u.pn * BM + cl;
#pragma unroll
                    for (int bj = 0; bj < 2; ++bj) { f32x4 v0 = acc[ai][bj][m][0], v1 = acc[ai][bj][m][1];
                        if (sg) { v0 = sigm4(v0); v1 = sigm4(v1); }
                        *(u32x4*)(rowp + bj * HALF) = pack8(v0, v1); } }
        }
    }
};
struct EpiBf {
    static constexpr bool PERM = true, AFTER_DRAIN = false, HOOK = false;
    int kind; bf16_t* O0; bf16_t* O1;
    __device__ __forceinline__ void operator()(const f32x4 (&acc)[2][2][4][2], const Unit& u, int wr, int wc, int fr, int fq) const {
        bf16_t* base; size_t pitch;
        if (kind == 0) {
            const int half = u.pm >> 1, chb = (u.pm & 1) * 256;
            if (u.pn < 32) { const int b = u.pn >> 3, l0 = (u.pn & 7) * 256; pitch = 4096; base = O0 + ((size_t)(b * 512 + chb) * 2 + half) * 2048 + l0; }
            else { const int b = u.pn - 32; pitch = 512; base = O1 + ((size_t)(b * 512 + chb) * 2 + half) * 256; }
        } else if (kind == 1) { const int b = u.pn >> 1; pitch = 2304; base = O0 + (size_t)(b * 2048 + u.pm * 256) * 2304 + 1280 + (u.pn & 1) * 256; }
        else if (kind == 2) { const int b = u.pn >> 1; pitch = 2304; base = O0 + (size_t)(8192 + b * 256) * 2304 + 1280 + (u.pn & 1) * 256; }
        else { pitch = 8192; base = O0 + (size_t)(u.pm * 256) * 8192 + u.pn * 256; }
        const int r0 = wr * 64 + fr, cl = wc * 32 + 8 * fq;
#pragma unroll
        for (int ai = 0; ai < 2; ++ai)
#pragma unroll
            for (int m = 0; m < 4; ++m) { bf16_t* rowp = base + (size_t)(r0 + ai * HALF + m * 16) * pitch + cl;
#pragma unroll
                for (int bj = 0; bj < 2; ++bj) { f32x4 v0 = acc[ai][bj][m][0], v1 = acc[ai][bj][m][1];
                    if (kind == 3) { v0 = __builtin_elementwise_max(v0, (f32x4){0.f, 0.f, 0.f, 0.f}); v1 = __builtin_elementwise_max(v1, (f32x4){0.f, 0.f, 0.f, 0.f}); v0 = v0 * v0; v1 = v1 * v1; }
                    *(u32x4*)(rowp + bj * HALF) = pack8(v0, v1); } }
    }
};
struct EpiChain {
    static constexpr bool PERM = true, AFTER_DRAIN = false, HOOK = true;
    const bf16_t* G; int ldg; bf16_t* Mo;
    __device__ __forceinline__ void khook(f32x4 (&acc)[2][2][4][2], const Unit& u, int t, int wr, int wc, int fr, int fq) const {
        if (t != 8 && t != 20 && t != 28) return;
        const int i = (t == 8) ? 0 : (t == 20 ? 1 : 2);
        int row0 = u.pm * BM + wr * 64 + fr; const int col0 = u.pn * BM + wc * 32 + 8 * fq + i * 2048;
        asm volatile("" : "+v"(row0));
#pragma unroll
        for (int ai = 0; ai < 2; ++ai)
#pragma unroll
            for (int m = 0; m < 4; ++m) { const bf16_t* gp = G + (size_t)(row0 + ai * HALF + m * 16) * ldg + col0;
#pragma unroll
                for (int bj = 0; bj < 2; ++bj) { const u32x4 g = *(const u32x4*)(gp + bj * HALF), h = *(const u32x4*)(gp + bj * HALF + 2048);
                    const unsigned gw[4] = {g.x, g.y, g.z, g.w}, hw[4] = {h.x, h.y, h.z, h.w};
#pragma unroll
                    for (int e2 = 0; e2 < 4; ++e2) { const float r0 = fmaxf(bflo(gw[e2]), 1e-6f) * __builtin_amdgcn_rcpf(fmaxf(bflo(hw[e2]), 1e-6f)), r1 = fmaxf(bfhi(gw[e2]), 1e-6f) * __builtin_amdgcn_rcpf(fmaxf(bfhi(hw[e2]), 1e-6f));
                        acc[ai][bj][m][e2 >> 1][(e2 & 1) * 2] *= r0; acc[ai][bj][m][e2 >> 1][(e2 & 1) * 2 + 1] *= r1; } }
                asm volatile("" ::: "memory"); }
    }
    __device__ __forceinline__ void operator()(const f32x4 (&acc)[2][2][4][2], const Unit& u, int wr, int wc, int fr, int fq) const {
        const int row0 = u.pm * BM + wr * 64 + fr, col0 = u.pn * BM + wc * 32 + 8 * fq;
#pragma unroll
        for (int ai = 0; ai < 2; ++ai)
#pragma unroll
            for (int m = 0; m < 4; ++m) { const size_t row = (size_t)(row0 + ai * HALF + m * 16);
#pragma unroll
                for (int bj = 0; bj < 2; ++bj) { const int col = col0 + bj * HALF;
                    const u32x4 g = *(const u32x4*)(G + row * ldg + col + 3 * 2048);
                    const f32x4 v0 = acc[ai][bj][m][0] * (f32x4){fmaxf(bflo(g.x), 1e-6f), fmaxf(bfhi(g.x), 1e-6f), fmaxf(bflo(g.y), 1e-6f), fmaxf(bfhi(g.y), 1e-6f)};
                    const f32x4 v1 = acc[ai][bj][m][1] * (f32x4){fmaxf(bflo(g.z), 1e-6f), fmaxf(bfhi(g.z), 1e-6f), fmaxf(bflo(g.w), 1e-6f), fmaxf(bfhi(g.w), 1e-6f)};
                    *(u32x4*)(Mo + row * 2048 + col) = pack8(v0, v1); } }
    }
};
struct EpiF32 {
    static constexpr bool PERM = false, AFTER_DRAIN = false, HOOK = false;
    float* C; float* YC;
    __device__ __forceinline__ void operator()(const f32x4 (&acc)[2][2][4][2], const Unit& u, int wr, int wc, int fr, int fq) const {
        const int row0 = u.pm * BM + wr * 64 + fr, col0 = u.pn * BM + wc * 32 + 4 * fq;
        float* base = u.kind ? (YC + (size_t)(u.kind - 1) * 1024 * 2048 + (size_t)(row0 - 8192) * 2048) : (C + (size_t)row0 * 2048);
#pragma unroll
        for (int ai = 0; ai < 2; ++ai)
#pragma unroll
            for (int m = 0; m < 4; ++m) { float* rowp = base + (size_t)(ai * HALF + m * 16) * 2048 + col0;
#pragma unroll
                for (int bj = 0; bj < 2; ++bj)
#pragma unroll
                    for (int n = 0; n < 2; ++n) *(f32x4*)(rowp + bj * HALF + n * 16) = acc[ai][bj][m][n]; }
    }
};
struct EpiIn2 {
    static constexpr bool PERM = true, AFTER_DRAIN = false, HOOK = false;
    EpiInproj e0; EpiBf e1;
    __device__ __forceinline__ void operator()(const f32x4 (&acc)[2][2][4][2], const Unit& u, int wr, int wc, int fr, int fq) const { if (u.kind == 0) e0(acc, u, wr, wc, fr, fq); else e1(acc, u, wr, wc, fr, fq); }
};
}

#define GAS __attribute__((address_space(1)))
#define LAS __attribute__((address_space(3)))
typedef unsigned short bf16;
typedef unsigned v4u __attribute__((ext_vector_type(4)));
typedef unsigned v2u __attribute__((ext_vector_type(2)));
typedef float f32x4 __attribute__((ext_vector_type(4)));
typedef float f32x2 __attribute__((ext_vector_type(2)));
constexpr int NWAVES = 8, NTHR = 512;
constexpr int DM = 2048, NBATCH = 4, LSEQ = 2048, LCTX = 256, DEPTH = 4;
constexpr int TLAT = NBATCH * LSEQ, TCTX = NBATCH * LCTX, TT = TLAT + TCTX;
constexpr int IN_DIM = 14168, DFF = 8192;
constexpr int NU = 13824;
constexpr int UZ = 0, UXBC = 768, URKV = 2560, UMISC = 4096, UCONV = 4608, UGATE = 5632;
constexpr int S_RKV = 2584, S_DT = 2560, S_WF = 4120, S_CONV = 4440, S_FFT = 5464, S_GATE = 5976;
constexpr int RJ = LCTX + LSEQ;
enum { I_X = 0, I_C, I_CTX, I_CCTX, I_MODW, I_MODB, I_NORMG, I_WIN, I_CONVW, I_CONVB, I_CLNG, I_CLNB, I_CONVOUT, I_SCW, I_SCB, I_SALOG, I_SDTB, I_SD, I_SNG, I_SOUT,
       I_FOUT, I_RMU, I_RW0, I_RW2, I_RA0, I_RA2, I_RG2, I_RKK, I_RKA, I_RRK, I_RLNG, I_RLNB, I_ROUT, I_WO, I_UP, I_DOWN, N_IN };
constexpr size_t MiB = 1u << 20;
constexpr size_t OFF_CTL = 0, CTL_BYTES = 1 * MiB;
constexpr size_t OFF_MODV = 1 * MiB;
constexpr size_t OFF_DFTL = 2 * MiB;
constexpr size_t OFF_DFTC = 18 * MiB;
constexpr size_t OFF_W = 20 * MiB, W_LAYER = 139 * MiB;
constexpr size_t WO_IN = 0, WO_FFT = 54 * MiB, WO_CAT = 58 * MiB  , WO_O = 67 * MiB, WO_UP = 75 * MiB, WO_DN = 107 * MiB;
constexpr size_t OFF_X = 576 * MiB;
constexpr size_t OFF_H = 648 * MiB;
constexpr size_t OFF_U = 684 * MiB;
constexpr size_t OFF_HB = OFF_U;
constexpr size_t OFF_MISC = 927 * MiB;
constexpr size_t OFF_VTL = 945 * MiB;
constexpr size_t OFF_VTC = 961 * MiB;
constexpr size_t OFF_ACAT = 963 * MiB;
constexpr int AC_CONV = 0, AC_SSD = 512, AC_FFT = 1280, AC_RWKV = 1792, ACW = 2304;
constexpr size_t OFF_XBC = 1004 * MiB;
constexpr size_t OFF_DTA = 1036 * MiB;
constexpr size_t OFF_YSSD = 1038 * MiB;
constexpr size_t OFF_RW = 1092 * MiB, RW_ARR = 18 * MiB;
constexpr size_t OFF_RCH = OFF_RW;
constexpr size_t OFF_RSC = 1254 * MiB;
constexpr size_t OFF_YRW = 1255 * MiB;
constexpr size_t OFF_MBUF = 1291 * MiB;
constexpr size_t OFF_M = 1363 * MiB;
constexpr size_t OFF_Y = 1399 * MiB;
constexpr size_t OFF_WLT = 1471 * MiB;
constexpr size_t OFF_YC = 1473 * MiB;
constexpr size_t WS_END = 1537 * MiB;
constexpr int CW_Q = 8192;
constexpr int CW_BAR = 4096;
constexpr int RING_BYTES = 131072, MISC_OFF = RING_BYTES + 320, LDS_BYTES = 147456;

__device__ __forceinline__ float bf2f(unsigned short b) { return __uint_as_float((unsigned)b << 16); }
__device__ __forceinline__ float bflo(unsigned u) { return __uint_as_float(u << 16); }
__device__ __forceinline__ float bfhi(unsigned u) { return __uint_as_float(u & 0xffff0000u); }
__device__ __forceinline__ unsigned f2bf(float f) { unsigned u = __builtin_bit_cast(unsigned, f); return (u + 0x7fffu + ((u >> 16) & 1u)) >> 16; }
__device__ __forceinline__ unsigned pk2(float lo, float hi) { return f2bf(lo) | (f2bf(hi) << 16); }
__device__ __forceinline__ float sigmoidf_(float x) { return 1.f / (1.f + __expf(-x)); }
__device__ __forceinline__ float siluf_(float x) { return x / (1.f + __expf(-x)); }
__device__ __forceinline__ float softplusf_(float x) { return fmaxf(x, 0.f) + log1pf(__expf(-fabsf(x))); }
template <int CTRL> __device__ __forceinline__ float dpp_add(float x) { return x + __int_as_float(__builtin_amdgcn_update_dpp(0, __float_as_int(x), CTRL, 0xf, 0xf, true)); }
__device__ __forceinline__ float sum8(float x) { x = dpp_add<0xB1>(x); x = dpp_add<0x4E>(x); x = dpp_add<0x141>(x); return x; }
__device__ __forceinline__ float row16_sum(float x) { x = sum8(x); x = dpp_add<0x140>(x); return x; }
__device__ __forceinline__ float wave_sum(float v) {
    const float r = row16_sum(v);
    return (__int_as_float(__builtin_amdgcn_readlane(__float_as_int(r), 0)) + __int_as_float(__builtin_amdgcn_readlane(__float_as_int(r), 16))) +
           (__int_as_float(__builtin_amdgcn_readlane(__float_as_int(r), 32)) + __int_as_float(__builtin_amdgcn_readlane(__float_as_int(r), 48)));
}
#define LDS_WAIT() asm volatile("s_waitcnt lgkmcnt(0)" ::: "memory")

struct Args { const float* in[N_IN]; float* out; unsigned char* ws; int ph_lo, ph_hi; };
typedef const __attribute__((address_space(4))) Args* KArgs;
__device__ __forceinline__ KArgs kargs() { KArgs p = (KArgs)__builtin_amdgcn_kernarg_segment_ptr(); asm volatile("" : "+s"(p)); return p; }
#define PH_IDS unsigned z_ = 0u; asm volatile("" : "+v"(z_)); const int lane_ = (int)__builtin_amdgcn_mbcnt_hi(~0u, __builtin_amdgcn_mbcnt_lo(~0u, z_)); int wv_ = wave0; asm volatile("" : "+s"(wv_)); const int lane = lane_, wave = wv_, tid = wv_ * 64 + lane_; (void)lane; (void)wave; (void)tid;

__device__ __forceinline__ int inmap(int n) {
    if (n < 2560) return n;
    if (n < 4096) return S_RKV + (n - 2560);
    if (n < 4608) { const int m = n - 4096; if (m < 24) return S_DT + m; if (m < 64) return -1; if (m < 384) return S_WF + (m - 64); return -1; }
    if (n < 5632) return S_CONV + (n - 4608);
    return S_GATE + (n - 5632);
}
__device__ __forceinline__ int rwkv_tok(int b, int j) { if (j < LCTX) return TLAT + b * LCTX + j; const int s = j - LCTX; return b * LSEQ + (s & 31) * 64 + (s >> 5); }

__device__ __forceinline__ void transpose_item(const float* W, int ldw, int Nsrc, bf16* WT, int k0, int n0, bool mapped, LAS float* scr, int lane, int koff = 0) {
    const int nn = lane & 31; const int sc = mapped ? inmap(n0 + nn) : (n0 + nn);
    float v[32];
#pragma unroll
    for (int i = 0; i < 32; ++i) { const int kk = 2 * i + (lane >> 5); v[i] = (sc >= 0) ? W[(size_t)(k0 + kk) * Nsrc + sc] : 0.f; }
#pragma unroll
    for (int i = 0; i < 32; ++i) { const int kk = 2 * i + (lane >> 5); scr[kk * 33 + nn] = v[i]; }
    LDS_WAIT();
    const int c = lane & 7;
#pragma unroll
    for (int j = 0; j < 4; ++j) { const int n = (lane >> 3) + 8 * j; const LAS float* s = scr + (8 * c) * 33 + n;
        v4u o; o.x = pk2(s[0 * 33], s[1 * 33]); o.y = pk2(s[2 * 33], s[3 * 33]); o.z = pk2(s[4 * 33], s[5 * 33]); o.w = pk2(s[6 * 33], s[7 * 33]);
        *(v4u*)(WT + (size_t)(n0 + n) * ldw + koff + k0 + 8 * c) = o; }
    LDS_WAIT();
}
constexpr int IT_IN = 32 * (NU / 32), IT_CO = 8 * 64, IT_SO = 12 * 64, IT_FO = 8 * 64, IT_RO = 8 * 64, IT_O = 32 * 64, IT_UP = 32 * 256, IT_DN = 128 * 64;
constexpr int IT_LAYER = IT_IN + IT_CO + IT_SO + IT_FO + IT_RO + IT_O + IT_UP + IT_DN;

__device__ __forceinline__ void p0_prologue(KArgs a, LAS unsigned char* lds, int bid, int G, const int wave0) {
    PH_IDS
    unsigned char* ws = a->ws;
    {
        LAS float* sc = (LAS float*)lds;
        LAS float* part = (LAS float*)(lds + 40960);
        for (int i = tid; i < 5 * DM; i += NTHR) { const float v = (i < 4 * DM) ? a->in[I_C][i] : a->in[I_CCTX][i - 4 * DM]; sc[i] = siluf_(v); }
        __syncthreads();
        float* MODV = (float*)(ws + OFF_MODV);
        for (int it = bid; it < DEPTH * 192; it += G) {
            const int l = it / 192, j = (it % 192) * 64 + lane;
            const float* wp = a->in[I_MODW] + (size_t)l * DM * 12288 + (size_t)(wave * 256) * 12288 + j;
            float acc[5] = {0.f, 0.f, 0.f, 0.f, 0.f};
#pragma unroll 1
            for (int k0 = 0; k0 < 256; k0 += 32) { float w[32];
#pragma unroll
                for (int k = 0; k < 32; ++k) w[k] = wp[(size_t)(k0 + k) * 12288];
#pragma unroll
                for (int k = 0; k < 32; ++k)
#pragma unroll
                    for (int r = 0; r < 5; ++r) acc[r] += sc[r * DM + wave * 256 + k0 + k] * w[k]; }
#pragma unroll
            for (int r = 0; r < 5; ++r) part[(wave * 5 + r) * 64 + lane] = acc[r];
            __syncthreads();
            if (tid < 320) { const int r = tid >> 6, jj = tid & 63; float s = 0.f;
#pragma unroll
                for (int w = 0; w < 8; ++w) s += part[(w * 5 + r) * 64 + jj];
                const int jo = (it % 192) * 64 + jj; MODV[((size_t)l * 5 + r) * 12288 + jo] = s + a->in[I_MODB][l * 12288 + jo]; }
            __syncthreads();
        }
    }
    {
        LAS float* wt = (LAS float*)lds;
        LAS float* ctab = (LAS float*)(lds + 32768);
        LAS float* scr = (LAS float*)(lds + 32768 + 512 + wave * 8448);
        __syncthreads();
        if (tid < 128) ctab[tid] = cospif((float)tid * (1.f / 64.f));
        for (int it = bid; it < DEPTH * 32 * 4; it += G) {
            const int l = it / 128, kb = (it % 128) / 4, g = it % 4, k0 = kb * 64;
            __syncthreads();
            for (int i = tid; i < 64 * 32; i += NTHR) { const int kk = i >> 5, c4 = i & 31;
                *(LAS f32x4*)(wt + kk * 128 + c4 * 4) = *(const f32x4*)(a->in[I_WIN] + ((size_t)l * DM + k0 + kk) * IN_DIM + S_FFT + g * 128 + c4 * 4); }
            __syncthreads();
            const int half = wave >> 2, cp = (wave & 3) * 32 + (lane & 31), n0 = half * 512 + g * 128 + (wave & 3) * 32;
#pragma unroll 1
            for (int i = 0; i < 32; ++i) { const int kk = 2 * i + (lane >> 5); float s = 0.f;
#pragma unroll 8
                for (int c = 0; c < 128; ++c) s += wt[kk * 128 + c] * ctab[(c * cp - 32 * half) & 127];
                scr[kk * 33 + (lane & 31)] = s; }
            LDS_WAIT();
            bf16* WT = (bf16*)(ws + OFF_W + (size_t)l * W_LAYER + WO_FFT);
            const int c = lane & 7;
#pragma unroll
            for (int j = 0; j < 4; ++j) { const int n = (lane >> 3) + 8 * j; const LAS float* s = scr + (8 * c) * 33 + n;
                v4u o; o.x = pk2(s[0 * 33], s[1 * 33]); o.y = pk2(s[2 * 33], s[3 * 33]); o.z = pk2(s[4 * 33], s[5 * 33]); o.w = pk2(s[6 * 33], s[7 * 33]);
                *(v4u*)(WT + (size_t)(n0 + n) * DM + k0 + 8 * c) = o; }
            LDS_WAIT();
        }
        __syncthreads();
    }
    const int gw = bid * NWAVES + wave, NGW = G * NWAVES;
    {
        LAS float* scr = (LAS float*)(lds + wave * 8448);
        for (int it = gw; it < DEPTH * IT_LAYER; it += NGW) {
            const int l = it / IT_LAYER; int r = it % IT_LAYER; unsigned char* wl = ws + OFF_W + (size_t)l * W_LAYER;
            if (r < IT_IN) { const int kb = r / (NU / 32), nb = r % (NU / 32); transpose_item(a->in[I_WIN] + (size_t)l * DM * IN_DIM, DM, IN_DIM, (bf16*)(wl + WO_IN), kb * 64, nb * 32, true, scr, lane); continue; } r -= IT_IN;
            if (r < IT_CO) { transpose_item(a->in[I_CONVOUT] + (size_t)l * 512 * DM, ACW, DM, (bf16*)(wl + WO_CAT), (r / 64) * 64, (r % 64) * 32, false, scr, lane, AC_CONV); continue; } r -= IT_CO;
            if (r < IT_SO) { transpose_item(a->in[I_SOUT] + (size_t)l * 768 * DM, ACW, DM, (bf16*)(wl + WO_CAT), (r / 64) * 64, (r % 64) * 32, false, scr, lane, AC_SSD); continue; } r -= IT_SO;
            if (r < IT_FO) { transpose_item(a->in[I_FOUT] + (size_t)l * 512 * DM, ACW, DM, (bf16*)(wl + WO_CAT), (r / 64) * 64, (r % 64) * 32, false, scr, lane, AC_FFT); continue; } r -= IT_FO;
            if (r < IT_RO) { transpose_item(a->in[I_ROUT] + (size_t)l * 512 * DM, ACW, DM, (bf16*)(wl + WO_CAT), (r / 64) * 64, (r % 64) * 32, false, scr, lane, AC_RWKV); continue; } r -= IT_RO;
            if (r < IT_O) { transpose_item(a->in[I_WO] + (size_t)l * DM * DM, DM, DM, (bf16*)(wl + WO_O), (r / 64) * 64, (r % 64) * 32, false, scr, lane); continue; } r -= IT_O;
            if (r < IT_UP) { transpose_item(a->in[I_UP] + (size_t)l * DM * DFF, DM, DFF, (bf16*)(wl + WO_UP), (r / 256) * 64, (r % 256) * 32, false, scr, lane); continue; } r -= IT_UP;
            transpose_item(a->in[I_DOWN] + (size_t)l * DFF * DM, DFF, DM, (bf16*)(wl + WO_DN), (r / 64) * 64, (r % 64) * 32, false, scr, lane);
        }
    }
    {
        const int gt = bid * NTHR + tid, NGT = G * NTHR;
        bf16* FL = (bf16*)(ws + OFF_DFTL); bf16* FC = (bf16*)(ws + OFF_DFTC);
        { bf16* WLT = (bf16*)(ws + OFF_WLT);
          for (int i = gt; i < DEPTH * 512 * 320; i += NGT) { const int l = i / (512 * 320), c = (i / 320) % 512, j = i % 320; float v;
              if (j < 64) v = a->in[I_RW2][((size_t)(l * 2 + 0) * 64 + j) * 512 + c]; else if (j < 128) v = a->in[I_RW2][((size_t)(l * 2 + 1) * 64 + (j - 64)) * 512 + c];
              else if (j < 192) v = a->in[I_RA2][((size_t)l * 64 + (j - 128)) * 512 + c]; else v = a->in[I_RG2][((size_t)l * 128 + (j - 192)) * 512 + c];
              WLT[i] = (bf16)f2bf(v); } }
        for (int i = gt; i < 2048 * 512; i += NGT) { const int lp = i >> 9, k8 = (i & 511) * 8; unsigned o[4];
#pragma unroll
            for (int e = 0; e < 4; ++e) { float v[2];
#pragma unroll
                for (int q = 0; q < 2; ++q) { const int k = k8 + 2 * e + q; const int m = (lp * (k & 2047)) & 2047; float sn, cs; sincospif((float)m * (1.f / 1024.f), &sn, &cs); v[q] = (k < 2048 ? cs : -sn) * (1.f / 512.f); }
                o[e] = pk2(v[0], v[1]); }
            *(v4u*)(FL + (size_t)lp * 4096 + k8) = (v4u){o[0], o[1], o[2], o[3]}; }
        for (int i = gt; i < 256 * 64; i += NGT) { const int lp = i >> 6, k8 = (i & 63) * 8; unsigned o[4];
#pragma unroll
            for (int e = 0; e < 4; ++e) { float v[2];
#pragma unroll
                for (int q = 0; q < 2; ++q) { const int k = k8 + 2 * e + q; const int m = (lp * (k & 255)) & 255; float sn, cs; sincospif((float)m * (1.f / 128.f), &sn, &cs); v[q] = (k < 256 ? cs : -sn) * 0.005524271728f; }
                o[e] = pk2(v[0], v[1]); }
            *(v4u*)(FC + (size_t)lp * 512 + k8) = (v4u){o[0], o[1], o[2], o[3]}; }
        f32x4* X4 = (f32x4*)(ws + OFF_X); const f32x4* x4 = (const f32x4*)a->in[I_X]; const f32x4* c4 = (const f32x4*)a->in[I_CTX];
        for (int i = gt; i < TT * (DM / 4); i += NGT) X4[i] = (i < TLAT * (DM / 4)) ? x4[i] : c4[i - TLAT * (DM / 4)];
    }
}

__device__ __forceinline__ void norm_phase(KArgs a, int mode, const float* gY, const float* gH, const float* modY  , const float* modH  ,
                                           int bid, int G, const int wave0, int nrows, bool split = false  ) {
    PH_IDS
    unsigned char* ws = a->ws; const int gw = bid * NWAVES + wave, NGW = G * NWAVES;
    float* X = (float*)(ws + OFF_X); const float* Y = (const float*)(ws + OFF_Y); bf16* H = (bf16*)(ws + OFF_H);
    for (int row = gw; row < nrows; row += NGW) {
        const int mr = row < TLAT ? (row >> 11) : 4;
        f32x4 x[8];
        const f32x4* xr = (const f32x4*)(X + (size_t)row * DM) + lane;
#pragma unroll
        for (int j = 0; j < 8; ++j) x[j] = xr[64 * j];
        if (mode != 0) {
            const f32x4* yr = (const f32x4*)(Y + (size_t)row * DM) + lane; f32x4 y[8]; float ss = 0.f;
            if (split && row >= TLAT) { const f32x4* yc = (const f32x4*)((const float*)(ws + OFF_YC) + (size_t)(row - TLAT) * DM) + lane;
#pragma unroll
                for (int j = 0; j < 8; ++j) { f32x4 t = yc[64 * j];
#pragma unroll
                    for (int sl = 1; sl < 8; ++sl) t += yc[(size_t)sl * 1024 * 512 + 64 * j];
                    y[j] = t; } }
            else {
#pragma unroll
                for (int j = 0; j < 8; ++j) y[j] = yr[64 * j]; }
#pragma unroll
            for (int j = 0; j < 8; ++j) { ss += (y[j].x * y[j].x + y[j].y * y[j].y) + (y[j].z * y[j].z + y[j].w * y[j].w); }
            const float r = rsqrtf(wave_sum(ss) * (1.f / DM) + 1e-6f);
            const f32x4* gp = (const f32x4*)gY + lane; const f32x4* gt = (const f32x4*)(modY + (size_t)mr * 12288) + lane;
#pragma unroll
            for (int j = 0; j < 8; ++j) x[j] += gt[64 * j] * (y[j] * r * gp[64 * j]);
            if (mode == 1) { f32x4* xw = (f32x4*)(X + (size_t)row * DM) + lane;
#pragma unroll
                for (int j = 0; j < 8; ++j) xw[64 * j] = x[j]; }
            else { f32x4* ow = (f32x4*)(a->out + (size_t)row * DM) + lane;
#pragma unroll
                for (int j = 0; j < 8; ++j) ow[64 * j] = x[j]; }
        }
        if (mode != 2) {
            float ss = 0.f;
#pragma unroll
            for (int j = 0; j < 8; ++j) ss += (x[j].x * x[j].x + x[j].y * x[j].y) + (x[j].z * x[j].z + x[j].w * x[j].w);
            const float r = rsqrtf(wave_sum(ss) * (1.f / DM) + 1e-6f);
            const f32x4* gp = (const f32x4*)gH + lane; const f32x4* sh = (const f32x4*)(modH + (size_t)mr * 12288) + lane; const f32x4* sc = sh + 512;
            v2u* hw = (v2u*)(H + (size_t)row * DM) + lane;
#pragma unroll
            for (int j = 0; j < 8; ++j) { const f32x4 h = (x[j] * r * gp[64 * j]) * (sc[64 * j] + 1.f) + sh[64 * j]; hw[64 * j] = (v2u){pk2(h.x, h.y), pk2(h.z, h.w)}; }
        }
    }
}
#define XB_TMO      128
#define XB_XCNT(j)  (256  + 64 * (j))
#define XB_XSUB(j)  (1280 + 64 * (j))
#define XB_XGEN(j)  (2304 + 64 * (j))
#define XB_TOP      3328
#define XB_TOPGEN   3392
#define XCD_BAR_WORDS 3456
#define XB_SPIN_CAP (1u << 18)

__device__ __forceinline__ unsigned xb_ld(unsigned* p)              { return __hip_atomic_load(p, __ATOMIC_RELAXED, __HIP_MEMORY_SCOPE_AGENT); }
__device__ __forceinline__ unsigned xb_add(unsigned* p, unsigned v) { return __hip_atomic_fetch_add(p, v, __ATOMIC_RELAXED, __HIP_MEMORY_SCOPE_AGENT); }
__device__ __forceinline__ unsigned xb_xcc_id() { return (unsigned)__builtin_amdgcn_s_getreg((3 << 11) | 20) & 0xFu; }
#define XB_SPIN(cond, bar) do { unsigned _sp = 0; while (cond) { __builtin_amdgcn_s_sleep(1); \
    if ((++_sp & 255u) == 0u) { if (xb_ld(&(bar)[XB_TMO])) break; if (_sp > XB_SPIN_CAP) { atomicAdd(&(bar)[XB_TMO], 1u); break; } } } } while (0)

struct XcdBarrier {
    unsigned* bar; unsigned x; int wv;
    volatile LAS unsigned* st;
};

__device__ __forceinline__ bool xb_t0(int wv) { unsigned z_ = 0u; asm volatile("" : "+v"(z_)); return wv == 0 && __builtin_amdgcn_mbcnt_hi(~0u, __builtin_amdgcn_mbcnt_lo(~0u, z_)) == 0u; }
__device__ __forceinline__ XcdBarrier xcd_barrier_post(unsigned* bar, volatile LAS unsigned* st, int wv) {
    XcdBarrier b; b.bar = bar; b.x = xb_xcc_id(); b.st = st; b.wv = wv;
    if (xb_t0(wv)) (void)xb_add(&bar[XB_XCNT(b.x)], 1u);
    return b;
}
__device__ __forceinline__ void xcd_barrier_complete(unsigned* bar, unsigned x, unsigned& nloc, unsigned& nx) {
    const unsigned G = gridDim.x * gridDim.y * gridDim.z;
    unsigned sum, cnt, mine, sp = 0u;
    for (;;) {
        sum = 0u; cnt = 0u; mine = 0u;
#pragma unroll
        for (unsigned j = 0; j < 16; ++j) { const unsigned c = xb_ld(&bar[XB_XCNT(j)]); sum += c; cnt += (c > 0u) ? 1u : 0u; mine = (j == x) ? c : mine; }
        if (sum == G) break;
        __builtin_amdgcn_s_sleep(1);
        if ((++sp & 255u) == 0u) { if (xb_ld(&bar[XB_TMO])) break; if (sp > XB_SPIN_CAP) { atomicAdd(&bar[XB_TMO], 1u); break; } }
    }
    nloc = mine > 0u ? mine : 1u; nx = cnt > 0u ? cnt : 1u;
}

__device__ __forceinline__ void xcd_barrier(const XcdBarrier& b) {
    asm volatile("s_waitcnt vmcnt(0)" ::: "memory");
    __syncthreads();
    if (xb_t0(b.wv)) {
        unsigned* bar = b.bar;
        __builtin_amdgcn_s_waitcnt(0);
        unsigned nloc = b.st[0], nx = b.st[1];
        if (nloc == 0u) { xcd_barrier_complete(bar, b.x, nloc, nx); b.st[0] = nloc; b.st[1] = nx; }
        const unsigned old = xb_add(&bar[XB_XSUB(b.x)], 1u);
        const unsigned gen = old / nloc;
        if (old + 1u == (gen + 1u) * nloc) {
            __builtin_amdgcn_fence(__ATOMIC_RELEASE, "agent");
            asm volatile("s_waitcnt vmcnt(0)" ::: "memory");
            const unsigned og = xb_add(&bar[XB_TOP], 1u);
            const unsigned tg = og / nx;
            if (og + 1u == (tg + 1u) * nx) xb_add(&bar[XB_TOPGEN], 1u);
            else XB_SPIN(xb_ld(&bar[XB_TOPGEN]) == tg, bar);
            __builtin_amdgcn_fence(__ATOMIC_ACQUIRE, "agent");
            xb_add(&bar[XB_XGEN(b.x)], 1u);
            asm volatile("s_waitcnt vmcnt(0)" ::: "memory");
        } else {
            XB_SPIN(xb_ld(&bar[XB_XGEN(b.x)]) == gen, bar);
            __builtin_amdgcn_fence(__ATOMIC_ACQUIRE, "agent");
            asm volatile("s_waitcnt vmcnt(0)" ::: "memory");
        }
    }
    __syncthreads();
}

constexpr int RCH_NT = 0, RCH_RT = 2048, RCH_KST = 4096, RCH_TT = 4608, RCH_ART = 5120, RCH_KRT = 5632, RCH_VM = 6144, RCH_APT = 8192, RCH_KPT = 10240, RCH_GC = 12288, RCH_BYTES = 12544;

typedef short bf16x8 __attribute__((ext_vector_type(8)));
constexpr int RP_PITCH = 516, ACT_PITCH = 328;
__device__ __forceinline__ void rwkv_prep_item(KArgs a, int l, int item, LAS unsigned char* lds, int tid, int lane, int wave) {
    unsigned char* ws = a->ws;
    const bf16* U = (const bf16*)(ws + OFF_U); const float* MISC = (const float*)(ws + OFF_MISC);
    const int b = item / 144, j0 = (item % 144) * 16; const bool isctx = j0 < LCTX;
    LAS float* RP = (LAS float*)lds;
    LAS float* KP = RP + 16 * RP_PITCH; LAS float* VP = KP + 16 * RP_PITCH;
    LAS bf16* ACT = (LAS bf16*)(lds + 3 * 16 * RP_PITCH * 4);
    const float* mu = a->in[I_RMU] + l * 1856;
    for (int idx = tid; idx < 16 * 192; idx += NTHR) { const int i = idx / 192, c8 = idx % 192, jj = j0 + i;
        const bool hp = isctx ? (jj - 1 >= 0) : (jj - 1 >= LCTX), hn = isctx ? (jj + 1 < LCTX) : (jj + 1 < RJ);
        const v4u c = *(const v4u*)(U + (size_t)rwkv_tok(b, jj) * NU + URKV + c8 * 8);
        v4u p = (v4u){0u, 0u, 0u, 0u}, n = p;
        if (hp) p = *(const v4u*)(U + (size_t)rwkv_tok(b, jj - 1) * NU + URKV + c8 * 8);
        if (hn) n = *(const v4u*)(U + (size_t)rwkv_tok(b, jj + 1) * NU + URKV + c8 * 8);
        const f32x4 m0 = *(const f32x4*)(mu + c8 * 8), m1 = *(const f32x4*)(mu + c8 * 8 + 4);
        f32x4 x0 = (f32x4){bflo(c.x), bfhi(c.x), bflo(c.y), bfhi(c.y)}, x1 = (f32x4){bflo(c.z), bfhi(c.z), bflo(c.w), bfhi(c.w)};
        const f32x4 s0 = (f32x4){bflo(p.x) + bflo(n.x), bfhi(p.x) + bfhi(n.x), bflo(p.y) + bflo(n.y), bfhi(p.y) + bfhi(n.y)}, s1 = (f32x4){bflo(p.z) + bflo(n.z), bfhi(p.z) + bfhi(n.z), bflo(p.w) + bflo(n.w), bfhi(p.w) + bfhi(n.w)};
        x0 = x0 + (0.5f * s0 - x0) * m0; x1 = x1 + (0.5f * s1 - x1) * m1;
        const int ch = c8 * 8, reg = ch >> 9; LAS float* dst = (reg == 0 ? RP : (reg == 1 ? KP : VP)) + i * RP_PITCH + (ch & 511);
        *(LAS f32x4*)dst = x0; *(LAS f32x4*)(dst + 4) = x1; }
    for (int idx = tid; idx < 16 * 80; idx += NTHR) { const int i = idx / 80, c4 = idx % 80, jj = j0 + i;
        const bool hp = isctx ? (jj - 1 >= 0) : (jj - 1 >= LCTX), hn = isctx ? (jj + 1 < LCTX) : (jj + 1 < RJ);
        f32x4 x = *(const f32x4*)(MISC + (size_t)rwkv_tok(b, jj) * 512 + 64 + c4 * 4); f32x4 p = (f32x4){0.f, 0.f, 0.f, 0.f}, n = p;
        if (hp) p = *(const f32x4*)(MISC + (size_t)rwkv_tok(b, jj - 1) * 512 + 64 + c4 * 4);
        if (hn) n = *(const f32x4*)(MISC + (size_t)rwkv_tok(b, jj + 1) * 512 + 64 + c4 * 4);
        x = x + (0.5f * (p + n) - x) * *(const f32x4*)(mu + 1536 + c4 * 4);
        const int m = c4 * 4;
        if (m < 128) x = (f32x4){tanhf(x.x), tanhf(x.y), tanhf(x.z), tanhf(x.w)}; else if (m >= 192) x = (f32x4){sigmoidf_(x.x), sigmoidf_(x.y), sigmoidf_(x.z), sigmoidf_(x.w)};
        *(LAS v2u*)(ACT + i * ACT_PITCH + m) = (v2u){pk2(x.x, x.y), pk2(x.z, x.w)}; }
    __syncthreads();
    const int fr = lane & 15, fq = lane >> 4, h = wave;
    f32x4 acc[4][4];
#pragma unroll
    for (int o = 0; o < 4; ++o)
#pragma unroll
        for (int nt = 0; nt < 4; ++nt) acc[o][nt] = (f32x4){0.f, 0.f, 0.f, 0.f};
    {
        const bf16* WLT = (const bf16*)(ws + OFF_WLT) + (size_t)l * 512 * 320 + (size_t)(64 * wave + fr) * 320 + fq * 8;
#pragma unroll
        for (int ks = 0; ks < 10; ++ks) { const int o = ks < 2 ? 0 : (ks < 4 ? 1 : (ks < 6 ? 2 : 3));
            const bf16x8 af = *(const LAS bf16x8*)(ACT + fr * ACT_PITCH + ks * 32 + fq * 8);
#pragma unroll
            for (int nt = 0; nt < 4; ++nt) { const bf16x8 bf = *(const bf16x8*)(WLT + (size_t)nt * 16 * 320 + ks * 32);
                acc[o][nt] = __builtin_amdgcn_mfma_f32_16x16x32_bf16(af, bf, acc[o][nt], 0, 0, 0); } }
    }
    float* RW = (float*)(ws + OFF_RW); constexpr size_t AS = RW_ARR / 4; float* RSC = (float*)(ws + OFF_RSC);
    float w0f[4], w0b[4], a0c[4], kkc[4], kac[4], rkc[4];
#pragma unroll
    for (int nt = 0; nt < 4; ++nt) { const int c = 64 * wave + 16 * nt + fr; w0f[nt] = a->in[I_RW0][(l * 2 + 0) * 512 + c]; w0b[nt] = a->in[I_RW0][(l * 2 + 1) * 512 + c]; a0c[nt] = a->in[I_RA0][l * 512 + c];
        kkc[nt] = a->in[I_RKK][l * 512 + c]; kac[nt] = a->in[I_RKA][l * 512 + c]; rkc[nt] = a->in[I_RRK][l * 512 + c]; }
    float Wd[2][4][4], Rr[4][4], Km[4][4], Nn[4][4], Ka[4][4], Vv[4][4];
#pragma unroll
    for (int i = 0; i < 4; ++i) { const int tok = 4 * fq + i; const size_t R = (size_t)b * RJ + j0 + tok;
        float k[4], av[4], kkv[4]; float ss = 0.f;
#pragma unroll
        for (int nt = 0; nt < 4; ++nt) { const int c = 64 * wave + 16 * nt + fr; Rr[i][nt] = RP[tok * RP_PITCH + c]; k[nt] = KP[tok * RP_PITCH + c]; Vv[i][nt] = VP[tok * RP_PITCH + c];
            av[nt] = sigmoidf_(a0c[nt] + acc[2][nt][i]); kkv[nt] = k[nt] * kkc[nt]; ss += kkv[nt] * kkv[nt]; }
        const float rn = rsqrtf(row16_sum(ss) + 1e-12f);
        float bon = 0.f;
#pragma unroll
        for (int nt = 0; nt < 4; ++nt) { const int c = 64 * wave + 16 * nt + fr;
            Wd[0][i][nt] = __expf(-__expf(-softplusf_(-(w0f[nt] + acc[0][nt][i])) - 0.5f)); Wd[1][i][nt] = __expf(-__expf(-softplusf_(-(w0b[nt] + acc[1][nt][i])) - 0.5f));
            const float kk = kkv[nt] * rn; Km[i][nt] = k[nt] * (1.f + (av[nt] - 1.f) * kac[nt]); Ka[i][nt] = kk * av[nt]; Nn[i][nt] = -kk;
            bon += Rr[i][nt] * Km[i][nt] * rkc[nt];
            float* o = RW + R * 512 + c; o[7 * AS] = Vv[i][nt]; o[8 * AS] = acc[3][nt][i]; }
        bon = row16_sum(bon);
        if (fr == 0) RSC[(size_t)2 * TT * 8 + R * 8 + h] = bon;
    }
    __syncthreads();
    LAS unsigned char* wl_ = lds + wave * 14336;
    LAS bf16* NTl = (LAS bf16*)wl_; LAS bf16* RTl = NTl + 16 * 68; LAS bf16* ATl = RTl + 16 * 68; LAS bf16* KTl = ATl + 16 * 68;
    LAS float* ASl = (LAS float*)(wl_ + 8704);
    LAS float* TTl = (LAS float*)(wl_ + 11264);
    typedef short bf16x4 __attribute__((ext_vector_type(4)));
#pragma unroll
    for (int d = 0; d < 2; ++d) {
        const int cidx = d ? (isctx ? (240 - j0) / 16 : (2544 - j0) / 16) : j0 / 16;
        unsigned char* img = ws + OFF_RCH + ((size_t)((b * 2 + d) * 8 + h) * 144 + cidx) * RCH_BYTES;
        const int laneD = d ? ((3 - fq) * 16 + fr) : lane;
#pragma unroll
        for (int nt = 0; nt < 4; ++nt) {
            float gam[4], gpv[4], G, E;
            if (d == 0) { gam[0] = Wd[0][0][nt]; gam[1] = gam[0] * Wd[0][1][nt]; gam[2] = gam[1] * Wd[0][2][nt]; gam[3] = gam[2] * Wd[0][3][nt]; G = gam[3];
                const float g1 = __int_as_float(__builtin_amdgcn_ds_bpermute((lane - 16) << 2, __float_as_int(G))), g2 = __int_as_float(__builtin_amdgcn_ds_bpermute((lane - 32) << 2, __float_as_int(G))), g3 = __int_as_float(__builtin_amdgcn_ds_bpermute((lane - 48) << 2, __float_as_int(G)));
                E = (fq >= 1 ? g1 : 1.f) * (fq >= 2 ? g2 : 1.f) * (fq >= 3 ? g3 : 1.f);
                gpv[0] = E; gpv[1] = E * gam[0]; gpv[2] = E * gam[1]; gpv[3] = E * gam[2];
#pragma unroll
                for (int i = 0; i < 4; ++i) gam[i] *= E; }
            else { gam[3] = Wd[1][3][nt]; gam[2] = gam[3] * Wd[1][2][nt]; gam[1] = gam[2] * Wd[1][1][nt]; gam[0] = gam[1] * Wd[1][0][nt]; G = gam[0];
                const float g1 = __int_as_float(__builtin_amdgcn_ds_bpermute((lane + 16) << 2, __float_as_int(G))), g2 = __int_as_float(__builtin_amdgcn_ds_bpermute((lane + 32) << 2, __float_as_int(G))), g3 = __int_as_float(__builtin_amdgcn_ds_bpermute((lane + 48) << 2, __float_as_int(G)));
                E = (fq <= 2 ? g1 : 1.f) * (fq <= 1 ? g2 : 1.f) * (fq <= 0 ? g3 : 1.f);
                gpv[3] = E; gpv[2] = E * gam[3]; gpv[1] = E * gam[2]; gpv[0] = E * gam[1];
#pragma unroll
                for (int i = 0; i < 4; ++i) gam[i] *= E; }
            float tot = G * __int_as_float(__builtin_amdgcn_ds_bpermute((lane ^ 16) << 2, __float_as_int(G)));
            tot = tot * __int_as_float(__builtin_amdgcn_ds_bpermute((lane ^ 32) << 2, __float_as_int(tot)));
            float ap[4], kp[4];
#pragma unroll
            for (int i = 0; i < 4; ++i) { const int td = d ? 15 - (4 * fq + i) : 4 * fq + i; const float ig = 1.f / gam[i];
                const float at_ = Ka[i][nt] * ig, kt_ = Km[i][nt] * ig; ap[i] = at_ * tot; kp[i] = kt_ * tot;
                NTl[td * 68 + 16 * nt + fr] = (bf16)f2bf(gpv[i] * Nn[i][nt]); RTl[td * 68 + 16 * nt + fr] = (bf16)f2bf(gam[i] * Rr[i][nt]);
                ATl[td * 68 + 16 * nt + fr] = (bf16)f2bf(at_); KTl[td * 68 + 16 * nt + fr] = (bf16)f2bf(kt_); }
            v2u pa, pk, pv;
            if (d == 0) { pa = (v2u){pk2(ap[0], ap[1]), pk2(ap[2], ap[3])}; pk = (v2u){pk2(kp[0], kp[1]), pk2(kp[2], kp[3])}; pv = (v2u){pk2(Vv[0][nt], Vv[1][nt]), pk2(Vv[2][nt], Vv[3][nt])}; }
            else { pa = (v2u){pk2(ap[3], ap[2]), pk2(ap[1], ap[0])}; pk = (v2u){pk2(kp[3], kp[2]), pk2(kp[1], kp[0])}; pv = (v2u){pk2(Vv[3][nt], Vv[2][nt]), pk2(Vv[1][nt], Vv[0][nt])}; }
            *(v2u*)(img + RCH_APT + nt * 512 + laneD * 8) = pa; *(v2u*)(img + RCH_KPT + nt * 512 + laneD * 8) = pk; *(v2u*)(img + RCH_VM + nt * 512 + laneD * 8) = pv;
            if (fq == 0) *(float*)(img + RCH_GC + (16 * nt + fr) * 4) = tot;
        }
        LDS_WAIT();
#pragma unroll
        for (int kt = 0; kt < 4; ++kt) { *(v2u*)(img + RCH_NT + kt * 512 + lane * 8) = *(const LAS v2u*)(NTl + fr * 68 + 16 * kt + 4 * fq); *(v2u*)(img + RCH_RT + kt * 512 + lane * 8) = *(const LAS v2u*)(RTl + fr * 68 + 16 * kt + 4 * fq); }
        f32x4 cAs = (f32x4){0.f, 0.f, 0.f, 0.f}, cKs = cAs, cAr = cAs, cKr = cAs;
#pragma unroll
        for (int sk = 0; sk < 4; ++sk) { const bf16x4 aA = *(const LAS bf16x4*)(ATl + fr * 68 + 16 * sk + 4 * fq), aK = *(const LAS bf16x4*)(KTl + fr * 68 + 16 * sk + 4 * fq);
            const bf16x4 bN = *(const LAS bf16x4*)(NTl + fr * 68 + 16 * sk + 4 * fq), bR = *(const LAS bf16x4*)(RTl + fr * 68 + 16 * sk + 4 * fq);
            cAs = __builtin_amdgcn_mfma_f32_16x16x16bf16_1k(aA, bN, cAs, 0, 0, 0); cKs = __builtin_amdgcn_mfma_f32_16x16x16bf16_1k(aK, bN, cKs, 0, 0, 0);
            cAr = __builtin_amdgcn_mfma_f32_16x16x16bf16_1k(aA, bR, cAr, 0, 0, 0); cKr = __builtin_amdgcn_mfma_f32_16x16x16bf16_1k(aK, bR, cKr, 0, 0, 0); }
#pragma unroll
        for (int j = 0; j < 4; ++j) { const int ii = 4 * fq + j; if (!(ii < fr)) { cAs[j] = 0.f; cKs[j] = 0.f; } if (!(ii <= fr)) { cAr[j] = 0.f; cKr[j] = 0.f; } }
        *(v2u*)(img + RCH_KST + lane * 8) = (v2u){pk2(cKs[0], cKs[1]), pk2(cKs[2], cKs[3])}; *(v2u*)(img + RCH_ART + lane * 8) = (v2u){pk2(cAr[0], cAr[1]), pk2(cAr[2], cAr[3])};
        *(v2u*)(img + RCH_KRT + lane * 8) = (v2u){pk2(cKr[0], cKr[1]), pk2(cKr[2], cKr[3])};
        *(LAS f32x4*)(ASl + (d * 16 + fr) * 20 + 4 * fq) = cAs;
        LDS_WAIT();
    }
    if (lane < 32) { const int d = lane >> 4, irow = lane & 15; float Tc[16];
#pragma unroll
        for (int t = 0; t < 16; ++t) { float x = (irow == t) ? 1.f : 0.f;
#pragma unroll
            for (int j4 = 0; j4 < (t + 3) / 4; ++j4) { const f32x4 av = *(const LAS f32x4*)(ASl + (d * 16 + t) * 20 + 4 * j4);
#pragma unroll
                for (int e = 0; e < 4; ++e) if (4 * j4 + e < t) x += Tc[4 * j4 + e] * av[e]; }
            Tc[t] = x; TTl[(d * 16 + t) * 20 + irow] = x; } }
    LDS_WAIT();
#pragma unroll
    for (int d = 0; d < 2; ++d) { const int cidx = d ? (isctx ? (240 - j0) / 16 : (2544 - j0) / 16) : j0 / 16;
        unsigned char* img = ws + OFF_RCH + ((size_t)((b * 2 + d) * 8 + h) * 144 + cidx) * RCH_BYTES;
        const f32x4 tv = *(const LAS f32x4*)(TTl + (d * 16 + fr) * 20 + 4 * fq);
        *(v2u*)(img + RCH_TT + lane * 8) = (v2u){pk2(tv[0], tv[1]), pk2(tv[2], tv[3])}; }
    __syncthreads();
}
__device__ __forceinline__ void ssd_prep_item(KArgs a, int l, int item, int tid) {
    unsigned char* ws = a->ws; const bf16* U = (const bf16*)(ws + OFF_U); const float* MISC = (const float*)(ws + OFF_MISC);
    bf16* XBC = (bf16*)(ws + OFF_XBC); float* DTA = (float*)(ws + OFF_DTA);
    const int t0 = item * 16;
    const int seq_lo = t0 < TLAT ? (t0 & ~(LSEQ - 1)) : TLAT + ((t0 - TLAT) & ~(LCTX - 1)), seq_hi = seq_lo + (t0 < TLAT ? LSEQ : LCTX);
    for (int cp = tid; cp < 896; cp += NTHR) {
        float w0[5], w1[5];
#pragma unroll
        for (int j = 0; j < 5; ++j) { const f32x2 w = *(const f32x2*)(a->in[I_SCW] + (size_t)(l * 5 + j) * 1792 + 2 * cp); w0[j] = w.x; w1[j] = w.y; }
        const f32x2 bb = *(const f32x2*)(a->in[I_SCB] + l * 1792 + 2 * cp);
        float i0[20], i1[20];
#pragma unroll
        for (int r = 0; r < 20; ++r) { const int row = t0 - 2 + r; unsigned u = 0u; if (row >= seq_lo && row < seq_hi) u = *(const unsigned*)(U + (size_t)row * NU + UXBC + 2 * cp); i0[r] = bflo(u); i1[r] = bfhi(u); }
#pragma unroll
        for (int o = 0; o < 16; ++o) { float s0 = bb.x, s1 = bb.y;
#pragma unroll
            for (int j = 0; j < 5; ++j) { s0 += w0[j] * i0[o + j]; s1 += w1[j] * i1[o + j]; }
            *(unsigned*)(XBC + (size_t)(t0 + o) * 1792 + 2 * cp) = pk2(siluf_(s0), siluf_(s1)); }
    }
    if (tid < 16 * 24) { const int o = tid / 24, q = tid % 24;
        const float dt = softplusf_(MISC[(size_t)(t0 + o) * 512 + q] + a->in[I_SDTB][l * 24 + q]); const float A = -__expf(a->in[I_SALOG][l * 24 + q]);
        DTA[(size_t)(t0 + o) * 48 + q] = dt; DTA[(size_t)(t0 + o) * 48 + 24 + q] = dt * A; }
}
__device__ __forceinline__ void conv_item(KArgs a, int l, int item, LAS unsigned char* lds, int tid, int lane, int wave) {
    unsigned char* ws = a->ws; const bf16* U = (const bf16*)(ws + OFF_U); bf16* AC = (bf16*)(ws + OFF_ACAT) + AC_CONV;
    int t0, seg_lo, seg_hi;
    if (item < 256) { t0 = item * 32; seg_lo = t0 & ~63; seg_hi = seg_lo + 64; }
    else { const int ci = item - 256; t0 = TLAT + ci * 32; seg_lo = TLAT + (ci >> 3) * LCTX; seg_hi = seg_lo + LCTX; }
    LAS bf16* inimg = (LAS bf16*)lds;
    LAS float* outimg = (LAS float*)(lds + 63488);
    for (int idx = tid; idx < 62 * 64; idx += NTHR) { const int rr = idx >> 6, c8 = idx & 63, row = t0 - 15 + rr;
        v4u o = (v4u){0u, 0u, 0u, 0u};
        if (row >= seg_lo && row < seg_hi) { const v4u va = *(const v4u*)(U + (size_t)row * NU + UCONV + c8 * 8), vg = *(const v4u*)(U + (size_t)row * NU + UCONV + 512 + c8 * 8);
            o.x = pk2(bflo(va.x) * sigmoidf_(bflo(vg.x)), bfhi(va.x) * sigmoidf_(bfhi(vg.x))); o.y = pk2(bflo(va.y) * sigmoidf_(bflo(vg.y)), bfhi(va.y) * sigmoidf_(bfhi(vg.y)));
            o.z = pk2(bflo(va.z) * sigmoidf_(bflo(vg.z)), bfhi(va.z) * sigmoidf_(bfhi(vg.z))); o.w = pk2(bflo(va.w) * sigmoidf_(bflo(vg.w)), bfhi(va.w) * sigmoidf_(bfhi(vg.w))); }
        *(LAS v4u*)(inimg + rr * 512 + c8 * 8) = o; }
    __syncthreads();
    {
        const int c = tid; float w[31];
#pragma unroll
        for (int j = 0; j < 31; ++j) w[j] = a->in[I_CONVW][(size_t)(l * 31 + j) * 512 + c];
        const float bias = a->in[I_CONVB][l * 512 + c];
#pragma unroll 2
        for (int o = 0; o < 32; ++o) { float s = bias;
#pragma unroll
            for (int j = 0; j < 31; ++j) s += w[j] * bf2f(inimg[(o + j) * 512 + c]);
            outimg[o * 512 + c] = s; }
    }
    __syncthreads();
    {
        const f32x4 g0 = *(const f32x4*)(a->in[I_CLNG] + l * 512 + 8 * lane), g1 = *(const f32x4*)(a->in[I_CLNG] + l * 512 + 8 * lane + 4);
        const f32x4 b0 = *(const f32x4*)(a->in[I_CLNB] + l * 512 + 8 * lane), b1 = *(const f32x4*)(a->in[I_CLNB] + l * 512 + 8 * lane + 4);
#pragma unroll
        for (int q = 0; q < 4; ++q) { const int o = wave * 4 + q;
            f32x4 x0 = *(const LAS f32x4*)(outimg + o * 512 + 8 * lane), x1 = *(const LAS f32x4*)(outimg + o * 512 + 8 * lane + 4);
            const float mean = wave_sum((x0.x + x0.y + x0.z + x0.w) + (x1.x + x1.y + x1.z + x1.w)) * (1.f / 512.f);
            x0 = x0 - mean; x1 = x1 - mean;
            const float var = wave_sum((x0.x * x0.x + x0.y * x0.y + x0.z * x0.z + x0.w * x0.w) + (x1.x * x1.x + x1.y * x1.y + x1.z * x1.z + x1.w * x1.w)) * (1.f / 512.f);
            const float rs = rsqrtf(var + 1e-5f);
            x0 = x0 * rs * g0 + b0; x1 = x1 * rs * g1 + b1;
            v4u ov; ov.x = pk2(siluf_(x0.x), siluf_(x0.y)); ov.y = pk2(siluf_(x0.z), siluf_(x0.w)); ov.z = pk2(siluf_(x1.x), siluf_(x1.y)); ov.w = pk2(siluf_(x1.z), siluf_(x1.w));
            *(v4u*)(AC + (size_t)(t0 + o) * ACW + 8 * lane) = ov; }
    }
    __syncthreads();
}

__device__ __forceinline__ int ssd_tok(int b, int dir, int pos) {
    if (pos < LCTX) return TLAT + b * LCTX + (dir ? (LCTX - 1 - pos) : pos);
    const int q = pos - LCTX; return b * LSEQ + (dir ? (LSEQ - 1 - q) : q);
}
__device__ __forceinline__ void post_phase(KArgs a, int l, int bid, int G, const int wave0) {
    PH_IDS
    unsigned char* ws = a->ws; const int gw = bid * NWAVES + wave, NGW = G * NWAVES;
    const bf16* U = (const bf16*)(ws + OFF_U); const bf16* XBC = (const bf16*)(ws + OFF_XBC);
    const float* Y0 = (const float*)(ws + OFF_YSSD); const float* Y1 = Y0 + (size_t)TT * 768; bf16* AS_ = (bf16*)(ws + OFF_ACAT) + AC_SSD;
    for (int row = gw; row < TT; row += NGW) {
        f32x4 y[3]; float ss = 0.f;
#pragma unroll
        for (int j = 0; j < 3; ++j) { const int col = 4 * lane + 256 * j; const float dsk = a->in[I_SD][l * 12 + (col >> 6)];
            const f32x4 yf = *(const f32x4*)(Y0 + (size_t)row * 768 + col), yb = *(const f32x4*)(Y1 + (size_t)row * 768 + col);
            const v2u xs = *(const v2u*)(XBC + (size_t)row * 1792 + col), z = *(const v2u*)(U + (size_t)row * NU + UZ + col);
            f32x4 v = yf + yb + dsk * (f32x4){bflo(xs.x), bfhi(xs.x), bflo(xs.y), bfhi(xs.y)};
            v = v * (f32x4){siluf_(bflo(z.x)), siluf_(bfhi(z.x)), siluf_(bflo(z.y)), siluf_(bfhi(z.y))};
            y[j] = v; ss += (v.x * v.x + v.y * v.y) + (v.z * v.z + v.w * v.w); }
        const float r = rsqrtf(wave_sum(ss) * (1.f / 768.f) + 1e-6f);
#pragma unroll
        for (int j = 0; j < 3; ++j) { const int col = 4 * lane + 256 * j; const f32x4 g = *(const f32x4*)(a->in[I_SNG] + l * 768 + col); const f32x4 o = y[j] * r * g;
            *(v2u*)(AS_ + (size_t)row * ACW + col) = (v2u){pk2(o.x, o.y), pk2(o.z, o.w)}; }
    }
    const float* RW = (const float*)(ws + OFF_RW); constexpr size_t AS = RW_ARR / 4; const float* RSC = (const float*)(ws + OFF_RSC);
    const float* R0 = (const float*)(ws + OFF_YRW); const float* R1 = R0 + (size_t)TT * 512; bf16* AR = (bf16*)(ws + OFF_ACAT) + AC_RWKV;
    for (int row = gw; row < TT; row += NGW) {
        size_t R;
        if (row < TLAT) { const int b = row >> 11, t = row & 2047, rr = t >> 6, cc = t & 63; R = (size_t)b * RJ + LCTX + cc * 32 + rr; }
        else { const int b = (row - TLAT) >> 8, jj = (row - TLAT) & 255; R = (size_t)b * RJ + jj; }
        const int c0 = 8 * lane, h = lane >> 3;
        f32x4 ya = *(const f32x4*)(R0 + R * 512 + c0) + *(const f32x4*)(R1 + R * 512 + c0), yb = *(const f32x4*)(R0 + R * 512 + c0 + 4) + *(const f32x4*)(R1 + R * 512 + c0 + 4);
        float s = (ya.x + ya.y + ya.z + ya.w) + (yb.x + yb.y + yb.z + yb.w);
        s = sum8(s);
        const float mean = s * (1.f / 64.f); ya = ya - mean; yb = yb - mean;
        float q = (ya.x * ya.x + ya.y * ya.y + ya.z * ya.z + ya.w * ya.w) + (yb.x * yb.x + yb.y * yb.y + yb.z * yb.z + yb.w * yb.w);
        q = sum8(q);
        const float rs = rsqrtf(q * (1.f / 64.f) + 64e-5f);
        const f32x4 lg0 = *(const f32x4*)(a->in[I_RLNG] + l * 512 + c0), lg1 = *(const f32x4*)(a->in[I_RLNG] + l * 512 + c0 + 4), lb0 = *(const f32x4*)(a->in[I_RLNB] + l * 512 + c0), lb1 = *(const f32x4*)(a->in[I_RLNB] + l * 512 + c0 + 4);
        const float bon = RSC[(size_t)2 * TT * 8 + R * 8 + h];
        const f32x4 v0 = *(const f32x4*)(RW + 7 * AS + R * 512 + c0), v1 = *(const f32x4*)(RW + 7 * AS + R * 512 + c0 + 4), g0 = *(const f32x4*)(RW + 8 * AS + R * 512 + c0), g1 = *(const f32x4*)(RW + 8 * AS + R * 512 + c0 + 4);
        const f32x4 o0 = (ya * rs * lg0 + lb0 + bon * v0) * g0, o1 = (yb * rs * lg1 + lb1 + bon * v1) * g1;
        *(v4u*)(AR + (size_t)row * ACW + c0) = (v4u){pk2(o0.x, o0.y), pk2(o0.z, o0.w), pk2(o1.x, o1.y), pk2(o1.z, o1.w)};
    }
}

__device__ __forceinline__ size_t rwkv_row(int b, int dir, int pos) { const int j = dir ? (pos < LCTX ? (LCTX - 1 - pos) : (RJ + LCTX - 1 - pos)) : pos; return (size_t)b * RJ + j; }
struct RchOps { v2u nt[4], rt[4], kst, tt, art, krt, vm, apt[4], kpt[4]; f32x4 gc[4]; };
__device__ __forceinline__ void rwkv_scan_chunk(KArgs a, int idx, int lane, int wave) {
    if (wave >= 4) return;
    typedef short bf16x4 __attribute__((ext_vector_type(4)));
    unsigned char* ws = a->ws;
    const int b = idx >> 4, dir = (idx >> 3) & 1, h = idx & 7, fr = lane & 15, fq = lane >> 4;
    float* Yo = (float*)(ws + OFF_YRW) + (size_t)dir * TT * 512;
    const unsigned char* base = ws + OFF_RCH + (size_t)((b * 2 + dir) * 8 + h) * 144 * RCH_BYTES;
    auto ld = [&](int c) { RchOps o; const unsigned char* p = base + (size_t)c * RCH_BYTES + lane * 8;
#pragma unroll
        for (int kt = 0; kt < 4; ++kt) { o.nt[kt] = *(const v2u*)(p + RCH_NT + kt * 512); o.rt[kt] = *(const v2u*)(p + RCH_RT + kt * 512); o.apt[kt] = *(const v2u*)(p + RCH_APT + kt * 512); o.kpt[kt] = *(const v2u*)(p + RCH_KPT + kt * 512);
            o.gc[kt] = *(const f32x4*)(base + (size_t)c * RCH_BYTES + RCH_GC + (16 * kt + 4 * fq) * 4); }
        o.kst = *(const v2u*)(p + RCH_KST); o.tt = *(const v2u*)(p + RCH_TT); o.art = *(const v2u*)(p + RCH_ART); o.krt = *(const v2u*)(p + RCH_KRT); o.vm = *(const v2u*)(p + RCH_VM + wave * 512); return o; };
#define MF16(A_, B_, C_) __builtin_amdgcn_mfma_f32_16x16x16bf16_1k(__builtin_bit_cast(bf16x4, A_), __builtin_bit_cast(bf16x4, B_), C_, 0, 0, 0)
    f32x4 S[4];
#pragma unroll
    for (int kt = 0; kt < 4; ++kt) S[kt] = (f32x4){0.f, 0.f, 0.f, 0.f};
    RchOps cur = ld(0), nx1 = ld(1);
    for (int c = 0; c < 144; ++c) {
        RchOps nx2 = nx1; if (c + 2 < 144) nx2 = ld(c + 2);
        v2u Sb[4];
#pragma unroll
        for (int kt = 0; kt < 4; ++kt) Sb[kt] = (v2u){pk2(S[kt][0], S[kt][1]), pk2(S[kt][2], S[kt][3])};
        f32x4 rhs = (f32x4){0.f, 0.f, 0.f, 0.f}, y = rhs;
#pragma unroll
        for (int kt = 0; kt < 4; ++kt) rhs = MF16(cur.nt[kt], Sb[kt], rhs);
        rhs = MF16(cur.kst, cur.vm, rhs);
        const v2u rb = (v2u){pk2(rhs[0], rhs[1]), pk2(rhs[2], rhs[3])};
        const f32x4 u = MF16(cur.tt, rb, ((f32x4){0.f, 0.f, 0.f, 0.f}));
        const v2u ub = (v2u){pk2(u[0], u[1]), pk2(u[2], u[3])};
#pragma unroll
        for (int kt = 0; kt < 4; ++kt) { S[kt] = S[kt] * cur.gc[kt]; S[kt] = MF16(cur.apt[kt], ub, S[kt]); S[kt] = MF16(cur.kpt[kt], cur.vm, S[kt]); }
#pragma unroll
        for (int kt = 0; kt < 4; ++kt) y = MF16(cur.rt[kt], Sb[kt], y);
        y = MF16(cur.art, ub, y); y = MF16(cur.krt, cur.vm, y);
#pragma unroll
        for (int j = 0; j < 4; ++j) { const size_t R = rwkv_row(b, dir, c * 16 + 4 * fq + j); Yo[R * 512 + h * 64 + 16 * wave + fr] = y[j]; }
        cur = nx1; nx1 = nx2;
    }
#undef MF16
}

constexpr int SS_CM = 0, SS_BM = 17408, SS_BST = 34816, SS_XT = 53248, SS_MX = 62464, SS_HB = 71680, SS_CS = 89088, SS_DT = 89344;
__device__ __forceinline__ float bfe(const v4u& v, int i) { const unsigned u = (i < 2) ? v.x : (i < 4) ? v.y : (i < 6) ? v.z : v.w; return (i & 1) ? bfhi(u) : bflo(u); }
__device__ __forceinline__ unsigned short bfraw(const v4u& v, int i) { const unsigned u = (i < 2) ? v.x : (i < 4) ? v.y : (i < 6) ? v.z : v.w; return (unsigned short)((i & 1) ? (u >> 16) : (u & 0xffffu)); }
__device__ __forceinline__ void ssd_scan_fast(KArgs a, int idx, LAS unsigned char* lds, int tid, int lane, int wave) {
    unsigned char* ws = a->ws; const bf16* XBC = (const bf16*)(ws + OFF_XBC); const float* DTA = (const float*)(ws + OFF_DTA);
    const int b = idx / 24, dir = (idx % 24) / 12, h = idx % 12, g = h / 3, q = dir * 12 + h;
    float* Yo = (float*)(ws + OFF_YSSD) + (size_t)dir * TT * 768;
    LAS bf16* Cm = (LAS bf16*)(lds + SS_CM); LAS bf16* Bm = (LAS bf16*)(lds + SS_BM); LAS bf16* BsT = (LAS bf16*)(lds + SS_BST); LAS bf16* XT = (LAS bf16*)(lds + SS_XT);
    LAS bf16* Mx = (LAS bf16*)(lds + SS_MX); LAS bf16* Hb = (LAS bf16*)(lds + SS_HB); LAS float* CS = (LAS float*)(lds + SS_CS); LAS float* DTV = (LAS float*)(lds + SS_DT);
    const int fr = lane & 15, fq = lane >> 4, ss = tid & 63, sc = tid >> 6, tl = wave >> 1, wh = wave & 1;
    { unsigned z = 0u; asm volatile("" : "+v"(z)); for (int i = tid; i < 17408 / 16; i += NTHR) *(LAS v4u*)(lds + SS_HB + i * 16) = (v4u){z, z, z, z}; }
    f32x4 hacc[4];
#pragma unroll
    for (int j = 0; j < 4; ++j) hacc[j] = (f32x4){0.f, 0.f, 0.f, 0.f};
    v4u pc0, pc1, pb0, pb1, px; float pdt = 0.f, pa = 0.f;
    auto issue = [&](int ch) {
        const int tok = ssd_tok(b, dir, ch * 64 + ss); const bf16* row = XBC + (size_t)tok * 1792;
        pc0 = *(const v4u*)(row + 1280 + g * 128 + sc * 8); pc1 = *(const v4u*)(row + 1280 + g * 128 + (sc + 8) * 8);
        pb0 = *(const v4u*)(row + 768 + g * 128 + sc * 8); pb1 = *(const v4u*)(row + 768 + g * 128 + (sc + 8) * 8);
        px = *(const v4u*)(row + h * 64 + sc * 8);
        if (tid < 64) { pdt = DTA[(size_t)tok * 48 + q]; pa = DTA[(size_t)tok * 48 + 24 + q]; }
    };
    issue(0);
    for (int ch = 0; ch < RJ / 64; ++ch) {
        *(LAS v4u*)(Cm + ss * 136 + sc * 8) = pc0; *(LAS v4u*)(Cm + ss * 136 + (sc + 8) * 8) = pc1;
        *(LAS v4u*)(Bm + ss * 136 + sc * 8) = pb0; *(LAS v4u*)(Bm + ss * 136 + (sc + 8) * 8) = pb1;
#pragma unroll
        for (int i = 0; i < 8; ++i) XT[(sc * 8 + i) * 72 + ss] = bfraw(px, i);
        if (tid < 64) { float x = pa;
            x += __int_as_float(__builtin_amdgcn_update_dpp(0, __float_as_int(x), 0x111, 0xf, 0xf, false)); x += __int_as_float(__builtin_amdgcn_update_dpp(0, __float_as_int(x), 0x112, 0xf, 0xf, false));
            x += __int_as_float(__builtin_amdgcn_update_dpp(0, __float_as_int(x), 0x114, 0xf, 0xf, false)); x += __int_as_float(__builtin_amdgcn_update_dpp(0, __float_as_int(x), 0x118, 0xf, 0xf, false));
            x += __int_as_float(__builtin_amdgcn_update_dpp(0, __float_as_int(x), 0x142, 0xa, 0xf, false)); x += __int_as_float(__builtin_amdgcn_update_dpp(0, __float_as_int(x), 0x143, 0xc, 0xf, false));
            CS[tid] = x; DTV[tid] = pdt; }
        __syncthreads();
        const float cl = CS[63];
        { const float scl = DTV[ss] * __expf(cl - CS[ss]);
#pragma unroll
            for (int i = 0; i < 8; ++i) { BsT[(sc * 8 + i) * 72 + ss] = (bf16)f2bf(bfe(pb0, i) * scl); BsT[((sc + 8) * 8 + i) * 72 + ss] = (bf16)f2bf(bfe(pb1, i) * scl); } }
        if (ch + 1 < RJ / 64) issue(ch + 1);
#pragma unroll
        for (int j = 0; j < 2; ++j) { const int tc = wh * 2 + j; f32x4 acc = (f32x4){0.f, 0.f, 0.f, 0.f};
            if (tc <= tl) {
#pragma unroll
                for (int ks = 0; ks < 4; ++ks) { const bf16x8 af = *(const LAS bf16x8*)(Cm + (16 * tl + fr) * 136 + ks * 32 + fq * 8), bf = *(const LAS bf16x8*)(Bm + (16 * tc + fr) * 136 + ks * 32 + fq * 8);
                    acc = __builtin_amdgcn_mfma_f32_16x16x32_bf16(af, bf, acc, 0, 0, 0); } }
            const int s = 16 * tc + fr; const float css = CS[s], dts = DTV[s];
#pragma unroll
            for (int i = 0; i < 4; ++i) { const int l = 16 * tl + 4 * fq + i; const float v = (s <= l) ? acc[i] * __expf(CS[l] - css) * dts : 0.f; Mx[l * 72 + s] = (bf16)f2bf(v); } }
        __syncthreads();
#pragma unroll
        for (int j = 0; j < 2; ++j) { const int tp = wh * 2 + j; f32x4 acc = (f32x4){0.f, 0.f, 0.f, 0.f};
#pragma unroll
            for (int ks = 0; ks < 4; ++ks) { const bf16x8 af = *(const LAS bf16x8*)(Cm + (16 * tl + fr) * 136 + ks * 32 + fq * 8), bf = *(const LAS bf16x8*)(Hb + (16 * tp + fr) * 136 + ks * 32 + fq * 8);
                acc = __builtin_amdgcn_mfma_f32_16x16x32_bf16(af, bf, acc, 0, 0, 0); }
#pragma unroll
            for (int i = 0; i < 4; ++i) acc[i] *= __expf(CS[16 * tl + 4 * fq + i]);
#pragma unroll
            for (int ks = 0; ks < 2; ++ks) { const bf16x8 af = *(const LAS bf16x8*)(Mx + (16 * tl + fr) * 72 + ks * 32 + fq * 8), bf = *(const LAS bf16x8*)(XT + (16 * tp + fr) * 72 + ks * 32 + fq * 8);
                acc = __builtin_amdgcn_mfma_f32_16x16x32_bf16(af, bf, acc, 0, 0, 0); }
#pragma unroll
            for (int i = 0; i < 4; ++i) { const int tok = ssd_tok(b, dir, ch * 64 + 16 * tl + 4 * fq + i); Yo[(size_t)tok * 768 + h * 64 + 16 * tp + fr] = acc[i]; } }
        { const float ecl = __expf(cl);
#pragma unroll
            for (int j = 0; j < 4; ++j) { const int tn = wh * 4 + j; hacc[j] = hacc[j] * ecl;
#pragma unroll
                for (int ks = 0; ks < 2; ++ks) { const bf16x8 af = *(const LAS bf16x8*)(XT + (16 * tl + fr) * 72 + ks * 32 + fq * 8), bf = *(const LAS bf16x8*)(BsT + (16 * tn + fr) * 72 + ks * 32 + fq * 8);
                    hacc[j] = __builtin_amdgcn_mfma_f32_16x16x32_bf16(af, bf, hacc[j], 0, 0, 0); } } }
        __syncthreads();
#pragma unroll
        for (int j = 0; j < 4; ++j) { const int tn = wh * 4 + j;
#pragma unroll
            for (int i = 0; i < 4; ++i) Hb[(16 * tl + 4 * fq + i) * 136 + 16 * tn + fr] = (bf16)f2bf(hacc[j][i]); }
    }
}

constexpr int NPH = 2 + 10 * DEPTH;
#ifndef PROBE_MASK
#define PROBE_MASK 0
#endif
#ifndef PROBE_P0
#define PROBE_P0 0
#endif
#ifndef PROBE_SUB
#define PROBE_SUB 0
#endif
#ifndef PROBE_REPS
#define PROBE_REPS 3
#endif
#define REPS(k) (((PROBE_MASK >> (k)) & 1) ? PROBE_REPS : 1)
constexpr int GATE_LATE = 32;
constexpr int GATE_X = 672, GATE_Z = 320;
#ifndef MK_ONE_LAUNCH
#define MK_ONE_LAUNCH 1
#endif

__global__ void __launch_bounds__(NTHR, 2) fwd(Args a_unused) {
    extern __shared__ __attribute__((aligned(16))) unsigned char lds_raw[];
    LAS unsigned char* lds = (LAS unsigned char*)lds_raw;
    const int bid0 = blockIdx.x, G0 = gridDim.x, wave0 = __builtin_amdgcn_readfirstlane(threadIdx.x >> 6);
#define PH_BG int bid = bid0, G = G0; asm volatile("" : "+s"(bid), "+s"(G));
    volatile LAS unsigned* MISCW = (volatile LAS unsigned*)(lds + MISC_OFF);
    if (threadIdx.x < 32) MISCW[threadIdx.x] = 0u;
    __syncthreads();
    const int ph_lo = kargs()->ph_lo, ph_hi = kargs()->ph_hi;
    const bool multi = (ph_hi - ph_lo) > 1;
    XcdBarrier bar; bar.bar = (unsigned*)(kargs()->ws + OFF_CTL) + CW_BAR; bar.x = 0; bar.st = nullptr; bar.wv = wave0;
    if (multi) bar = xcd_barrier_post((unsigned*)(kargs()->ws + OFF_CTL) + CW_BAR, MISCW + 8, wave0);
#define IN(k) (ph_lo <= (k) && (k) < ph_hi)
#define SEAM(k) do { if (IN(k) && IN((k) + 1)) xcd_barrier(bar); } while (0)

    for (int rep = 0; rep < (PROBE_P0 ? PROBE_REPS : 1); ++rep) {
    if (IN(0)) { PH_BG p0_prologue(kargs(), lds, bid, G, wave0); }
    if (rep + 1 < (PROBE_P0 ? PROBE_REPS : 1)) xcd_barrier(bar); }
    SEAM(0);
    if (IN(1)) { PH_BG KArgs a = kargs(); norm_phase(a, 0, nullptr, a->in[I_NORMG] + 0, nullptr, (const float*)(a->ws + OFF_MODV), bid, G, wave0, TT); }
    SEAM(1);

    for (int l = 0; l < DEPTH; ++l) {
        const int pb = 2 + 10 * l;
#define PH_LOCALS PH_BG KArgs a = kargs(); unsigned char* ws = a->ws; unsigned char* wl = ws + OFF_W + (size_t)l * W_LAYER; bf16* Hb = (bf16*)(ws + OFF_H); (void)wl; (void)Hb; \
        const float* ng = a->in[I_NORMG] + (size_t)l * 4 * DM; const float* mv = (const float*)(ws + OFF_MODV) + (size_t)l * 5 * 12288; (void)ng; (void)mv;
        const bool lastl = (l == DEPTH - 1);
        for (int rep = 0; rep < REPS(0); ++rep) {
        if (IN(pb + 0)) { PH_LOCALS
            __syncthreads();
            pg8::Sched2 S; S.A0 = (const char*)Hb; S.B0 = (const char*)(wl + WO_IN); S.A1 = (const char*)(wl + WO_FFT); S.B1 = (const char*)Hb; S.tstep = (size_t)256 * DM * 2; S.ntk = DM / 64;
            S.t0.init(TT / 256, NU / 256 - GATE_LATE); S.t1.init(4, TT / 256); S.G = G; S.c = bid;
            pg8::EpiIn2 E{pg8::EpiInproj{(bf16*)(ws + OFF_U), (float*)(ws + OFF_MISC), NU}, pg8::EpiBf{0, (bf16*)(ws + OFF_VTL), (bf16*)(ws + OFF_VTC)}};
            pg8::gemm_phase<pg8::EpiIn2, pg8::Sched2, true, true>(lds, DM, S, E, wave0);
        }
        if (rep + 1 < REPS(0)) xcd_barrier(bar); }
        SEAM(pb + 0);
        for (int rep = 0; rep < REPS(1); ++rep) {
        if (IN(pb + 1)) { PH_LOCALS PH_IDS
            __syncthreads();
            if (bid < 64) { pg8::Sched2 S; S.A0 = (const char*)(ws + OFF_DFTL); S.B0 = (const char*)(ws + OFF_VTL); S.A1 = S.A0; S.B1 = S.B0; S.tstep = (size_t)256 * 4096 * 2; S.ntk = 64; S.t0.init(8, 8); S.t1.init(0, 0); S.G = 64; S.c = bid;
                  pg8::EpiBf E{1, (bf16*)(ws + OFF_ACAT), nullptr};
                  pg8::gemm_phase<pg8::EpiBf, pg8::Sched2, true, true>(lds, 4096, S, E, wave0); }
            else if (bid < 72) { pg8::Sched2 S; S.A0 = (const char*)(ws + OFF_DFTC); S.B0 = (const char*)(ws + OFF_VTC); S.A1 = S.A0; S.B1 = S.B0; S.tstep = (size_t)256 * 512 * 2; S.ntk = 8; S.t0.init(1, 8); S.t1.init(0, 0); S.G = 8; S.c = bid - 64;
                  pg8::EpiBf E{2, (bf16*)(ws + OFF_ACAT), nullptr};
                  pg8::gemm_phase<pg8::EpiBf, pg8::Sched2, true, true>(lds, 512, S, E, wave0); }
            __syncthreads();
            {
                unsigned* qctr = (unsigned*)(ws + OFF_CTL) + CW_Q + (l * 4 + rep) * 64;
                volatile LAS unsigned* qslot = (volatile LAS unsigned*)(lds + MISC_OFF) + 16;
                for (;;) {
                    if (tid == 0) qslot[0] = __hip_atomic_fetch_add(qctr, 1u, __ATOMIC_RELAXED, __HIP_MEMORY_SCOPE_AGENT);
                    __syncthreads();
                    const int it = (int)qslot[0];
                    __syncthreads();
                    if (it >= 576 + 288 + 576) break;
                    int ln_i = lane; asm volatile("" : "+v"(ln_i)); const int tid_i = wave * 64 + ln_i;
                    if (it < 576) rwkv_prep_item(a, l, it, lds, tid_i, ln_i, wave);
                    else if (it < 576 + 288) conv_item(a, l, it - 576, lds, tid_i, ln_i, wave);
                    else ssd_prep_item(a, l, it - 576 - 288, tid_i);
                }
            }
        }
        if (rep + 1 < REPS(1)) xcd_barrier(bar); }
        SEAM(pb + 1);
        for (int rep = 0; rep < REPS(2); ++rep) {
        if (IN(pb + 2)) { PH_LOCALS PH_IDS
            __syncthreads();
            if (bid < 64) { if (rep == 0 || PROBE_SUB == 0) rwkv_scan_chunk(a, bid, lane, wave); }
            else if (bid < 160) { if (rep == 0 || PROBE_SUB == 1) ssd_scan_fast(a, bid - 64, lds, tid, lane, wave); }
            __syncthreads();
            if (rep == 0 || PROBE_SUB == 2) {
                pg8::Sched2 S; S.A0 = (const char*)Hb; S.B0 = (const char*)(wl + WO_IN); S.A1 = S.A0; S.B1 = S.B0; S.tstep = (size_t)256 * DM * 2; S.ntk = DM / 64;
                S.t0.init(TT / 256, GATE_LATE); S.t1.init(0, 0); S.pn_off0 = NU / 256 - GATE_LATE;
                if (bid >= 160) { S.G = 96; S.c = bid - 160; S.first = 0; S.limit = GATE_X; }
                else if (bid < 64) { S.G = 64; S.c = bid; S.first = GATE_X; S.limit = GATE_X + GATE_Z; }
                else { S.G = 96; S.c = bid - 64; S.first = GATE_X + GATE_Z; S.limit = 36 * GATE_LATE; }
                pg8::EpiIn2 E{pg8::EpiInproj{(bf16*)(ws + OFF_U), (float*)(ws + OFF_MISC), NU}, pg8::EpiBf{0, (bf16*)(ws + OFF_VTL), (bf16*)(ws + OFF_VTC)}};
                pg8::gemm_phase<pg8::EpiIn2, pg8::Sched2, true, true>(lds, DM, S, E, wave0); }
        }
        if (rep + 1 < REPS(2)) xcd_barrier(bar); }
        SEAM(pb + 2);
        for (int rep = 0; rep < REPS(3); ++rep) {
        if (IN(pb + 3)) { PH_BG post_phase(kargs(), l, bid, G, wave0); }
        if (rep + 1 < REPS(3)) xcd_barrier(bar); }
        SEAM(pb + 3);
        for (int rep = 0; rep < REPS(4); ++rep) {
        if (IN(pb + 4)) { PH_LOCALS
            __syncthreads();
            pg8::Sched2 S; S.A0 = (const char*)(ws + OFF_ACAT); S.B0 = (const char*)(wl + WO_CAT); S.A1 = S.A0; S.B1 = S.B0; S.tstep = (size_t)256 * ACW * 2; S.ntk = ACW / 64;
            S.t0.init(lastl ? TLAT / 256 : TT / 256, DM / 256); S.t1.init(0, 0); S.G = G; S.c = bid;
            pg8::EpiChain E{(const bf16*)(ws + OFF_U) + UGATE, NU, (bf16*)(ws + OFF_M)};
            pg8::gemm_phase<pg8::EpiChain, pg8::Sched2, true, true>(lds, ACW, S, E, wave0);
        }
        if (rep + 1 < REPS(4)) xcd_barrier(bar); }
        SEAM(pb + 4);
        for (int rep = 0; rep < REPS(5); ++rep) {
        if (IN(pb + 5)) { PH_LOCALS
            __syncthreads();
            pg8::SchedSplit S; S.A = (const char*)(ws + OFF_M); S.B = (const char*)(wl + WO_O); S.tstep = (size_t)256 * DM * 2; S.ntk = DM / 64; S.tm.init(32, 8); S.nctx = lastl ? 0 : 256; S.G = G; S.c = bid;
            pg8::EpiF32 E{(float*)(ws + OFF_Y), (float*)(ws + OFF_YC)};
            pg8::gemm_phase<pg8::EpiF32, pg8::SchedSplit, true, true>(lds, DM, S, E, wave0);
        }
        if (rep + 1 < REPS(5)) xcd_barrier(bar); }
        SEAM(pb + 5);
        if (IN(pb + 6)) { PH_LOCALS norm_phase(a, 1, ng + 1 * DM, ng + 2 * DM, mv + 2 * DM, mv + 3 * DM, bid, G, wave0, lastl ? TLAT : TT, !lastl); }
        SEAM(pb + 6);
        for (int rep = 0; rep < REPS(7); ++rep) {
        if (IN(pb + 7)) { PH_LOCALS
            __syncthreads();
            pg8::Sched2 S; S.A0 = (const char*)Hb; S.B0 = (const char*)(wl + WO_UP); S.A1 = S.A0; S.B1 = S.B0; S.tstep = (size_t)256 * DM * 2; S.ntk = DM / 64;
            S.t0.init(lastl ? TLAT / 256 : TT / 256, DFF / 256); S.t1.init(0, 0); S.G = G; S.c = bid;
            pg8::EpiBf E{3, (bf16*)(ws + OFF_HB), nullptr};
            pg8::gemm_phase<pg8::EpiBf, pg8::Sched2, true, true>(lds, DM, S, E, wave0);
        }
        if (rep + 1 < REPS(7)) xcd_barrier(bar); }
        SEAM(pb + 7);
        for (int rep = 0; rep < REPS(8); ++rep) {
        if (IN(pb + 8)) { PH_LOCALS
            __syncthreads();
            pg8::SchedSplit S; S.A = (const char*)(ws + OFF_HB); S.B = (const char*)(wl + WO_DN); S.tstep = (size_t)256 * DFF * 2; S.ntk = DFF / 64; S.tm.init(32, 8); S.nctx = lastl ? 0 : 256; S.G = G; S.c = bid;
            pg8::EpiF32 E{(float*)(ws + OFF_Y), (float*)(ws + OFF_YC)};
            pg8::gemm_phase<pg8::EpiF32, pg8::SchedSplit, true, true>(lds, DFF, S, E, wave0);
        }
        if (rep + 1 < REPS(8)) xcd_barrier(bar); }
        SEAM(pb + 8);
        if (IN(pb + 9)) { PH_LOCALS
            if (!lastl) norm_phase(a, 1, ng + 3 * DM, ng + 4 * DM  , mv + 5 * DM, mv + 5 * 12288  , bid, G, wave0, TT, true);
            else norm_phase(a, 2, ng + 3 * DM, nullptr, mv + 5 * DM, nullptr, bid, G, wave0, TLAT);
        }
        SEAM(pb + 9);
    }
#undef IN
#undef SEAM
}

extern "C" void kernel_launch(void* const* d_in, const int* in_sizes, int n_in, void* d_out, int out_size, void* d_ws, size_t ws_size, hipStream_t stream) {
    static int grid = 0;
    if (grid == 0) {
        if (n_in != N_IN || out_size != TLAT * DM || ws_size < WS_END) { fprintf(stderr, "kernel_launch: unexpected shapes (n_in %d out %d ws %zu); nothing launched\n", n_in, out_size, ws_size); grid = -1; return; }
        int dev = 0, cus = 0;
        if (hipGetDevice(&dev) != hipSuccess || hipDeviceGetAttribute(&cus, hipDeviceAttributeMultiprocessorCount, dev) != hipSuccess) { grid = -1; return; }
        if (hipFuncSetAttribute((const void*)fwd, hipFuncAttributeMaxDynamicSharedMemorySize, LDS_BYTES) != hipSuccess) { fprintf(stderr, "kernel_launch: hipFuncSetAttribute failed\n"); grid = -1; return; }
        int per_cu = 0;
        if (hipOccupancyMaxActiveBlocksPerMultiprocessor(&per_cu, (const void*)fwd, NTHR, LDS_BYTES) != hipSuccess || per_cu < 1) fprintf(stderr, "kernel_launch: occupancy query says %d\n", per_cu);
        (void)hipGetLastError();
        grid = cus;
        if (grid < 232) { fprintf(stderr, "kernel_launch: %d CUs: this kernel's scan phase needs > 160 workgroups\n", grid); grid = -1; return; }
    }
    if (grid < 0) return;
    if (hipMemsetAsync((char*)d_ws + OFF_CTL, 0, CTL_BYTES, stream) != hipSuccess) return;
    Args a{};
    for (int i = 0; i < N_IN; ++i) a.in[i] = (const float*)d_in[i];
    a.out = (float*)d_out; a.ws = (unsigned char*)d_ws;
#if MK_ONE_LAUNCH
    a.ph_lo = 0; a.ph_hi = NPH;
    hipLaunchKernelGGL(fwd, dim3(grid), dim3(NTHR), LDS_BYTES, stream, a);
#else
    for (int p = 0; p < NPH; ++p) { a.ph_lo = p; a.ph_hi = p + 1; hipLaunchKernelGGL(fwd, dim3(grid), dim3(NTHR), LDS_BYTES, stream, a); }
#endif
}
```

```cpp
#include <hip/hip_runtime.h>
#include <cstdio>
#include <cstdint>
namespace pg8 {
#define PG8_LAS __attribute__((address_space(3)))
typedef unsigned short bf16_t;
typedef short bf16x8 __attribute__((ext_vector_type(8)));
typedef float f32x4 __attribute__((ext_vector_type(4)));
typedef unsigned u32x4 __attribute__((ext_vector_type(4)));
constexpr int BM = 256, BK = 64, HALF = 128, HTB = HALF * BK * 2  , STAGE_BYTES = 8 * HTB, NXCD = 8, WGM = 8;

__host__ __device__ __forceinline__ int lds_byte(int r, int c) { const int st = (r >> 4) * 2 + (c >> 5), rr = r & 15, cc = c & 31, ob = rr * 64 + cc * 2; return st * 1024 + (ob ^ (((ob >> 9) & 1) << 5)); }
__host__ __device__ __forceinline__ void stage_rc(int b, int& R, int& C) { const int st = b / 1024, sb = b % 1024, swz = sb ^ (((sb >> 9) & 1) << 5); R = (st >> 1) * 16 + swz / 64; C = (st & 1) * 32 + (swz % 64) / 2; }
__host__ __device__ __forceinline__ int perm32(int rho) { const int n = rho >> 4, i = rho & 15; return 8 * (i >> 2) + 4 * n + (i & 3); }

struct Unit { int pm, pn, kind; };
struct Gemm { const bf16_t* A; const bf16_t* Bt; int M, N, K; };

struct StaticOrder {
    int nM, nN, nwg, G, c;
    __host__ __device__ void init(int M, int N, int G_, int c_) { nM = M / BM; nN = N / BM; nwg = nM * nN; G = G_; c = c_; }
    __host__ __device__ bool next(int i, Unit& u) const {
        const long L = (long)i * G + c; if (L >= nwg) return false;
        int wgid = (int)L; { const int q = nwg / NXCD, r = nwg % NXCD, xcd = wgid % NXCD, off = wgid / NXCD; wgid = (xcd < r ? xcd * (q + 1) : r * (q + 1) + (xcd - r) * q) + off; }
        const int nig = WGM * nN, gid = wgid / nig, fm = gid * WGM, gsz = (nM - fm) < WGM ? (nM - fm) : WGM;
        u.pm = fm + ((wgid % nig) % gsz); u.pn = (wgid % nig) / gsz; return true;
    }
    __device__ __forceinline__ void a_ready(const Unit&) const {}
    __device__ __forceinline__ void done(const Unit&) const {}
};
typedef float f32x2n __attribute__((ext_vector_type(2))); typedef __bf16 bf16x2n __attribute__((ext_vector_type(2)));
__device__ __forceinline__ unsigned cvt_pk_bf16(float lo, float hi) { const bf16x2n r = __builtin_convertvector((f32x2n){lo, hi}, bf16x2n); return __builtin_bit_cast(unsigned, r); }
typedef float f32x2 __attribute__((ext_vector_type(2)));
template <class Epi, class Sched, bool ALIGN_EPI = false, bool SP2 = false>
__device__ __forceinline__ void gemm_phase(PG8_LAS unsigned char* lds, const int ldk  , const Sched& S, const Epi& E, const int wave_id) {
    unsigned z_ = 0u; asm volatile("" : "+v"(z_)); const int lane_ = (int)__builtin_amdgcn_mbcnt_hi(~0u, __builtin_amdgcn_mbcnt_lo(~0u, z_)); int wid_ = wave_id; asm volatile("" : "+s"(wid_)); const int wid = wid_, lane = lane_, tid = wid * 64 + lane, wr = wid >> 2, wc = wid & 3, fr = lane & 15, fq = lane >> 4;
    const int K = ldk; int nt;
    unsigned voffA[2], voffB[2];
#pragma unroll
    for (int i = 0; i < 2; ++i) { int R, C; stage_rc(tid * 16 + i * 8192, R, C); const int Rb = Epi::PERM ? ((R & ~31) + perm32(R & 31)) : R;
        voffA[i] = (unsigned)(R * K + C) * 2u; voffB[i] = (unsigned)(Rb * K + C) * 2u; }
    const size_t kstep = (size_t)(BK * 2);
    const size_t hstep = (size_t)HALF * K * 2;
    const unsigned ldsw = (unsigned)wid * 1024u;
    const int aoff = lds_byte(wr * 64 + fr, fq * 8), boff = lds_byte(wc * 32 + fr, fq * 8);
#define PG8_SA(b, h) (((b) * 2 + (h)) * HTB)
#define PG8_SB(b, h) ((4 + (b) * 2 + (h)) * HTB)
#define PG8_STAGE(bufoff, gbase, voff) do { _Pragma("unroll") for (int _i = 0; _i < 2; ++_i) \
        __builtin_amdgcn_global_load_lds((const unsigned*)((const char*)(gbase) + (voff)[_i]), (PG8_LAS unsigned*)(lds + (bufoff) + ldsw + _i * 8192), 16, 0, 0); } while (0)
#define PG8_LDA(dst, b, h) do { _Pragma("unroll") for (int m = 0; m < 4; ++m) _Pragma("unroll") for (int k = 0; k < 2; ++k) dst[m][k] = *(const PG8_LAS bf16x8*)(lds + PG8_SA(b, h) + aoff + m * 2048 + k * 1024); } while (0)
#define PG8_LDB(dst, b, h) do { _Pragma("unroll") for (int n = 0; n < 2; ++n) _Pragma("unroll") for (int k = 0; k < 2; ++k) dst[n][k] = *(const PG8_LAS bf16x8*)(lds + PG8_SB(b, h) + boff + n * 2048 + k * 1024); } while (0)
#define PG8_MMA(ai, bj, At, Bt) do { __builtin_amdgcn_s_setprio(1); _Pragma("unroll") for (int m = 0; m < 4; ++m) _Pragma("unroll") for (int n = 0; n < 2; ++n) _Pragma("unroll") for (int k = 0; k < 2; ++k) \
        acc[ai][bj][m][n] = __builtin_amdgcn_mfma_f32_16x16x32_bf16(Bt[n][k], At[m][k], acc[ai][bj][m][n], 0, 0, 0); __builtin_amdgcn_s_setprio(0); } while (0)
#define PG8_WAIT_V(n) asm volatile("s_waitcnt vmcnt(" #n ")" ::: "memory")
#define PG8_WAIT_L(n) asm volatile("s_waitcnt lgkmcnt(" #n ")" ::: "memory")
#define PG8_BAR __builtin_amdgcn_s_barrier()
#define PG8_SCHED __builtin_amdgcn_sched_barrier(0)
    Unit cur, nxt; int ui = 0;
    if (!S.next(0, cur)) return;
    f32x4 acc[2][2][4][2];
#pragma unroll
    for (int a = 0; a < 2; ++a)
#pragma unroll
        for (int b = 0; b < 2; ++b)
#pragma unroll
            for (int m = 0; m < 4; ++m)
#pragma unroll
                for (int n = 0; n < 2; ++n) acc[a][b][m][n] = (f32x4){0.f, 0.f, 0.f, 0.f};
    bf16x8 At[4][2], B0[2][2], B1[2][2];
    const char* cA = S.abase(cur); const char* cB = S.bbase(cur); nt = S.nt(cur);
    S.a_ready(cur);
    if constexpr (SP2) {
        PG8_STAGE(PG8_SB(0, 0), cB, voffB); PG8_STAGE(PG8_SB(0, 1), cB + hstep, voffB); PG8_STAGE(PG8_SA(0, 0), cA, voffA); PG8_STAGE(PG8_SA(0, 1), cA + hstep, voffA);
        if (wr == 1) PG8_BAR;
        PG8_WAIT_V(2); PG8_BAR;
        PG8_STAGE(PG8_SB(1, 0), cB + kstep, voffB); PG8_STAGE(PG8_SA(1, 0), cA + kstep, voffA); PG8_STAGE(PG8_SB(1, 1), cB + hstep + kstep, voffB);
        PG8_WAIT_V(6); PG8_BAR;
    } else {
        PG8_STAGE(PG8_SB(0, 0), cB, voffB); PG8_STAGE(PG8_SA(0, 0), cA, voffA); PG8_STAGE(PG8_SB(0, 1), cB + hstep, voffB); PG8_STAGE(PG8_SA(0, 1), cA + hstep, voffA);
        if (wr == 1) PG8_BAR;
        PG8_WAIT_V(4); PG8_BAR;
        PG8_STAGE(PG8_SB(1, 0), cB + kstep, voffB); PG8_STAGE(PG8_SA(1, 0), cA + kstep, voffA); PG8_STAGE(PG8_SB(1, 1), cB + hstep + kstep, voffB);
        PG8_WAIT_V(6); PG8_BAR;
    }
    for (;;) {
        const bool has_next = S.next(ui + 1, nxt);
        const char* nA = has_next ? S.abase(nxt) : cA; const char* nB = has_next ? S.bbase(nxt) : cB;
        for (int t = 0; t < nt; t += 2) {
            const bool last = (t == nt - 2);
            const char* a1 = cA + (size_t)(t + 1) * kstep;
            const char* a2 = last ? nA : cA + (size_t)(t + 2) * kstep; const char* b2 = last ? nB : cB + (size_t)(t + 2) * kstep;
            const char* a3 = a2 + kstep; const char* b3 = b2 + kstep;
            if (last && has_next) S.a_ready(nxt);
            if constexpr (Epi::HOOK) E.khook(acc, cur, t, wr, wc, fr, fq);
            if constexpr (SP2) {
            PG8_LDB(B0, 0, 0); PG8_LDB(B1, 0, 1); PG8_SCHED; PG8_LDA(At, 0, 0); PG8_STAGE(PG8_SA(1, 1), a1 + hstep, voffA);
            PG8_WAIT_V(8); PG8_WAIT_L(0); PG8_BAR; PG8_MMA(0, 0, At, B0); PG8_MMA(0, 1, At, B1); PG8_BAR; PG8_SCHED;
            PG8_LDA(At, 0, 1); PG8_STAGE(PG8_SB(0, 0), b2, voffB); PG8_STAGE(PG8_SB(0, 1), b2 + hstep, voffB); PG8_STAGE(PG8_SA(0, 0), a2, voffA);
            PG8_WAIT_V(8); PG8_WAIT_L(0); PG8_BAR; PG8_MMA(1, 0, At, B0); PG8_MMA(1, 1, At, B1); PG8_BAR; PG8_SCHED;
            PG8_LDB(B0, 1, 0); PG8_LDB(B1, 1, 1); PG8_SCHED; PG8_LDA(At, 1, 0); PG8_STAGE(PG8_SA(0, 1), a2 + hstep, voffA);
            PG8_WAIT_V(8); PG8_WAIT_L(0); PG8_BAR; PG8_MMA(0, 0, At, B0); PG8_MMA(0, 1, At, B1); PG8_BAR; PG8_SCHED;
            PG8_LDA(At, 1, 1); PG8_STAGE(PG8_SB(1, 0), b3, voffB); PG8_STAGE(PG8_SB(1, 1), b3 + hstep, voffB); PG8_STAGE(PG8_SA(1, 0), a3, voffA);
            PG8_WAIT_V(8); PG8_WAIT_L(0); PG8_BAR; PG8_MMA(1, 0, At, B0); PG8_MMA(1, 1, At, B1); PG8_BAR; PG8_SCHED;
            } else {
            PG8_LDB(B0, 0, 0); PG8_SCHED; PG8_LDA(At, 0, 0); PG8_STAGE(PG8_SA(1, 1), a1 + hstep, voffA);
            PG8_WAIT_L(8); PG8_BAR; PG8_WAIT_L(0); PG8_MMA(0, 0, At, B0); PG8_BAR; PG8_SCHED;
            PG8_LDB(B1, 0, 1); PG8_STAGE(PG8_SB(0, 0), b2, voffB);
            PG8_BAR; PG8_WAIT_L(0); PG8_MMA(0, 1, At, B1); PG8_BAR;
            PG8_LDA(At, 0, 1); PG8_STAGE(PG8_SA(0, 0), a2, voffA);
            PG8_BAR; PG8_WAIT_L(0); PG8_MMA(1, 0, At, B0); PG8_BAR; PG8_SCHED;
            PG8_STAGE(PG8_SB(0, 1), b2 + hstep, voffB);
            PG8_WAIT_V(6); PG8_BAR; PG8_MMA(1, 1, At, B1); PG8_BAR;
            PG8_LDB(B0, 1, 0); PG8_SCHED; PG8_LDA(At, 1, 0); PG8_STAGE(PG8_SA(0, 1), a2 + hstep, voffA);
            PG8_WAIT_L(8); PG8_BAR; PG8_WAIT_L(0); PG8_MMA(0, 0, At, B0); PG8_BAR; PG8_SCHED;
            PG8_LDB(B1, 1, 1); PG8_STAGE(PG8_SB(1, 0), b3, voffB);
            PG8_BAR; PG8_WAIT_L(0); PG8_MMA(0, 1, At, B1); PG8_BAR;
            PG8_LDA(At, 1, 1); PG8_STAGE(PG8_SA(1, 0), a3, voffA);
            PG8_BAR; PG8_WAIT_L(0); PG8_MMA(1, 0, At, B0); PG8_BAR; PG8_SCHED;
            PG8_STAGE(PG8_SB(1, 1), b3 + hstep, voffB);
            PG8_WAIT_V(6); PG8_BAR; PG8_MMA(1, 1, At, B1); PG8_BAR;
            }
        }
        if constexpr (ALIGN_EPI) { if (wr == 0) PG8_BAR; }
        if constexpr (!Epi::AFTER_DRAIN) { E(acc, cur, wr, wc, fr, fq); S.done(cur); }
        if (!has_next) break;
#pragma unroll
        for (int a = 0; a < 2; ++a)
#pragma unroll
            for (int b = 0; b < 2; ++b)
#pragma unroll
                for (int m = 0; m < 4; ++m)
#pragma unroll
                    for (int n = 0; n < 2; ++n) acc[a][b][m][n] = (f32x4){0.f, 0.f, 0.f, 0.f};
        cur = nxt; cA = nA; cB = nB; ++ui; nt = S.nt(cur);
        if constexpr (ALIGN_EPI) { if (wr == 1) PG8_BAR; }
    }
    PG8_WAIT_V(0);
    if constexpr (!ALIGN_EPI) { if (wr == 0) PG8_BAR; }
    PG8_BAR;
    if constexpr (Epi::AFTER_DRAIN) { E.fused(acc, cur, wr, wc, fr, fq, lds, wid, lane); S.done(cur); }
#undef PG8_SA
#undef PG8_SB
#undef PG8_STAGE
#undef PG8_LDA
#undef PG8_LDB
#undef PG8_MMA
#undef PG8_WAIT_V
#undef PG8_WAIT_L
#undef PG8_BAR
#undef PG8_SCHED
}
}

namespace pg8 {
__device__ __forceinline__ float sigm(float x) { return __builtin_amdgcn_rcpf(1.f + __expf(-x)); }
__device__ __forceinline__ f32x4 sigm4(f32x4 v) { return (f32x4){sigm(v[0]), sigm(v[1]), sigm(v[2]), sigm(v[3])}; }
__device__ __forceinline__ u32x4 pack8(f32x4 v0, f32x4 v1) { u32x4 w; w.x = cvt_pk_bf16(v0[0], v0[1]); w.y = cvt_pk_bf16(v0[2], v0[3]); w.z = cvt_pk_bf16(v1[0], v1[1]); w.w = cvt_pk_bf16(v1[2], v1[3]); return w; }
__device__ __forceinline__ float bflo(unsigned u) { return __uint_as_float(u << 16); }
__device__ __forceinline__ float bfhi(unsigned u) { return __uint_as_float(u & 0xffff0000u); }


struct TileMap {
    int nM, nN, nwg;
    __device__ __forceinline__ void init(int nM_, int nN_) { nM = nM_; nN = nN_; nwg = nM_ * nN_; }
    __device__ __forceinline__ void map(int L, int& pm, int& pn) const {
        int wgid = L; { const int q = nwg / NXCD, r = nwg % NXCD, xcd = wgid % NXCD, off = wgid / NXCD; wgid = (xcd < r ? xcd * (q + 1) : r * (q + 1) + (xcd - r) * q) + off; }
        const int nig = WGM * nN, gid = wgid / nig, fm = gid * WGM, gsz = (nM - fm) < WGM ? (nM - fm) : WGM;
        pm = fm + ((wgid % nig) % gsz); pn = (wgid % nig) / gsz;
    }
};
struct Sched2 {
    const char *A0, *B0, *A1, *B1; size_t tstep; int ntk; TileMap t0, t1; int G, c;
    int pn_off0 = 0, first = 0, limit = 0x7fffffff;
    __device__ __forceinline__ bool next(int i, Unit& u) const { const int L = first + i * G + c;
        if (L >= limit) return false;
        if (L < t0.nwg) { t0.map(L, u.pm, u.pn); u.pn += pn_off0; u.kind = 0; return true; }
        if (L - t0.nwg < t1.nwg) { t1.map(L - t0.nwg, u.pm, u.pn); u.kind = 1; return true; }
        return false; }
    __device__ __forceinline__ const char* abase(const Unit& u) const { return (u.kind ? A1 : A0) + (size_t)u.pm * tstep; }
    __device__ __forceinline__ const char* bbase(const Unit& u) const { return (u.kind ? B1 : B0) + (size_t)u.pn * tstep; }
    __device__ __forceinline__ int nt(const Unit&) const { return ntk; }
    __device__ __forceinline__ void a_ready(const Unit&) const {}
    __device__ __forceinline__ void done(const Unit&) const {}
};
struct SchedSplit {
    const char *A, *B; size_t tstep; int ntk; TileMap tm; int nctx, G, c;
    __device__ __forceinline__ bool next(int i, Unit& u) const { const int L = i * G + c;
        if (L < 256) { tm.map(L, u.pm, u.pn); u.kind = 0; return true; }
        const int e = L - 256; if (e < nctx) { const int tile = e & 31; u.pm = 32 + (tile >> 3); u.pn = tile & 7; u.kind = 1 + (e >> 5); return true; }
        return false; }
    __device__ __forceinline__ const char* abase(const Unit& u) const { return A + (size_t)u.pm * tstep + (u.kind ? (size_t)(u.kind - 1) * (ntk / 8) * 128 : 0); }
    __device__ __forceinline__ const char* bbase(const Unit& u) const { return B + (size_t)u.pn * tstep + (u.kind ? (size_t)(u.kind - 1) * (ntk / 8) * 128 : 0); }
    __device__ __forceinline__ int nt(const Unit& u) const { return u.kind ? ntk / 8 : ntk; }
    __device__ __forceinline__ void a_ready(const Unit&) const {}
    __device__ __forceinline__ void done(const Unit&) const {}
};
struct EpiInproj {
    static constexpr bool PERM = true, AFTER_DRAIN = false, HOOK = false;
    bf16_t* U; float* MISC; int ldu;
    __device__ __forceinline__ void operator()(const f32x4 (&acc)[2][2][4][2], const Unit& u, int wr, int wc, int fr, int fq) const {
        const int row0 = u.pm * BM + wr * 64 + fr, cl = wc * 32 + 8 * fq;
        if (u.pn == 16 || u.pn == 17) {
#pragma unroll
            for (int ai = 0; ai < 2; ++ai)
#pragma unroll
                for (int m = 0; m < 4; ++m) { float* rowp = MISC + (size_t)(row0 + ai * HALF + m * 16) * 512 + (u.pn - 16) * BM + cl;
#pragma unroll
                    for (int bj = 0; bj < 2; ++bj) { *(f32x4*)(rowp + bj * HALF) = acc[ai][bj][m][0]; *(f32x4*)(rowp + bj * HALF + 4) = acc[ai][bj][m][1]; } }
        } else {
            const bool sg = u.pn >= 22;
#pragma unroll
            for (int ai = 0; ai < 2; ++ai)
#pragma unroll
                for (int m = 0; m < 4; ++m) { bf16_t* rowp = U + (size_t)(row0 + ai * HALF + m * 16) * ldu + u.pn * BM + cl;
#pragma unroll
                    for (int bj = 0; bj < 2; ++bj) { f32x4 v0 = acc[ai][bj][m][0], v1 = acc[ai][bj][m][1];
                        if (sg) { v0 = sigm4(v0); v1 = sigm4(v1); }
                        *(u32x4*)(rowp + bj * HALF) = pack8(v0, v1); } }
        }
    }
};
struct EpiBf {
    static constexpr bool PERM = true, AFTER_DRAIN = false, HOOK = false;
    int kind; bf16_t* O0; bf16_t* O1;
    __device__ __forceinline__ void operator()(const f32x4 (&acc)[2][2][4][2], const Unit& u, int wr, int wc, int fr, int fq) const {
        bf16_t* base; size_t pitch;
        if (kind == 0) {
            const int half = u.pm >> 1, chb = (u.pm & 1) * 256;
            if (u.pn < 32) { const int b = u.pn >> 3, l0 = (u.pn & 7) * 256; pitch = 4096; base = O0 + ((size_t)(b * 512 + chb) * 2 + half) * 2048 + l0; }
            else { const int b = u.pn - 32; pitch = 512; base = O1 + ((size_t)(b * 512 + chb) * 2 + half) * 256; }
        } else if (kind == 1) { const int b = u.pn >> 1; pitch = 2304; base = O0 + (size_t)(b * 2048 + u.pm * 256) * 2304 + 1280 + (u.pn & 1) * 256; }
        else if (kind == 2) { const int b = u.pn >> 1; pitch = 2304; base = O0 + (size_t)(8192 + b * 256) * 2304 + 1280 + (u.pn & 1) * 256; }
        else { pitch = 8192; base = O0 + (size_t)(u.pm * 256) * 8192 + u.pn * 256; }
        const int r0 = wr * 64 + fr, cl = wc * 32 + 8 * fq;
#pragma unroll
        for (int ai = 0; ai < 2; ++ai)
#pragma unroll
            for (int m = 0; m < 4; ++m) { bf16_t* rowp = base + (size_t)(r0 + ai * HALF + m * 16) * pitch + cl;
#pragma unroll
                for (int bj = 0; bj < 2; ++bj) { f32x4 v0 = acc[ai][bj][m][0], v1 = acc[ai][bj][m][1];
                    if (kind == 3) { v0 = __builtin_elementwise_max(v0, (f32x4){0.f, 0.f, 0.f, 0.f}); v1 = __builtin_elementwise_max(v1, (f32x4){0.f, 0.f, 0.f, 0.f}); v0 = v0 * v0; v1 = v1 * v1; }
                    *(u32x4*)(rowp + bj * HALF) = pack8(v0, v1); } }
    }
};
struct EpiChain {
    static constexpr bool PERM = true, AFTER_DRAIN = false, HOOK = true;
    const bf16_t* G; int ldg; bf16_t* Mo;
    __device__ __forceinline__ void khook(f32x4 (&acc)[2][2][4][2], const Unit& u, int t, int wr, int wc, int fr, int fq) const {
        if (t != 8 && t != 20 && t != 28) return;
        const int i = (t == 8) ? 0 : (t == 20 ? 1 : 2);
        int row0 = u.pm * BM + wr * 64 + fr; const int col0 = u.pn * BM + wc * 32 + 8 * fq + i * 2048;
        asm volatile("" : "+v"(row0));
#pragma unroll
        for (int ai = 0; ai < 2; ++ai)
#pragma unroll
            for (int m = 0; m < 4; ++m) { const bf16_t* gp = G + (size_t)(row0 + ai * HALF + m * 16) * ldg + col0;
#pragma unroll
                for (int bj = 0; bj < 2; ++bj) { const u32x4 g = *(const u32x4*)(gp + bj * HALF), h = *(const u32x4*)(gp + bj * HALF + 2048);
                    const unsigned gw[4] = {g.x, g.y, g.z, g.w}, hw[4] = {h.x, h.y, h.z, h.w};
#pragma unroll
                    for (int e2 = 0; e2 < 4; ++e2) { const float r0 = fmaxf(bflo(gw[e2]), 1e-6f) * __builtin_amdgcn_rcpf(fmaxf(bflo(hw[e2]), 1e-6f)), r1 = fmaxf(bfhi(gw[e2]), 1e-6f) * __builtin_amdgcn_rcpf(fmaxf(bfhi(hw[e2]), 1e-6f));
                        acc[ai][bj][m][e2 >> 1][(e2 & 1) * 2] *= r0; acc[ai][bj][m][e2 >> 1][(e2 & 1) * 2 + 1] *= r1; } }
                asm volatile("" ::: "memory"); }
    }
    __device__ __forceinline__ void operator()(const f32x4 (&acc)[2][2][4][2], const Unit& u, int wr, int wc, int fr, int fq) const {
        const int row0 = u.pm * BM + wr * 64 + fr, col0 = u.pn * BM + wc * 32 + 8 * fq;
#pragma unroll
        for (int ai = 0; ai < 2; ++ai)
#pragma unroll
            for (int m = 0; m < 4; ++m) { const size_t row = (size_t)(row0 + ai * HALF + m * 16);
#pragma unroll
                for (int bj = 0; bj < 2; ++bj) { const int col = col0 + bj * HALF;
                    const u32x4 g = *(const u32x4*)(G + row * ldg + col + 3 * 2048);
                    const f32x4 v0 = acc[ai][bj][m][0] * (f32x4){fmaxf(bflo(g.x), 1e-6f), fmaxf(bfhi(g.x), 1e-6f), fmaxf(bflo(g.y), 1e-6f), fmaxf(bfhi(g.y), 1e-6f)};
                    const f32x4 v1 = acc[ai][bj][m][1] * (f32x4){fmaxf(bflo(g.z), 1e-6f), fmaxf(bfhi(g.z), 1e-6f), fmaxf(bflo(g.w), 1e-6f), fmaxf(bfhi(g.w), 1e-6f)};
                    *(u32x4*)(Mo + row * 2048 + col) = pack8(v0, v1); } }
    }
};
struct EpiF32 {
    static constexpr bool PERM = false, AFTER_DRAIN = false, HOOK = false;
    float* C; float* YC;
    __device__ __forceinline__ void operator()(const f32x4 (&acc)[2][2][4][2], const Unit& u, int wr, int wc, int fr, int fq) const {
        const int row0 = u.pm * BM + wr * 64 + fr, col0 = u.pn * BM + wc * 32 + 4 * fq;
        float* base = u.kind ? (YC + (size_t)(u.kind - 1) * 1024 * 2048 + (size_t)(row0 - 8192) * 2048) : (C + (size_t)row0 * 2048);
#pragma unroll
        for (int ai = 0; ai < 2; ++ai)
#pragma unroll
            for (int m = 0; m < 4; ++m) { float* rowp = base + (size_t)(ai * HALF + m * 16) * 2048 + col0;
#pragma unroll
                for (int bj = 0; bj < 2; ++bj)
#pragma unroll
                    for (int n = 0; n < 2; ++n) *(f32x4*)(rowp + bj * HALF + n * 16) = acc[ai][bj][m][n]; }
    }
};
struct EpiIn2 {
    static constexpr bool PERM = true, AFTER_DRAIN = false, HOOK = false;
    EpiInproj e0; EpiBf e1;
    __device__ __forceinline__ void operator()(const f32x4 (&acc)[2][2][4][2], const Unit& u, int wr, int wc, int fr, int fq) const { if (u.kind == 0) e0(acc, u, wr, wc, fr, fq); else e1(acc, u, wr, wc, fr, fq); }
};
}

#define GAS __attribute__((address_space(1)))
#define LAS __attribute__((address_space(3)))
typedef unsigned short bf16;
typedef unsigned v4u __attribute__((ext_vector_type(4)));
typedef unsigned v2u __attribute__((ext_vector_type(2)));
typedef float f32x4 __attribute__((ext_vector_type(4)));
typedef float f32x2 __attribute__((ext_vector_type(2)));
constexpr int NWAVES = 8, NTHR = 512;
constexpr int DM = 2048, NBATCH = 4, LSEQ = 2048, LCTX = 256, DEPTH = 4;
constexpr int TLAT = NBATCH * LSEQ, TCTX = NBATCH * LCTX, TT = TLAT + TCTX;
constexpr int IN_DIM = 14168, DFF = 8192;
constexpr int NU = 13824;
constexpr int UZ = 0, UXBC = 768, URKV = 2560, UMISC = 4096, UCONV = 4608, UGATE = 5632;
constexpr int S_RKV = 2584, S_DT = 2560, S_WF = 4120, S_CONV = 4440, S_FFT = 5464, S_GATE = 5976;
constexpr int RJ = LCTX + LSEQ;
enum { I_X = 0, I_C, I_CTX, I_CCTX, I_MODW, I_MODB, I_NORMG, I_WIN, I_CONVW, I_CONVB, I_CLNG, I_CLNB, I_CONVOUT, I_SCW, I_SCB, I_SALOG, I_SDTB, I_SD, I_SNG, I_SOUT,
       I_FOUT, I_RMU, I_RW0, I_RW2, I_RA0, I_RA2, I_RG2, I_RKK, I_RKA, I_RRK, I_RLNG, I_RLNB, I_ROUT, I_WO, I_UP, I_DOWN, N_IN };
constexpr size_t MiB = 1u << 20;
constexpr size_t OFF_CTL = 0, CTL_BYTES = 1 * MiB;
constexpr size_t OFF_MODV = 1 * MiB;
constexpr size_t OFF_DFTL = 2 * MiB;
constexpr size_t OFF_DFTC = 18 * MiB;
constexpr size_t OFF_W = 20 * MiB, W_LAYER = 139 * MiB;
constexpr size_t WO_IN = 0, WO_FFT = 54 * MiB, WO_CAT = 58 * MiB  , WO_O = 67 * MiB, WO_UP = 75 * MiB, WO_DN = 107 * MiB;
constexpr size_t OFF_X = 576 * MiB;
constexpr size_t OFF_H = 648 * MiB;
constexpr size_t OFF_U = 684 * MiB;
constexpr size_t OFF_HB = OFF_U;
constexpr size_t OFF_MISC = 927 * MiB;
constexpr size_t OFF_VTL = 945 * MiB;
constexpr size_t OFF_VTC = 961 * MiB;
constexpr size_t OFF_ACAT = 963 * MiB;
constexpr int AC_CONV = 0, AC_SSD = 512, AC_FFT = 1280, AC_RWKV = 1792, ACW = 2304;
constexpr size_t OFF_XBC = 1004 * MiB;
constexpr size_t OFF_DTA = 1036 * MiB;
constexpr size_t OFF_YSSD = 1038 * MiB;
constexpr size_t OFF_RW = 1092 * MiB, RW_ARR = 18 * MiB;
constexpr size_t OFF_RCH = OFF_RW;
constexpr size_t OFF_RSC = 1254 * MiB;
constexpr size_t OFF_YRW = 1255 * MiB;
constexpr size_t OFF_MBUF = 1291 * MiB;
constexpr size_t OFF_M = 1363 * MiB;
constexpr size_t OFF_Y = 1399 * MiB;
constexpr size_t OFF_WLT = 1471 * MiB;
constexpr size_t OFF_YC = 1473 * MiB;
constexpr size_t WS_END = 1537 * MiB;
constexpr int CW_Q = 8192;
constexpr int CW_BAR = 4096;
constexpr int RING_BYTES = 131072, MISC_OFF = RING_BYTES + 320, LDS_BYTES = 147456;

__device__ __forceinline__ float bf2f(unsigned short b) { return __uint_as_float((unsigned)b << 16); }
__device__ __forceinline__ float bflo(unsigned u) { return __uint_as_float(u << 16); }
__device__ __forceinline__ float bfhi(unsigned u) { return __uint_as_float(u & 0xffff0000u); }
__device__ __forceinline__ unsigned f2bf(float f) { unsigned u = __builtin_bit_cast(unsigned, f); return (u + 0x7fffu + ((u >> 16) & 1u)) >> 16; }
typedef __bf16 bf16x2_t __attribute__((ext_vector_type(2)));
__device__ __forceinline__ unsigned pk2(float lo, float hi) { const bf16x2_t r = __builtin_convertvector((f32x2){lo, hi}, bf16x2_t); return __builtin_bit_cast(unsigned, r); }
__device__ __forceinline__ float sigmoidf_(float x) { return 1.f / (1.f + __expf(-x)); }
__device__ __forceinline__ float siluf_(float x) { return x / (1.f + __expf(-x)); }
__device__ __forceinline__ float softplusf_(float x) { return fmaxf(x, 0.f) + log1pf(__expf(-fabsf(x))); }
template <int CTRL> __device__ __forceinline__ float dpp_add(float x) { return x + __int_as_float(__builtin_amdgcn_update_dpp(0, __float_as_int(x), CTRL, 0xf, 0xf, true)); }
__device__ __forceinline__ float sum8(float x) { x = dpp_add<0xB1>(x); x = dpp_add<0x4E>(x); x = dpp_add<0x141>(x); return x; }
__device__ __forceinline__ float row16_sum(float x) { x = sum8(x); x = dpp_add<0x140>(x); return x; }
__device__ __forceinline__ float wave_sum(float v) {
    const float r = row16_sum(v);
    return (__int_as_float(__builtin_amdgcn_readlane(__float_as_int(r), 0)) + __int_as_float(__builtin_amdgcn_readlane(__float_as_int(r), 16))) +
           (__int_as_float(__builtin_amdgcn_readlane(__float_as_int(r), 32)) + __int_as_float(__builtin_amdgcn_readlane(__float_as_int(r), 48)));
}
#define LDS_WAIT() asm volatile("s_waitcnt lgkmcnt(0)" ::: "memory")

struct Args { const float* in[N_IN]; float* out; unsigned char* ws; int ph_lo, ph_hi; };
typedef const __attribute__((address_space(4))) Args* KArgs;
__device__ __forceinline__ KArgs kargs() { KArgs p = (KArgs)__builtin_amdgcn_kernarg_segment_ptr(); asm volatile("" : "+s"(p)); return p; }
#define PH_IDS unsigned z_ = 0u; asm volatile("" : "+v"(z_)); const int lane_ = (int)__builtin_amdgcn_mbcnt_hi(~0u, __builtin_amdgcn_mbcnt_lo(~0u, z_)); int wv_ = wave0; asm volatile("" : "+s"(wv_)); const int lane = lane_, wave = wv_, tid = wv_ * 64 + lane_; (void)lane; (void)wave; (void)tid;

__device__ __forceinline__ int inmap(int n) {
    if (n < 2560) return n;
    if (n < 4096) return S_RKV + (n - 2560);
    if (n < 4608) { const int m = n - 4096; if (m < 24) return S_DT + m; if (m < 64) return -1; if (m < 384) return S_WF + (m - 64); return -1; }
    if (n < 5632) return S_CONV + (n - 4608);
    return S_GATE + (n - 5632);
}
__device__ __forceinline__ int rwkv_tok(int b, int j) { if (j < LCTX) return TLAT + b * LCTX + j; const int s = j - LCTX; return b * LSEQ + (s & 31) * 64 + (s >> 5); }

__device__ __forceinline__ void transpose_item(const float* W, int ldw, int Nsrc, bf16* WT, int k0, int n0, bool mapped, LAS float* scr, int lane, int koff = 0) {
    const int nn = lane & 31; const int sc = mapped ? inmap(n0 + nn) : (n0 + nn);
    float v[32];
#pragma unroll
    for (int i = 0; i < 32; ++i) { const int kk = 2 * i + (lane >> 5); v[i] = (sc >= 0) ? W[(size_t)(k0 + kk) * Nsrc + sc] : 0.f; }
#pragma unroll
    for (int i = 0; i < 32; ++i) { const int kk = 2 * i + (lane >> 5); scr[kk * 33 + nn] = v[i]; }
    LDS_WAIT();
    const int c = lane & 7;
#pragma unroll
    for (int j = 0; j < 4; ++j) { const int n = (lane >> 3) + 8 * j; const LAS float* s = scr + (8 * c) * 33 + n;
        v4u o; o.x = pk2(s[0 * 33], s[1 * 33]); o.y = pk2(s[2 * 33], s[3 * 33]); o.z = pk2(s[4 * 33], s[5 * 33]); o.w = pk2(s[6 * 33], s[7 * 33]);
        *(v4u*)(WT + (size_t)(n0 + n) * ldw + koff + k0 + 8 * c) = o; }
    LDS_WAIT();
}
constexpr int IT_IN = 32 * (NU / 32), IT_CO = 8 * 64, IT_SO = 12 * 64, IT_FO = 8 * 64, IT_RO = 8 * 64, IT_O = 32 * 64, IT_UP = 32 * 256, IT_DN = 128 * 64;
constexpr int IT_LAYER = IT_IN + IT_CO + IT_SO + IT_FO + IT_RO + IT_O + IT_UP + IT_DN;

__device__ __forceinline__ void p0_prologue(KArgs a, LAS unsigned char* lds, int bid, int G, const int wave0) {
    PH_IDS
    unsigned char* ws = a->ws;
    {
        LAS float* sc = (LAS float*)lds;
        LAS float* part = (LAS float*)(lds + 40960);
        for (int i = tid; i < 5 * DM; i += NTHR) { const float v = (i < 4 * DM) ? a->in[I_C][i] : a->in[I_CCTX][i - 4 * DM]; sc[i] = siluf_(v); }
        __syncthreads();
        float* MODV = (float*)(ws + OFF_MODV);
        for (int it = bid; it < DEPTH * 192; it += G) {
            const int l = it / 192, j = (it % 192) * 64 + lane;
            const float* wp = a->in[I_MODW] + (size_t)l * DM * 12288 + (size_t)(wave * 256) * 12288 + j;
            float acc[5] = {0.f, 0.f, 0.f, 0.f, 0.f};
#pragma unroll 1
            for (int k0 = 0; k0 < 256; k0 += 32) { float w[32];
#pragma unroll
                for (int k = 0; k < 32; ++k) w[k] = wp[(size_t)(k0 + k) * 12288];
#pragma unroll
                for (int k = 0; k < 32; ++k)
#pragma unroll
                    for (int r = 0; r < 5; ++r) acc[r] += sc[r * DM + wave * 256 + k0 + k] * w[k]; }
#pragma unroll
            for (int r = 0; r < 5; ++r) part[(wave * 5 + r) * 64 + lane] = acc[r];
            __syncthreads();
            if (tid < 320) { const int r = tid >> 6, jj = tid & 63; float s = 0.f;
#pragma unroll
                for (int w = 0; w < 8; ++w) s += part[(w * 5 + r) * 64 + jj];
                const int jo = (it % 192) * 64 + jj; MODV[((size_t)l * 5 + r) * 12288 + jo] = s + a->in[I_MODB][l * 12288 + jo]; }
            __syncthreads();
        }
    }
    {
        LAS float* wt = (LAS float*)lds;
        LAS float* ctab = (LAS float*)(lds + 32768);
        LAS float* scr = (LAS float*)(lds + 32768 + 512 + wave * 8448);
        __syncthreads();
        if (tid < 128) ctab[tid] = cospif((float)tid * (1.f / 64.f));
        for (int it = bid; it < DEPTH * 32 * 4; it += G) {
            const int l = it / 128, kb = (it % 128) / 4, g = it % 4, k0 = kb * 64;
            __syncthreads();
            for (int i = tid; i < 64 * 32; i += NTHR) { const int kk = i >> 5, c4 = i & 31;
                *(LAS f32x4*)(wt + kk * 128 + c4 * 4) = *(const f32x4*)(a->in[I_WIN] + ((size_t)l * DM + k0 + kk) * IN_DIM + S_FFT + g * 128 + c4 * 4); }
            __syncthreads();
            const int half = wave >> 2, cp = (wave & 3) * 32 + (lane & 31), n0 = half * 512 + g * 128 + (wave & 3) * 32;
#pragma unroll 1
            for (int i = 0; i < 32; ++i) { const int kk = 2 * i + (lane >> 5); float s = 0.f;
#pragma unroll 8
                for (int c = 0; c < 128; ++c) s += wt[kk * 128 + c] * ctab[(c * cp - 32 * half) & 127];
                scr[kk * 33 + (lane & 31)] = s; }
            LDS_WAIT();
            bf16* WT = (bf16*)(ws + OFF_W + (size_t)l * W_LAYER + WO_FFT);
            const int c = lane & 7;
#pragma unroll
            for (int j = 0; j < 4; ++j) { const int n = (lane >> 3) + 8 * j; const LAS float* s = scr + (8 * c) * 33 + n;
                v4u o; o.x = pk2(s[0 * 33], s[1 * 33]); o.y = pk2(s[2 * 33], s[3 * 33]); o.z = pk2(s[4 * 33], s[5 * 33]); o.w = pk2(s[6 * 33], s[7 * 33]);
                *(v4u*)(WT + (size_t)(n0 + n) * DM + k0 + 8 * c) = o; }
            LDS_WAIT();
        }
        __syncthreads();
    }
    const int gw = bid * NWAVES + wave, NGW = G * NWAVES;
    {
        LAS float* scr = (LAS float*)(lds + wave * 8448);
        for (int it = gw; it < DEPTH * IT_LAYER; it += NGW) {
            const int l = it / IT_LAYER; int r = it % IT_LAYER; unsigned char* wl = ws + OFF_W + (size_t)l * W_LAYER;
            if (r < IT_IN) { const int kb = r / (NU / 32), nb = r % (NU / 32); transpose_item(a->in[I_WIN] + (size_t)l * DM * IN_DIM, DM, IN_DIM, (bf16*)(wl + WO_IN), kb * 64, nb * 32, true, scr, lane); continue; } r -= IT_IN;
            if (r < IT_CO) { transpose_item(a->in[I_CONVOUT] + (size_t)l * 512 * DM, ACW, DM, (bf16*)(wl + WO_CAT), (r / 64) * 64, (r % 64) * 32, false, scr, lane, AC_CONV); continue; } r -= IT_CO;
            if (r < IT_SO) { transpose_item(a->in[I_SOUT] + (size_t)l * 768 * DM, ACW, DM, (bf16*)(wl + WO_CAT), (r / 64) * 64, (r % 64) * 32, false, scr, lane, AC_SSD); continue; } r -= IT_SO;
            if (r < IT_FO) { transpose_item(a->in[I_FOUT] + (size_t)l * 512 * DM, ACW, DM, (bf16*)(wl + WO_CAT), (r / 64) * 64, (r % 64) * 32, false, scr, lane, AC_FFT); continue; } r -= IT_FO;
            if (r < IT_RO) { transpose_item(a->in[I_ROUT] + (size_t)l * 512 * DM, ACW, DM, (bf16*)(wl + WO_CAT), (r / 64) * 64, (r % 64) * 32, false, scr, lane, AC_RWKV); continue; } r -= IT_RO;
            if (r < IT_O) { transpose_item(a->in[I_WO] + (size_t)l * DM * DM, DM, DM, (bf16*)(wl + WO_O), (r / 64) * 64, (r % 64) * 32, false, scr, lane); continue; } r -= IT_O;
            if (r < IT_UP) { transpose_item(a->in[I_UP] + (size_t)l * DM * DFF, DM, DFF, (bf16*)(wl + WO_UP), (r / 256) * 64, (r % 256) * 32, false, scr, lane); continue; } r -= IT_UP;
            transpose_item(a->in[I_DOWN] + (size_t)l * DFF * DM, DFF, DM, (bf16*)(wl + WO_DN), (r / 64) * 64, (r % 64) * 32, false, scr, lane);
        }
    }
    {
        const int gt = bid * NTHR + tid, NGT = G * NTHR;
        bf16* FL = (bf16*)(ws + OFF_DFTL); bf16* FC = (bf16*)(ws + OFF_DFTC);
        { bf16* WLT = (bf16*)(ws + OFF_WLT);
          for (int i = gt; i < DEPTH * 512 * 320; i += NGT) { const int l = i / (512 * 320), c = (i / 320) % 512, j = i % 320; float v;
              if (j < 64) v = a->in[I_RW2][((size_t)(l * 2 + 0) * 64 + j) * 512 + c]; else if (j < 128) v = a->in[I_RW2][((size_t)(l * 2 + 1) * 64 + (j - 64)) * 512 + c];
              else if (j < 192) v = a->in[I_RA2][((size_t)l * 64 + (j - 128)) * 512 + c]; else v = a->in[I_RG2][((size_t)l * 128 + (j - 192)) * 512 + c];
              WLT[i] = (bf16)f2bf(v); } }
        for (int i = gt; i < 2048 * 512; i += NGT) { const int lp = i >> 9, k8 = (i & 511) * 8; unsigned o[4];
#pragma unroll
            for (int e = 0; e < 4; ++e) { float v[2];
#pragma unroll
                for (int q = 0; q < 2; ++q) { const int k = k8 + 2 * e + q; const int m = (lp * (k & 2047)) & 2047; float sn, cs; sincospif((float)m * (1.f / 1024.f), &sn, &cs); v[q] = (k < 2048 ? cs : -sn) * (1.f / 512.f); }
                o[e] = pk2(v[0], v[1]); }
            *(v4u*)(FL + (size_t)lp * 4096 + k8) = (v4u){o[0], o[1], o[2], o[3]}; }
        for (int i = gt; i < 256 * 64; i += NGT) { const int lp = i >> 6, k8 = (i & 63) * 8; unsigned o[4];
#pragma unroll
            for (int e = 0; e < 4; ++e) { float v[2];
#pragma unroll
                for (int q = 0; q < 2; ++q) { const int k = k8 + 2 * e + q; const int m = (lp * (k & 255)) & 255; float sn, cs; sincospif((float)m * (1.f / 128.f), &sn, &cs); v[q] = (k < 256 ? cs : -sn) * 0.005524271728f; }
                o[e] = pk2(v[0], v[1]); }
            *(v4u*)(FC + (size_t)lp * 512 + k8) = (v4u){o[0], o[1], o[2], o[3]}; }
        f32x4* X4 = (f32x4*)(ws + OFF_X); const f32x4* x4 = (const f32x4*)a->in[I_X]; const f32x4* c4 = (const f32x4*)a->in[I_CTX];
        for (int i = gt; i < TT * (DM / 4); i += NGT) X4[i] = (i < TLAT * (DM / 4)) ? x4[i] : c4[i - TLAT * (DM / 4)];
    }
}

__device__ __forceinline__ void norm_phase(KArgs a, int mode, const float* gY, const float* gH, const float* modY  , const float* modH  ,
                                           int bid, int G, const int wave0, int nrows, bool split = false  ) {
    PH_IDS
    unsigned char* ws = a->ws; const int gw = bid * NWAVES + wave, NGW = G * NWAVES;
    float* X = (float*)(ws + OFF_X); const float* Y = (const float*)(ws + OFF_Y); bf16* H = (bf16*)(ws + OFF_H);
    for (int row = gw; row < nrows; row += NGW) {
        const int mr = row < TLAT ? (row >> 11) : 4;
        f32x4 x[8];
        const f32x4* xr = (const f32x4*)(X + (size_t)row * DM) + lane;
#pragma unroll
        for (int j = 0; j < 8; ++j) x[j] = xr[64 * j];
        if (mode != 0) {
            const f32x4* yr = (const f32x4*)(Y + (size_t)row * DM) + lane; f32x4 y[8]; float ss = 0.f;
            if (split && row >= TLAT) { const f32x4* yc = (const f32x4*)((const float*)(ws + OFF_YC) + (size_t)(row - TLAT) * DM) + lane;
#pragma unroll
                for (int j = 0; j < 8; ++j) { f32x4 t = yc[64 * j];
#pragma unroll
                    for (int sl = 1; sl < 8; ++sl) t += yc[(size_t)sl * 1024 * 512 + 64 * j];
                    y[j] = t; } }
            else {
#pragma unroll
                for (int j = 0; j < 8; ++j) y[j] = yr[64 * j]; }
#pragma unroll
            for (int j = 0; j < 8; ++j) { ss += (y[j].x * y[j].x + y[j].y * y[j].y) + (y[j].z * y[j].z + y[j].w * y[j].w); }
            const float r = rsqrtf(wave_sum(ss) * (1.f / DM) + 1e-6f);
            const f32x4* gp = (const f32x4*)gY + lane; const f32x4* gt = (const f32x4*)(modY + (size_t)mr * 12288) + lane;
#pragma unroll
            for (int j = 0; j < 8; ++j) x[j] += gt[64 * j] * (y[j] * r * gp[64 * j]);
            if (mode == 1) { f32x4* xw = (f32x4*)(X + (size_t)row * DM) + lane;
#pragma unroll
                for (int j = 0; j < 8; ++j) xw[64 * j] = x[j]; }
            else { f32x4* ow = (f32x4*)(a->out + (size_t)row * DM) + lane;
#pragma unroll
                for (int j = 0; j < 8; ++j) ow[64 * j] = x[j]; }
        }
        if (mode != 2) {
            float ss = 0.f;
#pragma unroll
            for (int j = 0; j < 8; ++j) ss += (x[j].x * x[j].x + x[j].y * x[j].y) + (x[j].z * x[j].z + x[j].w * x[j].w);
            const float r = rsqrtf(wave_sum(ss) * (1.f / DM) + 1e-6f);
            const f32x4* gp = (const f32x4*)gH + lane; const f32x4* sh = (const f32x4*)(modH + (size_t)mr * 12288) + lane; const f32x4* sc = sh + 512;
            v2u* hw = (v2u*)(H + (size_t)row * DM) + lane;
#pragma unroll
            for (int j = 0; j < 8; ++j) { const f32x4 h = (x[j] * r * gp[64 * j]) * (sc[64 * j] + 1.f) + sh[64 * j]; hw[64 * j] = (v2u){pk2(h.x, h.y), pk2(h.z, h.w)}; }
        }
    }
}
#define XB_TMO      128
#define XB_XCNT(j)  (256  + 64 * (j))
#define XB_XSUB(j)  (1280 + 64 * (j))
#define XB_XGEN(j)  (2304 + 64 * (j))
#define XB_TOP      3328
#define XB_TOPGEN   3392
#define XCD_BAR_WORDS 3456
#define XB_SPIN_CAP (1u << 18)

__device__ __forceinline__ unsigned xb_ld(unsigned* p)              { return __hip_atomic_load(p, __ATOMIC_RELAXED, __HIP_MEMORY_SCOPE_AGENT); }
__device__ __forceinline__ unsigned xb_add(unsigned* p, unsigned v) { return __hip_atomic_fetch_add(p, v, __ATOMIC_RELAXED, __HIP_MEMORY_SCOPE_AGENT); }
__device__ __forceinline__ unsigned xb_xcc_id() { return (unsigned)__builtin_amdgcn_s_getreg((3 << 11) | 20) & 0xFu; }
#define XB_SPIN(cond, bar) do { unsigned _sp = 0; while (cond) { __builtin_amdgcn_s_sleep(1); \
    if ((++_sp & 255u) == 0u) { if (xb_ld(&(bar)[XB_TMO])) break; if (_sp > XB_SPIN_CAP) { atomicAdd(&(bar)[XB_TMO], 1u); break; } } } } while (0)

struct XcdBarrier {
    unsigned* bar; unsigned x; int wv;
    volatile LAS unsigned* st;
};

__device__ __forceinline__ bool xb_t0(int wv) { unsigned z_ = 0u; asm volatile("" : "+v"(z_)); return wv == 0 && __builtin_amdgcn_mbcnt_hi(~0u, __builtin_amdgcn_mbcnt_lo(~0u, z_)) == 0u; }
__device__ __forceinline__ XcdBarrier xcd_barrier_post(unsigned* bar, volatile LAS unsigned* st, int wv) {
    XcdBarrier b; b.bar = bar; b.x = xb_xcc_id(); b.st = st; b.wv = wv;
    if (xb_t0(wv)) (void)xb_add(&bar[XB_XCNT(b.x)], 1u);
    return b;
}
__device__ __forceinline__ void xcd_barrier_complete(unsigned* bar, unsigned x, unsigned& nloc, unsigned& nx) {
    const unsigned G = gridDim.x * gridDim.y * gridDim.z;
    unsigned sum, cnt, mine, sp = 0u;
    for (;;) {
        sum = 0u; cnt = 0u; mine = 0u;
#pragma unroll
        for (unsigned j = 0; j < 16; ++j) { const unsigned c = xb_ld(&bar[XB_XCNT(j)]); sum += c; cnt += (c > 0u) ? 1u : 0u; mine = (j == x) ? c : mine; }
        if (sum == G) break;
        __builtin_amdgcn_s_sleep(1);
        if ((++sp & 255u) == 0u) { if (xb_ld(&bar[XB_TMO])) break; if (sp > XB_SPIN_CAP) { atomicAdd(&bar[XB_TMO], 1u); break; } }
    }
    nloc = mine > 0u ? mine : 1u; nx = cnt > 0u ? cnt : 1u;
}

__device__ __forceinline__ void xcd_barrier(const XcdBarrier& b) {
    asm volatile("s_waitcnt vmcnt(0)" ::: "memory");
    __syncthreads();
    if (xb_t0(b.wv)) {
        unsigned* bar = b.bar;
        __builtin_amdgcn_s_waitcnt(0);
        unsigned nloc = b.st[0], nx = b.st[1];
        if (nloc == 0u) { xcd_barrier_complete(bar, b.x, nloc, nx); b.st[0] = nloc; b.st[1] = nx; }
        const unsigned old = xb_add(&bar[XB_XSUB(b.x)], 1u);
        const unsigned gen = old / nloc;
        if (old + 1u == (gen + 1u) * nloc) {
            __builtin_amdgcn_fence(__ATOMIC_RELEASE, "agent");
            asm volatile("s_waitcnt vmcnt(0)" ::: "memory");
            const unsigned og = xb_add(&bar[XB_TOP], 1u);
            const unsigned tg = og / nx;
            if (og + 1u == (tg + 1u) * nx) xb_add(&bar[XB_TOPGEN], 1u);
            else XB_SPIN(xb_ld(&bar[XB_TOPGEN]) == tg, bar);
            __builtin_amdgcn_fence(__ATOMIC_ACQUIRE, "agent");
            xb_add(&bar[XB_XGEN(b.x)], 1u);
            asm volatile("s_waitcnt vmcnt(0)" ::: "memory");
        } else {
            XB_SPIN(xb_ld(&bar[XB_XGEN(b.x)]) == gen, bar);
            __builtin_amdgcn_fence(__ATOMIC_ACQUIRE, "agent");
            asm volatile("s_waitcnt vmcnt(0)" ::: "memory");
        }
    }
    __syncthreads();
}

constexpr int RCH_NT = 0, RCH_RT = 2048, RCH_KST = 4096, RCH_TT = 4608, RCH_ART = 5120, RCH_KRT = 5632, RCH_VM = 6144, RCH_APT = 8192, RCH_KPT = 10240, RCH_GC = 12288, RCH_BYTES = 12544;

typedef short bf16x8 __attribute__((ext_vector_type(8)));
constexpr int RP_PITCH = 516, ACT_PITCH = 328;
__device__ __forceinline__ void rwkv_prep_item(KArgs a, int l, int item, LAS unsigned char* lds, int tid, int lane, int wave) {
    unsigned char* ws = a->ws;
    const bf16* U = (const bf16*)(ws + OFF_U); const float* MISC = (const float*)(ws + OFF_MISC);
    const int b = item / 144, j0 = (item % 144) * 16; const bool isctx = j0 < LCTX;
    LAS float* RP = (LAS float*)lds;
    LAS float* KP = RP + 16 * RP_PITCH; LAS float* VP = KP + 16 * RP_PITCH;
    LAS bf16* ACT = (LAS bf16*)(lds + 3 * 16 * RP_PITCH * 4);
    const float* mu = a->in[I_RMU] + l * 1856;
    for (int idx = tid; idx < 16 * 192; idx += NTHR) { const int i = idx / 192, c8 = idx % 192, jj = j0 + i;
        const bool hp = isctx ? (jj - 1 >= 0) : (jj - 1 >= LCTX), hn = isctx ? (jj + 1 < LCTX) : (jj + 1 < RJ);
        const v4u c = *(const v4u*)(U + (size_t)rwkv_tok(b, jj) * NU + URKV + c8 * 8);
        v4u p = (v4u){0u, 0u, 0u, 0u}, n = p;
        if (hp) p = *(const v4u*)(U + (size_t)rwkv_tok(b, jj - 1) * NU + URKV + c8 * 8);
        if (hn) n = *(const v4u*)(U + (size_t)rwkv_tok(b, jj + 1) * NU + URKV + c8 * 8);
        const f32x4 m0 = *(const f32x4*)(mu + c8 * 8), m1 = *(const f32x4*)(mu + c8 * 8 + 4);
        f32x4 x0 = (f32x4){bflo(c.x), bfhi(c.x), bflo(c.y), bfhi(c.y)}, x1 = (f32x4){bflo(c.z), bfhi(c.z), bflo(c.w), bfhi(c.w)};
        const f32x4 s0 = (f32x4){bflo(p.x) + bflo(n.x), bfhi(p.x) + bfhi(n.x), bflo(p.y) + bflo(n.y), bfhi(p.y) + bfhi(n.y)}, s1 = (f32x4){bflo(p.z) + bflo(n.z), bfhi(p.z) + bfhi(n.z), bflo(p.w) + bflo(n.w), bfhi(p.w) + bfhi(n.w)};
        x0 = x0 + (0.5f * s0 - x0) * m0; x1 = x1 + (0.5f * s1 - x1) * m1;
        const int ch = c8 * 8, reg = ch >> 9; LAS float* dst = (reg == 0 ? RP : (reg == 1 ? KP : VP)) + i * RP_PITCH + (ch & 511);
        *(LAS f32x4*)dst = x0; *(LAS f32x4*)(dst + 4) = x1; }
    for (int idx = tid; idx < 16 * 80; idx += NTHR) { const int i = idx / 80, c4 = idx % 80, jj = j0 + i;
        const bool hp = isctx ? (jj - 1 >= 0) : (jj - 1 >= LCTX), hn = isctx ? (jj + 1 < LCTX) : (jj + 1 < RJ);
        f32x4 x = *(const f32x4*)(MISC + (size_t)rwkv_tok(b, jj) * 512 + 64 + c4 * 4); f32x4 p = (f32x4){0.f, 0.f, 0.f, 0.f}, n = p;
        if (hp) p = *(const f32x4*)(MISC + (size_t)rwkv_tok(b, jj - 1) * 512 + 64 + c4 * 4);
        if (hn) n = *(const f32x4*)(MISC + (size_t)rwkv_tok(b, jj + 1) * 512 + 64 + c4 * 4);
        x = x + (0.5f * (p + n) - x) * *(const f32x4*)(mu + 1536 + c4 * 4);
        const int m = c4 * 4;
        if (m < 128) x = (f32x4){tanhf(x.x), tanhf(x.y), tanhf(x.z), tanhf(x.w)}; else if (m >= 192) x = (f32x4){sigmoidf_(x.x), sigmoidf_(x.y), sigmoidf_(x.z), sigmoidf_(x.w)};
        *(LAS v2u*)(ACT + i * ACT_PITCH + m) = (v2u){pk2(x.x, x.y), pk2(x.z, x.w)}; }
    __syncthreads();
    const int fr = lane & 15, fq = lane >> 4, h = wave;
    f32x4 acc[4][4];
#pragma unroll
    for (int o = 0; o < 4; ++o)
#pragma unroll
        for (int nt = 0; nt < 4; ++nt) acc[o][nt] = (f32x4){0.f, 0.f, 0.f, 0.f};
    {
        const bf16* WLT = (const bf16*)(ws + OFF_WLT) + (size_t)l * 512 * 320 + (size_t)(64 * wave + fr) * 320 + fq * 8;
#pragma unroll
        for (int ks = 0; ks < 10; ++ks) { const int o = ks < 2 ? 0 : (ks < 4 ? 1 : (ks < 6 ? 2 : 3));
            const bf16x8 af = *(const LAS bf16x8*)(ACT + fr * ACT_PITCH + ks * 32 + fq * 8);
#pragma unroll
            for (int nt = 0; nt < 4; ++nt) { const bf16x8 bf = *(const bf16x8*)(WLT + (size_t)nt * 16 * 320 + ks * 32);
                acc[o][nt] = __builtin_amdgcn_mfma_f32_16x16x32_bf16(af, bf, acc[o][nt], 0, 0, 0); } }
    }
    float* RW = (float*)(ws + OFF_RW); constexpr size_t AS = RW_ARR / 4; float* RSC = (float*)(ws + OFF_RSC);
    float w0f[4], w0b[4], a0c[4], kkc[4], kac[4], rkc[4];
#pragma unroll
    for (int nt = 0; nt < 4; ++nt) { const int c = 64 * wave + 16 * nt + fr; w0f[nt] = a->in[I_RW0][(l * 2 + 0) * 512 + c]; w0b[nt] = a->in[I_RW0][(l * 2 + 1) * 512 + c]; a0c[nt] = a->in[I_RA0][l * 512 + c];
        kkc[nt] = a->in[I_RKK][l * 512 + c]; kac[nt] = a->in[I_RKA][l * 512 + c]; rkc[nt] = a->in[I_RRK][l * 512 + c]; }
    float Wd[2][4][4], Rr[4][4], Km[4][4], Nn[4][4], Ka[4][4], Vv[4][4];
#pragma unroll
    for (int i = 0; i < 4; ++i) { const int tok = 4 * fq + i; const size_t R = (size_t)b * RJ + j0 + tok;
        float k[4], av[4], kkv[4]; float ss = 0.f;
#pragma unroll
        for (int nt = 0; nt < 4; ++nt) { const int c = 64 * wave + 16 * nt + fr; Rr[i][nt] = RP[tok * RP_PITCH + c]; k[nt] = KP[tok * RP_PITCH + c]; Vv[i][nt] = VP[tok * RP_PITCH + c];
            av[nt] = sigmoidf_(a0c[nt] + acc[2][nt][i]); kkv[nt] = k[nt] * kkc[nt]; ss += kkv[nt] * kkv[nt]; }
        const float rn = rsqrtf(row16_sum(ss) + 1e-12f);
        float bon = 0.f;
#pragma unroll
        for (int nt = 0; nt < 4; ++nt) { const int c = 64 * wave + 16 * nt + fr;
            Wd[0][i][nt] = __expf(-__expf(-softplusf_(-(w0f[nt] + acc[0][nt][i])) - 0.5f)); Wd[1][i][nt] = __expf(-__expf(-softplusf_(-(w0b[nt] + acc[1][nt][i])) - 0.5f));
            const float kk = kkv[nt] * rn; Km[i][nt] = k[nt] * (1.f + (av[nt] - 1.f) * kac[nt]); Ka[i][nt] = kk * av[nt]; Nn[i][nt] = -kk;
            bon += Rr[i][nt] * Km[i][nt] * rkc[nt];
            float* o = RW + R * 512 + c; o[7 * AS] = Vv[i][nt]; o[8 * AS] = acc[3][nt][i]; }
        bon = row16_sum(bon);
        if (fr == 0) RSC[(size_t)2 * TT * 8 + R * 8 + h] = bon;
    }
    __syncthreads();
    LAS unsigned char* wl_ = lds + wave * 14336;
    LAS bf16* NTl = (LAS bf16*)wl_; LAS bf16* RTl = NTl + 16 * 68; LAS bf16* ATl = RTl + 16 * 68; LAS bf16* KTl = ATl + 16 * 68;
    LAS float* ASl = (LAS float*)(wl_ + 8704);
    LAS float* TTl = (LAS float*)(wl_ + 11264);
    typedef short bf16x4 __attribute__((ext_vector_type(4)));
#pragma unroll
    for (int d = 0; d < 2; ++d) {
        const int cidx = d ? (isctx ? (240 - j0) / 16 : (2544 - j0) / 16) : j0 / 16;
        unsigned char* img = ws + OFF_RCH + ((size_t)((b * 2 + d) * 8 + h) * 144 + cidx) * RCH_BYTES;
        const int laneD = d ? ((3 - fq) * 16 + fr) : lane;
#pragma unroll
        for (int nt = 0; nt < 4; ++nt) {
            float gam[4], gpv[4], G, E;
            if (d == 0) { gam[0] = Wd[0][0][nt]; gam[1] = gam[0] * Wd[0][1][nt]; gam[2] = gam[1] * Wd[0][2][nt]; gam[3] = gam[2] * Wd[0][3][nt]; G = gam[3];
                const float g1 = __int_as_float(__builtin_amdgcn_ds_bpermute((lane - 16) << 2, __float_as_int(G))), g2 = __int_as_float(__builtin_amdgcn_ds_bpermute((lane - 32) << 2, __float_as_int(G))), g3 = __int_as_float(__builtin_amdgcn_ds_bpermute((lane - 48) << 2, __float_as_int(G)));
                E = (fq >= 1 ? g1 : 1.f) * (fq >= 2 ? g2 : 1.f) * (fq >= 3 ? g3 : 1.f);
                gpv[0] = E; gpv[1] = E * gam[0]; gpv[2] = E * gam[1]; gpv[3] = E * gam[2];
#pragma unroll
                for (int i = 0; i < 4; ++i) gam[i] *= E; }
            else { gam[3] = Wd[1][3][nt]; gam[2] = gam[3] * Wd[1][2][nt]; gam[1] = gam[2] * Wd[1][1][nt]; gam[0] = gam[1] * Wd[1][0][nt]; G = gam[0];
                const float g1 = __int_as_float(__builtin_amdgcn_ds_bpermute((lane + 16) << 2, __float_as_int(G))), g2 = __int_as_float(__builtin_amdgcn_ds_bpermute((lane + 32) << 2, __float_as_int(G))), g3 = __int_as_float(__builtin_amdgcn_ds_bpermute((lane + 48) << 2, __float_as_int(G)));
                E = (fq <= 2 ? g1 : 1.f) * (fq <= 1 ? g2 : 1.f) * (fq <= 0 ? g3 : 1.f);
                gpv[3] = E; gpv[2] = E * gam[3]; gpv[1] = E * gam[2]; gpv[0] = E * gam[1];
#pragma unroll
                for (int i = 0; i < 4; ++i) gam[i] *= E; }
            float tot = G * __int_as_float(__builtin_amdgcn_ds_bpermute((lane ^ 16) << 2, __float_as_int(G)));
            tot = tot * __int_as_float(__builtin_amdgcn_ds_bpermute((lane ^ 32) << 2, __float_as_int(tot)));
            float ap[4], kp[4];
#pragma unroll
            for (int i = 0; i < 4; ++i) { const int td = d ? 15 - (4 * fq + i) : 4 * fq + i; const float ig = 1.f / gam[i];
                const float at_ = Ka[i][nt] * ig, kt_ = Km[i][nt] * ig; ap[i] = at_ * tot; kp[i] = kt_ * tot;
                NTl[td * 68 + 16 * nt + fr] = (bf16)f2bf(gpv[i] * Nn[i][nt]); RTl[td * 68 + 16 * nt + fr] = (bf16)f2bf(gam[i] * Rr[i][nt]);
                ATl[td * 68 + 16 * nt + fr] = (bf16)f2bf(at_); KTl[td * 68 + 16 * nt + fr] = (bf16)f2bf(kt_); }
            v2u pa, pk, pv;
            if (d == 0) { pa = (v2u){pk2(ap[0], ap[1]), pk2(ap[2], ap[3])}; pk = (v2u){pk2(kp[0], kp[1]), pk2(kp[2], kp[3])}; pv = (v2u){pk2(Vv[0][nt], Vv[1][nt]), pk2(Vv[2][nt], Vv[3][nt])}; }
            else { pa = (v2u){pk2(ap[3], ap[2]), pk2(ap[1], ap[0])}; pk = (v2u){pk2(kp[3], kp[2]), pk2(kp[1], kp[0])}; pv = (v2u){pk2(Vv[3][nt], Vv[2][nt]), pk2(Vv[1][nt], Vv[0][nt])}; }
            *(v2u*)(img + RCH_APT + nt * 512 + laneD * 8) = pa; *(v2u*)(img + RCH_KPT + nt * 512 + laneD * 8) = pk; *(v2u*)(img + RCH_VM + nt * 512 + laneD * 8) = pv;
            if (fq == 0) *(float*)(img + RCH_GC + (16 * nt + fr) * 4) = tot;
        }
        LDS_WAIT();
#pragma unroll
        for (int kt = 0; kt < 4; ++kt) { *(v2u*)(img + RCH_NT + kt * 512 + lane * 8) = *(const LAS v2u*)(NTl + fr * 68 + 16 * kt + 4 * fq); *(v2u*)(img + RCH_RT + kt * 512 + lane * 8) = *(const LAS v2u*)(RTl + fr * 68 + 16 * kt + 4 * fq); }
        f32x4 cAs = (f32x4){0.f, 0.f, 0.f, 0.f}, cKs = cAs, cAr = cAs, cKr = cAs;
#pragma unroll
        for (int sk = 0; sk < 4; ++sk) { const bf16x4 aA = *(const LAS bf16x4*)(ATl + fr * 68 + 16 * sk + 4 * fq), aK = *(const LAS bf16x4*)(KTl + fr * 68 + 16 * sk + 4 * fq);
            const bf16x4 bN = *(const LAS bf16x4*)(NTl + fr * 68 + 16 * sk + 4 * fq), bR = *(const LAS bf16x4*)(RTl + fr * 68 + 16 * sk + 4 * fq);
            cAs = __builtin_amdgcn_mfma_f32_16x16x16bf16_1k(aA, bN, cAs, 0, 0, 0); cKs = __builtin_amdgcn_mfma_f32_16x16x16bf16_1k(aK, bN, cKs, 0, 0, 0);
            cAr = __builtin_amdgcn_mfma_f32_16x16x16bf16_1k(aA, bR, cAr, 0, 0, 0); cKr = __builtin_amdgcn_mfma_f32_16x16x16bf16_1k(aK, bR, cKr, 0, 0, 0); }
#pragma unroll
        for (int j = 0; j < 4; ++j) { const int ii = 4 * fq + j; if (!(ii < fr)) { cAs[j] = 0.f; cKs[j] = 0.f; } if (!(ii <= fr)) { cAr[j] = 0.f; cKr[j] = 0.f; } }
        *(v2u*)(img + RCH_KST + lane * 8) = (v2u){pk2(cKs[0], cKs[1]), pk2(cKs[2], cKs[3])}; *(v2u*)(img + RCH_ART + lane * 8) = (v2u){pk2(cAr[0], cAr[1]), pk2(cAr[2], cAr[3])};
        *(v2u*)(img + RCH_KRT + lane * 8) = (v2u){pk2(cKr[0], cKr[1]), pk2(cKr[2], cKr[3])};
        *(LAS f32x4*)(ASl + (d * 16 + fr) * 20 + 4 * fq) = cAs;
        LDS_WAIT();
    }
    if (lane < 32) { const int d = lane >> 4, irow = lane & 15; float Tc[16];
#pragma unroll
        for (int t = 0; t < 16; ++t) { float x = (irow == t) ? 1.f : 0.f;
#pragma unroll
            for (int j4 = 0; j4 < (t + 3) / 4; ++j4) { const f32x4 av = *(const LAS f32x4*)(ASl + (d * 16 + t) * 20 + 4 * j4);
#pragma unroll
                for (int e = 0; e < 4; ++e) if (4 * j4 + e < t) x += Tc[4 * j4 + e] * av[e]; }
            Tc[t] = x; TTl[(d * 16 + t) * 20 + irow] = x; } }
    LDS_WAIT();
#pragma unroll
    for (int d = 0; d < 2; ++d) { const int cidx = d ? (isctx ? (240 - j0) / 16 : (2544 - j0) / 16) : j0 / 16;
        unsigned char* img = ws + OFF_RCH + ((size_t)((b * 2 + d) * 8 + h) * 144 + cidx) * RCH_BYTES;
        const f32x4 tv = *(const LAS f32x4*)(TTl + (d * 16 + fr) * 20 + 4 * fq);
        *(v2u*)(img + RCH_TT + lane * 8) = (v2u){pk2(tv[0], tv[1]), pk2(tv[2], tv[3])}; }
    __syncthreads();
}
__device__ __forceinline__ void ssd_prep_item(KArgs a, int l, int item, int tid) {
    unsigned char* ws = a->ws; const bf16* U = (const bf16*)(ws + OFF_U); const float* MISC = (const float*)(ws + OFF_MISC);
    bf16* XBC = (bf16*)(ws + OFF_XBC); float* DTA = (float*)(ws + OFF_DTA);
    const int t0 = item * 16;
    const int seq_lo = t0 < TLAT ? (t0 & ~(LSEQ - 1)) : TLAT + ((t0 - TLAT) & ~(LCTX - 1)), seq_hi = seq_lo + (t0 < TLAT ? LSEQ : LCTX);
    for (int cp = tid; cp < 896; cp += NTHR) {
        float w0[5], w1[5];
#pragma unroll
        for (int j = 0; j < 5; ++j) { const f32x2 w = *(const f32x2*)(a->in[I_SCW] + (size_t)(l * 5 + j) * 1792 + 2 * cp); w0[j] = w.x; w1[j] = w.y; }
        const f32x2 bb = *(const f32x2*)(a->in[I_SCB] + l * 1792 + 2 * cp);
        float i0[20], i1[20];
#pragma unroll
        for (int r = 0; r < 20; ++r) { const int row = t0 - 2 + r; unsigned u = 0u; if (row >= seq_lo && row < seq_hi) u = *(const unsigned*)(U + (size_t)row * NU + UXBC + 2 * cp); i0[r] = bflo(u); i1[r] = bfhi(u); }
#pragma unroll
        for (int o = 0; o < 16; ++o) { float s0 = bb.x, s1 = bb.y;
#pragma unroll
            for (int j = 0; j < 5; ++j) { s0 += w0[j] * i0[o + j]; s1 += w1[j] * i1[o + j]; }
            *(unsigned*)(XBC + (size_t)(t0 + o) * 1792 + 2 * cp) = pk2(siluf_(s0), siluf_(s1)); }
    }
    if (tid < 16 * 24) { const int o = tid / 24, q = tid % 24;
        const float dt = softplusf_(MISC[(size_t)(t0 + o) * 512 + q] + a->in[I_SDTB][l * 24 + q]); const float A = -__expf(a->in[I_SALOG][l * 24 + q]);
        DTA[(size_t)(t0 + o) * 48 + q] = dt; DTA[(size_t)(t0 + o) * 48 + 24 + q] = dt * A; }
}
__device__ __forceinline__ void conv_item(KArgs a, int l, int item, LAS unsigned char* lds, int tid, int lane, int wave) {
    unsigned char* ws = a->ws; const bf16* U = (const bf16*)(ws + OFF_U); bf16* AC = (bf16*)(ws + OFF_ACAT) + AC_CONV;
    int t0, seg_lo, seg_hi;
    if (item < 256) { t0 = item * 32; seg_lo = t0 & ~63; seg_hi = seg_lo + 64; }
    else { const int ci = item - 256; t0 = TLAT + ci * 32; seg_lo = TLAT + (ci >> 3) * LCTX; seg_hi = seg_lo + LCTX; }
    LAS bf16* inimg = (LAS bf16*)lds;
    LAS float* outimg = (LAS float*)(lds + 63488);
    for (int idx = tid; idx < 62 * 64; idx += NTHR) { const int rr = idx >> 6, c8 = idx & 63, row = t0 - 15 + rr;
        v4u o = (v4u){0u, 0u, 0u, 0u};
        if (row >= seg_lo && row < seg_hi) { const v4u va = *(const v4u*)(U + (size_t)row * NU + UCONV + c8 * 8), vg = *(const v4u*)(U + (size_t)row * NU + UCONV + 512 + c8 * 8);
            o.x = pk2(bflo(va.x) * sigmoidf_(bflo(vg.x)), bfhi(va.x) * sigmoidf_(bfhi(vg.x))); o.y = pk2(bflo(va.y) * sigmoidf_(bflo(vg.y)), bfhi(va.y) * sigmoidf_(bfhi(vg.y)));
            o.z = pk2(bflo(va.z) * sigmoidf_(bflo(vg.z)), bfhi(va.z) * sigmoidf_(bfhi(vg.z))); o.w = pk2(bflo(va.w) * sigmoidf_(bflo(vg.w)), bfhi(va.w) * sigmoidf_(bfhi(vg.w))); }
        *(LAS v4u*)(inimg + rr * 512 + c8 * 8) = o; }
    __syncthreads();
    {
        const int c = tid; float w[31];
#pragma unroll
        for (int j = 0; j < 31; ++j) w[j] = a->in[I_CONVW][(size_t)(l * 31 + j) * 512 + c];
        const float bias = a->in[I_CONVB][l * 512 + c];
#pragma unroll 2
        for (int o = 0; o < 32; ++o) { float s = bias;
#pragma unroll
            for (int j = 0; j < 31; ++j) s += w[j] * bf2f(inimg[(o + j) * 512 + c]);
            outimg[o * 512 + c] = s; }
    }
    __syncthreads();
    {
        const f32x4 g0 = *(const f32x4*)(a->in[I_CLNG] + l * 512 + 8 * lane), g1 = *(const f32x4*)(a->in[I_CLNG] + l * 512 + 8 * lane + 4);
        const f32x4 b0 = *(const f32x4*)(a->in[I_CLNB] + l * 512 + 8 * lane), b1 = *(const f32x4*)(a->in[I_CLNB] + l * 512 + 8 * lane + 4);
#pragma unroll
        for (int q = 0; q < 4; ++q) { const int o = wave * 4 + q;
            f32x4 x0 = *(const LAS f32x4*)(outimg + o * 512 + 8 * lane), x1 = *(const LAS f32x4*)(outimg + o * 512 + 8 * lane + 4);
            const float mean = wave_sum((x0.x + x0.y + x0.z + x0.w) + (x1.x + x1.y + x1.z + x1.w)) * (1.f / 512.f);
            x0 = x0 - mean; x1 = x1 - mean;
            const float var = wave_sum((x0.x * x0.x + x0.y * x0.y + x0.z * x0.z + x0.w * x0.w) + (x1.x * x1.x + x1.y * x1.y + x1.z * x1.z + x1.w * x1.w)) * (1.f / 512.f);
            const float rs = rsqrtf(var + 1e-5f);
            x0 = x0 * rs * g0 + b0; x1 = x1 * rs * g1 + b1;
            v4u ov; ov.x = pk2(siluf_(x0.x), siluf_(x0.y)); ov.y = pk2(siluf_(x0.z), siluf_(x0.w)); ov.z = pk2(siluf_(x1.x), siluf_(x1.y)); ov.w = pk2(siluf_(x1.z), siluf_(x1.w));
            *(v4u*)(AC + (size_t)(t0 + o) * ACW + 8 * lane) = ov; }
    }
    __syncthreads();
}

__device__ __forceinline__ int ssd_tok(int b, int dir, int pos) {
    if (pos < LCTX) return TLAT + b * LCTX + (dir ? (LCTX - 1 - pos) : pos);
    const int q = pos - LCTX; return b * LSEQ + (dir ? (LSEQ - 1 - q) : q);
}
__device__ __forceinline__ void post_phase(KArgs a, int l, int bid, int G, const int wave0) {
    PH_IDS
    unsigned char* ws = a->ws; const int gw = bid * NWAVES + wave, NGW = G * NWAVES;
    const bf16* U = (const bf16*)(ws + OFF_U); const bf16* XBC = (const bf16*)(ws + OFF_XBC);
    const float* Y0 = (const float*)(ws + OFF_YSSD); const float* Y1 = Y0 + (size_t)TT * 768; bf16* AS_ = (bf16*)(ws + OFF_ACAT) + AC_SSD;
    for (int row = gw; row < TT; row += NGW) {
        f32x4 y[3]; float ss = 0.f;
#pragma unroll
        for (int j = 0; j < 3; ++j) { const int col = 4 * lane + 256 * j; const float dsk = a->in[I_SD][l * 12 + (col >> 6)];
            const f32x4 yf = *(const f32x4*)(Y0 + (size_t)row * 768 + col), yb = *(const f32x4*)(Y1 + (size_t)row * 768 + col);
            const v2u xs = *(const v2u*)(XBC + (size_t)row * 1792 + col), z = *(const v2u*)(U + (size_t)row * NU + UZ + col);
            f32x4 v = yf + yb + dsk * (f32x4){bflo(xs.x), bfhi(xs.x), bflo(xs.y), bfhi(xs.y)};
            v = v * (f32x4){siluf_(bflo(z.x)), siluf_(bfhi(z.x)), siluf_(bflo(z.y)), siluf_(bfhi(z.y))};
            y[j] = v; ss += (v.x * v.x + v.y * v.y) + (v.z * v.z + v.w * v.w); }
        const float r = rsqrtf(wave_sum(ss) * (1.f / 768.f) + 1e-6f);
#pragma unroll
        for (int j = 0; j < 3; ++j) { const int col = 4 * lane + 256 * j; const f32x4 g = *(const f32x4*)(a->in[I_SNG] + l * 768 + col); const f32x4 o = y[j] * r * g;
            *(v2u*)(AS_ + (size_t)row * ACW + col) = (v2u){pk2(o.x, o.y), pk2(o.z, o.w)}; }
    }
    const float* RW = (const float*)(ws + OFF_RW); constexpr size_t AS = RW_ARR / 4; const float* RSC = (const float*)(ws + OFF_RSC);
    const float* R0 = (const float*)(ws + OFF_YRW); const float* R1 = R0 + (size_t)TT * 512; bf16* AR = (bf16*)(ws + OFF_ACAT) + AC_RWKV;
    for (int row = gw; row < TT; row += NGW) {
        size_t R;
        if (row < TLAT) { const int b = row >> 11, t = row & 2047, rr = t >> 6, cc = t & 63; R = (size_t)b * RJ + LCTX + cc * 32 + rr; }
        else { const int b = (row - TLAT) >> 8, jj = (row - TLAT) & 255; R = (size_t)b * RJ + jj; }
        const int c0 = 8 * lane, h = lane >> 3;
        f32x4 ya = *(const f32x4*)(R0 + R * 512 + c0) + *(const f32x4*)(R1 + R * 512 + c0), yb = *(const f32x4*)(R0 + R * 512 + c0 + 4) + *(const f32x4*)(R1 + R * 512 + c0 + 4);
        float s = (ya.x + ya.y + ya.z + ya.w) + (yb.x + yb.y + yb.z + yb.w);
        s = sum8(s);
        const float mean = s * (1.f / 64.f); ya = ya - mean; yb = yb - mean;
        float q = (ya.x * ya.x + ya.y * ya.y + ya.z * ya.z + ya.w * ya.w) + (yb.x * yb.x + yb.y * yb.y + yb.z * yb.z + yb.w * yb.w);
        q = sum8(q);
        const float rs = rsqrtf(q * (1.f / 64.f) + 64e-5f);
        const f32x4 lg0 = *(const f32x4*)(a->in[I_RLNG] + l * 512 + c0), lg1 = *(const f32x4*)(a->in[I_RLNG] + l * 512 + c0 + 4), lb0 = *(const f32x4*)(a->in[I_RLNB] + l * 512 + c0), lb1 = *(const f32x4*)(a->in[I_RLNB] + l * 512 + c0 + 4);
        const float bon = RSC[(size_t)2 * TT * 8 + R * 8 + h];
        const f32x4 v0 = *(const f32x4*)(RW + 7 * AS + R * 512 + c0), v1 = *(const f32x4*)(RW + 7 * AS + R * 512 + c0 + 4), g0 = *(const f32x4*)(RW + 8 * AS + R * 512 + c0), g1 = *(const f32x4*)(RW + 8 * AS + R * 512 + c0 + 4);
        const f32x4 o0 = (ya * rs * lg0 + lb0 + bon * v0) * g0, o1 = (yb * rs * lg1 + lb1 + bon * v1) * g1;
        *(v4u*)(AR + (size_t)row * ACW + c0) = (v4u){pk2(o0.x, o0.y), pk2(o0.z, o0.w), pk2(o1.x, o1.y), pk2(o1.z, o1.w)};
    }
}

__device__ __forceinline__ size_t rwkv_row(int b, int dir, int pos) { const int j = dir ? (pos < LCTX ? (LCTX - 1 - pos) : (RJ + LCTX - 1 - pos)) : pos; return (size_t)b * RJ + j; }
struct RchOps { v2u nt[4], rt[4], kst, tt, art, krt, vm, apt[4], kpt[4]; f32x4 gc[4]; };
__device__ __forceinline__ void rwkv_scan_chunk(KArgs a, int idx, int lane, int wave) {
    if (wave >= 4) return;
    typedef short bf16x4 __attribute__((ext_vector_type(4)));
    unsigned char* ws = a->ws;
    const int b = idx >> 4, dir = (idx >> 3) & 1, h = idx & 7, fr = lane & 15, fq = lane >> 4;
    float* Yo = (float*)(ws + OFF_YRW) + (size_t)dir * TT * 512;
    const unsigned char* base = ws + OFF_RCH + (size_t)((b * 2 + dir) * 8 + h) * 144 * RCH_BYTES;
    auto ld = [&](int c) { RchOps o; const unsigned char* p = base + (size_t)c * RCH_BYTES + lane * 8;
#pragma unroll
        for (int kt = 0; kt < 4; ++kt) { o.nt[kt] = *(const v2u*)(p + RCH_NT + kt * 512); o.rt[kt] = *(const v2u*)(p + RCH_RT + kt * 512); o.apt[kt] = *(const v2u*)(p + RCH_APT + kt * 512); o.kpt[kt] = *(const v2u*)(p + RCH_KPT + kt * 512);
            o.gc[kt] = *(const f32x4*)(base + (size_t)c * RCH_BYTES + RCH_GC + (16 * kt + 4 * fq) * 4); }
        o.kst = *(const v2u*)(p + RCH_KST); o.tt = *(const v2u*)(p + RCH_TT); o.art = *(const v2u*)(p + RCH_ART); o.krt = *(const v2u*)(p + RCH_KRT); o.vm = *(const v2u*)(p + RCH_VM + wave * 512); return o; };
#define MF16(A_, B_, C_) __builtin_amdgcn_mfma_f32_16x16x16bf16_1k(__builtin_bit_cast(bf16x4, A_), __builtin_bit_cast(bf16x4, B_), C_, 0, 0, 0)
    f32x4 S[4];
#pragma unroll
    for (int kt = 0; kt < 4; ++kt) S[kt] = (f32x4){0.f, 0.f, 0.f, 0.f};
    RchOps cur = ld(0), nx1 = ld(1);
    for (int c = 0; c < 144; ++c) {
        RchOps nx2 = nx1; if (c + 2 < 144) nx2 = ld(c + 2);
        v2u Sb[4];
#pragma unroll
        for (int kt = 0; kt < 4; ++kt) Sb[kt] = (v2u){pk2(S[kt][0], S[kt][1]), pk2(S[kt][2], S[kt][3])};
        f32x4 rhs = (f32x4){0.f, 0.f, 0.f, 0.f}, y = rhs;
#pragma unroll
        for (int kt = 0; kt < 4; ++kt) rhs = MF16(cur.nt[kt], Sb[kt], rhs);
        rhs = MF16(cur.kst, cur.vm, rhs);
        const v2u rb = (v2u){pk2(rhs[0], rhs[1]), pk2(rhs[2], rhs[3])};
        const f32x4 u = MF16(cur.tt, rb, ((f32x4){0.f, 0.f, 0.f, 0.f}));
        const v2u ub = (v2u){pk2(u[0], u[1]), pk2(u[2], u[3])};
#pragma unroll
        for (int kt = 0; kt < 4; ++kt) { S[kt] = S[kt] * cur.gc[kt]; S[kt] = MF16(cur.apt[kt], ub, S[kt]); S[kt] = MF16(cur.kpt[kt], cur.vm, S[kt]); }
#pragma unroll
        for (int kt = 0; kt < 4; ++kt) y = MF16(cur.rt[kt], Sb[kt], y);
        y = MF16(cur.art, ub, y); y = MF16(cur.krt, cur.vm, y);
#pragma unroll
        for (int j = 0; j < 4; ++j) { const size_t R = rwkv_row(b, dir, c * 16 + 4 * fq + j); Yo[R * 512 + h * 64 + 16 * wave + fr] = y[j]; }
        cur = nx1; nx1 = nx2;
    }
#undef MF16
}

constexpr int SS_CM = 0, SS_BM = 17408, SS_BST = 34816, SS_XT = 53248, SS_MX = 62464, SS_HB = 71680, SS_CS = 89088, SS_DT = 89344;
__device__ __forceinline__ float bfe(const v4u& v, int i) { const unsigned u = (i < 2) ? v.x : (i < 4) ? v.y : (i < 6) ? v.z : v.w; return (i & 1) ? bfhi(u) : bflo(u); }
__device__ __forceinline__ unsigned short bfraw(const v4u& v, int i) { const unsigned u = (i < 2) ? v.x : (i < 4) ? v.y : (i < 6) ? v.z : v.w; return (unsigned short)((i & 1) ? (u >> 16) : (u & 0xffffu)); }
__device__ __forceinline__ void ssd_scan_fast(KArgs a, int idx, LAS unsigned char* lds, int tid, int lane, int wave) {
    unsigned char* ws = a->ws; const bf16* XBC = (const bf16*)(ws + OFF_XBC); const float* DTA = (const float*)(ws + OFF_DTA);
    const int b = idx / 24, dir = (idx % 24) / 12, h = idx % 12, g = h / 3, q = dir * 12 + h;
    float* Yo = (float*)(ws + OFF_YSSD) + (size_t)dir * TT * 768;
    LAS bf16* Cm = (LAS bf16*)(lds + SS_CM); LAS bf16* Bm = (LAS bf16*)(lds + SS_BM); LAS bf16* BsT = (LAS bf16*)(lds + SS_BST); LAS bf16* XT = (LAS bf16*)(lds + SS_XT);
    LAS bf16* Mx = (LAS bf16*)(lds + SS_MX); LAS bf16* Hb = (LAS bf16*)(lds + SS_HB); LAS float* CS = (LAS float*)(lds + SS_CS); LAS float* DTV = (LAS float*)(lds + SS_DT);
    const int fr = lane & 15, fq = lane >> 4, ss = tid & 63, sc = tid >> 6, tl = wave >> 1, wh = wave & 1;
    { unsigned z = 0u; asm volatile("" : "+v"(z)); for (int i = tid; i < 17408 / 16; i += NTHR) *(LAS v4u*)(lds + SS_HB + i * 16) = (v4u){z, z, z, z}; }
    f32x4 hacc[4];
#pragma unroll
    for (int j = 0; j < 4; ++j) hacc[j] = (f32x4){0.f, 0.f, 0.f, 0.f};
    v4u pc0, pc1, pb0, pb1, px; float pdt = 0.f, pa = 0.f;
    auto issue = [&](int ch) {
        const int tok = ssd_tok(b, dir, ch * 64 + ss); const bf16* row = XBC + (size_t)tok * 1792;
        pc0 = *(const v4u*)(row + 1280 + g * 128 + sc * 8); pc1 = *(const v4u*)(row + 1280 + g * 128 + (sc + 8) * 8);
        pb0 = *(const v4u*)(row + 768 + g * 128 + sc * 8); pb1 = *(const v4u*)(row + 768 + g * 128 + (sc + 8) * 8);
        px = *(const v4u*)(row + h * 64 + sc * 8);
        if (tid < 64) { pdt = DTA[(size_t)tok * 48 + q]; pa = DTA[(size_t)tok * 48 + 24 + q]; }
    };
    issue(0);
    for (int ch = 0; ch < RJ / 64; ++ch) {
        *(LAS v4u*)(Cm + ss * 136 + sc * 8) = pc0; *(LAS v4u*)(Cm + ss * 136 + (sc + 8) * 8) = pc1;
        *(LAS v4u*)(Bm + ss * 136 + sc * 8) = pb0; *(LAS v4u*)(Bm + ss * 136 + (sc + 8) * 8) = pb1;
#pragma unroll
        for (int i = 0; i < 8; ++i) XT[(sc * 8 + i) * 72 + ss] = bfraw(px, i);
        if (tid < 64) { float x = pa;
            x += __int_as_float(__builtin_amdgcn_update_dpp(0, __float_as_int(x), 0x111, 0xf, 0xf, false)); x += __int_as_float(__builtin_amdgcn_update_dpp(0, __float_as_int(x), 0x112, 0xf, 0xf, false));
            x += __int_as_float(__builtin_amdgcn_update_dpp(0, __float_as_int(x), 0x114, 0xf, 0xf, false)); x += __int_as_float(__builtin_amdgcn_update_dpp(0, __float_as_int(x), 0x118, 0xf, 0xf, false));
            x += __int_as_float(__builtin_amdgcn_update_dpp(0, __float_as_int(x), 0x142, 0xa, 0xf, false)); x += __int_as_float(__builtin_amdgcn_update_dpp(0, __float_as_int(x), 0x143, 0xc, 0xf, false));
            CS[tid] = x; DTV[tid] = pdt; }
        __syncthreads();
        const float cl = CS[63];
        { const float scl = DTV[ss] * __expf(cl - CS[ss]);
#pragma unroll
            for (int i = 0; i < 8; ++i) { BsT[(sc * 8 + i) * 72 + ss] = (bf16)f2bf(bfe(pb0, i) * scl); BsT[((sc + 8) * 8 + i) * 72 + ss] = (bf16)f2bf(bfe(pb1, i) * scl); } }
        if (ch + 1 < RJ / 64) issue(ch + 1);
#pragma unroll
        for (int j = 0; j < 2; ++j) { const int tc = wh * 2 + j; f32x4 acc = (f32x4){0.f, 0.f, 0.f, 0.f};
            if (tc <= tl) {
#pragma unroll
                for (int ks = 0; ks < 4; ++ks) { const bf16x8 af = *(const LAS bf16x8*)(Cm + (16 * tl + fr) * 136 + ks * 32 + fq * 8), bf = *(const LAS bf16x8*)(Bm + (16 * tc + fr) * 136 + ks * 32 + fq * 8);
                    acc = __builtin_amdgcn_mfma_f32_16x16x32_bf16(af, bf, acc, 0, 0, 0); } }
            const int s = 16 * tc + fr; const float css = CS[s], dts = DTV[s];
#pragma unroll
            for (int i = 0; i < 4; ++i) { const int l = 16 * tl + 4 * fq + i; const float v = (s <= l) ? acc[i] * __expf(CS[l] - css) * dts : 0.f; Mx[l * 72 + s] = (bf16)f2bf(v); } }
        __syncthreads();
#pragma unroll
        for (int j = 0; j < 2; ++j) { const int tp = wh * 2 + j; f32x4 acc = (f32x4){0.f, 0.f, 0.f, 0.f};
#pragma unroll
            for (int ks = 0; ks < 4; ++ks) { const bf16x8 af = *(const LAS bf16x8*)(Cm + (16 * tl + fr) * 136 + ks * 32 + fq * 8), bf = *(const LAS bf16x8*)(Hb + (16 * tp + fr) * 136 + ks * 32 + fq * 8);
                acc = __builtin_amdgcn_mfma_f32_16x16x32_bf16(af, bf, acc, 0, 0, 0); }
#pragma unroll
            for (int i = 0; i < 4; ++i) acc[i] *= __expf(CS[16 * tl + 4 * fq + i]);
#pragma unroll
            for (int ks = 0; ks < 2; ++ks) { const bf16x8 af = *(const LAS bf16x8*)(Mx + (16 * tl + fr) * 72 + ks * 32 + fq * 8), bf = *(const LAS bf16x8*)(XT + (16 * tp + fr) * 72 + ks * 32 + fq * 8);
                acc = __builtin_amdgcn_mfma_f32_16x16x32_bf16(af, bf, acc, 0, 0, 0); }
#pragma unroll
            for (int i = 0; i < 4; ++i) { const int tok = ssd_tok(b, dir, ch * 64 + 16 * tl + 4 * fq + i); Yo[(size_t)tok * 768 + h * 64 + 16 * tp + fr] = acc[i]; } }
        { const float ecl = __expf(cl);
#pragma unroll
            for (int j = 0; j < 4; ++j) { const int tn = wh * 4 + j; hacc[j] = hacc[j] * ecl;
#pragma unroll
                for (int ks = 0; ks < 2; ++ks) { const bf16x8 af = *(const LAS bf16x8*)(XT + (16 * tl + fr) * 72 + ks * 32 + fq * 8), bf = *(const LAS bf16x8*)(BsT + (16 * tn + fr) * 72 + ks * 32 + fq * 8);
                    hacc[j] = __builtin_amdgcn_mfma_f32_16x16x32_bf16(af, bf, hacc[j], 0, 0, 0); } } }
        __syncthreads();
#pragma unroll
        for (int j = 0; j < 4; ++j) { const int tn = wh * 4 + j;
#pragma unroll
            for (int i = 0; i < 4; ++i) Hb[(16 * tl + 4 * fq + i) * 136 + 16 * tn + fr] = (bf16)f2bf(hacc[j][i]); }
    }
}

constexpr int NPH = 2 + 10 * DEPTH;
#ifndef PROBE_MASK
#define PROBE_MASK 0
#endif
#ifndef PROBE_P0
#define PROBE_P0 0
#endif
#ifndef PROBE_SUB
#define PROBE_SUB 0
#endif
#ifndef PROBE_REPS
#define PROBE_REPS 3
#endif
#define REPS(k) (((PROBE_MASK >> (k)) & 1) ? PROBE_REPS : 1)
constexpr int GATE_LATE = 30;
constexpr int GATE_X = 672, GATE_Z = 192;
#ifndef MK_ONE_LAUNCH
#define MK_ONE_LAUNCH 1
#endif

__global__ void __launch_bounds__(NTHR, 2) fwd(Args a_unused) {
    extern __shared__ __attribute__((aligned(16))) unsigned char lds_raw[];
    LAS unsigned char* lds = (LAS unsigned char*)lds_raw;
    const int bid0 = blockIdx.x, G0 = gridDim.x, wave0 = __builtin_amdgcn_readfirstlane(threadIdx.x >> 6);
#define PH_BG int bid = bid0, G = G0; asm volatile("" : "+s"(bid), "+s"(G));
    volatile LAS unsigned* MISCW = (volatile LAS unsigned*)(lds + MISC_OFF);
    if (threadIdx.x < 32) MISCW[threadIdx.x] = 0u;
    __syncthreads();
    const int ph_lo = kargs()->ph_lo, ph_hi = kargs()->ph_hi;
    const bool multi = (ph_hi - ph_lo) > 1;
    XcdBarrier bar; bar.bar = (unsigned*)(kargs()->ws + OFF_CTL) + CW_BAR; bar.x = 0; bar.st = nullptr; bar.wv = wave0;
    if (multi) bar = xcd_barrier_post((unsigned*)(kargs()->ws + OFF_CTL) + CW_BAR, MISCW + 8, wave0);
#define IN(k) (ph_lo <= (k) && (k) < ph_hi)
#define SEAM(k) do { if (IN(k) && IN((k) + 1)) xcd_barrier(bar); } while (0)

    for (int rep = 0; rep < (PROBE_P0 ? PROBE_REPS : 1); ++rep) {
    if (IN(0)) { PH_BG p0_prologue(kargs(), lds, bid, G, wave0); }
    if (rep + 1 < (PROBE_P0 ? PROBE_REPS : 1)) xcd_barrier(bar); }
    SEAM(0);
    if (IN(1)) { PH_BG KArgs a = kargs(); norm_phase(a, 0, nullptr, a->in[I_NORMG] + 0, nullptr, (const float*)(a->ws + OFF_MODV), bid, G, wave0, TT); }
    SEAM(1);

    for (int l = 0; l < DEPTH; ++l) {
        const int pb = 2 + 10 * l;
#define PH_LOCALS PH_BG KArgs a = kargs(); unsigned char* ws = a->ws; unsigned char* wl = ws + OFF_W + (size_t)l * W_LAYER; bf16* Hb = (bf16*)(ws + OFF_H); (void)wl; (void)Hb; \
        const float* ng = a->in[I_NORMG] + (size_t)l * 4 * DM; const float* mv = (const float*)(ws + OFF_MODV) + (size_t)l * 5 * 12288; (void)ng; (void)mv;
        const bool lastl = (l == DEPTH - 1);
        for (int rep = 0; rep < REPS(0); ++rep) {
        if (IN(pb + 0)) { PH_LOCALS
            __syncthreads();
            pg8::Sched2 S; S.A0 = (const char*)Hb; S.B0 = (const char*)(wl + WO_IN); S.A1 = (const char*)(wl + WO_FFT); S.B1 = (const char*)Hb; S.tstep = (size_t)256 * DM * 2; S.ntk = DM / 64;
            S.t0.init(TT / 256, NU / 256 - GATE_LATE); S.t1.init(4, TT / 256); S.G = G; S.c = bid;
            pg8::EpiIn2 E{pg8::EpiInproj{(bf16*)(ws + OFF_U), (float*)(ws + OFF_MISC), NU}, pg8::EpiBf{0, (bf16*)(ws + OFF_VTL), (bf16*)(ws + OFF_VTC)}};
            pg8::gemm_phase<pg8::EpiIn2, pg8::Sched2, true, true>(lds, DM, S, E, wave0);
        }
        if (rep + 1 < REPS(0)) xcd_barrier(bar); }
        SEAM(pb + 0);
        for (int rep = 0; rep < REPS(1); ++rep) {
        if (IN(pb + 1)) { PH_LOCALS PH_IDS
            __syncthreads();
            if (bid < 64) { pg8::Sched2 S; S.A0 = (const char*)(ws + OFF_DFTL); S.B0 = (const char*)(ws + OFF_VTL); S.A1 = S.A0; S.B1 = S.B0; S.tstep = (size_t)256 * 4096 * 2; S.ntk = 64; S.t0.init(8, 8); S.t1.init(0, 0); S.G = 64; S.c = bid;
                  pg8::EpiBf E{1, (bf16*)(ws + OFF_ACAT), nullptr};
                  pg8::gemm_phase<pg8::EpiBf, pg8::Sched2, true, true>(lds, 4096, S, E, wave0); }
            else if (bid < 72) { pg8::Sched2 S; S.A0 = (const char*)(ws + OFF_DFTC); S.B0 = (const char*)(ws + OFF_VTC); S.A1 = S.A0; S.B1 = S.B0; S.tstep = (size_t)256 * 512 * 2; S.ntk = 8; S.t0.init(1, 8); S.t1.init(0, 0); S.G = 8; S.c = bid - 64;
                  pg8::EpiBf E{2, (bf16*)(ws + OFF_ACAT), nullptr};
                  pg8::gemm_phase<pg8::EpiBf, pg8::Sched2, true, true>(lds, 512, S, E, wave0); }
            __syncthreads();
            {
                unsigned* qctr = (unsigned*)(ws + OFF_CTL) + CW_Q + (l * 4 + rep) * 64;
                volatile LAS unsigned* qslot = (volatile LAS unsigned*)(lds + MISC_OFF) + 16;
                for (;;) {
                    if (tid == 0) qslot[0] = __hip_atomic_fetch_add(qctr, 1u, __ATOMIC_RELAXED, __HIP_MEMORY_SCOPE_AGENT);
                    __syncthreads();
                    const int it = (int)qslot[0];
                    __syncthreads();
                    if (it >= 576 + 288 + 576) break;
                    int ln_i = lane; asm volatile("" : "+v"(ln_i)); const int tid_i = wave * 64 + ln_i;
                    if (it < 576) rwkv_prep_item(a, l, it, lds, tid_i, ln_i, wave);
                    else if (it < 576 + 288) conv_item(a, l, it - 576, lds, tid_i, ln_i, wave);
                    else ssd_prep_item(a, l, it - 576 - 288, tid_i);
                }
            }
        }
        if (rep + 1 < REPS(1)) xcd_barrier(bar); }
        SEAM(pb + 1);
        for (int rep = 0; rep < REPS(2); ++rep) {
        if (IN(pb + 2)) { PH_LOCALS PH_IDS
            __syncthreads();
            if (bid < 64) { if (rep == 0 || PROBE_SUB == 0) rwkv_scan_chunk(a, bid, lane, wave); }
            else if (bid < 160) { if (rep == 0 || PROBE_SUB == 1) ssd_scan_fast(a, bid - 64, lds, tid, lane, wave); }
            __syncthreads();
            if (rep == 0 || PROBE_SUB == 2) {
                pg8::Sched2 S; S.A0 = (const char*)Hb; S.B0 = (const char*)(wl + WO_IN); S.A1 = S.A0; S.B1 = S.B0; S.tstep = (size_t)256 * DM * 2; S.ntk = DM / 64;
                S.t0.init(TT / 256, GATE_LATE); S.t1.init(0, 0); S.pn_off0 = NU / 256 - GATE_LATE;
                if (bid >= 160) { S.G = 96; S.c = bid - 160; S.first = 0; S.limit = GATE_X; }
                else if (bid < 64) { S.G = 64; S.c = bid; S.first = GATE_X; S.limit = GATE_X + GATE_Z; }
                else { S.G = 96; S.c = bid - 64; S.first = GATE_X + GATE_Z; S.limit = 36 * GATE_LATE; }
                pg8::EpiIn2 E{pg8::EpiInproj{(bf16*)(ws + OFF_U), (float*)(ws + OFF_MISC), NU}, pg8::EpiBf{0, (bf16*)(ws + OFF_VTL), (bf16*)(ws + OFF_VTC)}};
                pg8::gemm_phase<pg8::EpiIn2, pg8::Sched2, true, true>(lds, DM, S, E, wave0); }
        }
        if (rep + 1 < REPS(2)) xcd_barrier(bar); }
        SEAM(pb + 2);
        for (int rep = 0; rep < REPS(3); ++rep) {
        if (IN(pb + 3)) { PH_BG post_phase(kargs(), l, bid, G, wave0); }
        if (rep + 1 < REPS(3)) xcd_barrier(bar); }
        SEAM(pb + 3);
        for (int rep = 0; rep < REPS(4); ++rep) {
        if (IN(pb + 4)) { PH_LOCALS
            __syncthreads();
            pg8::Sched2 S; S.A0 = (const char*)(ws + OFF_ACAT); S.B0 = (const char*)(wl + WO_CAT); S.A1 = S.A0; S.B1 = S.B0; S.tstep = (size_t)256 * ACW * 2; S.ntk = ACW / 64;
            S.t0.init(lastl ? TLAT / 256 : TT / 256, DM / 256); S.t1.init(0, 0); S.G = G; S.c = bid;
            pg8::EpiChain E{(const bf16*)(ws + OFF_U) + UGATE, NU, (bf16*)(ws + OFF_M)};
            pg8::gemm_phase<pg8::EpiChain, pg8::Sched2, true, true>(lds, ACW, S, E, wave0);
        }
        if (rep + 1 < REPS(4)) xcd_barrier(bar); }
        SEAM(pb + 4);
        for (int rep = 0; rep < REPS(5); ++rep) {
        if (IN(pb + 5)) { PH_LOCALS
            __syncthreads();
            pg8::SchedSplit S; S.A = (const char*)(ws + OFF_M); S.B = (const char*)(wl + WO_O); S.tstep = (size_t)256 * DM * 2; S.ntk = DM / 64; S.tm.init(32, 8); S.nctx = lastl ? 0 : 256; S.G = G; S.c = bid;
            pg8::EpiF32 E{(float*)(ws + OFF_Y), (float*)(ws + OFF_YC)};
            pg8::gemm_phase<pg8::EpiF32, pg8::SchedSplit, true, true>(lds, DM, S, E, wave0);
        }
        if (rep + 1 < REPS(5)) xcd_barrier(bar); }
        SEAM(pb + 5);
        if (IN(pb + 6)) { PH_LOCALS norm_phase(a, 1, ng + 1 * DM, ng + 2 * DM, mv + 2 * DM, mv + 3 * DM, bid, G, wave0, lastl ? TLAT : TT, !lastl); }
        SEAM(pb + 6);
        for (int rep = 0; rep < REPS(7); ++rep) {
        if (IN(pb + 7)) { PH_LOCALS
            __syncthreads();
            pg8::Sched2 S; S.A0 = (const char*)Hb; S.B0 = (const char*)(wl + WO_UP); S.A1 = S.A0; S.B1 = S.B0; S.tstep = (size_t)256 * DM * 2; S.ntk = DM / 64;
            S.t0.init(lastl ? TLAT / 256 : TT / 256, DFF / 256); S.t1.init(0, 0); S.G = G; S.c = bid;
            pg8::EpiBf E{3, (bf16*)(ws + OFF_HB), nullptr};
            pg8::gemm_phase<pg8::EpiBf, pg8::Sched2, true, true>(lds, DM, S, E, wave0);
        }
        if (rep + 1 < REPS(7)) xcd_barrier(bar); }
        SEAM(pb + 7);
        for (int rep = 0; rep < REPS(8); ++rep) {
        if (IN(pb + 8)) { PH_LOCALS
            __syncthreads();
            pg8::SchedSplit S; S.A = (const char*)(ws + OFF_HB); S.B = (const char*)(wl + WO_DN); S.tstep = (size_t)256 * DFF * 2; S.ntk = DFF / 64; S.tm.init(32, 8); S.nctx = lastl ? 0 : 256; S.G = G; S.c = bid;
            pg8::EpiF32 E{(float*)(ws + OFF_Y), (float*)(ws + OFF_YC)};
            pg8::gemm_phase<pg8::EpiF32, pg8::SchedSplit, true, true>(lds, DFF, S, E, wave0);
        }
        if (rep + 1 < REPS(8)) xcd_barrier(bar); }
        SEAM(pb + 8);
        if (IN(pb + 9)) { PH_LOCALS
            if (!lastl) norm_phase(a, 1, ng + 3 * DM, ng + 4 * DM  , mv + 5 * DM, mv + 5 * 12288  , bid, G, wave0, TT, true);
            else norm_phase(a, 2, ng + 3 * DM, nullptr, mv + 5 * DM, nullptr, bid, G, wave0, TLAT);
        }
        SEAM(pb + 9);
    }
#undef IN
#undef SEAM
}

extern "C" void kernel_launch(void* const* d_in, const int* in_sizes, int n_in, void* d_out, int out_size, void* d_ws, size_t ws_size, hipStream_t stream) {
    static int grid = 0;
    if (grid == 0) {
        if (n_in != N_IN || out_size != TLAT * DM || ws_size < WS_END) { fprintf(stderr, "kernel_launch: unexpected shapes (n_in %d out %d ws %zu); nothing launched\n", n_in, out_size, ws_size); grid = -1; return; }
        int dev = 0, cus = 0;
        if (hipGetDevice(&dev) != hipSuccess || hipDeviceGetAttribute(&cus, hipDeviceAttributeMultiprocessorCount, dev) != hipSuccess) { grid = -1; return; }
        if (hipFuncSetAttribute((const void*)fwd, hipFuncAttributeMaxDynamicSharedMemorySize, LDS_BYTES) != hipSuccess) { fprintf(stderr, "kernel_launch: hipFuncSetAttribute failed\n"); grid = -1; return; }
        int per_cu = 0;
        if (hipOccupancyMaxActiveBlocksPerMultiprocessor(&per_cu, (const void*)fwd, NTHR, LDS_BYTES) != hipSuccess || per_cu < 1) fprintf(stderr, "kernel_launch: occupancy query says %d\n", per_cu);
        (void)hipGetLastError();
        grid = cus;
        if (grid < 232) { fprintf(stderr, "kernel_launch: %d CUs: this kernel's scan phase needs > 160 workgroups\n", grid); grid = -1; return; }
    }
    if (grid < 0) return;
    if (hipMemsetAsync((char*)d_ws + OFF_CTL, 0, CTL_BYTES, stream) != hipSuccess) return;
    Args a{};
    for (int i = 0; i < N_IN; ++i) a.in[i] = (const float*)d_in[i];
    a.out = (float*)d_out; a.ws = (unsigned char*)d_ws;
#if MK_ONE_LAUNCH
    a.ph_lo = 0; a.ph_hi = NPH;
    hipLaunchKernelGGL(fwd, dim3(grid), dim3(NTHR), LDS_BYTES, stream, a);
#else
    for (int p = 0; p < NPH; ++p) { a.ph_lo = p; a.ph_hi = p + 1; hipLaunchKernelGGL(fwd, dim3(grid), dim3(NTHR), LDS_BYTES, stream, a); }
#endif
}
```

```cpp
#include <hip/hip_runtime.h>
#include <cstdio>
#include <cstdint>
namespace pg8 {
#define PG8_LAS __attribute__((address_space(3)))
typedef unsigned short bf16_t;
typedef short bf16x8 __attribute__((ext_vector_type(8)));
typedef float f32x4 __attribute__((ext_vector_type(4)));
typedef unsigned u32x4 __attribute__((ext_vector_type(4)));
constexpr int BM = 256, BK = 64, HALF = 128, HTB = HALF * BK * 2  , STAGE_BYTES = 8 * HTB, NXCD = 8, WGM = 8;

__host__ __device__ __forceinline__ int lds_byte(int r, int c) { const int st = (r >> 4) * 2 + (c >> 5), rr = r & 15, cc = c & 31, ob = rr * 64 + cc * 2; return st * 1024 + (ob ^ (((ob >> 9) & 1) << 5)); }
__host__ __device__ __forceinline__ void stage_rc(int b, int& R, int& C) { const int st = b / 1024, sb = b % 1024, swz = sb ^ (((sb >> 9) & 1) << 5); R = (st >> 1) * 16 + swz / 64; C = (st & 1) * 32 + (swz % 64) / 2; }
__host__ __device__ __forceinline__ int perm32(int rho) { const int n = rho >> 4, i = rho & 15; return 8 * (i >> 2) + 4 * n + (i & 3); }

struct Unit { int pm, pn, kind; };
struct Gemm { const bf16_t* A; const bf16_t* Bt; int M, N, K; };

struct StaticOrder {
    int nM, nN, nwg, G, c;
    __host__ __device__ void init(int M, int N, int G_, int c_) { nM = M / BM; nN = N / BM; nwg = nM * nN; G = G_; c = c_; }
    __host__ __device__ bool next(int i, Unit& u) const {
        const long L = (long)i * G + c; if (L >= nwg) return false;
        int wgid = (int)L; { const int q = nwg / NXCD, r = nwg % NXCD, xcd = wgid % NXCD, off = wgid / NXCD; wgid = (xcd < r ? xcd * (q + 1) : r * (q + 1) + (xcd - r) * q) + off; }
        const int nig = WGM * nN, gid = wgid / nig, fm = gid * WGM, gsz = (nM - fm) < WGM ? (nM - fm) : WGM;
        u.pm = fm + ((wgid % nig) % gsz); u.pn = (wgid % nig) / gsz; return true;
    }
    __device__ __forceinline__ void a_ready(const Unit&) const {}
    __device__ __forceinline__ void done(const Unit&) const {}
};
typedef float f32x2n __attribute__((ext_vector_type(2))); typedef __bf16 bf16x2n __attribute__((ext_vector_type(2)));
__device__ __forceinline__ unsigned cvt_pk_bf16(float lo, float hi) { const bf16x2n r = __builtin_convertvector((f32x2n){lo, hi}, bf16x2n); return __builtin_bit_cast(unsigned, r); }
typedef float f32x2 __attribute__((ext_vector_type(2)));
template <class Epi, class Sched, bool ALIGN_EPI = false, bool SP2 = false>
__device__ __forceinline__ void gemm_phase(PG8_LAS unsigned char* lds, const int ldk  , const Sched& S, const Epi& E, const int wave_id) {
    unsigned z_ = 0u; asm volatile("" : "+v"(z_)); const int lane_ = (int)__builtin_amdgcn_mbcnt_hi(~0u, __builtin_amdgcn_mbcnt_lo(~0u, z_)); int wid_ = wave_id; asm volatile("" : "+s"(wid_)); const int wid = wid_, lane = lane_, tid = wid * 64 + lane, wr = wid >> 2, wc = wid & 3, fr = lane & 15, fq = lane >> 4;
    const int K = ldk; int nt;
    unsigned voffA[2], voffB[2];
#pragma unroll
    for (int i = 0; i < 2; ++i) { int R, C; stage_rc(tid * 16 + i * 8192, R, C); const int Rb = Epi::PERM ? ((R & ~31) + perm32(R & 31)) : R;
        voffA[i] = (unsigned)(R * K + C) * 2u; voffB[i] = (unsigned)(Rb * K + C) * 2u; }
    const size_t kstep = (size_t)(BK * 2);
    const size_t hstep = (size_t)HALF * K * 2;
    const unsigned ldsw = (unsigned)wid * 1024u;
    const int aoff = lds_byte(wr * 64 + fr, fq * 8), boff = lds_byte(wc * 32 + fr, fq * 8);
#define PG8_SA(b, h) (((b) * 2 + (h)) * HTB)
#define PG8_SB(b, h) ((4 + (b) * 2 + (h)) * HTB)
#define PG8_STAGE(bufoff, gbase, voff) do { _Pragma("unroll") for (int _i = 0; _i < 2; ++_i) \
        __builtin_amdgcn_global_load_lds((const unsigned*)((const char*)(gbase) + (voff)[_i]), (PG8_LAS unsigned*)(lds + (bufoff) + ldsw + _i * 8192), 16, 0, 0); } while (0)
#define PG8_LDA(dst, b, h) do { _Pragma("unroll") for (int m = 0; m < 4; ++m) _Pragma("unroll") for (int k = 0; k < 2; ++k) dst[m][k] = *(const PG8_LAS bf16x8*)(lds + PG8_SA(b, h) + aoff + m * 2048 + k * 1024); } while (0)
#define PG8_LDB(dst, b, h) do { _Pragma("unroll") for (int n = 0; n < 2; ++n) _Pragma("unroll") for (int k = 0; k < 2; ++k) dst[n][k] = *(const PG8_LAS bf16x8*)(lds + PG8_SB(b, h) + boff + n * 2048 + k * 1024); } while (0)
#define PG8_MMA(ai, bj, At, Bt) do { __builtin_amdgcn_s_setprio(1); _Pragma("unroll") for (int m = 0; m < 4; ++m) _Pragma("unroll") for (int n = 0; n < 2; ++n) _Pragma("unroll") for (int k = 0; k < 2; ++k) \
        acc[ai][bj][m][n] = __builtin_amdgcn_mfma_f32_16x16x32_bf16(Bt[n][k], At[m][k], acc[ai][bj][m][n], 0, 0, 0); __builtin_amdgcn_s_setprio(0); } while (0)
#define PG8_WAIT_V(n) asm volatile("s_waitcnt vmcnt(" #n ")" ::: "memory")
#define PG8_WAIT_L(n) asm volatile("s_waitcnt lgkmcnt(" #n ")" ::: "memory")
#define PG8_BAR __builtin_amdgcn_s_barrier()
#define PG8_SCHED __builtin_amdgcn_sched_barrier(0)
    Unit cur, nxt; int ui = 0;
    if (!S.next(0, cur)) return;
    f32x4 acc[2][2][4][2];
#pragma unroll
    for (int a = 0; a < 2; ++a)
#pragma unroll
        for (int b = 0; b < 2; ++b)
#pragma unroll
            for (int m = 0; m < 4; ++m)
#pragma unroll
                for (int n = 0; n < 2; ++n) acc[a][b][m][n] = (f32x4){0.f, 0.f, 0.f, 0.f};
    bf16x8 At[4][2], B0[2][2], B1[2][2];
    const char* cA = S.abase(cur); const char* cB = S.bbase(cur); nt = S.nt(cur);
    S.a_ready(cur);
    if constexpr (SP2) {
        PG8_STAGE(PG8_SB(0, 0), cB, voffB); PG8_STAGE(PG8_SB(0, 1), cB + hstep, voffB); PG8_STAGE(PG8_SA(0, 0), cA, voffA); PG8_STAGE(PG8_SA(0, 1), cA + hstep, voffA);
        if (wr == 1) PG8_BAR;
        PG8_WAIT_V(2); PG8_BAR;
        PG8_STAGE(PG8_SB(1, 0), cB + kstep, voffB); PG8_STAGE(PG8_SA(1, 0), cA + kstep, voffA); PG8_STAGE(PG8_SB(1, 1), cB + hstep + kstep, voffB);
        PG8_WAIT_V(6); PG8_BAR;
    } else {
        PG8_STAGE(PG8_SB(0, 0), cB, voffB); PG8_STAGE(PG8_SA(0, 0), cA, voffA); PG8_STAGE(PG8_SB(0, 1), cB + hstep, voffB); PG8_STAGE(PG8_SA(0, 1), cA + hstep, voffA);
        if (wr == 1) PG8_BAR;
        PG8_WAIT_V(4); PG8_BAR;
        PG8_STAGE(PG8_SB(1, 0), cB + kstep, voffB); PG8_STAGE(PG8_SA(1, 0), cA + kstep, voffA); PG8_STAGE(PG8_SB(1, 1), cB + hstep + kstep, voffB);
        PG8_WAIT_V(6); PG8_BAR;
    }
    for (;;) {
        const bool has_next = S.next(ui + 1, nxt);
        const char* nA = has_next ? S.abase(nxt) : cA; const char* nB = has_next ? S.bbase(nxt) : cB;
        for (int t = 0; t < nt; t += 2) {
            const bool last = (t == nt - 2);
            const char* a1 = cA + (size_t)(t + 1) * kstep;
            const char* a2 = last ? nA : cA + (size_t)(t + 2) * kstep; const char* b2 = last ? nB : cB + (size_t)(t + 2) * kstep;
            const char* a3 = a2 + kstep; const char* b3 = b2 + kstep;
            if (last && has_next) S.a_ready(nxt);
            if constexpr (Epi::HOOK) E.khook(acc, cur, t, wr, wc, fr, fq);
            if constexpr (SP2) {
            PG8_LDB(B0, 0, 0); PG8_LDB(B1, 0, 1); PG8_SCHED; PG8_LDA(At, 0, 0); PG8_STAGE(PG8_SA(1, 1), a1 + hstep, voffA);
            PG8_WAIT_V(8); PG8_WAIT_L(0); PG8_BAR; PG8_MMA(0, 0, At, B0); PG8_MMA(0, 1, At, B1); PG8_BAR; PG8_SCHED;
            PG8_LDA(At, 0, 1); PG8_STAGE(PG8_SB(0, 0), b2, voffB); PG8_STAGE(PG8_SB(0, 1), b2 + hstep, voffB); PG8_STAGE(PG8_SA(0, 0), a2, voffA);
            PG8_WAIT_V(8); PG8_WAIT_L(0); PG8_BAR; PG8_MMA(1, 0, At, B0); PG8_MMA(1, 1, At, B1); PG8_BAR; PG8_SCHED;
            PG8_LDB(B0, 1, 0); PG8_LDB(B1, 1, 1); PG8_SCHED; PG8_LDA(At, 1, 0); PG8_STAGE(PG8_SA(0, 1), a2 + hstep, voffA);
            PG8_WAIT_V(8); PG8_WAIT_L(0); PG8_BAR; PG8_MMA(0, 0, At, B0); PG8_MMA(0, 1, At, B1); PG8_BAR; PG8_SCHED;
            PG8_LDA(At, 1, 1); PG8_STAGE(PG8_SB(1, 0), b3, voffB); PG8_STAGE(PG8_SB(1, 1), b3 + hstep, voffB); PG8_STAGE(PG8_SA(1, 0), a3, voffA);
            PG8_WAIT_V(8); PG8_WAIT_L(0); PG8_BAR; PG8_MMA(1, 0, At, B0); PG8_MMA(1, 1, At, B1); PG8_BAR; PG8_SCHED;
            } else {
            PG8_LDB(B0, 0, 0); PG8_SCHED; PG8_LDA(At, 0, 0); PG8_STAGE(PG8_SA(1, 1), a1 + hstep, voffA);
            PG8_WAIT_L(8); PG8_BAR; PG8_WAIT_L(0); PG8_MMA(0, 0, At, B0); PG8_BAR; PG8_SCHED;
            PG8_LDB(B1, 0, 1); PG8_STAGE(PG8_SB(0, 0), b2, voffB);
            PG8_BAR; PG8_WAIT_L(0); PG8_MMA(0, 1, At, B1); PG8_BAR;
            PG8_LDA(At, 0, 1); PG8_STAGE(PG8_SA(0, 0), a2, voffA);
            PG8_BAR; PG8_WAIT_L(0); PG8_MMA(1, 0, At, B0); PG8_BAR; PG8_SCHED;
            PG8_STAGE(PG8_SB(0, 1), b2 + hstep, voffB);
            PG8_WAIT_V(6); PG8_BAR; PG8_MMA(1, 1, At, B1); PG8_BAR;
            PG8_LDB(B0, 1, 0); PG8_SCHED; PG8_LDA(At, 1, 0); PG8_STAGE(PG8_SA(0, 1), a2 + hstep, voffA);
            PG8_WAIT_L(8); PG8_BAR; PG8_WAIT_L(0); PG8_MMA(0, 0, At, B0); PG8_BAR; PG8_SCHED;
            PG8_LDB(B1, 1, 1); PG8_STAGE(PG8_SB(1, 0), b3, voffB);
            PG8_BAR; PG8_WAIT_L(0); PG8_MMA(0, 1, At, B1); PG8_BAR;
            PG8_LDA(At, 1, 1); PG8_STAGE(PG8_SA(1, 0), a3, voffA);
            PG8_BAR; PG8_WAIT_L(0); PG8_MMA(1, 0, At, B0); PG8_BAR; PG8_SCHED;
            PG8_STAGE(PG8_SB(1, 1), b3 + hstep, voffB);
            PG8_WAIT_V(6); PG8_BAR; PG8_MMA(1, 1, At, B1); PG8_BAR;
            }
        }
        if constexpr (ALIGN_EPI) { if (wr == 0) PG8_BAR; }
        if constexpr (!Epi::AFTER_DRAIN) { E(acc, cur, wr, wc, fr, fq); S.done(cur); }
        if (!has_next) break;
#pragma unroll
        for (int a = 0; a < 2; ++a)
#pragma unroll
            for (int b = 0; b < 2; ++b)
#pragma unroll
                for (int m = 0; m < 4; ++m)
#pragma unroll
                    for (int n = 0; n < 2; ++n) acc[a][b][m][n] = (f32x4){0.f, 0.f, 0.f, 0.f};
        cur = nxt; cA = nA; cB = nB; ++ui; nt = S.nt(cur);
        if constexpr (ALIGN_EPI) { if (wr == 1) PG8_BAR; }
    }
    PG8_WAIT_V(0);
    if constexpr (!ALIGN_EPI) { if (wr == 0) PG8_BAR; }
    PG8_BAR;
    if constexpr (Epi::AFTER_DRAIN) { E.fused(acc, cur, wr, wc, fr, fq, lds, wid, lane); S.done(cur); }
#undef PG8_SA
#undef PG8_SB
#undef PG8_STAGE
#undef PG8_LDA
#undef PG8_LDB
#undef PG8_MMA
#undef PG8_WAIT_V
#undef PG8_WAIT_L
#undef PG8_BAR
#undef PG8_SCHED
}
}

namespace pg8 {
__device__ __forceinline__ float sigm(float x) { return __builtin_amdgcn_rcpf(1.f + __expf(-x)); }
__device__ __forceinline__ f32x4 sigm4(f32x4 v) { return (f32x4){sigm(v[0]), sigm(v[1]), sigm(v[2]), sigm(v[3])}; }
__device__ __forceinline__ u32x4 pack8(f32x4 v0, f32x4 v1) { u32x4 w; w.x = cvt_pk_bf16(v0[0], v0[1]); w.y = cvt_pk_bf16(v0[2], v0[3]); w.z = cvt_pk_bf16(v1[0], v1[1]); w.w = cvt_pk_bf16(v1[2], v1[3]); return w; }
__device__ __forceinline__ float bflo(unsigned u) { return __uint_as_float(u << 16); }
__device__ __forceinline__ float bfhi(unsigned u) { return __uint_as_float(u & 0xffff0000u); }


struct TileMap {
    int nM, nN, nwg;
    __device__ __forceinline__ void init(int nM_, int nN_) { nM = nM_; nN = nN_; nwg = nM_ * nN_; }
    __device__ __forceinline__ void map(int L, int& pm, int& pn) const {
        int wgid = L; { const int q = nwg / NXCD, r = nwg % NXCD, xcd = wgid % NXCD, off = wgid / NXCD; wgid = (xcd < r ? xcd * (q + 1) : r * (q + 1) + (xcd - r) * q) + off; }
        const int nig = WGM * nN, gid = wgid / nig, fm = gid * WGM, gsz = (nM - fm) < WGM ? (nM - fm) : WGM;
        pm = fm + ((wgid % nig) % gsz); pn = (wgid % nig) / gsz;
    }
};
struct Sched2 {
    const char *A0, *B0, *A1, *B1; size_t tstep; int ntk; TileMap t0, t1; int G, c;
    int pn_off0 = 0, first = 0, limit = 0x7fffffff;
    __device__ __forceinline__ bool next(int i, Unit& u) const { const int L = first + i * G + c;
        if (L >= limit) return false;
        if (L < t0.nwg) { t0.map(L, u.pm, u.pn); u.pn += pn_off0; u.kind = 0; return true; }
        if (L - t0.nwg < t1.nwg) { t1.map(L - t0.nwg, u.pm, u.pn); u.kind = 1; return true; }
        return false; }
    __device__ __forceinline__ const char* abase(const Unit& u) const { return (u.kind ? A1 : A0) + (size_t)u.pm * tstep; }
    __device__ __forceinline__ const char* bbase(const Unit& u) const { return (u.kind ? B1 : B0) + (size_t)u.pn * tstep; }
    __device__ __forceinline__ int nt(const Unit&) const { return ntk; }
    __device__ __forceinline__ void a_ready(const Unit&) const {}
    __device__ __forceinline__ void done(const Unit&) const {}
};
struct SchedSplit {
    const char *A, *B; size_t tstep; int ntk; TileMap tm; int nctx, G, c;
    __device__ __forceinline__ bool next(int i, Unit& u) const { const int L = i * G + c;
        if (L < 256) { tm.map(L, u.pm, u.pn); u.kind = 0; return true; }
        const int e = L - 256; if (e < nctx) { const int tile = e & 31; u.pm = 32 + (tile >> 3); u.pn = tile & 7; u.kind = 1 + (e >> 5); return true; }
        return false; }
    __device__ __forceinline__ const char* abase(const Unit& u) const { return A + (size_t)u.pm * tstep + (u.kind ? (size_t)(u.kind - 1) * (ntk / 8) * 128 : 0); }
    __device__ __forceinline__ const char* bbase(const Unit& u) const { return B + (size_t)u.pn * tstep + (u.kind ? (size_t)(u.kind - 1) * (ntk / 8) * 128 : 0); }
    __device__ __forceinline__ int nt(const Unit& u) const { return u.kind ? ntk / 8 : ntk; }
    __device__ __forceinline__ void a_ready(const Unit&) const {}
    __device__ __forceinline__ void done(const Unit&) const {}
};
struct EpiInproj {
    static constexpr bool PERM = true, AFTER_DRAIN = false, HOOK = false;
    bf16_t* U; float* MISC; int ldu;
    __device__ __forceinline__ void operator()(const f32x4 (&acc)[2][2][4][2], const Unit& u, int wr, int wc, int fr, int fq) const {
        const int row0 = u.pm * BM + wr * 64 + fr, cl = wc * 32 + 8 * fq;
        if (u.pn == 16 || u.pn == 17) {
#pragma unroll
            for (int ai = 0; ai < 2; ++ai)
#pragma unroll
                for (int m = 0; m < 4; ++m) { float* rowp = MISC + (size_t)(row0 + ai * HALF + m * 16) * 512 + (u.pn - 16) * BM + cl;
#pragma unroll
                    for (int bj = 0; bj < 2; ++bj) { *(f32x4*)(rowp + bj * HALF) = acc[ai][bj][m][0]; *(f32x4*)(rowp + bj * HALF + 4) = acc[ai][bj][m][1]; } }
        } else {
            const bool sg = u.pn >= 22;
#pragma unroll
            for (int ai = 0; ai < 2; ++ai)
#pragma unroll
                for (int m = 0; m < 4; ++m) { bf16_t* rowp = U + (size_t)(row0 + ai * HALF + m * 16) * ldu + u.pn * BM + cl;
#pragma unroll
                    for (int bj = 0; bj < 2; ++bj) { f32x4 v0 = acc[ai][bj][m][0], v1 = acc[ai][bj][m][1];
                        if (sg) { v0 = sigm4(v0); v1 = sigm4(v1); }
                        *(u32x4*)(rowp + bj * HALF) = pack8(v0, v1); } }
        }
    }
};
struct EpiBf {
    static constexpr bool PERM = true, AFTER_DRAIN = false, HOOK = false;
    int kind; bf16_t* O0; bf16_t* O1;
    __device__ __forceinline__ void operator()(const f32x4 (&acc)[2][2][4][2], const Unit& u, int wr, int wc, int fr, int fq) const {
        bf16_t* base; size_t pitch;
        if (kind == 0) {
            const int half = u.pm >> 1, chb = (u.pm & 1) * 256;
            if (u.pn < 32) { const int b = u.pn >> 3, l0 = (u.pn & 7) * 256; pitch = 4096; base = O0 + ((size_t)(b * 512 + chb) * 2 + half) * 2048 + l0; }
            else { const int b = u.pn - 32; pitch = 512; base = O1 + ((size_t)(b * 512 + chb) * 2 + half) * 256; }
        } else if (kind == 1) { const int b = u.pn >> 1; pitch = 2304; base = O0 + (size_t)(b * 2048 + u.pm * 256) * 2304 + 1280 + (u.pn & 1) * 256; }
        else if (kind == 2) { const int b = u.pn >> 1; pitch = 2304; base = O0 + (size_t)(8192 + b * 256) * 2304 + 1280 + (u.pn & 1) * 256; }
        else { pitch = 8192; base = O0 + (size_t)(u.pm * 256) * 8192 + u.pn * 256; }
        const int r0 = wr * 64 + fr, cl = wc * 32 + 8 * fq;
#pragma unroll
        for (int ai = 0; ai < 2; ++ai)
#pragma unroll
            for (int m = 0; m < 4; ++m) { bf16_t* rowp = base + (size_t)(r0 + ai * HALF + m * 16) * pitch + cl;
#pragma unroll
                for (int bj = 0; bj < 2; ++bj) { f32x4 v0 = acc[ai][bj][m][0], v1 = acc[ai][bj][m][1];
                    if (kind == 3) { v0 = __builtin_elementwise_max(v0, (f32x4){0.f, 0.f, 0.f, 0.f}); v1 = __builtin_elementwise_max(v1, (f32x4){0.f, 0.f, 0.f, 0.f}); v0 = v0 * v0; v1 = v1 * v1; }
                    *(u32x4*)(rowp + bj * HALF) = pack8(v0, v1); } }
    }
};
struct EpiChain {
    static constexpr bool PERM = true, AFTER_DRAIN = false, HOOK = true;
    const bf16_t* G; int ldg; bf16_t* Mo;
    __device__ __forceinline__ void khook(f32x4 (&acc)[2][2][4][2], const Unit& u, int t, int wr, int wc, int fr, int fq) const {
        if (t != 8 && t != 20 && t != 28) return;
        const int i = (t == 8) ? 0 : (t == 20 ? 1 : 2);
        int row0 = u.pm * BM + wr * 64 + fr; const int col0 = u.pn * BM + wc * 32 + 8 * fq + i * 2048;
        asm volatile("" : "+v"(row0));
#pragma unroll
        for (int ai = 0; ai < 2; ++ai)
#pragma unroll
            for (int m = 0; m < 4; ++m) { const bf16_t* gp = G + (size_t)(row0 + ai * HALF + m * 16) * ldg + col0;
#pragma unroll
                for (int bj = 0; bj < 2; ++bj) { const u32x4 g = *(const u32x4*)(gp + bj * HALF), h = *(const u32x4*)(gp + bj * HALF + 2048);
                    const unsigned gw[4] = {g.x, g.y, g.z, g.w}, hw[4] = {h.x, h.y, h.z, h.w};
#pragma unroll
                    for (int e2 = 0; e2 < 4; ++e2) { const float r0 = fmaxf(bflo(gw[e2]), 1e-6f) * __builtin_amdgcn_rcpf(fmaxf(bflo(hw[e2]), 1e-6f)), r1 = fmaxf(bfhi(gw[e2]), 1e-6f) * __builtin_amdgcn_rcpf(fmaxf(bfhi(hw[e2]), 1e-6f));
                        acc[ai][bj][m][e2 >> 1][(e2 & 1) * 2] *= r0; acc[ai][bj][m][e2 >> 1][(e2 & 1) * 2 + 1] *= r1; } }
                asm volatile("" ::: "memory"); }
    }
    __device__ __forceinline__ void operator()(const f32x4 (&acc)[2][2][4][2], const Unit& u, int wr, int wc, int fr, int fq) const {
        const int row0 = u.pm * BM + wr * 64 + fr, col0 = u.pn * BM + wc * 32 + 8 * fq;
#pragma unroll
        for (int ai = 0; ai < 2; ++ai)
#pragma unroll
            for (int m = 0; m < 4; ++m) { const size_t row = (size_t)(row0 + ai * HALF + m * 16);
#pragma unroll
                for (int bj = 0; bj < 2; ++bj) { const int col = col0 + bj * HALF;
                    const u32x4 g = *(const u32x4*)(G + row * ldg + col + 3 * 2048);
                    const f32x4 v0 = acc[ai][bj][m][0] * (f32x4){fmaxf(bflo(g.x), 1e-6f), fmaxf(bfhi(g.x), 1e-6f), fmaxf(bflo(g.y), 1e-6f), fmaxf(bfhi(g.y), 1e-6f)};
                    const f32x4 v1 = acc[ai][bj][m][1] * (f32x4){fmaxf(bflo(g.z), 1e-6f), fmaxf(bfhi(g.z), 1e-6f), fmaxf(bflo(g.w), 1e-6f), fmaxf(bfhi(g.w), 1e-6f)};
                    *(u32x4*)(Mo + row * 2048 + col) = pack8(v0, v1); } }
    }
};
struct EpiF32 {
    static constexpr bool PERM = true, AFTER_DRAIN = false, HOOK = false;
    bf16_t* C; float* YC;
    __device__ __forceinline__ void operator()(const f32x4 (&acc)[2][2][4][2], const Unit& u, int wr, int wc, int fr, int fq) const {
        const int row0 = u.pm * BM + wr * 64 + fr, col0 = u.pn * BM + wc * 32 + 8 * fq;
        if (u.kind == 0) {
#pragma unroll
            for (int ai = 0; ai < 2; ++ai)
#pragma unroll
                for (int m = 0; m < 4; ++m) { bf16_t* rowp = C + (size_t)(row0 + ai * HALF + m * 16) * 2048 + col0;
#pragma unroll
                    for (int bj = 0; bj < 2; ++bj) *(u32x4*)(rowp + bj * HALF) = pack8(acc[ai][bj][m][0], acc[ai][bj][m][1]); }
        } else {
            float* base = YC + (size_t)(u.kind - 1) * 1024 * 2048 + (size_t)(row0 - 8192) * 2048 + col0;
#pragma unroll
            for (int ai = 0; ai < 2; ++ai)
#pragma unroll
                for (int m = 0; m < 4; ++m) { float* rowp = base + (size_t)(ai * HALF + m * 16) * 2048;
#pragma unroll
                    for (int bj = 0; bj < 2; ++bj) { *(f32x4*)(rowp + bj * HALF) = acc[ai][bj][m][0]; *(f32x4*)(rowp + bj * HALF + 4) = acc[ai][bj][m][1]; } }
        }
    }
};
struct EpiIn2 {
    static constexpr bool PERM = true, AFTER_DRAIN = false, HOOK = false;
    EpiInproj e0; EpiBf e1;
    __device__ __forceinline__ void operator()(const f32x4 (&acc)[2][2][4][2], const Unit& u, int wr, int wc, int fr, int fq) const { if (u.kind == 0) e0(acc, u, wr, wc, fr, fq); else e1(acc, u, wr, wc, fr, fq); }
};
}

#define GAS __attribute__((address_space(1)))
#define LAS __attribute__((address_space(3)))
typedef unsigned short bf16;
typedef unsigned v4u __attribute__((ext_vector_type(4)));
typedef unsigned v2u __attribute__((ext_vector_type(2)));
typedef float f32x4 __attribute__((ext_vector_type(4)));
typedef float f32x2 __attribute__((ext_vector_type(2)));
constexpr int NWAVES = 8, NTHR = 512;
constexpr int DM = 2048, NBATCH = 4, LSEQ = 2048, LCTX = 256, DEPTH = 4;
constexpr int TLAT = NBATCH * LSEQ, TCTX = NBATCH * LCTX, TT = TLAT + TCTX;
constexpr int IN_DIM = 14168, DFF = 8192;
constexpr int NU = 13824;
constexpr int UZ = 0, UXBC = 768, URKV = 2560, UMISC = 4096, UCONV = 4608, UGATE = 5632;
constexpr int S_RKV = 2584, S_DT = 2560, S_WF = 4120, S_CONV = 4440, S_FFT = 5464, S_GATE = 5976;
constexpr int RJ = LCTX + LSEQ;
enum { I_X = 0, I_C, I_CTX, I_CCTX, I_MODW, I_MODB, I_NORMG, I_WIN, I_CONVW, I_CONVB, I_CLNG, I_CLNB, I_CONVOUT, I_SCW, I_SCB, I_SALOG, I_SDTB, I_SD, I_SNG, I_SOUT,
       I_FOUT, I_RMU, I_RW0, I_RW2, I_RA0, I_RA2, I_RG2, I_RKK, I_RKA, I_RRK, I_RLNG, I_RLNB, I_ROUT, I_WO, I_UP, I_DOWN, N_IN };
constexpr size_t MiB = 1u << 20;
constexpr size_t OFF_CTL = 0, CTL_BYTES = 1 * MiB;
constexpr size_t OFF_MODV = 1 * MiB;
constexpr size_t OFF_DFTL = 2 * MiB;
constexpr size_t OFF_DFTC = 18 * MiB;
constexpr size_t OFF_W = 20 * MiB, W_LAYER = 139 * MiB;
constexpr size_t WO_IN = 0, WO_FFT = 54 * MiB, WO_CAT = 58 * MiB  , WO_O = 67 * MiB, WO_UP = 75 * MiB, WO_DN = 107 * MiB;
constexpr size_t OFF_X = 576 * MiB;
constexpr size_t OFF_H = 648 * MiB;
constexpr size_t OFF_U = 684 * MiB;
constexpr size_t OFF_HB = OFF_U;
constexpr size_t OFF_MISC = 927 * MiB;
constexpr size_t OFF_VTL = 945 * MiB;
constexpr size_t OFF_VTC = 961 * MiB;
constexpr size_t OFF_ACAT = 963 * MiB;
constexpr int AC_CONV = 0, AC_SSD = 512, AC_FFT = 1280, AC_RWKV = 1792, ACW = 2304;
constexpr size_t OFF_XBC = 1004 * MiB;
constexpr size_t OFF_DTA = 1036 * MiB;
constexpr size_t OFF_YSSD = 1038 * MiB;
constexpr size_t OFF_RW = 1092 * MiB, RW_ARR = 18 * MiB;
constexpr size_t OFF_RCH = OFF_RW;
constexpr size_t OFF_RSC = 1254 * MiB;
constexpr size_t OFF_YRW = 1255 * MiB;
constexpr size_t OFF_MBUF = 1291 * MiB;
constexpr size_t OFF_M = 1363 * MiB;
constexpr size_t OFF_Y = 1399 * MiB;
constexpr size_t OFF_WLT = 1471 * MiB;
constexpr size_t OFF_YC = 1473 * MiB;
constexpr size_t WS_END = 1537 * MiB;
constexpr int CW_Q = 8192;
constexpr int CW_BAR = 4096;
constexpr int RING_BYTES = 131072, MISC_OFF = RING_BYTES + 320, LDS_BYTES = 147456;

__device__ __forceinline__ float bf2f(unsigned short b) { return __uint_as_float((unsigned)b << 16); }
__device__ __forceinline__ float bflo(unsigned u) { return __uint_as_float(u << 16); }
__device__ __forceinline__ float bfhi(unsigned u) { return __uint_as_float(u & 0xffff0000u); }
__device__ __forceinline__ unsigned f2bf(float f) { unsigned u = __builtin_bit_cast(unsigned, f); return (u + 0x7fffu + ((u >> 16) & 1u)) >> 16; }
typedef __bf16 bf16x2_t __attribute__((ext_vector_type(2)));
__device__ __forceinline__ unsigned pk2(float lo, float hi) { const bf16x2_t r = __builtin_convertvector((f32x2){lo, hi}, bf16x2_t); return __builtin_bit_cast(unsigned, r); }
__device__ __forceinline__ float sigmoidf_(float x) { return 1.f / (1.f + __expf(-x)); }
__device__ __forceinline__ float siluf_(float x) { return x / (1.f + __expf(-x)); }
__device__ __forceinline__ float softplusf_(float x) { return fmaxf(x, 0.f) + log1pf(__expf(-fabsf(x))); }
template <int CTRL> __device__ __forceinline__ float dpp_add(float x) { return x + __int_as_float(__builtin_amdgcn_update_dpp(0, __float_as_int(x), CTRL, 0xf, 0xf, true)); }
__device__ __forceinline__ float sum8(float x) { x = dpp_add<0xB1>(x); x = dpp_add<0x4E>(x); x = dpp_add<0x141>(x); return x; }
__device__ __forceinline__ float row16_sum(float x) { x = sum8(x); x = dpp_add<0x140>(x); return x; }
__device__ __forceinline__ float wave_sum(float v) {
    const float r = row16_sum(v);
    return (__int_as_float(__builtin_amdgcn_readlane(__float_as_int(r), 0)) + __int_as_float(__builtin_amdgcn_readlane(__float_as_int(r), 16))) +
           (__int_as_float(__builtin_amdgcn_readlane(__float_as_int(r), 32)) + __int_as_float(__builtin_amdgcn_readlane(__float_as_int(r), 48)));
}
#define LDS_WAIT() asm volatile("s_waitcnt lgkmcnt(0)" ::: "memory")

struct Args { const float* in[N_IN]; float* out; unsigned char* ws; int ph_lo, ph_hi; };
typedef const __attribute__((address_space(4))) Args* KArgs;
__device__ __forceinline__ KArgs kargs() { KArgs p = (KArgs)__builtin_amdgcn_kernarg_segment_ptr(); asm volatile("" : "+s"(p)); return p; }
#define PH_IDS unsigned z_ = 0u; asm volatile("" : "+v"(z_)); const int lane_ = (int)__builtin_amdgcn_mbcnt_hi(~0u, __builtin_amdgcn_mbcnt_lo(~0u, z_)); int wv_ = wave0; asm volatile("" : "+s"(wv_)); const int lane = lane_, wave = wv_, tid = wv_ * 64 + lane_; (void)lane; (void)wave; (void)tid;

__device__ __forceinline__ int inmap(int n) {
    if (n < 2560) return n;
    if (n < 4096) return S_RKV + (n - 2560);
    if (n < 4608) { const int m = n - 4096; if (m < 24) return S_DT + m; if (m < 64) return -1; if (m < 384) return S_WF + (m - 64); return -1; }
    if (n < 5632) return S_CONV + (n - 4608);
    return S_GATE + (n - 5632);
}
__device__ __forceinline__ int rwkv_tok(int b, int j) { if (j < LCTX) return TLAT + b * LCTX + j; const int s = j - LCTX; return b * LSEQ + (s & 31) * 64 + (s >> 5); }

__device__ __forceinline__ void transpose_item(const float* W, int ldw, int Nsrc, bf16* WT, int k0, int n0, bool mapped, LAS float* scr, int lane, int koff = 0) {
    const int n4 = (lane & 7) * 4; const int sc = mapped ? inmap(n0 + n4) : (n0 + n4);
    f32x4 v[8];
#pragma unroll
    for (int i = 0; i < 8; ++i) { const int kk = 8 * i + (lane >> 3); v[i] = (sc >= 0) ? *(const f32x4*)(W + (size_t)(k0 + kk) * Nsrc + sc) : (f32x4){0.f, 0.f, 0.f, 0.f}; }
#pragma unroll
    for (int i = 0; i < 8; ++i) { const int kk = 8 * i + (lane >> 3); LAS float* d = scr + kk * 33 + n4; d[0] = v[i].x; d[1] = v[i].y; d[2] = v[i].z; d[3] = v[i].w; }
    LDS_WAIT();
    const int c = lane & 7;
#pragma unroll
    for (int j = 0; j < 4; ++j) { const int n = (lane >> 3) + 8 * j; const LAS float* s = scr + (8 * c) * 33 + n;
        v4u o; o.x = pk2(s[0 * 33], s[1 * 33]); o.y = pk2(s[2 * 33], s[3 * 33]); o.z = pk2(s[4 * 33], s[5 * 33]); o.w = pk2(s[6 * 33], s[7 * 33]);
        *(v4u*)(WT + (size_t)(n0 + n) * ldw + koff + k0 + 8 * c) = o; }
    LDS_WAIT();
}
constexpr int IT_IN = 32 * (NU / 32), IT_CO = 8 * 64, IT_SO = 12 * 64, IT_FO = 8 * 64, IT_RO = 8 * 64, IT_O = 32 * 64, IT_UP = 32 * 256, IT_DN = 128 * 64;
constexpr int IT_LAYER = IT_IN + IT_CO + IT_SO + IT_FO + IT_RO + IT_O + IT_UP + IT_DN;

__device__ __forceinline__ void p0_prologue(KArgs a, LAS unsigned char* lds, int bid, int G, const int wave0) {
    PH_IDS
    unsigned char* ws = a->ws;
    {
        LAS float* sc = (LAS float*)lds;
        LAS float* part = (LAS float*)(lds + 40960);
        for (int i = tid; i < 5 * DM; i += NTHR) { const float v = (i < 4 * DM) ? a->in[I_C][i] : a->in[I_CCTX][i - 4 * DM]; sc[i] = siluf_(v); }
        __syncthreads();
        float* MODV = (float*)(ws + OFF_MODV);
        for (int it = bid; it < DEPTH * 192; it += G) {
            const int l = it / 192, j = (it % 192) * 64 + lane;
            const float* wp = a->in[I_MODW] + (size_t)l * DM * 12288 + (size_t)(wave * 256) * 12288 + j;
            float acc[5] = {0.f, 0.f, 0.f, 0.f, 0.f};
#pragma unroll 1
            for (int k0 = 0; k0 < 256; k0 += 32) { float w[32];
#pragma unroll
                for (int k = 0; k < 32; ++k) w[k] = wp[(size_t)(k0 + k) * 12288];
#pragma unroll
                for (int k = 0; k < 32; ++k)
#pragma unroll
                    for (int r = 0; r < 5; ++r) acc[r] += sc[r * DM + wave * 256 + k0 + k] * w[k]; }
#pragma unroll
            for (int r = 0; r < 5; ++r) part[(wave * 5 + r) * 64 + lane] = acc[r];
            __syncthreads();
            if (tid < 320) { const int r = tid >> 6, jj = tid & 63; float s = 0.f;
#pragma unroll
                for (int w = 0; w < 8; ++w) s += part[(w * 5 + r) * 64 + jj];
                const int jo = (it % 192) * 64 + jj; MODV[((size_t)l * 5 + r) * 12288 + jo] = s + a->in[I_MODB][l * 12288 + jo]; }
            __syncthreads();
        }
    }
    {
        LAS float* wt = (LAS float*)lds;
        LAS float* ctab = (LAS float*)(lds + 32768);
        LAS float* scr = (LAS float*)(lds + 32768 + 512 + wave * 8448);
        __syncthreads();
        if (tid < 128) ctab[tid] = cospif((float)tid * (1.f / 64.f));
        for (int it = bid; it < DEPTH * 32 * 4; it += G) {
            const int l = it / 128, kb = (it % 128) / 4, g = it % 4, k0 = kb * 64;
            __syncthreads();
            for (int i = tid; i < 64 * 32; i += NTHR) { const int kk = i >> 5, c4 = i & 31;
                *(LAS f32x4*)(wt + kk * 128 + c4 * 4) = *(const f32x4*)(a->in[I_WIN] + ((size_t)l * DM + k0 + kk) * IN_DIM + S_FFT + g * 128 + c4 * 4); }
            __syncthreads();
            const int half = wave >> 2, cp = (wave & 3) * 32 + (lane & 31), n0 = half * 512 + g * 128 + (wave & 3) * 32;
#pragma unroll 1
            for (int i = 0; i < 32; ++i) { const int kk = 2 * i + (lane >> 5); float s = 0.f;
#pragma unroll 8
                for (int c = 0; c < 128; ++c) s += wt[kk * 128 + c] * ctab[(c * cp - 32 * half) & 127];
                scr[kk * 33 + (lane & 31)] = s; }
            LDS_WAIT();
            bf16* WT = (bf16*)(ws + OFF_W + (size_t)l * W_LAYER + WO_FFT);
            const int c = lane & 7;
#pragma unroll
            for (int j = 0; j < 4; ++j) { const int n = (lane >> 3) + 8 * j; const LAS float* s = scr + (8 * c) * 33 + n;
                v4u o; o.x = pk2(s[0 * 33], s[1 * 33]); o.y = pk2(s[2 * 33], s[3 * 33]); o.z = pk2(s[4 * 33], s[5 * 33]); o.w = pk2(s[6 * 33], s[7 * 33]);
                *(v4u*)(WT + (size_t)(n0 + n) * DM + k0 + 8 * c) = o; }
            LDS_WAIT();
        }
        __syncthreads();
    }
    const int gw = bid * NWAVES + wave, NGW = G * NWAVES;
    {
        LAS float* scr = (LAS float*)(lds + wave * 8448);
        for (int it = gw; it < DEPTH * IT_LAYER; it += NGW) {
            const int l = it / IT_LAYER; int r = it % IT_LAYER; unsigned char* wl = ws + OFF_W + (size_t)l * W_LAYER;
            if (r < IT_IN) { const int kb = r / (NU / 32), nb = r % (NU / 32); transpose_item(a->in[I_WIN] + (size_t)l * DM * IN_DIM, DM, IN_DIM, (bf16*)(wl + WO_IN), kb * 64, nb * 32, true, scr, lane); continue; } r -= IT_IN;
            if (r < IT_CO) { transpose_item(a->in[I_CONVOUT] + (size_t)l * 512 * DM, ACW, DM, (bf16*)(wl + WO_CAT), (r / 64) * 64, (r % 64) * 32, false, scr, lane, AC_CONV); continue; } r -= IT_CO;
            if (r < IT_SO) { transpose_item(a->in[I_SOUT] + (size_t)l * 768 * DM, ACW, DM, (bf16*)(wl + WO_CAT), (r / 64) * 64, (r % 64) * 32, false, scr, lane, AC_SSD); continue; } r -= IT_SO;
            if (r < IT_FO) { transpose_item(a->in[I_FOUT] + (size_t)l * 512 * DM, ACW, DM, (bf16*)(wl + WO_CAT), (r / 64) * 64, (r % 64) * 32, false, scr, lane, AC_FFT); continue; } r -= IT_FO;
            if (r < IT_RO) { transpose_item(a->in[I_ROUT] + (size_t)l * 512 * DM, ACW, DM, (bf16*)(wl + WO_CAT), (r / 64) * 64, (r % 64) * 32, false, scr, lane, AC_RWKV); continue; } r -= IT_RO;
            if (r < IT_O) { transpose_item(a->in[I_WO] + (size_t)l * DM * DM, DM, DM, (bf16*)(wl + WO_O), (r / 64) * 64, (r % 64) * 32, false, scr, lane); continue; } r -= IT_O;
            if (r < IT_UP) { transpose_item(a->in[I_UP] + (size_t)l * DM * DFF, DM, DFF, (bf16*)(wl + WO_UP), (r / 256) * 64, (r % 256) * 32, false, scr, lane); continue; } r -= IT_UP;
            transpose_item(a->in[I_DOWN] + (size_t)l * DFF * DM, DFF, DM, (bf16*)(wl + WO_DN), (r / 64) * 64, (r % 64) * 32, false, scr, lane);
        }
    }
    {
        const int gt = bid * NTHR + tid, NGT = G * NTHR;
        bf16* FL = (bf16*)(ws + OFF_DFTL); bf16* FC = (bf16*)(ws + OFF_DFTC);
        { bf16* WLT = (bf16*)(ws + OFF_WLT);
          for (int i = gt; i < DEPTH * 512 * 320; i += NGT) { const int l = i / (512 * 320), c = (i / 320) % 512, j = i % 320; float v;
              if (j < 64) v = a->in[I_RW2][((size_t)(l * 2 + 0) * 64 + j) * 512 + c]; else if (j < 128) v = a->in[I_RW2][((size_t)(l * 2 + 1) * 64 + (j - 64)) * 512 + c];
              else if (j < 192) v = a->in[I_RA2][((size_t)l * 64 + (j - 128)) * 512 + c]; else v = a->in[I_RG2][((size_t)l * 128 + (j - 192)) * 512 + c];
              WLT[i] = (bf16)f2bf(v); } }
        for (int i = gt; i < 2048 * 512; i += NGT) { const int lp = i >> 9, k8 = (i & 511) * 8; unsigned o[4];
#pragma unroll
            for (int e = 0; e < 4; ++e) { float v[2];
#pragma unroll
                for (int q = 0; q < 2; ++q) { const int k = k8 + 2 * e + q; const int m = (lp * (k & 2047)) & 2047; float sn, cs; sincospif((float)m * (1.f / 1024.f), &sn, &cs); v[q] = (k < 2048 ? cs : -sn) * (1.f / 512.f); }
                o[e] = pk2(v[0], v[1]); }
            *(v4u*)(FL + (size_t)lp * 4096 + k8) = (v4u){o[0], o[1], o[2], o[3]}; }
        for (int i = gt; i < 256 * 64; i += NGT) { const int lp = i >> 6, k8 = (i & 63) * 8; unsigned o[4];
#pragma unroll
            for (int e = 0; e < 4; ++e) { float v[2];
#pragma unroll
                for (int q = 0; q < 2; ++q) { const int k = k8 + 2 * e + q; const int m = (lp * (k & 255)) & 255; float sn, cs; sincospif((float)m * (1.f / 128.f), &sn, &cs); v[q] = (k < 256 ? cs : -sn) * 0.005524271728f; }
                o[e] = pk2(v[0], v[1]); }
            *(v4u*)(FC + (size_t)lp * 512 + k8) = (v4u){o[0], o[1], o[2], o[3]}; }
        f32x4* X4 = (f32x4*)(ws + OFF_X); const f32x4* x4 = (const f32x4*)a->in[I_X]; const f32x4* c4 = (const f32x4*)a->in[I_CTX];
        for (int i = gt; i < TT * (DM / 4); i += NGT) X4[i] = (i < TLAT * (DM / 4)) ? x4[i] : c4[i - TLAT * (DM / 4)];
    }
}

__device__ __forceinline__ void norm_phase(KArgs a, int mode, const float* gY, const float* gH, const float* modY  , const float* modH  ,
                                           int bid, int G, const int wave0, int nrows, bool split = false  ) {
    PH_IDS
    unsigned char* ws = a->ws; const int gw = bid * NWAVES + wave, NGW = G * NWAVES;
    float* X = (float*)(ws + OFF_X); const bf16* Y = (const bf16*)(ws + OFF_Y); bf16* H = (bf16*)(ws + OFF_H);
    for (int row = gw; row < nrows; row += NGW) {
        const int mr = row < TLAT ? (row >> 11) : 4;
        f32x4 x[8];
        const f32x4* xr = (const f32x4*)(X + (size_t)row * DM) + lane;
#pragma unroll
        for (int j = 0; j < 8; ++j) x[j] = xr[64 * j];
        if (mode != 0) {
            const v2u* yr = (const v2u*)(Y + (size_t)row * DM) + lane; f32x4 y[8]; float ss = 0.f;
            if (split && row >= TLAT) { const f32x4* yc = (const f32x4*)((const float*)(ws + OFF_YC) + (size_t)(row - TLAT) * DM) + lane;
#pragma unroll
                for (int j = 0; j < 8; ++j) { f32x4 t = yc[64 * j];
#pragma unroll
                    for (int sl = 1; sl < 8; ++sl) t += yc[(size_t)sl * 1024 * 512 + 64 * j];
                    y[j] = t; } }
            else {
#pragma unroll
                for (int j = 0; j < 8; ++j) { const v2u t = yr[64 * j]; y[j] = (f32x4){bflo(t.x), bfhi(t.x), bflo(t.y), bfhi(t.y)}; } }
#pragma unroll
            for (int j = 0; j < 8; ++j) { ss += (y[j].x * y[j].x + y[j].y * y[j].y) + (y[j].z * y[j].z + y[j].w * y[j].w); }
            const float r = rsqrtf(wave_sum(ss) * (1.f / DM) + 1e-6f);
            const f32x4* gp = (const f32x4*)gY + lane; const f32x4* gt = (const f32x4*)(modY + (size_t)mr * 12288) + lane;
#pragma unroll
            for (int j = 0; j < 8; ++j) x[j] += gt[64 * j] * (y[j] * r * gp[64 * j]);
            if (mode == 1) { f32x4* xw = (f32x4*)(X + (size_t)row * DM) + lane;
#pragma unroll
                for (int j = 0; j < 8; ++j) xw[64 * j] = x[j]; }
            else { f32x4* ow = (f32x4*)(a->out + (size_t)row * DM) + lane;
#pragma unroll
                for (int j = 0; j < 8; ++j) ow[64 * j] = x[j]; }
        }
        if (mode != 2) {
            float ss = 0.f;
#pragma unroll
            for (int j = 0; j < 8; ++j) ss += (x[j].x * x[j].x + x[j].y * x[j].y) + (x[j].z * x[j].z + x[j].w * x[j].w);
            const float r = rsqrtf(wave_sum(ss) * (1.f / DM) + 1e-6f);
            const f32x4* gp = (const f32x4*)gH + lane; const f32x4* sh = (const f32x4*)(modH + (size_t)mr * 12288) + lane; const f32x4* sc = sh + 512;
            v2u* hw = (v2u*)(H + (size_t)row * DM) + lane;
#pragma unroll
            for (int j = 0; j < 8; ++j) { const f32x4 h = (x[j] * r * gp[64 * j]) * (sc[64 * j] + 1.f) + sh[64 * j]; hw[64 * j] = (v2u){pk2(h.x, h.y), pk2(h.z, h.w)}; }
        }
    }
}
#define XB_TMO      128
#define XB_XCNT(j)  (256  + 64 * (j))
#define XB_XSUB(j)  (1280 + 64 * (j))
#define XB_XGEN(j)  (2304 + 64 * (j))
#define XB_TOP      3328
#define XB_TOPGEN   3392
#define XCD_BAR_WORDS 3456
#define XB_SPIN_CAP (1u << 18)

__device__ __forceinline__ unsigned xb_ld(unsigned* p)              { return __hip_atomic_load(p, __ATOMIC_RELAXED, __HIP_MEMORY_SCOPE_AGENT); }
__device__ __forceinline__ unsigned xb_add(unsigned* p, unsigned v) { return __hip_atomic_fetch_add(p, v, __ATOMIC_RELAXED, __HIP_MEMORY_SCOPE_AGENT); }
__device__ __forceinline__ unsigned xb_xcc_id() { return (unsigned)__builtin_amdgcn_s_getreg((3 << 11) | 20) & 0xFu; }
#define XB_SPIN(cond, bar) do { unsigned _sp = 0; while (cond) { __builtin_amdgcn_s_sleep(1); \
    if ((++_sp & 255u) == 0u) { if (xb_ld(&(bar)[XB_TMO])) break; if (_sp > XB_SPIN_CAP) { atomicAdd(&(bar)[XB_TMO], 1u); break; } } } } while (0)

struct XcdBarrier {
    unsigned* bar; unsigned x; int wv;
    volatile LAS unsigned* st;
};

__device__ __forceinline__ bool xb_t0(int wv) { unsigned z_ = 0u; asm volatile("" : "+v"(z_)); return wv == 0 && __builtin_amdgcn_mbcnt_hi(~0u, __builtin_amdgcn_mbcnt_lo(~0u, z_)) == 0u; }
__device__ __forceinline__ XcdBarrier xcd_barrier_post(unsigned* bar, volatile LAS unsigned* st, int wv) {
    XcdBarrier b; b.bar = bar; b.x = xb_xcc_id(); b.st = st; b.wv = wv;
    if (xb_t0(wv)) (void)xb_add(&bar[XB_XCNT(b.x)], 1u);
    return b;
}
__device__ __forceinline__ void xcd_barrier_complete(unsigned* bar, unsigned x, unsigned& nloc, unsigned& nx) {
    const unsigned G = gridDim.x * gridDim.y * gridDim.z;
    unsigned sum, cnt, mine, sp = 0u;
    for (;;) {
        sum = 0u; cnt = 0u; mine = 0u;
#pragma unroll
        for (unsigned j = 0; j < 16; ++j) { const unsigned c = xb_ld(&bar[XB_XCNT(j)]); sum += c; cnt += (c > 0u) ? 1u : 0u; mine = (j == x) ? c : mine; }
        if (sum == G) break;
        __builtin_amdgcn_s_sleep(1);
        if ((++sp & 255u) == 0u) { if (xb_ld(&bar[XB_TMO])) break; if (sp > XB_SPIN_CAP) { atomicAdd(&bar[XB_TMO], 1u); break; } }
    }
    nloc = mine > 0u ? mine : 1u; nx = cnt > 0u ? cnt : 1u;
}

__device__ __forceinline__ void xcd_barrier(const XcdBarrier& b) {
    asm volatile("s_waitcnt vmcnt(0)" ::: "memory");
    __syncthreads();
    if (xb_t0(b.wv)) {
        unsigned* bar = b.bar;
        __builtin_amdgcn_s_waitcnt(0);
        unsigned nloc = b.st[0], nx = b.st[1];
        if (nloc == 0u) { xcd_barrier_complete(bar, b.x, nloc, nx); b.st[0] = nloc; b.st[1] = nx; }
        const unsigned old = xb_add(&bar[XB_XSUB(b.x)], 1u);
        const unsigned gen = old / nloc;
        if (old + 1u == (gen + 1u) * nloc) {
            __builtin_amdgcn_fence(__ATOMIC_RELEASE, "agent");
            asm volatile("s_waitcnt vmcnt(0)" ::: "memory");
            const unsigned og = xb_add(&bar[XB_TOP], 1u);
            const unsigned tg = og / nx;
            if (og + 1u == (tg + 1u) * nx) xb_add(&bar[XB_TOPGEN], 1u);
            else XB_SPIN(xb_ld(&bar[XB_TOPGEN]) == tg, bar);
            __builtin_amdgcn_fence(__ATOMIC_ACQUIRE, "agent");
            xb_add(&bar[XB_XGEN(b.x)], 1u);
            asm volatile("s_waitcnt vmcnt(0)" ::: "memory");
        } else {
            XB_SPIN(xb_ld(&bar[XB_XGEN(b.x)]) == gen, bar);
            __builtin_amdgcn_fence(__ATOMIC_ACQUIRE, "agent");
            asm volatile("s_waitcnt vmcnt(0)" ::: "memory");
        }
    }
    __syncthreads();
}

constexpr int RCH_NT = 0, RCH_RT = 2048, RCH_KST = 4096, RCH_TT = 4608, RCH_ART = 5120, RCH_KRT = 5632, RCH_VM = 6144, RCH_APT = 8192, RCH_KPT = 10240, RCH_GC = 12288, RCH_BYTES = 12544;

typedef short bf16x8 __attribute__((ext_vector_type(8)));
constexpr int RP_PITCH = 516, ACT_PITCH = 328;
__device__ __forceinline__ void rwkv_prep_item(KArgs a, int l, int item, LAS unsigned char* lds, int tid, int lane, int wave) {
    unsigned char* ws = a->ws;
    const bf16* U = (const bf16*)(ws + OFF_U); const float* MISC = (const float*)(ws + OFF_MISC);
    const int b = item / 144, j0 = (item % 144) * 16; const bool isctx = j0 < LCTX;
    LAS float* RP = (LAS float*)lds;
    LAS float* KP = RP + 16 * RP_PITCH; LAS float* VP = KP + 16 * RP_PITCH;
    LAS bf16* ACT = (LAS bf16*)(lds + 3 * 16 * RP_PITCH * 4);
    const float* mu = a->in[I_RMU] + l * 1856;
    bf16x8 wfr[10][4];
    { const bf16* WLT = (const bf16*)(ws + OFF_WLT) + (size_t)l * 512 * 320 + (size_t)(64 * wave + (lane & 15)) * 320 + (lane >> 4) * 8;
#pragma unroll
      for (int ks = 0; ks < 10; ++ks)
#pragma unroll
          for (int nt = 0; nt < 4; ++nt) wfr[ks][nt] = *(const bf16x8*)(WLT + (size_t)nt * 16 * 320 + ks * 32); }
#pragma unroll
    for (int it_ = 0; it_ < 6; ++it_) { const int idx = tid + it_ * NTHR; const int i = idx / 192, c8 = idx % 192, jj = j0 + i;
        const bool hp = isctx ? (jj - 1 >= 0) : (jj - 1 >= LCTX), hn = isctx ? (jj + 1 < LCTX) : (jj + 1 < RJ);
        const v4u c = *(const v4u*)(U + (size_t)rwkv_tok(b, jj) * NU + URKV + c8 * 8);
        v4u p = (v4u){0u, 0u, 0u, 0u}, n = p;
        if (hp) p = *(const v4u*)(U + (size_t)rwkv_tok(b, jj - 1) * NU + URKV + c8 * 8);
        if (hn) n = *(const v4u*)(U + (size_t)rwkv_tok(b, jj + 1) * NU + URKV + c8 * 8);
        const f32x4 m0 = *(const f32x4*)(mu + c8 * 8), m1 = *(const f32x4*)(mu + c8 * 8 + 4);
        f32x4 x0 = (f32x4){bflo(c.x), bfhi(c.x), bflo(c.y), bfhi(c.y)}, x1 = (f32x4){bflo(c.z), bfhi(c.z), bflo(c.w), bfhi(c.w)};
        const f32x4 s0 = (f32x4){bflo(p.x) + bflo(n.x), bfhi(p.x) + bfhi(n.x), bflo(p.y) + bflo(n.y), bfhi(p.y) + bfhi(n.y)}, s1 = (f32x4){bflo(p.z) + bflo(n.z), bfhi(p.z) + bfhi(n.z), bflo(p.w) + bflo(n.w), bfhi(p.w) + bfhi(n.w)};
        x0 = x0 + (0.5f * s0 - x0) * m0; x1 = x1 + (0.5f * s1 - x1) * m1;
        const int ch = c8 * 8, reg = ch >> 9; LAS float* dst = (reg == 0 ? RP : (reg == 1 ? KP : VP)) + i * RP_PITCH + (ch & 511);
        *(LAS f32x4*)dst = x0; *(LAS f32x4*)(dst + 4) = x1; }
#pragma unroll
    for (int it_ = 0; it_ < 3; ++it_) { const int idx = tid + it_ * NTHR; if (idx >= 16 * 80) break; const int i = idx / 80, c4 = idx % 80, jj = j0 + i;
        const bool hp = isctx ? (jj - 1 >= 0) : (jj - 1 >= LCTX), hn = isctx ? (jj + 1 < LCTX) : (jj + 1 < RJ);
        f32x4 x = *(const f32x4*)(MISC + (size_t)rwkv_tok(b, jj) * 512 + 64 + c4 * 4); f32x4 p = (f32x4){0.f, 0.f, 0.f, 0.f}, n = p;
        if (hp) p = *(const f32x4*)(MISC + (size_t)rwkv_tok(b, jj - 1) * 512 + 64 + c4 * 4);
        if (hn) n = *(const f32x4*)(MISC + (size_t)rwkv_tok(b, jj + 1) * 512 + 64 + c4 * 4);
        x = x + (0.5f * (p + n) - x) * *(const f32x4*)(mu + 1536 + c4 * 4);
        const int m = c4 * 4;
        if (m < 128) x = (f32x4){tanhf(x.x), tanhf(x.y), tanhf(x.z), tanhf(x.w)}; else if (m >= 192) x = (f32x4){sigmoidf_(x.x), sigmoidf_(x.y), sigmoidf_(x.z), sigmoidf_(x.w)};
        *(LAS v2u*)(ACT + i * ACT_PITCH + m) = (v2u){pk2(x.x, x.y), pk2(x.z, x.w)}; }
    __syncthreads();
    const int fr = lane & 15, fq = lane >> 4, h = wave;
    f32x4 acc[4][4];
#pragma unroll
    for (int o = 0; o < 4; ++o)
#pragma unroll
        for (int nt = 0; nt < 4; ++nt) acc[o][nt] = (f32x4){0.f, 0.f, 0.f, 0.f};
    {
#pragma unroll
        for (int ks = 0; ks < 10; ++ks) { const int o = ks < 2 ? 0 : (ks < 4 ? 1 : (ks < 6 ? 2 : 3));
            const bf16x8 af = *(const LAS bf16x8*)(ACT + fr * ACT_PITCH + ks * 32 + fq * 8);
#pragma unroll
            for (int nt = 0; nt < 4; ++nt) acc[o][nt] = __builtin_amdgcn_mfma_f32_16x16x32_bf16(af, wfr[ks][nt], acc[o][nt], 0, 0, 0); }
    }
    float* RW = (float*)(ws + OFF_RW); constexpr size_t AS = RW_ARR / 4; float* RSC = (float*)(ws + OFF_RSC);
    float w0f[4], w0b[4], a0c[4], kkc[4], kac[4], rkc[4];
#pragma unroll
    for (int nt = 0; nt < 4; ++nt) { const int c = 64 * wave + 16 * nt + fr; w0f[nt] = a->in[I_RW0][(l * 2 + 0) * 512 + c]; w0b[nt] = a->in[I_RW0][(l * 2 + 1) * 512 + c]; a0c[nt] = a->in[I_RA0][l * 512 + c];
        kkc[nt] = a->in[I_RKK][l * 512 + c]; kac[nt] = a->in[I_RKA][l * 512 + c]; rkc[nt] = a->in[I_RRK][l * 512 + c]; }
    float Wd[2][4][4], Rr[4][4], Km[4][4], Nn[4][4], Ka[4][4], Vv[4][4];
#pragma unroll
    for (int i = 0; i < 4; ++i) { const int tok = 4 * fq + i; const size_t R = (size_t)b * RJ + j0 + tok;
        float k[4], av[4], kkv[4]; float ss = 0.f;
#pragma unroll
        for (int nt = 0; nt < 4; ++nt) { const int c = 64 * wave + 16 * nt + fr; Rr[i][nt] = RP[tok * RP_PITCH + c]; k[nt] = KP[tok * RP_PITCH + c]; Vv[i][nt] = VP[tok * RP_PITCH + c];
            av[nt] = sigmoidf_(a0c[nt] + acc[2][nt][i]); kkv[nt] = k[nt] * kkc[nt]; ss += kkv[nt] * kkv[nt]; }
        const float rn = rsqrtf(row16_sum(ss) + 1e-12f);
        float bon = 0.f;
#pragma unroll
        for (int nt = 0; nt < 4; ++nt) { const int c = 64 * wave + 16 * nt + fr;
            Wd[0][i][nt] = __expf(-__expf(-softplusf_(-(w0f[nt] + acc[0][nt][i])) - 0.5f)); Wd[1][i][nt] = __expf(-__expf(-softplusf_(-(w0b[nt] + acc[1][nt][i])) - 0.5f));
            const float kk = kkv[nt] * rn; Km[i][nt] = k[nt] * (1.f + (av[nt] - 1.f) * kac[nt]); Ka[i][nt] = kk * av[nt]; Nn[i][nt] = -kk;
            bon += Rr[i][nt] * Km[i][nt] * rkc[nt];
            float* o = RW + R * 512 + c; o[7 * AS] = Vv[i][nt]; o[8 * AS] = acc[3][nt][i]; }
        bon = row16_sum(bon);
        if (fr == 0) RSC[(size_t)2 * TT * 8 + R * 8 + h] = bon;
    }
    __syncthreads();
    LAS unsigned char* wl_ = lds + wave * 14336;
    LAS bf16* NTl = (LAS bf16*)wl_; LAS bf16* RTl = NTl + 16 * 68; LAS bf16* ATl = RTl + 16 * 68; LAS bf16* KTl = ATl + 16 * 68;
    LAS float* ASl = (LAS float*)(wl_ + 8704);
    LAS float* TTl = (LAS float*)(wl_ + 11264);
    typedef short bf16x4 __attribute__((ext_vector_type(4)));
#pragma unroll
    for (int d = 0; d < 2; ++d) {
        const int cidx = d ? (isctx ? (240 - j0) / 16 : (2544 - j0) / 16) : j0 / 16;
        unsigned char* img = ws + OFF_RCH + ((size_t)((b * 2 + d) * 8 + h) * 144 + cidx) * RCH_BYTES;
        const int laneD = d ? ((3 - fq) * 16 + fr) : lane;
#pragma unroll
        for (int nt = 0; nt < 4; ++nt) {
            float gam[4], gpv[4], G, E;
            if (d == 0) { gam[0] = Wd[0][0][nt]; gam[1] = gam[0] * Wd[0][1][nt]; gam[2] = gam[1] * Wd[0][2][nt]; gam[3] = gam[2] * Wd[0][3][nt]; G = gam[3];
                const float g1 = __int_as_float(__builtin_amdgcn_ds_bpermute((lane - 16) << 2, __float_as_int(G))), g2 = __int_as_float(__builtin_amdgcn_ds_bpermute((lane - 32) << 2, __float_as_int(G))), g3 = __int_as_float(__builtin_amdgcn_ds_bpermute((lane - 48) << 2, __float_as_int(G)));
                E = (fq >= 1 ? g1 : 1.f) * (fq >= 2 ? g2 : 1.f) * (fq >= 3 ? g3 : 1.f);
                gpv[0] = E; gpv[1] = E * gam[0]; gpv[2] = E * gam[1]; gpv[3] = E * gam[2];
#pragma unroll
                for (int i = 0; i < 4; ++i) gam[i] *= E; }
            else { gam[3] = Wd[1][3][nt]; gam[2] = gam[3] * Wd[1][2][nt]; gam[1] = gam[2] * Wd[1][1][nt]; gam[0] = gam[1] * Wd[1][0][nt]; G = gam[0];
                const float g1 = __int_as_float(__builtin_amdgcn_ds_bpermute((lane + 16) << 2, __float_as_int(G))), g2 = __int_as_float(__builtin_amdgcn_ds_bpermute((lane + 32) << 2, __float_as_int(G))), g3 = __int_as_float(__builtin_amdgcn_ds_bpermute((lane + 48) << 2, __float_as_int(G)));
                E = (fq <= 2 ? g1 : 1.f) * (fq <= 1 ? g2 : 1.f) * (fq <= 0 ? g3 : 1.f);
                gpv[3] = E; gpv[2] = E * gam[3]; gpv[1] = E * gam[2]; gpv[0] = E * gam[1];
#pragma unroll
                for (int i = 0; i < 4; ++i) gam[i] *= E; }
            float tot = G * __int_as_float(__builtin_amdgcn_ds_bpermute((lane ^ 16) << 2, __float_as_int(G)));
            tot = tot * __int_as_float(__builtin_amdgcn_ds_bpermute((lane ^ 32) << 2, __float_as_int(tot)));
            float ap[4], kp[4];
#pragma unroll
            for (int i = 0; i < 4; ++i) { const int td = d ? 15 - (4 * fq + i) : 4 * fq + i; const float ig = 1.f / gam[i];
                const float at_ = Ka[i][nt] * ig, kt_ = Km[i][nt] * ig; ap[i] = at_ * tot; kp[i] = kt_ * tot;
                NTl[td * 68 + 16 * nt + fr] = (bf16)f2bf(gpv[i] * Nn[i][nt]); RTl[td * 68 + 16 * nt + fr] = (bf16)f2bf(gam[i] * Rr[i][nt]);
                ATl[td * 68 + 16 * nt + fr] = (bf16)f2bf(at_); KTl[td * 68 + 16 * nt + fr] = (bf16)f2bf(kt_); }
            v2u pa, pk, pv;
            if (d == 0) { pa = (v2u){pk2(ap[0], ap[1]), pk2(ap[2], ap[3])}; pk = (v2u){pk2(kp[0], kp[1]), pk2(kp[2], kp[3])}; pv = (v2u){pk2(Vv[0][nt], Vv[1][nt]), pk2(Vv[2][nt], Vv[3][nt])}; }
            else { pa = (v2u){pk2(ap[3], ap[2]), pk2(ap[1], ap[0])}; pk = (v2u){pk2(kp[3], kp[2]), pk2(kp[1], kp[0])}; pv = (v2u){pk2(Vv[3][nt], Vv[2][nt]), pk2(Vv[1][nt], Vv[0][nt])}; }
            *(v2u*)(img + RCH_APT + nt * 512 + laneD * 8) = pa; *(v2u*)(img + RCH_KPT + nt * 512 + laneD * 8) = pk; *(v2u*)(img + RCH_VM + nt * 512 + laneD * 8) = pv;
            if (fq == 0) *(float*)(img + RCH_GC + (16 * nt + fr) * 4) = tot;
        }
        LDS_WAIT();
#pragma unroll
        for (int kt = 0; kt < 4; ++kt) { *(v2u*)(img + RCH_NT + kt * 512 + lane * 8) = *(const LAS v2u*)(NTl + fr * 68 + 16 * kt + 4 * fq); *(v2u*)(img + RCH_RT + kt * 512 + lane * 8) = *(const LAS v2u*)(RTl + fr * 68 + 16 * kt + 4 * fq); }
        f32x4 cAs = (f32x4){0.f, 0.f, 0.f, 0.f}, cKs = cAs, cAr = cAs, cKr = cAs;
#pragma unroll
        for (int sk = 0; sk < 4; ++sk) { const bf16x4 aA = *(const LAS bf16x4*)(ATl + fr * 68 + 16 * sk + 4 * fq), aK = *(const LAS bf16x4*)(KTl + fr * 68 + 16 * sk + 4 * fq);
            const bf16x4 bN = *(const LAS bf16x4*)(NTl + fr * 68 + 16 * sk + 4 * fq), bR = *(const LAS bf16x4*)(RTl + fr * 68 + 16 * sk + 4 * fq);
            cAs = __builtin_amdgcn_mfma_f32_16x16x16bf16_1k(aA, bN, cAs, 0, 0, 0); cKs = __builtin_amdgcn_mfma_f32_16x16x16bf16_1k(aK, bN, cKs, 0, 0, 0);
            cAr = __builtin_amdgcn_mfma_f32_16x16x16bf16_1k(aA, bR, cAr, 0, 0, 0); cKr = __builtin_amdgcn_mfma_f32_16x16x16bf16_1k(aK, bR, cKr, 0, 0, 0); }
#pragma unroll
        for (int j = 0; j < 4; ++j) { const int ii = 4 * fq + j; if (!(ii < fr)) { cAs[j] = 0.f; cKs[j] = 0.f; } if (!(ii <= fr)) { cAr[j] = 0.f; cKr[j] = 0.f; } }
        *(v2u*)(img + RCH_KST + lane * 8) = (v2u){pk2(cKs[0], cKs[1]), pk2(cKs[2], cKs[3])}; *(v2u*)(img + RCH_ART + lane * 8) = (v2u){pk2(cAr[0], cAr[1]), pk2(cAr[2], cAr[3])};
        *(v2u*)(img + RCH_KRT + lane * 8) = (v2u){pk2(cKr[0], cKr[1]), pk2(cKr[2], cKr[3])};
        *(LAS f32x4*)(ASl + (d * 16 + fr) * 20 + 4 * fq) = cAs;
        LDS_WAIT();
    }
    if (lane < 32) { const int d = lane >> 4, irow = lane & 15; float Tc[16];
#pragma unroll
        for (int t = 0; t < 16; ++t) { float x = (irow == t) ? 1.f : 0.f;
#pragma unroll
            for (int j4 = 0; j4 < (t + 3) / 4; ++j4) { const f32x4 av = *(const LAS f32x4*)(ASl + (d * 16 + t) * 20 + 4 * j4);
#pragma unroll
                for (int e = 0; e < 4; ++e) if (4 * j4 + e < t) x += Tc[4 * j4 + e] * av[e]; }
            Tc[t] = x; TTl[(d * 16 + t) * 20 + irow] = x; } }
    LDS_WAIT();
#pragma unroll
    for (int d = 0; d < 2; ++d) { const int cidx = d ? (isctx ? (240 - j0) / 16 : (2544 - j0) / 16) : j0 / 16;
        unsigned char* img = ws + OFF_RCH + ((size_t)((b * 2 + d) * 8 + h) * 144 + cidx) * RCH_BYTES;
        const f32x4 tv = *(const LAS f32x4*)(TTl + (d * 16 + fr) * 20 + 4 * fq);
        *(v2u*)(img + RCH_TT + lane * 8) = (v2u){pk2(tv[0], tv[1]), pk2(tv[2], tv[3])}; }
    __syncthreads();
}
__device__ __forceinline__ void ssd_prep_item(KArgs a, int l, int item, int tid) {
    unsigned char* ws = a->ws; const bf16* U = (const bf16*)(ws + OFF_U); const float* MISC = (const float*)(ws + OFF_MISC);
    bf16* XBC = (bf16*)(ws + OFF_XBC); float* DTA = (float*)(ws + OFF_DTA);
    const int t0 = item * 16;
    const int seq_lo = t0 < TLAT ? (t0 & ~(LSEQ - 1)) : TLAT + ((t0 - TLAT) & ~(LCTX - 1)), seq_hi = seq_lo + (t0 < TLAT ? LSEQ : LCTX);
    for (int cp = tid; cp < 896; cp += NTHR) {
        float w0[5], w1[5];
#pragma unroll
        for (int j = 0; j < 5; ++j) { const f32x2 w = *(const f32x2*)(a->in[I_SCW] + (size_t)(l * 5 + j) * 1792 + 2 * cp); w0[j] = w.x; w1[j] = w.y; }
        const f32x2 bb = *(const f32x2*)(a->in[I_SCB] + l * 1792 + 2 * cp);
        float i0[20], i1[20];
#pragma unroll
        for (int r = 0; r < 20; ++r) { const int row = t0 - 2 + r; unsigned u = 0u; if (row >= seq_lo && row < seq_hi) u = *(const unsigned*)(U + (size_t)row * NU + UXBC + 2 * cp); i0[r] = bflo(u); i1[r] = bfhi(u); }
#pragma unroll
        for (int o = 0; o < 16; ++o) { float s0 = bb.x, s1 = bb.y;
#pragma unroll
            for (int j = 0; j < 5; ++j) { s0 += w0[j] * i0[o + j]; s1 += w1[j] * i1[o + j]; }
            *(unsigned*)(XBC + (size_t)(t0 + o) * 1792 + 2 * cp) = pk2(siluf_(s0), siluf_(s1)); }
    }
    if (tid < 16 * 24) { const int o = tid / 24, q = tid % 24;
        const float dt = softplusf_(MISC[(size_t)(t0 + o) * 512 + q] + a->in[I_SDTB][l * 24 + q]); const float A = -__expf(a->in[I_SALOG][l * 24 + q]);
        DTA[(size_t)(t0 + o) * 48 + q] = dt; DTA[(size_t)(t0 + o) * 48 + 24 + q] = dt * A; }
}
__device__ __forceinline__ void conv_item(KArgs a, int l, int item, LAS unsigned char* lds, int tid, int lane, int wave) {
    unsigned char* ws = a->ws; const bf16* U = (const bf16*)(ws + OFF_U); bf16* AC = (bf16*)(ws + OFF_ACAT) + AC_CONV;
    int t0, seg_lo, seg_hi;
    if (item < 256) { t0 = item * 32; seg_lo = t0 & ~63; seg_hi = seg_lo + 64; }
    else { const int ci = item - 256; t0 = TLAT + ci * 32; seg_lo = TLAT + (ci >> 3) * LCTX; seg_hi = seg_lo + LCTX; }
    LAS bf16* inimg = (LAS bf16*)lds;
    LAS float* outimg = (LAS float*)(lds + 63488);
    for (int idx = tid; idx < 62 * 64; idx += NTHR) { const int rr = idx >> 6, c8 = idx & 63, row = t0 - 15 + rr;
        v4u o = (v4u){0u, 0u, 0u, 0u};
        if (row >= seg_lo && row < seg_hi) { const v4u va = *(const v4u*)(U + (size_t)row * NU + UCONV + c8 * 8), vg = *(const v4u*)(U + (size_t)row * NU + UCONV + 512 + c8 * 8);
            o.x = pk2(bflo(va.x) * sigmoidf_(bflo(vg.x)), bfhi(va.x) * sigmoidf_(bfhi(vg.x))); o.y = pk2(bflo(va.y) * sigmoidf_(bflo(vg.y)), bfhi(va.y) * sigmoidf_(bfhi(vg.y)));
            o.z = pk2(bflo(va.z) * sigmoidf_(bflo(vg.z)), bfhi(va.z) * sigmoidf_(bfhi(vg.z))); o.w = pk2(bflo(va.w) * sigmoidf_(bflo(vg.w)), bfhi(va.w) * sigmoidf_(bfhi(vg.w))); }
        *(LAS v4u*)(inimg + rr * 512 + c8 * 8) = o; }
    __syncthreads();
    {
        const int cp = tid & 255, th = tid >> 8;
        f32x2 w[31];
#pragma unroll
        for (int j = 0; j < 31; ++j) w[j] = *(const f32x2*)(a->in[I_CONVW] + (size_t)(l * 31 + j) * 512 + 2 * cp);
        const f32x2 bias = *(const f32x2*)(a->in[I_CONVB] + l * 512 + 2 * cp);
        f32x2 o[16];
#pragma unroll
        for (int q = 0; q < 16; ++q) o[q] = bias;
        const LAS unsigned* ip = (const LAS unsigned*)(inimg + (16 * th) * 512 + 2 * cp);
#pragma unroll
        for (int r = 0; r < 46; ++r) { const unsigned u = ip[r * 256]; const f32x2 v = (f32x2){bflo(u), bfhi(u)};
#pragma unroll
            for (int q = 0; q < 16; ++q) if (r - q >= 0 && r - q < 31) o[q] += w[r - q] * v; }
#pragma unroll
        for (int q = 0; q < 16; ++q) *(LAS f32x2*)(outimg + (16 * th + q) * 512 + 2 * cp) = o[q];
    }
    __syncthreads();
    {
        const f32x4 g0 = *(const f32x4*)(a->in[I_CLNG] + l * 512 + 8 * lane), g1 = *(const f32x4*)(a->in[I_CLNG] + l * 512 + 8 * lane + 4);
        const f32x4 b0 = *(const f32x4*)(a->in[I_CLNB] + l * 512 + 8 * lane), b1 = *(const f32x4*)(a->in[I_CLNB] + l * 512 + 8 * lane + 4);
#pragma unroll
        for (int q = 0; q < 4; ++q) { const int o = wave * 4 + q;
            f32x4 x0 = *(const LAS f32x4*)(outimg + o * 512 + 8 * lane), x1 = *(const LAS f32x4*)(outimg + o * 512 + 8 * lane + 4);
            const float mean = wave_sum((x0.x + x0.y + x0.z + x0.w) + (x1.x + x1.y + x1.z + x1.w)) * (1.f / 512.f);
            x0 = x0 - mean; x1 = x1 - mean;
            const float var = wave_sum((x0.x * x0.x + x0.y * x0.y + x0.z * x0.z + x0.w * x0.w) + (x1.x * x1.x + x1.y * x1.y + x1.z * x1.z + x1.w * x1.w)) * (1.f / 512.f);
            const float rs = rsqrtf(var + 1e-5f);
            x0 = x0 * rs * g0 + b0; x1 = x1 * rs * g1 + b1;
            v4u ov; ov.x = pk2(siluf_(x0.x), siluf_(x0.y)); ov.y = pk2(siluf_(x0.z), siluf_(x0.w)); ov.z = pk2(siluf_(x1.x), siluf_(x1.y)); ov.w = pk2(siluf_(x1.z), siluf_(x1.w));
            *(v4u*)(AC + (size_t)(t0 + o) * ACW + 8 * lane) = ov; }
    }
    __syncthreads();
}

__device__ __forceinline__ int ssd_tok(int b, int dir, int pos) {
    if (pos < LCTX) return TLAT + b * LCTX + (dir ? (LCTX - 1 - pos) : pos);
    const int q = pos - LCTX; return b * LSEQ + (dir ? (LSEQ - 1 - q) : q);
}
__device__ __forceinline__ void post_phase(KArgs a, int l, int bid, int G, const int wave0) {
    PH_IDS
    unsigned char* ws = a->ws; const int gw = bid * NWAVES + wave, NGW = G * NWAVES;
    const bf16* U = (const bf16*)(ws + OFF_U); const bf16* XBC = (const bf16*)(ws + OFF_XBC);
    const float* Y0 = (const float*)(ws + OFF_YSSD); const float* Y1 = Y0 + (size_t)TT * 768; bf16* AS_ = (bf16*)(ws + OFF_ACAT) + AC_SSD;
    for (int row = gw; row < TT; row += NGW) {
        f32x4 y[3]; float ss = 0.f;
#pragma unroll
        for (int j = 0; j < 3; ++j) { const int col = 4 * lane + 256 * j; const float dsk = a->in[I_SD][l * 12 + (col >> 6)];
            const f32x4 yf = *(const f32x4*)(Y0 + (size_t)row * 768 + col), yb = *(const f32x4*)(Y1 + (size_t)row * 768 + col);
            const v2u xs = *(const v2u*)(XBC + (size_t)row * 1792 + col), z = *(const v2u*)(U + (size_t)row * NU + UZ + col);
            f32x4 v = yf + yb + dsk * (f32x4){bflo(xs.x), bfhi(xs.x), bflo(xs.y), bfhi(xs.y)};
            v = v * (f32x4){siluf_(bflo(z.x)), siluf_(bfhi(z.x)), siluf_(bflo(z.y)), siluf_(bfhi(z.y))};
            y[j] = v; ss += (v.x * v.x + v.y * v.y) + (v.z * v.z + v.w * v.w); }
        const float r = rsqrtf(wave_sum(ss) * (1.f / 768.f) + 1e-6f);
#pragma unroll
        for (int j = 0; j < 3; ++j) { const int col = 4 * lane + 256 * j; const f32x4 g = *(const f32x4*)(a->in[I_SNG] + l * 768 + col); const f32x4 o = y[j] * r * g;
            *(v2u*)(AS_ + (size_t)row * ACW + col) = (v2u){pk2(o.x, o.y), pk2(o.z, o.w)}; }
    }
    const float* RW = (const float*)(ws + OFF_RW); constexpr size_t AS = RW_ARR / 4; const float* RSC = (const float*)(ws + OFF_RSC);
    const float* R0 = (const float*)(ws + OFF_YRW); const float* R1 = R0 + (size_t)TT * 512; bf16* AR = (bf16*)(ws + OFF_ACAT) + AC_RWKV;
    for (int row = gw; row < TT; row += NGW) {
        size_t R;
        if (row < TLAT) { const int b = row >> 11, t = row & 2047, rr = t >> 6, cc = t & 63; R = (size_t)b * RJ + LCTX + cc * 32 + rr; }
        else { const int b = (row - TLAT) >> 8, jj = (row - TLAT) & 255; R = (size_t)b * RJ + jj; }
        const int c0 = 8 * lane, h = lane >> 3;
        f32x4 ya = *(const f32x4*)(R0 + R * 512 + c0) + *(const f32x4*)(R1 + R * 512 + c0), yb = *(const f32x4*)(R0 + R * 512 + c0 + 4) + *(const f32x4*)(R1 + R * 512 + c0 + 4);
        float s = (ya.x + ya.y + ya.z + ya.w) + (yb.x + yb.y + yb.z + yb.w);
        s = sum8(s);
        const float mean = s * (1.f / 64.f); ya = ya - mean; yb = yb - mean;
        float q = (ya.x * ya.x + ya.y * ya.y + ya.z * ya.z + ya.w * ya.w) + (yb.x * yb.x + yb.y * yb.y + yb.z * yb.z + yb.w * yb.w);
        q = sum8(q);
        const float rs = rsqrtf(q * (1.f / 64.f) + 64e-5f);
        const f32x4 lg0 = *(const f32x4*)(a->in[I_RLNG] + l * 512 + c0), lg1 = *(const f32x4*)(a->in[I_RLNG] + l * 512 + c0 + 4), lb0 = *(const f32x4*)(a->in[I_RLNB] + l * 512 + c0), lb1 = *(const f32x4*)(a->in[I_RLNB] + l * 512 + c0 + 4);
        const float bon = RSC[(size_t)2 * TT * 8 + R * 8 + h];
        const f32x4 v0 = *(const f32x4*)(RW + 7 * AS + R * 512 + c0), v1 = *(const f32x4*)(RW + 7 * AS + R * 512 + c0 + 4), g0 = *(const f32x4*)(RW + 8 * AS + R * 512 + c0), g1 = *(const f32x4*)(RW + 8 * AS + R * 512 + c0 + 4);
        const f32x4 o0 = (ya * rs * lg0 + lb0 + bon * v0) * g0, o1 = (yb * rs * lg1 + lb1 + bon * v1) * g1;
        *(v4u*)(AR + (size_t)row * ACW + c0) = (v4u){pk2(o0.x, o0.y), pk2(o0.z, o0.w), pk2(o1.x, o1.y), pk2(o1.z, o1.w)};
    }
}

__device__ __forceinline__ size_t rwkv_row(int b, int dir, int pos) { const int j = dir ? (pos < LCTX ? (LCTX - 1 - pos) : (RJ + LCTX - 1 - pos)) : pos; return (size_t)b * RJ + j; }
struct RchOps { v2u nt[4], rt[4], kst, tt, art, krt, vm, apt[4], kpt[4]; f32x4 gc[4]; };
__device__ __forceinline__ void rwkv_scan_chunk(KArgs a, int idx, LAS unsigned char* lds, int tid, int lane, int wave) {
    typedef short bf16x4 __attribute__((ext_vector_type(4)));
    unsigned char* ws = a->ws;
    const int b = idx >> 4, dir = (idx >> 3) & 1, h = idx & 7, fr = lane & 15, fq = lane >> 4;
    float* Yo = (float*)(ws + OFF_YRW) + (size_t)dir * TT * 512;
    const unsigned char* base = ws + OFF_RCH + (size_t)((b * 2 + dir) * 8 + h) * 144 * RCH_BYTES;
    constexpr int BLK = 4 * RCH_BYTES;
    const int lt = tid - 256;
    v4u pre[13];
    auto issue = [&](int blk) { const v4u* src = (const v4u*)(base + (size_t)blk * BLK);
#pragma unroll
        for (int i = 0; i < 13; ++i) { const int e = lt + i * 256; if (e < BLK / 16) pre[i] = src[e]; } };
    auto commit = [&](int buf) { LAS v4u* dst = (LAS v4u*)(lds + buf * BLK);
#pragma unroll
        for (int i = 0; i < 13; ++i) { const int e = lt + i * 256; if (e < BLK / 16) dst[e] = pre[i]; } };
    auto ld = [&](const LAS unsigned char* p0, int wv) { RchOps o; const LAS unsigned char* p = p0 + lane * 8;
#pragma unroll
        for (int kt = 0; kt < 4; ++kt) { o.nt[kt] = *(const LAS v2u*)(p + RCH_NT + kt * 512); o.rt[kt] = *(const LAS v2u*)(p + RCH_RT + kt * 512); o.apt[kt] = *(const LAS v2u*)(p + RCH_APT + kt * 512); o.kpt[kt] = *(const LAS v2u*)(p + RCH_KPT + kt * 512);
            o.gc[kt] = *(const LAS f32x4*)(p0 + RCH_GC + (16 * kt + 4 * fq) * 4); }
        o.kst = *(const LAS v2u*)(p + RCH_KST); o.tt = *(const LAS v2u*)(p + RCH_TT); o.art = *(const LAS v2u*)(p + RCH_ART); o.krt = *(const LAS v2u*)(p + RCH_KRT); o.vm = *(const LAS v2u*)(p + RCH_VM + wv * 512); return o; };
#define MF16(A_, B_, C_) __builtin_amdgcn_mfma_f32_16x16x16bf16_1k(__builtin_bit_cast(bf16x4, A_), __builtin_bit_cast(bf16x4, B_), C_, 0, 0, 0)
    f32x4 S[4];
#pragma unroll
    for (int kt = 0; kt < 4; ++kt) S[kt] = (f32x4){0.f, 0.f, 0.f, 0.f};
    auto step = [&](const RchOps& cur, int c) {
        v2u Sb[4];
#pragma unroll
        for (int kt = 0; kt < 4; ++kt) Sb[kt] = (v2u){pk2(S[kt][0], S[kt][1]), pk2(S[kt][2], S[kt][3])};
        f32x4 rhs = (f32x4){0.f, 0.f, 0.f, 0.f}, y = rhs;
#pragma unroll
        for (int kt = 0; kt < 4; ++kt) rhs = MF16(cur.nt[kt], Sb[kt], rhs);
        rhs = MF16(cur.kst, cur.vm, rhs);
        const v2u rb = (v2u){pk2(rhs[0], rhs[1]), pk2(rhs[2], rhs[3])};
        const f32x4 u = MF16(cur.tt, rb, ((f32x4){0.f, 0.f, 0.f, 0.f}));
        const v2u ub = (v2u){pk2(u[0], u[1]), pk2(u[2], u[3])};
#pragma unroll
        for (int kt = 0; kt < 4; ++kt) { S[kt] = S[kt] * cur.gc[kt]; S[kt] = MF16(cur.apt[kt], ub, S[kt]); S[kt] = MF16(cur.kpt[kt], cur.vm, S[kt]); }
#pragma unroll
        for (int kt = 0; kt < 4; ++kt) y = MF16(cur.rt[kt], Sb[kt], y);
        y = MF16(cur.art, ub, y); y = MF16(cur.krt, cur.vm, y);
#pragma unroll
        for (int j = 0; j < 4; ++j) { const size_t R = rwkv_row(b, dir, c * 16 + 4 * fq + j); Yo[R * 512 + h * 64 + 16 * wave + fr] = y[j]; }
    };
    if (wave >= 4) { issue(0); commit(0); }
    __syncthreads();
    for (int blk = 0; blk < 36; ++blk) {
        if (wave >= 4) { if (blk + 1 < 36) issue(blk + 1); }
        else { const LAS unsigned char* B = lds + (blk & 1) * BLK;
            RchOps o0 = ld(B, wave), o1 = ld(B + RCH_BYTES, wave);
            step(o0, blk * 4 + 0); o0 = ld(B + 2 * RCH_BYTES, wave);
            step(o1, blk * 4 + 1); o1 = ld(B + 3 * RCH_BYTES, wave);
            step(o0, blk * 4 + 2);
            step(o1, blk * 4 + 3); }
        if (wave >= 4 && blk + 1 < 36) commit((blk + 1) & 1);
        __syncthreads();
    }
#undef MF16
}

constexpr int SS_CM = 0, SS_BM = 17408, SS_BST = 34816, SS_XT = 53248, SS_MX = 62464, SS_HB = 71680, SS_CS = 89088, SS_DT = 89344;
__device__ __forceinline__ float bfe(const v4u& v, int i) { const unsigned u = (i < 2) ? v.x : (i < 4) ? v.y : (i < 6) ? v.z : v.w; return (i & 1) ? bfhi(u) : bflo(u); }
__device__ __forceinline__ unsigned short bfraw(const v4u& v, int i) { const unsigned u = (i < 2) ? v.x : (i < 4) ? v.y : (i < 6) ? v.z : v.w; return (unsigned short)((i & 1) ? (u >> 16) : (u & 0xffffu)); }
__device__ __forceinline__ void ssd_scan_fast(KArgs a, int idx, LAS unsigned char* lds, int tid, int lane, int wave) {
    unsigned char* ws = a->ws; const bf16* XBC = (const bf16*)(ws + OFF_XBC); const float* DTA = (const float*)(ws + OFF_DTA);
    const int b = idx / 24, dir = (idx % 24) / 12, h = idx % 12, g = h / 3, q = dir * 12 + h;
    float* Yo = (float*)(ws + OFF_YSSD) + (size_t)dir * TT * 768;
    LAS bf16* Cm = (LAS bf16*)(lds + SS_CM); LAS bf16* Bm = (LAS bf16*)(lds + SS_BM); LAS bf16* BsT = (LAS bf16*)(lds + SS_BST); LAS bf16* XT = (LAS bf16*)(lds + SS_XT);
    LAS bf16* Mx = (LAS bf16*)(lds + SS_MX); LAS bf16* Hb = (LAS bf16*)(lds + SS_HB); LAS float* CS = (LAS float*)(lds + SS_CS); LAS float* DTV = (LAS float*)(lds + SS_DT);
    const int fr = lane & 15, fq = lane >> 4, ss = tid & 63, sc = tid >> 6, tl = wave >> 1, wh = wave & 1;
    { unsigned z = 0u; asm volatile("" : "+v"(z)); for (int i = tid; i < 17408 / 16; i += NTHR) *(LAS v4u*)(lds + SS_HB + i * 16) = (v4u){z, z, z, z}; }
    f32x4 hacc[4];
#pragma unroll
    for (int j = 0; j < 4; ++j) hacc[j] = (f32x4){0.f, 0.f, 0.f, 0.f};
    v4u pc0, pc1, pb0, pb1, px; float pdt = 0.f, pa = 0.f;
    auto issue = [&](int ch) {
        const int tok = ssd_tok(b, dir, ch * 64 + ss); const bf16* row = XBC + (size_t)tok * 1792;
        pc0 = *(const v4u*)(row + 1280 + g * 128 + sc * 8); pc1 = *(const v4u*)(row + 1280 + g * 128 + (sc + 8) * 8);
        pb0 = *(const v4u*)(row + 768 + g * 128 + sc * 8); pb1 = *(const v4u*)(row + 768 + g * 128 + (sc + 8) * 8);
        px = *(const v4u*)(row + h * 64 + sc * 8);
        if (tid < 64) { pdt = DTA[(size_t)tok * 48 + q]; pa = DTA[(size_t)tok * 48 + 24 + q]; }
    };
    issue(0);
    for (int ch = 0; ch < RJ / 64; ++ch) {
        *(LAS v4u*)(Cm + ss * 136 + sc * 8) = pc0; *(LAS v4u*)(Cm + ss * 136 + (sc + 8) * 8) = pc1;
        *(LAS v4u*)(Bm + ss * 136 + sc * 8) = pb0; *(LAS v4u*)(Bm + ss * 136 + (sc + 8) * 8) = pb1;
#pragma unroll
        for (int i = 0; i < 8; ++i) XT[(sc * 8 + i) * 72 + ss] = bfraw(px, i);
        if (tid < 64) { float x = pa;
            x += __int_as_float(__builtin_amdgcn_update_dpp(0, __float_as_int(x), 0x111, 0xf, 0xf, false)); x += __int_as_float(__builtin_amdgcn_update_dpp(0, __float_as_int(x), 0x112, 0xf, 0xf, false));
            x += __int_as_float(__builtin_amdgcn_update_dpp(0, __float_as_int(x), 0x114, 0xf, 0xf, false)); x += __int_as_float(__builtin_amdgcn_update_dpp(0, __float_as_int(x), 0x118, 0xf, 0xf, false));
            x += __int_as_float(__builtin_amdgcn_update_dpp(0, __float_as_int(x), 0x142, 0xa, 0xf, false)); x += __int_as_float(__builtin_amdgcn_update_dpp(0, __float_as_int(x), 0x143, 0xc, 0xf, false));
            CS[tid] = x; DTV[tid] = pdt; }
        __syncthreads();
        const float cl = CS[63];
        { const float scl = DTV[ss] * __expf(cl - CS[ss]);
#pragma unroll
            for (int i = 0; i < 8; ++i) { BsT[(sc * 8 + i) * 72 + ss] = (bf16)f2bf(bfe(pb0, i) * scl); BsT[((sc + 8) * 8 + i) * 72 + ss] = (bf16)f2bf(bfe(pb1, i) * scl); } }
        if (ch + 1 < RJ / 64) issue(ch + 1);
#pragma unroll
        for (int j = 0; j < 2; ++j) { const int tc = wh * 2 + j; f32x4 acc = (f32x4){0.f, 0.f, 0.f, 0.f};
            if (tc <= tl) {
#pragma unroll
                for (int ks = 0; ks < 4; ++ks) { const bf16x8 af = *(const LAS bf16x8*)(Cm + (16 * tl + fr) * 136 + ks * 32 + fq * 8), bf = *(const LAS bf16x8*)(Bm + (16 * tc + fr) * 136 + ks * 32 + fq * 8);
                    acc = __builtin_amdgcn_mfma_f32_16x16x32_bf16(af, bf, acc, 0, 0, 0); } }
            const int s = 16 * tc + fr; const float css = CS[s], dts = DTV[s];
#pragma unroll
            for (int i = 0; i < 4; ++i) { const int l = 16 * tl + 4 * fq + i; const float v = (s <= l) ? acc[i] * __expf(CS[l] - css) * dts : 0.f; Mx[l * 72 + s] = (bf16)f2bf(v); } }
        __syncthreads();
#pragma unroll
        for (int j = 0; j < 2; ++j) { const int tp = wh * 2 + j; f32x4 acc = (f32x4){0.f, 0.f, 0.f, 0.f};
#pragma unroll
            for (int ks = 0; ks < 4; ++ks) { const bf16x8 af = *(const LAS bf16x8*)(Cm + (16 * tl + fr) * 136 + ks * 32 + fq * 8), bf = *(const LAS bf16x8*)(Hb + (16 * tp + fr) * 136 + ks * 32 + fq * 8);
                acc = __builtin_amdgcn_mfma_f32_16x16x32_bf16(af, bf, acc, 0, 0, 0); }
#pragma unroll
            for (int i = 0; i < 4; ++i) acc[i] *= __expf(CS[16 * tl + 4 * fq + i]);
#pragma unroll
            for (int ks = 0; ks < 2; ++ks) { const bf16x8 af = *(const LAS bf16x8*)(Mx + (16 * tl + fr) * 72 + ks * 32 + fq * 8), bf = *(const LAS bf16x8*)(XT + (16 * tp + fr) * 72 + ks * 32 + fq * 8);
                acc = __builtin_amdgcn_mfma_f32_16x16x32_bf16(af, bf, acc, 0, 0, 0); }
#pragma unroll
            for (int i = 0; i < 4; ++i) { const int tok = ssd_tok(b, dir, ch * 64 + 16 * tl + 4 * fq + i); Yo[(size_t)tok * 768 + h * 64 + 16 * tp + fr] = acc[i]; } }
        { const float ecl = __expf(cl);
#pragma unroll
            for (int j = 0; j < 4; ++j) { const int tn = wh * 4 + j; hacc[j] = hacc[j] * ecl;
#pragma unroll
                for (int ks = 0; ks < 2; ++ks) { const bf16x8 af = *(const LAS bf16x8*)(XT + (16 * tl + fr) * 72 + ks * 32 + fq * 8), bf = *(const LAS bf16x8*)(BsT + (16 * tn + fr) * 72 + ks * 32 + fq * 8);
                    hacc[j] = __builtin_amdgcn_mfma_f32_16x16x32_bf16(af, bf, hacc[j], 0, 0, 0); } } }
        __syncthreads();
#pragma unroll
        for (int j = 0; j < 4; ++j) { const int tn = wh * 4 + j;
#pragma unroll
            for (int i = 0; i < 4; ++i) Hb[(16 * tl + 4 * fq + i) * 136 + 16 * tn + fr] = (bf16)f2bf(hacc[j][i]); }
    }
}

constexpr int NPH = 2 + 10 * DEPTH;
#ifndef PROBE_MASK
#define PROBE_MASK 0
#endif
#ifndef PROBE_P0
#define PROBE_P0 0
#endif
#ifndef PROBE_SUB
#define PROBE_SUB 0
#endif
#ifndef PROBE_REPS
#define PROBE_REPS 3
#endif
#define REPS(k) (((PROBE_MASK >> (k)) & 1) ? PROBE_REPS : 1)
constexpr int GATE_LATE = 30;
constexpr int GATE_X = 576, GATE_Z = 304;
#ifndef MK_ONE_LAUNCH
#define MK_ONE_LAUNCH 1
#endif

__global__ void __launch_bounds__(NTHR, 2) fwd(Args a_unused) {
    extern __shared__ __attribute__((aligned(16))) unsigned char lds_raw[];
    LAS unsigned char* lds = (LAS unsigned char*)lds_raw;
    const int bid0 = blockIdx.x, G0 = gridDim.x, wave0 = __builtin_amdgcn_readfirstlane(threadIdx.x >> 6);
#define PH_BG int bid = bid0, G = G0; asm volatile("" : "+s"(bid), "+s"(G));
    volatile LAS unsigned* MISCW = (volatile LAS unsigned*)(lds + MISC_OFF);
    if (threadIdx.x < 32) MISCW[threadIdx.x] = 0u;
    __syncthreads();
    const int ph_lo = kargs()->ph_lo, ph_hi = kargs()->ph_hi;
    const bool multi = (ph_hi - ph_lo) > 1;
    XcdBarrier bar; bar.bar = (unsigned*)(kargs()->ws + OFF_CTL) + CW_BAR; bar.x = 0; bar.st = nullptr; bar.wv = wave0;
    if (multi) bar = xcd_barrier_post((unsigned*)(kargs()->ws + OFF_CTL) + CW_BAR, MISCW + 8, wave0);
#define IN(k) (ph_lo <= (k) && (k) < ph_hi)
#define SEAM(k) do { if (IN(k) && IN((k) + 1)) xcd_barrier(bar); } while (0)

    for (int rep = 0; rep < (PROBE_P0 ? PROBE_REPS : 1); ++rep) {
    if (IN(0)) { PH_BG p0_prologue(kargs(), lds, bid, G, wave0); }
    if (rep + 1 < (PROBE_P0 ? PROBE_REPS : 1)) xcd_barrier(bar); }
    SEAM(0);
    if (IN(1)) { PH_BG KArgs a = kargs(); norm_phase(a, 0, nullptr, a->in[I_NORMG] + 0, nullptr, (const float*)(a->ws + OFF_MODV), bid, G, wave0, TT); }
    SEAM(1);

    for (int l = 0; l < DEPTH; ++l) {
        const int pb = 2 + 10 * l;
#define PH_LOCALS PH_BG KArgs a = kargs(); unsigned char* ws = a->ws; unsigned char* wl = ws + OFF_W + (size_t)l * W_LAYER; bf16* Hb = (bf16*)(ws + OFF_H); (void)wl; (void)Hb; \
        const float* ng = a->in[I_NORMG] + (size_t)l * 4 * DM; const float* mv = (const float*)(ws + OFF_MODV) + (size_t)l * 5 * 12288; (void)ng; (void)mv;
        const bool lastl = (l == DEPTH - 1);
        for (int rep = 0; rep < REPS(0); ++rep) {
        if (IN(pb + 0)) { PH_LOCALS
            __syncthreads();
            pg8::Sched2 S; S.A0 = (const char*)Hb; S.B0 = (const char*)(wl + WO_IN); S.A1 = (const char*)(wl + WO_FFT); S.B1 = (const char*)Hb; S.tstep = (size_t)256 * DM * 2; S.ntk = DM / 64;
            S.t0.init(TT / 256, NU / 256 - GATE_LATE); S.t1.init(4, TT / 256); S.G = G; S.c = bid;
            pg8::EpiIn2 E{pg8::EpiInproj{(bf16*)(ws + OFF_U), (float*)(ws + OFF_MISC), NU}, pg8::EpiBf{0, (bf16*)(ws + OFF_VTL), (bf16*)(ws + OFF_VTC)}};
            pg8::gemm_phase<pg8::EpiIn2, pg8::Sched2, true, true>(lds, DM, S, E, wave0);
        }
        if (rep + 1 < REPS(0)) xcd_barrier(bar); }
        SEAM(pb + 0);
        for (int rep = 0; rep < REPS(1); ++rep) {
        if (IN(pb + 1)) { PH_LOCALS PH_IDS
            __syncthreads();
            if (rep == 0 || PROBE_SUB == 3 || PROBE_SUB == 7) {
            if (bid < 64) { pg8::Sched2 S; S.A0 = (const char*)(ws + OFF_DFTL); S.B0 = (const char*)(ws + OFF_VTL); S.A1 = S.A0; S.B1 = S.B0; S.tstep = (size_t)256 * 4096 * 2; S.ntk = 64; S.t0.init(8, 8); S.t1.init(0, 0); S.G = 64; S.c = bid;
                  pg8::EpiBf E{1, (bf16*)(ws + OFF_ACAT), nullptr};
                  pg8::gemm_phase<pg8::EpiBf, pg8::Sched2, true, true>(lds, 4096, S, E, wave0); }
            else if (bid < 72) { pg8::Sched2 S; S.A0 = (const char*)(ws + OFF_DFTC); S.B0 = (const char*)(ws + OFF_VTC); S.A1 = S.A0; S.B1 = S.B0; S.tstep = (size_t)256 * 512 * 2; S.ntk = 8; S.t0.init(1, 8); S.t1.init(0, 0); S.G = 8; S.c = bid - 64;
                  pg8::EpiBf E{2, (bf16*)(ws + OFF_ACAT), nullptr};
                  pg8::gemm_phase<pg8::EpiBf, pg8::Sched2, true, true>(lds, 512, S, E, wave0); }
            }
            __syncthreads();
            {
                unsigned* qctr = (unsigned*)(ws + OFF_CTL) + CW_Q + (l * 4 + rep) * 64;
                volatile LAS unsigned* qslot = (volatile LAS unsigned*)(lds + MISC_OFF) + 16;
                unsigned qnext = 0u; if (tid == 0) qnext = __hip_atomic_fetch_add(qctr, 1u, __ATOMIC_RELAXED, __HIP_MEMORY_SCOPE_AGENT);
                for (;;) {
                    if (tid == 0) qslot[0] = qnext;
                    __syncthreads();
                    const int it = (int)qslot[0];
                    __syncthreads();
                    if (it >= 576 + 288 + 576) break;
                    if (tid == 0) qnext = __hip_atomic_fetch_add(qctr, 1u, __ATOMIC_RELAXED, __HIP_MEMORY_SCOPE_AGENT);
                    int ln_i = lane; asm volatile("" : "+v"(ln_i)); const int tid_i = wave * 64 + ln_i;
                    const bool pall = (rep == 0 || PROBE_SUB == 7);
                    if (it < 576) { if (pall || PROBE_SUB == 0) rwkv_prep_item(a, l, it, lds, tid_i, ln_i, wave); }
                    else if (it < 576 + 288) { if (pall || PROBE_SUB == 2) conv_item(a, l, it - 576, lds, tid_i, ln_i, wave); }
                    else if (pall || PROBE_SUB == 1) ssd_prep_item(a, l, it - 576 - 288, tid_i);
                }
            }
        }
        if (rep + 1 < REPS(1)) xcd_barrier(bar); }
        SEAM(pb + 1);
        for (int rep = 0; rep < REPS(2); ++rep) {
        if (IN(pb + 2)) { PH_LOCALS PH_IDS
            __syncthreads();
            if (bid < 64) { if (rep == 0 || PROBE_SUB == 0 || PROBE_SUB == 7) rwkv_scan_chunk(a, bid, lds, tid, lane, wave); }
            else if (bid < 160) { if (rep == 0 || PROBE_SUB == 1 || PROBE_SUB == 7) ssd_scan_fast(a, bid - 64, lds, tid, lane, wave); }
            __syncthreads();
            if (rep == 0 || PROBE_SUB == 2 || PROBE_SUB == 7) {
                pg8::Sched2 S; S.A0 = (const char*)Hb; S.B0 = (const char*)(wl + WO_IN); S.A1 = S.A0; S.B1 = S.B0; S.tstep = (size_t)256 * DM * 2; S.ntk = DM / 64;
                S.t0.init(TT / 256, GATE_LATE); S.t1.init(0, 0); S.pn_off0 = NU / 256 - GATE_LATE;
                if (bid >= 160) { S.G = 96; S.c = bid - 160; S.first = 0; S.limit = GATE_X; }
                else if (bid < 64) { S.G = 64; S.c = bid; S.first = GATE_X; S.limit = GATE_X + GATE_Z; }
                else { S.G = 96; S.c = bid - 64; S.first = GATE_X + GATE_Z; S.limit = 36 * GATE_LATE; }
                pg8::EpiIn2 E{pg8::EpiInproj{(bf16*)(ws + OFF_U), (float*)(ws + OFF_MISC), NU}, pg8::EpiBf{0, (bf16*)(ws + OFF_VTL), (bf16*)(ws + OFF_VTC)}};
                pg8::gemm_phase<pg8::EpiIn2, pg8::Sched2, true, true>(lds, DM, S, E, wave0); }
        }
        if (rep + 1 < REPS(2)) xcd_barrier(bar); }
        SEAM(pb + 2);
        for (int rep = 0; rep < REPS(3); ++rep) {
        if (IN(pb + 3)) { PH_BG post_phase(kargs(), l, bid, G, wave0); }
        if (rep + 1 < REPS(3)) xcd_barrier(bar); }
        SEAM(pb + 3);
        for (int rep = 0; rep < REPS(4); ++rep) {
        if (IN(pb + 4)) { PH_LOCALS
            __syncthreads();
            pg8::Sched2 S; S.A0 = (const char*)(ws + OFF_ACAT); S.B0 = (const char*)(wl + WO_CAT); S.A1 = S.A0; S.B1 = S.B0; S.tstep = (size_t)256 * ACW * 2; S.ntk = ACW / 64;
            S.t0.init(lastl ? TLAT / 256 : TT / 256, DM / 256); S.t1.init(0, 0); S.G = G; S.c = bid;
            pg8::EpiChain E{(const bf16*)(ws + OFF_U) + UGATE, NU, (bf16*)(ws + OFF_M)};
            pg8::gemm_phase<pg8::EpiChain, pg8::Sched2, true, true>(lds, ACW, S, E, wave0);
        }
        if (rep + 1 < REPS(4)) xcd_barrier(bar); }
        SEAM(pb + 4);
        for (int rep = 0; rep < REPS(5); ++rep) {
        if (IN(pb + 5)) { PH_LOCALS
            __syncthreads();
            pg8::SchedSplit S; S.A = (const char*)(ws + OFF_M); S.B = (const char*)(wl + WO_O); S.tstep = (size_t)256 * DM * 2; S.ntk = DM / 64; S.tm.init(32, 8); S.nctx = lastl ? 0 : 256; S.G = G; S.c = bid;
            pg8::EpiF32 E{(bf16*)(ws + OFF_Y), (float*)(ws + OFF_YC)};
            pg8::gemm_phase<pg8::EpiF32, pg8::SchedSplit, true, true>(lds, DM, S, E, wave0);
        }
        if (rep + 1 < REPS(5)) xcd_barrier(bar); }
        SEAM(pb + 5);
        if (IN(pb + 6)) { PH_LOCALS norm_phase(a, 1, ng + 1 * DM, ng + 2 * DM, mv + 2 * DM, mv + 3 * DM, bid, G, wave0, lastl ? TLAT : TT, !lastl); }
        SEAM(pb + 6);
        for (int rep = 0; rep < REPS(7); ++rep) {
        if (IN(pb + 7)) { PH_LOCALS
            __syncthreads();
            pg8::Sched2 S; S.A0 = (const char*)Hb; S.B0 = (const char*)(wl + WO_UP); S.A1 = S.A0; S.B1 = S.B0; S.tstep = (size_t)256 * DM * 2; S.ntk = DM / 64;
            S.t0.init(lastl ? TLAT / 256 : TT / 256, DFF / 256); S.t1.init(0, 0); S.G = G; S.c = bid;
            pg8::EpiBf E{3, (bf16*)(ws + OFF_HB), nullptr};
            pg8::gemm_phase<pg8::EpiBf, pg8::Sched2, true, true>(lds, DM, S, E, wave0);
        }
        if (rep + 1 < REPS(7)) xcd_barrier(bar); }
        SEAM(pb + 7);
        for (int rep = 0; rep < REPS(8); ++rep) {
        if (IN(pb + 8)) { PH_LOCALS
            __syncthreads();
            pg8::SchedSplit S; S.A = (const char*)(ws + OFF_HB); S.B = (const char*)(wl + WO_DN); S.tstep = (size_t)256 * DFF * 2; S.ntk = DFF / 64; S.tm.init(32, 8); S.nctx = lastl ? 0 : 256; S.G = G; S.c = bid;
            pg8::EpiF32 E{(bf16*)(ws + OFF_Y), (float*)(ws + OFF_YC)};
            pg8::gemm_phase<pg8::EpiF32, pg8::SchedSplit, true, true>(lds, DFF, S, E, wave0);
        }
        if (rep + 1 < REPS(8)) xcd_barrier(bar); }
        SEAM(pb + 8);
        if (IN(pb + 9)) { PH_LOCALS
            if (!lastl) norm_phase(a, 1, ng + 3 * DM, ng + 4 * DM  , mv + 5 * DM, mv + 5 * 12288  , bid, G, wave0, TT, true);
            else norm_phase(a, 2, ng + 3 * DM, nullptr, mv + 5 * DM, nullptr, bid, G, wave0, TLAT);
        }
        SEAM(pb + 9);
    }
#undef IN
#undef SEAM
}

extern "C" void kernel_launch(void* const* d_in, const int* in_sizes, int n_in, void* d_out, int out_size, void* d_ws, size_t ws_size, hipStream_t stream) {
    static int grid = 0;
    if (grid == 0) {
        if (n_in != N_IN || out_size != TLAT * DM || ws_size < WS_END) { fprintf(stderr, "kernel_launch: unexpected shapes (n_in %d out %d ws %zu); nothing launched\n", n_in, out_size, ws_size); grid = -1; return; }
        int dev = 0, cus = 0;
        if (hipGetDevice(&dev) != hipSuccess || hipDeviceGetAttribute(&cus, hipDeviceAttributeMultiprocessorCount, dev) != hipSuccess) { grid = -1; return; }
        if (hipFuncSetAttribute((const void*)fwd, hipFuncAttributeMaxDynamicSharedMemorySize, LDS_BYTES) != hipSuccess) { fprintf(stderr, "kernel_launch: hipFuncSetAttribute failed\n"); grid = -1; return; }
        int per_cu = 0;
        if (hipOccupancyMaxActiveBlocksPerMultiprocessor(&per_cu, (const void*)fwd, NTHR, LDS_BYTES) != hipSuccess || per_cu < 1) fprintf(stderr, "kernel_launch: occupancy query says %d\n", per_cu);
        (void)hipGetLastError();
        grid = cus;
        if (grid < 232) { fprintf(stderr, "kernel_launch: %d CUs: this kernel's scan phase needs > 160 workgroups\n", grid); grid = -1; return; }
    }
    if (grid < 0) return;
    if (hipMemsetAsync((char*)d_ws + OFF_CTL, 0, CTL_BYTES, stream) != hipSuccess) return;
    Args a{};
    for (int i = 0; i < N_IN; ++i) a.in[i] = (const float*)d_in[i];
    a.out = (float*)d_out; a.ws = (unsigned char*)d_ws;
#if MK_ONE_LAUNCH
    a.ph_lo = 0; a.ph_hi = NPH;
    hipLaunchKernelGGL(fwd, dim3(grid), dim3(NTHR), LDS_BYTES, stream, a);
#else
    for (int p = 0; p < NPH; ++p) { a.ph_lo = p; a.ph_hi = p + 1; hipLaunchKernelGGL(fwd, dim3(grid), dim3(NTHR), LDS_BYTES, stream, a); }
#endif
}
```

```cpp
#include <hip/hip_runtime.h>
#include <cstdio>
#include <cstdint>
namespace pg8 {
#define PG8_LAS __attribute__((address_space(3)))
typedef unsigned short bf16_t;
typedef short bf16x8 __attribute__((ext_vector_type(8)));
typedef float f32x4 __attribute__((ext_vector_type(4)));
typedef unsigned u32x4 __attribute__((ext_vector_type(4)));
constexpr int BM = 256, BK = 64, HALF = 128, HTB = HALF * BK * 2  , STAGE_BYTES = 8 * HTB, NXCD = 8, WGM = 8;

__host__ __device__ __forceinline__ int lds_byte(int r, int c) { const int st = (r >> 4) * 2 + (c >> 5), rr = r & 15, cc = c & 31, ob = rr * 64 + cc * 2; return st * 1024 + (ob ^ (((ob >> 9) & 1) << 5)); }
__host__ __device__ __forceinline__ void stage_rc(int b, int& R, int& C) { const int st = b / 1024, sb = b % 1024, swz = sb ^ (((sb >> 9) & 1) << 5); R = (st >> 1) * 16 + swz / 64; C = (st & 1) * 32 + (swz % 64) / 2; }
__host__ __device__ __forceinline__ int perm32(int rho) { const int n = rho >> 4, i = rho & 15; return 8 * (i >> 2) + 4 * n + (i & 3); }

struct Unit { int pm, pn, kind; };
struct Gemm { const bf16_t* A; const bf16_t* Bt; int M, N, K; };

struct StaticOrder {
    int nM, nN, nwg, G, c;
    __host__ __device__ void init(int M, int N, int G_, int c_) { nM = M / BM; nN = N / BM; nwg = nM * nN; G = G_; c = c_; }
    __host__ __device__ bool next(int i, Unit& u) const {
        const long L = (long)i * G + c; if (L >= nwg) return false;
        int wgid = (int)L; { const int q = nwg / NXCD, r = nwg % NXCD, xcd = wgid % NXCD, off = wgid / NXCD; wgid = (xcd < r ? xcd * (q + 1) : r * (q + 1) + (xcd - r) * q) + off; }
        const int nig = WGM * nN, gid = wgid / nig, fm = gid * WGM, gsz = (nM - fm) < WGM ? (nM - fm) : WGM;
        u.pm = fm + ((wgid % nig) % gsz); u.pn = (wgid % nig) / gsz; return true;
    }
    __device__ __forceinline__ void a_ready(const Unit&) const {}
    __device__ __forceinline__ void done(const Unit&) const {}
};
typedef float f32x2n __attribute__((ext_vector_type(2))); typedef __bf16 bf16x2n __attribute__((ext_vector_type(2)));
__device__ __forceinline__ unsigned cvt_pk_bf16(float lo, float hi) { const bf16x2n r = __builtin_convertvector((f32x2n){lo, hi}, bf16x2n); return __builtin_bit_cast(unsigned, r); }
typedef float f32x2 __attribute__((ext_vector_type(2)));
template <class Epi, class Sched, bool ALIGN_EPI = false, bool SP2 = false>
__device__ __forceinline__ void gemm_phase(PG8_LAS unsigned char* lds, const int ldk  , const Sched& S, const Epi& E, const int wave_id) {
    unsigned z_ = 0u; asm volatile("" : "+v"(z_)); const int lane_ = (int)__builtin_amdgcn_mbcnt_hi(~0u, __builtin_amdgcn_mbcnt_lo(~0u, z_)); int wid_ = wave_id; asm volatile("" : "+s"(wid_)); const int wid = wid_, lane = lane_, tid = wid * 64 + lane, wr = wid >> 2, wc = wid & 3, fr = lane & 15, fq = lane >> 4;
    const int K = ldk; int nt;
    unsigned voffA[2], voffB[2];
#pragma unroll
    for (int i = 0; i < 2; ++i) { int R, C; stage_rc(tid * 16 + i * 8192, R, C); const int Rb = Epi::PERM ? ((R & ~31) + perm32(R & 31)) : R;
        voffA[i] = (unsigned)(R * K + C) * 2u; voffB[i] = (unsigned)(Rb * K + C) * 2u; }
    const size_t kstep = (size_t)(BK * 2);
    const size_t hstep = (size_t)HALF * K * 2;
    const unsigned ldsw = (unsigned)wid * 1024u;
    const int aoff = lds_byte(wr * 64 + fr, fq * 8), boff = lds_byte(wc * 32 + fr, fq * 8);
#define PG8_SA(b, h) (((b) * 2 + (h)) * HTB)
#define PG8_SB(b, h) ((4 + (b) * 2 + (h)) * HTB)
#define PG8_STAGE(bufoff, gbase, voff) do { _Pragma("unroll") for (int _i = 0; _i < 2; ++_i) \
        __builtin_amdgcn_global_load_lds((const unsigned*)((const char*)(gbase) + (voff)[_i]), (PG8_LAS unsigned*)(lds + (bufoff) + ldsw + _i * 8192), 16, 0, 0); } while (0)
#define PG8_LDA(dst, b, h) do { _Pragma("unroll") for (int m = 0; m < 4; ++m) _Pragma("unroll") for (int k = 0; k < 2; ++k) dst[m][k] = *(const PG8_LAS bf16x8*)(lds + PG8_SA(b, h) + aoff + m * 2048 + k * 1024); } while (0)
#define PG8_LDB(dst, b, h) do { _Pragma("unroll") for (int n = 0; n < 2; ++n) _Pragma("unroll") for (int k = 0; k < 2; ++k) dst[n][k] = *(const PG8_LAS bf16x8*)(lds + PG8_SB(b, h) + boff + n * 2048 + k * 1024); } while (0)
#define PG8_MMA(ai, bj, At, Bt) do { __builtin_amdgcn_s_setprio(1); _Pragma("unroll") for (int m = 0; m < 4; ++m) _Pragma("unroll") for (int n = 0; n < 2; ++n) _Pragma("unroll") for (int k = 0; k < 2; ++k) \
        acc[ai][bj][m][n] = __builtin_amdgcn_mfma_f32_16x16x32_bf16(Bt[n][k], At[m][k], acc[ai][bj][m][n], 0, 0, 0); __builtin_amdgcn_s_setprio(0); } while (0)
#define PG8_WAIT_V(n) asm volatile("s_waitcnt vmcnt(" #n ")" ::: "memory")
#define PG8_WAIT_L(n) asm volatile("s_waitcnt lgkmcnt(" #n ")" ::: "memory")
#define PG8_BAR __builtin_amdgcn_s_barrier()
#define PG8_SCHED __builtin_amdgcn_sched_barrier(0)
    Unit cur, nxt; int ui = 0;
    if (!S.next(0, cur)) return;
    f32x4 acc[2][2][4][2];
#pragma unroll
    for (int a = 0; a < 2; ++a)
#pragma unroll
        for (int b = 0; b < 2; ++b)
#pragma unroll
            for (int m = 0; m < 4; ++m)
#pragma unroll
                for (int n = 0; n < 2; ++n) acc[a][b][m][n] = (f32x4){0.f, 0.f, 0.f, 0.f};
    bf16x8 At[4][2], B0[2][2], B1[2][2];
    const char* cA = S.abase(cur); const char* cB = S.bbase(cur); nt = S.nt(cur);
    S.a_ready(cur);
    if constexpr (SP2) {
        PG8_STAGE(PG8_SB(0, 0), cB, voffB); PG8_STAGE(PG8_SB(0, 1), cB + hstep, voffB); PG8_STAGE(PG8_SA(0, 0), cA, voffA); PG8_STAGE(PG8_SA(0, 1), cA + hstep, voffA);
        if (wr == 1) PG8_BAR;
        PG8_WAIT_V(2); PG8_BAR;
        PG8_STAGE(PG8_SB(1, 0), cB + kstep, voffB); PG8_STAGE(PG8_SA(1, 0), cA + kstep, voffA); PG8_STAGE(PG8_SB(1, 1), cB + hstep + kstep, voffB);
        PG8_WAIT_V(6); PG8_BAR;
    } else {
        PG8_STAGE(PG8_SB(0, 0), cB, voffB); PG8_STAGE(PG8_SA(0, 0), cA, voffA); PG8_STAGE(PG8_SB(0, 1), cB + hstep, voffB); PG8_STAGE(PG8_SA(0, 1), cA + hstep, voffA);
        if (wr == 1) PG8_BAR;
        PG8_WAIT_V(4); PG8_BAR;
        PG8_STAGE(PG8_SB(1, 0), cB + kstep, voffB); PG8_STAGE(PG8_SA(1, 0), cA + kstep, voffA); PG8_STAGE(PG8_SB(1, 1), cB + hstep + kstep, voffB);
        PG8_WAIT_V(6); PG8_BAR;
    }
    for (;;) {
        const bool has_next = S.next(ui + 1, nxt);
        const char* nA = has_next ? S.abase(nxt) : cA; const char* nB = has_next ? S.bbase(nxt) : cB;
        for (int t = 0; t < nt; t += 2) {
            const bool last = (t == nt - 2);
            const char* a1 = cA + (size_t)(t + 1) * kstep;
            const char* a2 = last ? nA : cA + (size_t)(t + 2) * kstep; const char* b2 = last ? nB : cB + (size_t)(t + 2) * kstep;
            const char* a3 = a2 + kstep; const char* b3 = b2 + kstep;
            if (last && has_next) S.a_ready(nxt);
            if constexpr (Epi::HOOK) E.khook(acc, cur, t, wr, wc, fr, fq);
            if constexpr (SP2) {
            PG8_LDB(B0, 0, 0); PG8_LDB(B1, 0, 1); PG8_SCHED; PG8_LDA(At, 0, 0); PG8_STAGE(PG8_SA(1, 1), a1 + hstep, voffA);
            PG8_WAIT_V(8); PG8_WAIT_L(0); PG8_BAR; PG8_MMA(0, 0, At, B0); PG8_MMA(0, 1, At, B1); PG8_BAR; PG8_SCHED;
            PG8_LDA(At, 0, 1); PG8_STAGE(PG8_SB(0, 0), b2, voffB); PG8_STAGE(PG8_SB(0, 1), b2 + hstep, voffB); PG8_STAGE(PG8_SA(0, 0), a2, voffA);
            PG8_WAIT_V(8); PG8_WAIT_L(0); PG8_BAR; PG8_MMA(1, 0, At, B0); PG8_MMA(1, 1, At, B1); PG8_BAR; PG8_SCHED;
            PG8_LDB(B0, 1, 0); PG8_LDB(B1, 1, 1); PG8_SCHED; PG8_LDA(At, 1, 0); PG8_STAGE(PG8_SA(0, 1), a2 + hstep, voffA);
            PG8_WAIT_V(8); PG8_WAIT_L(0); PG8_BAR; PG8_MMA(0, 0, At, B0); PG8_MMA(0, 1, At, B1); PG8_BAR; PG8_SCHED;
            PG8_LDA(At, 1, 1); PG8_STAGE(PG8_SB(1, 0), b3, voffB); PG8_STAGE(PG8_SB(1, 1), b3 + hstep, voffB); PG8_STAGE(PG8_SA(1, 0), a3, voffA);
            PG8_WAIT_V(8); PG8_WAIT_L(0); PG8_BAR; PG8_MMA(1, 0, At, B0); PG8_MMA(1, 1, At, B1); PG8_BAR; PG8_SCHED;
            } else {
            PG8_LDB(B0, 0, 0); PG8_SCHED; PG8_LDA(At, 0, 0); PG8_STAGE(PG8_SA(1, 1), a1 + hstep, voffA);
            PG8_WAIT_L(8); PG8_BAR; PG8_WAIT_L(0); PG8_MMA(0, 0, At, B0); PG8_BAR; PG8_SCHED;
            PG8_LDB(B1, 0, 1); PG8_STAGE(PG8_SB(0, 0), b2, voffB);
            PG8_BAR; PG8_WAIT_L(0); PG8_MMA(0, 1, At, B1); PG8_BAR;
            PG8_LDA(At, 0, 1); PG8_STAGE(PG8_SA(0, 0), a2, voffA);
            PG8_BAR; PG8_WAIT_L(0); PG8_MMA(1, 0, At, B0); PG8_BAR; PG8_SCHED;
            PG8_STAGE(PG8_SB(0, 1), b2 + hstep, voffB);
            PG8_WAIT_V(6); PG8_BAR; PG8_MMA(1, 1, At, B1); PG8_BAR;
            PG8_LDB(B0, 1, 0); PG8_SCHED; PG8_LDA(At, 1, 0); PG8_STAGE(PG8_SA(0, 1), a2 + hstep, voffA);
            PG8_WAIT_L(8); PG8_BAR; PG8_WAIT_L(0); PG8_MMA(0, 0, At, B0); PG8_BAR; PG8_SCHED;
            PG8_LDB(B1, 1, 1); PG8_STAGE(PG8_SB(1, 0), b3, voffB);
            PG8_BAR; PG8_WAIT_L(0); PG8_MMA(0, 1, At, B1); PG8_BAR;
            PG8_LDA(At, 1, 1); PG8_STAGE(PG8_SA(1, 0), a3, voffA);
            PG8_BAR; PG8_WAIT_L(0); PG8_MMA(1, 0, At, B0); PG8_BAR; PG8_SCHED;
            PG8_STAGE(PG8_SB(1, 1), b3 + hstep, voffB);
            PG8_WAIT_V(6); PG8_BAR; PG8_MMA(1, 1, At, B1); PG8_BAR;
            }
        }
        if constexpr (ALIGN_EPI) { if (wr == 0) PG8_BAR; }
        if constexpr (!Epi::AFTER_DRAIN) { E(acc, cur, wr, wc, fr, fq); S.done(cur); }
        if (!has_next) break;
#pragma unroll
        for (int a = 0; a < 2; ++a)
#pragma unroll
            for (int b = 0; b < 2; ++b)
#pragma unroll
                for (int m = 0; m < 4; ++m)
#pragma unroll
                    for (int n = 0; n < 2; ++n) acc[a][b][m][n] = (f32x4){0.f, 0.f, 0.f, 0.f};
        cur = nxt; cA = nA; cB = nB; ++ui; nt = S.nt(cur);
        if constexpr (ALIGN_EPI) { if (wr == 1) PG8_BAR; }
    }
    PG8_WAIT_V(0);
    if constexpr (!ALIGN_EPI) { if (wr == 0) PG8_BAR; }
    PG8_BAR;
    if constexpr (Epi::AFTER_DRAIN) { E.fused(acc, cur, wr, wc, fr, fq, lds, wid, lane); S.done(cur); }
#undef PG8_SA
#undef PG8_SB
#undef PG8_STAGE
#undef PG8_LDA
#undef PG8_LDB
#undef PG8_MMA
#undef PG8_WAIT_V
#undef PG8_WAIT_L
#undef PG8_BAR
#undef PG8_SCHED
}
}

namespace pg8 {
__device__ __forceinline__ float sigm(float x) { return __builtin_amdgcn_rcpf(1.f + __expf(-x)); }
__device__ __forceinline__ f32x4 sigm4(f32x4 v) { return (f32x4){sigm(v[0]), sigm(v[1]), sigm(v[2]), sigm(v[3])}; }
__device__ __forceinline__ u32x4 pack8(f32x4 v0, f32x4 v1) { u32x4 w; w.x = cvt_pk_bf16(v0[0], v0[1]); w.y = cvt_pk_bf16(v0[2], v0[3]); w.z = cvt_pk_bf16(v1[0], v1[1]); w.w = cvt_pk_bf16(v1[2], v1[3]); return w; }
__device__ __forceinline__ float bflo(unsigned u) { return __uint_as_float(u << 16); }
__device__ __forceinline__ float bfhi(unsigned u) { return __uint_as_float(u & 0xffff0000u); }


struct TileMap {
    int nM, nN, nwg;
    __device__ __forceinline__ void init(int nM_, int nN_) { nM = nM_; nN = nN_; nwg = nM_ * nN_; }
    __device__ __forceinline__ void map(int L, int& pm, int& pn) const {
        int wgid = L; { const int q = nwg / NXCD, r = nwg % NXCD, xcd = wgid % NXCD, off = wgid / NXCD; wgid = (xcd < r ? xcd * (q + 1) : r * (q + 1) + (xcd - r) * q) + off; }
        const int nig = WGM * nN, gid = wgid / nig, fm = gid * WGM, gsz = (nM - fm) < WGM ? (nM - fm) : WGM;
        pm = fm + ((wgid % nig) % gsz); pn = (wgid % nig) / gsz;
    }
};
struct Sched2 {
    const char *A0, *B0, *A1, *B1; size_t tstep; int ntk; TileMap t0, t1; int G, c;
    int pn_off0 = 0, first = 0, limit = 0x7fffffff;
    __device__ __forceinline__ bool next(int i, Unit& u) const { const int L = first + i * G + c;
        if (L >= limit) return false;
        if (L < t0.nwg) { t0.map(L, u.pm, u.pn); u.pn += pn_off0; u.kind = 0; return true; }
        if (L - t0.nwg < t1.nwg) { t1.map(L - t0.nwg, u.pm, u.pn); u.kind = 1; return true; }
        return false; }
    __device__ __forceinline__ const char* abase(const Unit& u) const { return (u.kind ? A1 : A0) + (size_t)u.pm * tstep; }
    __device__ __forceinline__ const char* bbase(const Unit& u) const { return (u.kind ? B1 : B0) + (size_t)u.pn * tstep; }
    __device__ __forceinline__ int nt(const Unit&) const { return ntk; }
    __device__ __forceinline__ void a_ready(const Unit&) const {}
    __device__ __forceinline__ void done(const Unit&) const {}
};
struct SchedSplit {
    const char *A, *B; size_t tstep; int ntk; TileMap tm; int nctx, G, c;
    __device__ __forceinline__ bool next(int i, Unit& u) const { const int L = i * G + c;
        if (L < 256) { tm.map(L, u.pm, u.pn); u.kind = 0; return true; }
        const int e = L - 256; if (e < nctx) { const int tile = e & 31; u.pm = 32 + (tile >> 3); u.pn = tile & 7; u.kind = 1 + (e >> 5); return true; }
        return false; }
    __device__ __forceinline__ const char* abase(const Unit& u) const { return A + (size_t)u.pm * tstep + (u.kind ? (size_t)(u.kind - 1) * (ntk / 8) * 128 : 0); }
    __device__ __forceinline__ const char* bbase(const Unit& u) const { return B + (size_t)u.pn * tstep + (u.kind ? (size_t)(u.kind - 1) * (ntk / 8) * 128 : 0); }
    __device__ __forceinline__ int nt(const Unit& u) const { return u.kind ? ntk / 8 : ntk; }
    __device__ __forceinline__ void a_ready(const Unit&) const {}
    __device__ __forceinline__ void done(const Unit&) const {}
};
struct EpiInproj {
    static constexpr bool PERM = true, AFTER_DRAIN = false, HOOK = false;
    bf16_t* U; float* MISC; int ldu;
    __device__ __forceinline__ void operator()(const f32x4 (&acc)[2][2][4][2], const Unit& u, int wr, int wc, int fr, int fq) const {
        const int row0 = u.pm * BM + wr * 64 + fr, cl = wc * 32 + 8 * fq;
        if (u.pn == 16 || u.pn == 17) {
#pragma unroll
            for (int ai = 0; ai < 2; ++ai)
#pragma unroll
                for (int m = 0; m < 4; ++m) { float* rowp = MISC + (size_t)(row0 + ai * HALF + m * 16) * 512 + (u.pn - 16) * BM + cl;
#pragma unroll
                    for (int bj = 0; bj < 2; ++bj) { *(f32x4*)(rowp + bj * HALF) = acc[ai][bj][m][0]; *(f32x4*)(rowp + bj * HALF + 4) = acc[ai][bj][m][1]; } }
        } else {
            const bool sg = u.pn >= 22;
#pragma unroll
            for (int ai = 0; ai < 2; ++ai)
#pragma unroll
                for (int m = 0; m < 4; ++m) { bf16_t* rowp = U + (size_t)(row0 + ai * HALF + m * 16) * ldu + u.pn * BM + cl;
#pragma unroll
                    for (int bj = 0; bj < 2; ++bj) { f32x4 v0 = acc[ai][bj][m][0], v1 = acc[ai][bj][m][1];
                        if (sg) { v0 = sigm4(v0); v1 = sigm4(v1); }
                        *(u32x4*)(rowp + bj * HALF) = pack8(v0, v1); } }
        }
    }
};
struct EpiBf {
    static constexpr bool PERM = true, AFTER_DRAIN = false, HOOK = false;
    int kind; bf16_t* O0; bf16_t* O1;
    __device__ __forceinline__ void operator()(const f32x4 (&acc)[2][2][4][2], const Unit& u, int wr, int wc, int fr, int fq) const {
        bf16_t* base; size_t pitch;
        if (kind == 0) {
            const int half = u.pm >> 1, chb = (u.pm & 1) * 256;
            if (u.pn < 32) { const int b = u.pn >> 3, l0 = (u.pn & 7) * 256; pitch = 4096; base = O0 + ((size_t)(b * 512 + chb) * 2 + half) * 2048 + l0; }
            else { const int b = u.pn - 32; pitch = 512; base = O1 + ((size_t)(b * 512 + chb) * 2 + half) * 256; }
        } else if (kind == 1) { const int b = u.pn >> 1; pitch = 2304; base = O0 + (size_t)(b * 2048 + u.pm * 256) * 2304 + 1280 + (u.pn & 1) * 256; }
        else if (kind == 2) { const int b = u.pn >> 1; pitch = 2304; base = O0 + (size_t)(8192 + b * 256) * 2304 + 1280 + (u.pn & 1) * 256; }
        else { pitch = 8192; base = O0 + (size_t)(u.pm * 256) * 8192 + u.pn * 256; }
        const int r0 = wr * 64 + fr, cl = wc * 32 + 8 * fq;
#pragma unroll
        for (int ai = 0; ai < 2; ++ai)
#pragma unroll
            for (int m = 0; m < 4; ++m) { bf16_t* rowp = base + (size_t)(r0 + ai * HALF + m * 16) * pitch + cl;
#pragma unroll
                for (int bj = 0; bj < 2; ++bj) { f32x4 v0 = acc[ai][bj][m][0], v1 = acc[ai][bj][m][1];
                    if (kind == 3) { v0 = __builtin_elementwise_max(v0, (f32x4){0.f, 0.f, 0.f, 0.f}); v1 = __builtin_elementwise_max(v1, (f32x4){0.f, 0.f, 0.f, 0.f}); v0 = v0 * v0; v1 = v1 * v1; }
                    *(u32x4*)(rowp + bj * HALF) = pack8(v0, v1); } }
    }
};
struct EpiChain {
    static constexpr bool PERM = true, AFTER_DRAIN = false, HOOK = true;
    const bf16_t* G; int ldg; bf16_t* Mo;
    __device__ __forceinline__ void khook(f32x4 (&acc)[2][2][4][2], const Unit& u, int t, int wr, int wc, int fr, int fq) const {
        if (t != 8 && t != 20 && t != 28) return;
        const int i = (t == 8) ? 0 : (t == 20 ? 1 : 2);
        int row0 = u.pm * BM + wr * 64 + fr; const int col0 = u.pn * BM + wc * 32 + 8 * fq + i * 2048;
        asm volatile("" : "+v"(row0));
#pragma unroll
        for (int ai = 0; ai < 2; ++ai) {
            u32x4 gv[4][2], hv[4][2];
#pragma unroll
            for (int m = 0; m < 4; ++m) { const bf16_t* gp = G + (size_t)(row0 + ai * HALF + m * 16) * ldg + col0;
#pragma unroll
                for (int bj = 0; bj < 2; ++bj) { gv[m][bj] = *(const u32x4*)(gp + bj * HALF); hv[m][bj] = *(const u32x4*)(gp + bj * HALF + 2048); } }
            asm volatile("" ::: "memory");
#pragma unroll
            for (int m = 0; m < 4; ++m)
#pragma unroll
                for (int bj = 0; bj < 2; ++bj) { const u32x4 g = gv[m][bj], h = hv[m][bj];
                    const unsigned gw[4] = {g.x, g.y, g.z, g.w}, hw[4] = {h.x, h.y, h.z, h.w};
#pragma unroll
                    for (int e2 = 0; e2 < 4; ++e2) { const float r0 = fmaxf(bflo(gw[e2]), 1e-6f) * __builtin_amdgcn_rcpf(fmaxf(bflo(hw[e2]), 1e-6f)), r1 = fmaxf(bfhi(gw[e2]), 1e-6f) * __builtin_amdgcn_rcpf(fmaxf(bfhi(hw[e2]), 1e-6f));
                        acc[ai][bj][m][e2 >> 1][(e2 & 1) * 2] *= r0; acc[ai][bj][m][e2 >> 1][(e2 & 1) * 2 + 1] *= r1; } }
            asm volatile("" ::: "memory");
        }
    }
    __device__ __forceinline__ void operator()(const f32x4 (&acc)[2][2][4][2], const Unit& u, int wr, int wc, int fr, int fq) const {
        const int row0 = u.pm * BM + wr * 64 + fr, col0 = u.pn * BM + wc * 32 + 8 * fq;
#pragma unroll
        for (int ai = 0; ai < 2; ++ai) {
            u32x4 gv[4][2];
#pragma unroll
            for (int m = 0; m < 4; ++m)
#pragma unroll
                for (int bj = 0; bj < 2; ++bj) gv[m][bj] = *(const u32x4*)(G + (size_t)(row0 + ai * HALF + m * 16) * ldg + col0 + bj * HALF + 3 * 2048);
            asm volatile("" ::: "memory");
#pragma unroll
            for (int m = 0; m < 4; ++m) { const size_t row = (size_t)(row0 + ai * HALF + m * 16);
#pragma unroll
                for (int bj = 0; bj < 2; ++bj) { const int col = col0 + bj * HALF; const u32x4 g = gv[m][bj];
                    const f32x4 v0 = acc[ai][bj][m][0] * (f32x4){fmaxf(bflo(g.x), 1e-6f), fmaxf(bfhi(g.x), 1e-6f), fmaxf(bflo(g.y), 1e-6f), fmaxf(bfhi(g.y), 1e-6f)};
                    const f32x4 v1 = acc[ai][bj][m][1] * (f32x4){fmaxf(bflo(g.z), 1e-6f), fmaxf(bfhi(g.z), 1e-6f), fmaxf(bflo(g.w), 1e-6f), fmaxf(bfhi(g.w), 1e-6f)};
                    *(u32x4*)(Mo + row * 2048 + col) = pack8(v0, v1); } }
        }
    }
};
struct EpiF32 {
    static constexpr bool PERM = true, AFTER_DRAIN = false, HOOK = false;
    bf16_t* C; float* YC;
    __device__ __forceinline__ void operator()(const f32x4 (&acc)[2][2][4][2], const Unit& u, int wr, int wc, int fr, int fq) const {
        const int row0 = u.pm * BM + wr * 64 + fr, col0 = u.pn * BM + wc * 32 + 8 * fq;
        if (u.kind == 0) {
#pragma unroll
            for (int ai = 0; ai < 2; ++ai)
#pragma unroll
                for (int m = 0; m < 4; ++m) { bf16_t* rowp = C + (size_t)(row0 + ai * HALF + m * 16) * 2048 + col0;
#pragma unroll
                    for (int bj = 0; bj < 2; ++bj) *(u32x4*)(rowp + bj * HALF) = pack8(acc[ai][bj][m][0], acc[ai][bj][m][1]); }
        } else {
            float* base = YC + (size_t)(u.kind - 1) * 1024 * 2048 + (size_t)(row0 - 8192) * 2048 + col0;
#pragma unroll
            for (int ai = 0; ai < 2; ++ai)
#pragma unroll
                for (int m = 0; m < 4; ++m) { float* rowp = base + (size_t)(ai * HALF + m * 16) * 2048;
#pragma unroll
                    for (int bj = 0; bj < 2; ++bj) { *(f32x4*)(rowp + bj * HALF) = acc[ai][bj][m][0]; *(f32x4*)(rowp + bj * HALF + 4) = acc[ai][bj][m][1]; } }
        }
    }
};
struct EpiIn2 {
    static constexpr bool PERM = true, AFTER_DRAIN = false, HOOK = false;
    EpiInproj e0; EpiBf e1;
    __device__ __forceinline__ void operator()(const f32x4 (&acc)[2][2][4][2], const Unit& u, int wr, int wc, int fr, int fq) const { if (u.kind == 0) e0(acc, u, wr, wc, fr, fq); else e1(acc, u, wr, wc, fr, fq); }
};
}

#define GAS __attribute__((address_space(1)))
#define LAS __attribute__((address_space(3)))
typedef unsigned short bf16;
typedef unsigned v4u __attribute__((ext_vector_type(4)));
typedef unsigned v2u __attribute__((ext_vector_type(2)));
typedef float f32x4 __attribute__((ext_vector_type(4)));
typedef float f32x2 __attribute__((ext_vector_type(2)));
constexpr int NWAVES = 8, NTHR = 512;
constexpr int DM = 2048, NBATCH = 4, LSEQ = 2048, LCTX = 256, DEPTH = 4;
constexpr int TLAT = NBATCH * LSEQ, TCTX = NBATCH * LCTX, TT = TLAT + TCTX;
constexpr int IN_DIM = 14168, DFF = 8192;
constexpr int NU = 13824;
constexpr int UZ = 0, UXBC = 768, URKV = 2560, UMISC = 4096, UCONV = 4608, UGATE = 5632;
constexpr int S_RKV = 2584, S_DT = 2560, S_WF = 4120, S_CONV = 4440, S_FFT = 5464, S_GATE = 5976;
constexpr int RJ = LCTX + LSEQ;
enum { I_X = 0, I_C, I_CTX, I_CCTX, I_MODW, I_MODB, I_NORMG, I_WIN, I_CONVW, I_CONVB, I_CLNG, I_CLNB, I_CONVOUT, I_SCW, I_SCB, I_SALOG, I_SDTB, I_SD, I_SNG, I_SOUT,
       I_FOUT, I_RMU, I_RW0, I_RW2, I_RA0, I_RA2, I_RG2, I_RKK, I_RKA, I_RRK, I_RLNG, I_RLNB, I_ROUT, I_WO, I_UP, I_DOWN, N_IN };
constexpr size_t MiB = 1u << 20;
constexpr size_t OFF_CTL = 0, CTL_BYTES = 1 * MiB;
constexpr size_t OFF_MODV = 1 * MiB;
constexpr size_t OFF_DFTL = 2 * MiB;
constexpr size_t OFF_DFTC = 18 * MiB;
constexpr size_t OFF_W = 20 * MiB, W_LAYER = 139 * MiB;
constexpr size_t WO_IN = 0, WO_FFT = 54 * MiB, WO_CAT = 58 * MiB  , WO_O = 67 * MiB, WO_UP = 75 * MiB, WO_DN = 107 * MiB;
constexpr size_t OFF_X = 576 * MiB;
constexpr size_t OFF_H = 648 * MiB;
constexpr size_t OFF_U = 684 * MiB;
constexpr size_t OFF_HB = OFF_U;
constexpr size_t OFF_MISC = 927 * MiB;
constexpr size_t OFF_VTL = 945 * MiB;
constexpr size_t OFF_VTC = 961 * MiB;
constexpr size_t OFF_ACAT = 963 * MiB;
constexpr int AC_CONV = 0, AC_SSD = 512, AC_FFT = 1280, AC_RWKV = 1792, ACW = 2304;
constexpr size_t OFF_XBC = 1004 * MiB;
constexpr size_t OFF_DTA = 1036 * MiB;
constexpr size_t OFF_YSSD = 1038 * MiB;
constexpr size_t OFF_RW = 1092 * MiB, RW_ARR = 18 * MiB;
constexpr size_t OFF_RCH = OFF_RW;
constexpr size_t OFF_RSC = 1254 * MiB;
constexpr size_t OFF_YRW = 1255 * MiB;
constexpr size_t OFF_MBUF = 1291 * MiB;
constexpr size_t OFF_M = 1363 * MiB;
constexpr size_t OFF_Y = 1399 * MiB;
constexpr size_t OFF_WLT = 1471 * MiB;
constexpr size_t OFF_YC = 1473 * MiB;
constexpr size_t WS_END = 1537 * MiB;
constexpr int CW_Q = 8192;
constexpr int CW_BAR = 4096;
constexpr int RING_BYTES = 131072, MISC_OFF = RING_BYTES + 320, LDS_BYTES = 147456;

__device__ __forceinline__ float bf2f(unsigned short b) { return __uint_as_float((unsigned)b << 16); }
__device__ __forceinline__ float bflo(unsigned u) { return __uint_as_float(u << 16); }
__device__ __forceinline__ float bfhi(unsigned u) { return __uint_as_float(u & 0xffff0000u); }
__device__ __forceinline__ unsigned f2bf(float f) { unsigned u = __builtin_bit_cast(unsigned, f); return (u + 0x7fffu + ((u >> 16) & 1u)) >> 16; }
typedef __bf16 bf16x2_t __attribute__((ext_vector_type(2)));
__device__ __forceinline__ unsigned pk2(float lo, float hi) { const bf16x2_t r = __builtin_convertvector((f32x2){lo, hi}, bf16x2_t); return __builtin_bit_cast(unsigned, r); }
__device__ __forceinline__ float sigmoidf_(float x) { return __builtin_amdgcn_rcpf(1.f + __expf(-x)); }
__device__ __forceinline__ float siluf_(float x) { return x * __builtin_amdgcn_rcpf(1.f + __expf(-x)); }
__device__ __forceinline__ float softplusf_(float x) { return fmaxf(x, 0.f) + __logf(1.f + __expf(-fabsf(x))); }
__device__ __forceinline__ bf16 bf1(float x) { return (bf16)(pk2(x, x) & 0xffffu); }
template <int CTRL> __device__ __forceinline__ float dpp_add(float x) { return x + __int_as_float(__builtin_amdgcn_update_dpp(0, __float_as_int(x), CTRL, 0xf, 0xf, true)); }
__device__ __forceinline__ float sum8(float x) { x = dpp_add<0xB1>(x); x = dpp_add<0x4E>(x); x = dpp_add<0x141>(x); return x; }
__device__ __forceinline__ float row16_sum(float x) { x = sum8(x); x = dpp_add<0x140>(x); return x; }
__device__ __forceinline__ float wave_sum(float v) {
    const float r = row16_sum(v);
    return (__int_as_float(__builtin_amdgcn_readlane(__float_as_int(r), 0)) + __int_as_float(__builtin_amdgcn_readlane(__float_as_int(r), 16))) +
           (__int_as_float(__builtin_amdgcn_readlane(__float_as_int(r), 32)) + __int_as_float(__builtin_amdgcn_readlane(__float_as_int(r), 48)));
}
#define LDS_WAIT() asm volatile("s_waitcnt lgkmcnt(0)" ::: "memory")

struct Args { const float* in[N_IN]; float* out; unsigned char* ws; int ph_lo, ph_hi; };
typedef const __attribute__((address_space(4))) Args* KArgs;
__device__ __forceinline__ KArgs kargs() { KArgs p = (KArgs)__builtin_amdgcn_kernarg_segment_ptr(); asm volatile("" : "+s"(p)); return p; }
#define PH_IDS unsigned z_ = 0u; asm volatile("" : "+v"(z_)); const int lane_ = (int)__builtin_amdgcn_mbcnt_hi(~0u, __builtin_amdgcn_mbcnt_lo(~0u, z_)); int wv_ = wave0; asm volatile("" : "+s"(wv_)); const int lane = lane_, wave = wv_, tid = wv_ * 64 + lane_; (void)lane; (void)wave; (void)tid;

__device__ __forceinline__ int inmap(int n) {
    if (n < 2560) return n;
    if (n < 4096) return S_RKV + (n - 2560);
    if (n < 4608) { const int m = n - 4096; if (m < 24) return S_DT + m; if (m < 64) return -1; if (m < 384) return S_WF + (m - 64); return -1; }
    if (n < 5632) return S_CONV + (n - 4608);
    return S_GATE + (n - 5632);
}
__device__ __forceinline__ int rwkv_tok(int b, int j) { if (j < LCTX) return TLAT + b * LCTX + j; const int s = j - LCTX; return b * LSEQ + (s & 31) * 64 + (s >> 5); }

__device__ __forceinline__ void transpose_item(const float* W, int ldw, int Nsrc, bf16* WT, int k0, int n0, bool mapped, LAS float* scr, int lane, int koff = 0) {
    const int n4 = (lane & 7) * 4; const int sc = mapped ? inmap(n0 + n4) : (n0 + n4);
    f32x4 v[8];
#pragma unroll
    for (int i = 0; i < 8; ++i) { const int kk = 8 * i + (lane >> 3); v[i] = (sc >= 0) ? *(const f32x4*)(W + (size_t)(k0 + kk) * Nsrc + sc) : (f32x4){0.f, 0.f, 0.f, 0.f}; }
#pragma unroll
    for (int i = 0; i < 8; ++i) { const int kk = 8 * i + (lane >> 3); LAS float* d = scr + kk * 33 + n4; d[0] = v[i].x; d[1] = v[i].y; d[2] = v[i].z; d[3] = v[i].w; }
    LDS_WAIT();
    const int c = lane & 7;
#pragma unroll
    for (int j = 0; j < 4; ++j) { const int n = (lane >> 3) + 8 * j; const LAS float* s = scr + (8 * c) * 33 + n;
        v4u o; o.x = pk2(s[0 * 33], s[1 * 33]); o.y = pk2(s[2 * 33], s[3 * 33]); o.z = pk2(s[4 * 33], s[5 * 33]); o.w = pk2(s[6 * 33], s[7 * 33]);
        *(v4u*)(WT + (size_t)(n0 + n) * ldw + koff + k0 + 8 * c) = o; }
    LDS_WAIT();
}
constexpr int IT_IN = 32 * (NU / 32), IT_CO = 8 * 64, IT_SO = 12 * 64, IT_FO = 8 * 64, IT_RO = 8 * 64, IT_O = 32 * 64, IT_UP = 32 * 256, IT_DN = 128 * 64;
constexpr int IT_LAYER = IT_IN + IT_CO + IT_SO + IT_FO + IT_RO + IT_O + IT_UP + IT_DN;

__device__ __forceinline__ void p0_prologue(KArgs a, LAS unsigned char* lds, int bid, int G, const int wave0) {
    PH_IDS
    unsigned char* ws = a->ws;
    {
        LAS float* sc = (LAS float*)lds;
        LAS float* part = (LAS float*)(lds + 40960);
        for (int i = tid; i < 5 * DM; i += NTHR) { const float v = (i < 4 * DM) ? a->in[I_C][i] : a->in[I_CCTX][i - 4 * DM]; sc[i] = siluf_(v); }
        __syncthreads();
        float* MODV = (float*)(ws + OFF_MODV);
        for (int it = bid; it < DEPTH * 192; it += G) {
            const int l = it / 192, j = (it % 192) * 64 + lane;
            const float* wp = a->in[I_MODW] + (size_t)l * DM * 12288 + (size_t)(wave * 256) * 12288 + j;
            float acc[5] = {0.f, 0.f, 0.f, 0.f, 0.f};
#pragma unroll 1
            for (int k0 = 0; k0 < 256; k0 += 32) { float w[32];
#pragma unroll
                for (int k = 0; k < 32; ++k) w[k] = wp[(size_t)(k0 + k) * 12288];
#pragma unroll
                for (int k = 0; k < 32; ++k)
#pragma unroll
                    for (int r = 0; r < 5; ++r) acc[r] += sc[r * DM + wave * 256 + k0 + k] * w[k]; }
#pragma unroll
            for (int r = 0; r < 5; ++r) part[(wave * 5 + r) * 64 + lane] = acc[r];
            __syncthreads();
            if (tid < 320) { const int r = tid >> 6, jj = tid & 63; float s = 0.f;
#pragma unroll
                for (int w = 0; w < 8; ++w) s += part[(w * 5 + r) * 64 + jj];
                const int jo = (it % 192) * 64 + jj; MODV[((size_t)l * 5 + r) * 12288 + jo] = s + a->in[I_MODB][l * 12288 + jo]; }
            __syncthreads();
        }
    }
    {
        LAS float* wt = (LAS float*)lds;
        LAS float* ctab = (LAS float*)(lds + 32768);
        LAS float* scr = (LAS float*)(lds + 32768 + 512 + wave * 8448);
        __syncthreads();
        if (tid < 128) ctab[tid] = cospif((float)tid * (1.f / 64.f));
        for (int it = bid; it < DEPTH * 32 * 4; it += G) {
            const int l = it / 128, kb = (it % 128) / 4, g = it % 4, k0 = kb * 64;
            __syncthreads();
            for (int i = tid; i < 64 * 32; i += NTHR) { const int kk = i >> 5, c4 = i & 31;
                *(LAS f32x4*)(wt + kk * 128 + c4 * 4) = *(const f32x4*)(a->in[I_WIN] + ((size_t)l * DM + k0 + kk) * IN_DIM + S_FFT + g * 128 + c4 * 4); }
            __syncthreads();
            const int half = wave >> 2, cp = (wave & 3) * 32 + (lane & 31), n0 = half * 512 + g * 128 + (wave & 3) * 32;
#pragma unroll 1
            for (int i = 0; i < 32; ++i) { const int kk = 2 * i + (lane >> 5); float s = 0.f;
#pragma unroll 8
                for (int c = 0; c < 128; ++c) s += wt[kk * 128 + c] * ctab[(c * cp - 32 * half) & 127];
                scr[kk * 33 + (lane & 31)] = s; }
            LDS_WAIT();
            bf16* WT = (bf16*)(ws + OFF_W + (size_t)l * W_LAYER + WO_FFT);
            const int c = lane & 7;
#pragma unroll
            for (int j = 0; j < 4; ++j) { const int n = (lane >> 3) + 8 * j; const LAS float* s = scr + (8 * c) * 33 + n;
                v4u o; o.x = pk2(s[0 * 33], s[1 * 33]); o.y = pk2(s[2 * 33], s[3 * 33]); o.z = pk2(s[4 * 33], s[5 * 33]); o.w = pk2(s[6 * 33], s[7 * 33]);
                *(v4u*)(WT + (size_t)(n0 + n) * DM + k0 + 8 * c) = o; }
            LDS_WAIT();
        }
        __syncthreads();
    }
    const int gw = bid * NWAVES + wave, NGW = G * NWAVES;
    {
        LAS float* scr = (LAS float*)(lds + wave * 8448);
        for (int it = gw; it < DEPTH * IT_LAYER; it += NGW) {
            const int l = it / IT_LAYER; int r = it % IT_LAYER; unsigned char* wl = ws + OFF_W + (size_t)l * W_LAYER;
            if (r < IT_IN) { const int kb = r / (NU / 32), nb = r % (NU / 32); transpose_item(a->in[I_WIN] + (size_t)l * DM * IN_DIM, DM, IN_DIM, (bf16*)(wl + WO_IN), kb * 64, nb * 32, true, scr, lane); continue; } r -= IT_IN;
            if (r < IT_CO) { transpose_item(a->in[I_CONVOUT] + (size_t)l * 512 * DM, ACW, DM, (bf16*)(wl + WO_CAT), (r / 64) * 64, (r % 64) * 32, false, scr, lane, AC_CONV); continue; } r -= IT_CO;
            if (r < IT_SO) { transpose_item(a->in[I_SOUT] + (size_t)l * 768 * DM, ACW, DM, (bf16*)(wl + WO_CAT), (r / 64) * 64, (r % 64) * 32, false, scr, lane, AC_SSD); continue; } r -= IT_SO;
            if (r < IT_FO) { transpose_item(a->in[I_FOUT] + (size_t)l * 512 * DM, ACW, DM, (bf16*)(wl + WO_CAT), (r / 64) * 64, (r % 64) * 32, false, scr, lane, AC_FFT); continue; } r -= IT_FO;
            if (r < IT_RO) { transpose_item(a->in[I_ROUT] + (size_t)l * 512 * DM, ACW, DM, (bf16*)(wl + WO_CAT), (r / 64) * 64, (r % 64) * 32, false, scr, lane, AC_RWKV); continue; } r -= IT_RO;
            if (r < IT_O) { transpose_item(a->in[I_WO] + (size_t)l * DM * DM, DM, DM, (bf16*)(wl + WO_O), (r / 64) * 64, (r % 64) * 32, false, scr, lane); continue; } r -= IT_O;
            if (r < IT_UP) { transpose_item(a->in[I_UP] + (size_t)l * DM * DFF, DM, DFF, (bf16*)(wl + WO_UP), (r / 256) * 64, (r % 256) * 32, false, scr, lane); continue; } r -= IT_UP;
            transpose_item(a->in[I_DOWN] + (size_t)l * DFF * DM, DFF, DM, (bf16*)(wl + WO_DN), (r / 64) * 64, (r % 64) * 32, false, scr, lane);
        }
    }
    {
        const int gt = bid * NTHR + tid, NGT = G * NTHR;
        bf16* FL = (bf16*)(ws + OFF_DFTL); bf16* FC = (bf16*)(ws + OFF_DFTC);
        { bf16* WLT = (bf16*)(ws + OFF_WLT);
          for (int i = gt; i < DEPTH * 512 * 320; i += NGT) { const int l = i / (512 * 320), c = (i / 320) % 512, j = i % 320; float v;
              if (j < 64) v = a->in[I_RW2][((size_t)(l * 2 + 0) * 64 + j) * 512 + c]; else if (j < 128) v = a->in[I_RW2][((size_t)(l * 2 + 1) * 64 + (j - 64)) * 512 + c];
              else if (j < 192) v = a->in[I_RA2][((size_t)l * 64 + (j - 128)) * 512 + c]; else v = a->in[I_RG2][((size_t)l * 128 + (j - 192)) * 512 + c];
              WLT[i] = (bf16)f2bf(v); } }
        for (int i = gt; i < 2048 * 512; i += NGT) { const int lp = i >> 9, k8 = (i & 511) * 8; unsigned o[4];
#pragma unroll
            for (int e = 0; e < 4; ++e) { float v[2];
#pragma unroll
                for (int q = 0; q < 2; ++q) { const int k = k8 + 2 * e + q; const int m = (lp * (k & 2047)) & 2047; float sn, cs; sincospif((float)m * (1.f / 1024.f), &sn, &cs); v[q] = (k < 2048 ? cs : -sn) * (1.f / 512.f); }
                o[e] = pk2(v[0], v[1]); }
            *(v4u*)(FL + (size_t)lp * 4096 + k8) = (v4u){o[0], o[1], o[2], o[3]}; }
        for (int i = gt; i < 256 * 64; i += NGT) { const int lp = i >> 6, k8 = (i & 63) * 8; unsigned o[4];
#pragma unroll
            for (int e = 0; e < 4; ++e) { float v[2];
#pragma unroll
                for (int q = 0; q < 2; ++q) { const int k = k8 + 2 * e + q; const int m = (lp * (k & 255)) & 255; float sn, cs; sincospif((float)m * (1.f / 128.f), &sn, &cs); v[q] = (k < 256 ? cs : -sn) * 0.005524271728f; }
                o[e] = pk2(v[0], v[1]); }
            *(v4u*)(FC + (size_t)lp * 512 + k8) = (v4u){o[0], o[1], o[2], o[3]}; }
        f32x4* X4 = (f32x4*)(ws + OFF_X); const f32x4* x4 = (const f32x4*)a->in[I_X]; const f32x4* c4 = (const f32x4*)a->in[I_CTX];
        for (int i = gt; i < TT * (DM / 4); i += NGT) X4[i] = (i < TLAT * (DM / 4)) ? x4[i] : c4[i - TLAT * (DM / 4)];
    }
}

__device__ __forceinline__ void norm_phase(KArgs a, int mode, const float* gY, const float* gH, const float* modY  , const float* modH  ,
                                           int bid, int G, const int wave0, int nrows, bool split = false  , bool dry = false  ) {
    PH_IDS
    unsigned char* ws = a->ws; const int gw = bid * NWAVES + wave, NGW = G * NWAVES;
    const float* X = (const float*)(ws + OFF_X); const bf16* Y = (const bf16*)(ws + OFF_Y); bf16* H = (bf16*)(ws + (dry ? WS_END + 80 * MiB : OFF_H)); float* Xw = (float*)(ws + (dry ? WS_END : OFF_X));
    for (int row = gw; row < nrows; row += NGW) {
        const int mr = row < TLAT ? (row >> 11) : 4;
        f32x4 x[8];
        const f32x4* xr = (const f32x4*)(X + (size_t)row * DM) + lane;
#pragma unroll
        for (int j = 0; j < 8; ++j) x[j] = xr[64 * j];
        if (mode != 0) {
            const v2u* yr = (const v2u*)(Y + (size_t)row * DM) + lane; f32x4 y[8]; float ss = 0.f;
            if (split && row >= TLAT) { const f32x4* yc = (const f32x4*)((const float*)(ws + OFF_YC) + (size_t)(row - TLAT) * DM) + lane;
#pragma unroll
                for (int j = 0; j < 8; ++j) { f32x4 t = yc[64 * j];
#pragma unroll
                    for (int sl = 1; sl < 8; ++sl) t += yc[(size_t)sl * 1024 * 512 + 64 * j];
                    y[j] = t; } }
            else {
#pragma unroll
                for (int j = 0; j < 8; ++j) { const v2u t = yr[64 * j]; y[j] = (f32x4){bflo(t.x), bfhi(t.x), bflo(t.y), bfhi(t.y)}; } }
#pragma unroll
            for (int j = 0; j < 8; ++j) { ss += (y[j].x * y[j].x + y[j].y * y[j].y) + (y[j].z * y[j].z + y[j].w * y[j].w); }
            const float r = rsqrtf(wave_sum(ss) * (1.f / DM) + 1e-6f);
            const f32x4* gp = (const f32x4*)gY + lane; const f32x4* gt = (const f32x4*)(modY + (size_t)mr * 12288) + lane;
#pragma unroll
            for (int j = 0; j < 8; ++j) x[j] += gt[64 * j] * (y[j] * r * gp[64 * j]);
            if (mode == 1) { f32x4* xw = (f32x4*)(Xw + (size_t)row * DM) + lane;
#pragma unroll
                for (int j = 0; j < 8; ++j) xw[64 * j] = x[j]; }
            else { f32x4* ow = (f32x4*)(a->out + (size_t)row * DM) + lane;
#pragma unroll
                for (int j = 0; j < 8; ++j) ow[64 * j] = x[j]; }
        }
        if (mode != 2) {
            float ss = 0.f;
#pragma unroll
            for (int j = 0; j < 8; ++j) ss += (x[j].x * x[j].x + x[j].y * x[j].y) + (x[j].z * x[j].z + x[j].w * x[j].w);
            const float r = rsqrtf(wave_sum(ss) * (1.f / DM) + 1e-6f);
            const f32x4* gp = (const f32x4*)gH + lane; const f32x4* sh = (const f32x4*)(modH + (size_t)mr * 12288) + lane; const f32x4* sc = sh + 512;
            v2u* hw = (v2u*)(H + (size_t)row * DM) + lane;
#pragma unroll
            for (int j = 0; j < 8; ++j) { const f32x4 h = (x[j] * r * gp[64 * j]) * (sc[64 * j] + 1.f) + sh[64 * j]; hw[64 * j] = (v2u){pk2(h.x, h.y), pk2(h.z, h.w)}; }
        }
    }
}
#define XB_TMO      128
#define XB_XCNT(j)  (256  + 64 * (j))
#define XB_XSUB(j)  (1280 + 64 * (j))
#define XB_XGEN(j)  (2304 + 64 * (j))
#define XB_TOP      3328
#define XB_TOPGEN   3392
#define XCD_BAR_WORDS 3456
#define XB_SPIN_CAP (1u << 18)

__device__ __forceinline__ unsigned xb_ld(unsigned* p)              { return __hip_atomic_load(p, __ATOMIC_RELAXED, __HIP_MEMORY_SCOPE_AGENT); }
__device__ __forceinline__ unsigned xb_add(unsigned* p, unsigned v) { return __hip_atomic_fetch_add(p, v, __ATOMIC_RELAXED, __HIP_MEMORY_SCOPE_AGENT); }
__device__ __forceinline__ unsigned xb_xcc_id() { return (unsigned)__builtin_amdgcn_s_getreg((3 << 11) | 20) & 0xFu; }
#define XB_SPIN(cond, bar) do { unsigned _sp = 0; while (cond) { __builtin_amdgcn_s_sleep(1); \
    if ((++_sp & 255u) == 0u) { if (xb_ld(&(bar)[XB_TMO])) break; if (_sp > XB_SPIN_CAP) { atomicAdd(&(bar)[XB_TMO], 1u); break; } } } } while (0)

struct XcdBarrier {
    unsigned* bar; unsigned x; int wv;
    volatile LAS unsigned* st;
};

__device__ __forceinline__ bool xb_t0(int wv) { unsigned z_ = 0u; asm volatile("" : "+v"(z_)); return wv == 0 && __builtin_amdgcn_mbcnt_hi(~0u, __builtin_amdgcn_mbcnt_lo(~0u, z_)) == 0u; }
__device__ __forceinline__ XcdBarrier xcd_barrier_post(unsigned* bar, volatile LAS unsigned* st, int wv) {
    XcdBarrier b; b.bar = bar; b.x = xb_xcc_id(); b.st = st; b.wv = wv;
    if (xb_t0(wv)) (void)xb_add(&bar[XB_XCNT(b.x)], 1u);
    return b;
}
__device__ __forceinline__ void xcd_barrier_complete(unsigned* bar, unsigned x, unsigned& nloc, unsigned& nx) {
    const unsigned G = gridDim.x * gridDim.y * gridDim.z;
    unsigned sum, cnt, mine, sp = 0u;
    for (;;) {
        sum = 0u; cnt = 0u; mine = 0u;
#pragma unroll
        for (unsigned j = 0; j < 16; ++j) { const unsigned c = xb_ld(&bar[XB_XCNT(j)]); sum += c; cnt += (c > 0u) ? 1u : 0u; mine = (j == x) ? c : mine; }
        if (sum == G) break;
        __builtin_amdgcn_s_sleep(1);
        if ((++sp & 255u) == 0u) { if (xb_ld(&bar[XB_TMO])) break; if (sp > XB_SPIN_CAP) { atomicAdd(&bar[XB_TMO], 1u); break; } }
    }
    nloc = mine > 0u ? mine : 1u; nx = cnt > 0u ? cnt : 1u;
}

__device__ __forceinline__ void xcd_barrier(const XcdBarrier& b) {
    asm volatile("s_waitcnt vmcnt(0)" ::: "memory");
    __syncthreads();
    if (xb_t0(b.wv)) {
        unsigned* bar = b.bar;
        __builtin_amdgcn_s_waitcnt(0);
        unsigned nloc = b.st[0], nx = b.st[1];
        if (nloc == 0u) { xcd_barrier_complete(bar, b.x, nloc, nx); b.st[0] = nloc; b.st[1] = nx; }
        const unsigned old = xb_add(&bar[XB_XSUB(b.x)], 1u);
        const unsigned gen = old / nloc;
        if (old + 1u == (gen + 1u) * nloc) {
            __builtin_amdgcn_fence(__ATOMIC_RELEASE, "agent");
            asm volatile("s_waitcnt vmcnt(0)" ::: "memory");
            const unsigned og = xb_add(&bar[XB_TOP], 1u);
            const unsigned tg = og / nx;
            if (og + 1u == (tg + 1u) * nx) xb_add(&bar[XB_TOPGEN], 1u);
            else XB_SPIN(xb_ld(&bar[XB_TOPGEN]) == tg, bar);
            __builtin_amdgcn_fence(__ATOMIC_ACQUIRE, "agent");
            xb_add(&bar[XB_XGEN(b.x)], 1u);
            asm volatile("s_waitcnt vmcnt(0)" ::: "memory");
        } else {
            XB_SPIN(xb_ld(&bar[XB_XGEN(b.x)]) == gen, bar);
            __builtin_amdgcn_fence(__ATOMIC_ACQUIRE, "agent");
            asm volatile("s_waitcnt vmcnt(0)" ::: "memory");
        }
    }
    __syncthreads();
}

constexpr int RCH_NT = 0, RCH_RT = 2048, RCH_KST = 4096, RCH_TT = 4608, RCH_ART = 5120, RCH_KRT = 5632, RCH_VM = 6144, RCH_APT = 8192, RCH_KPT = 10240, RCH_GC = 12288, RCH_BYTES = 12544;

typedef short bf16x8 __attribute__((ext_vector_type(8)));
constexpr int RP_PITCH = 516, ACT_PITCH = 328;
__device__ __forceinline__ void rwkv_prep_item(KArgs a, int l, int item, LAS unsigned char* lds, int tid, int lane, int wave) {
    unsigned char* ws = a->ws;
    const bf16* U = (const bf16*)(ws + OFF_U); const float* MISC = (const float*)(ws + OFF_MISC);
    const int b = item / 144, j0 = (item % 144) * 16; const bool isctx = j0 < LCTX;
    LAS float* RP = (LAS float*)lds;
    LAS float* KP = RP + 16 * RP_PITCH; LAS float* VP = KP + 16 * RP_PITCH;
    LAS bf16* ACT = (LAS bf16*)(lds + 3 * 16 * RP_PITCH * 4);
    const float* mu = a->in[I_RMU] + l * 1856;
    bf16x8 wfr[10][4];
    { const bf16* WLT = (const bf16*)(ws + OFF_WLT) + (size_t)l * 512 * 320 + (size_t)(64 * wave + (lane & 15)) * 320 + (lane >> 4) * 8;
#pragma unroll
      for (int ks = 0; ks < 10; ++ks)
#pragma unroll
          for (int nt = 0; nt < 4; ++nt) wfr[ks][nt] = *(const bf16x8*)(WLT + (size_t)nt * 16 * 320 + ks * 32); }
#pragma unroll
    for (int it_ = 0; it_ < 6; ++it_) { const int idx = tid + it_ * NTHR; const int i = idx / 192, c8 = idx % 192, jj = j0 + i;
        const bool hp = isctx ? (jj - 1 >= 0) : (jj - 1 >= LCTX), hn = isctx ? (jj + 1 < LCTX) : (jj + 1 < RJ);
        const v4u c = *(const v4u*)(U + (size_t)rwkv_tok(b, jj) * NU + URKV + c8 * 8);
        v4u p = (v4u){0u, 0u, 0u, 0u}, n = p;
        if (hp) p = *(const v4u*)(U + (size_t)rwkv_tok(b, jj - 1) * NU + URKV + c8 * 8);
        if (hn) n = *(const v4u*)(U + (size_t)rwkv_tok(b, jj + 1) * NU + URKV + c8 * 8);
        const f32x4 m0 = *(const f32x4*)(mu + c8 * 8), m1 = *(const f32x4*)(mu + c8 * 8 + 4);
        f32x4 x0 = (f32x4){bflo(c.x), bfhi(c.x), bflo(c.y), bfhi(c.y)}, x1 = (f32x4){bflo(c.z), bfhi(c.z), bflo(c.w), bfhi(c.w)};
        const f32x4 s0 = (f32x4){bflo(p.x) + bflo(n.x), bfhi(p.x) + bfhi(n.x), bflo(p.y) + bflo(n.y), bfhi(p.y) + bfhi(n.y)}, s1 = (f32x4){bflo(p.z) + bflo(n.z), bfhi(p.z) + bfhi(n.z), bflo(p.w) + bflo(n.w), bfhi(p.w) + bfhi(n.w)};
        x0 = x0 + (0.5f * s0 - x0) * m0; x1 = x1 + (0.5f * s1 - x1) * m1;
        const int ch = c8 * 8, reg = ch >> 9; LAS float* dst = (reg == 0 ? RP : (reg == 1 ? KP : VP)) + i * RP_PITCH + (ch & 511);
        *(LAS f32x4*)dst = x0; *(LAS f32x4*)(dst + 4) = x1; }
#pragma unroll
    for (int it_ = 0; it_ < 3; ++it_) { const int idx = tid + it_ * NTHR; if (idx >= 16 * 80) break; const int i = idx / 80, c4 = idx % 80, jj = j0 + i;
        const bool hp = isctx ? (jj - 1 >= 0) : (jj - 1 >= LCTX), hn = isctx ? (jj + 1 < LCTX) : (jj + 1 < RJ);
        f32x4 x = *(const f32x4*)(MISC + (size_t)rwkv_tok(b, jj) * 512 + 64 + c4 * 4); f32x4 p = (f32x4){0.f, 0.f, 0.f, 0.f}, n = p;
        if (hp) p = *(const f32x4*)(MISC + (size_t)rwkv_tok(b, jj - 1) * 512 + 64 + c4 * 4);
        if (hn) n = *(const f32x4*)(MISC + (size_t)rwkv_tok(b, jj + 1) * 512 + 64 + c4 * 4);
        x = x + (0.5f * (p + n) - x) * *(const f32x4*)(mu + 1536 + c4 * 4);
        const int m = c4 * 4;
        if (m < 128) x = (f32x4){tanhf(x.x), tanhf(x.y), tanhf(x.z), tanhf(x.w)}; else if (m >= 192) x = (f32x4){sigmoidf_(x.x), sigmoidf_(x.y), sigmoidf_(x.z), sigmoidf_(x.w)};
        *(LAS v2u*)(ACT + i * ACT_PITCH + m) = (v2u){pk2(x.x, x.y), pk2(x.z, x.w)}; }
    __syncthreads();
    const int fr = lane & 15, fq = lane >> 4, h = wave;
    f32x4 acc[4][4];
#pragma unroll
    for (int o = 0; o < 4; ++o)
#pragma unroll
        for (int nt = 0; nt < 4; ++nt) acc[o][nt] = (f32x4){0.f, 0.f, 0.f, 0.f};
    {
#pragma unroll
        for (int ks = 0; ks < 10; ++ks) { const int o = ks < 2 ? 0 : (ks < 4 ? 1 : (ks < 6 ? 2 : 3));
            const bf16x8 af = *(const LAS bf16x8*)(ACT + fr * ACT_PITCH + ks * 32 + fq * 8);
#pragma unroll
            for (int nt = 0; nt < 4; ++nt) acc[o][nt] = __builtin_amdgcn_mfma_f32_16x16x32_bf16(af, wfr[ks][nt], acc[o][nt], 0, 0, 0); }
    }
    float* RW = (float*)(ws + OFF_RW); constexpr size_t AS = RW_ARR / 4; float* RSC = (float*)(ws + OFF_RSC);
    float w0f[4], w0b[4], a0c[4], kkc[4], kac[4], rkc[4];
#pragma unroll
    for (int nt = 0; nt < 4; ++nt) { const int c = 64 * wave + 16 * nt + fr; w0f[nt] = a->in[I_RW0][(l * 2 + 0) * 512 + c]; w0b[nt] = a->in[I_RW0][(l * 2 + 1) * 512 + c]; a0c[nt] = a->in[I_RA0][l * 512 + c];
        kkc[nt] = a->in[I_RKK][l * 512 + c]; kac[nt] = a->in[I_RKA][l * 512 + c]; rkc[nt] = a->in[I_RRK][l * 512 + c]; }
    float Wd[2][4][4], Rr[4][4], Km[4][4], Nn[4][4], Ka[4][4], Vv[4][4];
#pragma unroll
    for (int i = 0; i < 4; ++i) { const int tok = 4 * fq + i; const size_t R = (size_t)b * RJ + j0 + tok;
        float k[4], av[4], kkv[4]; float ss = 0.f;
#pragma unroll
        for (int nt = 0; nt < 4; ++nt) { const int c = 64 * wave + 16 * nt + fr; Rr[i][nt] = RP[tok * RP_PITCH + c]; k[nt] = KP[tok * RP_PITCH + c]; Vv[i][nt] = VP[tok * RP_PITCH + c];
            av[nt] = sigmoidf_(a0c[nt] + acc[2][nt][i]); kkv[nt] = k[nt] * kkc[nt]; ss += kkv[nt] * kkv[nt]; }
        const float rn = rsqrtf(row16_sum(ss) + 1e-12f);
        float bon = 0.f;
#pragma unroll
        for (int nt = 0; nt < 4; ++nt) { const int c = 64 * wave + 16 * nt + fr;
            Wd[0][i][nt] = __expf(-__expf(-softplusf_(-(w0f[nt] + acc[0][nt][i])) - 0.5f)); Wd[1][i][nt] = __expf(-__expf(-softplusf_(-(w0b[nt] + acc[1][nt][i])) - 0.5f));
            const float kk = kkv[nt] * rn; Km[i][nt] = k[nt] * (1.f + (av[nt] - 1.f) * kac[nt]); Ka[i][nt] = kk * av[nt]; Nn[i][nt] = -kk;
            bon += Rr[i][nt] * Km[i][nt] * rkc[nt];
            float* o = RW + R * 512 + c; o[7 * AS] = Vv[i][nt]; o[8 * AS] = acc[3][nt][i]; }
        bon = row16_sum(bon);
        if (fr == 0) RSC[(size_t)2 * TT * 8 + R * 8 + h] = bon;
    }
    __syncthreads();
    LAS unsigned char* wl_ = lds + wave * 14336;
    LAS bf16* NTl = (LAS bf16*)wl_; LAS bf16* RTl = NTl + 16 * 68; LAS bf16* ATl = RTl + 16 * 68; LAS bf16* KTl = ATl + 16 * 68;
    LAS float* ASl = (LAS float*)(wl_ + 8704);
    LAS float* TTl = (LAS float*)(wl_ + 11264);
    typedef short bf16x4 __attribute__((ext_vector_type(4)));
#pragma unroll
    for (int d = 0; d < 2; ++d) {
        const int cidx = d ? (isctx ? (240 - j0) / 16 : (2544 - j0) / 16) : j0 / 16;
        unsigned char* img = ws + OFF_RCH + ((size_t)((b * 2 + d) * 8 + h) * 144 + cidx) * RCH_BYTES;
        const int laneD = d ? ((3 - fq) * 16 + fr) : lane;
#pragma unroll
        for (int nt = 0; nt < 4; ++nt) {
            float gam[4], gpv[4], G, E;
            if (d == 0) { gam[0] = Wd[0][0][nt]; gam[1] = gam[0] * Wd[0][1][nt]; gam[2] = gam[1] * Wd[0][2][nt]; gam[3] = gam[2] * Wd[0][3][nt]; G = gam[3];
                const float g1 = __int_as_float(__builtin_amdgcn_ds_bpermute((lane - 16) << 2, __float_as_int(G))), g2 = __int_as_float(__builtin_amdgcn_ds_bpermute((lane - 32) << 2, __float_as_int(G))), g3 = __int_as_float(__builtin_amdgcn_ds_bpermute((lane - 48) << 2, __float_as_int(G)));
                E = (fq >= 1 ? g1 : 1.f) * (fq >= 2 ? g2 : 1.f) * (fq >= 3 ? g3 : 1.f);
                gpv[0] = E; gpv[1] = E * gam[0]; gpv[2] = E * gam[1]; gpv[3] = E * gam[2];
#pragma unroll
                for (int i = 0; i < 4; ++i) gam[i] *= E; }
            else { gam[3] = Wd[1][3][nt]; gam[2] = gam[3] * Wd[1][2][nt]; gam[1] = gam[2] * Wd[1][1][nt]; gam[0] = gam[1] * Wd[1][0][nt]; G = gam[0];
                const float g1 = __int_as_float(__builtin_amdgcn_ds_bpermute((lane + 16) << 2, __float_as_int(G))), g2 = __int_as_float(__builtin_amdgcn_ds_bpermute((lane + 32) << 2, __float_as_int(G))), g3 = __int_as_float(__builtin_amdgcn_ds_bpermute((lane + 48) << 2, __float_as_int(G)));
                E = (fq <= 2 ? g1 : 1.f) * (fq <= 1 ? g2 : 1.f) * (fq <= 0 ? g3 : 1.f);
                gpv[3] = E; gpv[2] = E * gam[3]; gpv[1] = E * gam[2]; gpv[0] = E * gam[1];
#pragma unroll
                for (int i = 0; i < 4; ++i) gam[i] *= E; }
            float tot = G * __int_as_float(__builtin_amdgcn_ds_bpermute((lane ^ 16) << 2, __float_as_int(G)));
            tot = tot * __int_as_float(__builtin_amdgcn_ds_bpermute((lane ^ 32) << 2, __float_as_int(tot)));
            float ap[4], kp[4];
#pragma unroll
            for (int i = 0; i < 4; ++i) { const int td = d ? 15 - (4 * fq + i) : 4 * fq + i; const float ig = __builtin_amdgcn_rcpf(gam[i]);
                const float at_ = Ka[i][nt] * ig, kt_ = Km[i][nt] * ig; ap[i] = at_ * tot; kp[i] = kt_ * tot;
                NTl[td * 68 + 16 * nt + fr] = bf1(gpv[i] * Nn[i][nt]); RTl[td * 68 + 16 * nt + fr] = bf1(gam[i] * Rr[i][nt]);
                ATl[td * 68 + 16 * nt + fr] = bf1(at_); KTl[td * 68 + 16 * nt + fr] = bf1(kt_); }
            v2u pa, pk, pv;
            if (d == 0) { pa = (v2u){pk2(ap[0], ap[1]), pk2(ap[2], ap[3])}; pk = (v2u){pk2(kp[0], kp[1]), pk2(kp[2], kp[3])}; pv = (v2u){pk2(Vv[0][nt], Vv[1][nt]), pk2(Vv[2][nt], Vv[3][nt])}; }
            else { pa = (v2u){pk2(ap[3], ap[2]), pk2(ap[1], ap[0])}; pk = (v2u){pk2(kp[3], kp[2]), pk2(kp[1], kp[0])}; pv = (v2u){pk2(Vv[3][nt], Vv[2][nt]), pk2(Vv[1][nt], Vv[0][nt])}; }
            *(v2u*)(img + RCH_APT + nt * 512 + laneD * 8) = pa; *(v2u*)(img + RCH_KPT + nt * 512 + laneD * 8) = pk; *(v2u*)(img + RCH_VM + nt * 512 + laneD * 8) = pv;
            if (fq == 0) *(float*)(img + RCH_GC + (16 * nt + fr) * 4) = tot;
        }
        LDS_WAIT();
#pragma unroll
        for (int kt = 0; kt < 4; ++kt) { *(v2u*)(img + RCH_NT + kt * 512 + lane * 8) = *(const LAS v2u*)(NTl + fr * 68 + 16 * kt + 4 * fq); *(v2u*)(img + RCH_RT + kt * 512 + lane * 8) = *(const LAS v2u*)(RTl + fr * 68 + 16 * kt + 4 * fq); }
        f32x4 cAs = (f32x4){0.f, 0.f, 0.f, 0.f}, cKs = cAs, cAr = cAs, cKr = cAs;
#pragma unroll
        for (int sk = 0; sk < 4; ++sk) { const bf16x4 aA = *(const LAS bf16x4*)(ATl + fr * 68 + 16 * sk + 4 * fq), aK = *(const LAS bf16x4*)(KTl + fr * 68 + 16 * sk + 4 * fq);
            const bf16x4 bN = *(const LAS bf16x4*)(NTl + fr * 68 + 16 * sk + 4 * fq), bR = *(const LAS bf16x4*)(RTl + fr * 68 + 16 * sk + 4 * fq);
            cAs = __builtin_amdgcn_mfma_f32_16x16x16bf16_1k(aA, bN, cAs, 0, 0, 0); cKs = __builtin_amdgcn_mfma_f32_16x16x16bf16_1k(aK, bN, cKs, 0, 0, 0);
            cAr = __builtin_amdgcn_mfma_f32_16x16x16bf16_1k(aA, bR, cAr, 0, 0, 0); cKr = __builtin_amdgcn_mfma_f32_16x16x16bf16_1k(aK, bR, cKr, 0, 0, 0); }
#pragma unroll
        for (int j = 0; j < 4; ++j) { const int ii = 4 * fq + j; if (!(ii < fr)) { cAs[j] = 0.f; cKs[j] = 0.f; } if (!(ii <= fr)) { cAr[j] = 0.f; cKr[j] = 0.f; } }
        *(v2u*)(img + RCH_KST + lane * 8) = (v2u){pk2(cKs[0], cKs[1]), pk2(cKs[2], cKs[3])}; *(v2u*)(img + RCH_ART + lane * 8) = (v2u){pk2(cAr[0], cAr[1]), pk2(cAr[2], cAr[3])};
        *(v2u*)(img + RCH_KRT + lane * 8) = (v2u){pk2(cKr[0], cKr[1]), pk2(cKr[2], cKr[3])};
        *(LAS f32x4*)(ASl + (d * 16 + fr) * 20 + 4 * fq) = cAs;
        LDS_WAIT();
    }
    if (lane < 32) { const int d = lane >> 4, irow = lane & 15; float Tc[16];
#pragma unroll
        for (int t = 0; t < 16; ++t) { float x = (irow == t) ? 1.f : 0.f;
#pragma unroll
            for (int j4 = 0; j4 < (t + 3) / 4; ++j4) { const f32x4 av = *(const LAS f32x4*)(ASl + (d * 16 + t) * 20 + 4 * j4);
#pragma unroll
                for (int e = 0; e < 4; ++e) if (4 * j4 + e < t) x += Tc[4 * j4 + e] * av[e]; }
            Tc[t] = x; TTl[(d * 16 + t) * 20 + irow] = x; } }
    LDS_WAIT();
#pragma unroll
    for (int d = 0; d < 2; ++d) { const int cidx = d ? (isctx ? (240 - j0) / 16 : (2544 - j0) / 16) : j0 / 16;
        unsigned char* img = ws + OFF_RCH + ((size_t)((b * 2 + d) * 8 + h) * 144 + cidx) * RCH_BYTES;
        const f32x4 tv = *(const LAS f32x4*)(TTl + (d * 16 + fr) * 20 + 4 * fq);
        *(v2u*)(img + RCH_TT + lane * 8) = (v2u){pk2(tv[0], tv[1]), pk2(tv[2], tv[3])}; }
    __syncthreads();
}
__device__ __forceinline__ void ssd_prep_item(KArgs a, int l, int item, int tid) {
    unsigned char* ws = a->ws; const bf16* U = (const bf16*)(ws + OFF_U); const float* MISC = (const float*)(ws + OFF_MISC);
    bf16* XBC = (bf16*)(ws + OFF_XBC); float* DTA = (float*)(ws + OFF_DTA);
    const int t0 = item * 16;
    const int seq_lo = t0 < TLAT ? (t0 & ~(LSEQ - 1)) : TLAT + ((t0 - TLAT) & ~(LCTX - 1)), seq_hi = seq_lo + (t0 < TLAT ? LSEQ : LCTX);
    for (int cp = tid; cp < 896; cp += NTHR) {
        float w0[5], w1[5];
#pragma unroll
        for (int j = 0; j < 5; ++j) { const f32x2 w = *(const f32x2*)(a->in[I_SCW] + (size_t)(l * 5 + j) * 1792 + 2 * cp); w0[j] = w.x; w1[j] = w.y; }
        const f32x2 bb = *(const f32x2*)(a->in[I_SCB] + l * 1792 + 2 * cp);
        float i0[20], i1[20];
#pragma unroll
        for (int r = 0; r < 20; ++r) { const int row = t0 - 2 + r; unsigned u = 0u; if (row >= seq_lo && row < seq_hi) u = *(const unsigned*)(U + (size_t)row * NU + UXBC + 2 * cp); i0[r] = bflo(u); i1[r] = bfhi(u); }
#pragma unroll
        for (int o = 0; o < 16; ++o) { float s0 = bb.x, s1 = bb.y;
#pragma unroll
            for (int j = 0; j < 5; ++j) { s0 += w0[j] * i0[o + j]; s1 += w1[j] * i1[o + j]; }
            *(unsigned*)(XBC + (size_t)(t0 + o) * 1792 + 2 * cp) = pk2(siluf_(s0), siluf_(s1)); }
    }
    if (tid < 16 * 24) { const int o = tid / 24, q = tid % 24;
        const float dt = softplusf_(MISC[(size_t)(t0 + o) * 512 + q] + a->in[I_SDTB][l * 24 + q]); const float A = -__expf(a->in[I_SALOG][l * 24 + q]);
        DTA[(size_t)(t0 + o) * 48 + q] = dt; DTA[(size_t)(t0 + o) * 48 + 24 + q] = dt * A; }
}
__device__ __forceinline__ void conv_item(KArgs a, int l, int item, LAS unsigned char* lds, int tid, int lane, int wave) {
    unsigned char* ws = a->ws; const bf16* U = (const bf16*)(ws + OFF_U); bf16* AC = (bf16*)(ws + OFF_ACAT) + AC_CONV;
    int t0, seg_lo, seg_hi;
    if (item < 256) { t0 = item * 32; seg_lo = t0 & ~63; seg_hi = seg_lo + 64; }
    else { const int ci = item - 256; t0 = TLAT + ci * 32; seg_lo = TLAT + (ci >> 3) * LCTX; seg_hi = seg_lo + LCTX; }
    LAS bf16* inimg = (LAS bf16*)lds;
    LAS float* outimg = (LAS float*)(lds + 63488);
    for (int idx = tid; idx < 62 * 64; idx += NTHR) { const int rr = idx >> 6, c8 = idx & 63, row = t0 - 15 + rr;
        v4u o = (v4u){0u, 0u, 0u, 0u};
        if (row >= seg_lo && row < seg_hi) { const v4u va = *(const v4u*)(U + (size_t)row * NU + UCONV + c8 * 8), vg = *(const v4u*)(U + (size_t)row * NU + UCONV + 512 + c8 * 8);
            o.x = pk2(bflo(va.x) * sigmoidf_(bflo(vg.x)), bfhi(va.x) * sigmoidf_(bfhi(vg.x))); o.y = pk2(bflo(va.y) * sigmoidf_(bflo(vg.y)), bfhi(va.y) * sigmoidf_(bfhi(vg.y)));
            o.z = pk2(bflo(va.z) * sigmoidf_(bflo(vg.z)), bfhi(va.z) * sigmoidf_(bfhi(vg.z))); o.w = pk2(bflo(va.w) * sigmoidf_(bflo(vg.w)), bfhi(va.w) * sigmoidf_(bfhi(vg.w))); }
        *(LAS v4u*)(inimg + rr * 512 + c8 * 8) = o; }
    __syncthreads();
    {
        const int cp = tid & 255, th = tid >> 8;
        f32x2 w[31];
#pragma unroll
        for (int j = 0; j < 31; ++j) w[j] = *(const f32x2*)(a->in[I_CONVW] + (size_t)(l * 31 + j) * 512 + 2 * cp);
        const f32x2 bias = *(const f32x2*)(a->in[I_CONVB] + l * 512 + 2 * cp);
        f32x2 o[16];
#pragma unroll
        for (int q = 0; q < 16; ++q) o[q] = bias;
        const LAS unsigned* ip = (const LAS unsigned*)(inimg + (16 * th) * 512 + 2 * cp);
#pragma unroll
        for (int r = 0; r < 46; ++r) { const unsigned u = ip[r * 256]; const f32x2 v = (f32x2){bflo(u), bfhi(u)};
#pragma unroll
            for (int q = 0; q < 16; ++q) if (r - q >= 0 && r - q < 31) o[q] += w[r - q] * v; }
#pragma unroll
        for (int q = 0; q < 16; ++q) *(LAS f32x2*)(outimg + (16 * th + q) * 512 + 2 * cp) = o[q];
    }
    __syncthreads();
    {
        const f32x4 g0 = *(const f32x4*)(a->in[I_CLNG] + l * 512 + 8 * lane), g1 = *(const f32x4*)(a->in[I_CLNG] + l * 512 + 8 * lane + 4);
        const f32x4 b0 = *(const f32x4*)(a->in[I_CLNB] + l * 512 + 8 * lane), b1 = *(const f32x4*)(a->in[I_CLNB] + l * 512 + 8 * lane + 4);
#pragma unroll
        for (int q = 0; q < 4; ++q) { const int o = wave * 4 + q;
            f32x4 x0 = *(const LAS f32x4*)(outimg + o * 512 + 8 * lane), x1 = *(const LAS f32x4*)(outimg + o * 512 + 8 * lane + 4);
            const float mean = wave_sum((x0.x + x0.y + x0.z + x0.w) + (x1.x + x1.y + x1.z + x1.w)) * (1.f / 512.f);
            x0 = x0 - mean; x1 = x1 - mean;
            const float var = wave_sum((x0.x * x0.x + x0.y * x0.y + x0.z * x0.z + x0.w * x0.w) + (x1.x * x1.x + x1.y * x1.y + x1.z * x1.z + x1.w * x1.w)) * (1.f / 512.f);
            const float rs = rsqrtf(var + 1e-5f);
            x0 = x0 * rs * g0 + b0; x1 = x1 * rs * g1 + b1;
            v4u ov; ov.x = pk2(siluf_(x0.x), siluf_(x0.y)); ov.y = pk2(siluf_(x0.z), siluf_(x0.w)); ov.z = pk2(siluf_(x1.x), siluf_(x1.y)); ov.w = pk2(siluf_(x1.z), siluf_(x1.w));
            *(v4u*)(AC + (size_t)(t0 + o) * ACW + 8 * lane) = ov; }
    }
    __syncthreads();
}

__device__ __forceinline__ int ssd_tok(int b, int dir, int pos) {
    if (pos < LCTX) return TLAT + b * LCTX + (dir ? (LCTX - 1 - pos) : pos);
    const int q = pos - LCTX; return b * LSEQ + (dir ? (LSEQ - 1 - q) : q);
}
__device__ __forceinline__ void post_phase(KArgs a, int l, int bid, int G, const int wave0) {
    PH_IDS
    unsigned char* ws = a->ws; const int gw = bid * NWAVES + wave, NGW = G * NWAVES;
    const bf16* U = (const bf16*)(ws + OFF_U); const bf16* XBC = (const bf16*)(ws + OFF_XBC);
    const float* Y0 = (const float*)(ws + OFF_YSSD); const float* Y1 = Y0 + (size_t)TT * 768; bf16* AS_ = (bf16*)(ws + OFF_ACAT) + AC_SSD;
    for (int row = gw; row < TT; row += NGW) {
        f32x4 y[3]; float ss = 0.f;
#pragma unroll
        for (int j = 0; j < 3; ++j) { const int col = 4 * lane + 256 * j; const float dsk = a->in[I_SD][l * 12 + (col >> 6)];
            const f32x4 yf = *(const f32x4*)(Y0 + (size_t)row * 768 + col), yb = *(const f32x4*)(Y1 + (size_t)row * 768 + col);
            const v2u xs = *(const v2u*)(XBC + (size_t)row * 1792 + col), z = *(const v2u*)(U + (size_t)row * NU + UZ + col);
            f32x4 v = yf + yb + dsk * (f32x4){bflo(xs.x), bfhi(xs.x), bflo(xs.y), bfhi(xs.y)};
            v = v * (f32x4){siluf_(bflo(z.x)), siluf_(bfhi(z.x)), siluf_(bflo(z.y)), siluf_(bfhi(z.y))};
            y[j] = v; ss += (v.x * v.x + v.y * v.y) + (v.z * v.z + v.w * v.w); }
        const float r = rsqrtf(wave_sum(ss) * (1.f / 768.f) + 1e-6f);
#pragma unroll
        for (int j = 0; j < 3; ++j) { const int col = 4 * lane + 256 * j; const f32x4 g = *(const f32x4*)(a->in[I_SNG] + l * 768 + col); const f32x4 o = y[j] * r * g;
            *(v2u*)(AS_ + (size_t)row * ACW + col) = (v2u){pk2(o.x, o.y), pk2(o.z, o.w)}; }
    }
    const float* RW = (const float*)(ws + OFF_RW); constexpr size_t AS = RW_ARR / 4; const float* RSC = (const float*)(ws + OFF_RSC);
    const float* R0 = (const float*)(ws + OFF_YRW); const float* R1 = R0 + (size_t)TT * 512; bf16* AR = (bf16*)(ws + OFF_ACAT) + AC_RWKV;
    for (int row = gw; row < TT; row += NGW) {
        size_t R;
        if (row < TLAT) { const int b = row >> 11, t = row & 2047, rr = t >> 6, cc = t & 63; R = (size_t)b * RJ + LCTX + cc * 32 + rr; }
        else { const int b = (row - TLAT) >> 8, jj = (row - TLAT) & 255; R = (size_t)b * RJ + jj; }
        const int c0 = 8 * lane, h = lane >> 3;
        f32x4 ya = *(const f32x4*)(R0 + R * 512 + c0) + *(const f32x4*)(R1 + R * 512 + c0), yb = *(const f32x4*)(R0 + R * 512 + c0 + 4) + *(const f32x4*)(R1 + R * 512 + c0 + 4);
        float s = (ya.x + ya.y + ya.z + ya.w) + (yb.x + yb.y + yb.z + yb.w);
        s = sum8(s);
        const float mean = s * (1.f / 64.f); ya = ya - mean; yb = yb - mean;
        float q = (ya.x * ya.x + ya.y * ya.y + ya.z * ya.z + ya.w * ya.w) + (yb.x * yb.x + yb.y * yb.y + yb.z * yb.z + yb.w * yb.w);
        q = sum8(q);
        const float rs = rsqrtf(q * (1.f / 64.f) + 64e-5f);
        const f32x4 lg0 = *(const f32x4*)(a->in[I_RLNG] + l * 512 + c0), lg1 = *(const f32x4*)(a->in[I_RLNG] + l * 512 + c0 + 4), lb0 = *(const f32x4*)(a->in[I_RLNB] + l * 512 + c0), lb1 = *(const f32x4*)(a->in[I_RLNB] + l * 512 + c0 + 4);
        const float bon = RSC[(size_t)2 * TT * 8 + R * 8 + h];
        const f32x4 v0 = *(const f32x4*)(RW + 7 * AS + R * 512 + c0), v1 = *(const f32x4*)(RW + 7 * AS + R * 512 + c0 + 4), g0 = *(const f32x4*)(RW + 8 * AS + R * 512 + c0), g1 = *(const f32x4*)(RW + 8 * AS + R * 512 + c0 + 4);
        const f32x4 o0 = (ya * rs * lg0 + lb0 + bon * v0) * g0, o1 = (yb * rs * lg1 + lb1 + bon * v1) * g1;
        *(v4u*)(AR + (size_t)row * ACW + c0) = (v4u){pk2(o0.x, o0.y), pk2(o0.z, o0.w), pk2(o1.x, o1.y), pk2(o1.z, o1.w)};
    }
}

__device__ __forceinline__ size_t rwkv_row(int b, int dir, int pos) { const int j = dir ? (pos < LCTX ? (LCTX - 1 - pos) : (RJ + LCTX - 1 - pos)) : pos; return (size_t)b * RJ + j; }
struct RchOps { v2u nt[4], rt[4], kst, tt, art, krt, vm, apt[4], kpt[4]; f32x4 gc[4]; };
__device__ __forceinline__ void rwkv_scan_chunk(KArgs a, int idx, LAS unsigned char* lds, int tid, int lane, int wave) {
    typedef short bf16x4 __attribute__((ext_vector_type(4)));
    unsigned char* ws = a->ws;
    const int b = idx >> 4, dir = (idx >> 3) & 1, h = idx & 7, fr = lane & 15, fq = lane >> 4;
    float* Yo = (float*)(ws + OFF_YRW) + (size_t)dir * TT * 512;
    const unsigned char* base = ws + OFF_RCH + (size_t)((b * 2 + dir) * 8 + h) * 144 * RCH_BYTES;
    constexpr int BLK = 4 * RCH_BYTES;
    const int lt = tid - 256;
    v4u pre[13];
    auto issue = [&](int blk) { const v4u* src = (const v4u*)(base + (size_t)blk * BLK);
#pragma unroll
        for (int i = 0; i < 13; ++i) { const int e = lt + i * 256; if (e < BLK / 16) pre[i] = src[e]; } };
    auto commit = [&](int buf) { LAS v4u* dst = (LAS v4u*)(lds + buf * BLK);
#pragma unroll
        for (int i = 0; i < 13; ++i) { const int e = lt + i * 256; if (e < BLK / 16) dst[e] = pre[i]; } };
    auto ld = [&](const LAS unsigned char* p0, int wv) { RchOps o; const LAS unsigned char* p = p0 + lane * 8;
#pragma unroll
        for (int kt = 0; kt < 4; ++kt) { o.nt[kt] = *(const LAS v2u*)(p + RCH_NT + kt * 512); o.rt[kt] = *(const LAS v2u*)(p + RCH_RT + kt * 512); o.apt[kt] = *(const LAS v2u*)(p + RCH_APT + kt * 512); o.kpt[kt] = *(const LAS v2u*)(p + RCH_KPT + kt * 512);
            o.gc[kt] = *(const LAS f32x4*)(p0 + RCH_GC + (16 * kt + 4 * fq) * 4); }
        o.kst = *(const LAS v2u*)(p + RCH_KST); o.tt = *(const LAS v2u*)(p + RCH_TT); o.art = *(const LAS v2u*)(p + RCH_ART); o.krt = *(const LAS v2u*)(p + RCH_KRT); o.vm = *(const LAS v2u*)(p + RCH_VM + wv * 512); return o; };
#define MF16(A_, B_, C_) __builtin_amdgcn_mfma_f32_16x16x16bf16_1k(__builtin_bit_cast(bf16x4, A_), __builtin_bit_cast(bf16x4, B_), C_, 0, 0, 0)
    f32x4 S[4];
#pragma unroll
    for (int kt = 0; kt < 4; ++kt) S[kt] = (f32x4){0.f, 0.f, 0.f, 0.f};
    auto step = [&](const RchOps& cur, int c) {
        v2u Sb[4];
#pragma unroll
        for (int kt = 0; kt < 4; ++kt) Sb[kt] = (v2u){pk2(S[kt][0], S[kt][1]), pk2(S[kt][2], S[kt][3])};
        f32x4 rhs = (f32x4){0.f, 0.f, 0.f, 0.f}, y = rhs;
#pragma unroll
        for (int kt = 0; kt < 4; ++kt) rhs = MF16(cur.nt[kt], Sb[kt], rhs);
        rhs = MF16(cur.kst, cur.vm, rhs);
        const v2u rb = (v2u){pk2(rhs[0], rhs[1]), pk2(rhs[2], rhs[3])};
        const f32x4 u = MF16(cur.tt, rb, ((f32x4){0.f, 0.f, 0.f, 0.f}));
        const v2u ub = (v2u){pk2(u[0], u[1]), pk2(u[2], u[3])};
#pragma unroll
        for (int kt = 0; kt < 4; ++kt) { S[kt] = S[kt] * cur.gc[kt]; S[kt] = MF16(cur.apt[kt], ub, S[kt]); S[kt] = MF16(cur.kpt[kt], cur.vm, S[kt]); }
#pragma unroll
        for (int kt = 0; kt < 4; ++kt) y = MF16(cur.rt[kt], Sb[kt], y);
        y = MF16(cur.art, ub, y); y = MF16(cur.krt, cur.vm, y);
#pragma unroll
        for (int j = 0; j < 4; ++j) { const size_t R = rwkv_row(b, dir, c * 16 + 4 * fq + j); Yo[R * 512 + h * 64 + 16 * wave + fr] = y[j]; }
    };
    if (wave >= 4) { issue(0); commit(0); }
    __syncthreads();
    for (int blk = 0; blk < 36; ++blk) {
        if (wave >= 4) { if (blk + 1 < 36) issue(blk + 1); }
        else { const LAS unsigned char* B = lds + (blk & 1) * BLK;
            RchOps o0 = ld(B, wave), o1 = ld(B + RCH_BYTES, wave);
            step(o0, blk * 4 + 0); o0 = ld(B + 2 * RCH_BYTES, wave);
            step(o1, blk * 4 + 1); o1 = ld(B + 3 * RCH_BYTES, wave);
            step(o0, blk * 4 + 2);
            step(o1, blk * 4 + 3); }
        if (wave >= 4 && blk + 1 < 36) commit((blk + 1) & 1);
        __syncthreads();
    }
#undef MF16
}

constexpr int SS_CM = 0, SS_BM = 17408, SS_BST = 34816, SS_XT = 53248, SS_MX = 62464, SS_HB = 71680, SS_CS = 89088, SS_DT = 89344;
__device__ __forceinline__ float bfe(const v4u& v, int i) { const unsigned u = (i < 2) ? v.x : (i < 4) ? v.y : (i < 6) ? v.z : v.w; return (i & 1) ? bfhi(u) : bflo(u); }
__device__ __forceinline__ unsigned short bfraw(const v4u& v, int i) { const unsigned u = (i < 2) ? v.x : (i < 4) ? v.y : (i < 6) ? v.z : v.w; return (unsigned short)((i & 1) ? (u >> 16) : (u & 0xffffu)); }
__device__ __forceinline__ void ssd_scan_fast(KArgs a, int idx, LAS unsigned char* lds, int tid, int lane, int wave) {
    unsigned char* ws = a->ws; const bf16* XBC = (const bf16*)(ws + OFF_XBC); const float* DTA = (const float*)(ws + OFF_DTA);
    const int b = idx / 24, dir = (idx % 24) / 12, h = idx % 12, g = h / 3, q = dir * 12 + h;
    float* Yo = (float*)(ws + OFF_YSSD) + (size_t)dir * TT * 768;
    LAS bf16* Cm = (LAS bf16*)(lds + SS_CM); LAS bf16* Bm = (LAS bf16*)(lds + SS_BM); LAS bf16* BsT = (LAS bf16*)(lds + SS_BST); LAS bf16* XT = (LAS bf16*)(lds + SS_XT);
    LAS bf16* Mx = (LAS bf16*)(lds + SS_MX); LAS bf16* Hb = (LAS bf16*)(lds + SS_HB); LAS float* CS = (LAS float*)(lds + SS_CS); LAS float* DTV = (LAS float*)(lds + SS_DT);
    const int fr = lane & 15, fq = lane >> 4, ss = tid & 63, sc = tid >> 6, tl = wave >> 1, wh = wave & 1;
    { unsigned z = 0u; asm volatile("" : "+v"(z)); for (int i = tid; i < 17408 / 16; i += NTHR) *(LAS v4u*)(lds + SS_HB + i * 16) = (v4u){z, z, z, z}; }
    f32x4 hacc[4];
#pragma unroll
    for (int j = 0; j < 4; ++j) hacc[j] = (f32x4){0.f, 0.f, 0.f, 0.f};
    v4u pc0, pc1, pb0, pb1, px; float pdt = 0.f, pa = 0.f;
    auto issue = [&](int ch) {
        const int tok = ssd_tok(b, dir, ch * 64 + ss); const bf16* row = XBC + (size_t)tok * 1792;
        pc0 = *(const v4u*)(row + 1280 + g * 128 + sc * 8); pc1 = *(const v4u*)(row + 1280 + g * 128 + (sc + 8) * 8);
        pb0 = *(const v4u*)(row + 768 + g * 128 + sc * 8); pb1 = *(const v4u*)(row + 768 + g * 128 + (sc + 8) * 8);
        px = *(const v4u*)(row + h * 64 + sc * 8);
        if (tid < 64) { pdt = DTA[(size_t)tok * 48 + q]; pa = DTA[(size_t)tok * 48 + 24 + q]; }
    };
    issue(0);
    for (int ch = 0; ch < RJ / 64; ++ch) {
        *(LAS v4u*)(Cm + ss * 136 + sc * 8) = pc0; *(LAS v4u*)(Cm + ss * 136 + (sc + 8) * 8) = pc1;
        *(LAS v4u*)(Bm + ss * 136 + sc * 8) = pb0; *(LAS v4u*)(Bm + ss * 136 + (sc + 8) * 8) = pb1;
#pragma unroll
        for (int i = 0; i < 8; ++i) XT[(sc * 8 + i) * 72 + ss] = bfraw(px, i);
        if (tid < 64) { float x = pa;
            x += __int_as_float(__builtin_amdgcn_update_dpp(0, __float_as_int(x), 0x111, 0xf, 0xf, false)); x += __int_as_float(__builtin_amdgcn_update_dpp(0, __float_as_int(x), 0x112, 0xf, 0xf, false));
            x += __int_as_float(__builtin_amdgcn_update_dpp(0, __float_as_int(x), 0x114, 0xf, 0xf, false)); x += __int_as_float(__builtin_amdgcn_update_dpp(0, __float_as_int(x), 0x118, 0xf, 0xf, false));
            x += __int_as_float(__builtin_amdgcn_update_dpp(0, __float_as_int(x), 0x142, 0xa, 0xf, false)); x += __int_as_float(__builtin_amdgcn_update_dpp(0, __float_as_int(x), 0x143, 0xc, 0xf, false));
            CS[tid] = x; DTV[tid] = pdt; }
        __syncthreads();
        const float cl = CS[63];
        { const float scl = DTV[ss] * __expf(cl - CS[ss]);
#pragma unroll
            for (int i = 0; i < 8; ++i) { BsT[(sc * 8 + i) * 72 + ss] = bf1(bfe(pb0, i) * scl); BsT[((sc + 8) * 8 + i) * 72 + ss] = bf1(bfe(pb1, i) * scl); } }
        if (ch + 1 < RJ / 64) issue(ch + 1);
#pragma unroll
        for (int j = 0; j < 2; ++j) { const int tc = wh * 2 + j; f32x4 acc = (f32x4){0.f, 0.f, 0.f, 0.f};
            if (tc <= tl) {
#pragma unroll
                for (int ks = 0; ks < 4; ++ks) { const bf16x8 af = *(const LAS bf16x8*)(Cm + (16 * tl + fr) * 136 + ks * 32 + fq * 8), bf = *(const LAS bf16x8*)(Bm + (16 * tc + fr) * 136 + ks * 32 + fq * 8);
                    acc = __builtin_amdgcn_mfma_f32_16x16x32_bf16(af, bf, acc, 0, 0, 0); } }
            const int s = 16 * tc + fr; const float css = CS[s], dts = DTV[s];
#pragma unroll
            for (int i = 0; i < 4; ++i) { const int l = 16 * tl + 4 * fq + i; const float v = (s <= l) ? acc[i] * __expf(CS[l] - css) * dts : 0.f; Mx[l * 72 + s] = bf1(v); } }
        __syncthreads();
#pragma unroll
        for (int j = 0; j < 2; ++j) { const int tp = wh * 2 + j; f32x4 acc = (f32x4){0.f, 0.f, 0.f, 0.f};
#pragma unroll
            for (int ks = 0; ks < 4; ++ks) { const bf16x8 af = *(const LAS bf16x8*)(Cm + (16 * tl + fr) * 136 + ks * 32 + fq * 8), bf = *(const LAS bf16x8*)(Hb + (16 * tp + fr) * 136 + ks * 32 + fq * 8);
                acc = __builtin_amdgcn_mfma_f32_16x16x32_bf16(af, bf, acc, 0, 0, 0); }
#pragma unroll
            for (int i = 0; i < 4; ++i) acc[i] *= __expf(CS[16 * tl + 4 * fq + i]);
#pragma unroll
            for (int ks = 0; ks < 2; ++ks) { const bf16x8 af = *(const LAS bf16x8*)(Mx + (16 * tl + fr) * 72 + ks * 32 + fq * 8), bf = *(const LAS bf16x8*)(XT + (16 * tp + fr) * 72 + ks * 32 + fq * 8);
                acc = __builtin_amdgcn_mfma_f32_16x16x32_bf16(af, bf, acc, 0, 0, 0); }
#pragma unroll
            for (int i = 0; i < 4; ++i) { const int tok = ssd_tok(b, dir, ch * 64 + 16 * tl + 4 * fq + i); Yo[(size_t)tok * 768 + h * 64 + 16 * tp + fr] = acc[i]; } }
        { const float ecl = __expf(cl);
#pragma unroll
            for (int j = 0; j < 4; ++j) { const int tn = wh * 4 + j; hacc[j] = hacc[j] * ecl;
#pragma unroll
                for (int ks = 0; ks < 2; ++ks) { const bf16x8 af = *(const LAS bf16x8*)(XT + (16 * tl + fr) * 72 + ks * 32 + fq * 8), bf = *(const LAS bf16x8*)(BsT + (16 * tn + fr) * 72 + ks * 32 + fq * 8);
                    hacc[j] = __builtin_amdgcn_mfma_f32_16x16x32_bf16(af, bf, hacc[j], 0, 0, 0); } } }
        __syncthreads();
#pragma unroll
        for (int j = 0; j < 4; ++j) { const int tn = wh * 4 + j;
#pragma unroll
            for (int i = 0; i < 4; ++i) Hb[(16 * tl + 4 * fq + i) * 136 + 16 * tn + fr] = bf1(hacc[j][i]); }
    }
}

constexpr int NPH = 2 + 10 * DEPTH;
#ifndef PROBE_MASK
#define PROBE_MASK 0
#endif
#ifndef PROBE_P0
#define PROBE_P0 0
#endif
#ifndef PROBE_SUB
#define PROBE_SUB 0
#endif
#ifndef PROBE_REPS
#define PROBE_REPS 3
#endif
#define REPS(k) (((PROBE_MASK >> (k)) & 1) ? PROBE_REPS : 1)
constexpr int GATE_LATE = 30;
constexpr int GATE_X = 576, GATE_Z = 304;
#ifndef MK_ONE_LAUNCH
#define MK_ONE_LAUNCH 1
#endif

__global__ void __launch_bounds__(NTHR, 2) fwd(Args a_unused) {
    extern __shared__ __attribute__((aligned(16))) unsigned char lds_raw[];
    LAS unsigned char* lds = (LAS unsigned char*)lds_raw;
    const int bid0 = blockIdx.x, G0 = gridDim.x, wave0 = __builtin_amdgcn_readfirstlane(threadIdx.x >> 6);
#define PH_BG int bid = bid0, G = G0; asm volatile("" : "+s"(bid), "+s"(G));
    volatile LAS unsigned* MISCW = (volatile LAS unsigned*)(lds + MISC_OFF);
    if (threadIdx.x < 32) MISCW[threadIdx.x] = 0u;
    __syncthreads();
    const int ph_lo = kargs()->ph_lo, ph_hi = kargs()->ph_hi;
    const bool multi = (ph_hi - ph_lo) > 1;
    XcdBarrier bar; bar.bar = (unsigned*)(kargs()->ws + OFF_CTL) + CW_BAR; bar.x = 0; bar.st = nullptr; bar.wv = wave0;
    if (multi) bar = xcd_barrier_post((unsigned*)(kargs()->ws + OFF_CTL) + CW_BAR, MISCW + 8, wave0);
#define IN(k) (ph_lo <= (k) && (k) < ph_hi)
#define SEAM(k) do { if (IN(k) && IN((k) + 1)) xcd_barrier(bar); } while (0)

    for (int rep = 0; rep < (PROBE_P0 ? PROBE_REPS : 1); ++rep) {
    if (IN(0)) { PH_BG p0_prologue(kargs(), lds, bid, G, wave0); }
    if (rep + 1 < (PROBE_P0 ? PROBE_REPS : 1)) xcd_barrier(bar); }
    SEAM(0);
    if (IN(1)) { PH_BG KArgs a = kargs(); norm_phase(a, 0, nullptr, a->in[I_NORMG] + 0, nullptr, (const float*)(a->ws + OFF_MODV), bid, G, wave0, TT); }
    SEAM(1);

    for (int l = 0; l < DEPTH; ++l) {
        const int pb = 2 + 10 * l;
#define PH_LOCALS PH_BG KArgs a = kargs(); unsigned char* ws = a->ws; unsigned char* wl = ws + OFF_W + (size_t)l * W_LAYER; bf16* Hb = (bf16*)(ws + OFF_H); (void)wl; (void)Hb; \
        const float* ng = a->in[I_NORMG] + (size_t)l * 4 * DM; const float* mv = (const float*)(ws + OFF_MODV) + (size_t)l * 5 * 12288; (void)ng; (void)mv;
        const bool lastl = (l == DEPTH - 1);
        for (int rep = 0; rep < REPS(0); ++rep) {
        if (IN(pb + 0)) { PH_LOCALS
            __syncthreads();
            pg8::Sched2 S; S.A0 = (const char*)Hb; S.B0 = (const char*)(wl + WO_IN); S.A1 = (const char*)(wl + WO_FFT); S.B1 = (const char*)Hb; S.tstep = (size_t)256 * DM * 2; S.ntk = DM / 64;
            S.t0.init(TT / 256, NU / 256 - GATE_LATE); S.t1.init(4, TT / 256); S.G = G; S.c = bid;
            pg8::EpiIn2 E{pg8::EpiInproj{(bf16*)(ws + OFF_U), (float*)(ws + OFF_MISC), NU}, pg8::EpiBf{0, (bf16*)(ws + OFF_VTL), (bf16*)(ws + OFF_VTC)}};
            pg8::gemm_phase<pg8::EpiIn2, pg8::Sched2, true, true>(lds, DM, S, E, wave0);
        }
        if (rep + 1 < REPS(0)) xcd_barrier(bar); }
        SEAM(pb + 0);
        for (int rep = 0; rep < REPS(1); ++rep) {
        if (IN(pb + 1)) { PH_LOCALS PH_IDS
            __syncthreads();
            if (rep == 0 || PROBE_SUB == 3 || PROBE_SUB == 7) {
            if (bid < 64) { pg8::Sched2 S; S.A0 = (const char*)(ws + OFF_DFTL); S.B0 = (const char*)(ws + OFF_VTL); S.A1 = S.A0; S.B1 = S.B0; S.tstep = (size_t)256 * 4096 * 2; S.ntk = 64; S.t0.init(8, 8); S.t1.init(0, 0); S.G = 64; S.c = bid;
                  pg8::EpiBf E{1, (bf16*)(ws + OFF_ACAT), nullptr};
                  pg8::gemm_phase<pg8::EpiBf, pg8::Sched2, true, true>(lds, 4096, S, E, wave0); }
            else if (bid < 72) { pg8::Sched2 S; S.A0 = (const char*)(ws + OFF_DFTC); S.B0 = (const char*)(ws + OFF_VTC); S.A1 = S.A0; S.B1 = S.B0; S.tstep = (size_t)256 * 512 * 2; S.ntk = 8; S.t0.init(1, 8); S.t1.init(0, 0); S.G = 8; S.c = bid - 64;
                  pg8::EpiBf E{2, (bf16*)(ws + OFF_ACAT), nullptr};
                  pg8::gemm_phase<pg8::EpiBf, pg8::Sched2, true, true>(lds, 512, S, E, wave0); }
            }
            __syncthreads();
            {
                unsigned* qctr = (unsigned*)(ws + OFF_CTL) + CW_Q + (l * 4 + rep) * 64;
                volatile LAS unsigned* qslot = (volatile LAS unsigned*)(lds + MISC_OFF) + 16;
                unsigned qnext = 0u; if (tid == 0) qnext = __hip_atomic_fetch_add(qctr, 1u, __ATOMIC_RELAXED, __HIP_MEMORY_SCOPE_AGENT);
                for (;;) {
                    if (tid == 0) qslot[0] = qnext;
                    __syncthreads();
                    const int it = (int)qslot[0];
                    __syncthreads();
                    if (it >= 576 + 288 + 576) break;
                    if (tid == 0) qnext = __hip_atomic_fetch_add(qctr, 1u, __ATOMIC_RELAXED, __HIP_MEMORY_SCOPE_AGENT);
                    int ln_i = lane; asm volatile("" : "+v"(ln_i)); const int tid_i = wave * 64 + ln_i;
                    const bool pall = (rep == 0 || PROBE_SUB == 7);
                    if (it < 576) { if (pall || PROBE_SUB == 0) rwkv_prep_item(a, l, it, lds, tid_i, ln_i, wave); }
                    else if (it < 576 + 288) { if (pall || PROBE_SUB == 2) conv_item(a, l, it - 576, lds, tid_i, ln_i, wave); }
                    else if (pall || PROBE_SUB == 1) ssd_prep_item(a, l, it - 576 - 288, tid_i);
                }
            }
        }
        if (rep + 1 < REPS(1)) xcd_barrier(bar); }
        SEAM(pb + 1);
        for (int rep = 0; rep < REPS(2); ++rep) {
        if (IN(pb + 2)) { PH_LOCALS PH_IDS
            __syncthreads();
            if (bid < 64) { if (rep == 0 || PROBE_SUB == 0 || PROBE_SUB == 7) rwkv_scan_chunk(a, bid, lds, tid, lane, wave); }
            else if (bid < 160) { if (rep == 0 || PROBE_SUB == 1 || PROBE_SUB == 7) ssd_scan_fast(a, bid - 64, lds, tid, lane, wave); }
            __syncthreads();
            if (rep == 0 || PROBE_SUB == 2 || PROBE_SUB == 7) {
                pg8::Sched2 S; S.A0 = (const char*)Hb; S.B0 = (const char*)(wl + WO_IN); S.A1 = S.A0; S.B1 = S.B0; S.tstep = (size_t)256 * DM * 2; S.ntk = DM / 64;
                S.t0.init(TT / 256, GATE_LATE); S.t1.init(0, 0); S.pn_off0 = NU / 256 - GATE_LATE;
                if (bid >= 160) { S.G = 96; S.c = bid - 160; S.first = 0; S.limit = GATE_X; }
                else if (bid < 64) { S.G = 64; S.c = bid; S.first = GATE_X; S.limit = GATE_X + GATE_Z; }
                else { S.G = 96; S.c = bid - 64; S.first = GATE_X + GATE_Z; S.limit = 36 * GATE_LATE; }
                pg8::EpiIn2 E{pg8::EpiInproj{(bf16*)(ws + OFF_U), (float*)(ws + OFF_MISC), NU}, pg8::EpiBf{0, (bf16*)(ws + OFF_VTL), (bf16*)(ws + OFF_VTC)}};
                pg8::gemm_phase<pg8::EpiIn2, pg8::Sched2, true, true>(lds, DM, S, E, wave0); }
        }
        if (rep + 1 < REPS(2)) xcd_barrier(bar); }
        SEAM(pb + 2);
        for (int rep = 0; rep < REPS(3); ++rep) {
        if (IN(pb + 3)) { PH_BG post_phase(kargs(), l, bid, G, wave0); }
        if (rep + 1 < REPS(3)) xcd_barrier(bar); }
        SEAM(pb + 3);
        for (int rep = 0; rep < REPS(4); ++rep) {
        if (IN(pb + 4)) { PH_LOCALS
            __syncthreads();
            pg8::Sched2 S; S.A0 = (const char*)(ws + OFF_ACAT); S.B0 = (const char*)(wl + WO_CAT); S.A1 = S.A0; S.B1 = S.B0; S.tstep = (size_t)256 * ACW * 2; S.ntk = ACW / 64;
            S.t0.init(lastl ? TLAT / 256 : TT / 256, DM / 256); S.t1.init(0, 0); S.G = G; S.c = bid;
            pg8::EpiChain E{(const bf16*)(ws + OFF_U) + UGATE, NU, (bf16*)(ws + OFF_M)};
            pg8::gemm_phase<pg8::EpiChain, pg8::Sched2, true, true>(lds, ACW, S, E, wave0);
        }
        if (rep + 1 < REPS(4)) xcd_barrier(bar); }
        SEAM(pb + 4);
        for (int rep = 0; rep < REPS(5); ++rep) {
        if (IN(pb + 5)) { PH_LOCALS
            __syncthreads();
            pg8::SchedSplit S; S.A = (const char*)(ws + OFF_M); S.B = (const char*)(wl + WO_O); S.tstep = (size_t)256 * DM * 2; S.ntk = DM / 64; S.tm.init(32, 8); S.nctx = lastl ? 0 : 256; S.G = G; S.c = bid;
            pg8::EpiF32 E{(bf16*)(ws + OFF_Y), (float*)(ws + OFF_YC)};
            pg8::gemm_phase<pg8::EpiF32, pg8::SchedSplit, true, true>(lds, DM, S, E, wave0);
        }
        if (rep + 1 < REPS(5)) xcd_barrier(bar); }
        SEAM(pb + 5);
        for (int rep = 0; rep < REPS(6); ++rep) {
        if (IN(pb + 6)) { PH_LOCALS norm_phase(a, 1, ng + 1 * DM, ng + 2 * DM, mv + 2 * DM, mv + 3 * DM, bid, G, wave0, lastl ? TLAT : TT, !lastl, rep > 0); }
        if (rep + 1 < REPS(6)) xcd_barrier(bar); }
        SEAM(pb + 6);
        for (int rep = 0; rep < REPS(7); ++rep) {
        if (IN(pb + 7)) { PH_LOCALS
            __syncthreads();
            pg8::Sched2 S; S.A0 = (const char*)Hb; S.B0 = (const char*)(wl + WO_UP); S.A1 = S.A0; S.B1 = S.B0; S.tstep = (size_t)256 * DM * 2; S.ntk = DM / 64;
            S.t0.init(lastl ? TLAT / 256 : TT / 256, DFF / 256); S.t1.init(0, 0); S.G = G; S.c = bid;
            pg8::EpiBf E{3, (bf16*)(ws + OFF_HB), nullptr};
            pg8::gemm_phase<pg8::EpiBf, pg8::Sched2, true, true>(lds, DM, S, E, wave0);
        }
        if (rep + 1 < REPS(7)) xcd_barrier(bar); }
        SEAM(pb + 7);
        for (int rep = 0; rep < REPS(8); ++rep) {
        if (IN(pb + 8)) { PH_LOCALS
            __syncthreads();
            pg8::SchedSplit S; S.A = (const char*)(ws + OFF_HB); S.B = (const char*)(wl + WO_DN); S.tstep = (size_t)256 * DFF * 2; S.ntk = DFF / 64; S.tm.init(32, 8); S.nctx = lastl ? 0 : 256; S.G = G; S.c = bid;
            pg8::EpiF32 E{(bf16*)(ws + OFF_Y), (float*)(ws + OFF_YC)};
            pg8::gemm_phase<pg8::EpiF32, pg8::SchedSplit, true, true>(lds, DFF, S, E, wave0);
        }
        if (rep + 1 < REPS(8)) xcd_barrier(bar); }
        SEAM(pb + 8);
        if (IN(pb + 9)) { PH_LOCALS
            if (!lastl) norm_phase(a, 1, ng + 3 * DM, ng + 4 * DM  , mv + 5 * DM, mv + 5 * 12288  , bid, G, wave0, TT, true);
            else norm_phase(a, 2, ng + 3 * DM, nullptr, mv + 5 * DM, nullptr, bid, G, wave0, TLAT);
        }
        SEAM(pb + 9);
    }
#undef IN
#undef SEAM
}

extern "C" void kernel_launch(void* const* d_in, const int* in_sizes, int n_in, void* d_out, int out_size, void* d_ws, size_t ws_size, hipStream_t stream) {
    static int grid = 0;
    if (grid == 0) {
        if (n_in != N_IN || out_size != TLAT * DM || ws_size < WS_END + 120 * MiB) { fprintf(stderr, "kernel_launch: unexpected shapes (n_in %d out %d ws %zu); nothing launched\n", n_in, out_size, ws_size); grid = -1; return; }
        int dev = 0, cus = 0;
        if (hipGetDevice(&dev) != hipSuccess || hipDeviceGetAttribute(&cus, hipDeviceAttributeMultiprocessorCount, dev) != hipSuccess) { grid = -1; return; }
        if (hipFuncSetAttribute((const void*)fwd, hipFuncAttributeMaxDynamicSharedMemorySize, LDS_BYTES) != hipSuccess) { fprintf(stderr, "kernel_launch: hipFuncSetAttribute failed\n"); grid = -1; return; }
        int per_cu = 0;
        if (hipOccupancyMaxActiveBlocksPerMultiprocessor(&per_cu, (const void*)fwd, NTHR, LDS_BYTES) != hipSuccess || per_cu < 1) fprintf(stderr, "kernel_launch: occupancy query says %d\n", per_cu);
        (void)hipGetLastError();
        grid = cus;
        if (grid < 232) { fprintf(stderr, "kernel_launch: %d CUs: this kernel's scan phase needs > 160 workgroups\n", grid); grid = -1; return; }
    }
    if (grid < 0) return;
    if (hipMemsetAsync((char*)d_ws + OFF_CTL, 0, CTL_BYTES, stream) != hipSuccess) return;
    Args a{};
    for (int i = 0; i < N_IN; ++i) a.in[i] = (const float*)d_in[i];
    a.out = (float*)d_out; a.ws = (unsigned char*)d_ws;
#if MK_ONE_LAUNCH
    a.ph_lo = 0; a.ph_hi = NPH;
    hipLaunchKernelGGL(fwd, dim3(grid), dim3(NTHR), LDS_BYTES, stream, a);
#else
    for (int p = 0; p < NPH; ++p) { a.ph_lo = p; a.ph_hi = p + 1; hipLaunchKernelGGL(fwd, dim3(grid), dim3(NTHR), LDS_BYTES, stream, a); }
#endif
}
```

```cpp
#include <hip/hip_runtime.h>
#include <cstdio>
#include <cstdint>
namespace pg8 {
#define PG8_LAS __attribute__((address_space(3)))
typedef unsigned short bf16_t;
typedef short bf16x8 __attribute__((ext_vector_type(8)));
typedef float f32x4 __attribute__((ext_vector_type(4)));
typedef unsigned u32x4 __attribute__((ext_vector_type(4)));
constexpr int BM = 256, BK = 64, HALF = 128, HTB = HALF * BK * 2  , STAGE_BYTES = 8 * HTB, NXCD = 8, WGM = 8;

__host__ __device__ __forceinline__ int lds_byte(int r, int c) { const int st = (r >> 4) * 2 + (c >> 5), rr = r & 15, cc = c & 31, ob = rr * 64 + cc * 2; return st * 1024 + (ob ^ (((ob >> 9) & 1) << 5)); }
__host__ __device__ __forceinline__ void stage_rc(int b, int& R, int& C) { const int st = b / 1024, sb = b % 1024, swz = sb ^ (((sb >> 9) & 1) << 5); R = (st >> 1) * 16 + swz / 64; C = (st & 1) * 32 + (swz % 64) / 2; }
__host__ __device__ __forceinline__ int perm32(int rho) { const int n = rho >> 4, i = rho & 15; return 8 * (i >> 2) + 4 * n + (i & 3); }

struct Unit { int pm, pn, kind; };
struct Gemm { const bf16_t* A; const bf16_t* Bt; int M, N, K; };

struct StaticOrder {
    int nM, nN, nwg, G, c;
    __host__ __device__ void init(int M, int N, int G_, int c_) { nM = M / BM; nN = N / BM; nwg = nM * nN; G = G_; c = c_; }
    __host__ __device__ bool next(int i, Unit& u) const {
        const long L = (long)i * G + c; if (L >= nwg) return false;
        int wgid = (int)L; { const int q = nwg / NXCD, r = nwg % NXCD, xcd = wgid % NXCD, off = wgid / NXCD; wgid = (xcd < r ? xcd * (q + 1) : r * (q + 1) + (xcd - r) * q) + off; }
        const int nig = WGM * nN, gid = wgid / nig, fm = gid * WGM, gsz = (nM - fm) < WGM ? (nM - fm) : WGM;
        u.pm = fm + ((wgid % nig) % gsz); u.pn = (wgid % nig) / gsz; return true;
    }
    __device__ __forceinline__ void a_ready(const Unit&) const {}
    __device__ __forceinline__ void done(const Unit&) const {}
};
typedef float f32x2n __attribute__((ext_vector_type(2))); typedef __bf16 bf16x2n __attribute__((ext_vector_type(2)));
__device__ __forceinline__ unsigned cvt_pk_bf16(float lo, float hi) { const bf16x2n r = __builtin_convertvector((f32x2n){lo, hi}, bf16x2n); return __builtin_bit_cast(unsigned, r); }
typedef float f32x2 __attribute__((ext_vector_type(2)));
template <class Epi, class Sched, bool ALIGN_EPI = false, bool SP2 = false>
__device__ __forceinline__ void gemm_phase(PG8_LAS unsigned char* lds, const int ldk  , const Sched& S, const Epi& E, const int wave_id) {
    unsigned z_ = 0u; asm volatile("" : "+v"(z_)); const int lane_ = (int)__builtin_amdgcn_mbcnt_hi(~0u, __builtin_amdgcn_mbcnt_lo(~0u, z_)); int wid_ = wave_id; asm volatile("" : "+s"(wid_)); const int wid = wid_, lane = lane_, tid = wid * 64 + lane, wr = wid >> 2, wc = wid & 3, fr = lane & 15, fq = lane >> 4;
    const int K = ldk; int nt;
    unsigned voffA[2], voffB[2];
#pragma unroll
    for (int i = 0; i < 2; ++i) { int R, C; stage_rc(tid * 16 + i * 8192, R, C); const int Rb = Epi::PERM ? ((R & ~31) + perm32(R & 31)) : R;
        voffA[i] = (unsigned)(R * K + C) * 2u; voffB[i] = (unsigned)(Rb * K + C) * 2u; }
    const size_t kstep = (size_t)(BK * 2);
    const size_t hstep = (size_t)HALF * K * 2;
    const unsigned ldsw = (unsigned)wid * 1024u;
    const int aoff = lds_byte(wr * 64 + fr, fq * 8), boff = lds_byte(wc * 32 + fr, fq * 8);
#define PG8_SA(b, h) (((b) * 2 + (h)) * HTB)
#define PG8_SB(b, h) ((4 + (b) * 2 + (h)) * HTB)
#define PG8_STAGE(bufoff, gbase, voff) do { _Pragma("unroll") for (int _i = 0; _i < 2; ++_i) \
        __builtin_amdgcn_global_load_lds((const unsigned*)((const char*)(gbase) + (voff)[_i]), (PG8_LAS unsigned*)(lds + (bufoff) + ldsw + _i * 8192), 16, 0, 0); } while (0)
#define PG8_LDA(dst, b, h) do { _Pragma("unroll") for (int m = 0; m < 4; ++m) _Pragma("unroll") for (int k = 0; k < 2; ++k) dst[m][k] = *(const PG8_LAS bf16x8*)(lds + PG8_SA(b, h) + aoff + m * 2048 + k * 1024); } while (0)
#define PG8_LDB(dst, b, h) do { _Pragma("unroll") for (int n = 0; n < 2; ++n) _Pragma("unroll") for (int k = 0; k < 2; ++k) dst[n][k] = *(const PG8_LAS bf16x8*)(lds + PG8_SB(b, h) + boff + n * 2048 + k * 1024); } while (0)
#define PG8_MMA(ai, bj, At, Bt) do { __builtin_amdgcn_s_setprio(1); _Pragma("unroll") for (int m = 0; m < 4; ++m) _Pragma("unroll") for (int n = 0; n < 2; ++n) _Pragma("unroll") for (int k = 0; k < 2; ++k) \
        acc[ai][bj][m][n] = __builtin_amdgcn_mfma_f32_16x16x32_bf16(Bt[n][k], At[m][k], acc[ai][bj][m][n], 0, 0, 0); __builtin_amdgcn_s_setprio(0); } while (0)
#define PG8_WAIT_V(n) asm volatile("s_waitcnt vmcnt(" #n ")" ::: "memory")
#define PG8_WAIT_L(n) asm volatile("s_waitcnt lgkmcnt(" #n ")" ::: "memory")
#define PG8_BAR __builtin_amdgcn_s_barrier()
#define PG8_SCHED __builtin_amdgcn_sched_barrier(0)
    Unit cur, nxt; int ui = 0;
    if (!S.next(0, cur)) return;
    f32x4 acc[2][2][4][2];
#pragma unroll
    for (int a = 0; a < 2; ++a)
#pragma unroll
        for (int b = 0; b < 2; ++b)
#pragma unroll
            for (int m = 0; m < 4; ++m)
#pragma unroll
                for (int n = 0; n < 2; ++n) acc[a][b][m][n] = (f32x4){0.f, 0.f, 0.f, 0.f};
    bf16x8 At[4][2], B0[2][2], B1[2][2];
    const char* cA = S.abase(cur); const char* cB = S.bbase(cur); nt = S.nt(cur);
    S.a_ready(cur);
    if constexpr (SP2) {
        PG8_STAGE(PG8_SB(0, 0), cB, voffB); PG8_STAGE(PG8_SB(0, 1), cB + hstep, voffB); PG8_STAGE(PG8_SA(0, 0), cA, voffA); PG8_STAGE(PG8_SA(0, 1), cA + hstep, voffA);
        if (wr == 1) PG8_BAR;
        PG8_WAIT_V(2); PG8_BAR;
        PG8_STAGE(PG8_SB(1, 0), cB + kstep, voffB); PG8_STAGE(PG8_SA(1, 0), cA + kstep, voffA); PG8_STAGE(PG8_SB(1, 1), cB + hstep + kstep, voffB);
        PG8_WAIT_V(6); PG8_BAR;
    } else {
        PG8_STAGE(PG8_SB(0, 0), cB, voffB); PG8_STAGE(PG8_SA(0, 0), cA, voffA); PG8_STAGE(PG8_SB(0, 1), cB + hstep, voffB); PG8_STAGE(PG8_SA(0, 1), cA + hstep, voffA);
        if (wr == 1) PG8_BAR;
        PG8_WAIT_V(4); PG8_BAR;
        PG8_STAGE(PG8_SB(1, 0), cB + kstep, voffB); PG8_STAGE(PG8_SA(1, 0), cA + kstep, voffA); PG8_STAGE(PG8_SB(1, 1), cB + hstep + kstep, voffB);
        PG8_WAIT_V(6); PG8_BAR;
    }
    for (;;) {
        const bool has_next = S.next(ui + 1, nxt);
        const char* nA = has_next ? S.abase(nxt) : cA; const char* nB = has_next ? S.bbase(nxt) : cB;
        for (int t = 0; t < nt; t += 2) {
            const bool last = (t == nt - 2);
            const char* a1 = cA + (size_t)(t + 1) * kstep;
            const char* a2 = last ? nA : cA + (size_t)(t + 2) * kstep; const char* b2 = last ? nB : cB + (size_t)(t + 2) * kstep;
            const char* a3 = a2 + kstep; const char* b3 = b2 + kstep;
            if (last && has_next) S.a_ready(nxt);
            if constexpr (Epi::HOOK) { if (E.hook_at(t)) {
                if (wr == 0) PG8_BAR;
                E.khook(acc, cur, t, wr, wc, fr, fq);
                if (wr == 1) PG8_BAR; } }
            if constexpr (SP2) {
            PG8_LDB(B0, 0, 0); PG8_LDB(B1, 0, 1); PG8_SCHED; PG8_LDA(At, 0, 0); PG8_STAGE(PG8_SA(1, 1), a1 + hstep, voffA);
            PG8_WAIT_V(8); PG8_WAIT_L(0); PG8_BAR; PG8_MMA(0, 0, At, B0); PG8_MMA(0, 1, At, B1); PG8_BAR; PG8_SCHED;
            PG8_LDA(At, 0, 1); PG8_STAGE(PG8_SB(0, 0), b2, voffB); PG8_STAGE(PG8_SB(0, 1), b2 + hstep, voffB); PG8_STAGE(PG8_SA(0, 0), a2, voffA);
            PG8_WAIT_V(8); PG8_WAIT_L(0); PG8_BAR; PG8_MMA(1, 0, At, B0); PG8_MMA(1, 1, At, B1); PG8_BAR; PG8_SCHED;
            PG8_LDB(B0, 1, 0); PG8_LDB(B1, 1, 1); PG8_SCHED; PG8_LDA(At, 1, 0); PG8_STAGE(PG8_SA(0, 1), a2 + hstep, voffA);
            PG8_WAIT_V(8); PG8_WAIT_L(0); PG8_BAR; PG8_MMA(0, 0, At, B0); PG8_MMA(0, 1, At, B1); PG8_BAR; PG8_SCHED;
            PG8_LDA(At, 1, 1); PG8_STAGE(PG8_SB(1, 0), b3, voffB); PG8_STAGE(PG8_SB(1, 1), b3 + hstep, voffB); PG8_STAGE(PG8_SA(1, 0), a3, voffA);
            PG8_WAIT_V(8); PG8_WAIT_L(0); PG8_BAR; PG8_MMA(1, 0, At, B0); PG8_MMA(1, 1, At, B1); PG8_BAR; PG8_SCHED;
            } else {
            PG8_LDB(B0, 0, 0); PG8_SCHED; PG8_LDA(At, 0, 0); PG8_STAGE(PG8_SA(1, 1), a1 + hstep, voffA);
            PG8_WAIT_L(8); PG8_BAR; PG8_WAIT_L(0); PG8_MMA(0, 0, At, B0); PG8_BAR; PG8_SCHED;
            PG8_LDB(B1, 0, 1); PG8_STAGE(PG8_SB(0, 0), b2, voffB);
            PG8_BAR; PG8_WAIT_L(0); PG8_MMA(0, 1, At, B1); PG8_BAR;
            PG8_LDA(At, 0, 1); PG8_STAGE(PG8_SA(0, 0), a2, voffA);
            PG8_BAR; PG8_WAIT_L(0); PG8_MMA(1, 0, At, B0); PG8_BAR; PG8_SCHED;
            PG8_STAGE(PG8_SB(0, 1), b2 + hstep, voffB);
            PG8_WAIT_V(6); PG8_BAR; PG8_MMA(1, 1, At, B1); PG8_BAR;
            PG8_LDB(B0, 1, 0); PG8_SCHED; PG8_LDA(At, 1, 0); PG8_STAGE(PG8_SA(0, 1), a2 + hstep, voffA);
            PG8_WAIT_L(8); PG8_BAR; PG8_WAIT_L(0); PG8_MMA(0, 0, At, B0); PG8_BAR; PG8_SCHED;
            PG8_LDB(B1, 1, 1); PG8_STAGE(PG8_SB(1, 0), b3, voffB);
            PG8_BAR; PG8_WAIT_L(0); PG8_MMA(0, 1, At, B1); PG8_BAR;
            PG8_LDA(At, 1, 1); PG8_STAGE(PG8_SA(1, 0), a3, voffA);
            PG8_BAR; PG8_WAIT_L(0); PG8_MMA(1, 0, At, B0); PG8_BAR; PG8_SCHED;
            PG8_STAGE(PG8_SB(1, 1), b3 + hstep, voffB);
            PG8_WAIT_V(6); PG8_BAR; PG8_MMA(1, 1, At, B1); PG8_BAR;
            }
        }
        if constexpr (ALIGN_EPI) { if (wr == 0) PG8_BAR; }
        if constexpr (!Epi::AFTER_DRAIN) { E(acc, cur, wr, wc, fr, fq); S.done(cur); }
        if (!has_next) break;
#pragma unroll
        for (int a = 0; a < 2; ++a)
#pragma unroll
            for (int b = 0; b < 2; ++b)
#pragma unroll
                for (int m = 0; m < 4; ++m)
#pragma unroll
                    for (int n = 0; n < 2; ++n) acc[a][b][m][n] = (f32x4){0.f, 0.f, 0.f, 0.f};
        cur = nxt; cA = nA; cB = nB; ++ui; nt = S.nt(cur);
        if constexpr (ALIGN_EPI) { if (wr == 1) PG8_BAR; }
    }
    PG8_WAIT_V(0);
    if constexpr (!ALIGN_EPI) { if (wr == 0) PG8_BAR; }
    PG8_BAR;
    if constexpr (Epi::AFTER_DRAIN) { E.fused(acc, cur, wr, wc, fr, fq, lds, wid, lane); S.done(cur); }
#undef PG8_SA
#undef PG8_SB
#undef PG8_STAGE
#undef PG8_LDA
#undef PG8_LDB
#undef PG8_MMA
#undef PG8_WAIT_V
#undef PG8_WAIT_L
#undef PG8_BAR
#undef PG8_SCHED
}
}

namespace pg8 {
__device__ __forceinline__ float sigm(float x) { return __builtin_amdgcn_rcpf(1.f + __expf(-x)); }
__device__ __forceinline__ f32x4 sigm4(f32x4 v) { return (f32x4){sigm(v[0]), sigm(v[1]), sigm(v[2]), sigm(v[3])}; }
__device__ __forceinline__ u32x4 pack8(f32x4 v0, f32x4 v1) { u32x4 w; w.x = cvt_pk_bf16(v0[0], v0[1]); w.y = cvt_pk_bf16(v0[2], v0[3]); w.z = cvt_pk_bf16(v1[0], v1[1]); w.w = cvt_pk_bf16(v1[2], v1[3]); return w; }
__device__ __forceinline__ float bflo(unsigned u) { return __uint_as_float(u << 16); }
__device__ __forceinline__ float bfhi(unsigned u) { return __uint_as_float(u & 0xffff0000u); }


struct TileMap {
    int nM, nN, nwg;
    __device__ __forceinline__ void init(int nM_, int nN_) { nM = nM_; nN = nN_; nwg = nM_ * nN_; }
    __device__ __forceinline__ void map(int L, int& pm, int& pn) const {
        int wgid = L; { const int q = nwg / NXCD, r = nwg % NXCD, xcd = wgid % NXCD, off = wgid / NXCD; wgid = (xcd < r ? xcd * (q + 1) : r * (q + 1) + (xcd - r) * q) + off; }
        const int nig = WGM * nN, gid = wgid / nig, fm = gid * WGM, gsz = (nM - fm) < WGM ? (nM - fm) : WGM;
        pm = fm + ((wgid % nig) % gsz); pn = (wgid % nig) / gsz;
    }
};
struct Sched2 {
    const char *A0, *B0, *A1, *B1; size_t tstep; int ntk; TileMap t0, t1; int G, c;
    int pm_off0 = 0, pn_off0 = 0, first = 0, limit = 0x7fffffff;
    int spread = 0;
    __device__ __forceinline__ bool next(int i, Unit& u) const { const int L = first + i * G + c;
        if (spread) {
            const int lo = 48 * i, rem = t1.nwg - 32 * i, nf = rem < 0 ? 0 : (rem < 32 ? rem : 32);
            if (c >= lo && c < lo + nf) { t1.map(32 * i + c - lo, u.pm, u.pn); u.kind = 1; return true; }
            const int Ln = 224 * i + (c < lo ? c : c - nf);
            if (Ln >= t0.nwg) return false;
            t0.map(Ln, u.pm, u.pn); u.pm += pm_off0; u.pn += pn_off0; u.kind = 0; return true; }
        if (L >= limit) return false;
        if (L < t0.nwg) { t0.map(L, u.pm, u.pn); u.pm += pm_off0; u.pn += pn_off0; u.kind = 0; return true; }
        if (L - t0.nwg < t1.nwg) { t1.map(L - t0.nwg, u.pm, u.pn); u.kind = 1; return true; }
        return false; }
    __device__ __forceinline__ const char* abase(const Unit& u) const { return (u.kind ? A1 : A0) + (size_t)u.pm * tstep; }
    __device__ __forceinline__ const char* bbase(const Unit& u) const { return (u.kind ? B1 : B0) + (size_t)u.pn * tstep; }
    __device__ __forceinline__ int nt(const Unit&) const { return ntk; }
    __device__ __forceinline__ void a_ready(const Unit&) const {}
    __device__ __forceinline__ void done(const Unit&) const {}
};
struct SchedSplit {
    const char *A, *B; size_t tstep; int ntk; TileMap tm; int nctx, G, c;
    __device__ __forceinline__ bool next(int i, Unit& u) const { const int L = i * G + c;
        if (L < 256) { tm.map(L, u.pm, u.pn); u.kind = 0; return true; }
        const int e = L - 256; if (e < nctx) { const int tile = e & 31; u.pm = 32 + (tile >> 3); u.pn = tile & 7; u.kind = 1 + (e >> 5); return true; }
        return false; }
    __device__ __forceinline__ const char* abase(const Unit& u) const { return A + (size_t)u.pm * tstep + (u.kind ? (size_t)(u.kind - 1) * (ntk / 8) * 128 : 0); }
    __device__ __forceinline__ const char* bbase(const Unit& u) const { return B + (size_t)u.pn * tstep + (u.kind ? (size_t)(u.kind - 1) * (ntk / 8) * 128 : 0); }
    __device__ __forceinline__ int nt(const Unit& u) const { return u.kind ? ntk / 8 : ntk; }
    __device__ __forceinline__ void a_ready(const Unit&) const {}
    __device__ __forceinline__ void done(const Unit&) const {}
};
struct EpiInproj {
    static constexpr bool PERM = true, AFTER_DRAIN = false, HOOK = false;
    bf16_t* U; float* MISC; int ldu;
    __device__ __forceinline__ void operator()(const f32x4 (&acc)[2][2][4][2], const Unit& u, int wr, int wc, int fr, int fq) const {
        const int row0 = u.pm * BM + wr * 64 + fr, cl = wc * 32 + 8 * fq;
        if (u.pn == 16 || u.pn == 17) {
#pragma unroll
            for (int ai = 0; ai < 2; ++ai)
#pragma unroll
                for (int m = 0; m < 4; ++m) { float* rowp = MISC + (size_t)(row0 + ai * HALF + m * 16) * 512 + (u.pn - 16) * BM + cl;
#pragma unroll
                    for (int bj = 0; bj < 2; ++bj) { *(f32x4*)(rowp + bj * HALF) = acc[ai][bj][m][0]; *(f32x4*)(rowp + bj * HALF + 4) = acc[ai][bj][m][1]; } }
        } else {
            const bool sg = u.pn >= 22;
#pragma unroll
            for (int ai = 0; ai < 2; ++ai)
#pragma unroll
                for (int m = 0; m < 4; ++m) { bf16_t* rowp = U + (size_t)(row0 + ai * HALF + m * 16) * ldu + u.pn * BM + cl;
#pragma unroll
                    for (int bj = 0; bj < 2; ++bj) { f32x4 v0 = acc[ai][bj][m][0], v1 = acc[ai][bj][m][1];
                        if (sg) { v0 = sigm4(v0); v1 = sigm4(v1); }
                        *(u32x4*)(rowp + bj * HALF) = pack8(v0, v1); } }
        }
    }
};
struct EpiBf {
    static constexpr bool PERM = true, AFTER_DRAIN = false, HOOK = false;
    int kind; bf16_t* O0; bf16_t* O1;
    __device__ __forceinline__ void operator()(const f32x4 (&acc)[2][2][4][2], const Unit& u, int wr, int wc, int fr, int fq) const {
        bf16_t* base; size_t pitch;
        if (kind == 0) {
            const int half = u.pm >> 1, chb = (u.pm & 1) * 256;
            if (u.pn < 32) { const int b = u.pn >> 3, l0 = (u.pn & 7) * 256; pitch = 4096; base = O0 + ((size_t)(b * 512 + chb) * 2 + half) * 2048 + l0; }
            else { const int b = u.pn - 32; pitch = 512; base = O1 + ((size_t)(b * 512 + chb) * 2 + half) * 256; }
        } else if (kind == 1) { const int b = u.pn >> 1; pitch = 2304; base = O0 + (size_t)(b * 2048 + u.pm * 256) * 2304 + 1280 + (u.pn & 1) * 256; }
        else if (kind == 2) { const int b = u.pn >> 1; pitch = 2304; base = O0 + (size_t)(8192 + b * 256) * 2304 + 1280 + (u.pn & 1) * 256; }
        else { pitch = 8192; base = O0 + (size_t)(u.pm * 256) * 8192 + u.pn * 256; }
        const int r0 = wr * 64 + fr, cl = wc * 32 + 8 * fq;
#pragma unroll
        for (int ai = 0; ai < 2; ++ai)
#pragma unroll
            for (int m = 0; m < 4; ++m) { bf16_t* rowp = base + (size_t)(r0 + ai * HALF + m * 16) * pitch + cl;
#pragma unroll
                for (int bj = 0; bj < 2; ++bj) { f32x4 v0 = acc[ai][bj][m][0], v1 = acc[ai][bj][m][1];
                    if (kind == 3) { v0 = __builtin_elementwise_max(v0, (f32x4){0.f, 0.f, 0.f, 0.f}); v1 = __builtin_elementwise_max(v1, (f32x4){0.f, 0.f, 0.f, 0.f}); v0 = v0 * v0; v1 = v1 * v1; }
                    *(u32x4*)(rowp + bj * HALF) = pack8(v0, v1); } }
    }
};
struct EpiChain {
    static constexpr bool PERM = true, AFTER_DRAIN = false, HOOK = true;
    const bf16_t* G; int ldg; bf16_t* Mo;
    __device__ __forceinline__ bool hook_at(int t) const { return t == 8 || t == 20 || t == 28; }
    __device__ __forceinline__ void khook(f32x4 (&acc)[2][2][4][2], const Unit& u, int t, int wr, int wc, int fr, int fq) const {
        const int i = (t == 8) ? 0 : (t == 20 ? 1 : 2);
        int row0 = u.pm * BM + wr * 64 + fr; const int col0 = u.pn * BM + wc * 32 + 8 * fq + i * 2048;
        asm volatile("" : "+v"(row0));
#pragma unroll
        for (int ai = 0; ai < 2; ++ai) {
            u32x4 gv[4][2], hv[4][2];
#pragma unroll
            for (int m = 0; m < 4; ++m) { const bf16_t* gp = G + (size_t)(row0 + ai * HALF + m * 16) * ldg + col0;
#pragma unroll
                for (int bj = 0; bj < 2; ++bj) { gv[m][bj] = *(const u32x4*)(gp + bj * HALF); hv[m][bj] = *(const u32x4*)(gp + bj * HALF + 2048); } }
            asm volatile("" ::: "memory");
#pragma unroll
            for (int m = 0; m < 4; ++m)
#pragma unroll
                for (int bj = 0; bj < 2; ++bj) { const u32x4 g = gv[m][bj], h = hv[m][bj];
                    const unsigned gw[4] = {g.x, g.y, g.z, g.w}, hw[4] = {h.x, h.y, h.z, h.w};
#pragma unroll
                    for (int e2 = 0; e2 < 4; ++e2) { const float r0 = fmaxf(bflo(gw[e2]), 1e-6f) * __builtin_amdgcn_rcpf(fmaxf(bflo(hw[e2]), 1e-6f)), r1 = fmaxf(bfhi(gw[e2]), 1e-6f) * __builtin_amdgcn_rcpf(fmaxf(bfhi(hw[e2]), 1e-6f));
                        acc[ai][bj][m][e2 >> 1][(e2 & 1) * 2] *= r0; acc[ai][bj][m][e2 >> 1][(e2 & 1) * 2 + 1] *= r1; } }
            asm volatile("" ::: "memory");
        }
    }
    __device__ __forceinline__ void operator()(const f32x4 (&acc)[2][2][4][2], const Unit& u, int wr, int wc, int fr, int fq) const {
        const int row0 = u.pm * BM + wr * 64 + fr, col0 = u.pn * BM + wc * 32 + 8 * fq;
#pragma unroll
        for (int ai = 0; ai < 2; ++ai) {
            u32x4 gv[4][2];
#pragma unroll
            for (int m = 0; m < 4; ++m)
#pragma unroll
                for (int bj = 0; bj < 2; ++bj) gv[m][bj] = *(const u32x4*)(G + (size_t)(row0 + ai * HALF + m * 16) * ldg + col0 + bj * HALF + 3 * 2048);
            asm volatile("" ::: "memory");
#pragma unroll
            for (int m = 0; m < 4; ++m) { const size_t row = (size_t)(row0 + ai * HALF + m * 16);
#pragma unroll
                for (int bj = 0; bj < 2; ++bj) { const int col = col0 + bj * HALF; const u32x4 g = gv[m][bj];
                    const f32x4 v0 = acc[ai][bj][m][0] * (f32x4){fmaxf(bflo(g.x), 1e-6f), fmaxf(bfhi(g.x), 1e-6f), fmaxf(bflo(g.y), 1e-6f), fmaxf(bfhi(g.y), 1e-6f)};
                    const f32x4 v1 = acc[ai][bj][m][1] * (f32x4){fmaxf(bflo(g.z), 1e-6f), fmaxf(bfhi(g.z), 1e-6f), fmaxf(bflo(g.w), 1e-6f), fmaxf(bfhi(g.w), 1e-6f)};
                    *(u32x4*)(Mo + row * 2048 + col) = pack8(v0, v1); } }
        }
    }
};
struct EpiF32 {
    static constexpr bool PERM = true, AFTER_DRAIN = false, HOOK = false;
    bf16_t* C; bf16_t* YC;
    __device__ __forceinline__ void operator()(const f32x4 (&acc)[2][2][4][2], const Unit& u, int wr, int wc, int fr, int fq) const {
        const int row0 = u.pm * BM + wr * 64 + fr, col0 = u.pn * BM + wc * 32 + 8 * fq;
        if (u.kind == 0) {
#pragma unroll
            for (int ai = 0; ai < 2; ++ai)
#pragma unroll
                for (int m = 0; m < 4; ++m) { bf16_t* rowp = C + (size_t)(row0 + ai * HALF + m * 16) * 2048 + col0;
#pragma unroll
                    for (int bj = 0; bj < 2; ++bj) *(u32x4*)(rowp + bj * HALF) = pack8(acc[ai][bj][m][0], acc[ai][bj][m][1]); }
        } else {
            bf16_t* base = YC + (size_t)(u.kind - 1) * 1024 * 2048 + (size_t)(row0 - 8192) * 2048 + col0;
#pragma unroll
            for (int ai = 0; ai < 2; ++ai)
#pragma unroll
                for (int m = 0; m < 4; ++m) { bf16_t* rowp = base + (size_t)(ai * HALF + m * 16) * 2048;
#pragma unroll
                    for (int bj = 0; bj < 2; ++bj) *(u32x4*)(rowp + bj * HALF) = pack8(acc[ai][bj][m][0], acc[ai][bj][m][1]); }
        }
    }
};
struct EpiGateSlab {
    static constexpr bool PERM = true, AFTER_DRAIN = false, HOOK = false;
    const bf16_t* G; int ldg; bf16_t* SC;
    __device__ __forceinline__ void operator()(const f32x4 (&acc)[2][2][4][2], const Unit& u, int wr, int wc, int fr, int fq) const {
        const int row0 = u.pm * BM + wr * 64 + fr, cl = wc * 32 + 8 * fq;
#pragma unroll
        for (int ai = 0; ai < 2; ++ai) {
            u32x4 gv[4][2];
#pragma unroll
            for (int m = 0; m < 4; ++m)
#pragma unroll
                for (int bj = 0; bj < 2; ++bj) gv[m][bj] = *(const u32x4*)(G + (size_t)(row0 + ai * HALF + m * 16) * ldg + u.pn * BM + cl + bj * HALF + u.kind * 2048);
            asm volatile("" ::: "memory");
#pragma unroll
            for (int m = 0; m < 4; ++m) { bf16_t* rowp = SC + (size_t)u.kind * 1024 * 2048 + (size_t)(row0 + ai * HALF + m * 16 - 8192) * 2048 + u.pn * 256 + cl;
#pragma unroll
                for (int bj = 0; bj < 2; ++bj) { const u32x4 g = gv[m][bj];
                    const f32x4 v0 = acc[ai][bj][m][0] * (f32x4){bflo(g.x), bfhi(g.x), bflo(g.y), bfhi(g.y)}, v1 = acc[ai][bj][m][1] * (f32x4){bflo(g.z), bfhi(g.z), bflo(g.w), bfhi(g.w)};
                    *(u32x4*)(rowp + bj * HALF) = pack8(v0, v1); } }
        }
    }
};
struct SchedCB {
    const char *A, *B; size_t tstep; int G, c;
    __device__ __forceinline__ bool next(int i, Unit& u) const { const int L = i * G + c; if (L >= 128) return false; const int tile = L & 31; u.pm = 32 + (tile >> 3); u.pn = tile & 7; u.kind = L >> 5; return true; }
    __device__ __forceinline__ int koff(int k) const { return k == 0 ? 0 : (k == 1 ? 512 : (k == 2 ? 1280 : 1792)); }
    __device__ __forceinline__ const char* abase(const Unit& u) const { return A + (size_t)u.pm * tstep + koff(u.kind) * 2; }
    __device__ __forceinline__ const char* bbase(const Unit& u) const { return B + (size_t)u.pn * tstep + koff(u.kind) * 2; }
    __device__ __forceinline__ int nt(const Unit& u) const { return u.kind == 1 ? 12 : 8; }
    __device__ __forceinline__ void a_ready(const Unit&) const {}
    __device__ __forceinline__ void done(const Unit&) const {}
};
struct SchedCW {
    const char *A, *B; int G, c;
    __device__ __forceinline__ bool next(int i, Unit& u) const { const int L = i * G + c; if (L >= 256) return false; const int tile = L & 31; u.pm = 32 + (tile >> 3); u.pn = tile & 7; u.kind = 1 + (L >> 5); return true; }
    __device__ __forceinline__ const char* abase(const Unit& u) const { return A + (size_t)((u.kind - 1) >> 1) * 1024 * 2048 * 2 + (size_t)(u.pm - 32) * 256 * 2048 * 2 + (size_t)((u.kind - 1) & 1) * 2048; }
    __device__ __forceinline__ const char* bbase(const Unit& u) const { return B + (size_t)u.pn * 256 * 2048 * 2 + (size_t)((u.kind - 1) & 1) * 2048; }
    __device__ __forceinline__ int nt(const Unit&) const { return 16; }
    __device__ __forceinline__ void a_ready(const Unit&) const {}
    __device__ __forceinline__ void done(const Unit&) const {}
};
struct EpiIn2 {
    static constexpr bool PERM = true, AFTER_DRAIN = false, HOOK = false;
    EpiInproj e0; EpiBf e1;
    __device__ __forceinline__ void operator()(const f32x4 (&acc)[2][2][4][2], const Unit& u, int wr, int wc, int fr, int fq) const { if (u.kind == 0) e0(acc, u, wr, wc, fr, fq); else e1(acc, u, wr, wc, fr, fq); }
};
}

#define GAS __attribute__((address_space(1)))
#define LAS __attribute__((address_space(3)))
typedef unsigned short bf16;
typedef unsigned v4u __attribute__((ext_vector_type(4)));
typedef unsigned v2u __attribute__((ext_vector_type(2)));
typedef float f32x4 __attribute__((ext_vector_type(4)));
typedef float f32x2 __attribute__((ext_vector_type(2)));
constexpr int NWAVES = 8, NTHR = 512;
constexpr int DM = 2048, NBATCH = 4, LSEQ = 2048, LCTX = 256, DEPTH = 4;
constexpr int TLAT = NBATCH * LSEQ, TCTX = NBATCH * LCTX, TT = TLAT + TCTX;
constexpr int IN_DIM = 14168, DFF = 8192;
constexpr int NU = 13824;
constexpr int UZ = 0, UXBC = 768, URKV = 2560, UMISC = 4096, UCONV = 4608, UGATE = 5632;
constexpr int S_RKV = 2584, S_DT = 2560, S_WF = 4120, S_CONV = 4440, S_FFT = 5464, S_GATE = 5976;
constexpr int RJ = LCTX + LSEQ;
enum { I_X = 0, I_C, I_CTX, I_CCTX, I_MODW, I_MODB, I_NORMG, I_WIN, I_CONVW, I_CONVB, I_CLNG, I_CLNB, I_CONVOUT, I_SCW, I_SCB, I_SALOG, I_SDTB, I_SD, I_SNG, I_SOUT,
       I_FOUT, I_RMU, I_RW0, I_RW2, I_RA0, I_RA2, I_RG2, I_RKK, I_RKA, I_RRK, I_RLNG, I_RLNB, I_ROUT, I_WO, I_UP, I_DOWN, N_IN };
constexpr size_t MiB = 1u << 20;
constexpr size_t OFF_CTL = 0, CTL_BYTES = 128 * 1024;
constexpr size_t OFF_MODV = 1 * MiB;
constexpr size_t OFF_DFTL = 2 * MiB;
constexpr size_t OFF_DFTC = 18 * MiB;
constexpr size_t OFF_W = 20 * MiB, W_LAYER = 139 * MiB;
constexpr size_t WO_IN = 0, WO_FFT = 54 * MiB, WO_CAT = 58 * MiB  , WO_O = 67 * MiB, WO_UP = 75 * MiB, WO_DN = 107 * MiB;
constexpr size_t OFF_X = 576 * MiB;
constexpr size_t OFF_H = 648 * MiB;
constexpr size_t OFF_U = 684 * MiB;
constexpr size_t OFF_HB = OFF_U;
constexpr size_t OFF_MISC = 927 * MiB;
constexpr size_t OFF_VTL = 945 * MiB;
constexpr size_t OFF_VTC = 961 * MiB;
constexpr size_t OFF_ACAT = 963 * MiB;
constexpr int AC_CONV = 0, AC_SSD = 512, AC_FFT = 1280, AC_RWKV = 1792, ACW = 2304;
constexpr size_t OFF_XBC = 1004 * MiB;
constexpr size_t OFF_DTA = 1036 * MiB;
constexpr size_t OFF_YSSD = 1038 * MiB;
constexpr size_t OFF_RW = 1092 * MiB, RW_ARR = 18 * MiB;
constexpr size_t OFF_RCH = OFF_RW;
constexpr size_t OFF_RSC = 1254 * MiB;
constexpr size_t OFF_YRW = 1255 * MiB;
constexpr size_t OFF_MBUF = 1291 * MiB;
constexpr size_t OFF_M = 1363 * MiB;
constexpr size_t OFF_Y = 1399 * MiB;
constexpr size_t OFF_WLT = 1471 * MiB;
constexpr size_t OFF_YC = 1473 * MiB;
constexpr size_t OFF_WO4 = 1537 * MiB, WO4_LAYER = 32 * MiB;
constexpr size_t OFF_SCAT = OFF_MBUF;
constexpr size_t WS_END = 1665 * MiB;
constexpr int CW_Q = 8192;
constexpr int CW_CQ = 12288;
constexpr int CW_BAR = 4096;
constexpr int RING_BYTES = 131072, MISC_OFF = RING_BYTES + 320, LDS_BYTES = 147456;

__device__ __forceinline__ float bf2f(unsigned short b) { return __uint_as_float((unsigned)b << 16); }
__device__ __forceinline__ float bflo(unsigned u) { return __uint_as_float(u << 16); }
__device__ __forceinline__ float bfhi(unsigned u) { return __uint_as_float(u & 0xffff0000u); }
__device__ __forceinline__ unsigned f2bf(float f) { unsigned u = __builtin_bit_cast(unsigned, f); return (u + 0x7fffu + ((u >> 16) & 1u)) >> 16; }
typedef __bf16 bf16x2_t __attribute__((ext_vector_type(2)));
__device__ __forceinline__ unsigned pk2(float lo, float hi) { const bf16x2_t r = __builtin_convertvector((f32x2){lo, hi}, bf16x2_t); return __builtin_bit_cast(unsigned, r); }
__device__ __forceinline__ float sigmoidf_(float x) { return __builtin_amdgcn_rcpf(1.f + __expf(-x)); }
__device__ __forceinline__ float siluf_(float x) { return x * __builtin_amdgcn_rcpf(1.f + __expf(-x)); }
__device__ __forceinline__ float softplusf_(float x) { return fmaxf(x, 0.f) + __logf(1.f + __expf(-fabsf(x))); }
__device__ __forceinline__ bf16 bf1(float x) { return (bf16)(pk2(x, x) & 0xffffu); }
template <int CTRL> __device__ __forceinline__ float dpp_add(float x) { return x + __int_as_float(__builtin_amdgcn_update_dpp(0, __float_as_int(x), CTRL, 0xf, 0xf, true)); }
__device__ __forceinline__ float sum8(float x) { x = dpp_add<0xB1>(x); x = dpp_add<0x4E>(x); x = dpp_add<0x141>(x); return x; }
__device__ __forceinline__ float row16_sum(float x) { x = sum8(x); x = dpp_add<0x140>(x); return x; }
__device__ __forceinline__ float wave_sum(float v) {
    const float r = row16_sum(v);
    return (__int_as_float(__builtin_amdgcn_readlane(__float_as_int(r), 0)) + __int_as_float(__builtin_amdgcn_readlane(__float_as_int(r), 16))) +
           (__int_as_float(__builtin_amdgcn_readlane(__float_as_int(r), 32)) + __int_as_float(__builtin_amdgcn_readlane(__float_as_int(r), 48)));
}
#define LDS_WAIT() asm volatile("s_waitcnt lgkmcnt(0)" ::: "memory")

struct Args { const float* in[N_IN]; float* out; unsigned char* ws; int ph_lo, ph_hi; };
typedef const __attribute__((address_space(4))) Args* KArgs;
__device__ __forceinline__ KArgs kargs() { KArgs p = (KArgs)__builtin_amdgcn_kernarg_segment_ptr(); asm volatile("" : "+s"(p)); return p; }
#define PH_IDS unsigned z_ = 0u; asm volatile("" : "+v"(z_)); const int lane_ = (int)__builtin_amdgcn_mbcnt_hi(~0u, __builtin_amdgcn_mbcnt_lo(~0u, z_)); int wv_ = wave0; asm volatile("" : "+s"(wv_)); const int lane = lane_, wave = wv_, tid = wv_ * 64 + lane_; (void)lane; (void)wave; (void)tid;

__device__ __forceinline__ int inmap(int n) {
    if (n < 2560) return n;
    if (n < 4096) return S_RKV + (n - 2560);
    if (n < 4608) { const int m = n - 4096; if (m < 24) return S_DT + m; if (m < 64) return -1; if (m < 384) return S_WF + (m - 64); return -1; }
    if (n < 5632) return S_CONV + (n - 4608);
    return S_GATE + (n - 5632);
}
__device__ __forceinline__ int rwkv_tok(int b, int j) { if (j < LCTX) return TLAT + b * LCTX + j; const int s = j - LCTX; return b * LSEQ + (s & 31) * 64 + (s >> 5); }

constexpr int IT_IN = 32 * (NU / 32), IT_CO = 8 * 64, IT_SO = 12 * 64, IT_FO = 8 * 64, IT_RO = 8 * 64, IT_O = 32 * 64, IT_UP = 32 * 256, IT_DN = 128 * 64;
constexpr int IT_LAYER = IT_IN + IT_CO + IT_SO + IT_FO + IT_RO + IT_O + IT_UP + IT_DN;
struct CvItem { const float* src; bf16* dst; int Nsrc, ldw, k0, n0, koff; bool mapped; bf16* dst4; };
__device__ __forceinline__ CvItem cv_decode(KArgs a, int l, int r) {
    unsigned char* wl = a->ws + OFF_W + (size_t)l * W_LAYER;
    if (r < IT_IN) { const int kb = r / (NU / 32), nb = r % (NU / 32); return CvItem{a->in[I_WIN] + (size_t)l * DM * IN_DIM, (bf16*)(wl + WO_IN), IN_DIM, DM, kb * 64, nb * 32, 0, true, nullptr}; } r -= IT_IN;
    if (r < IT_CO) return CvItem{a->in[I_CONVOUT] + (size_t)l * 512 * DM, (bf16*)(wl + WO_CAT), DM, ACW, (r / 64) * 64, (r % 64) * 32, AC_CONV, false, nullptr}; r -= IT_CO;
    if (r < IT_SO) return CvItem{a->in[I_SOUT] + (size_t)l * 768 * DM, (bf16*)(wl + WO_CAT), DM, ACW, (r / 64) * 64, (r % 64) * 32, AC_SSD, false, nullptr}; r -= IT_SO;
    if (r < IT_FO) return CvItem{a->in[I_FOUT] + (size_t)l * 512 * DM, (bf16*)(wl + WO_CAT), DM, ACW, (r / 64) * 64, (r % 64) * 32, AC_FFT, false, nullptr}; r -= IT_FO;
    if (r < IT_RO) return CvItem{a->in[I_ROUT] + (size_t)l * 512 * DM, (bf16*)(wl + WO_CAT), DM, ACW, (r / 64) * 64, (r % 64) * 32, AC_RWKV, false, nullptr}; r -= IT_RO;
    if (r < IT_O) return CvItem{a->in[I_WO] + (size_t)l * DM * DM, (bf16*)(wl + WO_O), DM, DM, (r / 64) * 64, (r % 64) * 32, 0, false, nullptr}; r -= IT_O;
    if (r < IT_UP) return CvItem{a->in[I_UP] + (size_t)l * DM * DFF, (bf16*)(wl + WO_UP), DFF, DM, (r / 256) * 64, (r % 256) * 32, 0, false, nullptr}; r -= IT_UP;
    return CvItem{a->in[I_DOWN] + (size_t)l * DFF * DM, (bf16*)(wl + WO_DN), DM, DFF, (r / 64) * 64, (r % 64) * 32, 0, false, nullptr};
}
__device__ __forceinline__ void cv_load(const CvItem& c, f32x4 (&v)[8], int lane) {
    const int n4 = (lane & 7) * 4; const int sc = c.mapped ? inmap(c.n0 + n4) : (c.n0 + n4);
#pragma unroll
    for (int i = 0; i < 8; ++i) { const int kk = 8 * i + (lane >> 3); v[i] = (sc >= 0) ? *(const f32x4*)(c.src + (size_t)(c.k0 + kk) * c.Nsrc + sc) : (f32x4){0.f, 0.f, 0.f, 0.f}; }
}
__device__ __forceinline__ void cv_store(const CvItem& c, const f32x4 (&v)[8], LAS float* scr, int lane) {
    const int n4 = (lane & 7) * 4;
#pragma unroll
    for (int i = 0; i < 8; ++i) { const int kk = 8 * i + (lane >> 3); LAS float* d = scr + kk * 33 + n4; d[0] = v[i].x; d[1] = v[i].y; d[2] = v[i].z; d[3] = v[i].w; }
    LDS_WAIT();
    const int cc = lane & 7;
#pragma unroll
    for (int j = 0; j < 4; ++j) { const int n = (lane >> 3) + 8 * j; const LAS float* s = scr + (8 * cc) * 33 + n;
        v4u o; o.x = pk2(s[0 * 33], s[1 * 33]); o.y = pk2(s[2 * 33], s[3 * 33]); o.z = pk2(s[4 * 33], s[5 * 33]); o.w = pk2(s[6 * 33], s[7 * 33]);
        *(v4u*)(c.dst + (size_t)(c.n0 + n) * c.ldw + c.koff + c.k0 + 8 * cc) = o;
        if (c.dst4) { bf16* d4 = c.dst4 + (size_t)(c.n0 + n) * 8192 + (c.k0 >> 8) * 1024 + (c.k0 & 255) + 8 * cc;
#pragma unroll
            for (int i = 0; i < 4; ++i) *(v4u*)(d4 + i * 256) = o; } }
    LDS_WAIT();
}
__device__ __forceinline__ void p0_prologue(KArgs a, LAS unsigned char* lds, int bid, int G, const int wave0, const int sel = 15) {
    PH_IDS
    unsigned char* ws = a->ws;
    if (sel & 1) {
        LAS float* sc = (LAS float*)lds;
        LAS float* part = (LAS float*)(lds + 40960);
        for (int i = tid; i < 5 * DM; i += NTHR) { const float v = (i < 4 * DM) ? a->in[I_C][i] : a->in[I_CCTX][i - 4 * DM]; sc[i] = siluf_(v); }
        __syncthreads();
        float* MODV = (float*)(ws + OFF_MODV);
        const int nblk = ((DEPTH * 192 - bid + G - 1) / G) * 16;
        auto wptr = [&](int q) { int ln = lane; asm volatile("" : "+v"(ln));
            const int it = bid + (q >> 4) * G, l = it / 192;
            return a->in[I_MODW] + (size_t)l * DM * 12288 + (size_t)(wave * 256 + (q & 15) * 16) * 12288 + (it % 192) * 64 + ln; };
        float w0[16], w1[16], acc[5] = {0.f, 0.f, 0.f, 0.f, 0.f};
        { const float* wp = wptr(0);
#pragma unroll
          for (int k = 0; k < 16; ++k) w0[k] = wp[(size_t)k * 12288]; }
#pragma unroll 1
        for (int q = 0; q < nblk; q += 2) {
            { const float* wp = wptr(q + 1);
#pragma unroll
              for (int k = 0; k < 16; ++k) w1[k] = wp[(size_t)k * 12288]; }
            { const int kb = wave * 256 + (q & 15) * 16;
#pragma unroll
              for (int k = 0; k < 16; ++k)
#pragma unroll
                  for (int r = 0; r < 5; ++r) acc[r] += sc[r * DM + kb + k] * w0[k]; }
            if (q + 2 < nblk) { const float* wp = wptr(q + 2);
#pragma unroll
              for (int k = 0; k < 16; ++k) w0[k] = wp[(size_t)k * 12288]; }
            { const int kb = wave * 256 + ((q + 1) & 15) * 16;
#pragma unroll
              for (int k = 0; k < 16; ++k)
#pragma unroll
                  for (int r = 0; r < 5; ++r) acc[r] += sc[r * DM + kb + k] * w1[k]; }
            if (((q + 1) & 15) == 15) {
                const int it = bid + (q >> 4) * G, l = it / 192;
#pragma unroll
                for (int r = 0; r < 5; ++r) { part[(wave * 5 + r) * 64 + lane] = acc[r]; acc[r] = 0.f; }
                __syncthreads();
                if (tid < 320) { const int r = tid >> 6, jj = tid & 63; float s = 0.f;
#pragma unroll
                    for (int w = 0; w < 8; ++w) s += part[(w * 5 + r) * 64 + jj];
                    const int jo = (it % 192) * 64 + jj; MODV[((size_t)l * 5 + r) * 12288 + jo] = s + a->in[I_MODB][l * 12288 + jo]; }
                __syncthreads();
            }
        }
    }
    if (sel & 2) {
        typedef short bfx8 __attribute__((ext_vector_type(8)));
        LAS float* ctab = (LAS float*)(lds + 32768);
        __syncthreads();
        if (tid < 128) ctab[tid] = cospif((float)tid * (1.f / 64.f));
        __syncthreads();
        const int fr = lane & 15, fq = lane >> 4, half = wave >> 2, cb = (wave & 3) * 32;
        v4u th[2][4], tl[2][4];
#pragma unroll
        for (int nt = 0; nt < 2; ++nt)
#pragma unroll
            for (int ct = 0; ct < 4; ++ct) { const int cp = cb + 16 * nt + fr; unsigned h[4], lo[4];
#pragma unroll
                for (int e = 0; e < 4; ++e) { const int c = 32 * ct + 8 * fq + 2 * e;
                    const float v0 = ctab[(c * cp - 32 * half) & 127], v1 = ctab[((c + 1) * cp - 32 * half) & 127];
                    h[e] = pk2(v0, v1); lo[e] = pk2(v0 - bflo(h[e]), v1 - bfhi(h[e])); }
                th[nt][ct] = (v4u){h[0], h[1], h[2], h[3]}; tl[nt][ct] = (v4u){lo[0], lo[1], lo[2], lo[3]}; }
        for (int it = bid; it < DEPTH * 32 * 4; it += G) {
            const int l = it / 128, kb = (it % 128) / 4, g = it % 4, k0 = kb * 64;
            const float* Wsrc = a->in[I_WIN] + ((size_t)l * DM + k0) * IN_DIM + S_FFT + g * 128 + 8 * fq;
            bf16* WT = (bf16*)(ws + OFF_W + (size_t)l * W_LAYER + WO_FFT) + (size_t)(half * 512 + g * 128 + cb + fr) * DM + k0 + 8 * fq;
#pragma unroll 1
            for (int p = 0; p < 2; ++p) {
                f32x4 raw[2][4][2];
#pragma unroll
                for (int mi = 0; mi < 2; ++mi) { const int kk = 32 * p + 8 * (fr >> 2) + 4 * mi + (fr & 3);
#pragma unroll
                    for (int ct = 0; ct < 4; ++ct) { const float* sp = Wsrc + (size_t)kk * IN_DIM + 32 * ct; raw[mi][ct][0] = *(const f32x4*)sp; raw[mi][ct][1] = *(const f32x4*)(sp + 4); } }
                f32x4 acc[2][2];
#pragma unroll
                for (int mi = 0; mi < 2; ++mi)
#pragma unroll
                    for (int nt = 0; nt < 2; ++nt) acc[mi][nt] = (f32x4){0.f, 0.f, 0.f, 0.f};
#pragma unroll
                for (int mi = 0; mi < 2; ++mi)
#pragma unroll
                    for (int ct = 0; ct < 4; ++ct) { const f32x4 r0 = raw[mi][ct][0], r1 = raw[mi][ct][1];
                        v4u ah, al; ah.x = pk2(r0.x, r0.y); ah.y = pk2(r0.z, r0.w); ah.z = pk2(r1.x, r1.y); ah.w = pk2(r1.z, r1.w);
                        al.x = pk2(r0.x - bflo(ah.x), r0.y - bfhi(ah.x)); al.y = pk2(r0.z - bflo(ah.y), r0.w - bfhi(ah.y)); al.z = pk2(r1.x - bflo(ah.z), r1.y - bfhi(ah.z)); al.w = pk2(r1.z - bflo(ah.w), r1.w - bfhi(ah.w));
#pragma unroll
                        for (int nt = 0; nt < 2; ++nt) {
                            acc[mi][nt] = __builtin_amdgcn_mfma_f32_16x16x32_bf16(__builtin_bit_cast(bfx8, ah), __builtin_bit_cast(bfx8, th[nt][ct]), acc[mi][nt], 0, 0, 0);
                            acc[mi][nt] = __builtin_amdgcn_mfma_f32_16x16x32_bf16(__builtin_bit_cast(bfx8, ah), __builtin_bit_cast(bfx8, tl[nt][ct]), acc[mi][nt], 0, 0, 0);
                            acc[mi][nt] = __builtin_amdgcn_mfma_f32_16x16x32_bf16(__builtin_bit_cast(bfx8, al), __builtin_bit_cast(bfx8, th[nt][ct]), acc[mi][nt], 0, 0, 0); } }
#pragma unroll
                for (int nt = 0; nt < 2; ++nt)
                    *(v4u*)(WT + (size_t)(16 * nt) * DM + 32 * p) = (v4u){pk2(acc[0][nt][0], acc[0][nt][1]), pk2(acc[0][nt][2], acc[0][nt][3]), pk2(acc[1][nt][0], acc[1][nt][1]), pk2(acc[1][nt][2], acc[1][nt][3])};
            }
        }
        __syncthreads();
    }
    const int gw = bid * NWAVES + wave, NGW = G * NWAVES;
    if (sel & 4) {
        LAS float* scr = (LAS float*)(lds + wave * 8448);
        f32x4 v0[8], v1[8]; int it = gw;
        if (it < DEPTH * IT_LAYER) { CvItem c0 = cv_decode(a, it / IT_LAYER, it % IT_LAYER); cv_load(c0, v0, lane);
            for (;;) { const int itn = it + NGW; const bool more = itn < DEPTH * IT_LAYER; CvItem c1 = c0;
                if (more) { c1 = cv_decode(a, itn / IT_LAYER, itn % IT_LAYER); cv_load(c1, v1, lane); }
                cv_store(c0, v0, scr, lane);
                if (!more) break;
#pragma unroll
                for (int i = 0; i < 8; ++i) v0[i] = v1[i];
                c0 = c1; it = itn; } }
    }
    if (sel & 8) {
        const int gt = bid * NTHR + tid, NGT = G * NTHR;
        bf16* FL = (bf16*)(ws + OFF_DFTL); bf16* FC = (bf16*)(ws + OFF_DFTC);
        { bf16* WLT = (bf16*)(ws + OFF_WLT);
          for (int i = gt; i < DEPTH * 512 * 320; i += NGT) { const int l = i / (512 * 320), c = (i / 320) % 512, j = i % 320; float v;
              if (j < 64) v = a->in[I_RW2][((size_t)(l * 2 + 0) * 64 + j) * 512 + c]; else if (j < 128) v = a->in[I_RW2][((size_t)(l * 2 + 1) * 64 + (j - 64)) * 512 + c];
              else if (j < 192) v = a->in[I_RA2][((size_t)l * 64 + (j - 128)) * 512 + c]; else v = a->in[I_RG2][((size_t)l * 128 + (j - 192)) * 512 + c];
              WLT[i] = (bf16)f2bf(v); } }
        for (int i = gt; i < 2048 * 512; i += NGT) { const int lp = i >> 9, k8 = (i & 511) * 8; unsigned o[4];
#pragma unroll
            for (int e = 0; e < 4; ++e) { float v[2];
#pragma unroll
                for (int q = 0; q < 2; ++q) { const int k = k8 + 2 * e + q; const int m = (lp * (k & 2047)) & 2047; float sn, cs; sincospif((float)m * (1.f / 1024.f), &sn, &cs); v[q] = (k < 2048 ? cs : -sn) * (1.f / 512.f); }
                o[e] = pk2(v[0], v[1]); }
            *(v4u*)(FL + (size_t)lp * 4096 + k8) = (v4u){o[0], o[1], o[2], o[3]}; }
        for (int i = gt; i < 256 * 64; i += NGT) { const int lp = i >> 6, k8 = (i & 63) * 8; unsigned o[4];
#pragma unroll
            for (int e = 0; e < 4; ++e) { float v[2];
#pragma unroll
                for (int q = 0; q < 2; ++q) { const int k = k8 + 2 * e + q; const int m = (lp * (k & 255)) & 255; float sn, cs; sincospif((float)m * (1.f / 128.f), &sn, &cs); v[q] = (k < 256 ? cs : -sn) * 0.005524271728f; }
                o[e] = pk2(v[0], v[1]); }
            *(v4u*)(FC + (size_t)lp * 512 + k8) = (v4u){o[0], o[1], o[2], o[3]}; }
    }
}

__device__ __forceinline__ void norm_phase(KArgs a, int mode, const float* gY, const float* gH, const float* modY  , const float* modH  ,
                                           int bid, int G, const int wave0, int nrows, bool split = false  , bool dry = false  , bool xin = false  ) {
    PH_IDS
    unsigned char* ws = a->ws; const int gw = bid * NWAVES + wave, NGW = G * NWAVES;
    const float* X = (const float*)(ws + OFF_X); const bf16* Y = (const bf16*)(ws + OFF_Y); bf16* H = (bf16*)(ws + (dry ? OFF_M : OFF_H)); float* Xw = (float*)(ws + (dry ? OFF_MBUF : OFF_X));
    f32x4 xn[8]; v2u yn[8];
    auto fetch = [&](int row) {
        const f32x4* xr = (const f32x4*)(xin ? (row < TLAT ? a->in[I_X] + (size_t)row * DM : a->in[I_CTX] + (size_t)(row - TLAT) * DM) : X + (size_t)row * DM) + lane;
#pragma unroll
        for (int j = 0; j < 8; ++j) xn[j] = xr[64 * j];
        if (mode != 0 && !(split && row >= TLAT)) { const v2u* yr = (const v2u*)(Y + (size_t)row * DM) + lane;
#pragma unroll
            for (int j = 0; j < 8; ++j) yn[j] = yr[64 * j]; } };
    if (gw < nrows) fetch(gw);
    for (int row = gw; row < nrows; row += NGW) {
        const int mr = row < TLAT ? (row >> 11) : 4;
        f32x4 x[8];
#pragma unroll
        for (int j = 0; j < 8; ++j) x[j] = xn[j];
        if (mode != 0) {
            f32x4 y[8]; float ss = 0.f;
            if (split && row >= TLAT) { const v2u* yc = (const v2u*)((const bf16*)(ws + OFF_YC) + (size_t)(row - TLAT) * DM) + lane;
#pragma unroll
                for (int j = 0; j < 8; ++j) { f32x4 t = (f32x4){0.f, 0.f, 0.f, 0.f};
#pragma unroll
                    for (int sl = 0; sl < 8; ++sl) { const v2u q = yc[(size_t)sl * 1024 * 512 + 64 * j]; t += (f32x4){bflo(q.x), bfhi(q.x), bflo(q.y), bfhi(q.y)}; }
                    y[j] = t; } }
            else {
#pragma unroll
                for (int j = 0; j < 8; ++j) { const v2u t = yn[j]; y[j] = (f32x4){bflo(t.x), bfhi(t.x), bflo(t.y), bfhi(t.y)}; } }
            const f32x4* gp = (const f32x4*)gY + lane; const f32x4* gt = (const f32x4*)(modY + (size_t)mr * 12288) + lane;
            f32x4 gv[8], tv[8];
#pragma unroll
            for (int j = 0; j < 8; ++j) { gv[j] = gp[64 * j]; tv[j] = gt[64 * j]; }
            if (row + NGW < nrows) fetch(row + NGW);
#pragma unroll
            for (int j = 0; j < 8; ++j) { ss += (y[j].x * y[j].x + y[j].y * y[j].y) + (y[j].z * y[j].z + y[j].w * y[j].w); }
            const float r = rsqrtf(wave_sum(ss) * (1.f / DM) + 1e-6f);
#pragma unroll
            for (int j = 0; j < 8; ++j) x[j] += tv[j] * (y[j] * r * gv[j]);
        } else if (row + NGW < nrows) fetch(row + NGW);
        f32x4 hg[8], hs[8], hc[8];
        if (mode != 2) { const f32x4* gp = (const f32x4*)gH + lane; const f32x4* sh = (const f32x4*)(modH + (size_t)mr * 12288) + lane; const f32x4* sc = sh + 512;
#pragma unroll
            for (int j = 0; j < 8; ++j) { hg[j] = gp[64 * j]; hs[j] = sh[64 * j]; hc[j] = sc[64 * j]; } }
        asm volatile("" ::: "memory");
        if (mode == 1) { f32x4* xw = (f32x4*)(Xw + (size_t)row * DM) + lane;
#pragma unroll
            for (int j = 0; j < 8; ++j) xw[64 * j] = x[j]; }
        else if (mode == 2) { f32x4* ow = (f32x4*)(a->out + (size_t)row * DM) + lane;
#pragma unroll
            for (int j = 0; j < 8; ++j) ow[64 * j] = x[j]; }
        if (mode != 2) {
            float ss = 0.f;
#pragma unroll
            for (int j = 0; j < 8; ++j) ss += (x[j].x * x[j].x + x[j].y * x[j].y) + (x[j].z * x[j].z + x[j].w * x[j].w);
            const float r = rsqrtf(wave_sum(ss) * (1.f / DM) + 1e-6f);
            v2u* hw = (v2u*)(H + (size_t)row * DM) + lane;
#pragma unroll
            for (int j = 0; j < 8; ++j) { const f32x4 h = (x[j] * r * hg[j]) * (hc[j] + 1.f) + hs[j]; hw[64 * j] = (v2u){pk2(h.x, h.y), pk2(h.z, h.w)}; }
        }
    }
}
#define XB_TMO      128
#define XB_XCNT(j)  (256  + 64 * (j))
#define XB_XSUB(j)  (1280 + 64 * (j))
#define XB_XGEN(j)  (2304 + 64 * (j))
#define XB_TOP      3328
#define XB_TOPGEN   3392
#define XCD_BAR_WORDS 3456
#define XB_SPIN_CAP (1u << 18)

__device__ __forceinline__ unsigned xb_ld(unsigned* p)              { return __hip_atomic_load(p, __ATOMIC_RELAXED, __HIP_MEMORY_SCOPE_AGENT); }
__device__ __forceinline__ unsigned xb_add(unsigned* p, unsigned v) { return __hip_atomic_fetch_add(p, v, __ATOMIC_RELAXED, __HIP_MEMORY_SCOPE_AGENT); }
__device__ __forceinline__ unsigned xb_xcc_id() { return (unsigned)__builtin_amdgcn_s_getreg((3 << 11) | 20) & 0xFu; }
#define XB_SPIN(cond, bar) do { unsigned _sp = 0; while (cond) { __builtin_amdgcn_s_sleep(1); \
    if ((++_sp & 255u) == 0u) { if (xb_ld(&(bar)[XB_TMO])) break; if (_sp > XB_SPIN_CAP) { atomicAdd(&(bar)[XB_TMO], 1u); break; } } } } while (0)

struct XcdBarrier {
    unsigned* bar; unsigned x; int wv;
    volatile LAS unsigned* st;
};

__device__ __forceinline__ bool xb_t0(int wv) { unsigned z_ = 0u; asm volatile("" : "+v"(z_)); return wv == 0 && __builtin_amdgcn_mbcnt_hi(~0u, __builtin_amdgcn_mbcnt_lo(~0u, z_)) == 0u; }
__device__ __forceinline__ XcdBarrier xcd_barrier_post(unsigned* bar, volatile LAS unsigned* st, int wv) {
    XcdBarrier b; b.bar = bar; b.x = xb_xcc_id(); b.st = st; b.wv = wv;
    if (xb_t0(wv)) (void)xb_add(&bar[XB_XCNT(b.x)], 1u);
    return b;
}
__device__ __forceinline__ void xcd_barrier_complete(unsigned* bar, unsigned x, unsigned& nloc, unsigned& nx) {
    const unsigned G = gridDim.x * gridDim.y * gridDim.z;
    unsigned sum, cnt, mine, sp = 0u;
    for (;;) {
        sum = 0u; cnt = 0u; mine = 0u;
#pragma unroll
        for (unsigned j = 0; j < 16; ++j) { const unsigned c = xb_ld(&bar[XB_XCNT(j)]); sum += c; cnt += (c > 0u) ? 1u : 0u; mine = (j == x) ? c : mine; }
        if (sum == G) break;
        __builtin_amdgcn_s_sleep(1);
        if ((++sp & 255u) == 0u) { if (xb_ld(&bar[XB_TMO])) break; if (sp > XB_SPIN_CAP) { atomicAdd(&bar[XB_TMO], 1u); break; } }
    }
    nloc = mine > 0u ? mine : 1u; nx = cnt > 0u ? cnt : 1u;
}

__device__ __forceinline__ void xcd_barrier(const XcdBarrier& b) {
    asm volatile("s_waitcnt vmcnt(0)" ::: "memory");
    __syncthreads();
    if (xb_t0(b.wv)) {
        unsigned* bar = b.bar;
        __builtin_amdgcn_s_waitcnt(0);
        unsigned nloc = b.st[0], nx = b.st[1];
        if (nloc == 0u) { xcd_barrier_complete(bar, b.x, nloc, nx); b.st[0] = nloc; b.st[1] = nx; }
        const unsigned old = xb_add(&bar[XB_XSUB(b.x)], 1u);
        const unsigned gen = old / nloc;
        if (old + 1u == (gen + 1u) * nloc) {
            __builtin_amdgcn_fence(__ATOMIC_RELEASE, "agent");
            asm volatile("s_waitcnt vmcnt(0)" ::: "memory");
            const unsigned og = xb_add(&bar[XB_TOP], 1u);
            const unsigned tg = og / nx;
            if (og + 1u == (tg + 1u) * nx) xb_add(&bar[XB_TOPGEN], 1u);
            else XB_SPIN(xb_ld(&bar[XB_TOPGEN]) == tg, bar);
            __builtin_amdgcn_fence(__ATOMIC_ACQUIRE, "agent");
            xb_add(&bar[XB_XGEN(b.x)], 1u);
            asm volatile("s_waitcnt vmcnt(0)" ::: "memory");
        } else {
            XB_SPIN(xb_ld(&bar[XB_XGEN(b.x)]) == gen, bar);
            __builtin_amdgcn_fence(__ATOMIC_ACQUIRE, "agent");
            asm volatile("s_waitcnt vmcnt(0)" ::: "memory");
        }
    }
    __syncthreads();
}

constexpr int RCH_NT = 0, RCH_RT = 2048, RCH_KST = 4096, RCH_TT = 4608, RCH_ART = 5120, RCH_KRT = 5632, RCH_VM = 6144, RCH_APT = 8192, RCH_KPT = 10240, RCH_GC = 12288, RCH_BYTES = 12544;

typedef short bf16x8 __attribute__((ext_vector_type(8)));
constexpr int RP_PITCH = 516, ACT_PITCH = 328;
__device__ __forceinline__ void rwkv_prep_item(KArgs a, int l, int item, LAS unsigned char* lds, int tid, int lane, int wave) {
    unsigned char* ws = a->ws;
    const bf16* U = (const bf16*)(ws + OFF_U); const float* MISC = (const float*)(ws + OFF_MISC);
    const int b = item / 144, j0 = (item % 144) * 16; const bool isctx = j0 < LCTX;
    LAS float* RP = (LAS float*)lds;
    LAS float* KP = RP + 16 * RP_PITCH; LAS float* VP = KP + 16 * RP_PITCH;
    LAS bf16* ACT = (LAS bf16*)(lds + 3 * 16 * RP_PITCH * 4);
    const float* mu = a->in[I_RMU] + l * 1856;
    bf16x8 wfr[10][4];
    { const bf16* WLT = (const bf16*)(ws + OFF_WLT) + (size_t)l * 512 * 320 + (size_t)(64 * wave + (lane & 15)) * 320 + (lane >> 4) * 8;
#pragma unroll
      for (int ks = 0; ks < 10; ++ks)
#pragma unroll
          for (int nt = 0; nt < 4; ++nt) wfr[ks][nt] = *(const bf16x8*)(WLT + (size_t)nt * 16 * 320 + ks * 32); }
#pragma unroll
    for (int it_ = 0; it_ < 6; ++it_) { const int idx = tid + it_ * NTHR; const int i = idx / 192, c8 = idx % 192, jj = j0 + i;
        const bool hp = isctx ? (jj - 1 >= 0) : (jj - 1 >= LCTX), hn = isctx ? (jj + 1 < LCTX) : (jj + 1 < RJ);
        const v4u c = *(const v4u*)(U + (size_t)rwkv_tok(b, jj) * NU + URKV + c8 * 8);
        v4u p = (v4u){0u, 0u, 0u, 0u}, n = p;
        if (hp) p = *(const v4u*)(U + (size_t)rwkv_tok(b, jj - 1) * NU + URKV + c8 * 8);
        if (hn) n = *(const v4u*)(U + (size_t)rwkv_tok(b, jj + 1) * NU + URKV + c8 * 8);
        const f32x4 m0 = *(const f32x4*)(mu + c8 * 8), m1 = *(const f32x4*)(mu + c8 * 8 + 4);
        f32x4 x0 = (f32x4){bflo(c.x), bfhi(c.x), bflo(c.y), bfhi(c.y)}, x1 = (f32x4){bflo(c.z), bfhi(c.z), bflo(c.w), bfhi(c.w)};
        const f32x4 s0 = (f32x4){bflo(p.x) + bflo(n.x), bfhi(p.x) + bfhi(n.x), bflo(p.y) + bflo(n.y), bfhi(p.y) + bfhi(n.y)}, s1 = (f32x4){bflo(p.z) + bflo(n.z), bfhi(p.z) + bfhi(n.z), bflo(p.w) + bflo(n.w), bfhi(p.w) + bfhi(n.w)};
        x0 = x0 + (0.5f * s0 - x0) * m0; x1 = x1 + (0.5f * s1 - x1) * m1;
        const int ch = c8 * 8, reg = ch >> 9; LAS float* dst = (reg == 0 ? RP : (reg == 1 ? KP : VP)) + i * RP_PITCH + (ch & 511);
        *(LAS f32x4*)dst = x0; *(LAS f32x4*)(dst + 4) = x1; }
#pragma unroll
    for (int it_ = 0; it_ < 3; ++it_) { const int idx = tid + it_ * NTHR; if (idx >= 16 * 80) break; const int i = idx / 80, c4 = idx % 80, jj = j0 + i;
        const bool hp = isctx ? (jj - 1 >= 0) : (jj - 1 >= LCTX), hn = isctx ? (jj + 1 < LCTX) : (jj + 1 < RJ);
        f32x4 x = *(const f32x4*)(MISC + (size_t)rwkv_tok(b, jj) * 512 + 64 + c4 * 4); f32x4 p = (f32x4){0.f, 0.f, 0.f, 0.f}, n = p;
        if (hp) p = *(const f32x4*)(MISC + (size_t)rwkv_tok(b, jj - 1) * 512 + 64 + c4 * 4);
        if (hn) n = *(const f32x4*)(MISC + (size_t)rwkv_tok(b, jj + 1) * 512 + 64 + c4 * 4);
        x = x + (0.5f * (p + n) - x) * *(const f32x4*)(mu + 1536 + c4 * 4);
        const int m = c4 * 4;
        if (m < 128) x = (f32x4){tanhf(x.x), tanhf(x.y), tanhf(x.z), tanhf(x.w)}; else if (m >= 192) x = (f32x4){sigmoidf_(x.x), sigmoidf_(x.y), sigmoidf_(x.z), sigmoidf_(x.w)};
        *(LAS v2u*)(ACT + i * ACT_PITCH + m) = (v2u){pk2(x.x, x.y), pk2(x.z, x.w)}; }
    __syncthreads();
    const int fr = lane & 15, fq = lane >> 4, h = wave;
    f32x4 acc[4][4];
#pragma unroll
    for (int o = 0; o < 4; ++o)
#pragma unroll
        for (int nt = 0; nt < 4; ++nt) acc[o][nt] = (f32x4){0.f, 0.f, 0.f, 0.f};
    {
#pragma unroll
        for (int ks = 0; ks < 10; ++ks) { const int o = ks < 2 ? 0 : (ks < 4 ? 1 : (ks < 6 ? 2 : 3));
            const bf16x8 af = *(const LAS bf16x8*)(ACT + fr * ACT_PITCH + ks * 32 + fq * 8);
#pragma unroll
            for (int nt = 0; nt < 4; ++nt) acc[o][nt] = __builtin_amdgcn_mfma_f32_16x16x32_bf16(af, wfr[ks][nt], acc[o][nt], 0, 0, 0); }
    }
    float* RW = (float*)(ws + OFF_RW); constexpr size_t AS = RW_ARR / 4; float* RSC = (float*)(ws + OFF_RSC);
    float w0f[4], w0b[4], a0c[4], kkc[4], kac[4], rkc[4];
#pragma unroll
    for (int nt = 0; nt < 4; ++nt) { const int c = 64 * wave + 16 * nt + fr; w0f[nt] = a->in[I_RW0][(l * 2 + 0) * 512 + c]; w0b[nt] = a->in[I_RW0][(l * 2 + 1) * 512 + c]; a0c[nt] = a->in[I_RA0][l * 512 + c];
        kkc[nt] = a->in[I_RKK][l * 512 + c]; kac[nt] = a->in[I_RKA][l * 512 + c]; rkc[nt] = a->in[I_RRK][l * 512 + c]; }
    float Wd[2][4][4], Rr[4][4], Km[4][4], Nn[4][4], Ka[4][4], Vv[4][4];
#pragma unroll
    for (int i = 0; i < 4; ++i) { const int tok = 4 * fq + i; const size_t R = (size_t)b * RJ + j0 + tok;
        float k[4], av[4], kkv[4]; float ss = 0.f;
#pragma unroll
        for (int nt = 0; nt < 4; ++nt) { const int c = 64 * wave + 16 * nt + fr; Rr[i][nt] = RP[tok * RP_PITCH + c]; k[nt] = KP[tok * RP_PITCH + c]; Vv[i][nt] = VP[tok * RP_PITCH + c];
            av[nt] = sigmoidf_(a0c[nt] + acc[2][nt][i]); kkv[nt] = k[nt] * kkc[nt]; ss += kkv[nt] * kkv[nt]; }
        const float rn = rsqrtf(row16_sum(ss) + 1e-12f);
        float bon = 0.f;
#pragma unroll
        for (int nt = 0; nt < 4; ++nt) { const int c = 64 * wave + 16 * nt + fr;
            Wd[0][i][nt] = __expf(-__expf(-softplusf_(-(w0f[nt] + acc[0][nt][i])) - 0.5f)); Wd[1][i][nt] = __expf(-__expf(-softplusf_(-(w0b[nt] + acc[1][nt][i])) - 0.5f));
            const float kk = kkv[nt] * rn; Km[i][nt] = k[nt] * (1.f + (av[nt] - 1.f) * kac[nt]); Ka[i][nt] = kk * av[nt]; Nn[i][nt] = -kk;
            bon += Rr[i][nt] * Km[i][nt] * rkc[nt];
            float* o = RW + R * 512 + c; o[7 * AS] = Vv[i][nt]; o[8 * AS] = acc[3][nt][i]; }
        bon = row16_sum(bon);
        if (fr == 0) RSC[(size_t)2 * TT * 8 + R * 8 + h] = bon;
    }
    __syncthreads();
    LAS unsigned char* wl_ = lds + wave * 14336;
    LAS bf16* NTl = (LAS bf16*)wl_; LAS bf16* RTl = NTl + 16 * 68; LAS bf16* ATl = RTl + 16 * 68; LAS bf16* KTl = ATl + 16 * 68;
    LAS float* ASl = (LAS float*)(wl_ + 8704);
    LAS float* TTl = (LAS float*)(wl_ + 11264);
    typedef short bf16x4 __attribute__((ext_vector_type(4)));
#pragma unroll
    for (int d = 0; d < 2; ++d) {
        const int cidx = d ? (isctx ? (240 - j0) / 16 : (2544 - j0) / 16) : j0 / 16;
        unsigned char* img = ws + OFF_RCH + ((size_t)((b * 2 + d) * 8 + h) * 144 + cidx) * RCH_BYTES;
        const int laneD = d ? ((3 - fq) * 16 + fr) : lane;
#pragma unroll
        for (int nt = 0; nt < 4; ++nt) {
            float gam[4], gpv[4], G, E;
            if (d == 0) { gam[0] = Wd[0][0][nt]; gam[1] = gam[0] * Wd[0][1][nt]; gam[2] = gam[1] * Wd[0][2][nt]; gam[3] = gam[2] * Wd[0][3][nt]; G = gam[3];
                const float g1 = __int_as_float(__builtin_amdgcn_ds_bpermute((lane - 16) << 2, __float_as_int(G))), g2 = __int_as_float(__builtin_amdgcn_ds_bpermute((lane - 32) << 2, __float_as_int(G))), g3 = __int_as_float(__builtin_amdgcn_ds_bpermute((lane - 48) << 2, __float_as_int(G)));
                E = (fq >= 1 ? g1 : 1.f) * (fq >= 2 ? g2 : 1.f) * (fq >= 3 ? g3 : 1.f);
                gpv[0] = E; gpv[1] = E * gam[0]; gpv[2] = E * gam[1]; gpv[3] = E * gam[2];
#pragma unroll
                for (int i = 0; i < 4; ++i) gam[i] *= E; }
            else { gam[3] = Wd[1][3][nt]; gam[2] = gam[3] * Wd[1][2][nt]; gam[1] = gam[2] * Wd[1][1][nt]; gam[0] = gam[1] * Wd[1][0][nt]; G = gam[0];
                const float g1 = __int_as_float(__builtin_amdgcn_ds_bpermute((lane + 16) << 2, __float_as_int(G))), g2 = __int_as_float(__builtin_amdgcn_ds_bpermute((lane + 32) << 2, __float_as_int(G))), g3 = __int_as_float(__builtin_amdgcn_ds_bpermute((lane + 48) << 2, __float_as_int(G)));
                E = (fq <= 2 ? g1 : 1.f) * (fq <= 1 ? g2 : 1.f) * (fq <= 0 ? g3 : 1.f);
                gpv[3] = E; gpv[2] = E * gam[3]; gpv[1] = E * gam[2]; gpv[0] = E * gam[1];
#pragma unroll
                for (int i = 0; i < 4; ++i) gam[i] *= E; }
            float tot = G * __int_as_float(__builtin_amdgcn_ds_bpermute((lane ^ 16) << 2, __float_as_int(G)));
            tot = tot * __int_as_float(__builtin_amdgcn_ds_bpermute((lane ^ 32) << 2, __float_as_int(tot)));
            float ap[4], kp[4];
#pragma unroll
            for (int i = 0; i < 4; ++i) { const int td = d ? 15 - (4 * fq + i) : 4 * fq + i; const float ig = __builtin_amdgcn_rcpf(gam[i]);
                const float at_ = Ka[i][nt] * ig, kt_ = Km[i][nt] * ig; ap[i] = at_ * tot; kp[i] = kt_ * tot;
                NTl[td * 68 + 16 * nt + fr] = bf1(gpv[i] * Nn[i][nt]); RTl[td * 68 + 16 * nt + fr] = bf1(gam[i] * Rr[i][nt]);
                ATl[td * 68 + 16 * nt + fr] = bf1(at_); KTl[td * 68 + 16 * nt + fr] = bf1(kt_); }
            v2u pa, pk, pv;
            if (d == 0) { pa = (v2u){pk2(ap[0], ap[1]), pk2(ap[2], ap[3])}; pk = (v2u){pk2(kp[0], kp[1]), pk2(kp[2], kp[3])}; pv = (v2u){pk2(Vv[0][nt], Vv[1][nt]), pk2(Vv[2][nt], Vv[3][nt])}; }
            else { pa = (v2u){pk2(ap[3], ap[2]), pk2(ap[1], ap[0])}; pk = (v2u){pk2(kp[3], kp[2]), pk2(kp[1], kp[0])}; pv = (v2u){pk2(Vv[3][nt], Vv[2][nt]), pk2(Vv[1][nt], Vv[0][nt])}; }
            *(v2u*)(img + RCH_APT + nt * 512 + laneD * 8) = pa; *(v2u*)(img + RCH_KPT + nt * 512 + laneD * 8) = pk; *(v2u*)(img + RCH_VM + nt * 512 + laneD * 8) = pv;
            if (fq == 0) *(float*)(img + RCH_GC + (16 * nt + fr) * 4) = tot;
        }
        LDS_WAIT();
#pragma unroll
        for (int kt = 0; kt < 4; ++kt) { *(v2u*)(img + RCH_NT + kt * 512 + lane * 8) = *(const LAS v2u*)(NTl + fr * 68 + 16 * kt + 4 * fq); *(v2u*)(img + RCH_RT + kt * 512 + lane * 8) = *(const LAS v2u*)(RTl + fr * 68 + 16 * kt + 4 * fq); }
        f32x4 cAs = (f32x4){0.f, 0.f, 0.f, 0.f}, cKs = cAs, cAr = cAs, cKr = cAs;
#pragma unroll
        for (int sk = 0; sk < 4; ++sk) { const bf16x4 aA = *(const LAS bf16x4*)(ATl + fr * 68 + 16 * sk + 4 * fq), aK = *(const LAS bf16x4*)(KTl + fr * 68 + 16 * sk + 4 * fq);
            const bf16x4 bN = *(const LAS bf16x4*)(NTl + fr * 68 + 16 * sk + 4 * fq), bR = *(const LAS bf16x4*)(RTl + fr * 68 + 16 * sk + 4 * fq);
            cAs = __builtin_amdgcn_mfma_f32_16x16x16bf16_1k(aA, bN, cAs, 0, 0, 0); cKs = __builtin_amdgcn_mfma_f32_16x16x16bf16_1k(aK, bN, cKs, 0, 0, 0);
            cAr = __builtin_amdgcn_mfma_f32_16x16x16bf16_1k(aA, bR, cAr, 0, 0, 0); cKr = __builtin_amdgcn_mfma_f32_16x16x16bf16_1k(aK, bR, cKr, 0, 0, 0); }
#pragma unroll
        for (int j = 0; j < 4; ++j) { const int ii = 4 * fq + j; if (!(ii < fr)) { cAs[j] = 0.f; cKs[j] = 0.f; } if (!(ii <= fr)) { cAr[j] = 0.f; cKr[j] = 0.f; } }
        *(v2u*)(img + RCH_KST + lane * 8) = (v2u){pk2(cKs[0], cKs[1]), pk2(cKs[2], cKs[3])}; *(v2u*)(img + RCH_ART + lane * 8) = (v2u){pk2(cAr[0], cAr[1]), pk2(cAr[2], cAr[3])};
        *(v2u*)(img + RCH_KRT + lane * 8) = (v2u){pk2(cKr[0], cKr[1]), pk2(cKr[2], cKr[3])};
        *(LAS f32x4*)(ASl + (d * 16 + fr) * 20 + 4 * fq) = cAs;
        LDS_WAIT();
    }
    if (lane < 32) { const int d = lane >> 4, irow = lane & 15; float Tc[16];
#pragma unroll
        for (int t = 0; t < 16; ++t) { float x = (irow == t) ? 1.f : 0.f;
#pragma unroll
            for (int j4 = 0; j4 < (t + 3) / 4; ++j4) { const f32x4 av = *(const LAS f32x4*)(ASl + (d * 16 + t) * 20 + 4 * j4);
#pragma unroll
                for (int e = 0; e < 4; ++e) if (4 * j4 + e < t) x += Tc[4 * j4 + e] * av[e]; }
            Tc[t] = x; TTl[(d * 16 + t) * 20 + irow] = x; } }
    LDS_WAIT();
#pragma unroll
    for (int d = 0; d < 2; ++d) { const int cidx = d ? (isctx ? (240 - j0) / 16 : (2544 - j0) / 16) : j0 / 16;
        unsigned char* img = ws + OFF_RCH + ((size_t)((b * 2 + d) * 8 + h) * 144 + cidx) * RCH_BYTES;
        const f32x4 tv = *(const LAS f32x4*)(TTl + (d * 16 + fr) * 20 + 4 * fq);
        *(v2u*)(img + RCH_TT + lane * 8) = (v2u){pk2(tv[0], tv[1]), pk2(tv[2], tv[3])}; }
    __syncthreads();
}
__device__ __forceinline__ void ssd_prep_item(KArgs a, int l, int item, int tid) {
    unsigned char* ws = a->ws; const bf16* U = (const bf16*)(ws + OFF_U); const float* MISC = (const float*)(ws + OFF_MISC);
    bf16* XBC = (bf16*)(ws + OFF_XBC); float* DTA = (float*)(ws + OFF_DTA);
    const int t0 = item * 16;
    const int seq_lo = t0 < TLAT ? (t0 & ~(LSEQ - 1)) : TLAT + ((t0 - TLAT) & ~(LCTX - 1)), seq_hi = seq_lo + (t0 < TLAT ? LSEQ : LCTX);
    for (int cp = tid; cp < 896; cp += NTHR) {
        float w0[5], w1[5];
#pragma unroll
        for (int j = 0; j < 5; ++j) { const f32x2 w = *(const f32x2*)(a->in[I_SCW] + (size_t)(l * 5 + j) * 1792 + 2 * cp); w0[j] = w.x; w1[j] = w.y; }
        const f32x2 bb = *(const f32x2*)(a->in[I_SCB] + l * 1792 + 2 * cp);
        float i0[20], i1[20];
#pragma unroll
        for (int r = 0; r < 20; ++r) { const int row = t0 - 2 + r; unsigned u = 0u; if (row >= seq_lo && row < seq_hi) u = *(const unsigned*)(U + (size_t)row * NU + UXBC + 2 * cp); i0[r] = bflo(u); i1[r] = bfhi(u); }
#pragma unroll
        for (int o = 0; o < 16; ++o) { float s0 = bb.x, s1 = bb.y;
#pragma unroll
            for (int j = 0; j < 5; ++j) { s0 += w0[j] * i0[o + j]; s1 += w1[j] * i1[o + j]; }
            *(unsigned*)(XBC + (size_t)(t0 + o) * 1792 + 2 * cp) = pk2(siluf_(s0), siluf_(s1)); }
    }
    if (tid < 16 * 24) { const int o = tid / 24, q = tid % 24;
        const float dt = softplusf_(MISC[(size_t)(t0 + o) * 512 + q] + a->in[I_SDTB][l * 24 + q]); const float A = -__expf(a->in[I_SALOG][l * 24 + q]);
        DTA[(size_t)(t0 + o) * 48 + q] = dt; DTA[(size_t)(t0 + o) * 48 + 24 + q] = dt * A; }
}
__device__ __forceinline__ void conv_item(KArgs a, int l, int item, LAS unsigned char* lds, int tid, int lane, int wave) {
    unsigned char* ws = a->ws; const bf16* U = (const bf16*)(ws + OFF_U); bf16* AC = (bf16*)(ws + OFF_ACAT) + AC_CONV;
    int t0, seg_lo, seg_hi;
    if (item < 256) { t0 = item * 32; seg_lo = t0 & ~63; seg_hi = seg_lo + 64; }
    else { const int ci = item - 256; t0 = TLAT + ci * 32; seg_lo = TLAT + (ci >> 3) * LCTX; seg_hi = seg_lo + LCTX; }
    LAS bf16* inimg = (LAS bf16*)lds;
    LAS float* outimg = (LAS float*)(lds + 63488);
    v4u cva[8], cvg[8];
#pragma unroll
    for (int it_ = 0; it_ < 8; ++it_) { const int idx = tid + it_ * NTHR; const int rr = idx >> 6, c8 = idx & 63, row = t0 - 15 + rr; cva[it_] = (v4u){0u, 0u, 0u, 0u}; cvg[it_] = cva[it_];
        if (idx < 62 * 64 && row >= seg_lo && row < seg_hi) { cva[it_] = *(const v4u*)(U + (size_t)row * NU + UCONV + c8 * 8); cvg[it_] = *(const v4u*)(U + (size_t)row * NU + UCONV + 512 + c8 * 8); } }
#pragma unroll
    for (int it_ = 0; it_ < 8; ++it_) { const int idx = tid + it_ * NTHR; if (idx >= 62 * 64) break; const int rr = idx >> 6, c8 = idx & 63, row = t0 - 15 + rr;
        v4u o = (v4u){0u, 0u, 0u, 0u};
        if (row >= seg_lo && row < seg_hi) { const v4u va = cva[it_], vg = cvg[it_];
            o.x = pk2(bflo(va.x) * sigmoidf_(bflo(vg.x)), bfhi(va.x) * sigmoidf_(bfhi(vg.x))); o.y = pk2(bflo(va.y) * sigmoidf_(bflo(vg.y)), bfhi(va.y) * sigmoidf_(bfhi(vg.y)));
            o.z = pk2(bflo(va.z) * sigmoidf_(bflo(vg.z)), bfhi(va.z) * sigmoidf_(bfhi(vg.z))); o.w = pk2(bflo(va.w) * sigmoidf_(bflo(vg.w)), bfhi(va.w) * sigmoidf_(bfhi(vg.w))); }
        *(LAS v4u*)(inimg + rr * 512 + c8 * 8) = o; }
    __syncthreads();
    {
        const int cp = tid & 255, th = tid >> 8;
        f32x2 w[31];
#pragma unroll
        for (int j = 0; j < 31; ++j) w[j] = *(const f32x2*)(a->in[I_CONVW] + (size_t)(l * 31 + j) * 512 + 2 * cp);
        const f32x2 bias = *(const f32x2*)(a->in[I_CONVB] + l * 512 + 2 * cp);
        f32x2 o[16];
#pragma unroll
        for (int q = 0; q < 16; ++q) o[q] = bias;
        const LAS unsigned* ip = (const LAS unsigned*)(inimg + (16 * th) * 512 + 2 * cp);
#pragma unroll
        for (int r = 0; r < 46; ++r) { const unsigned u = ip[r * 256]; const f32x2 v = (f32x2){bflo(u), bfhi(u)};
#pragma unroll
            for (int q = 0; q < 16; ++q) if (r - q >= 0 && r - q < 31) o[q] += w[r - q] * v; }
#pragma unroll
        for (int q = 0; q < 16; ++q) *(LAS f32x2*)(outimg + (16 * th + q) * 512 + 2 * cp) = o[q];
    }
    __syncthreads();
    {
        const f32x4 g0 = *(const f32x4*)(a->in[I_CLNG] + l * 512 + 8 * lane), g1 = *(const f32x4*)(a->in[I_CLNG] + l * 512 + 8 * lane + 4);
        const f32x4 b0 = *(const f32x4*)(a->in[I_CLNB] + l * 512 + 8 * lane), b1 = *(const f32x4*)(a->in[I_CLNB] + l * 512 + 8 * lane + 4);
#pragma unroll
        for (int q = 0; q < 4; ++q) { const int o = wave * 4 + q;
            f32x4 x0 = *(const LAS f32x4*)(outimg + o * 512 + 8 * lane), x1 = *(const LAS f32x4*)(outimg + o * 512 + 8 * lane + 4);
            const float mean = wave_sum((x0.x + x0.y + x0.z + x0.w) + (x1.x + x1.y + x1.z + x1.w)) * (1.f / 512.f);
            x0 = x0 - mean; x1 = x1 - mean;
            const float var = wave_sum((x0.x * x0.x + x0.y * x0.y + x0.z * x0.z + x0.w * x0.w) + (x1.x * x1.x + x1.y * x1.y + x1.z * x1.z + x1.w * x1.w)) * (1.f / 512.f);
            const float rs = rsqrtf(var + 1e-5f);
            x0 = x0 * rs * g0 + b0; x1 = x1 * rs * g1 + b1;
            v4u ov; ov.x = pk2(siluf_(x0.x), siluf_(x0.y)); ov.y = pk2(siluf_(x0.z), siluf_(x0.w)); ov.z = pk2(siluf_(x1.x), siluf_(x1.y)); ov.w = pk2(siluf_(x1.z), siluf_(x1.w));
            *(v4u*)(AC + (size_t)(t0 + o) * ACW + 8 * lane) = ov; }
    }
    __syncthreads();
}

__device__ __forceinline__ int ssd_tok(int b, int dir, int pos) {
    if (pos < LCTX) return TLAT + b * LCTX + (dir ? (LCTX - 1 - pos) : pos);
    const int q = pos - LCTX; return b * LSEQ + (dir ? (LSEQ - 1 - q) : q);
}
__device__ __forceinline__ void post_phase(KArgs a, int l, int bid, int G, const int wave0) {
    PH_IDS
    unsigned char* ws = a->ws; const int gw = bid * NWAVES + wave, NGW = G * NWAVES;
    const bf16* U = (const bf16*)(ws + OFF_U); const bf16* XBC = (const bf16*)(ws + OFF_XBC);
    const float* Y0 = (const float*)(ws + OFF_YSSD); const float* Y1 = Y0 + (size_t)TT * 768; bf16* AS_ = (bf16*)(ws + OFF_ACAT) + AC_SSD;
    {
        f32x4 nyf[3], nyb[3]; v2u nxs[3], nz[3];
        auto fetch = [&](int row) {
#pragma unroll
            for (int j = 0; j < 3; ++j) { const int col = 4 * lane + 256 * j;
                nyf[j] = *(const f32x4*)(Y0 + (size_t)row * 768 + col); nyb[j] = *(const f32x4*)(Y1 + (size_t)row * 768 + col);
                nxs[j] = *(const v2u*)(XBC + (size_t)row * 1792 + col); nz[j] = *(const v2u*)(U + (size_t)row * NU + UZ + col); } };
        f32x4 gn[3]; float dsk[3];
#pragma unroll
        for (int j = 0; j < 3; ++j) { const int col = 4 * lane + 256 * j; gn[j] = *(const f32x4*)(a->in[I_SNG] + l * 768 + col); dsk[j] = a->in[I_SD][l * 12 + (col >> 6)]; }
        if (gw < TT) fetch(gw);
        for (int row = gw; row < TT; row += NGW) {
            f32x4 y[3]; float ss = 0.f;
#pragma unroll
            for (int j = 0; j < 3; ++j) { const v2u xs = nxs[j], z = nz[j];
                f32x4 v = nyf[j] + nyb[j] + dsk[j] * (f32x4){bflo(xs.x), bfhi(xs.x), bflo(xs.y), bfhi(xs.y)};
                v = v * (f32x4){siluf_(bflo(z.x)), siluf_(bfhi(z.x)), siluf_(bflo(z.y)), siluf_(bfhi(z.y))};
                y[j] = v; ss += (v.x * v.x + v.y * v.y) + (v.z * v.z + v.w * v.w); }
            if (row + NGW < TT) fetch(row + NGW);
            const float r = rsqrtf(wave_sum(ss) * (1.f / 768.f) + 1e-6f);
#pragma unroll
            for (int j = 0; j < 3; ++j) { const int col = 4 * lane + 256 * j; const f32x4 o = y[j] * r * gn[j];
                *(v2u*)(AS_ + (size_t)row * ACW + col) = (v2u){pk2(o.x, o.y), pk2(o.z, o.w)}; }
        }
    }
    const float* RW = (const float*)(ws + OFF_RW); constexpr size_t AS = RW_ARR / 4; const float* RSC = (const float*)(ws + OFF_RSC);
    const float* R0 = (const float*)(ws + OFF_YRW); const float* R1 = R0 + (size_t)TT * 512; bf16* AR = (bf16*)(ws + OFF_ACAT) + AC_RWKV;
    {
        const int c0 = 8 * lane, h = lane >> 3;
        const f32x4 lg0 = *(const f32x4*)(a->in[I_RLNG] + l * 512 + c0), lg1 = *(const f32x4*)(a->in[I_RLNG] + l * 512 + c0 + 4), lb0 = *(const f32x4*)(a->in[I_RLNB] + l * 512 + c0), lb1 = *(const f32x4*)(a->in[I_RLNB] + l * 512 + c0 + 4);
        f32x4 n0a, n0b, n1a, n1b, nv0, nv1, ng0, ng1; float nbon = 0.f;
        auto rowR = [&](int row) -> size_t { if (row < TLAT) { const int b = row >> 11, t = row & 2047, rr = t >> 6, cc = t & 63; return (size_t)b * RJ + LCTX + cc * 32 + rr; }
            const int b = (row - TLAT) >> 8, jj = (row - TLAT) & 255; return (size_t)b * RJ + jj; };
        auto fetch = [&](int row) { const size_t R = rowR(row);
            n0a = *(const f32x4*)(R0 + R * 512 + c0); n0b = *(const f32x4*)(R0 + R * 512 + c0 + 4); n1a = *(const f32x4*)(R1 + R * 512 + c0); n1b = *(const f32x4*)(R1 + R * 512 + c0 + 4);
            nv0 = *(const f32x4*)(RW + 7 * AS + R * 512 + c0); nv1 = *(const f32x4*)(RW + 7 * AS + R * 512 + c0 + 4); ng0 = *(const f32x4*)(RW + 8 * AS + R * 512 + c0); ng1 = *(const f32x4*)(RW + 8 * AS + R * 512 + c0 + 4);
            nbon = RSC[(size_t)2 * TT * 8 + R * 8 + h]; };
        if (gw < TT) fetch(gw);
        for (int row = gw; row < TT; row += NGW) {
            f32x4 ya = n0a + n1a, yb = n0b + n1b; const f32x4 v0 = nv0, v1 = nv1, g0 = ng0, g1 = ng1; const float bon = nbon;
            if (row + NGW < TT) fetch(row + NGW);
            float s = (ya.x + ya.y + ya.z + ya.w) + (yb.x + yb.y + yb.z + yb.w);
            s = sum8(s);
            const float mean = s * (1.f / 64.f); ya = ya - mean; yb = yb - mean;
            float q = (ya.x * ya.x + ya.y * ya.y + ya.z * ya.z + ya.w * ya.w) + (yb.x * yb.x + yb.y * yb.y + yb.z * yb.z + yb.w * yb.w);
            q = sum8(q);
            const float rs = rsqrtf(q * (1.f / 64.f) + 64e-5f);
            const f32x4 o0 = (ya * rs * lg0 + lb0 + bon * v0) * g0, o1 = (yb * rs * lg1 + lb1 + bon * v1) * g1;
            *(v4u*)(AR + (size_t)row * ACW + c0) = (v4u){pk2(o0.x, o0.y), pk2(o0.z, o0.w), pk2(o1.x, o1.y), pk2(o1.z, o1.w)};
        }
    }
}

__device__ __forceinline__ size_t rwkv_row(int b, int dir, int pos) { const int j = dir ? (pos < LCTX ? (LCTX - 1 - pos) : (RJ + LCTX - 1 - pos)) : pos; return (size_t)b * RJ + j; }
struct RchOps { v2u nt[4], rt[4], kst, tt, art, krt, vm, apt[4], kpt[4]; f32x4 gc[4]; };
__device__ __forceinline__ void rwkv_scan_chunk(KArgs a, int idx, LAS unsigned char* lds, int tid, int lane, int wave) {
    typedef short bf16x4 __attribute__((ext_vector_type(4)));
    unsigned char* ws = a->ws;
    const int b = idx >> 4, dir = (idx >> 3) & 1, h = idx & 7, fr = lane & 15, fq = lane >> 4;
    float* Yo = (float*)(ws + OFF_YRW) + (size_t)dir * TT * 512;
    const unsigned char* base = ws + OFF_RCH + (size_t)((b * 2 + dir) * 8 + h) * 144 * RCH_BYTES;
    constexpr int BLK = 4 * RCH_BYTES;
    const int lt = tid - 256;
    v4u pre[13];
    auto issue = [&](int blk) { const v4u* src = (const v4u*)(base + (size_t)blk * BLK);
#pragma unroll
        for (int i = 0; i < 13; ++i) { const int e = lt + i * 256; if (e < BLK / 16) pre[i] = src[e]; } };
    auto commit = [&](int buf) { LAS v4u* dst = (LAS v4u*)(lds + buf * BLK);
#pragma unroll
        for (int i = 0; i < 13; ++i) { const int e = lt + i * 256; if (e < BLK / 16) dst[e] = pre[i]; } };
    auto ld = [&](const LAS unsigned char* p0, int wv) { RchOps o; const LAS unsigned char* p = p0 + lane * 8;
#pragma unroll
        for (int kt = 0; kt < 4; ++kt) { o.nt[kt] = *(const LAS v2u*)(p + RCH_NT + kt * 512); o.rt[kt] = *(const LAS v2u*)(p + RCH_RT + kt * 512); o.apt[kt] = *(const LAS v2u*)(p + RCH_APT + kt * 512); o.kpt[kt] = *(const LAS v2u*)(p + RCH_KPT + kt * 512);
            o.gc[kt] = *(const LAS f32x4*)(p0 + RCH_GC + (16 * kt + 4 * fq) * 4); }
        o.kst = *(const LAS v2u*)(p + RCH_KST); o.tt = *(const LAS v2u*)(p + RCH_TT); o.art = *(const LAS v2u*)(p + RCH_ART); o.krt = *(const LAS v2u*)(p + RCH_KRT); o.vm = *(const LAS v2u*)(p + RCH_VM + wv * 512); return o; };
#define MF16(A_, B_, C_) __builtin_amdgcn_mfma_f32_16x16x16bf16_1k(__builtin_bit_cast(bf16x4, A_), __builtin_bit_cast(bf16x4, B_), C_, 0, 0, 0)
    f32x4 S[4];
#pragma unroll
    for (int kt = 0; kt < 4; ++kt) S[kt] = (f32x4){0.f, 0.f, 0.f, 0.f};
    auto step = [&](const RchOps& cur, int c) {
        v2u Sb[4];
#pragma unroll
        for (int kt = 0; kt < 4; ++kt) Sb[kt] = (v2u){pk2(S[kt][0], S[kt][1]), pk2(S[kt][2], S[kt][3])};
        f32x4 rhs = (f32x4){0.f, 0.f, 0.f, 0.f}, y = rhs;
#pragma unroll
        for (int kt = 0; kt < 4; ++kt) rhs = MF16(cur.nt[kt], Sb[kt], rhs);
        rhs = MF16(cur.kst, cur.vm, rhs);
        const v2u rb = (v2u){pk2(rhs[0], rhs[1]), pk2(rhs[2], rhs[3])};
        const f32x4 u = MF16(cur.tt, rb, ((f32x4){0.f, 0.f, 0.f, 0.f}));
        const v2u ub = (v2u){pk2(u[0], u[1]), pk2(u[2], u[3])};
#pragma unroll
        for (int kt = 0; kt < 4; ++kt) { S[kt] = S[kt] * cur.gc[kt]; S[kt] = MF16(cur.apt[kt], ub, S[kt]); S[kt] = MF16(cur.kpt[kt], cur.vm, S[kt]); }
#pragma unroll
        for (int kt = 0; kt < 4; ++kt) y = MF16(cur.rt[kt], Sb[kt], y);
        y = MF16(cur.art, ub, y); y = MF16(cur.krt, cur.vm, y);
#pragma unroll
        for (int j = 0; j < 4; ++j) { const size_t R = rwkv_row(b, dir, c * 16 + 4 * fq + j); Yo[R * 512 + h * 64 + 16 * wave + fr] = y[j]; }
    };
    if (wave >= 4) { issue(0); commit(0); }
    __syncthreads();
    for (int blk = 0; blk < 36; ++blk) {
        if (wave >= 4) { if (blk + 1 < 36) issue(blk + 1); }
        else { const LAS unsigned char* B = lds + (blk & 1) * BLK;
            RchOps o0 = ld(B, wave), o1 = ld(B + RCH_BYTES, wave);
            step(o0, blk * 4 + 0); o0 = ld(B + 2 * RCH_BYTES, wave);
            step(o1, blk * 4 + 1); o1 = ld(B + 3 * RCH_BYTES, wave);
            step(o0, blk * 4 + 2);
            step(o1, blk * 4 + 3); }
        if (wave >= 4 && blk + 1 < 36) commit((blk + 1) & 1);
        __syncthreads();
    }
#undef MF16
}

constexpr int SS_CM = 0, SS_BM = 17408, SS_BST = 34816, SS_XT = 53248, SS_MX = 62464, SS_HB = 71680, SS_CS = 89088, SS_DT = 89344;
__device__ __forceinline__ float bfe(const v4u& v, int i) { const unsigned u = (i < 2) ? v.x : (i < 4) ? v.y : (i < 6) ? v.z : v.w; return (i & 1) ? bfhi(u) : bflo(u); }
__device__ __forceinline__ unsigned short bfraw(const v4u& v, int i) { const unsigned u = (i < 2) ? v.x : (i < 4) ? v.y : (i < 6) ? v.z : v.w; return (unsigned short)((i & 1) ? (u >> 16) : (u & 0xffffu)); }
__device__ __forceinline__ void ssd_scan_fast(KArgs a, int idx, LAS unsigned char* lds, int tid, int lane, int wave) {
    unsigned char* ws = a->ws; const bf16* XBC = (const bf16*)(ws + OFF_XBC); const float* DTA = (const float*)(ws + OFF_DTA);
    const int b = idx / 24, dir = (idx % 24) / 12, h = idx % 12, g = h / 3, q = dir * 12 + h;
    float* Yo = (float*)(ws + OFF_YSSD) + (size_t)dir * TT * 768;
    LAS bf16* Cm = (LAS bf16*)(lds + SS_CM); LAS bf16* Bm = (LAS bf16*)(lds + SS_BM); LAS bf16* BsT = (LAS bf16*)(lds + SS_BST); LAS bf16* XT = (LAS bf16*)(lds + SS_XT);
    LAS bf16* Mx = (LAS bf16*)(lds + SS_MX); LAS bf16* Hb = (LAS bf16*)(lds + SS_HB); LAS float* CS = (LAS float*)(lds + SS_CS); LAS float* DTV = (LAS float*)(lds + SS_DT);
    const int fr = lane & 15, fq = lane >> 4, ss = tid & 63, sc = tid >> 6, tl = wave >> 1, wh = wave & 1;
    { unsigned z = 0u; asm volatile("" : "+v"(z)); for (int i = tid; i < 17408 / 16; i += NTHR) *(LAS v4u*)(lds + SS_HB + i * 16) = (v4u){z, z, z, z}; }
    f32x4 hacc[4];
#pragma unroll
    for (int j = 0; j < 4; ++j) hacc[j] = (f32x4){0.f, 0.f, 0.f, 0.f};
    v4u pc0, pc1, pb0, pb1, px; float pdt = 0.f, pa = 0.f;
    auto issue = [&](int ch) {
        const int tok = ssd_tok(b, dir, ch * 64 + ss); const bf16* row = XBC + (size_t)tok * 1792;
        pc0 = *(const v4u*)(row + 1280 + g * 128 + sc * 8); pc1 = *(const v4u*)(row + 1280 + g * 128 + (sc + 8) * 8);
        pb0 = *(const v4u*)(row + 768 + g * 128 + sc * 8); pb1 = *(const v4u*)(row + 768 + g * 128 + (sc + 8) * 8);
        px = *(const v4u*)(row + h * 64 + sc * 8);
        if (tid < 64) { pdt = DTA[(size_t)tok * 48 + q]; pa = DTA[(size_t)tok * 48 + 24 + q]; }
    };
    issue(0);
    for (int ch = 0; ch < RJ / 64; ++ch) {
        *(LAS v4u*)(Cm + ss * 136 + sc * 8) = pc0; *(LAS v4u*)(Cm + ss * 136 + (sc + 8) * 8) = pc1;
        *(LAS v4u*)(Bm + ss * 136 + sc * 8) = pb0; *(LAS v4u*)(Bm + ss * 136 + (sc + 8) * 8) = pb1;
#pragma unroll
        for (int i = 0; i < 8; ++i) XT[(sc * 8 + i) * 72 + ss] = bfraw(px, i);
        if (tid < 64) { float x = pa;
            x += __int_as_float(__builtin_amdgcn_update_dpp(0, __float_as_int(x), 0x111, 0xf, 0xf, false)); x += __int_as_float(__builtin_amdgcn_update_dpp(0, __float_as_int(x), 0x112, 0xf, 0xf, false));
            x += __int_as_float(__builtin_amdgcn_update_dpp(0, __float_as_int(x), 0x114, 0xf, 0xf, false)); x += __int_as_float(__builtin_amdgcn_update_dpp(0, __float_as_int(x), 0x118, 0xf, 0xf, false));
            x += __int_as_float(__builtin_amdgcn_update_dpp(0, __float_as_int(x), 0x142, 0xa, 0xf, false)); x += __int_as_float(__builtin_amdgcn_update_dpp(0, __float_as_int(x), 0x143, 0xc, 0xf, false));
            CS[tid] = x; DTV[tid] = pdt; }
        __syncthreads();
        const float cl = CS[63];
        { const float scl = DTV[ss] * __expf(cl - CS[ss]);
#pragma unroll
            for (int i = 0; i < 8; ++i) { BsT[(sc * 8 + i) * 72 + ss] = bf1(bfe(pb0, i) * scl); BsT[((sc + 8) * 8 + i) * 72 + ss] = bf1(bfe(pb1, i) * scl); } }
        if (ch + 1 < RJ / 64) issue(ch + 1);
        bf16x8 cf[4];
#pragma unroll
        for (int ks = 0; ks < 4; ++ks) cf[ks] = *(const LAS bf16x8*)(Cm + (16 * tl + fr) * 136 + ks * 32 + fq * 8);
#pragma unroll
        for (int j = 0; j < 2; ++j) { const int tc = wh * 2 + j; f32x4 acc = (f32x4){0.f, 0.f, 0.f, 0.f};
            if (tc <= tl) {
#pragma unroll
                for (int ks = 0; ks < 4; ++ks) { const bf16x8 bf = *(const LAS bf16x8*)(Bm + (16 * tc + fr) * 136 + ks * 32 + fq * 8);
                    acc = __builtin_amdgcn_mfma_f32_16x16x32_bf16(cf[ks], bf, acc, 0, 0, 0); } }
            const int s = 16 * tc + fr; const float css = CS[s], dts = DTV[s];
#pragma unroll
            for (int i = 0; i < 4; ++i) { const int l = 16 * tl + 4 * fq + i; const float v = (s <= l) ? acc[i] * __expf(CS[l] - css) * dts : 0.f; Mx[l * 72 + s] = bf1(v); } }
        __syncthreads();
        bf16x8 mf[2], xf[2];
#pragma unroll
        for (int ks = 0; ks < 2; ++ks) { mf[ks] = *(const LAS bf16x8*)(Mx + (16 * tl + fr) * 72 + ks * 32 + fq * 8); xf[ks] = *(const LAS bf16x8*)(XT + (16 * tl + fr) * 72 + ks * 32 + fq * 8); }
#pragma unroll
        for (int j = 0; j < 2; ++j) { const int tp = wh * 2 + j; f32x4 acc = (f32x4){0.f, 0.f, 0.f, 0.f};
#pragma unroll
            for (int ks = 0; ks < 4; ++ks) { const bf16x8 bf = *(const LAS bf16x8*)(Hb + (16 * tp + fr) * 136 + ks * 32 + fq * 8);
                acc = __builtin_amdgcn_mfma_f32_16x16x32_bf16(cf[ks], bf, acc, 0, 0, 0); }
#pragma unroll
            for (int i = 0; i < 4; ++i) acc[i] *= __expf(CS[16 * tl + 4 * fq + i]);
#pragma unroll
            for (int ks = 0; ks < 2; ++ks) { const bf16x8 bf = *(const LAS bf16x8*)(XT + (16 * tp + fr) * 72 + ks * 32 + fq * 8);
                acc = __builtin_amdgcn_mfma_f32_16x16x32_bf16(mf[ks], bf, acc, 0, 0, 0); }
#pragma unroll
            for (int i = 0; i < 4; ++i) { const int tok = ssd_tok(b, dir, ch * 64 + 16 * tl + 4 * fq + i); Yo[(size_t)tok * 768 + h * 64 + 16 * tp + fr] = acc[i]; } }
        { const float ecl = __expf(cl);
#pragma unroll
            for (int j = 0; j < 4; ++j) { const int tn = wh * 4 + j; hacc[j] = hacc[j] * ecl;
#pragma unroll
                for (int ks = 0; ks < 2; ++ks) { const bf16x8 bf = *(const LAS bf16x8*)(BsT + (16 * tn + fr) * 72 + ks * 32 + fq * 8);
                    hacc[j] = __builtin_amdgcn_mfma_f32_16x16x32_bf16(xf[ks], bf, hacc[j], 0, 0, 0); } } }
        __syncthreads();
#pragma unroll
        for (int j = 0; j < 4; ++j) { const int tn = wh * 4 + j;
#pragma unroll
            for (int i = 0; i < 4; ++i) Hb[(16 * tl + 4 * fq + i) * 136 + 16 * tn + fr] = bf1(hacc[j][i]); }
    }
}

constexpr int NPH = 2 + 10 * DEPTH;
#ifndef PROBE_MASK
#define PROBE_MASK 0
#endif
#ifndef PROBE_P0
#define PROBE_P0 0
#endif
#ifndef PROBE_SUB
#define PROBE_SUB 0
#endif
#ifndef PROBE_REPS
#define PROBE_REPS 3
#endif
#define REPS(k) (((PROBE_MASK >> (k)) & 1) ? PROBE_REPS : 1)
constexpr int GATE_LATE = 23;
constexpr int GATE_X = 288, GATE_Z = 192, GATE_STATIC = 576;
constexpr int CW_GQ = 16384;
#ifndef MK_ONE_LAUNCH
#define MK_ONE_LAUNCH 1
#endif

__global__ void __launch_bounds__(NTHR, 2) fwd(Args a_unused) {
    extern __shared__ __attribute__((aligned(16))) unsigned char lds_raw[];
    LAS unsigned char* lds = (LAS unsigned char*)lds_raw;
    const int bid0 = blockIdx.x, G0 = gridDim.x, wave0 = __builtin_amdgcn_readfirstlane(threadIdx.x >> 6);
#define PH_BG int bid = bid0, G = G0; asm volatile("" : "+s"(bid), "+s"(G));
    volatile LAS unsigned* MISCW = (volatile LAS unsigned*)(lds + MISC_OFF);
    if (threadIdx.x < 32) MISCW[threadIdx.x] = 0u;
    __syncthreads();
    const int ph_lo = kargs()->ph_lo, ph_hi = kargs()->ph_hi;
    const bool multi = (ph_hi - ph_lo) > 1;
    XcdBarrier bar; bar.bar = (unsigned*)(kargs()->ws + OFF_CTL) + CW_BAR; bar.x = 0; bar.st = nullptr; bar.wv = wave0;
    if (multi) bar = xcd_barrier_post((unsigned*)(kargs()->ws + OFF_CTL) + CW_BAR, MISCW + 8, wave0);
#define IN(k) (ph_lo <= (k) && (k) < ph_hi)
#define SEAM(k) do { if (IN(k) && IN((k) + 1)) xcd_barrier(bar); } while (0)

    for (int rep = 0; rep < (PROBE_P0 ? PROBE_REPS : 1); ++rep) {
    if (IN(0)) { PH_BG p0_prologue(kargs(), lds, bid, G, wave0, rep == 0 ? 15 : PROBE_SUB); }
    if (rep + 1 < (PROBE_P0 ? PROBE_REPS : 1)) xcd_barrier(bar); }
    SEAM(0);
    if (IN(1)) { PH_BG KArgs a = kargs(); norm_phase(a, 0, nullptr, a->in[I_NORMG] + 0, nullptr, (const float*)(a->ws + OFF_MODV), bid, G, wave0, TT, false, false, true); }
    SEAM(1);

    for (int l = 0; l < DEPTH; ++l) {
        const int pb = 2 + 10 * l;
#define PH_LOCALS PH_BG KArgs a = kargs(); unsigned char* ws = a->ws; unsigned char* wl = ws + OFF_W + (size_t)l * W_LAYER; bf16* Hb = (bf16*)(ws + OFF_H); (void)wl; (void)Hb; \
        const float* ng = a->in[I_NORMG] + (size_t)l * 4 * DM; const float* mv = (const float*)(ws + OFF_MODV) + (size_t)l * 5 * 12288; (void)ng; (void)mv;
        const bool lastl = (l == DEPTH - 1);
        for (int rep = 0; rep < REPS(0); ++rep) {
        if (IN(pb + 0)) { PH_LOCALS
            __syncthreads();
            pg8::Sched2 S; S.A0 = (const char*)Hb; S.B0 = (const char*)(wl + WO_IN); S.A1 = (const char*)(wl + WO_FFT); S.B1 = (const char*)Hb; S.tstep = (size_t)256 * DM * 2; S.ntk = DM / 64;
            S.t0.init(TT / 256, NU / 256 - GATE_LATE); S.t1.init(4, TT / 256); S.G = G; S.c = bid; S.spread = 1;
            pg8::EpiIn2 E{pg8::EpiInproj{(bf16*)(ws + OFF_U), (float*)(ws + OFF_MISC), NU}, pg8::EpiBf{0, (bf16*)(ws + OFF_VTL), (bf16*)(ws + OFF_VTC)}};
            pg8::gemm_phase<pg8::EpiIn2, pg8::Sched2, true, true>(lds, DM, S, E, wave0);
        }
        if (rep + 1 < REPS(0)) xcd_barrier(bar); }
        SEAM(pb + 0);
        for (int rep = 0; rep < REPS(1); ++rep) {
        if (IN(pb + 1)) { PH_LOCALS PH_IDS
            __syncthreads();
            if (rep == 0 || PROBE_SUB == 3 || PROBE_SUB == 7) {
            if (bid < 64) { pg8::Sched2 S; S.A0 = (const char*)(ws + OFF_DFTL); S.B0 = (const char*)(ws + OFF_VTL); S.A1 = S.A0; S.B1 = S.B0; S.tstep = (size_t)256 * 4096 * 2; S.ntk = 64; S.t0.init(8, 8); S.t1.init(0, 0); S.G = 64; S.c = bid;
                  pg8::EpiBf E{1, (bf16*)(ws + OFF_ACAT), nullptr};
                  pg8::gemm_phase<pg8::EpiBf, pg8::Sched2, true, true>(lds, 4096, S, E, wave0); }
            else if (bid < 72) { pg8::Sched2 S; S.A0 = (const char*)(ws + OFF_DFTC); S.B0 = (const char*)(ws + OFF_VTC); S.A1 = S.A0; S.B1 = S.B0; S.tstep = (size_t)256 * 512 * 2; S.ntk = 8; S.t0.init(1, 8); S.t1.init(0, 0); S.G = 8; S.c = bid - 64;
                  pg8::EpiBf E{2, (bf16*)(ws + OFF_ACAT), nullptr};
                  pg8::gemm_phase<pg8::EpiBf, pg8::Sched2, true, true>(lds, 512, S, E, wave0); }
            else if (bid < 72 + 4 * GATE_LATE && !lastl) {
                pg8::Sched2 S; S.A0 = (const char*)Hb; S.B0 = (const char*)(wl + WO_IN); S.A1 = S.A0; S.B1 = S.B0; S.tstep = (size_t)256 * DM * 2; S.ntk = DM / 64;
                S.t0.init(TCTX / 256, GATE_LATE); S.t1.init(0, 0); S.pm_off0 = TLAT / 256; S.pn_off0 = NU / 256 - GATE_LATE; S.G = 4 * GATE_LATE; S.c = bid - 72;
                pg8::EpiIn2 E{pg8::EpiInproj{(bf16*)(ws + OFF_U), (float*)(ws + OFF_MISC), NU}, pg8::EpiBf{0, (bf16*)(ws + OFF_VTL), (bf16*)(ws + OFF_VTC)}};
                pg8::gemm_phase<pg8::EpiIn2, pg8::Sched2, true, true>(lds, DM, S, E, wave0); }
            }
            __syncthreads();
            {
                unsigned* qctr = (unsigned*)(ws + OFF_CTL) + CW_Q + (l * 4 + rep) * 64;
                volatile LAS unsigned* qslot = (volatile LAS unsigned*)(lds + MISC_OFF) + 16;
                unsigned qnext = 0u; if (tid == 0) qnext = __hip_atomic_fetch_add(qctr, 1u, __ATOMIC_RELAXED, __HIP_MEMORY_SCOPE_AGENT);
                for (;;) {
                    if (tid == 0) qslot[0] = qnext;
                    __syncthreads();
                    const int it = (int)qslot[0];
                    __syncthreads();
                    if (it >= 576 + 288 + 576) break;
                    if (tid == 0) qnext = __hip_atomic_fetch_add(qctr, 1u, __ATOMIC_RELAXED, __HIP_MEMORY_SCOPE_AGENT);
                    int ln_i = lane; asm volatile("" : "+v"(ln_i)); const int tid_i = wave * 64 + ln_i;
                    const bool pall = (rep == 0 || PROBE_SUB == 7);
                    if (it < 576) { if (pall || PROBE_SUB == 0) rwkv_prep_item(a, l, it, lds, tid_i, ln_i, wave); }
                    else if (it < 576 + 288) { if (pall || PROBE_SUB == 2) conv_item(a, l, it - 576, lds, tid_i, ln_i, wave); }
                    else if (pall || PROBE_SUB == 1) ssd_prep_item(a, l, it - 576 - 288, tid_i);
                }
            }
        }
        if (rep + 1 < REPS(1)) xcd_barrier(bar); }
        SEAM(pb + 1);
        for (int rep = 0; rep < REPS(2); ++rep) {
        if (IN(pb + 2)) { PH_LOCALS PH_IDS
            __syncthreads();
            if (bid < 64) { if (rep == 0 || PROBE_SUB == 0 || PROBE_SUB == 7) rwkv_scan_chunk(a, bid, lds, tid, lane, wave); }
            else if (bid < 160) { if (rep == 0 || PROBE_SUB == 1 || PROBE_SUB == 7) ssd_scan_fast(a, bid - 64, lds, tid, lane, wave); }
            __syncthreads();
            if (rep == 0 || PROBE_SUB == 2 || PROBE_SUB == 7) {
                pg8::Sched2 S; S.A0 = (const char*)Hb; S.B0 = (const char*)(wl + WO_IN); S.A1 = S.A0; S.B1 = S.B0; S.tstep = (size_t)256 * DM * 2; S.ntk = DM / 64;
                const int gpan = TLAT / 256;
                S.t0.init(gpan, GATE_LATE); S.t1.init(0, 0); S.pn_off0 = NU / 256 - GATE_LATE;
                if (bid >= 160) { S.G = 96; S.c = bid - 160; S.first = 0; S.limit = GATE_X; }
                else if (bid < 64) { S.G = 64; S.c = bid; S.first = GATE_X; S.limit = GATE_X + GATE_Z; }
                else { S.G = 96; S.c = bid - 64; S.first = GATE_X + GATE_Z; S.limit = GATE_STATIC; }
                pg8::EpiIn2 E{pg8::EpiInproj{(bf16*)(ws + OFF_U), (float*)(ws + OFF_MISC), NU}, pg8::EpiBf{0, (bf16*)(ws + OFF_VTL), (bf16*)(ws + OFF_VTC)}};
                pg8::gemm_phase<pg8::EpiIn2, pg8::Sched2, true, true>(lds, DM, S, E, wave0);
                unsigned* gq = (unsigned*)(ws + OFF_CTL) + CW_GQ + ((l * 4 + rep) * 8) * 64;
                volatile LAS unsigned* gslot = (volatile LAS unsigned*)(lds + MISC_OFF) + 20;
                int qx = bid & 7, qtries = 0;
                for (;;) {
                    __syncthreads();
                    if (tid == 0) gslot[0] = __hip_atomic_fetch_add(gq + qx * 64, 1u, __ATOMIC_RELAXED, __HIP_MEMORY_SCOPE_AGENT);
                    __syncthreads();
                    const int gu = GATE_STATIC + 8 * (int)gslot[0] + qx;
                    if (gu >= gpan * GATE_LATE) { if (++qtries >= 8) break; qx = (qx + 1) & 7; continue; }
                    S.G = 1; S.c = 0; S.first = gu; S.limit = gu + 1;
                    pg8::gemm_phase<pg8::EpiIn2, pg8::Sched2, true, true>(lds, DM, S, E, wave0);
                } }
        }
        if (rep + 1 < REPS(2)) xcd_barrier(bar); }
        SEAM(pb + 2);
        for (int rep = 0; rep < REPS(3); ++rep) {
        if (IN(pb + 3)) { PH_BG post_phase(kargs(), l, bid, G, wave0); }
        if (rep + 1 < REPS(3)) xcd_barrier(bar); }
        SEAM(pb + 3);
        for (int rep = 0; rep < REPS(4); ++rep) {
        if (IN(pb + 4)) { PH_LOCALS
            __syncthreads();
            pg8::Sched2 S; S.A0 = (const char*)(ws + OFF_ACAT); S.B0 = (const char*)(wl + WO_CAT); S.A1 = S.A0; S.B1 = S.B0; S.tstep = (size_t)256 * ACW * 2; S.ntk = ACW / 64;
            S.t0.init(TLAT / 256, DM / 256); S.t1.init(0, 0); S.G = G; S.c = bid;
            pg8::EpiChain E{(const bf16*)(ws + OFF_U) + UGATE, NU, (bf16*)(ws + OFF_M)};
            pg8::gemm_phase<pg8::EpiChain, pg8::Sched2, true, true>(lds, ACW, S, E, wave0);
            if (!lastl) {
                pg8::SchedCB C; C.A = (const char*)(ws + OFF_ACAT); C.B = (const char*)(wl + WO_CAT); C.tstep = (size_t)256 * ACW * 2; C.G = G; C.c = bid;
                pg8::EpiGateSlab Eg{(const bf16*)(ws + OFF_U) + UGATE, NU, (bf16*)(ws + OFF_SCAT)};
                pg8::gemm_phase<pg8::EpiGateSlab, pg8::SchedCB, true, true>(lds, ACW, C, Eg, wave0); }
        }
        if (rep + 1 < REPS(4)) xcd_barrier(bar); }
        SEAM(pb + 4);
        for (int rep = 0; rep < REPS(5); ++rep) {
        if (IN(pb + 5)) { PH_LOCALS
            __syncthreads();
            pg8::SchedSplit S; S.A = (const char*)(ws + OFF_M); S.B = (const char*)(wl + WO_O); S.tstep = (size_t)256 * DM * 2; S.ntk = DM / 64; S.tm.init(32, 8); S.nctx = 0; S.G = G; S.c = bid;
            pg8::EpiF32 E{(bf16*)(ws + OFF_Y), (bf16*)(ws + OFF_YC)};
            pg8::gemm_phase<pg8::EpiF32, pg8::SchedSplit, true, true>(lds, DM, S, E, wave0);
            if (!lastl) {
                pg8::SchedCW C; C.A = (const char*)(ws + OFF_SCAT); C.B = (const char*)(wl + WO_O); C.G = G; C.c = bid;
                pg8::gemm_phase<pg8::EpiF32, pg8::SchedCW, true, true>(lds, DM, C, E, wave0); }
        }
        if (rep + 1 < REPS(5)) xcd_barrier(bar); }
        SEAM(pb + 5);
        for (int rep = 0; rep < REPS(6); ++rep) {
        if (IN(pb + 6)) { PH_LOCALS norm_phase(a, 1, ng + 1 * DM, ng + 2 * DM, mv + 2 * DM, mv + 3 * DM, bid, G, wave0, lastl ? TLAT : TT, !lastl, rep > 0, l == 0); }
        if (rep + 1 < REPS(6)) xcd_barrier(bar); }
        SEAM(pb + 6);
        for (int rep = 0; rep < REPS(7); ++rep) {
        if (IN(pb + 7)) { PH_LOCALS
            __syncthreads();
            pg8::Sched2 S; S.A0 = (const char*)Hb; S.B0 = (const char*)(wl + WO_UP); S.A1 = S.A0; S.B1 = S.B0; S.tstep = (size_t)256 * DM * 2; S.ntk = DM / 64;
            S.t0.init(lastl ? TLAT / 256 : TT / 256, DFF / 256); S.t1.init(0, 0); S.G = G; S.c = bid;
            pg8::EpiBf E{3, (bf16*)(ws + OFF_HB), nullptr};
            pg8::gemm_phase<pg8::EpiBf, pg8::Sched2, true, true>(lds, DM, S, E, wave0);
        }
        if (rep + 1 < REPS(7)) xcd_barrier(bar); }
        SEAM(pb + 7);
        for (int rep = 0; rep < REPS(8); ++rep) {
        if (IN(pb + 8)) { PH_LOCALS
            __syncthreads();
            pg8::SchedSplit S; S.A = (const char*)(ws + OFF_HB); S.B = (const char*)(wl + WO_DN); S.tstep = (size_t)256 * DFF * 2; S.ntk = DFF / 64; S.tm.init(32, 8); S.nctx = lastl ? 0 : 256; S.G = G; S.c = bid;
            pg8::EpiF32 E{(bf16*)(ws + OFF_Y), (bf16*)(ws + OFF_YC)};
            pg8::gemm_phase<pg8::EpiF32, pg8::SchedSplit, true, true>(lds, DFF, S, E, wave0);
        }
        if (rep + 1 < REPS(8)) xcd_barrier(bar); }
        SEAM(pb + 8);
        if (IN(pb + 9)) { PH_LOCALS
            if (!lastl) norm_phase(a, 1, ng + 3 * DM, ng + 4 * DM  , mv + 5 * DM, mv + 5 * 12288  , bid, G, wave0, TT, true);
            else norm_phase(a, 2, ng + 3 * DM, nullptr, mv + 5 * DM, nullptr, bid, G, wave0, TLAT);
        }
        SEAM(pb + 9);
    }
#undef IN
#undef SEAM
}

extern "C" void kernel_launch(void* const* d_in, const int* in_sizes, int n_in, void* d_out, int out_size, void* d_ws, size_t ws_size, hipStream_t stream) {
    static int grid = 0;
    if (grid == 0) {
        if (n_in != N_IN || out_size != TLAT * DM || ws_size < WS_END) { fprintf(stderr, "kernel_launch: unexpected shapes (n_in %d out %d ws %zu); nothing launched\n", n_in, out_size, ws_size); grid = -1; return; }
        int dev = 0, cus = 0;
        if (hipGetDevice(&dev) != hipSuccess || hipDeviceGetAttribute(&cus, hipDeviceAttributeMultiprocessorCount, dev) != hipSuccess) { grid = -1; return; }
        if (hipFuncSetAttribute((const void*)fwd, hipFuncAttributeMaxDynamicSharedMemorySize, LDS_BYTES) != hipSuccess) { fprintf(stderr, "kernel_launch: hipFuncSetAttribute failed\n"); grid = -1; return; }
        int per_cu = 0;
        if (hipOccupancyMaxActiveBlocksPerMultiprocessor(&per_cu, (const void*)fwd, NTHR, LDS_BYTES) != hipSuccess || per_cu < 1) fprintf(stderr, "kernel_launch: occupancy query says %d\n", per_cu);
        (void)hipGetLastError();
        grid = cus;
        if (grid != 256) { fprintf(stderr, "kernel_launch: %d CUs: this kernel's phase program is laid out for 256 workgroups (one per CU of an MI355X)\n", grid); grid = -1; return; }
    }
    if (grid < 0) return;
    if (hipMemsetAsync((char*)d_ws + OFF_CTL, 0, CTL_BYTES, stream) != hipSuccess) return;
    Args a{};
    for (int i = 0; i < N_IN; ++i) a.in[i] = (const float*)d_in[i];
    a.out = (float*)d_out; a.ws = (unsigned char*)d_ws;
#if MK_ONE_LAUNCH
    a.ph_lo = 0; a.ph_hi = NPH;
    hipLaunchKernelGGL(fwd, dim3(grid), dim3(NTHR), LDS_BYTES, stream, a);
#else
    for (int p = 0; p < NPH; ++p) { a.ph_lo = p; a.ph_hi = p + 1; hipLaunchKernelGGL(fwd, dim3(grid), dim3(NTHR), LDS_BYTES, stream, a); }
#endif
}
```

```cpp
#include <hip/hip_runtime.h>
#include <cstdio>
#include <cstdint>
namespace pg8 {
#define PG8_LAS __attribute__((address_space(3)))
typedef unsigned short bf16_t;
typedef short bf16x8 __attribute__((ext_vector_type(8)));
typedef float f32x4 __attribute__((ext_vector_type(4)));
typedef unsigned u32x4 __attribute__((ext_vector_type(4)));
constexpr int BM = 256, BK = 64, HALF = 128, HTB = HALF * BK * 2  , STAGE_BYTES = 8 * HTB, NXCD = 8, WGM = 8;

__host__ __device__ __forceinline__ int lds_byte(int r, int c) { const int st = (r >> 4) * 2 + (c >> 5), rr = r & 15, cc = c & 31, ob = rr * 64 + cc * 2; return st * 1024 + (ob ^ (((ob >> 9) & 1) << 5)); }
__host__ __device__ __forceinline__ void stage_rc(int b, int& R, int& C) { const int st = b / 1024, sb = b % 1024, swz = sb ^ (((sb >> 9) & 1) << 5); R = (st >> 1) * 16 + swz / 64; C = (st & 1) * 32 + (swz % 64) / 2; }
__host__ __device__ __forceinline__ int perm32(int rho) { const int n = rho >> 4, i = rho & 15; return 8 * (i >> 2) + 4 * n + (i & 3); }

struct Unit { int pm, pn, kind; };
struct Gemm { const bf16_t* A; const bf16_t* Bt; int M, N, K; };

struct StaticOrder {
    int nM, nN, nwg, G, c;
    __host__ __device__ void init(int M, int N, int G_, int c_) { nM = M / BM; nN = N / BM; nwg = nM * nN; G = G_; c = c_; }
    __host__ __device__ bool next(int i, Unit& u) const {
        const long L = (long)i * G + c; if (L >= nwg) return false;
        int wgid = (int)L; { const int q = nwg / NXCD, r = nwg % NXCD, xcd = wgid % NXCD, off = wgid / NXCD; wgid = (xcd < r ? xcd * (q + 1) : r * (q + 1) + (xcd - r) * q) + off; }
        const int nig = WGM * nN, gid = wgid / nig, fm = gid * WGM, gsz = (nM - fm) < WGM ? (nM - fm) : WGM;
        u.pm = fm + ((wgid % nig) % gsz); u.pn = (wgid % nig) / gsz; return true;
    }
    __device__ __forceinline__ void a_ready(const Unit&) const {}
    __device__ __forceinline__ void done(const Unit&) const {}
};
typedef float f32x2n __attribute__((ext_vector_type(2))); typedef __bf16 bf16x2n __attribute__((ext_vector_type(2)));
__device__ __forceinline__ unsigned cvt_pk_bf16(float lo, float hi) { const bf16x2n r = __builtin_convertvector((f32x2n){lo, hi}, bf16x2n); return __builtin_bit_cast(unsigned, r); }
typedef float f32x2 __attribute__((ext_vector_type(2)));
template <class Epi, class Sched, bool ALIGN_EPI = false, bool SP2 = false>
__device__ __forceinline__ void gemm_phase(PG8_LAS unsigned char* lds, const int ldk  , const Sched& S, const Epi& E, const int wave_id) {
    unsigned z_ = 0u; asm volatile("" : "+v"(z_)); const int lane_ = (int)__builtin_amdgcn_mbcnt_hi(~0u, __builtin_amdgcn_mbcnt_lo(~0u, z_)); int wid_ = wave_id; asm volatile("" : "+s"(wid_)); const int wid = wid_, lane = lane_, tid = wid * 64 + lane, wr = wid >> 2, wc = wid & 3, fr = lane & 15, fq = lane >> 4;
    const int K = ldk; int nt;
    unsigned voffA[2], voffB[2];
#pragma unroll
    for (int i = 0; i < 2; ++i) { int R, C; stage_rc(tid * 16 + i * 8192, R, C); const int Rb = Epi::PERM ? ((R & ~31) + perm32(R & 31)) : R;
        voffA[i] = (unsigned)(R * K + C) * 2u; voffB[i] = (unsigned)(Rb * K + C) * 2u; }
    const size_t kstep = (size_t)(BK * 2);
    const size_t hstep = (size_t)HALF * K * 2;
    const unsigned ldsw = (unsigned)wid * 1024u;
    const int aoff = lds_byte(wr * 64 + fr, fq * 8), boff = lds_byte(wc * 32 + fr, fq * 8);
#define PG8_SA(b, h) (((b) * 2 + (h)) * HTB)
#define PG8_SB(b, h) ((4 + (b) * 2 + (h)) * HTB)
#define PG8_STAGE(bufoff, gbase, voff) do { _Pragma("unroll") for (int _i = 0; _i < 2; ++_i) \
        __builtin_amdgcn_global_load_lds((const unsigned*)((const char*)(gbase) + (voff)[_i]), (PG8_LAS unsigned*)(lds + (bufoff) + ldsw + _i * 8192), 16, 0, 0); } while (0)
#define PG8_LDA(dst, b, h) do { _Pragma("unroll") for (int m = 0; m < 4; ++m) _Pragma("unroll") for (int k = 0; k < 2; ++k) dst[m][k] = *(const PG8_LAS bf16x8*)(lds + PG8_SA(b, h) + aoff + m * 2048 + k * 1024); } while (0)
#define PG8_LDB(dst, b, h) do { _Pragma("unroll") for (int n = 0; n < 2; ++n) _Pragma("unroll") for (int k = 0; k < 2; ++k) dst[n][k] = *(const PG8_LAS bf16x8*)(lds + PG8_SB(b, h) + boff + n * 2048 + k * 1024); } while (0)
#define PG8_MMA(ai, bj, At, Bt) do { __builtin_amdgcn_s_setprio(1); _Pragma("unroll") for (int m = 0; m < 4; ++m) _Pragma("unroll") for (int n = 0; n < 2; ++n) _Pragma("unroll") for (int k = 0; k < 2; ++k) \
        acc[ai][bj][m][n] = __builtin_amdgcn_mfma_f32_16x16x32_bf16(Bt[n][k], At[m][k], acc[ai][bj][m][n], 0, 0, 0); __builtin_amdgcn_s_setprio(0); } while (0)
#define PG8_WAIT_V(n) asm volatile("s_waitcnt vmcnt(" #n ")" ::: "memory")
#define PG8_WAIT_L(n) asm volatile("s_waitcnt lgkmcnt(" #n ")" ::: "memory")
#define PG8_BAR __builtin_amdgcn_s_barrier()
#define PG8_SCHED __builtin_amdgcn_sched_barrier(0)
    Unit cur, nxt; int ui = 0;
    if (!S.next(0, cur)) return;
    f32x4 acc[2][2][4][2];
#pragma unroll
    for (int a = 0; a < 2; ++a)
#pragma unroll
        for (int b = 0; b < 2; ++b)
#pragma unroll
            for (int m = 0; m < 4; ++m)
#pragma unroll
                for (int n = 0; n < 2; ++n) acc[a][b][m][n] = (f32x4){0.f, 0.f, 0.f, 0.f};
    bf16x8 At[4][2], B0[2][2], B1[2][2];
    const char* cA = S.abase(cur); const char* cB = S.bbase(cur); nt = S.nt(cur);
    S.a_ready(cur);
    if constexpr (SP2) {
        PG8_STAGE(PG8_SB(0, 0), cB, voffB); PG8_STAGE(PG8_SB(0, 1), cB + hstep, voffB); PG8_STAGE(PG8_SA(0, 0), cA, voffA); PG8_STAGE(PG8_SA(0, 1), cA + hstep, voffA);
        if (wr == 1) PG8_BAR;
        PG8_WAIT_V(2); PG8_BAR;
        PG8_STAGE(PG8_SB(1, 0), cB + kstep, voffB); PG8_STAGE(PG8_SA(1, 0), cA + kstep, voffA); PG8_STAGE(PG8_SB(1, 1), cB + hstep + kstep, voffB);
        PG8_WAIT_V(6); PG8_BAR;
    } else {
        PG8_STAGE(PG8_SB(0, 0), cB, voffB); PG8_STAGE(PG8_SA(0, 0), cA, voffA); PG8_STAGE(PG8_SB(0, 1), cB + hstep, voffB); PG8_STAGE(PG8_SA(0, 1), cA + hstep, voffA);
        if (wr == 1) PG8_BAR;
        PG8_WAIT_V(4); PG8_BAR;
        PG8_STAGE(PG8_SB(1, 0), cB + kstep, voffB); PG8_STAGE(PG8_SA(1, 0), cA + kstep, voffA); PG8_STAGE(PG8_SB(1, 1), cB + hstep + kstep, voffB);
        PG8_WAIT_V(6); PG8_BAR;
    }
    for (;;) {
        const bool has_next = S.next(ui + 1, nxt);
        const char* nA = has_next ? S.abase(nxt) : cA; const char* nB = has_next ? S.bbase(nxt) : cB;
        for (int t = 0; t < nt; t += 2) {
            const bool last = (t == nt - 2);
            const char* a1 = cA + (size_t)(t + 1) * kstep;
            const char* a2 = last ? nA : cA + (size_t)(t + 2) * kstep; const char* b2 = last ? nB : cB + (size_t)(t + 2) * kstep;
            const char* a3 = a2 + kstep; const char* b3 = b2 + kstep;
            if (last && has_next) S.a_ready(nxt);
            if constexpr (Epi::HOOK) { if (E.hook_at(t)) {
                if (wr == 0) PG8_BAR;
                E.khook(acc, cur, t, wr, wc, fr, fq);
                if (wr == 1) PG8_BAR; } }
            if constexpr (SP2) {
            PG8_LDB(B0, 0, 0); PG8_LDB(B1, 0, 1); PG8_SCHED; PG8_LDA(At, 0, 0); PG8_STAGE(PG8_SA(1, 1), a1 + hstep, voffA);
            PG8_WAIT_V(8); PG8_WAIT_L(0); PG8_BAR; PG8_MMA(0, 0, At, B0); PG8_MMA(0, 1, At, B1); PG8_BAR; PG8_SCHED;
            PG8_LDA(At, 0, 1); PG8_STAGE(PG8_SB(0, 0), b2, voffB); PG8_STAGE(PG8_SB(0, 1), b2 + hstep, voffB); PG8_STAGE(PG8_SA(0, 0), a2, voffA);
            PG8_WAIT_V(8); PG8_WAIT_L(0); PG8_BAR; PG8_MMA(1, 0, At, B0); PG8_MMA(1, 1, At, B1); PG8_BAR; PG8_SCHED;
            PG8_LDB(B0, 1, 0); PG8_LDB(B1, 1, 1); PG8_SCHED; PG8_LDA(At, 1, 0); PG8_STAGE(PG8_SA(0, 1), a2 + hstep, voffA);
            PG8_WAIT_V(8); PG8_WAIT_L(0); PG8_BAR; PG8_MMA(0, 0, At, B0); PG8_MMA(0, 1, At, B1); PG8_BAR; PG8_SCHED;
            PG8_LDA(At, 1, 1); PG8_STAGE(PG8_SB(1, 0), b3, voffB); PG8_STAGE(PG8_SB(1, 1), b3 + hstep, voffB); PG8_STAGE(PG8_SA(1, 0), a3, voffA);
            PG8_WAIT_V(8); PG8_WAIT_L(0); PG8_BAR; PG8_MMA(1, 0, At, B0); PG8_MMA(1, 1, At, B1); PG8_BAR; PG8_SCHED;
            } else {
            PG8_LDB(B0, 0, 0); PG8_SCHED; PG8_LDA(At, 0, 0); PG8_STAGE(PG8_SA(1, 1), a1 + hstep, voffA);
            PG8_WAIT_L(8); PG8_BAR; PG8_WAIT_L(0); PG8_MMA(0, 0, At, B0); PG8_BAR; PG8_SCHED;
            PG8_LDB(B1, 0, 1); PG8_STAGE(PG8_SB(0, 0), b2, voffB);
            PG8_BAR; PG8_WAIT_L(0); PG8_MMA(0, 1, At, B1); PG8_BAR;
            PG8_LDA(At, 0, 1); PG8_STAGE(PG8_SA(0, 0), a2, voffA);
            PG8_BAR; PG8_WAIT_L(0); PG8_MMA(1, 0, At, B0); PG8_BAR; PG8_SCHED;
            PG8_STAGE(PG8_SB(0, 1), b2 + hstep, voffB);
            PG8_WAIT_V(6); PG8_BAR; PG8_MMA(1, 1, At, B1); PG8_BAR;
            PG8_LDB(B0, 1, 0); PG8_SCHED; PG8_LDA(At, 1, 0); PG8_STAGE(PG8_SA(0, 1), a2 + hstep, voffA);
            PG8_WAIT_L(8); PG8_BAR; PG8_WAIT_L(0); PG8_MMA(0, 0, At, B0); PG8_BAR; PG8_SCHED;
            PG8_LDB(B1, 1, 1); PG8_STAGE(PG8_SB(1, 0), b3, voffB);
            PG8_BAR; PG8_WAIT_L(0); PG8_MMA(0, 1, At, B1); PG8_BAR;
            PG8_LDA(At, 1, 1); PG8_STAGE(PG8_SA(1, 0), a3, voffA);
            PG8_BAR; PG8_WAIT_L(0); PG8_MMA(1, 0, At, B0); PG8_BAR; PG8_SCHED;
            PG8_STAGE(PG8_SB(1, 1), b3 + hstep, voffB);
            PG8_WAIT_V(6); PG8_BAR; PG8_MMA(1, 1, At, B1); PG8_BAR;
            }
        }
        if constexpr (ALIGN_EPI) { if (wr == 0) PG8_BAR; }
        if constexpr (!Epi::AFTER_DRAIN) { E(acc, cur, wr, wc, fr, fq); S.done(cur); }
        if (!has_next) break;
#pragma unroll
        for (int a = 0; a < 2; ++a)
#pragma unroll
            for (int b = 0; b < 2; ++b)
#pragma unroll
                for (int m = 0; m < 4; ++m)
#pragma unroll
                    for (int n = 0; n < 2; ++n) acc[a][b][m][n] = (f32x4){0.f, 0.f, 0.f, 0.f};
        cur = nxt; cA = nA; cB = nB; ++ui; nt = S.nt(cur);
        if constexpr (ALIGN_EPI) { if (wr == 1) PG8_BAR; }
    }
    PG8_WAIT_V(0);
    if constexpr (!ALIGN_EPI) { if (wr == 0) PG8_BAR; }
    PG8_BAR;
    if constexpr (Epi::AFTER_DRAIN) { E.fused(acc, cur, wr, wc, fr, fq, lds, wid, lane); S.done(cur); }
#undef PG8_SA
#undef PG8_SB
#undef PG8_STAGE
#undef PG8_LDA
#undef PG8_LDB
#undef PG8_MMA
#undef PG8_WAIT_V
#undef PG8_WAIT_L
#undef PG8_BAR
#undef PG8_SCHED
}
}

namespace pg8 {
__device__ __forceinline__ float sigm(float x) { return __builtin_amdgcn_rcpf(1.f + __expf(-x)); }
__device__ __forceinline__ f32x4 sigm4(f32x4 v) { return (f32x4){sigm(v[0]), sigm(v[1]), sigm(v[2]), sigm(v[3])}; }
__device__ __forceinline__ u32x4 pack8(f32x4 v0, f32x4 v1) { u32x4 w; w.x = cvt_pk_bf16(v0[0], v0[1]); w.y = cvt_pk_bf16(v0[2], v0[3]); w.z = cvt_pk_bf16(v1[0], v1[1]); w.w = cvt_pk_bf16(v1[2], v1[3]); return w; }
__device__ __forceinline__ float bflo(unsigned u) { return __uint_as_float(u << 16); }
__device__ __forceinline__ float bfhi(unsigned u) { return __uint_as_float(u & 0xffff0000u); }


struct TileMap {
    int nM, nN, nwg;
    __device__ __forceinline__ void init(int nM_, int nN_) { nM = nM_; nN = nN_; nwg = nM_ * nN_; }
    __device__ __forceinline__ void map(int L, int& pm, int& pn) const {
        int wgid = L; { const int q = nwg / NXCD, r = nwg % NXCD, xcd = wgid % NXCD, off = wgid / NXCD; wgid = (xcd < r ? xcd * (q + 1) : r * (q + 1) + (xcd - r) * q) + off; }
        const int nig = WGM * nN, gid = wgid / nig, fm = gid * WGM, gsz = (nM - fm) < WGM ? (nM - fm) : WGM;
        pm = fm + ((wgid % nig) % gsz); pn = (wgid % nig) / gsz;
    }
};
struct Sched2 {
    const char *A0, *B0, *A1, *B1; size_t tstep; int ntk; TileMap t0, t1; int G, c;
    int pm_off0 = 0, pn_off0 = 0, first = 0, limit = 0x7fffffff;
    int spread = 0;
    __device__ __forceinline__ bool next(int i, Unit& u) const { const int L = first + i * G + c;
        if (spread) {
            const int lo = 48 * i, rem = t1.nwg - 32 * i, nf = rem < 0 ? 0 : (rem < 32 ? rem : 32);
            if (c >= lo && c < lo + nf) { t1.map(32 * i + c - lo, u.pm, u.pn); u.kind = 1; return true; }
            const int Ln = 224 * i + (c < lo ? c : c - nf);
            if (Ln >= t0.nwg) return false;
            t0.map(Ln, u.pm, u.pn); u.pm += pm_off0; u.pn += pn_off0; u.kind = 0; return true; }
        if (L >= limit) return false;
        if (L < t0.nwg) { t0.map(L, u.pm, u.pn); u.pm += pm_off0; u.pn += pn_off0; u.kind = 0; return true; }
        if (L - t0.nwg < t1.nwg) { t1.map(L - t0.nwg, u.pm, u.pn); u.kind = 1; return true; }
        return false; }
    __device__ __forceinline__ const char* abase(const Unit& u) const { return (u.kind ? A1 : A0) + (size_t)u.pm * tstep; }
    __device__ __forceinline__ const char* bbase(const Unit& u) const { return (u.kind ? B1 : B0) + (size_t)u.pn * tstep; }
    __device__ __forceinline__ int nt(const Unit&) const { return ntk; }
    __device__ __forceinline__ void a_ready(const Unit&) const {}
    __device__ __forceinline__ void done(const Unit&) const {}
};
struct SchedSplit {
    const char *A, *B; size_t tstep; int ntk; TileMap tm; int nctx, G, c;
    __device__ __forceinline__ bool next(int i, Unit& u) const { const int L = i * G + c;
        if (L < 256) { tm.map(L, u.pm, u.pn); u.kind = 0; return true; }
        const int e = L - 256; if (e < nctx) { const int tile = e & 31; u.pm = 32 + (tile >> 3); u.pn = tile & 7; u.kind = 1 + (e >> 5); return true; }
        return false; }
    __device__ __forceinline__ const char* abase(const Unit& u) const { return A + (size_t)u.pm * tstep + (u.kind ? (size_t)(u.kind - 1) * (ntk / 8) * 128 : 0); }
    __device__ __forceinline__ const char* bbase(const Unit& u) const { return B + (size_t)u.pn * tstep + (u.kind ? (size_t)(u.kind - 1) * (ntk / 8) * 128 : 0); }
    __device__ __forceinline__ int nt(const Unit& u) const { return u.kind ? ntk / 8 : ntk; }
    __device__ __forceinline__ void a_ready(const Unit&) const {}
    __device__ __forceinline__ void done(const Unit&) const {}
};
struct EpiInproj {
    static constexpr bool PERM = true, AFTER_DRAIN = false, HOOK = false;
    bf16_t* U; float* MISC; int ldu;
    __device__ __forceinline__ void operator()(const f32x4 (&acc)[2][2][4][2], const Unit& u, int wr, int wc, int fr, int fq) const {
        const int row0 = u.pm * BM + wr * 64 + fr, cl = wc * 32 + 8 * fq;
        if (u.pn == 16 || u.pn == 17) {
#pragma unroll
            for (int ai = 0; ai < 2; ++ai)
#pragma unroll
                for (int m = 0; m < 4; ++m) { float* rowp = MISC + (size_t)(row0 + ai * HALF + m * 16) * 512 + (u.pn - 16) * BM + cl;
#pragma unroll
                    for (int bj = 0; bj < 2; ++bj) { *(f32x4*)(rowp + bj * HALF) = acc[ai][bj][m][0]; *(f32x4*)(rowp + bj * HALF + 4) = acc[ai][bj][m][1]; } }
        } else {
            const bool sg = u.pn >= 22;
#pragma unroll
            for (int ai = 0; ai < 2; ++ai)
#pragma unroll
                for (int m = 0; m < 4; ++m) { bf16_t* rowp = U + (size_t)(row0 + ai * HALF + m * 16) * ldu + u.pn * BM + cl;
#pragma unroll
                    for (int bj = 0; bj < 2; ++bj) { f32x4 v0 = acc[ai][bj][m][0], v1 = acc[ai][bj][m][1];
                        if (sg) { v0 = sigm4(v0); v1 = sigm4(v1); }
                        *(u32x4*)(rowp + bj * HALF) = pack8(v0, v1); } }
        }
    }
};
struct EpiBf {
    static constexpr bool PERM = true, AFTER_DRAIN = false, HOOK = false;
    int kind; bf16_t* O0; bf16_t* O1;
    __device__ __forceinline__ void operator()(const f32x4 (&acc)[2][2][4][2], const Unit& u, int wr, int wc, int fr, int fq) const {
        bf16_t* base; size_t pitch;
        if (kind == 0) {
            const int half = u.pm >> 1, chb = (u.pm & 1) * 256;
            if (u.pn < 32) { const int b = u.pn >> 3, l0 = (u.pn & 7) * 256; pitch = 4096; base = O0 + ((size_t)(b * 512 + chb) * 2 + half) * 2048 + l0; }
            else { const int b = u.pn - 32; pitch = 512; base = O1 + ((size_t)(b * 512 + chb) * 2 + half) * 256; }
        } else if (kind == 1) { const int b = u.pn >> 1; pitch = 2304; base = O0 + (size_t)(b * 2048 + u.pm * 256) * 2304 + 1280 + (u.pn & 1) * 256; }
        else if (kind == 2) { const int b = u.pn >> 1; pitch = 2304; base = O0 + (size_t)(8192 + b * 256) * 2304 + 1280 + (u.pn & 1) * 256; }
        else { pitch = 8192; base = O0 + (size_t)(u.pm * 256) * 8192 + u.pn * 256; }
        const int r0 = wr * 64 + fr, cl = wc * 32 + 8 * fq;
#pragma unroll
        for (int ai = 0; ai < 2; ++ai)
#pragma unroll
            for (int m = 0; m < 4; ++m) { bf16_t* rowp = base + (size_t)(r0 + ai * HALF + m * 16) * pitch + cl;
#pragma unroll
                for (int bj = 0; bj < 2; ++bj) { f32x4 v0 = acc[ai][bj][m][0], v1 = acc[ai][bj][m][1];
                    if (kind == 3) { v0 = __builtin_elementwise_max(v0, (f32x4){0.f, 0.f, 0.f, 0.f}); v1 = __builtin_elementwise_max(v1, (f32x4){0.f, 0.f, 0.f, 0.f}); v0 = v0 * v0; v1 = v1 * v1; }
                    *(u32x4*)(rowp + bj * HALF) = pack8(v0, v1); } }
    }
};
struct EpiChain {
    static constexpr bool PERM = true, AFTER_DRAIN = false, HOOK = true;
    const bf16_t* G; int ldg; bf16_t* Mo;
    __device__ __forceinline__ bool hook_at(int t) const { return t == 8 || t == 20 || t == 28; }
    __device__ __forceinline__ void khook(f32x4 (&acc)[2][2][4][2], const Unit& u, int t, int wr, int wc, int fr, int fq) const {
        const int i = (t == 8) ? 0 : (t == 20 ? 1 : 2);
        int row0 = u.pm * BM + wr * 64 + fr; const int col0 = u.pn * BM + wc * 32 + 8 * fq + i * 2048;
        asm volatile("" : "+v"(row0));
#pragma unroll
        for (int ai = 0; ai < 2; ++ai) {
            u32x4 gv[4][2], hv[4][2];
#pragma unroll
            for (int m = 0; m < 4; ++m) { const bf16_t* gp = G + (size_t)(row0 + ai * HALF + m * 16) * ldg + col0;
#pragma unroll
                for (int bj = 0; bj < 2; ++bj) { gv[m][bj] = *(const u32x4*)(gp + bj * HALF); hv[m][bj] = *(const u32x4*)(gp + bj * HALF + 2048); } }
            asm volatile("" ::: "memory");
#pragma unroll
            for (int m = 0; m < 4; ++m)
#pragma unroll
                for (int bj = 0; bj < 2; ++bj) { const u32x4 g = gv[m][bj], h = hv[m][bj];
                    const unsigned gw[4] = {g.x, g.y, g.z, g.w}, hw[4] = {h.x, h.y, h.z, h.w};
#pragma unroll
                    for (int e2 = 0; e2 < 4; ++e2) { const float r0 = fmaxf(bflo(gw[e2]), 1e-6f) * __builtin_amdgcn_rcpf(fmaxf(bflo(hw[e2]), 1e-6f)), r1 = fmaxf(bfhi(gw[e2]), 1e-6f) * __builtin_amdgcn_rcpf(fmaxf(bfhi(hw[e2]), 1e-6f));
                        acc[ai][bj][m][e2 >> 1][(e2 & 1) * 2] *= r0; acc[ai][bj][m][e2 >> 1][(e2 & 1) * 2 + 1] *= r1; } }
            asm volatile("" ::: "memory");
        }
    }
    __device__ __forceinline__ void operator()(const f32x4 (&acc)[2][2][4][2], const Unit& u, int wr, int wc, int fr, int fq) const {
        const int row0 = u.pm * BM + wr * 64 + fr, col0 = u.pn * BM + wc * 32 + 8 * fq;
#pragma unroll
        for (int ai = 0; ai < 2; ++ai) {
            u32x4 gv[4][2];
#pragma unroll
            for (int m = 0; m < 4; ++m)
#pragma unroll
                for (int bj = 0; bj < 2; ++bj) gv[m][bj] = *(const u32x4*)(G + (size_t)(row0 + ai * HALF + m * 16) * ldg + col0 + bj * HALF + 3 * 2048);
            asm volatile("" ::: "memory");
#pragma unroll
            for (int m = 0; m < 4; ++m) { const size_t row = (size_t)(row0 + ai * HALF + m * 16);
#pragma unroll
                for (int bj = 0; bj < 2; ++bj) { const int col = col0 + bj * HALF; const u32x4 g = gv[m][bj];
                    const f32x4 v0 = acc[ai][bj][m][0] * (f32x4){fmaxf(bflo(g.x), 1e-6f), fmaxf(bfhi(g.x), 1e-6f), fmaxf(bflo(g.y), 1e-6f), fmaxf(bfhi(g.y), 1e-6f)};
                    const f32x4 v1 = acc[ai][bj][m][1] * (f32x4){fmaxf(bflo(g.z), 1e-6f), fmaxf(bfhi(g.z), 1e-6f), fmaxf(bflo(g.w), 1e-6f), fmaxf(bfhi(g.w), 1e-6f)};
                    *(u32x4*)(Mo + row * 2048 + col) = pack8(v0, v1); } }
        }
    }
};
struct EpiF32 {
    static constexpr bool PERM = true, AFTER_DRAIN = false, HOOK = false;
    bf16_t* C; bf16_t* YC;
    __device__ __forceinline__ void operator()(const f32x4 (&acc)[2][2][4][2], const Unit& u, int wr, int wc, int fr, int fq) const {
        const int row0 = u.pm * BM + wr * 64 + fr, col0 = u.pn * BM + wc * 32 + 8 * fq;
        if (u.kind == 0) {
#pragma unroll
            for (int ai = 0; ai < 2; ++ai)
#pragma unroll
                for (int m = 0; m < 4; ++m) { bf16_t* rowp = C + (size_t)(row0 + ai * HALF + m * 16) * 2048 + col0;
#pragma unroll
                    for (int bj = 0; bj < 2; ++bj) *(u32x4*)(rowp + bj * HALF) = pack8(acc[ai][bj][m][0], acc[ai][bj][m][1]); }
        } else {
            bf16_t* base = YC + (size_t)(u.kind - 1) * 1024 * 2048 + (size_t)(row0 - 8192) * 2048 + col0;
#pragma unroll
            for (int ai = 0; ai < 2; ++ai)
#pragma unroll
                for (int m = 0; m < 4; ++m) { bf16_t* rowp = base + (size_t)(ai * HALF + m * 16) * 2048;
#pragma unroll
                    for (int bj = 0; bj < 2; ++bj) *(u32x4*)(rowp + bj * HALF) = pack8(acc[ai][bj][m][0], acc[ai][bj][m][1]); }
        }
    }
};
struct EpiGateSlab {
    static constexpr bool PERM = true, AFTER_DRAIN = false, HOOK = false;
    const bf16_t* G; int ldg; bf16_t* SC;
    __device__ __forceinline__ void operator()(const f32x4 (&acc)[2][2][4][2], const Unit& u, int wr, int wc, int fr, int fq) const {
        const int row0 = u.pm * BM + wr * 64 + fr, cl = wc * 32 + 8 * fq;
#pragma unroll
        for (int ai = 0; ai < 2; ++ai) {
            u32x4 gv[4][2];
#pragma unroll
            for (int m = 0; m < 4; ++m)
#pragma unroll
                for (int bj = 0; bj < 2; ++bj) gv[m][bj] = *(const u32x4*)(G + (size_t)(row0 + ai * HALF + m * 16) * ldg + u.pn * BM + cl + bj * HALF + u.kind * 2048);
            asm volatile("" ::: "memory");
#pragma unroll
            for (int m = 0; m < 4; ++m) { bf16_t* rowp = SC + (size_t)u.kind * 1024 * 2048 + (size_t)(row0 + ai * HALF + m * 16 - 8192) * 2048 + u.pn * 256 + cl;
#pragma unroll
                for (int bj = 0; bj < 2; ++bj) { const u32x4 g = gv[m][bj];
                    const f32x4 v0 = acc[ai][bj][m][0] * (f32x4){bflo(g.x), bfhi(g.x), bflo(g.y), bfhi(g.y)}, v1 = acc[ai][bj][m][1] * (f32x4){bflo(g.z), bfhi(g.z), bflo(g.w), bfhi(g.w)};
                    *(u32x4*)(rowp + bj * HALF) = pack8(v0, v1); } }
        }
    }
};
struct SchedCB {
    const char *A, *B; size_t tstep; int G, c;
    __device__ __forceinline__ bool next(int i, Unit& u) const { const int L = i * G + c; if (L >= 128) return false; const int tile = L & 31; u.pm = 32 + (tile >> 3); u.pn = tile & 7; u.kind = L >> 5; return true; }
    __device__ __forceinline__ int koff(int k) const { return k == 0 ? 0 : (k == 1 ? 512 : (k == 2 ? 1280 : 1792)); }
    __device__ __forceinline__ const char* abase(const Unit& u) const { return A + (size_t)u.pm * tstep + koff(u.kind) * 2; }
    __device__ __forceinline__ const char* bbase(const Unit& u) const { return B + (size_t)u.pn * tstep + koff(u.kind) * 2; }
    __device__ __forceinline__ int nt(const Unit& u) const { return u.kind == 1 ? 12 : 8; }
    __device__ __forceinline__ void a_ready(const Unit&) const {}
    __device__ __forceinline__ void done(const Unit&) const {}
};
struct SchedCW {
    const char *A, *B; int G, c;
    __device__ __forceinline__ bool next(int i, Unit& u) const { const int L = i * G + c; if (L >= 256) return false; const int tile = L & 31; u.pm = 32 + (tile >> 3); u.pn = tile & 7; u.kind = 1 + (L >> 5); return true; }
    __device__ __forceinline__ const char* abase(const Unit& u) const { return A + (size_t)((u.kind - 1) >> 1) * 1024 * 2048 * 2 + (size_t)(u.pm - 32) * 256 * 2048 * 2 + (size_t)((u.kind - 1) & 1) * 2048; }
    __device__ __forceinline__ const char* bbase(const Unit& u) const { return B + (size_t)u.pn * 256 * 2048 * 2 + (size_t)((u.kind - 1) & 1) * 2048; }
    __device__ __forceinline__ int nt(const Unit&) const { return 16; }
    __device__ __forceinline__ void a_ready(const Unit&) const {}
    __device__ __forceinline__ void done(const Unit&) const {}
};
struct EpiIn2 {
    static constexpr bool PERM = true, AFTER_DRAIN = false, HOOK = false;
    EpiInproj e0; EpiBf e1;
    __device__ __forceinline__ void operator()(const f32x4 (&acc)[2][2][4][2], const Unit& u, int wr, int wc, int fr, int fq) const { if (u.kind == 0) e0(acc, u, wr, wc, fr, fq); else e1(acc, u, wr, wc, fr, fq); }
};
}

#define GAS __attribute__((address_space(1)))
#define LAS __attribute__((address_space(3)))
typedef unsigned short bf16;
typedef unsigned v4u __attribute__((ext_vector_type(4)));
typedef unsigned v2u __attribute__((ext_vector_type(2)));
typedef float f32x4 __attribute__((ext_vector_type(4)));
typedef float f32x2 __attribute__((ext_vector_type(2)));
constexpr int NWAVES = 8, NTHR = 512;
constexpr int DM = 2048, NBATCH = 4, LSEQ = 2048, LCTX = 256, DEPTH = 4;
constexpr int TLAT = NBATCH * LSEQ, TCTX = NBATCH * LCTX, TT = TLAT + TCTX;
constexpr int IN_DIM = 14168, DFF = 8192;
constexpr int NU = 13824;
constexpr int UZ = 0, UXBC = 768, URKV = 2560, UMISC = 4096, UCONV = 4608, UGATE = 5632;
constexpr int S_RKV = 2584, S_DT = 2560, S_WF = 4120, S_CONV = 4440, S_FFT = 5464, S_GATE = 5976;
constexpr int RJ = LCTX + LSEQ;
enum { I_X = 0, I_C, I_CTX, I_CCTX, I_MODW, I_MODB, I_NORMG, I_WIN, I_CONVW, I_CONVB, I_CLNG, I_CLNB, I_CONVOUT, I_SCW, I_SCB, I_SALOG, I_SDTB, I_SD, I_SNG, I_SOUT,
       I_FOUT, I_RMU, I_RW0, I_RW2, I_RA0, I_RA2, I_RG2, I_RKK, I_RKA, I_RRK, I_RLNG, I_RLNB, I_ROUT, I_WO, I_UP, I_DOWN, N_IN };
constexpr size_t MiB = 1u << 20;
constexpr size_t OFF_CTL = 0, CTL_BYTES = 128 * 1024;
constexpr size_t OFF_MODV = 1 * MiB;
constexpr size_t OFF_DFTL = 2 * MiB;
constexpr size_t OFF_DFTC = 18 * MiB;
constexpr size_t OFF_W = 20 * MiB, W_LAYER = 139 * MiB;
constexpr size_t WO_IN = 0, WO_FFT = 54 * MiB, WO_CAT = 58 * MiB  , WO_O = 67 * MiB, WO_UP = 75 * MiB, WO_DN = 107 * MiB;
constexpr size_t OFF_X = 576 * MiB;
constexpr size_t OFF_H = 648 * MiB;
constexpr size_t OFF_U = 684 * MiB;
constexpr size_t OFF_HB = OFF_U;
constexpr size_t OFF_MISC = 927 * MiB;
constexpr size_t OFF_VTL = 945 * MiB;
constexpr size_t OFF_VTC = 961 * MiB;
constexpr size_t OFF_ACAT = 963 * MiB;
constexpr int AC_CONV = 0, AC_SSD = 512, AC_FFT = 1280, AC_RWKV = 1792, ACW = 2304;
constexpr size_t OFF_XBC = 1004 * MiB;
constexpr size_t OFF_DTA = 1036 * MiB;
constexpr size_t OFF_YSSD = 1038 * MiB;
constexpr size_t OFF_RW = 1092 * MiB, RW_ARR = 18 * MiB;
constexpr size_t OFF_RCH = OFF_RW;
constexpr size_t OFF_RSC = 1254 * MiB;
constexpr size_t OFF_YRW = 1255 * MiB;
constexpr size_t OFF_MBUF = 1291 * MiB;
constexpr size_t OFF_M = 1363 * MiB;
constexpr size_t OFF_Y = 1399 * MiB;
constexpr size_t OFF_WLT = 1471 * MiB;
constexpr size_t OFF_YC = 1473 * MiB;
constexpr size_t OFF_WO4 = 1537 * MiB, WO4_LAYER = 32 * MiB;
constexpr size_t OFF_SCAT = OFF_MBUF;
constexpr size_t WS_END = 1665 * MiB;
constexpr int CW_Q = 8192;
constexpr int CW_CQ = 12288;
constexpr int CW_BAR = 4096;
constexpr int RING_BYTES = 131072, MISC_OFF = RING_BYTES + 320, LDS_BYTES = 147456;

__device__ __forceinline__ float bf2f(unsigned short b) { return __uint_as_float((unsigned)b << 16); }
__device__ __forceinline__ float bflo(unsigned u) { return __uint_as_float(u << 16); }
__device__ __forceinline__ float bfhi(unsigned u) { return __uint_as_float(u & 0xffff0000u); }
__device__ __forceinline__ unsigned f2bf(float f) { unsigned u = __builtin_bit_cast(unsigned, f); return (u + 0x7fffu + ((u >> 16) & 1u)) >> 16; }
typedef __bf16 bf16x2_t __attribute__((ext_vector_type(2)));
__device__ __forceinline__ unsigned pk2(float lo, float hi) { const bf16x2_t r = __builtin_convertvector((f32x2){lo, hi}, bf16x2_t); return __builtin_bit_cast(unsigned, r); }
__device__ __forceinline__ float sigmoidf_(float x) { return __builtin_amdgcn_rcpf(1.f + __expf(-x)); }
__device__ __forceinline__ float siluf_(float x) { return x * __builtin_amdgcn_rcpf(1.f + __expf(-x)); }
__device__ __forceinline__ float softplusf_(float x) { return fmaxf(x, 0.f) + __logf(1.f + __expf(-fabsf(x))); }
__device__ __forceinline__ bf16 bf1(float x) { return (bf16)(pk2(x, x) & 0xffffu); }
template <int CTRL> __device__ __forceinline__ float dpp_add(float x) { return x + __int_as_float(__builtin_amdgcn_update_dpp(0, __float_as_int(x), CTRL, 0xf, 0xf, true)); }
__device__ __forceinline__ float sum8(float x) { x = dpp_add<0xB1>(x); x = dpp_add<0x4E>(x); x = dpp_add<0x141>(x); return x; }
__device__ __forceinline__ float row16_sum(float x) { x = sum8(x); x = dpp_add<0x140>(x); return x; }
__device__ __forceinline__ float wave_sum(float v) {
    const float r = row16_sum(v);
    return (__int_as_float(__builtin_amdgcn_readlane(__float_as_int(r), 0)) + __int_as_float(__builtin_amdgcn_readlane(__float_as_int(r), 16))) +
           (__int_as_float(__builtin_amdgcn_readlane(__float_as_int(r), 32)) + __int_as_float(__builtin_amdgcn_readlane(__float_as_int(r), 48)));
}
#define LDS_WAIT() asm volatile("s_waitcnt lgkmcnt(0)" ::: "memory")

struct Args { const float* in[N_IN]; float* out; unsigned char* ws; int ph_lo, ph_hi; };
typedef const __attribute__((address_space(4))) Args* KArgs;
__device__ __forceinline__ KArgs kargs() { KArgs p = (KArgs)__builtin_amdgcn_kernarg_segment_ptr(); asm volatile("" : "+s"(p)); return p; }
#define PH_IDS unsigned z_ = 0u; asm volatile("" : "+v"(z_)); const int lane_ = (int)__builtin_amdgcn_mbcnt_hi(~0u, __builtin_amdgcn_mbcnt_lo(~0u, z_)); int wv_ = wave0; asm volatile("" : "+s"(wv_)); const int lane = lane_, wave = wv_, tid = wv_ * 64 + lane_; (void)lane; (void)wave; (void)tid;

__device__ __forceinline__ int inmap(int n) {
    if (n < 2560) return n;
    if (n < 4096) return S_RKV + (n - 2560);
    if (n < 4608) { const int m = n - 4096; if (m < 24) return S_DT + m; if (m < 64) return -1; if (m < 384) return S_WF + (m - 64); return -1; }
    if (n < 5632) return S_CONV + (n - 4608);
    return S_GATE + (n - 5632);
}
__device__ __forceinline__ int rwkv_tok(int b, int j) { if (j < LCTX) return TLAT + b * LCTX + j; const int s = j - LCTX; return b * LSEQ + (s & 31) * 64 + (s >> 5); }

constexpr int IT_IN = 32 * (NU / 32), IT_CO = 8 * 64, IT_SO = 12 * 64, IT_FO = 8 * 64, IT_RO = 8 * 64, IT_O = 32 * 64, IT_UP = 32 * 256, IT_DN = 128 * 64;
constexpr int IT_LAYER = IT_IN + IT_CO + IT_SO + IT_FO + IT_RO + IT_O + IT_UP + IT_DN;
struct CvItem { const float* src; bf16* dst; int Nsrc, ldw, k0, n0, koff; bool mapped; bf16* dst4; };
__device__ __forceinline__ CvItem cv_decode(KArgs a, int l, int r) {
    unsigned char* wl = a->ws + OFF_W + (size_t)l * W_LAYER;
    if (r < IT_IN) { const int kb = r / (NU / 32), nb = r % (NU / 32); return CvItem{a->in[I_WIN] + (size_t)l * DM * IN_DIM, (bf16*)(wl + WO_IN), IN_DIM, DM, kb * 64, nb * 32, 0, true, nullptr}; } r -= IT_IN;
    if (r < IT_CO) return CvItem{a->in[I_CONVOUT] + (size_t)l * 512 * DM, (bf16*)(wl + WO_CAT), DM, ACW, (r / 64) * 64, (r % 64) * 32, AC_CONV, false, nullptr}; r -= IT_CO;
    if (r < IT_SO) return CvItem{a->in[I_SOUT] + (size_t)l * 768 * DM, (bf16*)(wl + WO_CAT), DM, ACW, (r / 64) * 64, (r % 64) * 32, AC_SSD, false, nullptr}; r -= IT_SO;
    if (r < IT_FO) return CvItem{a->in[I_FOUT] + (size_t)l * 512 * DM, (bf16*)(wl + WO_CAT), DM, ACW, (r / 64) * 64, (r % 64) * 32, AC_FFT, false, nullptr}; r -= IT_FO;
    if (r < IT_RO) return CvItem{a->in[I_ROUT] + (size_t)l * 512 * DM, (bf16*)(wl + WO_CAT), DM, ACW, (r / 64) * 64, (r % 64) * 32, AC_RWKV, false, nullptr}; r -= IT_RO;
    if (r < IT_O) return CvItem{a->in[I_WO] + (size_t)l * DM * DM, (bf16*)(wl + WO_O), DM, DM, (r / 64) * 64, (r % 64) * 32, 0, false, nullptr}; r -= IT_O;
    if (r < IT_UP) return CvItem{a->in[I_UP] + (size_t)l * DM * DFF, (bf16*)(wl + WO_UP), DFF, DM, (r / 256) * 64, (r % 256) * 32, 0, false, nullptr}; r -= IT_UP;
    return CvItem{a->in[I_DOWN] + (size_t)l * DFF * DM, (bf16*)(wl + WO_DN), DM, DFF, (r / 64) * 64, (r % 64) * 32, 0, false, nullptr};
}
__device__ __forceinline__ void cv_load(const CvItem& c, f32x4 (&v)[8], int lane) {
    const int n4 = (lane & 7) * 4; const int sc = c.mapped ? inmap(c.n0 + n4) : (c.n0 + n4);
#pragma unroll
    for (int i = 0; i < 8; ++i) { const int kk = 8 * i + (lane >> 3); v[i] = (sc >= 0) ? *(const f32x4*)(c.src + (size_t)(c.k0 + kk) * c.Nsrc + sc) : (f32x4){0.f, 0.f, 0.f, 0.f}; }
}
__device__ __forceinline__ void cv_store(const CvItem& c, const f32x4 (&v)[8], LAS float* scr, int lane) {
    const int n4 = (lane & 7) * 4;
#pragma unroll
    for (int i = 0; i < 8; ++i) { const int kk = 8 * i + (lane >> 3); LAS float* d = scr + kk * 33 + n4; d[0] = v[i].x; d[1] = v[i].y; d[2] = v[i].z; d[3] = v[i].w; }
    LDS_WAIT();
    const int cc = lane & 7;
#pragma unroll
    for (int j = 0; j < 4; ++j) { const int n = (lane >> 3) + 8 * j; const LAS float* s = scr + (8 * cc) * 33 + n;
        v4u o; o.x = pk2(s[0 * 33], s[1 * 33]); o.y = pk2(s[2 * 33], s[3 * 33]); o.z = pk2(s[4 * 33], s[5 * 33]); o.w = pk2(s[6 * 33], s[7 * 33]);
        *(v4u*)(c.dst + (size_t)(c.n0 + n) * c.ldw + c.koff + c.k0 + 8 * cc) = o;
        if (c.dst4) { bf16* d4 = c.dst4 + (size_t)(c.n0 + n) * 8192 + (c.k0 >> 8) * 1024 + (c.k0 & 255) + 8 * cc;
#pragma unroll
            for (int i = 0; i < 4; ++i) *(v4u*)(d4 + i * 256) = o; } }
    LDS_WAIT();
}
__device__ __forceinline__ void p0_prologue(KArgs a, LAS unsigned char* lds, int bid, int G, const int wave0, const int sel = 15) {
    PH_IDS
    unsigned char* ws = a->ws;
    if (sel & 1) {
        LAS float* sc = (LAS float*)lds;
        LAS float* part = (LAS float*)(lds + 40960);
        for (int i = tid; i < 5 * DM; i += NTHR) { const float v = (i < 4 * DM) ? a->in[I_C][i] : a->in[I_CCTX][i - 4 * DM]; sc[i] = siluf_(v); }
        __syncthreads();
        float* MODV = (float*)(ws + OFF_MODV);
        const int nblk = ((DEPTH * 192 - bid + G - 1) / G) * 16;
        auto wptr = [&](int q) { int ln = lane; asm volatile("" : "+v"(ln));
            const int it = bid + (q >> 4) * G, l = it / 192;
            return a->in[I_MODW] + (size_t)l * DM * 12288 + (size_t)(wave * 256 + (q & 15) * 16) * 12288 + (it % 192) * 64 + ln; };
        float w0[16], w1[16], acc[5] = {0.f, 0.f, 0.f, 0.f, 0.f};
        { const float* wp = wptr(0);
#pragma unroll
          for (int k = 0; k < 16; ++k) w0[k] = wp[(size_t)k * 12288]; }
#pragma unroll 1
        for (int q = 0; q < nblk; q += 2) {
            { const float* wp = wptr(q + 1);
#pragma unroll
              for (int k = 0; k < 16; ++k) w1[k] = wp[(size_t)k * 12288]; }
            { const int kb = wave * 256 + (q & 15) * 16;
#pragma unroll
              for (int k = 0; k < 16; ++k)
#pragma unroll
                  for (int r = 0; r < 5; ++r) acc[r] += sc[r * DM + kb + k] * w0[k]; }
            if (q + 2 < nblk) { const float* wp = wptr(q + 2);
#pragma unroll
              for (int k = 0; k < 16; ++k) w0[k] = wp[(size_t)k * 12288]; }
            { const int kb = wave * 256 + ((q + 1) & 15) * 16;
#pragma unroll
              for (int k = 0; k < 16; ++k)
#pragma unroll
                  for (int r = 0; r < 5; ++r) acc[r] += sc[r * DM + kb + k] * w1[k]; }
            if (((q + 1) & 15) == 15) {
                const int it = bid + (q >> 4) * G, l = it / 192;
#pragma unroll
                for (int r = 0; r < 5; ++r) { part[(wave * 5 + r) * 64 + lane] = acc[r]; acc[r] = 0.f; }
                __syncthreads();
                if (tid < 320) { const int r = tid >> 6, jj = tid & 63; float s = 0.f;
#pragma unroll
                    for (int w = 0; w < 8; ++w) s += part[(w * 5 + r) * 64 + jj];
                    const int jo = (it % 192) * 64 + jj; MODV[((size_t)l * 5 + r) * 12288 + jo] = s + a->in[I_MODB][l * 12288 + jo]; }
                __syncthreads();
            }
        }
    }
    if (sel & 2) {
        typedef short bfx8 __attribute__((ext_vector_type(8)));
        LAS float* ctab = (LAS float*)(lds + 32768);
        __syncthreads();
        if (tid < 128) ctab[tid] = cospif((float)tid * (1.f / 64.f));
        __syncthreads();
        const int fr = lane & 15, fq = lane >> 4, half = wave >> 2, cb = (wave & 3) * 32;
        v4u th[2][4], tl[2][4];
#pragma unroll
        for (int nt = 0; nt < 2; ++nt)
#pragma unroll
            for (int ct = 0; ct < 4; ++ct) { const int cp = cb + 16 * nt + fr; unsigned h[4], lo[4];
#pragma unroll
                for (int e = 0; e < 4; ++e) { const int c = 32 * ct + 8 * fq + 2 * e;
                    const float v0 = ctab[(c * cp - 32 * half) & 127], v1 = ctab[((c + 1) * cp - 32 * half) & 127];
                    h[e] = pk2(v0, v1); lo[e] = pk2(v0 - bflo(h[e]), v1 - bfhi(h[e])); }
                th[nt][ct] = (v4u){h[0], h[1], h[2], h[3]}; tl[nt][ct] = (v4u){lo[0], lo[1], lo[2], lo[3]}; }
        for (int it = bid; it < DEPTH * 32 * 4; it += G) {
            const int l = it / 128, kb = (it % 128) / 4, g = it % 4, k0 = kb * 64;
            const float* Wsrc = a->in[I_WIN] + ((size_t)l * DM + k0) * IN_DIM + S_FFT + g * 128 + 8 * fq;
            bf16* WT = (bf16*)(ws + OFF_W + (size_t)l * W_LAYER + WO_FFT) + (size_t)(half * 512 + g * 128 + cb + fr) * DM + k0 + 8 * fq;
#pragma unroll 1
            for (int p = 0; p < 2; ++p) {
                f32x4 raw[2][4][2];
#pragma unroll
                for (int mi = 0; mi < 2; ++mi) { const int kk = 32 * p + 8 * (fr >> 2) + 4 * mi + (fr & 3);
#pragma unroll
                    for (int ct = 0; ct < 4; ++ct) { const float* sp = Wsrc + (size_t)kk * IN_DIM + 32 * ct; raw[mi][ct][0] = *(const f32x4*)sp; raw[mi][ct][1] = *(const f32x4*)(sp + 4); } }
                f32x4 acc[2][2];
#pragma unroll
                for (int mi = 0; mi < 2; ++mi)
#pragma unroll
                    for (int nt = 0; nt < 2; ++nt) acc[mi][nt] = (f32x4){0.f, 0.f, 0.f, 0.f};
#pragma unroll
                for (int mi = 0; mi < 2; ++mi)
#pragma unroll
                    for (int ct = 0; ct < 4; ++ct) { const f32x4 r0 = raw[mi][ct][0], r1 = raw[mi][ct][1];
                        v4u ah, al; ah.x = pk2(r0.x, r0.y); ah.y = pk2(r0.z, r0.w); ah.z = pk2(r1.x, r1.y); ah.w = pk2(r1.z, r1.w);
                        al.x = pk2(r0.x - bflo(ah.x), r0.y - bfhi(ah.x)); al.y = pk2(r0.z - bflo(ah.y), r0.w - bfhi(ah.y)); al.z = pk2(r1.x - bflo(ah.z), r1.y - bfhi(ah.z)); al.w = pk2(r1.z - bflo(ah.w), r1.w - bfhi(ah.w));
#pragma unroll
                        for (int nt = 0; nt < 2; ++nt) {
                            acc[mi][nt] = __builtin_amdgcn_mfma_f32_16x16x32_bf16(__builtin_bit_cast(bfx8, ah), __builtin_bit_cast(bfx8, th[nt][ct]), acc[mi][nt], 0, 0, 0);
                            acc[mi][nt] = __builtin_amdgcn_mfma_f32_16x16x32_bf16(__builtin_bit_cast(bfx8, ah), __builtin_bit_cast(bfx8, tl[nt][ct]), acc[mi][nt], 0, 0, 0);
                            acc[mi][nt] = __builtin_amdgcn_mfma_f32_16x16x32_bf16(__builtin_bit_cast(bfx8, al), __builtin_bit_cast(bfx8, th[nt][ct]), acc[mi][nt], 0, 0, 0); } }
#pragma unroll
                for (int nt = 0; nt < 2; ++nt)
                    *(v4u*)(WT + (size_t)(16 * nt) * DM + 32 * p) = (v4u){pk2(acc[0][nt][0], acc[0][nt][1]), pk2(acc[0][nt][2], acc[0][nt][3]), pk2(acc[1][nt][0], acc[1][nt][1]), pk2(acc[1][nt][2], acc[1][nt][3])};
            }
        }
        __syncthreads();
    }
    const int gw = bid * NWAVES + wave, NGW = G * NWAVES;
    if (sel & 4) {
        LAS float* scr = (LAS float*)(lds + wave * 8448);
        f32x4 v0[8], v1[8]; int it = gw;
        if (it < DEPTH * IT_LAYER) { CvItem c0 = cv_decode(a, it / IT_LAYER, it % IT_LAYER); cv_load(c0, v0, lane);
            for (;;) { const int itn = it + NGW; const bool more = itn < DEPTH * IT_LAYER; CvItem c1 = c0;
                if (more) { c1 = cv_decode(a, itn / IT_LAYER, itn % IT_LAYER); cv_load(c1, v1, lane); }
                cv_store(c0, v0, scr, lane);
                if (!more) break;
#pragma unroll
                for (int i = 0; i < 8; ++i) v0[i] = v1[i];
                c0 = c1; it = itn; } }
    }
    if (sel & 8) {
        const int gt = bid * NTHR + tid, NGT = G * NTHR;
        bf16* FL = (bf16*)(ws + OFF_DFTL); bf16* FC = (bf16*)(ws + OFF_DFTC);
        { bf16* WLT = (bf16*)(ws + OFF_WLT);
          for (int i = gt; i < DEPTH * 512 * 320; i += NGT) { const int l = i / (512 * 320), c = (i / 320) % 512, j = i % 320; float v;
              if (j < 64) v = a->in[I_RW2][((size_t)(l * 2 + 0) * 64 + j) * 512 + c]; else if (j < 128) v = a->in[I_RW2][((size_t)(l * 2 + 1) * 64 + (j - 64)) * 512 + c];
              else if (j < 192) v = a->in[I_RA2][((size_t)l * 64 + (j - 128)) * 512 + c]; else v = a->in[I_RG2][((size_t)l * 128 + (j - 192)) * 512 + c];
              WLT[i] = (bf16)f2bf(v); } }
        for (int i = gt; i < 2048 * 512; i += NGT) { const int lp = i >> 9, k8 = (i & 511) * 8; unsigned o[4];
#pragma unroll
            for (int e = 0; e < 4; ++e) { float v[2];
#pragma unroll
                for (int q = 0; q < 2; ++q) { const int k = k8 + 2 * e + q; const int m = (lp * (k & 2047)) & 2047; float sn, cs; sincospif((float)m * (1.f / 1024.f), &sn, &cs); v[q] = (k < 2048 ? cs : -sn) * (1.f / 512.f); }
                o[e] = pk2(v[0], v[1]); }
            *(v4u*)(FL + (size_t)lp * 4096 + k8) = (v4u){o[0], o[1], o[2], o[3]}; }
        for (int i = gt; i < 256 * 64; i += NGT) { const int lp = i >> 6, k8 = (i & 63) * 8; unsigned o[4];
#pragma unroll
            for (int e = 0; e < 4; ++e) { float v[2];
#pragma unroll
                for (int q = 0; q < 2; ++q) { const int k = k8 + 2 * e + q; const int m = (lp * (k & 255)) & 255; float sn, cs; sincospif((float)m * (1.f / 128.f), &sn, &cs); v[q] = (k < 256 ? cs : -sn) * 0.005524271728f; }
                o[e] = pk2(v[0], v[1]); }
            *(v4u*)(FC + (size_t)lp * 512 + k8) = (v4u){o[0], o[1], o[2], o[3]}; }
    }
}

__device__ __forceinline__ void norm_phase(KArgs a, int mode, const float* gY, const float* gH, const float* modY  , const float* modH  ,
                                           int bid, int G, const int wave0, int nrows, bool split = false  , bool dry = false  , bool xin = false  ) {
    PH_IDS
    unsigned char* ws = a->ws; const int gw = bid * NWAVES + wave, NGW = G * NWAVES;
    const float* X = (const float*)(ws + OFF_X); const bf16* Y = (const bf16*)(ws + OFF_Y); bf16* H = (bf16*)(ws + (dry ? OFF_M : OFF_H)); float* Xw = (float*)(ws + (dry ? OFF_MBUF : OFF_X));
    f32x4 xn[8]; v2u yn[8];
    auto fetch = [&](int row) {
        const f32x4* xr = (const f32x4*)(xin ? (row < TLAT ? a->in[I_X] + (size_t)row * DM : a->in[I_CTX] + (size_t)(row - TLAT) * DM) : X + (size_t)row * DM) + lane;
#pragma unroll
        for (int j = 0; j < 8; ++j) xn[j] = xr[64 * j];
        if (mode != 0 && !(split && row >= TLAT)) { const v2u* yr = (const v2u*)(Y + (size_t)row * DM) + lane;
#pragma unroll
            for (int j = 0; j < 8; ++j) yn[j] = yr[64 * j]; } };
    f32x4 gvc[8], hgc[8];
#pragma unroll
    for (int j = 0; j < 8; ++j) { gvc[j] = (mode != 0) ? ((const f32x4*)gY + lane)[64 * j] : (f32x4){0.f, 0.f, 0.f, 0.f}; hgc[j] = (mode != 2) ? ((const f32x4*)gH + lane)[64 * j] : (f32x4){0.f, 0.f, 0.f, 0.f}; }
    if (gw < nrows) fetch(gw);
    for (int row = gw; row < nrows; row += NGW) {
        const int mr = row < TLAT ? (row >> 11) : 4;
        f32x4 x[8];
#pragma unroll
        for (int j = 0; j < 8; ++j) x[j] = xn[j];
        if (mode != 0) {
            f32x4 y[8]; float ss = 0.f;
            if (split && row >= TLAT) { const v2u* yc = (const v2u*)((const bf16*)(ws + OFF_YC) + (size_t)(row - TLAT) * DM) + lane;
#pragma unroll
                for (int j = 0; j < 8; ++j) { f32x4 t = (f32x4){0.f, 0.f, 0.f, 0.f};
#pragma unroll
                    for (int sl = 0; sl < 8; ++sl) { const v2u q = yc[(size_t)sl * 1024 * 512 + 64 * j]; t += (f32x4){bflo(q.x), bfhi(q.x), bflo(q.y), bfhi(q.y)}; }
                    y[j] = t; } }
            else {
#pragma unroll
                for (int j = 0; j < 8; ++j) { const v2u t = yn[j]; y[j] = (f32x4){bflo(t.x), bfhi(t.x), bflo(t.y), bfhi(t.y)}; } }
            const f32x4* gt = (const f32x4*)(modY + (size_t)mr * 12288) + lane;
            f32x4 tv[8];
#pragma unroll
            for (int j = 0; j < 8; ++j) tv[j] = gt[64 * j];
            if (row + NGW < nrows) fetch(row + NGW);
#pragma unroll
            for (int j = 0; j < 8; ++j) { ss += (y[j].x * y[j].x + y[j].y * y[j].y) + (y[j].z * y[j].z + y[j].w * y[j].w); }
            const float r = rsqrtf(wave_sum(ss) * (1.f / DM) + 1e-6f);
#pragma unroll
            for (int j = 0; j < 8; ++j) x[j] += tv[j] * (y[j] * r * gvc[j]);
        } else if (row + NGW < nrows) fetch(row + NGW);
        f32x4 hs[8], hc[8];
        if (mode != 2) { const f32x4* sh = (const f32x4*)(modH + (size_t)mr * 12288) + lane; const f32x4* sc = sh + 512;
#pragma unroll
            for (int j = 0; j < 8; ++j) { hs[j] = sh[64 * j]; hc[j] = sc[64 * j]; } }
        asm volatile("" ::: "memory");
        if (mode == 1) { f32x4* xw = (f32x4*)(Xw + (size_t)row * DM) + lane;
#pragma unroll
            for (int j = 0; j < 8; ++j) xw[64 * j] = x[j]; }
        else if (mode == 2) { f32x4* ow = (f32x4*)(a->out + (size_t)row * DM) + lane;
#pragma unroll
            for (int j = 0; j < 8; ++j) ow[64 * j] = x[j]; }
        if (mode != 2) {
            float ss = 0.f;
#pragma unroll
            for (int j = 0; j < 8; ++j) ss += (x[j].x * x[j].x + x[j].y * x[j].y) + (x[j].z * x[j].z + x[j].w * x[j].w);
            const float r = rsqrtf(wave_sum(ss) * (1.f / DM) + 1e-6f);
            v2u* hw = (v2u*)(H + (size_t)row * DM) + lane;
#pragma unroll
            for (int j = 0; j < 8; ++j) { const f32x4 h = (x[j] * r * hgc[j]) * (hc[j] + 1.f) + hs[j]; hw[64 * j] = (v2u){pk2(h.x, h.y), pk2(h.z, h.w)}; }
        }
    }
}
#define XB_TMO      128
#define XB_XCNT(j)  (256  + 64 * (j))
#define XB_XSUB(j)  (1280 + 64 * (j))
#define XB_XGEN(j)  (2304 + 64 * (j))
#define XB_TOP      3328
#define XB_TOPGEN   3392
#define XCD_BAR_WORDS 3456
#define XB_SPIN_CAP (1u << 18)

__device__ __forceinline__ unsigned xb_ld(unsigned* p)              { return __hip_atomic_load(p, __ATOMIC_RELAXED, __HIP_MEMORY_SCOPE_AGENT); }
__device__ __forceinline__ unsigned xb_add(unsigned* p, unsigned v) { return __hip_atomic_fetch_add(p, v, __ATOMIC_RELAXED, __HIP_MEMORY_SCOPE_AGENT); }
__device__ __forceinline__ unsigned xb_xcc_id() { return (unsigned)__builtin_amdgcn_s_getreg((3 << 11) | 20) & 0xFu; }
#define XB_SPIN(cond, bar) do { unsigned _sp = 0; while (cond) { __builtin_amdgcn_s_sleep(1); \
    if ((++_sp & 255u) == 0u) { if (xb_ld(&(bar)[XB_TMO])) break; if (_sp > XB_SPIN_CAP) { atomicAdd(&(bar)[XB_TMO], 1u); break; } } } } while (0)

struct XcdBarrier {
    unsigned* bar; unsigned x; int wv;
    volatile LAS unsigned* st;
};

__device__ __forceinline__ bool xb_t0(int wv) { unsigned z_ = 0u; asm volatile("" : "+v"(z_)); return wv == 0 && __builtin_amdgcn_mbcnt_hi(~0u, __builtin_amdgcn_mbcnt_lo(~0u, z_)) == 0u; }
__device__ __forceinline__ XcdBarrier xcd_barrier_post(unsigned* bar, volatile LAS unsigned* st, int wv) {
    XcdBarrier b; b.bar = bar; b.x = xb_xcc_id(); b.st = st; b.wv = wv;
    if (xb_t0(wv)) (void)xb_add(&bar[XB_XCNT(b.x)], 1u);
    return b;
}
__device__ __forceinline__ void xcd_barrier_complete(unsigned* bar, unsigned x, unsigned& nloc, unsigned& nx) {
    const unsigned G = gridDim.x * gridDim.y * gridDim.z;
    unsigned sum, cnt, mine, sp = 0u;
    for (;;) {
        sum = 0u; cnt = 0u; mine = 0u;
#pragma unroll
        for (unsigned j = 0; j < 16; ++j) { const unsigned c = xb_ld(&bar[XB_XCNT(j)]); sum += c; cnt += (c > 0u) ? 1u : 0u; mine = (j == x) ? c : mine; }
        if (sum == G) break;
        __builtin_amdgcn_s_sleep(1);
        if ((++sp & 255u) == 0u) { if (xb_ld(&bar[XB_TMO])) break; if (sp > XB_SPIN_CAP) { atomicAdd(&bar[XB_TMO], 1u); break; } }
    }
    nloc = mine > 0u ? mine : 1u; nx = cnt > 0u ? cnt : 1u;
}

__device__ __forceinline__ void xcd_barrier(const XcdBarrier& b) {
    asm volatile("s_waitcnt vmcnt(0)" ::: "memory");
    __syncthreads();
    if (xb_t0(b.wv)) {
        unsigned* bar = b.bar;
        __builtin_amdgcn_s_waitcnt(0);
        unsigned nloc = b.st[0], nx = b.st[1];
        if (nloc == 0u) { xcd_barrier_complete(bar, b.x, nloc, nx); b.st[0] = nloc; b.st[1] = nx; }
        const unsigned old = xb_add(&bar[XB_XSUB(b.x)], 1u);
        const unsigned gen = old / nloc;
        if (old + 1u == (gen + 1u) * nloc) {
            __builtin_amdgcn_fence(__ATOMIC_RELEASE, "agent");
            asm volatile("s_waitcnt vmcnt(0)" ::: "memory");
            const unsigned og = xb_add(&bar[XB_TOP], 1u);
            const unsigned tg = og / nx;
            if (og + 1u == (tg + 1u) * nx) xb_add(&bar[XB_TOPGEN], 1u);
            else XB_SPIN(xb_ld(&bar[XB_TOPGEN]) == tg, bar);
            __builtin_amdgcn_fence(__ATOMIC_ACQUIRE, "agent");
            xb_add(&bar[XB_XGEN(b.x)], 1u);
            asm volatile("s_waitcnt vmcnt(0)" ::: "memory");
        } else {
            XB_SPIN(xb_ld(&bar[XB_XGEN(b.x)]) == gen, bar);
            __builtin_amdgcn_fence(__ATOMIC_ACQUIRE, "agent");
            asm volatile("s_waitcnt vmcnt(0)" ::: "memory");
        }
    }
    __syncthreads();
}

constexpr int RCH_NT = 0, RCH_RT = 2048, RCH_KST = 4096, RCH_TT = 4608, RCH_ART = 5120, RCH_KRT = 5632, RCH_VM = 6144, RCH_APT = 8192, RCH_KPT = 10240, RCH_GC = 12288, RCH_BYTES = 12544;

typedef short bf16x8 __attribute__((ext_vector_type(8)));
constexpr int RP_PITCH = 516, ACT_PITCH = 328;
__device__ __forceinline__ void rwkv_prep_item(KArgs a, int l, int item, LAS unsigned char* lds, int tid, int lane, int wave) {
    unsigned char* ws = a->ws;
    const bf16* U = (const bf16*)(ws + OFF_U); const float* MISC = (const float*)(ws + OFF_MISC);
    const int b = item / 144, j0 = (item % 144) * 16; const bool isctx = j0 < LCTX;
    LAS float* RP = (LAS float*)lds;
    LAS float* KP = RP + 16 * RP_PITCH; LAS float* VP = KP + 16 * RP_PITCH;
    LAS bf16* ACT = (LAS bf16*)(lds + 3 * 16 * RP_PITCH * 4);
    const float* mu = a->in[I_RMU] + l * 1856;
    bf16x8 wfr[10][4];
    { const bf16* WLT = (const bf16*)(ws + OFF_WLT) + (size_t)l * 512 * 320 + (size_t)(64 * wave + (lane & 15)) * 320 + (lane >> 4) * 8;
#pragma unroll
      for (int ks = 0; ks < 10; ++ks)
#pragma unroll
          for (int nt = 0; nt < 4; ++nt) wfr[ks][nt] = *(const bf16x8*)(WLT + (size_t)nt * 16 * 320 + ks * 32); }
#pragma unroll
    for (int it_ = 0; it_ < 6; ++it_) { const int idx = tid + it_ * NTHR; const int i = idx / 192, c8 = idx % 192, jj = j0 + i;
        const bool hp = isctx ? (jj - 1 >= 0) : (jj - 1 >= LCTX), hn = isctx ? (jj + 1 < LCTX) : (jj + 1 < RJ);
        const v4u c = *(const v4u*)(U + (size_t)rwkv_tok(b, jj) * NU + URKV + c8 * 8);
        v4u p = (v4u){0u, 0u, 0u, 0u}, n = p;
        if (hp) p = *(const v4u*)(U + (size_t)rwkv_tok(b, jj - 1) * NU + URKV + c8 * 8);
        if (hn) n = *(const v4u*)(U + (size_t)rwkv_tok(b, jj + 1) * NU + URKV + c8 * 8);
        const f32x4 m0 = *(const f32x4*)(mu + c8 * 8), m1 = *(const f32x4*)(mu + c8 * 8 + 4);
        f32x4 x0 = (f32x4){bflo(c.x), bfhi(c.x), bflo(c.y), bfhi(c.y)}, x1 = (f32x4){bflo(c.z), bfhi(c.z), bflo(c.w), bfhi(c.w)};
        const f32x4 s0 = (f32x4){bflo(p.x) + bflo(n.x), bfhi(p.x) + bfhi(n.x), bflo(p.y) + bflo(n.y), bfhi(p.y) + bfhi(n.y)}, s1 = (f32x4){bflo(p.z) + bflo(n.z), bfhi(p.z) + bfhi(n.z), bflo(p.w) + bflo(n.w), bfhi(p.w) + bfhi(n.w)};
        x0 = x0 + (0.5f * s0 - x0) * m0; x1 = x1 + (0.5f * s1 - x1) * m1;
        const int ch = c8 * 8, reg = ch >> 9; LAS float* dst = (reg == 0 ? RP : (reg == 1 ? KP : VP)) + i * RP_PITCH + (ch & 511);
        *(LAS f32x4*)dst = x0; *(LAS f32x4*)(dst + 4) = x1; }
#pragma unroll
    for (int it_ = 0; it_ < 3; ++it_) { const int idx = tid + it_ * NTHR; if (idx >= 16 * 80) break; const int i = idx / 80, c4 = idx % 80, jj = j0 + i;
        const bool hp = isctx ? (jj - 1 >= 0) : (jj - 1 >= LCTX), hn = isctx ? (jj + 1 < LCTX) : (jj + 1 < RJ);
        f32x4 x = *(const f32x4*)(MISC + (size_t)rwkv_tok(b, jj) * 512 + 64 + c4 * 4); f32x4 p = (f32x4){0.f, 0.f, 0.f, 0.f}, n = p;
        if (hp) p = *(const f32x4*)(MISC + (size_t)rwkv_tok(b, jj - 1) * 512 + 64 + c4 * 4);
        if (hn) n = *(const f32x4*)(MISC + (size_t)rwkv_tok(b, jj + 1) * 512 + 64 + c4 * 4);
        x = x + (0.5f * (p + n) - x) * *(const f32x4*)(mu + 1536 + c4 * 4);
        const int m = c4 * 4;
        if (m < 128) x = (f32x4){tanhf(x.x), tanhf(x.y), tanhf(x.z), tanhf(x.w)}; else if (m >= 192) x = (f32x4){sigmoidf_(x.x), sigmoidf_(x.y), sigmoidf_(x.z), sigmoidf_(x.w)};
        *(LAS v2u*)(ACT + i * ACT_PITCH + m) = (v2u){pk2(x.x, x.y), pk2(x.z, x.w)}; }
    __syncthreads();
    const int fr = lane & 15, fq = lane >> 4, h = wave;
    f32x4 acc[4][4];
#pragma unroll
    for (int o = 0; o < 4; ++o)
#pragma unroll
        for (int nt = 0; nt < 4; ++nt) acc[o][nt] = (f32x4){0.f, 0.f, 0.f, 0.f};
    {
#pragma unroll
        for (int ks = 0; ks < 10; ++ks) { const int o = ks < 2 ? 0 : (ks < 4 ? 1 : (ks < 6 ? 2 : 3));
            const bf16x8 af = *(const LAS bf16x8*)(ACT + fr * ACT_PITCH + ks * 32 + fq * 8);
#pragma unroll
            for (int nt = 0; nt < 4; ++nt) acc[o][nt] = __builtin_amdgcn_mfma_f32_16x16x32_bf16(af, wfr[ks][nt], acc[o][nt], 0, 0, 0); }
    }
    float* RW = (float*)(ws + OFF_RW); constexpr size_t AS = RW_ARR / 4; float* RSC = (float*)(ws + OFF_RSC);
    float w0f[4], w0b[4], a0c[4], kkc[4], kac[4], rkc[4];
#pragma unroll
    for (int nt = 0; nt < 4; ++nt) { const int c = 64 * wave + 16 * nt + fr; w0f[nt] = a->in[I_RW0][(l * 2 + 0) * 512 + c]; w0b[nt] = a->in[I_RW0][(l * 2 + 1) * 512 + c]; a0c[nt] = a->in[I_RA0][l * 512 + c];
        kkc[nt] = a->in[I_RKK][l * 512 + c]; kac[nt] = a->in[I_RKA][l * 512 + c]; rkc[nt] = a->in[I_RRK][l * 512 + c]; }
    float Wd[2][4][4], Rr[4][4], Km[4][4], Nn[4][4], Ka[4][4], Vv[4][4];
#pragma unroll
    for (int i = 0; i < 4; ++i) { const int tok = 4 * fq + i; const size_t R = (size_t)b * RJ + j0 + tok;
        float k[4], av[4], kkv[4]; float ss = 0.f;
#pragma unroll
        for (int nt = 0; nt < 4; ++nt) { const int c = 64 * wave + 16 * nt + fr; Rr[i][nt] = RP[tok * RP_PITCH + c]; k[nt] = KP[tok * RP_PITCH + c]; Vv[i][nt] = VP[tok * RP_PITCH + c];
            av[nt] = sigmoidf_(a0c[nt] + acc[2][nt][i]); kkv[nt] = k[nt] * kkc[nt]; ss += kkv[nt] * kkv[nt]; }
        const float rn = rsqrtf(row16_sum(ss) + 1e-12f);
        float bon = 0.f;
#pragma unroll
        for (int nt = 0; nt < 4; ++nt) { const int c = 64 * wave + 16 * nt + fr;
            Wd[0][i][nt] = __expf(-__expf(-softplusf_(-(w0f[nt] + acc[0][nt][i])) - 0.5f)); Wd[1][i][nt] = __expf(-__expf(-softplusf_(-(w0b[nt] + acc[1][nt][i])) - 0.5f));
            const float kk = kkv[nt] * rn; Km[i][nt] = k[nt] * (1.f + (av[nt] - 1.f) * kac[nt]); Ka[i][nt] = kk * av[nt]; Nn[i][nt] = -kk;
            bon += Rr[i][nt] * Km[i][nt] * rkc[nt];
            float* o = RW + R * 512 + c; o[7 * AS] = Vv[i][nt]; o[8 * AS] = acc[3][nt][i]; }
        bon = row16_sum(bon);
        if (fr == 0) RSC[(size_t)2 * TT * 8 + R * 8 + h] = bon;
    }
    __syncthreads();
    LAS unsigned char* wl_ = lds + wave * 14336;
    LAS bf16* NTl = (LAS bf16*)wl_; LAS bf16* RTl = NTl + 16 * 68; LAS bf16* ATl = RTl + 16 * 68; LAS bf16* KTl = ATl + 16 * 68;
    LAS float* ASl = (LAS float*)(wl_ + 8704);
    LAS float* TTl = (LAS float*)(wl_ + 11264);
    typedef short bf16x4 __attribute__((ext_vector_type(4)));
#pragma unroll
    for (int d = 0; d < 2; ++d) {
        const int cidx = d ? (isctx ? (240 - j0) / 16 : (2544 - j0) / 16) : j0 / 16;
        unsigned char* img = ws + OFF_RCH + ((size_t)((b * 2 + d) * 8 + h) * 144 + cidx) * RCH_BYTES;
        const int laneD = d ? ((3 - fq) * 16 + fr) : lane;
#pragma unroll
        for (int nt = 0; nt < 4; ++nt) {
            float gam[4], gpv[4], G, E;
            if (d == 0) { gam[0] = Wd[0][0][nt]; gam[1] = gam[0] * Wd[0][1][nt]; gam[2] = gam[1] * Wd[0][2][nt]; gam[3] = gam[2] * Wd[0][3][nt]; G = gam[3];
                const float g1 = __int_as_float(__builtin_amdgcn_ds_bpermute((lane - 16) << 2, __float_as_int(G))), g2 = __int_as_float(__builtin_amdgcn_ds_bpermute((lane - 32) << 2, __float_as_int(G))), g3 = __int_as_float(__builtin_amdgcn_ds_bpermute((lane - 48) << 2, __float_as_int(G)));
                E = (fq >= 1 ? g1 : 1.f) * (fq >= 2 ? g2 : 1.f) * (fq >= 3 ? g3 : 1.f);
                gpv[0] = E; gpv[1] = E * gam[0]; gpv[2] = E * gam[1]; gpv[3] = E * gam[2];
#pragma unroll
                for (int i = 0; i < 4; ++i) gam[i] *= E; }
            else { gam[3] = Wd[1][3][nt]; gam[2] = gam[3] * Wd[1][2][nt]; gam[1] = gam[2] * Wd[1][1][nt]; gam[0] = gam[1] * Wd[1][0][nt]; G = gam[0];
                const float g1 = __int_as_float(__builtin_amdgcn_ds_bpermute((lane + 16) << 2, __float_as_int(G))), g2 = __int_as_float(__builtin_amdgcn_ds_bpermute((lane + 32) << 2, __float_as_int(G))), g3 = __int_as_float(__builtin_amdgcn_ds_bpermute((lane + 48) << 2, __float_as_int(G)));
                E = (fq <= 2 ? g1 : 1.f) * (fq <= 1 ? g2 : 1.f) * (fq <= 0 ? g3 : 1.f);
                gpv[3] = E; gpv[2] = E * gam[3]; gpv[1] = E * gam[2]; gpv[0] = E * gam[1];
#pragma unroll
                for (int i = 0; i < 4; ++i) gam[i] *= E; }
            float tot = G * __int_as_float(__builtin_amdgcn_ds_bpermute((lane ^ 16) << 2, __float_as_int(G)));
            tot = tot * __int_as_float(__builtin_amdgcn_ds_bpermute((lane ^ 32) << 2, __float_as_int(tot)));
            float ap[4], kp[4];
#pragma unroll
            for (int i = 0; i < 4; ++i) { const int td = d ? 15 - (4 * fq + i) : 4 * fq + i; const float ig = __builtin_amdgcn_rcpf(gam[i]);
                const float at_ = Ka[i][nt] * ig, kt_ = Km[i][nt] * ig; ap[i] = at_ * tot; kp[i] = kt_ * tot;
                NTl[td * 68 + 16 * nt + fr] = bf1(gpv[i] * Nn[i][nt]); RTl[td * 68 + 16 * nt + fr] = bf1(gam[i] * Rr[i][nt]);
                ATl[td * 68 + 16 * nt + fr] = bf1(at_); KTl[td * 68 + 16 * nt + fr] = bf1(kt_); }
            v2u pa, pk, pv;
            if (d == 0) { pa = (v2u){pk2(ap[0], ap[1]), pk2(ap[2], ap[3])}; pk = (v2u){pk2(kp[0], kp[1]), pk2(kp[2], kp[3])}; pv = (v2u){pk2(Vv[0][nt], Vv[1][nt]), pk2(Vv[2][nt], Vv[3][nt])}; }
            else { pa = (v2u){pk2(ap[3], ap[2]), pk2(ap[1], ap[0])}; pk = (v2u){pk2(kp[3], kp[2]), pk2(kp[1], kp[0])}; pv = (v2u){pk2(Vv[3][nt], Vv[2][nt]), pk2(Vv[1][nt], Vv[0][nt])}; }
            *(v2u*)(img + RCH_APT + nt * 512 + laneD * 8) = pa; *(v2u*)(img + RCH_KPT + nt * 512 + laneD * 8) = pk; *(v2u*)(img + RCH_VM + nt * 512 + laneD * 8) = pv;
            if (fq == 0) *(float*)(img + RCH_GC + (16 * nt + fr) * 4) = tot;
        }
        LDS_WAIT();
#pragma unroll
        for (int kt = 0; kt < 4; ++kt) { *(v2u*)(img + RCH_NT + kt * 512 + lane * 8) = *(const LAS v2u*)(NTl + fr * 68 + 16 * kt + 4 * fq); *(v2u*)(img + RCH_RT + kt * 512 + lane * 8) = *(const LAS v2u*)(RTl + fr * 68 + 16 * kt + 4 * fq); }
        f32x4 cAs = (f32x4){0.f, 0.f, 0.f, 0.f}, cKs = cAs, cAr = cAs, cKr = cAs;
#pragma unroll
        for (int sk = 0; sk < 4; ++sk) { const bf16x4 aA = *(const LAS bf16x4*)(ATl + fr * 68 + 16 * sk + 4 * fq), aK = *(const LAS bf16x4*)(KTl + fr * 68 + 16 * sk + 4 * fq);
            const bf16x4 bN = *(const LAS bf16x4*)(NTl + fr * 68 + 16 * sk + 4 * fq), bR = *(const LAS bf16x4*)(RTl + fr * 68 + 16 * sk + 4 * fq);
            cAs = __builtin_amdgcn_mfma_f32_16x16x16bf16_1k(aA, bN, cAs, 0, 0, 0); cKs = __builtin_amdgcn_mfma_f32_16x16x16bf16_1k(aK, bN, cKs, 0, 0, 0);
            cAr = __builtin_amdgcn_mfma_f32_16x16x16bf16_1k(aA, bR, cAr, 0, 0, 0); cKr = __builtin_amdgcn_mfma_f32_16x16x16bf16_1k(aK, bR, cKr, 0, 0, 0); }
#pragma unroll
        for (int j = 0; j < 4; ++j) { const int ii = 4 * fq + j; if (!(ii < fr)) { cAs[j] = 0.f; cKs[j] = 0.f; } if (!(ii <= fr)) { cAr[j] = 0.f; cKr[j] = 0.f; } }
        *(v2u*)(img + RCH_KST + lane * 8) = (v2u){pk2(cKs[0], cKs[1]), pk2(cKs[2], cKs[3])}; *(v2u*)(img + RCH_ART + lane * 8) = (v2u){pk2(cAr[0], cAr[1]), pk2(cAr[2], cAr[3])};
        *(v2u*)(img + RCH_KRT + lane * 8) = (v2u){pk2(cKr[0], cKr[1]), pk2(cKr[2], cKr[3])};
        *(LAS f32x4*)(ASl + (d * 16 + fr) * 20 + 4 * fq) = cAs;
        LDS_WAIT();
    }
    if (lane < 32) { const int d = lane >> 4, irow = lane & 15; float Tc[16];
#pragma unroll
        for (int t = 0; t < 16; ++t) { float x = (irow == t) ? 1.f : 0.f;
#pragma unroll
            for (int j4 = 0; j4 < (t + 3) / 4; ++j4) { const f32x4 av = *(const LAS f32x4*)(ASl + (d * 16 + t) * 20 + 4 * j4);
#pragma unroll
                for (int e = 0; e < 4; ++e) if (4 * j4 + e < t) x += Tc[4 * j4 + e] * av[e]; }
            Tc[t] = x; TTl[(d * 16 + t) * 20 + irow] = x; } }
    LDS_WAIT();
#pragma unroll
    for (int d = 0; d < 2; ++d) { const int cidx = d ? (isctx ? (240 - j0) / 16 : (2544 - j0) / 16) : j0 / 16;
        unsigned char* img = ws + OFF_RCH + ((size_t)((b * 2 + d) * 8 + h) * 144 + cidx) * RCH_BYTES;
        const f32x4 tv = *(const LAS f32x4*)(TTl + (d * 16 + fr) * 20 + 4 * fq);
        *(v2u*)(img + RCH_TT + lane * 8) = (v2u){pk2(tv[0], tv[1]), pk2(tv[2], tv[3])}; }
    __syncthreads();
}
__device__ __forceinline__ void ssd_prep_item(KArgs a, int l, int item, int tid) {
    unsigned char* ws = a->ws; const bf16* U = (const bf16*)(ws + OFF_U); const float* MISC = (const float*)(ws + OFF_MISC);
    bf16* XBC = (bf16*)(ws + OFF_XBC); float* DTA = (float*)(ws + OFF_DTA);
    const int t0 = item * 16;
    const int seq_lo = t0 < TLAT ? (t0 & ~(LSEQ - 1)) : TLAT + ((t0 - TLAT) & ~(LCTX - 1)), seq_hi = seq_lo + (t0 < TLAT ? LSEQ : LCTX);
    for (int cp = tid; cp < 896; cp += NTHR) {
        float w0[5], w1[5];
#pragma unroll
        for (int j = 0; j < 5; ++j) { const f32x2 w = *(const f32x2*)(a->in[I_SCW] + (size_t)(l * 5 + j) * 1792 + 2 * cp); w0[j] = w.x; w1[j] = w.y; }
        const f32x2 bb = *(const f32x2*)(a->in[I_SCB] + l * 1792 + 2 * cp);
        float i0[20], i1[20];
#pragma unroll
        for (int r = 0; r < 20; ++r) { const int row = t0 - 2 + r; unsigned u = 0u; if (row >= seq_lo && row < seq_hi) u = *(const unsigned*)(U + (size_t)row * NU + UXBC + 2 * cp); i0[r] = bflo(u); i1[r] = bfhi(u); }
#pragma unroll
        for (int o = 0; o < 16; ++o) { float s0 = bb.x, s1 = bb.y;
#pragma unroll
            for (int j = 0; j < 5; ++j) { s0 += w0[j] * i0[o + j]; s1 += w1[j] * i1[o + j]; }
            *(unsigned*)(XBC + (size_t)(t0 + o) * 1792 + 2 * cp) = pk2(siluf_(s0), siluf_(s1)); }
    }
    if (tid < 16 * 24) { const int o = tid / 24, q = tid % 24;
        const float dt = softplusf_(MISC[(size_t)(t0 + o) * 512 + q] + a->in[I_SDTB][l * 24 + q]); const float A = -__expf(a->in[I_SALOG][l * 24 + q]);
        DTA[(size_t)(t0 + o) * 48 + q] = dt; DTA[(size_t)(t0 + o) * 48 + 24 + q] = dt * A; }
}
__device__ __forceinline__ void conv_item(KArgs a, int l, int item, LAS unsigned char* lds, int tid, int lane, int wave) {
    unsigned char* ws = a->ws; const bf16* U = (const bf16*)(ws + OFF_U); bf16* AC = (bf16*)(ws + OFF_ACAT) + AC_CONV;
    int t0, seg_lo, seg_hi;
    if (item < 256) { t0 = item * 32; seg_lo = t0 & ~63; seg_hi = seg_lo + 64; }
    else { const int ci = item - 256; t0 = TLAT + ci * 32; seg_lo = TLAT + (ci >> 3) * LCTX; seg_hi = seg_lo + LCTX; }
    LAS bf16* inimg = (LAS bf16*)lds;
    LAS float* outimg = (LAS float*)(lds + 63488);
    v4u cva[8], cvg[8];
#pragma unroll
    for (int it_ = 0; it_ < 8; ++it_) { const int idx = tid + it_ * NTHR; const int rr = idx >> 6, c8 = idx & 63, row = t0 - 15 + rr; cva[it_] = (v4u){0u, 0u, 0u, 0u}; cvg[it_] = cva[it_];
        if (idx < 62 * 64 && row >= seg_lo && row < seg_hi) { cva[it_] = *(const v4u*)(U + (size_t)row * NU + UCONV + c8 * 8); cvg[it_] = *(const v4u*)(U + (size_t)row * NU + UCONV + 512 + c8 * 8); } }
#pragma unroll
    for (int it_ = 0; it_ < 8; ++it_) { const int idx = tid + it_ * NTHR; if (idx >= 62 * 64) break; const int rr = idx >> 6, c8 = idx & 63, row = t0 - 15 + rr;
        v4u o = (v4u){0u, 0u, 0u, 0u};
        if (row >= seg_lo && row < seg_hi) { const v4u va = cva[it_], vg = cvg[it_];
            o.x = pk2(bflo(va.x) * sigmoidf_(bflo(vg.x)), bfhi(va.x) * sigmoidf_(bfhi(vg.x))); o.y = pk2(bflo(va.y) * sigmoidf_(bflo(vg.y)), bfhi(va.y) * sigmoidf_(bfhi(vg.y)));
            o.z = pk2(bflo(va.z) * sigmoidf_(bflo(vg.z)), bfhi(va.z) * sigmoidf_(bfhi(vg.z))); o.w = pk2(bflo(va.w) * sigmoidf_(bflo(vg.w)), bfhi(va.w) * sigmoidf_(bfhi(vg.w))); }
        *(LAS v4u*)(inimg + rr * 512 + c8 * 8) = o; }
    __syncthreads();
    {
        const int cp = tid & 255, th = tid >> 8;
        f32x2 w[31];
#pragma unroll
        for (int j = 0; j < 31; ++j) w[j] = *(const f32x2*)(a->in[I_CONVW] + (size_t)(l * 31 + j) * 512 + 2 * cp);
        const f32x2 bias = *(const f32x2*)(a->in[I_CONVB] + l * 512 + 2 * cp);
        f32x2 o[16];
#pragma unroll
        for (int q = 0; q < 16; ++q) o[q] = bias;
        const LAS unsigned* ip = (const LAS unsigned*)(inimg + (16 * th) * 512 + 2 * cp);
#pragma unroll
        for (int r = 0; r < 46; ++r) { const unsigned u = ip[r * 256]; const f32x2 v = (f32x2){bflo(u), bfhi(u)};
#pragma unroll
            for (int q = 0; q < 16; ++q) if (r - q >= 0 && r - q < 31) o[q] += w[r - q] * v; }
#pragma unroll
        for (int q = 0; q < 16; ++q) *(LAS f32x2*)(outimg + (16 * th + q) * 512 + 2 * cp) = o[q];
    }
    __syncthreads();
    {
        const f32x4 g0 = *(const f32x4*)(a->in[I_CLNG] + l * 512 + 8 * lane), g1 = *(const f32x4*)(a->in[I_CLNG] + l * 512 + 8 * lane + 4);
        const f32x4 b0 = *(const f32x4*)(a->in[I_CLNB] + l * 512 + 8 * lane), b1 = *(const f32x4*)(a->in[I_CLNB] + l * 512 + 8 * lane + 4);
#pragma unroll
        for (int q = 0; q < 4; ++q) { const int o = wave * 4 + q;
            f32x4 x0 = *(const LAS f32x4*)(outimg + o * 512 + 8 * lane), x1 = *(const LAS f32x4*)(outimg + o * 512 + 8 * lane + 4);
            const float mean = wave_sum((x0.x + x0.y + x0.z + x0.w) + (x1.x + x1.y + x1.z + x1.w)) * (1.f / 512.f);
            x0 = x0 - mean; x1 = x1 - mean;
            const float var = wave_sum((x0.x * x0.x + x0.y * x0.y + x0.z * x0.z + x0.w * x0.w) + (x1.x * x1.x + x1.y * x1.y + x1.z * x1.z + x1.w * x1.w)) * (1.f / 512.f);
            const float rs = rsqrtf(var + 1e-5f);
            x0 = x0 * rs * g0 + b0; x1 = x1 * rs * g1 + b1;
            v4u ov; ov.x = pk2(siluf_(x0.x), siluf_(x0.y)); ov.y = pk2(siluf_(x0.z), siluf_(x0.w)); ov.z = pk2(siluf_(x1.x), siluf_(x1.y)); ov.w = pk2(siluf_(x1.z), siluf_(x1.w));
            *(v4u*)(AC + (size_t)(t0 + o) * ACW + 8 * lane) = ov; }
    }
    __syncthreads();
}

__device__ __forceinline__ int ssd_tok(int b, int dir, int pos) {
    if (pos < LCTX) return TLAT + b * LCTX + (dir ? (LCTX - 1 - pos) : pos);
    const int q = pos - LCTX; return b * LSEQ + (dir ? (LSEQ - 1 - q) : q);
}
__device__ __forceinline__ void post_phase(KArgs a, int l, int bid, int G, const int wave0) {
    PH_IDS
    unsigned char* ws = a->ws; const int gw = bid * NWAVES + wave, NGW = G * NWAVES;
    const bf16* U = (const bf16*)(ws + OFF_U); const bf16* XBC = (const bf16*)(ws + OFF_XBC);
    const float* Y0 = (const float*)(ws + OFF_YSSD); const float* Y1 = Y0 + (size_t)TT * 768; bf16* AS_ = (bf16*)(ws + OFF_ACAT) + AC_SSD;
    {
        f32x4 nyf[3], nyb[3]; v2u nxs[3], nz[3];
        auto fetch = [&](int row) {
#pragma unroll
            for (int j = 0; j < 3; ++j) { const int col = 4 * lane + 256 * j;
                nyf[j] = *(const f32x4*)(Y0 + (size_t)row * 768 + col); nyb[j] = *(const f32x4*)(Y1 + (size_t)row * 768 + col);
                nxs[j] = *(const v2u*)(XBC + (size_t)row * 1792 + col); nz[j] = *(const v2u*)(U + (size_t)row * NU + UZ + col); } };
        f32x4 gn[3]; float dsk[3];
#pragma unroll
        for (int j = 0; j < 3; ++j) { const int col = 4 * lane + 256 * j; gn[j] = *(const f32x4*)(a->in[I_SNG] + l * 768 + col); dsk[j] = a->in[I_SD][l * 12 + (col >> 6)]; }
        if (gw < TT) fetch(gw);
        for (int row = gw; row < TT; row += NGW) {
            f32x4 y[3]; float ss = 0.f;
#pragma unroll
            for (int j = 0; j < 3; ++j) { const v2u xs = nxs[j], z = nz[j];
                f32x4 v = nyf[j] + nyb[j] + dsk[j] * (f32x4){bflo(xs.x), bfhi(xs.x), bflo(xs.y), bfhi(xs.y)};
                v = v * (f32x4){siluf_(bflo(z.x)), siluf_(bfhi(z.x)), siluf_(bflo(z.y)), siluf_(bfhi(z.y))};
                y[j] = v; ss += (v.x * v.x + v.y * v.y) + (v.z * v.z + v.w * v.w); }
            if (row + NGW < TT) fetch(row + NGW);
            const float r = rsqrtf(wave_sum(ss) * (1.f / 768.f) + 1e-6f);
#pragma unroll
            for (int j = 0; j < 3; ++j) { const int col = 4 * lane + 256 * j; const f32x4 o = y[j] * r * gn[j];
                *(v2u*)(AS_ + (size_t)row * ACW + col) = (v2u){pk2(o.x, o.y), pk2(o.z, o.w)}; }
        }
    }
    const float* RW = (const float*)(ws + OFF_RW); constexpr size_t AS = RW_ARR / 4; const float* RSC = (const float*)(ws + OFF_RSC);
    const float* R0 = (const float*)(ws + OFF_YRW); const float* R1 = R0 + (size_t)TT * 512; bf16* AR = (bf16*)(ws + OFF_ACAT) + AC_RWKV;
    {
        const int c0 = 8 * lane, h = lane >> 3;
        const f32x4 lg0 = *(const f32x4*)(a->in[I_RLNG] + l * 512 + c0), lg1 = *(const f32x4*)(a->in[I_RLNG] + l * 512 + c0 + 4), lb0 = *(const f32x4*)(a->in[I_RLNB] + l * 512 + c0), lb1 = *(const f32x4*)(a->in[I_RLNB] + l * 512 + c0 + 4);
        f32x4 n0a, n0b, n1a, n1b, nv0, nv1, ng0, ng1; float nbon = 0.f;
        auto rowR = [&](int row) -> size_t { if (row < TLAT) { const int b = row >> 11, t = row & 2047, rr = t >> 6, cc = t & 63; return (size_t)b * RJ + LCTX + cc * 32 + rr; }
            const int b = (row - TLAT) >> 8, jj = (row - TLAT) & 255; return (size_t)b * RJ + jj; };
        auto fetch = [&](int row) { const size_t R = rowR(row);
            n0a = *(const f32x4*)(R0 + R * 512 + c0); n0b = *(const f32x4*)(R0 + R * 512 + c0 + 4); n1a = *(const f32x4*)(R1 + R * 512 + c0); n1b = *(const f32x4*)(R1 + R * 512 + c0 + 4);
            nv0 = *(const f32x4*)(RW + 7 * AS + R * 512 + c0); nv1 = *(const f32x4*)(RW + 7 * AS + R * 512 + c0 + 4); ng0 = *(const f32x4*)(RW + 8 * AS + R * 512 + c0); ng1 = *(const f32x4*)(RW + 8 * AS + R * 512 + c0 + 4);
            nbon = RSC[(size_t)2 * TT * 8 + R * 8 + h]; };
        if (gw < TT) fetch(gw);
        for (int row = gw; row < TT; row += NGW) {
            f32x4 ya = n0a + n1a, yb = n0b + n1b; const f32x4 v0 = nv0, v1 = nv1, g0 = ng0, g1 = ng1; const float bon = nbon;
            if (row + NGW < TT) fetch(row + NGW);
            float s = (ya.x + ya.y + ya.z + ya.w) + (yb.x + yb.y + yb.z + yb.w);
            s = sum8(s);
            const float mean = s * (1.f / 64.f); ya = ya - mean; yb = yb - mean;
            float q = (ya.x * ya.x + ya.y * ya.y + ya.z * ya.z + ya.w * ya.w) + (yb.x * yb.x + yb.y * yb.y + yb.z * yb.z + yb.w * yb.w);
            q = sum8(q);
            const float rs = rsqrtf(q * (1.f / 64.f) + 64e-5f);
            const f32x4 o0 = (ya * rs * lg0 + lb0 + bon * v0) * g0, o1 = (yb * rs * lg1 + lb1 + bon * v1) * g1;
            *(v4u*)(AR + (size_t)row * ACW + c0) = (v4u){pk2(o0.x, o0.y), pk2(o0.z, o0.w), pk2(o1.x, o1.y), pk2(o1.z, o1.w)};
        }
    }
}

__device__ __forceinline__ size_t rwkv_row(int b, int dir, int pos) { const int j = dir ? (pos < LCTX ? (LCTX - 1 - pos) : (RJ + LCTX - 1 - pos)) : pos; return (size_t)b * RJ + j; }
struct RchOps { v2u nt[4], rt[4], kst, tt, art, krt, vm, apt[4], kpt[4]; f32x4 gc[4]; };
__device__ __forceinline__ void rwkv_scan_chunk(KArgs a, int idx, LAS unsigned char* lds, int tid, int lane, int wave) {
    typedef short bf16x4 __attribute__((ext_vector_type(4)));
    unsigned char* ws = a->ws;
    const int b = idx >> 4, dir = (idx >> 3) & 1, h = idx & 7, fr = lane & 15, fq = lane >> 4;
    float* Yo = (float*)(ws + OFF_YRW) + (size_t)dir * TT * 512;
    const unsigned char* base = ws + OFF_RCH + (size_t)((b * 2 + dir) * 8 + h) * 144 * RCH_BYTES;
    constexpr int BLK = 4 * RCH_BYTES;
    const int lt = tid - 256;
    v4u pre[13];
    auto issue = [&](int blk) { const v4u* src = (const v4u*)(base + (size_t)blk * BLK);
#pragma unroll
        for (int i = 0; i < 13; ++i) { const int e = lt + i * 256; if (e < BLK / 16) pre[i] = src[e]; } };
    auto commit = [&](int buf) { LAS v4u* dst = (LAS v4u*)(lds + buf * BLK);
#pragma unroll
        for (int i = 0; i < 13; ++i) { const int e = lt + i * 256; if (e < BLK / 16) dst[e] = pre[i]; } };
    auto ld = [&](const LAS unsigned char* p0, int wv) { RchOps o; const LAS unsigned char* p = p0 + lane * 8;
#pragma unroll
        for (int kt = 0; kt < 4; ++kt) { o.nt[kt] = *(const LAS v2u*)(p + RCH_NT + kt * 512); o.rt[kt] = *(const LAS v2u*)(p + RCH_RT + kt * 512); o.apt[kt] = *(const LAS v2u*)(p + RCH_APT + kt * 512); o.kpt[kt] = *(const LAS v2u*)(p + RCH_KPT + kt * 512);
            o.gc[kt] = *(const LAS f32x4*)(p0 + RCH_GC + (16 * kt + 4 * fq) * 4); }
        o.kst = *(const LAS v2u*)(p + RCH_KST); o.tt = *(const LAS v2u*)(p + RCH_TT); o.art = *(const LAS v2u*)(p + RCH_ART); o.krt = *(const LAS v2u*)(p + RCH_KRT); o.vm = *(const LAS v2u*)(p + RCH_VM + wv * 512); return o; };
#define MF16(A_, B_, C_) __builtin_amdgcn_mfma_f32_16x16x16bf16_1k(__builtin_bit_cast(bf16x4, A_), __builtin_bit_cast(bf16x4, B_), C_, 0, 0, 0)
    f32x4 S[4];
#pragma unroll
    for (int kt = 0; kt < 4; ++kt) S[kt] = (f32x4){0.f, 0.f, 0.f, 0.f};
    auto step = [&](const RchOps& cur, int c) {
        v2u Sb[4];
#pragma unroll
        for (int kt = 0; kt < 4; ++kt) Sb[kt] = (v2u){pk2(S[kt][0], S[kt][1]), pk2(S[kt][2], S[kt][3])};
        f32x4 rhs = (f32x4){0.f, 0.f, 0.f, 0.f}, y = rhs;
#pragma unroll
        for (int kt = 0; kt < 4; ++kt) rhs = MF16(cur.nt[kt], Sb[kt], rhs);
        rhs = MF16(cur.kst, cur.vm, rhs);
        const v2u rb = (v2u){pk2(rhs[0], rhs[1]), pk2(rhs[2], rhs[3])};
        const f32x4 u = MF16(cur.tt, rb, ((f32x4){0.f, 0.f, 0.f, 0.f}));
        const v2u ub = (v2u){pk2(u[0], u[1]), pk2(u[2], u[3])};
#pragma unroll
        for (int kt = 0; kt < 4; ++kt) { S[kt] = S[kt] * cur.gc[kt]; S[kt] = MF16(cur.apt[kt], ub, S[kt]); S[kt] = MF16(cur.kpt[kt], cur.vm, S[kt]); }
#pragma unroll
        for (int kt = 0; kt < 4; ++kt) y = MF16(cur.rt[kt], Sb[kt], y);
        y = MF16(cur.art, ub, y); y = MF16(cur.krt, cur.vm, y);
#pragma unroll
        for (int j = 0; j < 4; ++j) { const size_t R = rwkv_row(b, dir, c * 16 + 4 * fq + j); Yo[R * 512 + h * 64 + 16 * wave + fr] = y[j]; }
    };
    if (wave >= 4) { issue(0); commit(0); }
    __syncthreads();
    for (int blk = 0; blk < 36; ++blk) {
        if (wave >= 4) { if (blk + 1 < 36) issue(blk + 1); }
        else { const LAS unsigned char* B = lds + (blk & 1) * BLK;
            RchOps o0 = ld(B, wave), o1 = ld(B + RCH_BYTES, wave);
            step(o0, blk * 4 + 0); o0 = ld(B + 2 * RCH_BYTES, wave);
            step(o1, blk * 4 + 1); o1 = ld(B + 3 * RCH_BYTES, wave);
            step(o0, blk * 4 + 2);
            step(o1, blk * 4 + 3); }
        if (wave >= 4 && blk + 1 < 36) commit((blk + 1) & 1);
        __syncthreads();
    }
#undef MF16
}

constexpr int SS_CM = 0, SS_BM = 17408, SS_BST = 34816, SS_XT = 53248, SS_MX = 62464, SS_HB = 71680, SS_CS = 89088, SS_DT = 89344;
__device__ __forceinline__ float bfe(const v4u& v, int i) { const unsigned u = (i < 2) ? v.x : (i < 4) ? v.y : (i < 6) ? v.z : v.w; return (i & 1) ? bfhi(u) : bflo(u); }
__device__ __forceinline__ unsigned short bfraw(const v4u& v, int i) { const unsigned u = (i < 2) ? v.x : (i < 4) ? v.y : (i < 6) ? v.z : v.w; return (unsigned short)((i & 1) ? (u >> 16) : (u & 0xffffu)); }
__device__ __forceinline__ void ssd_scan_fast(KArgs a, int idx, LAS unsigned char* lds, int tid, int lane, int wave) {
    unsigned char* ws = a->ws; const bf16* XBC = (const bf16*)(ws + OFF_XBC); const float* DTA = (const float*)(ws + OFF_DTA);
    const int b = idx / 24, dir = (idx % 24) / 12, h = idx % 12, g = h / 3, q = dir * 12 + h;
    float* Yo = (float*)(ws + OFF_YSSD) + (size_t)dir * TT * 768;
    LAS bf16* Cm = (LAS bf16*)(lds + SS_CM); LAS bf16* Bm = (LAS bf16*)(lds + SS_BM); LAS bf16* BsT = (LAS bf16*)(lds + SS_BST); LAS bf16* XT = (LAS bf16*)(lds + SS_XT);
    LAS bf16* Mx = (LAS bf16*)(lds + SS_MX); LAS bf16* Hb = (LAS bf16*)(lds + SS_HB); LAS float* CS = (LAS float*)(lds + SS_CS); LAS float* DTV = (LAS float*)(lds + SS_DT);
    const int fr = lane & 15, fq = lane >> 4, ss = tid & 63, sc = tid >> 6, tl = wave >> 1, wh = wave & 1;
    { unsigned z = 0u; asm volatile("" : "+v"(z)); for (int i = tid; i < 17408 / 16; i += NTHR) *(LAS v4u*)(lds + SS_HB + i * 16) = (v4u){z, z, z, z}; }
    f32x4 hacc[4];
#pragma unroll
    for (int j = 0; j < 4; ++j) hacc[j] = (f32x4){0.f, 0.f, 0.f, 0.f};
    v4u pc0, pc1, pb0, pb1, px; float pdt = 0.f, pa = 0.f;
    auto issue = [&](int ch) {
        const int tok = ssd_tok(b, dir, ch * 64 + ss); const bf16* row = XBC + (size_t)tok * 1792;
        pc0 = *(const v4u*)(row + 1280 + g * 128 + sc * 8); pc1 = *(const v4u*)(row + 1280 + g * 128 + (sc + 8) * 8);
        pb0 = *(const v4u*)(row + 768 + g * 128 + sc * 8); pb1 = *(const v4u*)(row + 768 + g * 128 + (sc + 8) * 8);
        px = *(const v4u*)(row + h * 64 + sc * 8);
        if (tid < 64) { pdt = DTA[(size_t)tok * 48 + q]; pa = DTA[(size_t)tok * 48 + 24 + q]; }
    };
    issue(0);
    for (int ch = 0; ch < RJ / 64; ++ch) {
        *(LAS v4u*)(Cm + ss * 136 + sc * 8) = pc0; *(LAS v4u*)(Cm + ss * 136 + (sc + 8) * 8) = pc1;
        *(LAS v4u*)(Bm + ss * 136 + sc * 8) = pb0; *(LAS v4u*)(Bm + ss * 136 + (sc + 8) * 8) = pb1;
#pragma unroll
        for (int i = 0; i < 8; ++i) XT[(sc * 8 + i) * 72 + ss] = bfraw(px, i);
        if (tid < 64) { float x = pa;
            x += __int_as_float(__builtin_amdgcn_update_dpp(0, __float_as_int(x), 0x111, 0xf, 0xf, false)); x += __int_as_float(__builtin_amdgcn_update_dpp(0, __float_as_int(x), 0x112, 0xf, 0xf, false));
            x += __int_as_float(__builtin_amdgcn_update_dpp(0, __float_as_int(x), 0x114, 0xf, 0xf, false)); x += __int_as_float(__builtin_amdgcn_update_dpp(0, __float_as_int(x), 0x118, 0xf, 0xf, false));
            x += __int_as_float(__builtin_amdgcn_update_dpp(0, __float_as_int(x), 0x142, 0xa, 0xf, false)); x += __int_as_float(__builtin_amdgcn_update_dpp(0, __float_as_int(x), 0x143, 0xc, 0xf, false));
            CS[tid] = x; DTV[tid] = pdt; }
        __syncthreads();
        const float cl = CS[63];
        { const float scl = DTV[ss] * __expf(cl - CS[ss]);
#pragma unroll
            for (int i = 0; i < 8; ++i) { BsT[(sc * 8 + i) * 72 + ss] = bf1(bfe(pb0, i) * scl); BsT[((sc + 8) * 8 + i) * 72 + ss] = bf1(bfe(pb1, i) * scl); } }
        if (ch + 1 < RJ / 64) issue(ch + 1);
        bf16x8 cf[4];
#pragma unroll
        for (int ks = 0; ks < 4; ++ks) cf[ks] = *(const LAS bf16x8*)(Cm + (16 * tl + fr) * 136 + ks * 32 + fq * 8);
#pragma unroll
        for (int j = 0; j < 2; ++j) { const int tc = wh * 2 + j; f32x4 acc = (f32x4){0.f, 0.f, 0.f, 0.f};
            if (tc <= tl) {
#pragma unroll
                for (int ks = 0; ks < 4; ++ks) { const bf16x8 bf = *(const LAS bf16x8*)(Bm + (16 * tc + fr) * 136 + ks * 32 + fq * 8);
                    acc = __builtin_amdgcn_mfma_f32_16x16x32_bf16(cf[ks], bf, acc, 0, 0, 0); } }
            const int s = 16 * tc + fr; const float css = CS[s], dts = DTV[s];
#pragma unroll
            for (int i = 0; i < 4; ++i) { const int l = 16 * tl + 4 * fq + i; const float v = (s <= l) ? acc[i] * __expf(CS[l] - css) * dts : 0.f; Mx[l * 72 + s] = bf1(v); } }
        __syncthreads();
        bf16x8 mf[2], xf[2];
#pragma unroll
        for (int ks = 0; ks < 2; ++ks) { mf[ks] = *(const LAS bf16x8*)(Mx + (16 * tl + fr) * 72 + ks * 32 + fq * 8); xf[ks] = *(const LAS bf16x8*)(XT + (16 * tl + fr) * 72 + ks * 32 + fq * 8); }
#pragma unroll
        for (int j = 0; j < 2; ++j) { const int tp = wh * 2 + j; f32x4 acc = (f32x4){0.f, 0.f, 0.f, 0.f};
#pragma unroll
            for (int ks = 0; ks < 4; ++ks) { const bf16x8 bf = *(const LAS bf16x8*)(Hb + (16 * tp + fr) * 136 + ks * 32 + fq * 8);
                acc = __builtin_amdgcn_mfma_f32_16x16x32_bf16(cf[ks], bf, acc, 0, 0, 0); }
#pragma unroll
            for (int i = 0; i < 4; ++i) acc[i] *= __expf(CS[16 * tl + 4 * fq + i]);
#pragma unroll
            for (int ks = 0; ks < 2; ++ks) { const bf16x8 bf = *(const LAS bf16x8*)(XT + (16 * tp + fr) * 72 + ks * 32 + fq * 8);
                acc = __builtin_amdgcn_mfma_f32_16x16x32_bf16(mf[ks], bf, acc, 0, 0, 0); }
#pragma unroll
            for (int i = 0; i < 4; ++i) { const int tok = ssd_tok(b, dir, ch * 64 + 16 * tl + 4 * fq + i); Yo[(size_t)tok * 768 + h * 64 + 16 * tp + fr] = acc[i]; } }
        { const float ecl = __expf(cl);
#pragma unroll
            for (int j = 0; j < 4; ++j) { const int tn = wh * 4 + j; hacc[j] = hacc[j] * ecl;
#pragma unroll
                for (int ks = 0; ks < 2; ++ks) { const bf16x8 bf = *(const LAS bf16x8*)(BsT + (16 * tn + fr) * 72 + ks * 32 + fq * 8);
                    hacc[j] = __builtin_amdgcn_mfma_f32_16x16x32_bf16(xf[ks], bf, hacc[j], 0, 0, 0); } } }
        __syncthreads();
#pragma unroll
        for (int j = 0; j < 4; ++j) { const int tn = wh * 4 + j;
#pragma unroll
            for (int i = 0; i < 4; ++i) Hb[(16 * tl + 4 * fq + i) * 136 + 16 * tn + fr] = bf1(hacc[j][i]); }
    }
}

constexpr int NPH = 2 + 10 * DEPTH;
#ifndef PROBE_MASK
#define PROBE_MASK 0
#endif
#ifndef PROBE_P0
#define PROBE_P0 0
#endif
#ifndef PROBE_SUB
#define PROBE_SUB 0
#endif
#ifndef PROBE_REPS
#define PROBE_REPS 3
#endif
#define REPS(k) (((PROBE_MASK >> (k)) & 1) ? PROBE_REPS : 1)
constexpr int GATE_LATE = 23;
constexpr int GATE_X = 288, GATE_Z = 192, GATE_STATIC = 576;
constexpr int CW_GQ = 16384;
#ifndef MK_ONE_LAUNCH
#define MK_ONE_LAUNCH 1
#endif

__global__ void __launch_bounds__(NTHR, 2) fwd(Args a_unused) {
    extern __shared__ __attribute__((aligned(16))) unsigned char lds_raw[];
    LAS unsigned char* lds = (LAS unsigned char*)lds_raw;
    const int bid0 = blockIdx.x, G0 = gridDim.x, wave0 = __builtin_amdgcn_readfirstlane(threadIdx.x >> 6);
#define PH_BG int bid = bid0, G = G0; asm volatile("" : "+s"(bid), "+s"(G));
    volatile LAS unsigned* MISCW = (volatile LAS unsigned*)(lds + MISC_OFF);
    if (threadIdx.x < 32) MISCW[threadIdx.x] = 0u;
    __syncthreads();
    const int ph_lo = kargs()->ph_lo, ph_hi = kargs()->ph_hi;
    const bool multi = (ph_hi - ph_lo) > 1;
    XcdBarrier bar; bar.bar = (unsigned*)(kargs()->ws + OFF_CTL) + CW_BAR; bar.x = 0; bar.st = nullptr; bar.wv = wave0;
    if (multi) bar = xcd_barrier_post((unsigned*)(kargs()->ws + OFF_CTL) + CW_BAR, MISCW + 8, wave0);
#define IN(k) (ph_lo <= (k) && (k) < ph_hi)
#define SEAM(k) do { if (IN(k) && IN((k) + 1)) xcd_barrier(bar); } while (0)

    for (int rep = 0; rep < (PROBE_P0 ? PROBE_REPS : 1); ++rep) {
    if (IN(0)) { PH_BG p0_prologue(kargs(), lds, bid, G, wave0, rep == 0 ? 15 : PROBE_SUB); }
    if (rep + 1 < (PROBE_P0 ? PROBE_REPS : 1)) xcd_barrier(bar); }
    SEAM(0);
    if (IN(1)) { PH_BG KArgs a = kargs(); norm_phase(a, 0, nullptr, a->in[I_NORMG] + 0, nullptr, (const float*)(a->ws + OFF_MODV), bid, G, wave0, TT, false, false, true); }
    SEAM(1);

    for (int l = 0; l < DEPTH; ++l) {
        const int pb = 2 + 10 * l;
#define PH_LOCALS PH_BG KArgs a = kargs(); unsigned char* ws = a->ws; unsigned char* wl = ws + OFF_W + (size_t)l * W_LAYER; bf16* Hb = (bf16*)(ws + OFF_H); (void)wl; (void)Hb; \
        const float* ng = a->in[I_NORMG] + (size_t)l * 4 * DM; const float* mv = (const float*)(ws + OFF_MODV) + (size_t)l * 5 * 12288; (void)ng; (void)mv;
        const bool lastl = (l == DEPTH - 1);
        for (int rep = 0; rep < REPS(0); ++rep) {
        if (IN(pb + 0)) { PH_LOCALS
            __syncthreads();
            pg8::Sched2 S; S.A0 = (const char*)Hb; S.B0 = (const char*)(wl + WO_IN); S.A1 = (const char*)(wl + WO_FFT); S.B1 = (const char*)Hb; S.tstep = (size_t)256 * DM * 2; S.ntk = DM / 64;
            S.t0.init(TT / 256, NU / 256 - GATE_LATE); S.t1.init(4, TT / 256); S.G = G; S.c = bid; S.spread = 1;
            pg8::EpiIn2 E{pg8::EpiInproj{(bf16*)(ws + OFF_U), (float*)(ws + OFF_MISC), NU}, pg8::EpiBf{0, (bf16*)(ws + OFF_VTL), (bf16*)(ws + OFF_VTC)}};
            pg8::gemm_phase<pg8::EpiIn2, pg8::Sched2, true, true>(lds, DM, S, E, wave0);
        }
        if (rep + 1 < REPS(0)) xcd_barrier(bar); }
        SEAM(pb + 0);
        for (int rep = 0; rep < REPS(1); ++rep) {
        if (IN(pb + 1)) { PH_LOCALS PH_IDS
            __syncthreads();
            if (rep == 0 || PROBE_SUB == 3 || PROBE_SUB == 7) {
            if (bid < 64) { pg8::Sched2 S; S.A0 = (const char*)(ws + OFF_DFTL); S.B0 = (const char*)(ws + OFF_VTL); S.A1 = S.A0; S.B1 = S.B0; S.tstep = (size_t)256 * 4096 * 2; S.ntk = 64; S.t0.init(8, 8); S.t1.init(0, 0); S.G = 64; S.c = bid;
                  pg8::EpiBf E{1, (bf16*)(ws + OFF_ACAT), nullptr};
                  pg8::gemm_phase<pg8::EpiBf, pg8::Sched2, true, true>(lds, 4096, S, E, wave0); }
            else if (bid < 72) { pg8::Sched2 S; S.A0 = (const char*)(ws + OFF_DFTC); S.B0 = (const char*)(ws + OFF_VTC); S.A1 = S.A0; S.B1 = S.B0; S.tstep = (size_t)256 * 512 * 2; S.ntk = 8; S.t0.init(1, 8); S.t1.init(0, 0); S.G = 8; S.c = bid - 64;
                  pg8::EpiBf E{2, (bf16*)(ws + OFF_ACAT), nullptr};
                  pg8::gemm_phase<pg8::EpiBf, pg8::Sched2, true, true>(lds, 512, S, E, wave0); }
            else if (bid < 72 + 4 * GATE_LATE && !lastl) {
                pg8::Sched2 S; S.A0 = (const char*)Hb; S.B0 = (const char*)(wl + WO_IN); S.A1 = S.A0; S.B1 = S.B0; S.tstep = (size_t)256 * DM * 2; S.ntk = DM / 64;
                S.t0.init(TCTX / 256, GATE_LATE); S.t1.init(0, 0); S.pm_off0 = TLAT / 256; S.pn_off0 = NU / 256 - GATE_LATE; S.G = 4 * GATE_LATE; S.c = bid - 72;
                pg8::EpiIn2 E{pg8::EpiInproj{(bf16*)(ws + OFF_U), (float*)(ws + OFF_MISC), NU}, pg8::EpiBf{0, (bf16*)(ws + OFF_VTL), (bf16*)(ws + OFF_VTC)}};
                pg8::gemm_phase<pg8::EpiIn2, pg8::Sched2, true, true>(lds, DM, S, E, wave0); }
            }
            __syncthreads();
            {
                unsigned* qctr = (unsigned*)(ws + OFF_CTL) + CW_Q + (l * 4 + rep) * 64;
                volatile LAS unsigned* qslot = (volatile LAS unsigned*)(lds + MISC_OFF) + 16;
                unsigned qnext = 0u; if (tid == 0) qnext = __hip_atomic_fetch_add(qctr, 1u, __ATOMIC_RELAXED, __HIP_MEMORY_SCOPE_AGENT);
                for (;;) {
                    if (tid == 0) qslot[0] = qnext;
                    __syncthreads();
                    const int it = (int)qslot[0];
                    __syncthreads();
                    if (it >= 576 + 288 + 576) break;
                    if (tid == 0) qnext = __hip_atomic_fetch_add(qctr, 1u, __ATOMIC_RELAXED, __HIP_MEMORY_SCOPE_AGENT);
                    int ln_i = lane; asm volatile("" : "+v"(ln_i)); const int tid_i = wave * 64 + ln_i;
                    const bool pall = (rep == 0 || PROBE_SUB == 7);
                    if (it < 576) { if (pall || PROBE_SUB == 0) rwkv_prep_item(a, l, it, lds, tid_i, ln_i, wave); }
                    else if (it < 576 + 288) { if (pall || PROBE_SUB == 2) conv_item(a, l, it - 576, lds, tid_i, ln_i, wave); }
                    else if (pall || PROBE_SUB == 1) ssd_prep_item(a, l, it - 576 - 288, tid_i);
                }
            }
        }
        if (rep + 1 < REPS(1)) xcd_barrier(bar); }
        SEAM(pb + 1);
        for (int rep = 0; rep < REPS(2); ++rep) {
        if (IN(pb + 2)) { PH_LOCALS PH_IDS
            __syncthreads();
            if (bid < 64) { if (rep == 0 || PROBE_SUB == 0 || PROBE_SUB == 7) rwkv_scan_chunk(a, bid, lds, tid, lane, wave); }
            else if (bid < 160) { if (rep == 0 || PROBE_SUB == 1 || PROBE_SUB == 7) ssd_scan_fast(a, bid - 64, lds, tid, lane, wave); }
            __syncthreads();
            if (rep == 0 || PROBE_SUB == 2 || PROBE_SUB == 7) {
                pg8::Sched2 S; S.A0 = (const char*)Hb; S.B0 = (const char*)(wl + WO_IN); S.A1 = S.A0; S.B1 = S.B0; S.tstep = (size_t)256 * DM * 2; S.ntk = DM / 64;
                const int gpan = TLAT / 256;
                S.t0.init(gpan, GATE_LATE); S.t1.init(0, 0); S.pn_off0 = NU / 256 - GATE_LATE;
                if (bid >= 160) { S.G = 96; S.c = bid - 160; S.first = 0; S.limit = GATE_X; }
                else if (bid < 64) { S.G = 64; S.c = bid; S.first = GATE_X; S.limit = GATE_X + GATE_Z; }
                else { S.G = 96; S.c = bid - 64; S.first = GATE_X + GATE_Z; S.limit = GATE_STATIC; }
                pg8::EpiIn2 E{pg8::EpiInproj{(bf16*)(ws + OFF_U), (float*)(ws + OFF_MISC), NU}, pg8::EpiBf{0, (bf16*)(ws + OFF_VTL), (bf16*)(ws + OFF_VTC)}};
                pg8::gemm_phase<pg8::EpiIn2, pg8::Sched2, true, true>(lds, DM, S, E, wave0);
                unsigned* gq = (unsigned*)(ws + OFF_CTL) + CW_GQ + ((l * 4 + rep) * 8) * 64;
                volatile LAS unsigned* gslot = (volatile LAS unsigned*)(lds + MISC_OFF) + 20;
                int qx = bid & 7, qtries = 0;
                for (;;) {
                    __syncthreads();
                    if (tid == 0) gslot[0] = __hip_atomic_fetch_add(gq + qx * 64, 1u, __ATOMIC_RELAXED, __HIP_MEMORY_SCOPE_AGENT);
                    __syncthreads();
                    const int gu = GATE_STATIC + 8 * (int)gslot[0] + qx;
                    if (gu >= gpan * GATE_LATE) { if (++qtries >= 8) break; qx = (qx + 1) & 7; continue; }
                    S.G = 1; S.c = 0; S.first = gu; S.limit = gu + 1;
                    pg8::gemm_phase<pg8::EpiIn2, pg8::Sched2, true, true>(lds, DM, S, E, wave0);
                } }
        }
        if (rep + 1 < REPS(2)) xcd_barrier(bar); }
        SEAM(pb + 2);
        for (int rep = 0; rep < REPS(3); ++rep) {
        if (IN(pb + 3)) { PH_BG post_phase(kargs(), l, bid, G, wave0); }
        if (rep + 1 < REPS(3)) xcd_barrier(bar); }
        SEAM(pb + 3);
        for (int rep = 0; rep < REPS(4); ++rep) {
        if (IN(pb + 4)) { PH_LOCALS
            __syncthreads();
            pg8::Sched2 S; S.A0 = (const char*)(ws + OFF_ACAT); S.B0 = (const char*)(wl + WO_CAT); S.A1 = S.A0; S.B1 = S.B0; S.tstep = (size_t)256 * ACW * 2; S.ntk = ACW / 64;
            S.t0.init(TLAT / 256, DM / 256); S.t1.init(0, 0); S.G = G; S.c = bid;
            pg8::EpiChain E{(const bf16*)(ws + OFF_U) + UGATE, NU, (bf16*)(ws + OFF_M)};
            pg8::gemm_phase<pg8::EpiChain, pg8::Sched2, true, true>(lds, ACW, S, E, wave0);
            if (!lastl) {
                pg8::SchedCB C; C.A = (const char*)(ws + OFF_ACAT); C.B = (const char*)(wl + WO_CAT); C.tstep = (size_t)256 * ACW * 2; C.G = G; C.c = bid;
                pg8::EpiGateSlab Eg{(const bf16*)(ws + OFF_U) + UGATE, NU, (bf16*)(ws + OFF_SCAT)};
                pg8::gemm_phase<pg8::EpiGateSlab, pg8::SchedCB, true, true>(lds, ACW, C, Eg, wave0); }
        }
        if (rep + 1 < REPS(4)) xcd_barrier(bar); }
        SEAM(pb + 4);
        for (int rep = 0; rep < REPS(5); ++rep) {
        if (IN(pb + 5)) { PH_LOCALS
            __syncthreads();
            pg8::SchedSplit S; S.A = (const char*)(ws + OFF_M); S.B = (const char*)(wl + WO_O); S.tstep = (size_t)256 * DM * 2; S.ntk = DM / 64; S.tm.init(32, 8); S.nctx = 0; S.G = G; S.c = bid;
            pg8::EpiF32 E{(bf16*)(ws + OFF_Y), (bf16*)(ws + OFF_YC)};
            pg8::gemm_phase<pg8::EpiF32, pg8::SchedSplit, true, true>(lds, DM, S, E, wave0);
            if (!lastl) {
                pg8::SchedCW C; C.A = (const char*)(ws + OFF_SCAT); C.B = (const char*)(wl + WO_O); C.G = G; C.c = bid;
                pg8::gemm_phase<pg8::EpiF32, pg8::SchedCW, true, true>(lds, DM, C, E, wave0); }
        }
        if (rep + 1 < REPS(5)) xcd_barrier(bar); }
        SEAM(pb + 5);
        for (int rep = 0; rep < REPS(6); ++rep) {
        if (IN(pb + 6)) { PH_LOCALS norm_phase(a, 1, ng + 1 * DM, ng + 2 * DM, mv + 2 * DM, mv + 3 * DM, bid, G, wave0, lastl ? TLAT : TT, !lastl, rep > 0, l == 0); }
        if (rep + 1 < REPS(6)) xcd_barrier(bar); }
        SEAM(pb + 6);
        for (int rep = 0; rep < REPS(7); ++rep) {
        if (IN(pb + 7)) { PH_LOCALS
            __syncthreads();
            pg8::Sched2 S; S.A0 = (const char*)Hb; S.B0 = (const char*)(wl + WO_UP); S.A1 = S.A0; S.B1 = S.B0; S.tstep = (size_t)256 * DM * 2; S.ntk = DM / 64;
            S.t0.init(lastl ? TLAT / 256 : TT / 256, DFF / 256); S.t1.init(0, 0); S.G = G; S.c = bid;
            pg8::EpiBf E{3, (bf16*)(ws + OFF_HB), nullptr};
            pg8::gemm_phase<pg8::EpiBf, pg8::Sched2, true, true>(lds, DM, S, E, wave0);
        }
        if (rep + 1 < REPS(7)) xcd_barrier(bar); }
        SEAM(pb + 7);
        for (int rep = 0; rep < REPS(8); ++rep) {
        if (IN(pb + 8)) { PH_LOCALS
            __syncthreads();
            pg8::SchedSplit S; S.A = (const char*)(ws + OFF_HB); S.B = (const char*)(wl + WO_DN); S.tstep = (size_t)256 * DFF * 2; S.ntk = DFF / 64; S.tm.init(32, 8); S.nctx = lastl ? 0 : 256; S.G = G; S.c = bid;
            pg8::EpiF32 E{(bf16*)(ws + OFF_Y), (bf16*)(ws + OFF_YC)};
            pg8::gemm_phase<pg8::EpiF32, pg8::SchedSplit, true, true>(lds, DFF, S, E, wave0);
        }
        if (rep + 1 < REPS(8)) xcd_barrier(bar); }
        SEAM(pb + 8);
        if (IN(pb + 9)) { PH_LOCALS
            if (!lastl) norm_phase(a, 1, ng + 3 * DM, ng + 4 * DM  , mv + 5 * DM, mv + 5 * 12288  , bid, G, wave0, TT, true);
            else norm_phase(a, 2, ng + 3 * DM, nullptr, mv + 5 * DM, nullptr, bid, G, wave0, TLAT);
        }
        SEAM(pb + 9);
    }
#undef IN
#undef SEAM
}

extern "C" void kernel_launch(void* const* d_in, const int* in_sizes, int n_in, void* d_out, int out_size, void* d_ws, size_t ws_size, hipStream_t stream) {
    static int grid = 0;
    if (grid == 0) {
        if (n_in != N_IN || out_size != TLAT * DM || ws_size < WS_END) { fprintf(stderr, "kernel_launch: unexpected shapes (n_in %d out %d ws %zu); nothing launched\n", n_in, out_size, ws_size); grid = -1; return; }
        int dev = 0, cus = 0;
        if (hipGetDevice(&dev) != hipSuccess || hipDeviceGetAttribute(&cus, hipDeviceAttributeMultiprocessorCount, dev) != hipSuccess) { grid = -1; return; }
        if (hipFuncSetAttribute((const void*)fwd, hipFuncAttributeMaxDynamicSharedMemorySize, LDS_BYTES) != hipSuccess) { fprintf(stderr, "kernel_launch: hipFuncSetAttribute failed\n"); grid = -1; return; }
        int per_cu = 0;
        if (hipOccupancyMaxActiveBlocksPerMultiprocessor(&per_cu, (const void*)fwd, NTHR, LDS_BYTES) != hipSuccess || per_cu < 1) fprintf(stderr, "kernel_launch: occupancy query says %d\n", per_cu);
        (void)hipGetLastError();
        grid = cus;
        if (grid != 256) { fprintf(stderr, "kernel_launch: %d CUs: this kernel's phase program is laid out for 256 workgroups (one per CU of an MI355X)\n", grid); grid = -1; return; }
    }
    if (grid < 0) return;
    if (hipMemsetAsync((char*)d_ws + OFF_CTL, 0, CTL_BYTES, stream) != hipSuccess) return;
    Args a{};
    for (int i = 0; i < N_IN; ++i) a.in[i] = (const float*)d_in[i];
    a.out = (float*)d_out; a.ws = (unsigned char*)d_ws;
#if MK_ONE_LAUNCH
    a.ph_lo = 0; a.ph_hi = NPH;
    hipLaunchKernelGGL(fwd, dim3(grid), dim3(NTHR), LDS_BYTES, stream, a);
#else
    for (int p = 0; p < NPH; ++p) { a.ph_lo = p; a.ph_hi = p + 1; hipLaunchKernelGGL(fwd, dim3(grid), dim3(NTHR), LDS_BYTES, stream, a); }
#endif
}
```

```cpp
#include <hip/hip_runtime.h>
#include <cstdio>
#include <cstdint>
namespace pg8 {
#define PG8_LAS __attribute__((address_space(3)))
typedef unsigned short bf16_t;
typedef short bf16x8 __attribute__((ext_vector_type(8)));
typedef float f32x4 __attribute__((ext_vector_type(4)));
typedef unsigned u32x4 __attribute__((ext_vector_type(4)));
constexpr int BM = 256, BK = 64, HALF = 128, HTB = HALF * BK * 2  , STAGE_BYTES = 8 * HTB, NXCD = 8, WGM = 8;

__host__ __device__ __forceinline__ int lds_byte(int r, int c) { const int st = (r >> 4) * 2 + (c >> 5), rr = r & 15, cc = c & 31, ob = rr * 64 + cc * 2; return st * 1024 + (ob ^ (((ob >> 9) & 1) << 5)); }
__host__ __device__ __forceinline__ void stage_rc(int b, int& R, int& C) { const int st = b / 1024, sb = b % 1024, swz = sb ^ (((sb >> 9) & 1) << 5); R = (st >> 1) * 16 + swz / 64; C = (st & 1) * 32 + (swz % 64) / 2; }
__host__ __device__ __forceinline__ int perm32(int rho) { const int n = rho >> 4, i = rho & 15; return 8 * (i >> 2) + 4 * n + (i & 3); }

struct Unit { int pm, pn, kind; };
struct Gemm { const bf16_t* A; const bf16_t* Bt; int M, N, K; };

struct StaticOrder {
    int nM, nN, nwg, G, c;
    __host__ __device__ void init(int M, int N, int G_, int c_) { nM = M / BM; nN = N / BM; nwg = nM * nN; G = G_; c = c_; }
    __host__ __device__ bool next(int i, Unit& u) const {
        const long L = (long)i * G + c; if (L >= nwg) return false;
        int wgid = (int)L; { const int q = nwg / NXCD, r = nwg % NXCD, xcd = wgid % NXCD, off = wgid / NXCD; wgid = (xcd < r ? xcd * (q + 1) : r * (q + 1) + (xcd - r) * q) + off; }
        const int nig = WGM * nN, gid = wgid / nig, fm = gid * WGM, gsz = (nM - fm) < WGM ? (nM - fm) : WGM;
        u.pm = fm + ((wgid % nig) % gsz); u.pn = (wgid % nig) / gsz; return true;
    }
    __device__ __forceinline__ void a_ready(const Unit&) const {}
    __device__ __forceinline__ void done(const Unit&) const {}
};
typedef float f32x2n __attribute__((ext_vector_type(2))); typedef __bf16 bf16x2n __attribute__((ext_vector_type(2)));
__device__ __forceinline__ unsigned cvt_pk_bf16(float lo, float hi) { const bf16x2n r = __builtin_convertvector((f32x2n){lo, hi}, bf16x2n); return __builtin_bit_cast(unsigned, r); }
typedef float f32x2 __attribute__((ext_vector_type(2)));
template <class Epi, class Sched, bool ALIGN_EPI = false, bool SP2 = false>
__device__ __forceinline__ void gemm_phase(PG8_LAS unsigned char* lds, const int ldk  , const Sched& S, const Epi& E, const int wave_id) {
    unsigned z_ = 0u; asm volatile("" : "+v"(z_)); const int lane_ = (int)__builtin_amdgcn_mbcnt_hi(~0u, __builtin_amdgcn_mbcnt_lo(~0u, z_)); int wid_ = wave_id; asm volatile("" : "+s"(wid_)); const int wid = wid_, lane = lane_, tid = wid * 64 + lane, wr = wid >> 2, wc = wid & 3, fr = lane & 15, fq = lane >> 4;
    const int K = ldk; int nt;
    unsigned voffA[2], voffB[2];
#pragma unroll
    for (int i = 0; i < 2; ++i) { int R, C; stage_rc(tid * 16 + i * 8192, R, C); const int Rb = Epi::PERM ? ((R & ~31) + perm32(R & 31)) : R;
        voffA[i] = (unsigned)(R * K + C) * 2u; voffB[i] = (unsigned)(Rb * K + C) * 2u; }
    const size_t kstep = (size_t)(BK * 2);
    const size_t hstep = (size_t)HALF * K * 2;
    const unsigned ldsw = (unsigned)wid * 1024u;
    const int aoff = lds_byte(wr * 64 + fr, fq * 8), boff = lds_byte(wc * 32 + fr, fq * 8);
#define PG8_SA(b, h) (((b) * 2 + (h)) * HTB)
#define PG8_SB(b, h) ((4 + (b) * 2 + (h)) * HTB)
#define PG8_STAGE(bufoff, gbase, voff) do { _Pragma("unroll") for (int _i = 0; _i < 2; ++_i) \
        __builtin_amdgcn_global_load_lds((const unsigned*)((const char*)(gbase) + (voff)[_i]), (PG8_LAS unsigned*)(lds + (bufoff) + ldsw + _i * 8192), 16, 0, 0); } while (0)
#define PG8_LDA(dst, b, h) do { _Pragma("unroll") for (int m = 0; m < 4; ++m) _Pragma("unroll") for (int k = 0; k < 2; ++k) dst[m][k] = *(const PG8_LAS bf16x8*)(lds + PG8_SA(b, h) + aoff + m * 2048 + k * 1024); } while (0)
#define PG8_LDB(dst, b, h) do { _Pragma("unroll") for (int n = 0; n < 2; ++n) _Pragma("unroll") for (int k = 0; k < 2; ++k) dst[n][k] = *(const PG8_LAS bf16x8*)(lds + PG8_SB(b, h) + boff + n * 2048 + k * 1024); } while (0)
#define PG8_MMA(ai, bj, At, Bt) do { __builtin_amdgcn_s_setprio(1); _Pragma("unroll") for (int m = 0; m < 4; ++m) _Pragma("unroll") for (int n = 0; n < 2; ++n) _Pragma("unroll") for (int k = 0; k < 2; ++k) \
        acc[ai][bj][m][n] = __builtin_amdgcn_mfma_f32_16x16x32_bf16(Bt[n][k], At[m][k], acc[ai][bj][m][n], 0, 0, 0); __builtin_amdgcn_s_setprio(0); } while (0)
#define PG8_WAIT_V(n) asm volatile("s_waitcnt vmcnt(" #n ")" ::: "memory")
#define PG8_WAIT_L(n) asm volatile("s_waitcnt lgkmcnt(" #n ")" ::: "memory")
#define PG8_BAR __builtin_amdgcn_s_barrier()
#define PG8_SCHED __builtin_amdgcn_sched_barrier(0)
    Unit cur, nxt; int ui = 0;
    if (!S.next(0, cur)) return;
    f32x4 acc[2][2][4][2];
#pragma unroll
    for (int a = 0; a < 2; ++a)
#pragma unroll
        for (int b = 0; b < 2; ++b)
#pragma unroll
            for (int m = 0; m < 4; ++m)
#pragma unroll
                for (int n = 0; n < 2; ++n) acc[a][b][m][n] = (f32x4){0.f, 0.f, 0.f, 0.f};
    bf16x8 At[4][2], B0[2][2], B1[2][2];
    const char* cA = S.abase(cur); const char* cB = S.bbase(cur); nt = S.nt(cur);
    S.a_ready(cur);
    if constexpr (SP2) {
        PG8_STAGE(PG8_SB(0, 0), cB, voffB); PG8_STAGE(PG8_SB(0, 1), cB + hstep, voffB); PG8_STAGE(PG8_SA(0, 0), cA, voffA); PG8_STAGE(PG8_SA(0, 1), cA + hstep, voffA);
        if (wr == 1) PG8_BAR;
        PG8_WAIT_V(2); PG8_BAR;
        PG8_STAGE(PG8_SB(1, 0), cB + kstep, voffB); PG8_STAGE(PG8_SA(1, 0), cA + kstep, voffA); PG8_STAGE(PG8_SB(1, 1), cB + hstep + kstep, voffB);
        PG8_WAIT_V(6); PG8_BAR;
    } else {
        PG8_STAGE(PG8_SB(0, 0), cB, voffB); PG8_STAGE(PG8_SA(0, 0), cA, voffA); PG8_STAGE(PG8_SB(0, 1), cB + hstep, voffB); PG8_STAGE(PG8_SA(0, 1), cA + hstep, voffA);
        if (wr == 1) PG8_BAR;
        PG8_WAIT_V(4); PG8_BAR;
        PG8_STAGE(PG8_SB(1, 0), cB + kstep, voffB); PG8_STAGE(PG8_SA(1, 0), cA + kstep, voffA); PG8_STAGE(PG8_SB(1, 1), cB + hstep + kstep, voffB);
        PG8_WAIT_V(6); PG8_BAR;
    }
    for (;;) {
        const bool has_next = S.next(ui + 1, nxt);
        const char* nA = has_next ? S.abase(nxt) : cA; const char* nB = has_next ? S.bbase(nxt) : cB;
        for (int t = 0; t < nt; t += 2) {
            const bool last = (t == nt - 2);
            const char* a1 = cA + (size_t)(t + 1) * kstep;
            const char* a2 = last ? nA : cA + (size_t)(t + 2) * kstep; const char* b2 = last ? nB : cB + (size_t)(t + 2) * kstep;
            const char* a3 = a2 + kstep; const char* b3 = b2 + kstep;
            if (last && has_next) S.a_ready(nxt);
            if constexpr (Epi::HOOK) { if (E.hook_at(t)) {
                if (wr == 0) PG8_BAR;
                E.khook(acc, cur, t, wr, wc, fr, fq);
                if (wr == 1) PG8_BAR; } }
            if constexpr (SP2) {
            PG8_LDB(B0, 0, 0); PG8_LDB(B1, 0, 1); PG8_SCHED; PG8_LDA(At, 0, 0); PG8_STAGE(PG8_SA(1, 1), a1 + hstep, voffA);
            PG8_WAIT_V(8); PG8_WAIT_L(0); PG8_BAR; PG8_MMA(0, 0, At, B0); PG8_MMA(0, 1, At, B1); PG8_BAR; PG8_SCHED;
            PG8_LDA(At, 0, 1); PG8_STAGE(PG8_SB(0, 0), b2, voffB); PG8_STAGE(PG8_SB(0, 1), b2 + hstep, voffB); PG8_STAGE(PG8_SA(0, 0), a2, voffA);
            PG8_WAIT_V(8); PG8_WAIT_L(0); PG8_BAR; PG8_MMA(1, 0, At, B0); PG8_MMA(1, 1, At, B1); PG8_BAR; PG8_SCHED;
            PG8_LDB(B0, 1, 0); PG8_LDB(B1, 1, 1); PG8_SCHED; PG8_LDA(At, 1, 0); PG8_STAGE(PG8_SA(0, 1), a2 + hstep, voffA);
            PG8_WAIT_V(8); PG8_WAIT_L(0); PG8_BAR; PG8_MMA(0, 0, At, B0); PG8_MMA(0, 1, At, B1); PG8_BAR; PG8_SCHED;
            PG8_LDA(At, 1, 1); PG8_STAGE(PG8_SB(1, 0), b3, voffB); PG8_STAGE(PG8_SB(1, 1), b3 + hstep, voffB); PG8_STAGE(PG8_SA(1, 0), a3, voffA);
            PG8_WAIT_V(8); PG8_WAIT_L(0); PG8_BAR; PG8_MMA(1, 0, At, B0); PG8_MMA(1, 1, At, B1); PG8_BAR; PG8_SCHED;
            } else {
            PG8_LDB(B0, 0, 0); PG8_SCHED; PG8_LDA(At, 0, 0); PG8_STAGE(PG8_SA(1, 1), a1 + hstep, voffA);
            PG8_WAIT_L(8); PG8_BAR; PG8_WAIT_L(0); PG8_MMA(0, 0, At, B0); PG8_BAR; PG8_SCHED;
            PG8_LDB(B1, 0, 1); PG8_STAGE(PG8_SB(0, 0), b2, voffB);
            PG8_BAR; PG8_WAIT_L(0); PG8_MMA(0, 1, At, B1); PG8_BAR;
            PG8_LDA(At, 0, 1); PG8_STAGE(PG8_SA(0, 0), a2, voffA);
            PG8_BAR; PG8_WAIT_L(0); PG8_MMA(1, 0, At, B0); PG8_BAR; PG8_SCHED;
            PG8_STAGE(PG8_SB(0, 1), b2 + hstep, voffB);
            PG8_WAIT_V(6); PG8_BAR; PG8_MMA(1, 1, At, B1); PG8_BAR;
            PG8_LDB(B0, 1, 0); PG8_SCHED; PG8_LDA(At, 1, 0); PG8_STAGE(PG8_SA(0, 1), a2 + hstep, voffA);
            PG8_WAIT_L(8); PG8_BAR; PG8_WAIT_L(0); PG8_MMA(0, 0, At, B0); PG8_BAR; PG8_SCHED;
            PG8_LDB(B1, 1, 1); PG8_STAGE(PG8_SB(1, 0), b3, voffB);
            PG8_BAR; PG8_WAIT_L(0); PG8_MMA(0, 1, At, B1); PG8_BAR;
            PG8_LDA(At, 1, 1); PG8_STAGE(PG8_SA(1, 0), a3, voffA);
            PG8_BAR; PG8_WAIT_L(0); PG8_MMA(1, 0, At, B0); PG8_BAR; PG8_SCHED;
            PG8_STAGE(PG8_SB(1, 1), b3 + hstep, voffB);
            PG8_WAIT_V(6); PG8_BAR; PG8_MMA(1, 1, At, B1); PG8_BAR;
            }
        }
        if constexpr (ALIGN_EPI) { if (wr == 0) PG8_BAR; }
        if constexpr (!Epi::AFTER_DRAIN) { E(acc, cur, wr, wc, fr, fq); S.done(cur); }
        if (!has_next) break;
#pragma unroll
        for (int a = 0; a < 2; ++a)
#pragma unroll
            for (int b = 0; b < 2; ++b)
#pragma unroll
                for (int m = 0; m < 4; ++m)
#pragma unroll
                    for (int n = 0; n < 2; ++n) acc[a][b][m][n] = (f32x4){0.f, 0.f, 0.f, 0.f};
        cur = nxt; cA = nA; cB = nB; ++ui; nt = S.nt(cur);
        if constexpr (ALIGN_EPI) { if (wr == 1) PG8_BAR; }
    }
    PG8_WAIT_V(0);
    if constexpr (!ALIGN_EPI) { if (wr == 0) PG8_BAR; }
    PG8_BAR;
    if constexpr (Epi::AFTER_DRAIN) { E.fused(acc, cur, wr, wc, fr, fq, lds, wid, lane); S.done(cur); }
#undef PG8_SA
#undef PG8_SB
#undef PG8_STAGE
#undef PG8_LDA
#undef PG8_LDB
#undef PG8_MMA
#undef PG8_WAIT_V
#undef PG8_WAIT_L
#undef PG8_BAR
#undef PG8_SCHED
}
}

namespace pg8 {
__device__ __forceinline__ float sigm(float x) { return __builtin_amdgcn_rcpf(1.f + __expf(-x)); }
__device__ __forceinline__ f32x4 sigm4(f32x4 v) { return (f32x4){sigm(v[0]), sigm(v[1]), sigm(v[2]), sigm(v[3])}; }
__device__ __forceinline__ u32x4 pack8(f32x4 v0, f32x4 v1) { u32x4 w; w.x = cvt_pk_bf16(v0[0], v0[1]); w.y = cvt_pk_bf16(v0[2], v0[3]); w.z = cvt_pk_bf16(v1[0], v1[1]); w.w = cvt_pk_bf16(v1[2], v1[3]); return w; }
__device__ __forceinline__ float bflo(unsigned u) { return __uint_as_float(u << 16); }
__device__ __forceinline__ float bfhi(unsigned u) { return __uint_as_float(u & 0xffff0000u); }


struct TileMap {
    int nM, nN, nwg;
    __device__ __forceinline__ void init(int nM_, int nN_) { nM = nM_; nN = nN_; nwg = nM_ * nN_; }
    __device__ __forceinline__ void map(int L, int& pm, int& pn) const {
        int wgid = L; { const int q = nwg / NXCD, r = nwg % NXCD, xcd = wgid % NXCD, off = wgid / NXCD; wgid = (xcd < r ? xcd * (q + 1) : r * (q + 1) + (xcd - r) * q) + off; }
        const int nig = WGM * nN, gid = wgid / nig, fm = gid * WGM, gsz = (nM - fm) < WGM ? (nM - fm) : WGM;
        pm = fm + ((wgid % nig) % gsz); pn = (wgid % nig) / gsz;
    }
};
struct Sched2 {
    const char *A0, *B0, *A1, *B1; size_t tstep; int ntk; TileMap t0, t1; int G, c;
    int pm_off0 = 0, pn_off0 = 0, first = 0, limit = 0x7fffffff;
    int spread = 0;
    __device__ __forceinline__ bool next(int i, Unit& u) const { const int L = first + i * G + c;
        if (spread) {
            const int lo = 48 * i, rem = t1.nwg - 32 * i, nf = rem < 0 ? 0 : (rem < 32 ? rem : 32);
            if (c >= lo && c < lo + nf) { t1.map(32 * i + c - lo, u.pm, u.pn); u.kind = 1; return true; }
            const int Ln = 224 * i + (c < lo ? c : c - nf);
            if (Ln >= t0.nwg) return false;
            t0.map(Ln, u.pm, u.pn); u.pm += pm_off0; u.pn += pn_off0; u.kind = 0; return true; }
        if (L >= limit) return false;
        if (L < t0.nwg) { t0.map(L, u.pm, u.pn); u.pm += pm_off0; u.pn += pn_off0; u.kind = 0; return true; }
        if (L - t0.nwg < t1.nwg) { t1.map(L - t0.nwg, u.pm, u.pn); u.kind = 1; return true; }
        return false; }
    __device__ __forceinline__ const char* abase(const Unit& u) const { return (u.kind ? A1 : A0) + (size_t)u.pm * tstep; }
    __device__ __forceinline__ const char* bbase(const Unit& u) const { return (u.kind ? B1 : B0) + (size_t)u.pn * tstep; }
    __device__ __forceinline__ int nt(const Unit&) const { return ntk; }
    __device__ __forceinline__ void a_ready(const Unit&) const {}
    __device__ __forceinline__ void done(const Unit&) const {}
};
struct SchedSplit {
    const char *A, *B; size_t tstep; int ntk; TileMap tm; int nctx, G, c;
    __device__ __forceinline__ bool next(int i, Unit& u) const { const int L = i * G + c;
        if (L < 256) { tm.map(L, u.pm, u.pn); u.kind = 0; return true; }
        const int e = L - 256; if (e < nctx) { const int tile = e & 31; u.pm = 32 + (tile >> 3); u.pn = tile & 7; u.kind = 1 + (e >> 5); return true; }
        return false; }
    __device__ __forceinline__ const char* abase(const Unit& u) const { return A + (size_t)u.pm * tstep + (u.kind ? (size_t)(u.kind - 1) * (ntk / 8) * 128 : 0); }
    __device__ __forceinline__ const char* bbase(const Unit& u) const { return B + (size_t)u.pn * tstep + (u.kind ? (size_t)(u.kind - 1) * (ntk / 8) * 128 : 0); }
    __device__ __forceinline__ int nt(const Unit& u) const { return u.kind ? ntk / 8 : ntk; }
    __device__ __forceinline__ void a_ready(const Unit&) const {}
    __device__ __forceinline__ void done(const Unit&) const {}
};
struct EpiInproj {
    static constexpr bool PERM = true, AFTER_DRAIN = false, HOOK = false;
    bf16_t* U; float* MISC; int ldu;
    __device__ __forceinline__ void operator()(const f32x4 (&acc)[2][2][4][2], const Unit& u, int wr, int wc, int fr, int fq) const {
        const int row0 = u.pm * BM + wr * 64 + fr, cl = wc * 32 + 8 * fq;
        if (u.pn == 16 || u.pn == 17) {
#pragma unroll
            for (int ai = 0; ai < 2; ++ai)
#pragma unroll
                for (int m = 0; m < 4; ++m) { float* rowp = MISC + (size_t)(row0 + ai * HALF + m * 16) * 512 + (u.pn - 16) * BM + cl;
#pragma unroll
                    for (int bj = 0; bj < 2; ++bj) { *(f32x4*)(rowp + bj * HALF) = acc[ai][bj][m][0]; *(f32x4*)(rowp + bj * HALF + 4) = acc[ai][bj][m][1]; } }
        } else {
            const bool sg = u.pn >= 22;
#pragma unroll
            for (int ai = 0; ai < 2; ++ai)
#pragma unroll
                for (int m = 0; m < 4; ++m) { bf16_t* rowp = U + (size_t)(row0 + ai * HALF + m * 16) * ldu + u.pn * BM + cl;
#pragma unroll
                    for (int bj = 0; bj < 2; ++bj) { f32x4 v0 = acc[ai][bj][m][0], v1 = acc[ai][bj][m][1];
                        if (sg) { v0 = sigm4(v0); v1 = sigm4(v1); }
                        *(u32x4*)(rowp + bj * HALF) = pack8(v0, v1); } }
        }
    }
};
struct EpiBf {
    static constexpr bool PERM = true, AFTER_DRAIN = false, HOOK = false;
    int kind; bf16_t* O0; bf16_t* O1;
    __device__ __forceinline__ void operator()(const f32x4 (&acc)[2][2][4][2], const Unit& u, int wr, int wc, int fr, int fq) const {
        bf16_t* base; size_t pitch;
        if (kind == 0) {
            const int half = u.pm >> 1, chb = (u.pm & 1) * 256;
            if (u.pn < 32) { const int b = u.pn >> 3, l0 = (u.pn & 7) * 256; pitch = 4096; base = O0 + ((size_t)(b * 512 + chb) * 2 + half) * 2048 + l0; }
            else { const int b = u.pn - 32; pitch = 512; base = O1 + ((size_t)(b * 512 + chb) * 2 + half) * 256; }
        } else if (kind == 1) { const int b = u.pn >> 1; pitch = 2304; base = O0 + (size_t)(b * 2048 + u.pm * 256) * 2304 + 1280 + (u.pn & 1) * 256; }
        else if (kind == 2) { const int b = u.pn >> 1; pitch = 2304; base = O0 + (size_t)(8192 + b * 256) * 2304 + 1280 + (u.pn & 1) * 256; }
        else { pitch = 8192; base = O0 + (size_t)(u.pm * 256) * 8192 + u.pn * 256; }
        const int r0 = wr * 64 + fr, cl = wc * 32 + 8 * fq;
#pragma unroll
        for (int ai = 0; ai < 2; ++ai)
#pragma unroll
            for (int m = 0; m < 4; ++m) { bf16_t* rowp = base + (size_t)(r0 + ai * HALF + m * 16) * pitch + cl;
#pragma unroll
                for (int bj = 0; bj < 2; ++bj) { f32x4 v0 = acc[ai][bj][m][0], v1 = acc[ai][bj][m][1];
                    if (kind == 3) { v0 = __builtin_elementwise_max(v0, (f32x4){0.f, 0.f, 0.f, 0.f}); v1 = __builtin_elementwise_max(v1, (f32x4){0.f, 0.f, 0.f, 0.f}); v0 = v0 * v0; v1 = v1 * v1; }
                    *(u32x4*)(rowp + bj * HALF) = pack8(v0, v1); } }
    }
};
struct EpiChain {
    static constexpr bool PERM = true, AFTER_DRAIN = false, HOOK = true;
    const bf16_t* G; int ldg; bf16_t* Mo;
    __device__ __forceinline__ bool hook_at(int t) const { return t == 8 || t == 20 || t == 28; }
    __device__ __forceinline__ void khook(f32x4 (&acc)[2][2][4][2], const Unit& u, int t, int wr, int wc, int fr, int fq) const {
        const int i = (t == 8) ? 0 : (t == 20 ? 1 : 2);
        int row0 = u.pm * BM + wr * 64 + fr; const int col0 = u.pn * BM + wc * 32 + 8 * fq + i * 2048;
        asm volatile("" : "+v"(row0));
#pragma unroll
        for (int ai = 0; ai < 2; ++ai) {
            u32x4 gv[4][2], hv[4][2];
#pragma unroll
            for (int m = 0; m < 4; ++m) { const bf16_t* gp = G + (size_t)(row0 + ai * HALF + m * 16) * ldg + col0;
#pragma unroll
                for (int bj = 0; bj < 2; ++bj) { gv[m][bj] = *(const u32x4*)(gp + bj * HALF); hv[m][bj] = *(const u32x4*)(gp + bj * HALF + 2048); } }
            asm volatile("" ::: "memory");
#pragma unroll
            for (int m = 0; m < 4; ++m)
#pragma unroll
                for (int bj = 0; bj < 2; ++bj) { const u32x4 g = gv[m][bj], h = hv[m][bj];
                    const unsigned gw[4] = {g.x, g.y, g.z, g.w}, hw[4] = {h.x, h.y, h.z, h.w};
#pragma unroll
                    for (int e2 = 0; e2 < 4; ++e2) { const float r0 = fmaxf(bflo(gw[e2]), 1e-6f) * __builtin_amdgcn_rcpf(fmaxf(bflo(hw[e2]), 1e-6f)), r1 = fmaxf(bfhi(gw[e2]), 1e-6f) * __builtin_amdgcn_rcpf(fmaxf(bfhi(hw[e2]), 1e-6f));
                        acc[ai][bj][m][e2 >> 1][(e2 & 1) * 2] *= r0; acc[ai][bj][m][e2 >> 1][(e2 & 1) * 2 + 1] *= r1; } }
            asm volatile("" ::: "memory");
        }
    }
    __device__ __forceinline__ void operator()(const f32x4 (&acc)[2][2][4][2], const Unit& u, int wr, int wc, int fr, int fq) const {
        const int row0 = u.pm * BM + wr * 64 + fr, col0 = u.pn * BM + wc * 32 + 8 * fq;
#pragma unroll
        for (int ai = 0; ai < 2; ++ai) {
            u32x4 gv[4][2];
#pragma unroll
            for (int m = 0; m < 4; ++m)
#pragma unroll
                for (int bj = 0; bj < 2; ++bj) gv[m][bj] = *(const u32x4*)(G + (size_t)(row0 + ai * HALF + m * 16) * ldg + col0 + bj * HALF + 3 * 2048);
            asm volatile("" ::: "memory");
#pragma unroll
            for (int m = 0; m < 4; ++m) { const size_t row = (size_t)(row0 + ai * HALF + m * 16);
#pragma unroll
                for (int bj = 0; bj < 2; ++bj) { const int col = col0 + bj * HALF; const u32x4 g = gv[m][bj];
                    const f32x4 v0 = acc[ai][bj][m][0] * (f32x4){fmaxf(bflo(g.x), 1e-6f), fmaxf(bfhi(g.x), 1e-6f), fmaxf(bflo(g.y), 1e-6f), fmaxf(bfhi(g.y), 1e-6f)};
                    const f32x4 v1 = acc[ai][bj][m][1] * (f32x4){fmaxf(bflo(g.z), 1e-6f), fmaxf(bfhi(g.z), 1e-6f), fmaxf(bflo(g.w), 1e-6f), fmaxf(bfhi(g.w), 1e-6f)};
                    *(u32x4*)(Mo + row * 2048 + col) = pack8(v0, v1); } }
        }
    }
};
struct EpiF32 {
    static constexpr bool PERM = true, AFTER_DRAIN = false, HOOK = false;
    bf16_t* C; bf16_t* YC;
    __device__ __forceinline__ void operator()(const f32x4 (&acc)[2][2][4][2], const Unit& u, int wr, int wc, int fr, int fq) const {
        const int row0 = u.pm * BM + wr * 64 + fr, col0 = u.pn * BM + wc * 32 + 8 * fq;
        if (u.kind == 0) {
#pragma unroll
            for (int ai = 0; ai < 2; ++ai)
#pragma unroll
                for (int m = 0; m < 4; ++m) { bf16_t* rowp = C + (size_t)(row0 + ai * HALF + m * 16) * 2048 + col0;
#pragma unroll
                    for (int bj = 0; bj < 2; ++bj) *(u32x4*)(rowp + bj * HALF) = pack8(acc[ai][bj][m][0], acc[ai][bj][m][1]); }
        } else {
            bf16_t* base = YC + (size_t)(u.kind - 1) * 1024 * 2048 + (size_t)(row0 - 8192) * 2048 + col0;
#pragma unroll
            for (int ai = 0; ai < 2; ++ai)
#pragma unroll
                for (int m = 0; m < 4; ++m) { bf16_t* rowp = base + (size_t)(ai * HALF + m * 16) * 2048;
#pragma unroll
                    for (int bj = 0; bj < 2; ++bj) *(u32x4*)(rowp + bj * HALF) = pack8(acc[ai][bj][m][0], acc[ai][bj][m][1]); }
        }
    }
};
struct EpiGateSlab {
    static constexpr bool PERM = true, AFTER_DRAIN = false, HOOK = false;
    const bf16_t* G; int ldg; bf16_t* SC;
    __device__ __forceinline__ void operator()(const f32x4 (&acc)[2][2][4][2], const Unit& u, int wr, int wc, int fr, int fq) const {
        const int row0 = u.pm * BM + wr * 64 + fr, cl = wc * 32 + 8 * fq;
#pragma unroll
        for (int ai = 0; ai < 2; ++ai) {
            u32x4 gv[4][2];
#pragma unroll
            for (int m = 0; m < 4; ++m)
#pragma unroll
                for (int bj = 0; bj < 2; ++bj) gv[m][bj] = *(const u32x4*)(G + (size_t)(row0 + ai * HALF + m * 16) * ldg + u.pn * BM + cl + bj * HALF + u.kind * 2048);
            asm volatile("" ::: "memory");
#pragma unroll
            for (int m = 0; m < 4; ++m) { bf16_t* rowp = SC + (size_t)u.kind * 1024 * 2048 + (size_t)(row0 + ai * HALF + m * 16 - 8192) * 2048 + u.pn * 256 + cl;
#pragma unroll
                for (int bj = 0; bj < 2; ++bj) { const u32x4 g = gv[m][bj];
                    const f32x4 v0 = acc[ai][bj][m][0] * (f32x4){bflo(g.x), bfhi(g.x), bflo(g.y), bfhi(g.y)}, v1 = acc[ai][bj][m][1] * (f32x4){bflo(g.z), bfhi(g.z), bflo(g.w), bfhi(g.w)};
                    *(u32x4*)(rowp + bj * HALF) = pack8(v0, v1); } }
        }
    }
};
struct SchedCB {
    const char *A, *B; size_t tstep; int G, c;
    __device__ __forceinline__ bool next(int i, Unit& u) const { const int L = i * G + c; if (L >= 128) return false; const int tile = L & 31; u.pm = 32 + (tile >> 3); u.pn = tile & 7; u.kind = L >> 5; return true; }
    __device__ __forceinline__ int koff(int k) const { return k == 0 ? 0 : (k == 1 ? 512 : (k == 2 ? 1280 : 1792)); }
    __device__ __forceinline__ const char* abase(const Unit& u) const { return A + (size_t)u.pm * tstep + koff(u.kind) * 2; }
    __device__ __forceinline__ const char* bbase(const Unit& u) const { return B + (size_t)u.pn * tstep + koff(u.kind) * 2; }
    __device__ __forceinline__ int nt(const Unit& u) const { return u.kind == 1 ? 12 : 8; }
    __device__ __forceinline__ void a_ready(const Unit&) const {}
    __device__ __forceinline__ void done(const Unit&) const {}
};
struct SchedCW {
    const char *A, *B; int G, c;
    __device__ __forceinline__ bool next(int i, Unit& u) const { const int L = i * G + c; if (L >= 256) return false; const int tile = L & 31; u.pm = 32 + (tile >> 3); u.pn = tile & 7; u.kind = 1 + (L >> 5); return true; }
    __device__ __forceinline__ const char* abase(const Unit& u) const { return A + (size_t)((u.kind - 1) >> 1) * 1024 * 2048 * 2 + (size_t)(u.pm - 32) * 256 * 2048 * 2 + (size_t)((u.kind - 1) & 1) * 2048; }
    __device__ __forceinline__ const char* bbase(const Unit& u) const { return B + (size_t)u.pn * 256 * 2048 * 2 + (size_t)((u.kind - 1) & 1) * 2048; }
    __device__ __forceinline__ int nt(const Unit&) const { return 16; }
    __device__ __forceinline__ void a_ready(const Unit&) const {}
    __device__ __forceinline__ void done(const Unit&) const {}
};
struct EpiIn2 {
    static constexpr bool PERM = true, AFTER_DRAIN = false, HOOK = false;
    EpiInproj e0; EpiBf e1;
    __device__ __forceinline__ void operator()(const f32x4 (&acc)[2][2][4][2], const Unit& u, int wr, int wc, int fr, int fq) const { if (u.kind == 0) e0(acc, u, wr, wc, fr, fq); else e1(acc, u, wr, wc, fr, fq); }
};
}

#define GAS __attribute__((address_space(1)))
#define LAS __attribute__((address_space(3)))
typedef unsigned short bf16;
typedef unsigned v4u __attribute__((ext_vector_type(4)));
typedef unsigned v2u __attribute__((ext_vector_type(2)));
typedef float f32x4 __attribute__((ext_vector_type(4)));
typedef float f32x2 __attribute__((ext_vector_type(2)));
constexpr int NWAVES = 8, NTHR = 512;
constexpr int DM = 2048, NBATCH = 4, LSEQ = 2048, LCTX = 256, DEPTH = 4;
constexpr int TLAT = NBATCH * LSEQ, TCTX = NBATCH * LCTX, TT = TLAT + TCTX;
constexpr int IN_DIM = 14168, DFF = 8192;
constexpr int NU = 13824;
constexpr int UZ = 0, UXBC = 768, URKV = 2560, UMISC = 4096, UCONV = 4608, UGATE = 5632;
constexpr int S_RKV = 2584, S_DT = 2560, S_WF = 4120, S_CONV = 4440, S_FFT = 5464, S_GATE = 5976;
constexpr int RJ = LCTX + LSEQ;
enum { I_X = 0, I_C, I_CTX, I_CCTX, I_MODW, I_MODB, I_NORMG, I_WIN, I_CONVW, I_CONVB, I_CLNG, I_CLNB, I_CONVOUT, I_SCW, I_SCB, I_SALOG, I_SDTB, I_SD, I_SNG, I_SOUT,
       I_FOUT, I_RMU, I_RW0, I_RW2, I_RA0, I_RA2, I_RG2, I_RKK, I_RKA, I_RRK, I_RLNG, I_RLNB, I_ROUT, I_WO, I_UP, I_DOWN, N_IN };
constexpr size_t MiB = 1u << 20;
constexpr size_t OFF_CTL = 0, CTL_BYTES = 128 * 1024;
constexpr size_t OFF_MODV = 1 * MiB;
constexpr size_t OFF_DFTL = 2 * MiB;
constexpr size_t OFF_DFTC = 18 * MiB;
constexpr size_t OFF_W = 20 * MiB, W_LAYER = 139 * MiB;
constexpr size_t WO_IN = 0, WO_FFT = 54 * MiB, WO_CAT = 58 * MiB  , WO_O = 67 * MiB, WO_UP = 75 * MiB, WO_DN = 107 * MiB;
constexpr size_t OFF_X = 576 * MiB;
constexpr size_t OFF_H = 648 * MiB;
constexpr size_t OFF_U = 684 * MiB;
constexpr size_t OFF_HB = OFF_U;
constexpr size_t OFF_MISC = 927 * MiB;
constexpr size_t OFF_VTL = 945 * MiB;
constexpr size_t OFF_VTC = 961 * MiB;
constexpr size_t OFF_ACAT = 963 * MiB;
constexpr int AC_CONV = 0, AC_SSD = 512, AC_FFT = 1280, AC_RWKV = 1792, ACW = 2304;
constexpr size_t OFF_XBC = 1004 * MiB;
constexpr size_t OFF_DTA = 1036 * MiB;
constexpr size_t OFF_YSSD = 1038 * MiB;
constexpr size_t OFF_RW = 1092 * MiB, RW_ARR = 18 * MiB;
constexpr size_t OFF_RCH = OFF_RW;
constexpr size_t OFF_RSC = 1254 * MiB;
constexpr size_t OFF_YRW = 1255 * MiB;
constexpr size_t OFF_MBUF = 1291 * MiB;
constexpr size_t OFF_M = 1363 * MiB;
constexpr size_t OFF_Y = 1399 * MiB;
constexpr size_t OFF_WLT = 1471 * MiB;
constexpr size_t OFF_YC = 1473 * MiB;
constexpr size_t OFF_WO4 = 1537 * MiB, WO4_LAYER = 32 * MiB;
constexpr size_t OFF_SCAT = OFF_MBUF;
constexpr size_t WS_END = 1665 * MiB;
constexpr int CW_Q = 8192;
constexpr int CW_CQ = 12288;
constexpr int CW_BAR = 4096;
constexpr int RING_BYTES = 131072, MISC_OFF = RING_BYTES + 320, LDS_BYTES = 147456;

__device__ __forceinline__ float bf2f(unsigned short b) { return __uint_as_float((unsigned)b << 16); }
__device__ __forceinline__ float bflo(unsigned u) { return __uint_as_float(u << 16); }
__device__ __forceinline__ float bfhi(unsigned u) { return __uint_as_float(u & 0xffff0000u); }
__device__ __forceinline__ unsigned f2bf(float f) { unsigned u = __builtin_bit_cast(unsigned, f); return (u + 0x7fffu + ((u >> 16) & 1u)) >> 16; }
typedef __bf16 bf16x2_t __attribute__((ext_vector_type(2)));
__device__ __forceinline__ unsigned pk2(float lo, float hi) { const bf16x2_t r = __builtin_convertvector((f32x2){lo, hi}, bf16x2_t); return __builtin_bit_cast(unsigned, r); }
__device__ __forceinline__ float sigmoidf_(float x) { return __builtin_amdgcn_rcpf(1.f + __expf(-x)); }
__device__ __forceinline__ float siluf_(float x) { return x * __builtin_amdgcn_rcpf(1.f + __expf(-x)); }
__device__ __forceinline__ float softplusf_(float x) { return fmaxf(x, 0.f) + __logf(1.f + __expf(-fabsf(x))); }
__device__ __forceinline__ bf16 bf1(float x) { return (bf16)(pk2(x, x) & 0xffffu); }
template <int CTRL> __device__ __forceinline__ float dpp_add(float x) { return x + __int_as_float(__builtin_amdgcn_update_dpp(0, __float_as_int(x), CTRL, 0xf, 0xf, true)); }
__device__ __forceinline__ float sum8(float x) { x = dpp_add<0xB1>(x); x = dpp_add<0x4E>(x); x = dpp_add<0x141>(x); return x; }
__device__ __forceinline__ float row16_sum(float x) { x = sum8(x); x = dpp_add<0x140>(x); return x; }
__device__ __forceinline__ float wave_sum(float v) {
    const float r = row16_sum(v);
    return (__int_as_float(__builtin_amdgcn_readlane(__float_as_int(r), 0)) + __int_as_float(__builtin_amdgcn_readlane(__float_as_int(r), 16))) +
           (__int_as_float(__builtin_amdgcn_readlane(__float_as_int(r), 32)) + __int_as_float(__builtin_amdgcn_readlane(__float_as_int(r), 48)));
}
#define LDS_WAIT() asm volatile("s_waitcnt lgkmcnt(0)" ::: "memory")

struct Args { const float* in[N_IN]; float* out; unsigned char* ws; int ph_lo, ph_hi; };
typedef const __attribute__((address_space(4))) Args* KArgs;
__device__ __forceinline__ KArgs kargs() { KArgs p = (KArgs)__builtin_amdgcn_kernarg_segment_ptr(); asm volatile("" : "+s"(p)); return p; }
#define PH_IDS unsigned z_ = 0u; asm volatile("" : "+v"(z_)); const int lane_ = (int)__builtin_amdgcn_mbcnt_hi(~0u, __builtin_amdgcn_mbcnt_lo(~0u, z_)); int wv_ = wave0; asm volatile("" : "+s"(wv_)); const int lane = lane_, wave = wv_, tid = wv_ * 64 + lane_; (void)lane; (void)wave; (void)tid;

__device__ __forceinline__ int inmap(int n) {
    if (n < 2560) return n;
    if (n < 4096) return S_RKV + (n - 2560);
    if (n < 4608) { const int m = n - 4096; if (m < 24) return S_DT + m; if (m < 64) return -1; if (m < 384) return S_WF + (m - 64); return -1; }
    if (n < 5632) return S_CONV + (n - 4608);
    return S_GATE + (n - 5632);
}
__device__ __forceinline__ int rwkv_tok(int b, int j) { if (j < LCTX) return TLAT + b * LCTX + j; const int s = j - LCTX; return b * LSEQ + (s & 31) * 64 + (s >> 5); }

constexpr int IT_IN = 32 * (NU / 32), IT_CO = 8 * 64, IT_SO = 12 * 64, IT_FO = 8 * 64, IT_RO = 8 * 64, IT_O = 32 * 64, IT_UP = 32 * 256, IT_DN = 128 * 64;
constexpr int IT_LAYER = IT_IN + IT_CO + IT_SO + IT_FO + IT_RO + IT_O + IT_UP + IT_DN;
struct CvItem { const float* src; bf16* dst; int Nsrc, ldw, k0, n0, koff; bool mapped; bf16* dst4; };
__device__ __forceinline__ CvItem cv_decode(KArgs a, int l, int r) {
    unsigned char* wl = a->ws + OFF_W + (size_t)l * W_LAYER;
    if (r < IT_IN) { const int kb = r / (NU / 32), nb = r % (NU / 32); return CvItem{a->in[I_WIN] + (size_t)l * DM * IN_DIM, (bf16*)(wl + WO_IN), IN_DIM, DM, kb * 64, nb * 32, 0, true, nullptr}; } r -= IT_IN;
    if (r < IT_CO) return CvItem{a->in[I_CONVOUT] + (size_t)l * 512 * DM, (bf16*)(wl + WO_CAT), DM, ACW, (r / 64) * 64, (r % 64) * 32, AC_CONV, false, nullptr}; r -= IT_CO;
    if (r < IT_SO) return CvItem{a->in[I_SOUT] + (size_t)l * 768 * DM, (bf16*)(wl + WO_CAT), DM, ACW, (r / 64) * 64, (r % 64) * 32, AC_SSD, false, nullptr}; r -= IT_SO;
    if (r < IT_FO) return CvItem{a->in[I_FOUT] + (size_t)l * 512 * DM, (bf16*)(wl + WO_CAT), DM, ACW, (r / 64) * 64, (r % 64) * 32, AC_FFT, false, nullptr}; r -= IT_FO;
    if (r < IT_RO) return CvItem{a->in[I_ROUT] + (size_t)l * 512 * DM, (bf16*)(wl + WO_CAT), DM, ACW, (r / 64) * 64, (r % 64) * 32, AC_RWKV, false, nullptr}; r -= IT_RO;
    if (r < IT_O) return CvItem{a->in[I_WO] + (size_t)l * DM * DM, (bf16*)(wl + WO_O), DM, DM, (r / 64) * 64, (r % 64) * 32, 0, false, nullptr}; r -= IT_O;
    if (r < IT_UP) return CvItem{a->in[I_UP] + (size_t)l * DM * DFF, (bf16*)(wl + WO_UP), DFF, DM, (r / 256) * 64, (r % 256) * 32, 0, false, nullptr}; r -= IT_UP;
    return CvItem{a->in[I_DOWN] + (size_t)l * DFF * DM, (bf16*)(wl + WO_DN), DM, DFF, (r / 64) * 64, (r % 64) * 32, 0, false, nullptr};
}
__device__ __forceinline__ void cv_load(const CvItem& c, f32x4 (&v)[8], int lane) {
    const int n4 = (lane & 7) * 4; const int sc = c.mapped ? inmap(c.n0 + n4) : (c.n0 + n4);
#pragma unroll
    for (int i = 0; i < 8; ++i) { const int kk = 8 * i + (lane >> 3); v[i] = (sc >= 0) ? *(const f32x4*)(c.src + (size_t)(c.k0 + kk) * c.Nsrc + sc) : (f32x4){0.f, 0.f, 0.f, 0.f}; }
}
__device__ __forceinline__ void cv_store(const CvItem& c, const f32x4 (&v)[8], LAS float* scr, int lane) {
    const int n4 = (lane & 7) * 4;
#pragma unroll
    for (int i = 0; i < 8; ++i) { const int kk = 8 * i + (lane >> 3); LAS float* d = scr + kk * 33 + n4; d[0] = v[i].x; d[1] = v[i].y; d[2] = v[i].z; d[3] = v[i].w; }
    LDS_WAIT();
    const int cc = lane & 7;
#pragma unroll
    for (int j = 0; j < 4; ++j) { const int n = (lane >> 3) + 8 * j; const LAS float* s = scr + (8 * cc) * 33 + n;
        v4u o; o.x = pk2(s[0 * 33], s[1 * 33]); o.y = pk2(s[2 * 33], s[3 * 33]); o.z = pk2(s[4 * 33], s[5 * 33]); o.w = pk2(s[6 * 33], s[7 * 33]);
        *(v4u*)(c.dst + (size_t)(c.n0 + n) * c.ldw + c.koff + c.k0 + 8 * cc) = o;
        if (c.dst4) { bf16* d4 = c.dst4 + (size_t)(c.n0 + n) * 8192 + (c.k0 >> 8) * 1024 + (c.k0 & 255) + 8 * cc;
#pragma unroll
            for (int i = 0; i < 4; ++i) *(v4u*)(d4 + i * 256) = o; } }
    LDS_WAIT();
}
__device__ __forceinline__ void p0_prologue(KArgs a, LAS unsigned char* lds, int bid, int G, const int wave0, const int sel = 15) {
    PH_IDS
    unsigned char* ws = a->ws;
    if (sel & 1) {
        LAS float* sc = (LAS float*)lds;
        LAS float* part = (LAS float*)(lds + 40960);
        for (int i = tid; i < 5 * DM; i += NTHR) { const float v = (i < 4 * DM) ? a->in[I_C][i] : a->in[I_CCTX][i - 4 * DM]; sc[i] = siluf_(v); }
        __syncthreads();
        float* MODV = (float*)(ws + OFF_MODV);
        const int nblk = ((DEPTH * 192 - bid + G - 1) / G) * 16;
        auto wptr = [&](int q) { int ln = lane; asm volatile("" : "+v"(ln));
            const int it = bid + (q >> 4) * G, l = it / 192;
            return a->in[I_MODW] + (size_t)l * DM * 12288 + (size_t)(wave * 256 + (q & 15) * 16) * 12288 + (it % 192) * 64 + ln; };
        float w0[16], w1[16], acc[5] = {0.f, 0.f, 0.f, 0.f, 0.f};
        { const float* wp = wptr(0);
#pragma unroll
          for (int k = 0; k < 16; ++k) w0[k] = wp[(size_t)k * 12288]; }
#pragma unroll 1
        for (int q = 0; q < nblk; q += 2) {
            { const float* wp = wptr(q + 1);
#pragma unroll
              for (int k = 0; k < 16; ++k) w1[k] = wp[(size_t)k * 12288]; }
            { const int kb = wave * 256 + (q & 15) * 16;
#pragma unroll
              for (int k = 0; k < 16; ++k)
#pragma unroll
                  for (int r = 0; r < 5; ++r) acc[r] += sc[r * DM + kb + k] * w0[k]; }
            if (q + 2 < nblk) { const float* wp = wptr(q + 2);
#pragma unroll
              for (int k = 0; k < 16; ++k) w0[k] = wp[(size_t)k * 12288]; }
            { const int kb = wave * 256 + ((q + 1) & 15) * 16;
#pragma unroll
              for (int k = 0; k < 16; ++k)
#pragma unroll
                  for (int r = 0; r < 5; ++r) acc[r] += sc[r * DM + kb + k] * w1[k]; }
            if (((q + 1) & 15) == 15) {
                const int it = bid + (q >> 4) * G, l = it / 192;
#pragma unroll
                for (int r = 0; r < 5; ++r) { part[(wave * 5 + r) * 64 + lane] = acc[r]; acc[r] = 0.f; }
                __syncthreads();
                if (tid < 320) { const int r = tid >> 6, jj = tid & 63; float s = 0.f;
#pragma unroll
                    for (int w = 0; w < 8; ++w) s += part[(w * 5 + r) * 64 + jj];
                    const int jo = (it % 192) * 64 + jj; MODV[((size_t)l * 5 + r) * 12288 + jo] = s + a->in[I_MODB][l * 12288 + jo]; }
                __syncthreads();
            }
        }
    }
    if (sel & 2) {
        typedef short bfx8 __attribute__((ext_vector_type(8)));
        LAS float* ctab = (LAS float*)(lds + 32768);
        __syncthreads();
        if (tid < 128) ctab[tid] = cospif((float)tid * (1.f / 64.f));
        __syncthreads();
        const int fr = lane & 15, fq = lane >> 4, half = wave >> 2, cb = (wave & 3) * 32;
        v4u th[2][4], tl[2][4];
#pragma unroll
        for (int nt = 0; nt < 2; ++nt)
#pragma unroll
            for (int ct = 0; ct < 4; ++ct) { const int cp = cb + 16 * nt + fr; unsigned h[4], lo[4];
#pragma unroll
                for (int e = 0; e < 4; ++e) { const int c = 32 * ct + 8 * fq + 2 * e;
                    const float v0 = ctab[(c * cp - 32 * half) & 127], v1 = ctab[((c + 1) * cp - 32 * half) & 127];
                    h[e] = pk2(v0, v1); lo[e] = pk2(v0 - bflo(h[e]), v1 - bfhi(h[e])); }
                th[nt][ct] = (v4u){h[0], h[1], h[2], h[3]}; tl[nt][ct] = (v4u){lo[0], lo[1], lo[2], lo[3]}; }
        for (int it = bid; it < DEPTH * 32 * 4; it += G) {
            const int l = it / 128, kb = (it % 128) / 4, g = it % 4, k0 = kb * 64;
            const float* Wsrc = a->in[I_WIN] + ((size_t)l * DM + k0) * IN_DIM + S_FFT + g * 128 + 8 * fq;
            bf16* WT = (bf16*)(ws + OFF_W + (size_t)l * W_LAYER + WO_FFT) + (size_t)(half * 512 + g * 128 + cb + fr) * DM + k0 + 8 * fq;
#pragma unroll 1
            for (int p = 0; p < 2; ++p) {
                f32x4 raw[2][4][2];
#pragma unroll
                for (int mi = 0; mi < 2; ++mi) { const int kk = 32 * p + 8 * (fr >> 2) + 4 * mi + (fr & 3);
#pragma unroll
                    for (int ct = 0; ct < 4; ++ct) { const float* sp = Wsrc + (size_t)kk * IN_DIM + 32 * ct; raw[mi][ct][0] = *(const f32x4*)sp; raw[mi][ct][1] = *(const f32x4*)(sp + 4); } }
                f32x4 acc[2][2];
#pragma unroll
                for (int mi = 0; mi < 2; ++mi)
#pragma unroll
                    for (int nt = 0; nt < 2; ++nt) acc[mi][nt] = (f32x4){0.f, 0.f, 0.f, 0.f};
#pragma unroll
                for (int mi = 0; mi < 2; ++mi)
#pragma unroll
                    for (int ct = 0; ct < 4; ++ct) { const f32x4 r0 = raw[mi][ct][0], r1 = raw[mi][ct][1];
                        v4u ah, al; ah.x = pk2(r0.x, r0.y); ah.y = pk2(r0.z, r0.w); ah.z = pk2(r1.x, r1.y); ah.w = pk2(r1.z, r1.w);
                        al.x = pk2(r0.x - bflo(ah.x), r0.y - bfhi(ah.x)); al.y = pk2(r0.z - bflo(ah.y), r0.w - bfhi(ah.y)); al.z = pk2(r1.x - bflo(ah.z), r1.y - bfhi(ah.z)); al.w = pk2(r1.z - bflo(ah.w), r1.w - bfhi(ah.w));
#pragma unroll
                        for (int nt = 0; nt < 2; ++nt) {
                            acc[mi][nt] = __builtin_amdgcn_mfma_f32_16x16x32_bf16(__builtin_bit_cast(bfx8, ah), __builtin_bit_cast(bfx8, th[nt][ct]), acc[mi][nt], 0, 0, 0);
                            acc[mi][nt] = __builtin_amdgcn_mfma_f32_16x16x32_bf16(__builtin_bit_cast(bfx8, ah), __builtin_bit_cast(bfx8, tl[nt][ct]), acc[mi][nt], 0, 0, 0);
                            acc[mi][nt] = __builtin_amdgcn_mfma_f32_16x16x32_bf16(__builtin_bit_cast(bfx8, al), __builtin_bit_cast(bfx8, th[nt][ct]), acc[mi][nt], 0, 0, 0); } }
#pragma unroll
                for (int nt = 0; nt < 2; ++nt)
                    *(v4u*)(WT + (size_t)(16 * nt) * DM + 32 * p) = (v4u){pk2(acc[0][nt][0], acc[0][nt][1]), pk2(acc[0][nt][2], acc[0][nt][3]), pk2(acc[1][nt][0], acc[1][nt][1]), pk2(acc[1][nt][2], acc[1][nt][3])};
            }
        }
        __syncthreads();
    }
    const int gw = bid * NWAVES + wave, NGW = G * NWAVES;
    if (sel & 4) {
        LAS float* scr = (LAS float*)(lds + wave * 8448);
        f32x4 v0[8], v1[8]; int it = gw;
        if (it < DEPTH * IT_LAYER) { CvItem c0 = cv_decode(a, it / IT_LAYER, it % IT_LAYER); cv_load(c0, v0, lane);
            for (;;) { const int itn = it + NGW; const bool more = itn < DEPTH * IT_LAYER; CvItem c1 = c0;
                if (more) { c1 = cv_decode(a, itn / IT_LAYER, itn % IT_LAYER); cv_load(c1, v1, lane); }
                cv_store(c0, v0, scr, lane);
                if (!more) break;
#pragma unroll
                for (int i = 0; i < 8; ++i) v0[i] = v1[i];
                c0 = c1; it = itn; } }
    }
    if (sel & 8) {
        const int gt = bid * NTHR + tid, NGT = G * NTHR;
        bf16* FL = (bf16*)(ws + OFF_DFTL); bf16* FC = (bf16*)(ws + OFF_DFTC);
        { bf16* WLT = (bf16*)(ws + OFF_WLT);
          for (int i = gt; i < DEPTH * 512 * 320; i += NGT) { const int l = i / (512 * 320), c = (i / 320) % 512, j = i % 320; float v;
              if (j < 64) v = a->in[I_RW2][((size_t)(l * 2 + 0) * 64 + j) * 512 + c]; else if (j < 128) v = a->in[I_RW2][((size_t)(l * 2 + 1) * 64 + (j - 64)) * 512 + c];
              else if (j < 192) v = a->in[I_RA2][((size_t)l * 64 + (j - 128)) * 512 + c]; else v = a->in[I_RG2][((size_t)l * 128 + (j - 192)) * 512 + c];
              WLT[i] = (bf16)f2bf(v); } }
        for (int i = gt; i < 2048 * 512; i += NGT) { const int lp = i >> 9, k8 = (i & 511) * 8; unsigned o[4];
#pragma unroll
            for (int e = 0; e < 4; ++e) { float v[2];
#pragma unroll
                for (int q = 0; q < 2; ++q) { const int k = k8 + 2 * e + q; const int m = (lp * (k & 2047)) & 2047; float sn, cs; sincospif((float)m * (1.f / 1024.f), &sn, &cs); v[q] = (k < 2048 ? cs : -sn) * (1.f / 512.f); }
                o[e] = pk2(v[0], v[1]); }
            *(v4u*)(FL + (size_t)lp * 4096 + k8) = (v4u){o[0], o[1], o[2], o[3]}; }
        for (int i = gt; i < 256 * 64; i += NGT) { const int lp = i >> 6, k8 = (i & 63) * 8; unsigned o[4];
#pragma unroll
            for (int e = 0; e < 4; ++e) { float v[2];
#pragma unroll
                for (int q = 0; q < 2; ++q) { const int k = k8 + 2 * e + q; const int m = (lp * (k & 255)) & 255; float sn, cs; sincospif((float)m * (1.f / 128.f), &sn, &cs); v[q] = (k < 256 ? cs : -sn) * 0.005524271728f; }
                o[e] = pk2(v[0], v[1]); }
            *(v4u*)(FC + (size_t)lp * 512 + k8) = (v4u){o[0], o[1], o[2], o[3]}; }
    }
}

__device__ __forceinline__ void norm_phase(KArgs a, int mode, const float* gY, const float* gH, const float* modY  , const float* modH  ,
                                           int bid, int G, const int wave0, int nrows, bool split = false  , bool dry = false  , bool xin = false  ) {
    PH_IDS
    unsigned char* ws = a->ws; const int gw = bid * NWAVES + wave, NGW = G * NWAVES;
    const float* X = (const float*)(ws + OFF_X); const bf16* Y = (const bf16*)(ws + OFF_Y); bf16* H = (bf16*)(ws + (dry ? OFF_M : OFF_H)); float* Xw = (float*)(ws + (dry ? OFF_MBUF : OFF_X));
    f32x4 xn[8]; v2u yn[8];
    auto fetch = [&](int row) {
        const f32x4* xr = (const f32x4*)(xin ? (row < TLAT ? a->in[I_X] + (size_t)row * DM : a->in[I_CTX] + (size_t)(row - TLAT) * DM) : X + (size_t)row * DM) + lane;
#pragma unroll
        for (int j = 0; j < 8; ++j) xn[j] = xr[64 * j];
        if (mode != 0 && !(split && row >= TLAT)) { const v2u* yr = (const v2u*)(Y + (size_t)row * DM) + lane;
#pragma unroll
            for (int j = 0; j < 8; ++j) yn[j] = yr[64 * j]; } };
    f32x4 gvc[8], hgc[8];
#pragma unroll
    for (int j = 0; j < 8; ++j) { gvc[j] = (mode != 0) ? ((const f32x4*)gY + lane)[64 * j] : (f32x4){0.f, 0.f, 0.f, 0.f}; hgc[j] = (mode != 2) ? ((const f32x4*)gH + lane)[64 * j] : (f32x4){0.f, 0.f, 0.f, 0.f}; }
    const int rlast = gw + ((nrows - 1 - gw) / NGW) * NGW;
    if (gw < nrows) fetch(rlast);
    for (int row = rlast; row >= 0 && gw < nrows; row -= NGW) {
        const int mr = row < TLAT ? (row >> 11) : 4;
        f32x4 x[8];
#pragma unroll
        for (int j = 0; j < 8; ++j) x[j] = xn[j];
        if (mode != 0) {
            f32x4 y[8]; float ss = 0.f;
            if (split && row >= TLAT) { const v2u* yc = (const v2u*)((const bf16*)(ws + OFF_YC) + (size_t)(row - TLAT) * DM) + lane;
#pragma unroll
                for (int j = 0; j < 8; ++j) { f32x4 t = (f32x4){0.f, 0.f, 0.f, 0.f};
#pragma unroll
                    for (int sl = 0; sl < 8; ++sl) { const v2u q = yc[(size_t)sl * 1024 * 512 + 64 * j]; t += (f32x4){bflo(q.x), bfhi(q.x), bflo(q.y), bfhi(q.y)}; }
                    y[j] = t; } }
            else {
#pragma unroll
                for (int j = 0; j < 8; ++j) { const v2u t = yn[j]; y[j] = (f32x4){bflo(t.x), bfhi(t.x), bflo(t.y), bfhi(t.y)}; } }
            const f32x4* gt = (const f32x4*)(modY + (size_t)mr * 12288) + lane;
            f32x4 tv[8];
#pragma unroll
            for (int j = 0; j < 8; ++j) tv[j] = gt[64 * j];
            if (row >= NGW) fetch(row - NGW);
#pragma unroll
            for (int j = 0; j < 8; ++j) { ss += (y[j].x * y[j].x + y[j].y * y[j].y) + (y[j].z * y[j].z + y[j].w * y[j].w); }
            const float r = rsqrtf(wave_sum(ss) * (1.f / DM) + 1e-6f);
#pragma unroll
            for (int j = 0; j < 8; ++j) x[j] += tv[j] * (y[j] * r * gvc[j]);
        } else if (row >= NGW) fetch(row - NGW);
        f32x4 hs[8], hc[8];
        if (mode != 2) { const f32x4* sh = (const f32x4*)(modH + (size_t)mr * 12288) + lane; const f32x4* sc = sh + 512;
#pragma unroll
            for (int j = 0; j < 8; ++j) { hs[j] = sh[64 * j]; hc[j] = sc[64 * j]; } }
        asm volatile("" ::: "memory");
        if (mode == 1) { f32x4* xw = (f32x4*)(Xw + (size_t)row * DM) + lane;
#pragma unroll
            for (int j = 0; j < 8; ++j) xw[64 * j] = x[j]; }
        else if (mode == 2) { f32x4* ow = (f32x4*)(a->out + (size_t)row * DM) + lane;
#pragma unroll
            for (int j = 0; j < 8; ++j) ow[64 * j] = x[j]; }
        if (mode != 2) {
            float ss = 0.f;
#pragma unroll
            for (int j = 0; j < 8; ++j) ss += (x[j].x * x[j].x + x[j].y * x[j].y) + (x[j].z * x[j].z + x[j].w * x[j].w);
            const float r = rsqrtf(wave_sum(ss) * (1.f / DM) + 1e-6f);
            v2u* hw = (v2u*)(H + (size_t)row * DM) + lane;
#pragma unroll
            for (int j = 0; j < 8; ++j) { const f32x4 h = (x[j] * r * hgc[j]) * (hc[j] + 1.f) + hs[j]; hw[64 * j] = (v2u){pk2(h.x, h.y), pk2(h.z, h.w)}; }
        }
    }
}
#define XB_TMO      128
#define XB_XCNT(j)  (256  + 64 * (j))
#define XB_XSUB(j)  (1280 + 64 * (j))
#define XB_XGEN(j)  (2304 + 64 * (j))
#define XB_TOP      3328
#define XB_TOPGEN   3392
#define XCD_BAR_WORDS 3456
#define XB_SPIN_CAP (1u << 18)

__device__ __forceinline__ unsigned xb_ld(unsigned* p)              { return __hip_atomic_load(p, __ATOMIC_RELAXED, __HIP_MEMORY_SCOPE_AGENT); }
__device__ __forceinline__ unsigned xb_add(unsigned* p, unsigned v) { return __hip_atomic_fetch_add(p, v, __ATOMIC_RELAXED, __HIP_MEMORY_SCOPE_AGENT); }
__device__ __forceinline__ unsigned xb_xcc_id() { return (unsigned)__builtin_amdgcn_s_getreg((3 << 11) | 20) & 0xFu; }
#define XB_SPIN(cond, bar) do { unsigned _sp = 0; while (cond) { __builtin_amdgcn_s_sleep(1); \
    if ((++_sp & 255u) == 0u) { if (xb_ld(&(bar)[XB_TMO])) break; if (_sp > XB_SPIN_CAP) { atomicAdd(&(bar)[XB_TMO], 1u); break; } } } } while (0)

struct XcdBarrier {
    unsigned* bar; unsigned x; int wv;
    volatile LAS unsigned* st;
};

__device__ __forceinline__ bool xb_t0(int wv) { unsigned z_ = 0u; asm volatile("" : "+v"(z_)); return wv == 0 && __builtin_amdgcn_mbcnt_hi(~0u, __builtin_amdgcn_mbcnt_lo(~0u, z_)) == 0u; }
__device__ __forceinline__ XcdBarrier xcd_barrier_post(unsigned* bar, volatile LAS unsigned* st, int wv) {
    XcdBarrier b; b.bar = bar; b.x = xb_xcc_id(); b.st = st; b.wv = wv;
    if (xb_t0(wv)) (void)xb_add(&bar[XB_XCNT(b.x)], 1u);
    return b;
}
__device__ __forceinline__ void xcd_barrier_complete(unsigned* bar, unsigned x, unsigned& nloc, unsigned& nx) {
    const unsigned G = gridDim.x * gridDim.y * gridDim.z;
    unsigned sum, cnt, mine, sp = 0u;
    for (;;) {
        sum = 0u; cnt = 0u; mine = 0u;
#pragma unroll
        for (unsigned j = 0; j < 16; ++j) { const unsigned c = xb_ld(&bar[XB_XCNT(j)]); sum += c; cnt += (c > 0u) ? 1u : 0u; mine = (j == x) ? c : mine; }
        if (sum == G) break;
        __builtin_amdgcn_s_sleep(1);
        if ((++sp & 255u) == 0u) { if (xb_ld(&bar[XB_TMO])) break; if (sp > XB_SPIN_CAP) { atomicAdd(&bar[XB_TMO], 1u); break; } }
    }
    nloc = mine > 0u ? mine : 1u; nx = cnt > 0u ? cnt : 1u;
}

__device__ __forceinline__ void xcd_barrier(const XcdBarrier& b) {
    asm volatile("s_waitcnt vmcnt(0)" ::: "memory");
    __syncthreads();
    if (xb_t0(b.wv)) {
        unsigned* bar = b.bar;
        __builtin_amdgcn_s_waitcnt(0);
        unsigned nloc = b.st[0], nx = b.st[1];
        if (nloc == 0u) { xcd_barrier_complete(bar, b.x, nloc, nx); b.st[0] = nloc; b.st[1] = nx; }
        const unsigned old = xb_add(&bar[XB_XSUB(b.x)], 1u);
        const unsigned gen = old / nloc;
        if (old + 1u == (gen + 1u) * nloc) {
            __builtin_amdgcn_fence(__ATOMIC_RELEASE, "agent");
            asm volatile("s_waitcnt vmcnt(0)" ::: "memory");
            const unsigned og = xb_add(&bar[XB_TOP], 1u);
            const unsigned tg = og / nx;
            if (og + 1u == (tg + 1u) * nx) xb_add(&bar[XB_TOPGEN], 1u);
            else XB_SPIN(xb_ld(&bar[XB_TOPGEN]) == tg, bar);
            __builtin_amdgcn_fence(__ATOMIC_ACQUIRE, "agent");
            xb_add(&bar[XB_XGEN(b.x)], 1u);
            asm volatile("s_waitcnt vmcnt(0)" ::: "memory");
        } else {
            XB_SPIN(xb_ld(&bar[XB_XGEN(b.x)]) == gen, bar);
            __builtin_amdgcn_fence(__ATOMIC_ACQUIRE, "agent");
            asm volatile("s_waitcnt vmcnt(0)" ::: "memory");
        }
    }
    __syncthreads();
}

constexpr int RCH_NT = 0, RCH_RT = 2048, RCH_KST = 4096, RCH_TT = 4608, RCH_ART = 5120, RCH_KRT = 5632, RCH_VM = 6144, RCH_APT = 8192, RCH_KPT = 10240, RCH_GC = 12288, RCH_BYTES = 12544;

typedef short bf16x8 __attribute__((ext_vector_type(8)));
constexpr int RP_PITCH = 516, ACT_PITCH = 328;
__device__ __forceinline__ void rwkv_prep_item(KArgs a, int l, int item, LAS unsigned char* lds, int tid, int lane, int wave) {
    unsigned char* ws = a->ws;
    const bf16* U = (const bf16*)(ws + OFF_U); const float* MISC = (const float*)(ws + OFF_MISC);
    const int b = item / 144, j0 = (item % 144) * 16; const bool isctx = j0 < LCTX;
    LAS float* RP = (LAS float*)lds;
    LAS float* KP = RP + 16 * RP_PITCH; LAS float* VP = KP + 16 * RP_PITCH;
    LAS bf16* ACT = (LAS bf16*)(lds + 3 * 16 * RP_PITCH * 4);
    const float* mu = a->in[I_RMU] + l * 1856;
    bf16x8 wfr[10][4];
    { const bf16* WLT = (const bf16*)(ws + OFF_WLT) + (size_t)l * 512 * 320 + (size_t)(64 * wave + (lane & 15)) * 320 + (lane >> 4) * 8;
#pragma unroll
      for (int ks = 0; ks < 10; ++ks)
#pragma unroll
          for (int nt = 0; nt < 4; ++nt) wfr[ks][nt] = *(const bf16x8*)(WLT + (size_t)nt * 16 * 320 + ks * 32); }
#pragma unroll
    for (int it_ = 0; it_ < 6; ++it_) { const int idx = tid + it_ * NTHR; const int i = idx / 192, c8 = idx % 192, jj = j0 + i;
        const bool hp = isctx ? (jj - 1 >= 0) : (jj - 1 >= LCTX), hn = isctx ? (jj + 1 < LCTX) : (jj + 1 < RJ);
        const v4u c = *(const v4u*)(U + (size_t)rwkv_tok(b, jj) * NU + URKV + c8 * 8);
        v4u p = (v4u){0u, 0u, 0u, 0u}, n = p;
        if (hp) p = *(const v4u*)(U + (size_t)rwkv_tok(b, jj - 1) * NU + URKV + c8 * 8);
        if (hn) n = *(const v4u*)(U + (size_t)rwkv_tok(b, jj + 1) * NU + URKV + c8 * 8);
        const f32x4 m0 = *(const f32x4*)(mu + c8 * 8), m1 = *(const f32x4*)(mu + c8 * 8 + 4);
        f32x4 x0 = (f32x4){bflo(c.x), bfhi(c.x), bflo(c.y), bfhi(c.y)}, x1 = (f32x4){bflo(c.z), bfhi(c.z), bflo(c.w), bfhi(c.w)};
        const f32x4 s0 = (f32x4){bflo(p.x) + bflo(n.x), bfhi(p.x) + bfhi(n.x), bflo(p.y) + bflo(n.y), bfhi(p.y) + bfhi(n.y)}, s1 = (f32x4){bflo(p.z) + bflo(n.z), bfhi(p.z) + bfhi(n.z), bflo(p.w) + bflo(n.w), bfhi(p.w) + bfhi(n.w)};
        x0 = x0 + (0.5f * s0 - x0) * m0; x1 = x1 + (0.5f * s1 - x1) * m1;
        const int ch = c8 * 8, reg = ch >> 9; LAS float* dst = (reg == 0 ? RP : (reg == 1 ? KP : VP)) + i * RP_PITCH + (ch & 511);
        *(LAS f32x4*)dst = x0; *(LAS f32x4*)(dst + 4) = x1; }
#pragma unroll
    for (int it_ = 0; it_ < 3; ++it_) { const int idx = tid + it_ * NTHR; if (idx >= 16 * 80) break; const int i = idx / 80, c4 = idx % 80, jj = j0 + i;
        const bool hp = isctx ? (jj - 1 >= 0) : (jj - 1 >= LCTX), hn = isctx ? (jj + 1 < LCTX) : (jj + 1 < RJ);
        f32x4 x = *(const f32x4*)(MISC + (size_t)rwkv_tok(b, jj) * 512 + 64 + c4 * 4); f32x4 p = (f32x4){0.f, 0.f, 0.f, 0.f}, n = p;
        if (hp) p = *(const f32x4*)(MISC + (size_t)rwkv_tok(b, jj - 1) * 512 + 64 + c4 * 4);
        if (hn) n = *(const f32x4*)(MISC + (size_t)rwkv_tok(b, jj + 1) * 512 + 64 + c4 * 4);
        x = x + (0.5f * (p + n) - x) * *(const f32x4*)(mu + 1536 + c4 * 4);
        const int m = c4 * 4;
        if (m < 128) x = (f32x4){tanhf(x.x), tanhf(x.y), tanhf(x.z), tanhf(x.w)}; else if (m >= 192) x = (f32x4){sigmoidf_(x.x), sigmoidf_(x.y), sigmoidf_(x.z), sigmoidf_(x.w)};
        *(LAS v2u*)(ACT + i * ACT_PITCH + m) = (v2u){pk2(x.x, x.y), pk2(x.z, x.w)}; }
    __syncthreads();
    const int fr = lane & 15, fq = lane >> 4, h = wave;
    f32x4 acc[4][4];
#pragma unroll
    for (int o = 0; o < 4; ++o)
#pragma unroll
        for (int nt = 0; nt < 4; ++nt) acc[o][nt] = (f32x4){0.f, 0.f, 0.f, 0.f};
    {
#pragma unroll
        for (int ks = 0; ks < 10; ++ks) { const int o = ks < 2 ? 0 : (ks < 4 ? 1 : (ks < 6 ? 2 : 3));
            const bf16x8 af = *(const LAS bf16x8*)(ACT + fr * ACT_PITCH + ks * 32 + fq * 8);
#pragma unroll
            for (int nt = 0; nt < 4; ++nt) acc[o][nt] = __builtin_amdgcn_mfma_f32_16x16x32_bf16(af, wfr[ks][nt], acc[o][nt], 0, 0, 0); }
    }
    float* RW = (float*)(ws + OFF_RW); constexpr size_t AS = RW_ARR / 4; float* RSC = (float*)(ws + OFF_RSC);
    float w0f[4], w0b[4], a0c[4], kkc[4], kac[4], rkc[4];
#pragma unroll
    for (int nt = 0; nt < 4; ++nt) { const int c = 64 * wave + 16 * nt + fr; w0f[nt] = a->in[I_RW0][(l * 2 + 0) * 512 + c]; w0b[nt] = a->in[I_RW0][(l * 2 + 1) * 512 + c]; a0c[nt] = a->in[I_RA0][l * 512 + c];
        kkc[nt] = a->in[I_RKK][l * 512 + c]; kac[nt] = a->in[I_RKA][l * 512 + c]; rkc[nt] = a->in[I_RRK][l * 512 + c]; }
    float Wd[2][4][4], Rr[4][4], Km[4][4], Nn[4][4], Ka[4][4], Vv[4][4];
#pragma unroll
    for (int i = 0; i < 4; ++i) { const int tok = 4 * fq + i; const size_t R = (size_t)b * RJ + j0 + tok;
        float k[4], av[4], kkv[4]; float ss = 0.f;
#pragma unroll
        for (int nt = 0; nt < 4; ++nt) { const int c = 64 * wave + 16 * nt + fr; Rr[i][nt] = RP[tok * RP_PITCH + c]; k[nt] = KP[tok * RP_PITCH + c]; Vv[i][nt] = VP[tok * RP_PITCH + c];
            av[nt] = sigmoidf_(a0c[nt] + acc[2][nt][i]); kkv[nt] = k[nt] * kkc[nt]; ss += kkv[nt] * kkv[nt]; }
        const float rn = rsqrtf(row16_sum(ss) + 1e-12f);
        float bon = 0.f;
#pragma unroll
        for (int nt = 0; nt < 4; ++nt) { const int c = 64 * wave + 16 * nt + fr;
            Wd[0][i][nt] = __expf(-__expf(-softplusf_(-(w0f[nt] + acc[0][nt][i])) - 0.5f)); Wd[1][i][nt] = __expf(-__expf(-softplusf_(-(w0b[nt] + acc[1][nt][i])) - 0.5f));
            const float kk = kkv[nt] * rn; Km[i][nt] = k[nt] * (1.f + (av[nt] - 1.f) * kac[nt]); Ka[i][nt] = kk * av[nt]; Nn[i][nt] = -kk;
            bon += Rr[i][nt] * Km[i][nt] * rkc[nt];
            float* o = RW + R * 512 + c; o[7 * AS] = Vv[i][nt]; o[8 * AS] = acc[3][nt][i]; }
        bon = row16_sum(bon);
        if (fr == 0) RSC[(size_t)2 * TT * 8 + R * 8 + h] = bon;
    }
    __syncthreads();
    LAS unsigned char* wl_ = lds + wave * 14336;
    LAS bf16* NTl = (LAS bf16*)wl_; LAS bf16* RTl = NTl + 16 * 68; LAS bf16* ATl = RTl + 16 * 68; LAS bf16* KTl = ATl + 16 * 68;
    LAS float* ASl = (LAS float*)(wl_ + 8704);
    LAS float* TTl = (LAS float*)(wl_ + 11264);
    typedef short bf16x4 __attribute__((ext_vector_type(4)));
#pragma unroll
    for (int d = 0; d < 2; ++d) {
        const int cidx = d ? (isctx ? (240 - j0) / 16 : (2544 - j0) / 16) : j0 / 16;
        unsigned char* img = ws + OFF_RCH + ((size_t)((b * 2 + d) * 8 + h) * 144 + cidx) * RCH_BYTES;
        const int laneD = d ? ((3 - fq) * 16 + fr) : lane;
#pragma unroll
        for (int nt = 0; nt < 4; ++nt) {
            float gam[4], gpv[4], G, E;
            if (d == 0) { gam[0] = Wd[0][0][nt]; gam[1] = gam[0] * Wd[0][1][nt]; gam[2] = gam[1] * Wd[0][2][nt]; gam[3] = gam[2] * Wd[0][3][nt]; G = gam[3];
                const float g1 = __int_as_float(__builtin_amdgcn_ds_bpermute((lane - 16) << 2, __float_as_int(G))), g2 = __int_as_float(__builtin_amdgcn_ds_bpermute((lane - 32) << 2, __float_as_int(G))), g3 = __int_as_float(__builtin_amdgcn_ds_bpermute((lane - 48) << 2, __float_as_int(G)));
                E = (fq >= 1 ? g1 : 1.f) * (fq >= 2 ? g2 : 1.f) * (fq >= 3 ? g3 : 1.f);
                gpv[0] = E; gpv[1] = E * gam[0]; gpv[2] = E * gam[1]; gpv[3] = E * gam[2];
#pragma unroll
                for (int i = 0; i < 4; ++i) gam[i] *= E; }
            else { gam[3] = Wd[1][3][nt]; gam[2] = gam[3] * Wd[1][2][nt]; gam[1] = gam[2] * Wd[1][1][nt]; gam[0] = gam[1] * Wd[1][0][nt]; G = gam[0];
                const float g1 = __int_as_float(__builtin_amdgcn_ds_bpermute((lane + 16) << 2, __float_as_int(G))), g2 = __int_as_float(__builtin_amdgcn_ds_bpermute((lane + 32) << 2, __float_as_int(G))), g3 = __int_as_float(__builtin_amdgcn_ds_bpermute((lane + 48) << 2, __float_as_int(G)));
                E = (fq <= 2 ? g1 : 1.f) * (fq <= 1 ? g2 : 1.f) * (fq <= 0 ? g3 : 1.f);
                gpv[3] = E; gpv[2] = E * gam[3]; gpv[1] = E * gam[2]; gpv[0] = E * gam[1];
#pragma unroll
                for (int i = 0; i < 4; ++i) gam[i] *= E; }
            float tot = G * __int_as_float(__builtin_amdgcn_ds_bpermute((lane ^ 16) << 2, __float_as_int(G)));
            tot = tot * __int_as_float(__builtin_amdgcn_ds_bpermute((lane ^ 32) << 2, __float_as_int(tot)));
            float ap[4], kp[4];
#pragma unroll
            for (int i = 0; i < 4; ++i) { const int td = d ? 15 - (4 * fq + i) : 4 * fq + i; const float ig = __builtin_amdgcn_rcpf(gam[i]);
                const float at_ = Ka[i][nt] * ig, kt_ = Km[i][nt] * ig; ap[i] = at_ * tot; kp[i] = kt_ * tot;
                NTl[td * 68 + 16 * nt + fr] = bf1(gpv[i] * Nn[i][nt]); RTl[td * 68 + 16 * nt + fr] = bf1(gam[i] * Rr[i][nt]);
                ATl[td * 68 + 16 * nt + fr] = bf1(at_); KTl[td * 68 + 16 * nt + fr] = bf1(kt_); }
            v2u pa, pk, pv;
            if (d == 0) { pa = (v2u){pk2(ap[0], ap[1]), pk2(ap[2], ap[3])}; pk = (v2u){pk2(kp[0], kp[1]), pk2(kp[2], kp[3])}; pv = (v2u){pk2(Vv[0][nt], Vv[1][nt]), pk2(Vv[2][nt], Vv[3][nt])}; }
            else { pa = (v2u){pk2(ap[3], ap[2]), pk2(ap[1], ap[0])}; pk = (v2u){pk2(kp[3], kp[2]), pk2(kp[1], kp[0])}; pv = (v2u){pk2(Vv[3][nt], Vv[2][nt]), pk2(Vv[1][nt], Vv[0][nt])}; }
            *(v2u*)(img + RCH_APT + nt * 512 + laneD * 8) = pa; *(v2u*)(img + RCH_KPT + nt * 512 + laneD * 8) = pk; *(v2u*)(img + RCH_VM + nt * 512 + laneD * 8) = pv;
            if (fq == 0) *(float*)(img + RCH_GC + (16 * nt + fr) * 4) = tot;
        }
        LDS_WAIT();
#pragma unroll
        for (int kt = 0; kt < 4; ++kt) { *(v2u*)(img + RCH_NT + kt * 512 + lane * 8) = *(const LAS v2u*)(NTl + fr * 68 + 16 * kt + 4 * fq); *(v2u*)(img + RCH_RT + kt * 512 + lane * 8) = *(const LAS v2u*)(RTl + fr * 68 + 16 * kt + 4 * fq); }
        f32x4 cAs = (f32x4){0.f, 0.f, 0.f, 0.f}, cKs = cAs, cAr = cAs, cKr = cAs;
#pragma unroll
        for (int sk = 0; sk < 4; ++sk) { const bf16x4 aA = *(const LAS bf16x4*)(ATl + fr * 68 + 16 * sk + 4 * fq), aK = *(const LAS bf16x4*)(KTl + fr * 68 + 16 * sk + 4 * fq);
            const bf16x4 bN = *(const LAS bf16x4*)(NTl + fr * 68 + 16 * sk + 4 * fq), bR = *(const LAS bf16x4*)(RTl + fr * 68 + 16 * sk + 4 * fq);
            cAs = __builtin_amdgcn_mfma_f32_16x16x16bf16_1k(aA, bN, cAs, 0, 0, 0); cKs = __builtin_amdgcn_mfma_f32_16x16x16bf16_1k(aK, bN, cKs, 0, 0, 0);
            cAr = __builtin_amdgcn_mfma_f32_16x16x16bf16_1k(aA, bR, cAr, 0, 0, 0); cKr = __builtin_amdgcn_mfma_f32_16x16x16bf16_1k(aK, bR, cKr, 0, 0, 0); }
#pragma unroll
        for (int j = 0; j < 4; ++j) { const int ii = 4 * fq + j; if (!(ii < fr)) { cAs[j] = 0.f; cKs[j] = 0.f; } if (!(ii <= fr)) { cAr[j] = 0.f; cKr[j] = 0.f; } }
        *(v2u*)(img + RCH_KST + lane * 8) = (v2u){pk2(cKs[0], cKs[1]), pk2(cKs[2], cKs[3])}; *(v2u*)(img + RCH_ART + lane * 8) = (v2u){pk2(cAr[0], cAr[1]), pk2(cAr[2], cAr[3])};
        *(v2u*)(img + RCH_KRT + lane * 8) = (v2u){pk2(cKr[0], cKr[1]), pk2(cKr[2], cKr[3])};
        *(LAS f32x4*)(ASl + (d * 16 + fr) * 20 + 4 * fq) = cAs;
        LDS_WAIT();
    }
    if (lane < 32) { const int d = lane >> 4, irow = lane & 15; float Tc[16];
#pragma unroll
        for (int t = 0; t < 16; ++t) { float x = (irow == t) ? 1.f : 0.f;
#pragma unroll
            for (int j4 = 0; j4 < (t + 3) / 4; ++j4) { const f32x4 av = *(const LAS f32x4*)(ASl + (d * 16 + t) * 20 + 4 * j4);
#pragma unroll
                for (int e = 0; e < 4; ++e) if (4 * j4 + e < t) x += Tc[4 * j4 + e] * av[e]; }
            Tc[t] = x; TTl[(d * 16 + t) * 20 + irow] = x; } }
    LDS_WAIT();
#pragma unroll
    for (int d = 0; d < 2; ++d) { const int cidx = d ? (isctx ? (240 - j0) / 16 : (2544 - j0) / 16) : j0 / 16;
        unsigned char* img = ws + OFF_RCH + ((size_t)((b * 2 + d) * 8 + h) * 144 + cidx) * RCH_BYTES;
        const f32x4 tv = *(const LAS f32x4*)(TTl + (d * 16 + fr) * 20 + 4 * fq);
        *(v2u*)(img + RCH_TT + lane * 8) = (v2u){pk2(tv[0], tv[1]), pk2(tv[2], tv[3])}; }
    __syncthreads();
}
__device__ __forceinline__ void ssd_prep_item(KArgs a, int l, int item, int tid) {
    unsigned char* ws = a->ws; const bf16* U = (const bf16*)(ws + OFF_U); const float* MISC = (const float*)(ws + OFF_MISC);
    bf16* XBC = (bf16*)(ws + OFF_XBC); float* DTA = (float*)(ws + OFF_DTA);
    const int t0 = item * 16;
    const int seq_lo = t0 < TLAT ? (t0 & ~(LSEQ - 1)) : TLAT + ((t0 - TLAT) & ~(LCTX - 1)), seq_hi = seq_lo + (t0 < TLAT ? LSEQ : LCTX);
    for (int cp = tid; cp < 896; cp += NTHR) {
        float w0[5], w1[5];
#pragma unroll
        for (int j = 0; j < 5; ++j) { const f32x2 w = *(const f32x2*)(a->in[I_SCW] + (size_t)(l * 5 + j) * 1792 + 2 * cp); w0[j] = w.x; w1[j] = w.y; }
        const f32x2 bb = *(const f32x2*)(a->in[I_SCB] + l * 1792 + 2 * cp);
        float i0[20], i1[20];
#pragma unroll
        for (int r = 0; r < 20; ++r) { const int row = t0 - 2 + r; unsigned u = 0u; if (row >= seq_lo && row < seq_hi) u = *(const unsigned*)(U + (size_t)row * NU + UXBC + 2 * cp); i0[r] = bflo(u); i1[r] = bfhi(u); }
#pragma unroll
        for (int o = 0; o < 16; ++o) { float s0 = bb.x, s1 = bb.y;
#pragma unroll
            for (int j = 0; j < 5; ++j) { s0 += w0[j] * i0[o + j]; s1 += w1[j] * i1[o + j]; }
            *(unsigned*)(XBC + (size_t)(t0 + o) * 1792 + 2 * cp) = pk2(siluf_(s0), siluf_(s1)); }
    }
    if (tid < 16 * 24) { const int o = tid / 24, q = tid % 24;
        const float dt = softplusf_(MISC[(size_t)(t0 + o) * 512 + q] + a->in[I_SDTB][l * 24 + q]); const float A = -__expf(a->in[I_SALOG][l * 24 + q]);
        DTA[(size_t)(t0 + o) * 48 + q] = dt; DTA[(size_t)(t0 + o) * 48 + 24 + q] = dt * A; }
}
__device__ __forceinline__ void conv_item(KArgs a, int l, int item, LAS unsigned char* lds, int tid, int lane, int wave) {
    unsigned char* ws = a->ws; const bf16* U = (const bf16*)(ws + OFF_U); bf16* AC = (bf16*)(ws + OFF_ACAT) + AC_CONV;
    int t0, seg_lo, seg_hi;
    if (item < 256) { t0 = item * 32; seg_lo = t0 & ~63; seg_hi = seg_lo + 64; }
    else { const int ci = item - 256; t0 = TLAT + ci * 32; seg_lo = TLAT + (ci >> 3) * LCTX; seg_hi = seg_lo + LCTX; }
    LAS bf16* inimg = (LAS bf16*)lds;
    LAS float* outimg = (LAS float*)(lds + 63488);
    v4u cva[8], cvg[8];
#pragma unroll
    for (int it_ = 0; it_ < 8; ++it_) { const int idx = tid + it_ * NTHR; const int rr = idx >> 6, c8 = idx & 63, row = t0 - 15 + rr; cva[it_] = (v4u){0u, 0u, 0u, 0u}; cvg[it_] = cva[it_];
        if (idx < 62 * 64 && row >= seg_lo && row < seg_hi) { cva[it_] = *(const v4u*)(U + (size_t)row * NU + UCONV + c8 * 8); cvg[it_] = *(const v4u*)(U + (size_t)row * NU + UCONV + 512 + c8 * 8); } }
#pragma unroll
    for (int it_ = 0; it_ < 8; ++it_) { const int idx = tid + it_ * NTHR; if (idx >= 62 * 64) break; const int rr = idx >> 6, c8 = idx & 63, row = t0 - 15 + rr;
        v4u o = (v4u){0u, 0u, 0u, 0u};
        if (row >= seg_lo && row < seg_hi) { const v4u va = cva[it_], vg = cvg[it_];
            o.x = pk2(bflo(va.x) * sigmoidf_(bflo(vg.x)), bfhi(va.x) * sigmoidf_(bfhi(vg.x))); o.y = pk2(bflo(va.y) * sigmoidf_(bflo(vg.y)), bfhi(va.y) * sigmoidf_(bfhi(vg.y)));
            o.z = pk2(bflo(va.z) * sigmoidf_(bflo(vg.z)), bfhi(va.z) * sigmoidf_(bfhi(vg.z))); o.w = pk2(bflo(va.w) * sigmoidf_(bflo(vg.w)), bfhi(va.w) * sigmoidf_(bfhi(vg.w))); }
        *(LAS v4u*)(inimg + rr * 512 + c8 * 8) = o; }
    __syncthreads();
    {
        const int cp = tid & 255, th = tid >> 8;
        f32x2 w[31];
#pragma unroll
        for (int j = 0; j < 31; ++j) w[j] = *(const f32x2*)(a->in[I_CONVW] + (size_t)(l * 31 + j) * 512 + 2 * cp);
        const f32x2 bias = *(const f32x2*)(a->in[I_CONVB] + l * 512 + 2 * cp);
        f32x2 o[16];
#pragma unroll
        for (int q = 0; q < 16; ++q) o[q] = bias;
        const LAS unsigned* ip = (const LAS unsigned*)(inimg + (16 * th) * 512 + 2 * cp);
#pragma unroll
        for (int r = 0; r < 46; ++r) { const unsigned u = ip[r * 256]; const f32x2 v = (f32x2){bflo(u), bfhi(u)};
#pragma unroll
            for (int q = 0; q < 16; ++q) if (r - q >= 0 && r - q < 31) o[q] += w[r - q] * v; }
#pragma unroll
        for (int q = 0; q < 16; ++q) *(LAS f32x2*)(outimg + (16 * th + q) * 512 + 2 * cp) = o[q];
    }
    __syncthreads();
    {
        const f32x4 g0 = *(const f32x4*)(a->in[I_CLNG] + l * 512 + 8 * lane), g1 = *(const f32x4*)(a->in[I_CLNG] + l * 512 + 8 * lane + 4);
        const f32x4 b0 = *(const f32x4*)(a->in[I_CLNB] + l * 512 + 8 * lane), b1 = *(const f32x4*)(a->in[I_CLNB] + l * 512 + 8 * lane + 4);
#pragma unroll
        for (int q = 0; q < 4; ++q) { const int o = wave * 4 + q;
            f32x4 x0 = *(const LAS f32x4*)(outimg + o * 512 + 8 * lane), x1 = *(const LAS f32x4*)(outimg + o * 512 + 8 * lane + 4);
            const float mean = wave_sum((x0.x + x0.y + x0.z + x0.w) + (x1.x + x1.y + x1.z + x1.w)) * (1.f / 512.f);
            x0 = x0 - mean; x1 = x1 - mean;
            const float var = wave_sum((x0.x * x0.x + x0.y * x0.y + x0.z * x0.z + x0.w * x0.w) + (x1.x * x1.x + x1.y * x1.y + x1.z * x1.z + x1.w * x1.w)) * (1.f / 512.f);
            const float rs = rsqrtf(var + 1e-5f);
            x0 = x0 * rs * g0 + b0; x1 = x1 * rs * g1 + b1;
            v4u ov; ov.x = pk2(siluf_(x0.x), siluf_(x0.y)); ov.y = pk2(siluf_(x0.z), siluf_(x0.w)); ov.z = pk2(siluf_(x1.x), siluf_(x1.y)); ov.w = pk2(siluf_(x1.z), siluf_(x1.w));
            *(v4u*)(AC + (size_t)(t0 + o) * ACW + 8 * lane) = ov; }
    }
    __syncthreads();
}

__device__ __forceinline__ int ssd_tok(int b, int dir, int pos) {
    if (pos < LCTX) return TLAT + b * LCTX + (dir ? (LCTX - 1 - pos) : pos);
    const int q = pos - LCTX; return b * LSEQ + (dir ? (LSEQ - 1 - q) : q);
}
__device__ __forceinline__ void post_phase(KArgs a, int l, int bid, int G, const int wave0) {
    PH_IDS
    unsigned char* ws = a->ws; const int gw = bid * NWAVES + wave, NGW = G * NWAVES;
    const bf16* U = (const bf16*)(ws + OFF_U); const bf16* XBC = (const bf16*)(ws + OFF_XBC);
    const float* Y0 = (const float*)(ws + OFF_YSSD); const float* Y1 = Y0 + (size_t)TT * 768; bf16* AS_ = (bf16*)(ws + OFF_ACAT) + AC_SSD;
    {
        f32x4 nyf[3], nyb[3]; v2u nxs[3], nz[3];
        auto fetch = [&](int row) {
#pragma unroll
            for (int j = 0; j < 3; ++j) { const int col = 4 * lane + 256 * j;
                nyf[j] = *(const f32x4*)(Y0 + (size_t)row * 768 + col); nyb[j] = *(const f32x4*)(Y1 + (size_t)row * 768 + col);
                nxs[j] = *(const v2u*)(XBC + (size_t)row * 1792 + col); nz[j] = *(const v2u*)(U + (size_t)row * NU + UZ + col); } };
        f32x4 gn[3]; float dsk[3];
#pragma unroll
        for (int j = 0; j < 3; ++j) { const int col = 4 * lane + 256 * j; gn[j] = *(const f32x4*)(a->in[I_SNG] + l * 768 + col); dsk[j] = a->in[I_SD][l * 12 + (col >> 6)]; }
        if (gw < TT) fetch(gw);
        for (int row = gw; row < TT; row += NGW) {
            f32x4 y[3]; float ss = 0.f;
#pragma unroll
            for (int j = 0; j < 3; ++j) { const v2u xs = nxs[j], z = nz[j];
                f32x4 v = nyf[j] + nyb[j] + dsk[j] * (f32x4){bflo(xs.x), bfhi(xs.x), bflo(xs.y), bfhi(xs.y)};
                v = v * (f32x4){siluf_(bflo(z.x)), siluf_(bfhi(z.x)), siluf_(bflo(z.y)), siluf_(bfhi(z.y))};
                y[j] = v; ss += (v.x * v.x + v.y * v.y) + (v.z * v.z + v.w * v.w); }
            if (row + NGW < TT) fetch(row + NGW);
            const float r = rsqrtf(wave_sum(ss) * (1.f / 768.f) + 1e-6f);
#pragma unroll
            for (int j = 0; j < 3; ++j) { const int col = 4 * lane + 256 * j; const f32x4 o = y[j] * r * gn[j];
                *(v2u*)(AS_ + (size_t)row * ACW + col) = (v2u){pk2(o.x, o.y), pk2(o.z, o.w)}; }
        }
    }
    const float* RW = (const float*)(ws + OFF_RW); constexpr size_t AS = RW_ARR / 4; const float* RSC = (const float*)(ws + OFF_RSC);
    const float* R0 = (const float*)(ws + OFF_YRW); const float* R1 = R0 + (size_t)TT * 512; bf16* AR = (bf16*)(ws + OFF_ACAT) + AC_RWKV;
    {
        const int c0 = 8 * lane, h = lane >> 3;
        const f32x4 lg0 = *(const f32x4*)(a->in[I_RLNG] + l * 512 + c0), lg1 = *(const f32x4*)(a->in[I_RLNG] + l * 512 + c0 + 4), lb0 = *(const f32x4*)(a->in[I_RLNB] + l * 512 + c0), lb1 = *(const f32x4*)(a->in[I_RLNB] + l * 512 + c0 + 4);
        f32x4 n0a, n0b, n1a, n1b, nv0, nv1, ng0, ng1; float nbon = 0.f;
        auto rowR = [&](int row) -> size_t { if (row < TLAT) { const int b = row >> 11, t = row & 2047, rr = t >> 6, cc = t & 63; return (size_t)b * RJ + LCTX + cc * 32 + rr; }
            const int b = (row - TLAT) >> 8, jj = (row - TLAT) & 255; return (size_t)b * RJ + jj; };
        auto fetch = [&](int row) { const size_t R = rowR(row);
            n0a = *(const f32x4*)(R0 + R * 512 + c0); n0b = *(const f32x4*)(R0 + R * 512 + c0 + 4); n1a = *(const f32x4*)(R1 + R * 512 + c0); n1b = *(const f32x4*)(R1 + R * 512 + c0 + 4);
            nv0 = *(const f32x4*)(RW + 7 * AS + R * 512 + c0); nv1 = *(const f32x4*)(RW + 7 * AS + R * 512 + c0 + 4); ng0 = *(const f32x4*)(RW + 8 * AS + R * 512 + c0); ng1 = *(const f32x4*)(RW + 8 * AS + R * 512 + c0 + 4);
            nbon = RSC[(size_t)2 * TT * 8 + R * 8 + h]; };
        if (gw < TT) fetch(gw);
        for (int row = gw; row < TT; row += NGW) {
            f32x4 ya = n0a + n1a, yb = n0b + n1b; const f32x4 v0 = nv0, v1 = nv1, g0 = ng0, g1 = ng1; const float bon = nbon;
            if (row + NGW < TT) fetch(row + NGW);
            float s = (ya.x + ya.y + ya.z + ya.w) + (yb.x + yb.y + yb.z + yb.w);
            s = sum8(s);
            const float mean = s * (1.f / 64.f); ya = ya - mean; yb = yb - mean;
            float q = (ya.x * ya.x + ya.y * ya.y + ya.z * ya.z + ya.w * ya.w) + (yb.x * yb.x + yb.y * yb.y + yb.z * yb.z + yb.w * yb.w);
            q = sum8(q);
            const float rs = rsqrtf(q * (1.f / 64.f) + 64e-5f);
            const f32x4 o0 = (ya * rs * lg0 + lb0 + bon * v0) * g0, o1 = (yb * rs * lg1 + lb1 + bon * v1) * g1;
            *(v4u*)(AR + (size_t)row * ACW + c0) = (v4u){pk2(o0.x, o0.y), pk2(o0.z, o0.w), pk2(o1.x, o1.y), pk2(o1.z, o1.w)};
        }
    }
}

__device__ __forceinline__ size_t rwkv_row(int b, int dir, int pos) { const int j = dir ? (pos < LCTX ? (LCTX - 1 - pos) : (RJ + LCTX - 1 - pos)) : pos; return (size_t)b * RJ + j; }
struct RchOps { v2u nt[4], rt[4], kst, tt, art, krt, vm, apt[4], kpt[4]; f32x4 gc[4]; };
__device__ __forceinline__ void rwkv_scan_chunk(KArgs a, int idx, LAS unsigned char* lds, int tid, int lane, int wave) {
    typedef short bf16x4 __attribute__((ext_vector_type(4)));
    unsigned char* ws = a->ws;
    const int b = idx >> 4, dir = (idx >> 3) & 1, h = idx & 7, fr = lane & 15, fq = lane >> 4;
    float* Yo = (float*)(ws + OFF_YRW) + (size_t)dir * TT * 512;
    const unsigned char* base = ws + OFF_RCH + (size_t)((b * 2 + dir) * 8 + h) * 144 * RCH_BYTES;
    constexpr int BLK = 4 * RCH_BYTES;
    const int lt = tid - 256;
    v4u pre[13];
    auto issue = [&](int blk) { const v4u* src = (const v4u*)(base + (size_t)blk * BLK);
#pragma unroll
        for (int i = 0; i < 13; ++i) { const int e = lt + i * 256; if (e < BLK / 16) pre[i] = src[e]; } };
    auto commit = [&](int buf) { LAS v4u* dst = (LAS v4u*)(lds + buf * BLK);
#pragma unroll
        for (int i = 0; i < 13; ++i) { const int e = lt + i * 256; if (e < BLK / 16) dst[e] = pre[i]; } };
    auto ld = [&](const LAS unsigned char* p0, int wv) { RchOps o; const LAS unsigned char* p = p0 + lane * 8;
#pragma unroll
        for (int kt = 0; kt < 4; ++kt) { o.nt[kt] = *(const LAS v2u*)(p + RCH_NT + kt * 512); o.rt[kt] = *(const LAS v2u*)(p + RCH_RT + kt * 512); o.apt[kt] = *(const LAS v2u*)(p + RCH_APT + kt * 512); o.kpt[kt] = *(const LAS v2u*)(p + RCH_KPT + kt * 512);
            o.gc[kt] = *(const LAS f32x4*)(p0 + RCH_GC + (16 * kt + 4 * fq) * 4); }
        o.kst = *(const LAS v2u*)(p + RCH_KST); o.tt = *(const LAS v2u*)(p + RCH_TT); o.art = *(const LAS v2u*)(p + RCH_ART); o.krt = *(const LAS v2u*)(p + RCH_KRT); o.vm = *(const LAS v2u*)(p + RCH_VM + wv * 512); return o; };
#define MF16(A_, B_, C_) __builtin_amdgcn_mfma_f32_16x16x16bf16_1k(__builtin_bit_cast(bf16x4, A_), __builtin_bit_cast(bf16x4, B_), C_, 0, 0, 0)
    f32x4 S[4];
#pragma unroll
    for (int kt = 0; kt < 4; ++kt) S[kt] = (f32x4){0.f, 0.f, 0.f, 0.f};
    auto step = [&](const RchOps& cur, int c) {
        v2u Sb[4];
#pragma unroll
        for (int kt = 0; kt < 4; ++kt) Sb[kt] = (v2u){pk2(S[kt][0], S[kt][1]), pk2(S[kt][2], S[kt][3])};
        f32x4 rhs = (f32x4){0.f, 0.f, 0.f, 0.f}, y = rhs;
#pragma unroll
        for (int kt = 0; kt < 4; ++kt) rhs = MF16(cur.nt[kt], Sb[kt], rhs);
        rhs = MF16(cur.kst, cur.vm, rhs);
        const v2u rb = (v2u){pk2(rhs[0], rhs[1]), pk2(rhs[2], rhs[3])};
        const f32x4 u = MF16(cur.tt, rb, ((f32x4){0.f, 0.f, 0.f, 0.f}));
        const v2u ub = (v2u){pk2(u[0], u[1]), pk2(u[2], u[3])};
#pragma unroll
        for (int kt = 0; kt < 4; ++kt) { S[kt] = S[kt] * cur.gc[kt]; S[kt] = MF16(cur.apt[kt], ub, S[kt]); S[kt] = MF16(cur.kpt[kt], cur.vm, S[kt]); }
#pragma unroll
        for (int kt = 0; kt < 4; ++kt) y = MF16(cur.rt[kt], Sb[kt], y);
        y = MF16(cur.art, ub, y); y = MF16(cur.krt, cur.vm, y);
#pragma unroll
        for (int j = 0; j < 4; ++j) { const size_t R = rwkv_row(b, dir, c * 16 + 4 * fq + j); Yo[R * 512 + h * 64 + 16 * wave + fr] = y[j]; }
    };
    if (wave >= 4) { issue(0); commit(0); }
    __syncthreads();
    for (int blk = 0; blk < 36; ++blk) {
        if (wave >= 4) { if (blk + 1 < 36) issue(blk + 1); }
        else { const LAS unsigned char* B = lds + (blk & 1) * BLK;
            RchOps o0 = ld(B, wave), o1 = ld(B + RCH_BYTES, wave);
            step(o0, blk * 4 + 0); o0 = ld(B + 2 * RCH_BYTES, wave);
            step(o1, blk * 4 + 1); o1 = ld(B + 3 * RCH_BYTES, wave);
            step(o0, blk * 4 + 2);
            step(o1, blk * 4 + 3); }
        if (wave >= 4 && blk + 1 < 36) commit((blk + 1) & 1);
        __syncthreads();
    }
#undef MF16
}

constexpr int SS_CM = 0, SS_BM = 17408, SS_BST = 34816, SS_XT = 53248, SS_MX = 62464, SS_HB = 71680, SS_CS = 89088, SS_DT = 89344;
__device__ __forceinline__ float bfe(const v4u& v, int i) { const unsigned u = (i < 2) ? v.x : (i < 4) ? v.y : (i < 6) ? v.z : v.w; return (i & 1) ? bfhi(u) : bflo(u); }
__device__ __forceinline__ unsigned short bfraw(const v4u& v, int i) { const unsigned u = (i < 2) ? v.x : (i < 4) ? v.y : (i < 6) ? v.z : v.w; return (unsigned short)((i & 1) ? (u >> 16) : (u & 0xffffu)); }
__device__ __forceinline__ void ssd_scan_fast(KArgs a, int idx, LAS unsigned char* lds, int tid, int lane, int wave) {
    unsigned char* ws = a->ws; const bf16* XBC = (const bf16*)(ws + OFF_XBC); const float* DTA = (const float*)(ws + OFF_DTA);
    const int b = idx / 24, dir = (idx % 24) / 12, h = idx % 12, g = h / 3, q = dir * 12 + h;
    float* Yo = (float*)(ws + OFF_YSSD) + (size_t)dir * TT * 768;
    LAS bf16* Cm = (LAS bf16*)(lds + SS_CM); LAS bf16* Bm = (LAS bf16*)(lds + SS_BM); LAS bf16* BsT = (LAS bf16*)(lds + SS_BST); LAS bf16* XT = (LAS bf16*)(lds + SS_XT);
    LAS bf16* Mx = (LAS bf16*)(lds + SS_MX); LAS bf16* Hb = (LAS bf16*)(lds + SS_HB); LAS float* CS = (LAS float*)(lds + SS_CS); LAS float* DTV = (LAS float*)(lds + SS_DT);
    const int fr = lane & 15, fq = lane >> 4, ss = tid & 63, sc = tid >> 6, tl = wave >> 1, wh = wave & 1;
    { unsigned z = 0u; asm volatile("" : "+v"(z)); for (int i = tid; i < 17408 / 16; i += NTHR) *(LAS v4u*)(lds + SS_HB + i * 16) = (v4u){z, z, z, z}; }
    f32x4 hacc[4];
#pragma unroll
    for (int j = 0; j < 4; ++j) hacc[j] = (f32x4){0.f, 0.f, 0.f, 0.f};
    v4u pc0, pc1, pb0, pb1, px; float pdt = 0.f, pa = 0.f;
    auto issue = [&](int ch) {
        const int tok = ssd_tok(b, dir, ch * 64 + ss); const bf16* row = XBC + (size_t)tok * 1792;
        pc0 = *(const v4u*)(row + 1280 + g * 128 + sc * 8); pc1 = *(const v4u*)(row + 1280 + g * 128 + (sc + 8) * 8);
        pb0 = *(const v4u*)(row + 768 + g * 128 + sc * 8); pb1 = *(const v4u*)(row + 768 + g * 128 + (sc + 8) * 8);
        px = *(const v4u*)(row + h * 64 + sc * 8);
        if (tid < 64) { pdt = DTA[(size_t)tok * 48 + q]; pa = DTA[(size_t)tok * 48 + 24 + q]; }
    };
    issue(0);
    for (int ch = 0; ch < RJ / 64; ++ch) {
        *(LAS v4u*)(Cm + ss * 136 + sc * 8) = pc0; *(LAS v4u*)(Cm + ss * 136 + (sc + 8) * 8) = pc1;
        *(LAS v4u*)(Bm + ss * 136 + sc * 8) = pb0; *(LAS v4u*)(Bm + ss * 136 + (sc + 8) * 8) = pb1;
#pragma unroll
        for (int i = 0; i < 8; ++i) XT[(sc * 8 + i) * 72 + ss] = bfraw(px, i);
        if (tid < 64) { float x = pa;
            x += __int_as_float(__builtin_amdgcn_update_dpp(0, __float_as_int(x), 0x111, 0xf, 0xf, false)); x += __int_as_float(__builtin_amdgcn_update_dpp(0, __float_as_int(x), 0x112, 0xf, 0xf, false));
            x += __int_as_float(__builtin_amdgcn_update_dpp(0, __float_as_int(x), 0x114, 0xf, 0xf, false)); x += __int_as_float(__builtin_amdgcn_update_dpp(0, __float_as_int(x), 0x118, 0xf, 0xf, false));
            x += __int_as_float(__builtin_amdgcn_update_dpp(0, __float_as_int(x), 0x142, 0xa, 0xf, false)); x += __int_as_float(__builtin_amdgcn_update_dpp(0, __float_as_int(x), 0x143, 0xc, 0xf, false));
            CS[tid] = x; DTV[tid] = pdt; }
        __syncthreads();
        const float cl = CS[63];
        { const float scl = DTV[ss] * __expf(cl - CS[ss]);
#pragma unroll
            for (int i = 0; i < 8; ++i) { BsT[(sc * 8 + i) * 72 + ss] = bf1(bfe(pb0, i) * scl); BsT[((sc + 8) * 8 + i) * 72 + ss] = bf1(bfe(pb1, i) * scl); } }
        if (ch + 1 < RJ / 64) issue(ch + 1);
        bf16x8 cf[4];
#pragma unroll
        for (int ks = 0; ks < 4; ++ks) cf[ks] = *(const LAS bf16x8*)(Cm + (16 * tl + fr) * 136 + ks * 32 + fq * 8);
#pragma unroll
        for (int j = 0; j < 2; ++j) { const int tc = wh * 2 + j; f32x4 acc = (f32x4){0.f, 0.f, 0.f, 0.f};
            if (tc <= tl) {
#pragma unroll
                for (int ks = 0; ks < 4; ++ks) { const bf16x8 bf = *(const LAS bf16x8*)(Bm + (16 * tc + fr) * 136 + ks * 32 + fq * 8);
                    acc = __builtin_amdgcn_mfma_f32_16x16x32_bf16(cf[ks], bf, acc, 0, 0, 0); } }
            const int s = 16 * tc + fr; const float css = CS[s], dts = DTV[s];
#pragma unroll
            for (int i = 0; i < 4; ++i) { const int l = 16 * tl + 4 * fq + i; const float v = (s <= l) ? acc[i] * __expf(CS[l] - css) * dts : 0.f; Mx[l * 72 + s] = bf1(v); } }
        __syncthreads();
        bf16x8 mf[2], xf[2];
#pragma unroll
        for (int ks = 0; ks < 2; ++ks) { mf[ks] = *(const LAS bf16x8*)(Mx + (16 * tl + fr) * 72 + ks * 32 + fq * 8); xf[ks] = *(const LAS bf16x8*)(XT + (16 * tl + fr) * 72 + ks * 32 + fq * 8); }
#pragma unroll
        for (int j = 0; j < 2; ++j) { const int tp = wh * 2 + j; f32x4 acc = (f32x4){0.f, 0.f, 0.f, 0.f};
#pragma unroll
            for (int ks = 0; ks < 4; ++ks) { const bf16x8 bf = *(const LAS bf16x8*)(Hb + (16 * tp + fr) * 136 + ks * 32 + fq * 8);
                acc = __builtin_amdgcn_mfma_f32_16x16x32_bf16(cf[ks], bf, acc, 0, 0, 0); }
#pragma unroll
            for (int i = 0; i < 4; ++i) acc[i] *= __expf(CS[16 * tl + 4 * fq + i]);
#pragma unroll
            for (int ks = 0; ks < 2; ++ks) { const bf16x8 bf = *(const LAS bf16x8*)(XT + (16 * tp + fr) * 72 + ks * 32 + fq * 8);
                acc = __builtin_amdgcn_mfma_f32_16x16x32_bf16(mf[ks], bf, acc, 0, 0, 0); }
#pragma unroll
            for (int i = 0; i < 4; ++i) { const int tok = ssd_tok(b, dir, ch * 64 + 16 * tl + 4 * fq + i); Yo[(size_t)tok * 768 + h * 64 + 16 * tp + fr] = acc[i]; } }
        { const float ecl = __expf(cl);
#pragma unroll
            for (int j = 0; j < 4; ++j) { const int tn = wh * 4 + j; hacc[j] = hacc[j] * ecl;
#pragma unroll
                for (int ks = 0; ks < 2; ++ks) { const bf16x8 bf = *(const LAS bf16x8*)(BsT + (16 * tn + fr) * 72 + ks * 32 + fq * 8);
                    hacc[j] = __builtin_amdgcn_mfma_f32_16x16x32_bf16(xf[ks], bf, hacc[j], 0, 0, 0); } } }
        __syncthreads();
#pragma unroll
        for (int j = 0; j < 4; ++j) { const int tn = wh * 4 + j;
#pragma unroll
            for (int i = 0; i < 4; ++i) Hb[(16 * tl + 4 * fq + i) * 136 + 16 * tn + fr] = bf1(hacc[j][i]); }
    }
}

constexpr int NPH = 2 + 10 * DEPTH;
#ifndef PROBE_MASK
#define PROBE_MASK 0
#endif
#ifndef PROBE_P0
#define PROBE_P0 0
#endif
#ifndef PROBE_SUB
#define PROBE_SUB 0
#endif
#ifndef PROBE_REPS
#define PROBE_REPS 3
#endif
#define REPS(k) (((PROBE_MASK >> (k)) & 1) ? PROBE_REPS : 1)
constexpr int GATE_LATE = 23;
constexpr int GATE_X = 288, GATE_Z = 192, GATE_STATIC = 576;
constexpr int CW_GQ = 16384;
#ifndef MK_ONE_LAUNCH
#define MK_ONE_LAUNCH 1
#endif

__global__ void __launch_bounds__(NTHR, 2) fwd(Args a_unused) {
    extern __shared__ __attribute__((aligned(16))) unsigned char lds_raw[];
    LAS unsigned char* lds = (LAS unsigned char*)lds_raw;
    const int bid0 = blockIdx.x, G0 = gridDim.x, wave0 = __builtin_amdgcn_readfirstlane(threadIdx.x >> 6);
#define PH_BG int bid = bid0, G = G0; asm volatile("" : "+s"(bid), "+s"(G));
    volatile LAS unsigned* MISCW = (volatile LAS unsigned*)(lds + MISC_OFF);
    if (threadIdx.x < 32) MISCW[threadIdx.x] = 0u;
    __syncthreads();
    const int ph_lo = kargs()->ph_lo, ph_hi = kargs()->ph_hi;
    const bool multi = (ph_hi - ph_lo) > 1;
    XcdBarrier bar; bar.bar = (unsigned*)(kargs()->ws + OFF_CTL) + CW_BAR; bar.x = 0; bar.st = nullptr; bar.wv = wave0;
    if (multi) bar = xcd_barrier_post((unsigned*)(kargs()->ws + OFF_CTL) + CW_BAR, MISCW + 8, wave0);
#define IN(k) (ph_lo <= (k) && (k) < ph_hi)
#define SEAM(k) do { if (IN(k) && IN((k) + 1)) xcd_barrier(bar); } while (0)

    for (int rep = 0; rep < (PROBE_P0 ? PROBE_REPS : 1); ++rep) {
    if (IN(0)) { PH_BG p0_prologue(kargs(), lds, bid, G, wave0, rep == 0 ? 15 : PROBE_SUB); }
    if (rep + 1 < (PROBE_P0 ? PROBE_REPS : 1)) xcd_barrier(bar); }
    SEAM(0);
    if (IN(1)) { PH_BG KArgs a = kargs(); norm_phase(a, 0, nullptr, a->in[I_NORMG] + 0, nullptr, (const float*)(a->ws + OFF_MODV), bid, G, wave0, TT, false, false, true); }
    SEAM(1);

    for (int l = 0; l < DEPTH; ++l) {
        const int pb = 2 + 10 * l;
#define PH_LOCALS PH_BG KArgs a = kargs(); unsigned char* ws = a->ws; unsigned char* wl = ws + OFF_W + (size_t)l * W_LAYER; bf16* Hb = (bf16*)(ws + OFF_H); (void)wl; (void)Hb; \
        const float* ng = a->in[I_NORMG] + (size_t)l * 4 * DM; const float* mv = (const float*)(ws + OFF_MODV) + (size_t)l * 5 * 12288; (void)ng; (void)mv;
        const bool lastl = (l == DEPTH - 1);
        for (int rep = 0; rep < REPS(0); ++rep) {
        if (IN(pb + 0)) { PH_LOCALS
            __syncthreads();
            pg8::Sched2 S; S.A0 = (const char*)Hb; S.B0 = (const char*)(wl + WO_IN); S.A1 = (const char*)(wl + WO_FFT); S.B1 = (const char*)Hb; S.tstep = (size_t)256 * DM * 2; S.ntk = DM / 64;
            S.t0.init(TT / 256, NU / 256 - GATE_LATE); S.t1.init(4, TT / 256); S.G = G; S.c = bid; S.spread = 1;
            pg8::EpiIn2 E{pg8::EpiInproj{(bf16*)(ws + OFF_U), (float*)(ws + OFF_MISC), NU}, pg8::EpiBf{0, (bf16*)(ws + OFF_VTL), (bf16*)(ws + OFF_VTC)}};
            pg8::gemm_phase<pg8::EpiIn2, pg8::Sched2, true, true>(lds, DM, S, E, wave0);
        }
        if (rep + 1 < REPS(0)) xcd_barrier(bar); }
        SEAM(pb + 0);
        for (int rep = 0; rep < REPS(1); ++rep) {
        if (IN(pb + 1)) { PH_LOCALS PH_IDS
            __syncthreads();
            if (rep == 0 || PROBE_SUB == 3 || PROBE_SUB == 7) {
            if (bid < 64) { pg8::Sched2 S; S.A0 = (const char*)(ws + OFF_DFTL); S.B0 = (const char*)(ws + OFF_VTL); S.A1 = S.A0; S.B1 = S.B0; S.tstep = (size_t)256 * 4096 * 2; S.ntk = 64; S.t0.init(8, 8); S.t1.init(0, 0); S.G = 64; S.c = bid;
                  pg8::EpiBf E{1, (bf16*)(ws + OFF_ACAT), nullptr};
                  pg8::gemm_phase<pg8::EpiBf, pg8::Sched2, true, true>(lds, 4096, S, E, wave0); }
            else if (bid < 72) { pg8::Sched2 S; S.A0 = (const char*)(ws + OFF_DFTC); S.B0 = (const char*)(ws + OFF_VTC); S.A1 = S.A0; S.B1 = S.B0; S.tstep = (size_t)256 * 512 * 2; S.ntk = 8; S.t0.init(1, 8); S.t1.init(0, 0); S.G = 8; S.c = bid - 64;
                  pg8::EpiBf E{2, (bf16*)(ws + OFF_ACAT), nullptr};
                  pg8::gemm_phase<pg8::EpiBf, pg8::Sched2, true, true>(lds, 512, S, E, wave0); }
            else if (bid < 72 + 4 * GATE_LATE && !lastl) {
                pg8::Sched2 S; S.A0 = (const char*)Hb; S.B0 = (const char*)(wl + WO_IN); S.A1 = S.A0; S.B1 = S.B0; S.tstep = (size_t)256 * DM * 2; S.ntk = DM / 64;
                S.t0.init(TCTX / 256, GATE_LATE); S.t1.init(0, 0); S.pm_off0 = TLAT / 256; S.pn_off0 = NU / 256 - GATE_LATE; S.G = 4 * GATE_LATE; S.c = bid - 72;
                pg8::EpiIn2 E{pg8::EpiInproj{(bf16*)(ws + OFF_U), (float*)(ws + OFF_MISC), NU}, pg8::EpiBf{0, (bf16*)(ws + OFF_VTL), (bf16*)(ws + OFF_VTC)}};
                pg8::gemm_phase<pg8::EpiIn2, pg8::Sched2, true, true>(lds, DM, S, E, wave0); }
            }
            __syncthreads();
            {
                unsigned* qctr = (unsigned*)(ws + OFF_CTL) + CW_Q + (l * 4 + rep) * 64;
                volatile LAS unsigned* qslot = (volatile LAS unsigned*)(lds + MISC_OFF) + 16;
                unsigned qnext = 0u; if (tid == 0) qnext = __hip_atomic_fetch_add(qctr, 1u, __ATOMIC_RELAXED, __HIP_MEMORY_SCOPE_AGENT);
                for (;;) {
                    if (tid == 0) qslot[0] = qnext;
                    __syncthreads();
                    const int it = (int)qslot[0];
                    __syncthreads();
                    if (it >= 576 + 288 + 576) break;
                    if (tid == 0) qnext = __hip_atomic_fetch_add(qctr, 1u, __ATOMIC_RELAXED, __HIP_MEMORY_SCOPE_AGENT);
                    int ln_i = lane; asm volatile("" : "+v"(ln_i)); const int tid_i = wave * 64 + ln_i;
                    const bool pall = (rep == 0 || PROBE_SUB == 7);
                    if (it < 576) { if (pall || PROBE_SUB == 0) rwkv_prep_item(a, l, it, lds, tid_i, ln_i, wave); }
                    else if (it < 576 + 288) { if (pall || PROBE_SUB == 2) conv_item(a, l, it - 576, lds, tid_i, ln_i, wave); }
                    else if (pall || PROBE_SUB == 1) ssd_prep_item(a, l, it - 576 - 288, tid_i);
                }
            }
        }
        if (rep + 1 < REPS(1)) xcd_barrier(bar); }
        SEAM(pb + 1);
        for (int rep = 0; rep < REPS(2); ++rep) {
        if (IN(pb + 2)) { PH_LOCALS PH_IDS
            __syncthreads();
            if (bid < 64) { if (rep == 0 || PROBE_SUB == 0 || PROBE_SUB == 7) rwkv_scan_chunk(a, bid, lds, tid, lane, wave); }
            else if (bid < 160) { if (rep == 0 || PROBE_SUB == 1 || PROBE_SUB == 7) ssd_scan_fast(a, bid - 64, lds, tid, lane, wave); }
            __syncthreads();
            if (rep == 0 || PROBE_SUB == 2 || PROBE_SUB == 7) {
                pg8::Sched2 S; S.A0 = (const char*)Hb; S.B0 = (const char*)(wl + WO_IN); S.A1 = S.A0; S.B1 = S.B0; S.tstep = (size_t)256 * DM * 2; S.ntk = DM / 64;
                const int gpan = TLAT / 256;
                S.t0.init(gpan, GATE_LATE); S.t1.init(0, 0); S.pn_off0 = NU / 256 - GATE_LATE;
                if (bid >= 160) { S.G = 96; S.c = bid - 160; S.first = 0; S.limit = GATE_X; }
                else if (bid < 64) { S.G = 64; S.c = bid; S.first = GATE_X; S.limit = GATE_X + GATE_Z; }
                else { S.G = 96; S.c = bid - 64; S.first = GATE_X + GATE_Z; S.limit = GATE_STATIC; }
                pg8::EpiIn2 E{pg8::EpiInproj{(bf16*)(ws + OFF_U), (float*)(ws + OFF_MISC), NU}, pg8::EpiBf{0, (bf16*)(ws + OFF_VTL), (bf16*)(ws + OFF_VTC)}};
                pg8::gemm_phase<pg8::EpiIn2, pg8::Sched2, true, true>(lds, DM, S, E, wave0);
                unsigned* gq = (unsigned*)(ws + OFF_CTL) + CW_GQ + ((l * 4 + rep) * 8) * 64;
                volatile LAS unsigned* gslot = (volatile LAS unsigned*)(lds + MISC_OFF) + 20;
                int qx = bid & 7, qtries = 0;
                for (;;) {
                    __syncthreads();
                    if (tid == 0) gslot[0] = __hip_atomic_fetch_add(gq + qx * 64, 1u, __ATOMIC_RELAXED, __HIP_MEMORY_SCOPE_AGENT);
                    __syncthreads();
                    const int gu = GATE_STATIC + 8 * (int)gslot[0] + qx;
                    if (gu >= gpan * GATE_LATE) { if (++qtries >= 8) break; qx = (qx + 1) & 7; continue; }
                    S.G = 1; S.c = 0; S.first = gu; S.limit = gu + 1;
                    pg8::gemm_phase<pg8::EpiIn2, pg8::Sched2, true, true>(lds, DM, S, E, wave0);
                } }
        }
        if (rep + 1 < REPS(2)) xcd_barrier(bar); }
        SEAM(pb + 2);
        for (int rep = 0; rep < REPS(3); ++rep) {
        if (IN(pb + 3)) { PH_BG post_phase(kargs(), l, bid, G, wave0); }
        if (rep + 1 < REPS(3)) xcd_barrier(bar); }
        SEAM(pb + 3);
        for (int rep = 0; rep < REPS(4); ++rep) {
        if (IN(pb + 4)) { PH_LOCALS
            __syncthreads();
            pg8::Sched2 S; S.A0 = (const char*)(ws + OFF_ACAT); S.B0 = (const char*)(wl + WO_CAT); S.A1 = S.A0; S.B1 = S.B0; S.tstep = (size_t)256 * ACW * 2; S.ntk = ACW / 64;
            S.t0.init(TLAT / 256, DM / 256); S.t1.init(0, 0); S.G = G; S.c = bid;
            pg8::EpiChain E{(const bf16*)(ws + OFF_U) + UGATE, NU, (bf16*)(ws + OFF_M)};
            pg8::gemm_phase<pg8::EpiChain, pg8::Sched2, true, true>(lds, ACW, S, E, wave0);
            if (!lastl) {
                pg8::SchedCB C; C.A = (const char*)(ws + OFF_ACAT); C.B = (const char*)(wl + WO_CAT); C.tstep = (size_t)256 * ACW * 2; C.G = G; C.c = bid;
                pg8::EpiGateSlab Eg{(const bf16*)(ws + OFF_U) + UGATE, NU, (bf16*)(ws + OFF_SCAT)};
                pg8::gemm_phase<pg8::EpiGateSlab, pg8::SchedCB, true, true>(lds, ACW, C, Eg, wave0); }
        }
        if (rep + 1 < REPS(4)) xcd_barrier(bar); }
        SEAM(pb + 4);
        for (int rep = 0; rep < REPS(5); ++rep) {
        if (IN(pb + 5)) { PH_LOCALS
            __syncthreads();
            pg8::SchedSplit S; S.A = (const char*)(ws + OFF_M); S.B = (const char*)(wl + WO_O); S.tstep = (size_t)256 * DM * 2; S.ntk = DM / 64; S.tm.init(32, 8); S.nctx = 0; S.G = G; S.c = bid;
            pg8::EpiF32 E{(bf16*)(ws + OFF_Y), (bf16*)(ws + OFF_YC)};
            pg8::gemm_phase<pg8::EpiF32, pg8::SchedSplit, true, true>(lds, DM, S, E, wave0);
            if (!lastl) {
                pg8::SchedCW C; C.A = (const char*)(ws + OFF_SCAT); C.B = (const char*)(wl + WO_O); C.G = G; C.c = bid;
                pg8::gemm_phase<pg8::EpiF32, pg8::SchedCW, true, true>(lds, DM, C, E, wave0); }
        }
        if (rep + 1 < REPS(5)) xcd_barrier(bar); }
        SEAM(pb + 5);
        for (int rep = 0; rep < REPS(6); ++rep) {
        if (IN(pb + 6)) { PH_LOCALS norm_phase(a, 1, ng + 1 * DM, ng + 2 * DM, mv + 2 * DM, mv + 3 * DM, bid, G, wave0, lastl ? TLAT : TT, !lastl, rep > 0, l == 0); }
        if (rep + 1 < REPS(6)) xcd_barrier(bar); }
        SEAM(pb + 6);
        for (int rep = 0; rep < REPS(7); ++rep) {
        if (IN(pb + 7)) { PH_LOCALS
            __syncthreads();
            pg8::Sched2 S; S.A0 = (const char*)Hb; S.B0 = (const char*)(wl + WO_UP); S.A1 = S.A0; S.B1 = S.B0; S.tstep = (size_t)256 * DM * 2; S.ntk = DM / 64;
            S.t0.init(lastl ? TLAT / 256 : TT / 256, DFF / 256); S.t1.init(0, 0); S.G = G; S.c = bid;
            pg8::EpiBf E{3, (bf16*)(ws + OFF_HB), nullptr};
            pg8::gemm_phase<pg8::EpiBf, pg8::Sched2, true, true>(lds, DM, S, E, wave0);
        }
        if (rep + 1 < REPS(7)) xcd_barrier(bar); }
        SEAM(pb + 7);
        for (int rep = 0; rep < REPS(8); ++rep) {
        if (IN(pb + 8)) { PH_LOCALS
            __syncthreads();
            pg8::SchedSplit S; S.A = (const char*)(ws + OFF_HB); S.B = (const char*)(wl + WO_DN); S.tstep = (size_t)256 * DFF * 2; S.ntk = DFF / 64; S.tm.init(32, 8); S.nctx = lastl ? 0 : 256; S.G = G; S.c = bid;
            pg8::EpiF32 E{(bf16*)(ws + OFF_Y), (bf16*)(ws + OFF_YC)};
            pg8::gemm_phase<pg8::EpiF32, pg8::SchedSplit, true, true>(lds, DFF, S, E, wave0);
        }
        if (rep + 1 < REPS(8)) xcd_barrier(bar); }
        SEAM(pb + 8);
        if (IN(pb + 9)) { PH_LOCALS
            if (!lastl) norm_phase(a, 1, ng + 3 * DM, ng + 4 * DM  , mv + 5 * DM, mv + 5 * 12288  , bid, G, wave0, TT, true);
            else norm_phase(a, 2, ng + 3 * DM, nullptr, mv + 5 * DM, nullptr, bid, G, wave0, TLAT);
        }
        SEAM(pb + 9);
    }
#undef IN
#undef SEAM
}

extern "C" void kernel_launch(void* const* d_in, const int* in_sizes, int n_in, void* d_out, int out_size, void* d_ws, size_t ws_size, hipStream_t stream) {
    static int grid = 0;
    if (grid == 0) {
        if (n_in != N_IN || out_size != TLAT * DM || ws_size < WS_END) { fprintf(stderr, "kernel_launch: unexpected shapes (n_in %d out %d ws %zu); nothing launched\n", n_in, out_size, ws_size); grid = -1; return; }
        int dev = 0, cus = 0;
        if (hipGetDevice(&dev) != hipSuccess || hipDeviceGetAttribute(&cus, hipDeviceAttributeMultiprocessorCount, dev) != hipSuccess) { grid = -1; return; }
        if (hipFuncSetAttribute((const void*)fwd, hipFuncAttributeMaxDynamicSharedMemorySize, LDS_BYTES) != hipSuccess) { fprintf(stderr, "kernel_launch: hipFuncSetAttribute failed\n"); grid = -1; return; }
        int per_cu = 0;
        if (hipOccupancyMaxActiveBlocksPerMultiprocessor(&per_cu, (const void*)fwd, NTHR, LDS_BYTES) != hipSuccess || per_cu < 1) fprintf(stderr, "kernel_launch: occupancy query says %d\n", per_cu);
        (void)hipGetLastError();
        grid = cus;
        if (grid != 256) { fprintf(stderr, "kernel_launch: %d CUs: this kernel's phase program is laid out for 256 workgroups (one per CU of an MI355X)\n", grid); grid = -1; return; }
    }
    if (grid < 0) return;
    if (hipMemsetAsync((char*)d_ws + OFF_CTL, 0, CTL_BYTES, stream) != hipSuccess) return;
    Args a{};
    for (int i = 0; i < N_IN; ++i) a.in[i] = (const float*)d_in[i];
    a.out = (float*)d_out; a.ws = (unsigned char*)d_ws;
#if MK_ONE_LAUNCH
    a.ph_lo = 0; a.ph_hi = NPH;
    hipLaunchKernelGGL(fwd, dim3(grid), dim3(NTHR), LDS_BYTES, stream, a);
#else
    for (int p = 0; p < NPH; ++p) { a.ph_lo = p; a.ph_hi = p + 1; hipLaunchKernelGGL(fwd, dim3(grid), dim3(NTHR), LDS_BYTES, stream, a); }
#endif
}
```
